# Optimizing an MI355X kernel written in HIP

```python
import math
import jax, jax.numpy as jnp
from jax import lax
import numpy as np

D_MODEL = 1024
BATCH = 1
SEQ = 16384
DEPTH = 1

HEAD_DIM = 64
GRID_W = 64
Q_BLOCK = 128
EPS = 1e-6
ROPE_THETA = 10000.0
AX_DIM = HEAD_DIM // 2
A_HEADS = 8
A_KV_HEADS = 2
A_GROUP = A_HEADS // A_KV_HEADS
B_HEADS = 4
B_VDIM = 2 * HEAD_DIM
A_Q_COLS = A_HEADS * HEAD_DIM
A_KV_COLS = A_KV_HEADS * HEAD_DIM
B_QK_COLS = B_HEADS * 2 * HEAD_DIM
B_V_COLS = B_HEADS * B_VDIM
IN_COLS = A_Q_COLS + 2 * A_KV_COLS + 2 * B_QK_COLS + B_V_COLS
MIX_WIDTH = A_HEADS * HEAD_DIM + B_HEADS * B_VDIM
D_FF = 2816
LAMBDA_STD = 0.1

kernel_name = "hybrid_gqa_axialrope_diffattn_alibi_macaron"


def rms_norm(x, g):
    xf = x.astype(jnp.float32)
    y = xf * lax.rsqrt(jnp.mean(xf * xf, axis=-1, keepdims=True) + EPS)
    return (y * g.astype(jnp.float32)).astype(x.dtype)


def swiglu(h, w_gate, w_up, w_down):
    return (jax.nn.silu(h @ w_gate) * (h @ w_up)) @ w_down


def rotate(part, cos, sin):
    x1, x2 = part[..., : AX_DIM // 2], part[..., AX_DIM // 2:]
    c = cos[None, :, None, :]
    s = sin[None, :, None, :]
    return jnp.concatenate([x1 * c - x2 * s, x2 * c + x1 * s], axis=-1)


def axial_rope(x, cos_r, sin_r, cos_c, sin_c):
    xf = x.astype(jnp.float32)
    out = jnp.concatenate([rotate(xf[..., :AX_DIM], cos_r, sin_r),
                           rotate(xf[..., AX_DIM:], cos_c, sin_c)], axis=-1)
    return out.astype(x.dtype)


def gqa_axial_attention(q, k, v, q_norm, k_norm, rope):
    B, S = q.shape[0], q.shape[1]
    nb = S // Q_BLOCK
    q = axial_rope(rms_norm(q, q_norm), *rope)
    k = axial_rope(rms_norm(k, k_norm), *rope)
    scale = 1.0 / math.sqrt(HEAD_DIM)
    qb = q.reshape(B, nb, Q_BLOCK, A_KV_HEADS, A_GROUP, HEAD_DIM).transpose(1, 0, 2, 3, 4, 5)

    def block(qblk):
        s = jnp.einsum('bqgrd,bkgd->bgrqk', qblk, k).astype(jnp.float32) * scale
        p = jax.nn.softmax(s, axis=-1).astype(v.dtype)
        return jnp.einsum('bgrqk,bkgd->bqgrd', p, v)

    o = lax.map(block, qb)
    return o.transpose(1, 0, 2, 3, 4, 5).reshape(B, S, A_HEADS * HEAD_DIM)


def diff_alibi_attention(q, k, v, q_norm, k_norm, lq1, lk1, lq2, lk2, subln, lambda_init):
    B, S = q.shape[0], q.shape[1]
    nb = S // Q_BLOCK
    q = rms_norm(q, q_norm)
    k = rms_norm(k, k_norm)
    scale = 1.0 / math.sqrt(HEAD_DIM)
    lam = (jnp.exp(jnp.sum(lq1.astype(jnp.float32) * lk1.astype(jnp.float32), axis=-1))
           - jnp.exp(jnp.sum(lq2.astype(jnp.float32) * lk2.astype(jnp.float32), axis=-1))
           + lambda_init)
    slopes = 2.0 ** (-8.0 * (jnp.arange(B_HEADS, dtype=jnp.float32) + 1.0) / B_HEADS)
    k_pos = jnp.arange(S, dtype=jnp.int32)
    qb = q.reshape(B, nb, Q_BLOCK, B_HEADS, 2, HEAD_DIM).transpose(1, 0, 2, 3, 4, 5)
    starts = jnp.arange(nb, dtype=jnp.int32) * Q_BLOCK

    def block(args):
        qblk, start = args
        s = jnp.einsum('bqhcd,bkhcd->bhcqk', qblk, k).astype(jnp.float32) * scale
        q_pos = start + jnp.arange(Q_BLOCK, dtype=jnp.int32)
        dist = jnp.abs(q_pos[:, None] - k_pos[None, :]).astype(jnp.float32)
        s = s - slopes[None, :, None, None, None] * dist[None, None, None]
        p = jax.nn.softmax(s, axis=-1)
        attn = (p[:, :, 0] - lam[None, :, None, None] * p[:, :, 1]).astype(v.dtype)
        return jnp.einsum('bhqk,bkhe->bqhe', attn, v)

    o = lax.map(block, (qb, starts))
    o = o.transpose(1, 0, 2, 3, 4).reshape(B, S, B_HEADS, B_VDIM)
    o = rms_norm(o, subln) * (1.0 - lambda_init)
    return o.reshape(B, S, B_HEADS * B_VDIM)


def setup_inputs(seed: int = 0) -> dict:
    key = jax.random.key(seed)
    ks = jax.random.split(key, 24)
    f32 = jnp.float32

    def w(k, shape, fan_in):
        return jax.random.normal(k, shape, f32) * (fan_in ** -0.5)

    def gain(k, shape):
        return 1.0 + 0.01 * jax.random.normal(k, shape, f32)

    L = DEPTH
    return {
        "x": jax.random.normal(ks[0], (BATCH, SEQ, D_MODEL), f32),
        "ffn1_norm": gain(ks[1], (L, D_MODEL)),
        "ffn1_w_gate": w(ks[2], (L, D_MODEL, D_FF), D_MODEL),
        "ffn1_w_up": w(ks[3], (L, D_MODEL, D_FF), D_MODEL),
        "ffn1_w_down": w(ks[4], (L, D_FF, D_MODEL), D_FF),
        "attn_norm": gain(ks[5], (L, D_MODEL)),
        "w_in": w(ks[6], (L, D_MODEL, IN_COLS), D_MODEL),
        "a_q_norm": gain(ks[7], (L, HEAD_DIM)),
        "a_k_norm": gain(ks[8], (L, HEAD_DIM)),
        "b_q_norm": gain(ks[9], (L, HEAD_DIM)),
        "b_k_norm": gain(ks[10], (L, HEAD_DIM)),
        "lambda_q1": LAMBDA_STD * jax.random.normal(ks[11], (L, B_HEADS, HEAD_DIM), f32),
        "lambda_k1": LAMBDA_STD * jax.random.normal(ks[12], (L, B_HEADS, HEAD_DIM), f32),
        "lambda_q2": LAMBDA_STD * jax.random.normal(ks[13], (L, B_HEADS, HEAD_DIM), f32),
        "lambda_k2": LAMBDA_STD * jax.random.normal(ks[14], (L, B_HEADS, HEAD_DIM), f32),
        "b_subln": gain(ks[15], (L, B_VDIM)),
        "w_out": w(ks[16], (L, MIX_WIDTH, D_MODEL), MIX_WIDTH),
        "ffn2_norm": gain(ks[17], (L, D_MODEL)),
        "ffn2_w_gate": w(ks[18], (L, D_MODEL, D_FF), D_MODEL),
        "ffn2_w_up": w(ks[19], (L, D_MODEL, D_FF), D_MODEL),
        "ffn2_w_down": w(ks[20], (L, D_FF, D_MODEL), D_FF),
    }


def reference(x, ffn1_norm, ffn1_w_gate, ffn1_w_up, ffn1_w_down, attn_norm, w_in,
              a_q_norm, a_k_norm, b_q_norm, b_k_norm, lambda_q1, lambda_k1, lambda_q2, lambda_k2,
              b_subln, w_out, ffn2_norm, ffn2_w_gate, ffn2_w_up, ffn2_w_down):
    B, S, _ = x.shape
    ROWS = S // GRID_W
    row = jnp.broadcast_to(jnp.arange(ROWS, dtype=jnp.float32)[:, None], (ROWS, GRID_W)).reshape(-1)
    col = jnp.broadcast_to(jnp.arange(GRID_W, dtype=jnp.float32)[None, :], (ROWS, GRID_W)).reshape(-1)
    inv_freq = ROPE_THETA ** (-jnp.arange(0, AX_DIM, 2, dtype=jnp.float32) / AX_DIM)
    ang_r = row[:, None] * inv_freq[None, :]
    ang_c = col[:, None] * inv_freq[None, :]
    rope = (jnp.cos(ang_r), jnp.sin(ang_r), jnp.cos(ang_c), jnp.sin(ang_c))

    split_at = [A_Q_COLS, A_Q_COLS + A_KV_COLS, A_Q_COLS + 2 * A_KV_COLS,
                A_Q_COLS + 2 * A_KV_COLS + B_QK_COLS, A_Q_COLS + 2 * A_KV_COLS + 2 * B_QK_COLS]

    for l in range(DEPTH):
        lambda_init = 0.8 - 0.6 * math.exp(-0.3 * l)
        h = rms_norm(x, ffn1_norm[l])
        x = x + 0.5 * swiglu(h, ffn1_w_gate[l], ffn1_w_up[l], ffn1_w_down[l])
        h = rms_norm(x, attn_norm[l])
        proj = h @ w_in[l]
        a_q, a_k, a_v, b_q, b_k, b_v = jnp.split(proj, split_at, axis=-1)
        a_out = gqa_axial_attention(
            a_q.reshape(B, S, A_HEADS, HEAD_DIM),
            a_k.reshape(B, S, A_KV_HEADS, HEAD_DIM),
            a_v.reshape(B, S, A_KV_HEADS, HEAD_DIM),
            a_q_norm[l], a_k_norm[l], rope)
        b_out = diff_alibi_attention(
            b_q.reshape(B, S, B_HEADS, 2, HEAD_DIM),
            b_k.reshape(B, S, B_HEADS, 2, HEAD_DIM),
            b_v.reshape(B, S, B_HEADS, B_VDIM),
            b_q_norm[l], b_k_norm[l], lambda_q1[l], lambda_k1[l], lambda_q2[l], lambda_k2[l],
            b_subln[l], lambda_init)
        x = x + jnp.concatenate([a_out, b_out], axis=-1) @ w_out[l]
        h = rms_norm(x, ffn2_norm[l])
        x = x + 0.5 * swiglu(h, ffn2_w_gate[l], ffn2_w_up[l], ffn2_w_down[l])
    return x
```

```cpp
#include <hip/hip_runtime.h>
#include <cstdio>
#include <cstdint>

constexpr int NWAVES = 8;
constexpr int M = 16384, D = 1024, FF = 2816, NGU = 2 * FF, NIN = 2304;
constexpr size_t MiB = 1u << 20;
constexpr size_t WS_CTL = 0, CTL_ZERO_BYTES = 64 * 1024;
constexpr size_t WS_WGU1 = 2 * MiB, WS_WD1 = 13 * MiB, WS_WIN = 19 * MiB, WS_WOUT = 24 * MiB, WS_WGU2 = 26 * MiB, WS_WD2 = 37 * MiB;
constexpr size_t WS_ROPE = 43 * MiB, WS_SSQ = 44 * MiB;
constexpr size_t WS_XB = 48 * MiB;
constexpr size_t WS_H = 80 * MiB;
constexpr size_t WS_QA = 80 * MiB, WS_KA = 96 * MiB, WS_VA = 100 * MiB, WS_QB = 104 * MiB, WS_KB = 120 * MiB, WS_VB = 136 * MiB, WS_MIX = 152 * MiB;
constexpr size_t WS_END = 184 * MiB;
static_assert(WS_WGU1 + (size_t)NGU * D * 2 <= WS_WD1 && WS_WD1 + (size_t)D * FF * 2 <= WS_WIN && WS_WIN + (size_t)NIN * D * 2 <= WS_WOUT && WS_WOUT + (size_t)D * D * 2 <= WS_WGU2 &&
              WS_WGU2 + (size_t)NGU * D * 2 <= WS_WD2 && WS_WD2 + (size_t)D * FF * 2 <= WS_ROPE && WS_H + (size_t)M * FF * 2 <= WS_END && WS_MIX + (size_t)M * D * 2 <= WS_END, "d_ws map");
constexpr int CW_BAR = 1024;
constexpr int CW_QUEUE = 8192;
constexpr int RING_OFF = 0, RING_BYTES = 131072;
constexpr int LDSCTL_OFF = RING_BYTES, MISC_OFF = LDSCTL_OFF + 320, RSTD_OFF = LDSCTL_OFF + 1024, PRM_OFF = LDSCTL_OFF + 8192;
constexpr int LDS_BYTES = 147456;
constexpr int PRM_GAQ = 0, PRM_GAK = 64, PRM_GBQ = 128, PRM_GBK = 192, PRM_SUBLN = 256, PRM_NEGM2A = 384, PRM_NEGM2B = 385, PRM_LAM = 388, PRM_WORDS = 392;
static_assert(RSTD_OFF + 6 * 256 * 4 <= PRM_OFF && PRM_OFF + PRM_WORDS * 4 <= LDS_BYTES, "LDS map");

__device__ __forceinline__ int lane_id_v() { int l; asm volatile("v_mbcnt_lo_u32_b32 %0, -1, 0\n\tv_mbcnt_hi_u32_b32 %0, -1, %0" : "=v"(l)); return l; }
namespace pg8 {
#define PG8_LAS __attribute__((address_space(3)))
typedef unsigned short bf16_t;
typedef short bf16x8 __attribute__((ext_vector_type(8)));
typedef float f32x4 __attribute__((ext_vector_type(4)));
typedef unsigned u32x4 __attribute__((ext_vector_type(4)));
constexpr int BM = 256, BK = 64, HALF = 128, HTB = HALF * BK * 2  , STAGE_BYTES = 8 * HTB, NXCD = 8, WGM = 8;

__host__ __device__ __forceinline__ int lds_byte(int r, int c) { const int st = (r >> 4) * 2 + (c >> 5), rr = r & 15, cc = c & 31, ob = rr * 64 + cc * 2; return st * 1024 + (ob ^ (((ob >> 9) & 1) << 5)); }
__host__ __device__ __forceinline__ void stage_rc(int b, int& R, int& C) { const int st = b / 1024, sb = b % 1024, swz = sb ^ (((sb >> 9) & 1) << 5); R = (st >> 1) * 16 + swz / 64; C = (st & 1) * 32 + (swz % 64) / 2; }
__host__ __device__ __forceinline__ int perm32(int rho) { const int n = rho >> 4, i = rho & 15; return 8 * (i >> 2) + 4 * n + (i & 3); }

struct Unit { int pm, pn; };
struct Gemm { const bf16_t* A; const bf16_t* Bt; int M, N, K; };

template <int MD, int ND> struct StaticOrderT {
    static constexpr int nM = MD / BM, nN = ND / BM, nwg = nM * nN;
    int G, c;
    __host__ __device__ void init(int G_, int c_) { G = G_; c = c_; }
    __host__ __device__ bool next(int i, Unit& u) const {
        const int L = i * G + c; if (L >= nwg) return false;
        int wgid = L; { constexpr int q = nwg / NXCD, r = nwg % NXCD; const int xcd = wgid % NXCD, off = wgid / NXCD; wgid = (xcd < r ? xcd * (q + 1) : r * (q + 1) + (xcd - r) * q) + off; }
        constexpr int nig = WGM * nN; const int gid = wgid / nig, fm = gid * WGM, gsz = (nM - fm) < WGM ? (nM - fm) : WGM;
        u.pm = fm + ((wgid % nig) % gsz); u.pn = (wgid % nig) / gsz; return true;
    }
    __device__ __forceinline__ void a_ready(const Unit&) const {}
    __device__ __forceinline__ void done(const Unit&) const {}
};


__device__ __forceinline__ unsigned cvt_pk_bf16(float lo, float hi) { unsigned r; asm volatile("v_cvt_pk_bf16_f32 %0, %1, %2" : "=v"(r) : "v"(lo), "v"(hi)); return r; }
__device__ __forceinline__ unsigned short f2bf1(float f) { unsigned u = __builtin_bit_cast(unsigned, f); return (unsigned short)((u + 0x7fffu + ((u >> 16) & 1u)) >> 16); }
typedef unsigned u32x2 __attribute__((ext_vector_type(2)));
constexpr int MROWS = M, DMODEL = D, DFF = FF;

__device__ __forceinline__ f32x4 swiglu4(f32x4 g, f32x4 u) {
    f32x4 o;
#pragma unroll
    for (int e = 0; e < 4; ++e) { const float ex = __builtin_amdgcn_exp2f(g[e] * -1.4426950408889634f); o[e] = g[e] * u[e] * __builtin_amdgcn_rcpf(1.0f + ex); }
    return o;
}
struct EpiSwiGLU {
    static constexpr bool PERM = true, AFTER_DRAIN = false;
    unsigned char* ws; const PG8_LAS float* rstd;
    __device__ __forceinline__ void operator()(const f32x4 (&acc)[2][2][4][2], const Unit& u, int ui, int wr, int wc, int fr, int fq) const {
        const int col0 = u.pn * 128 + wc * 32 + 8 * fq; unsigned char* w2 = ws; asm volatile("" : "+s"(w2)); bf16_t* H = (bf16_t*)(w2 + WS_H);
#pragma unroll
        for (int ai = 0; ai < 2; ++ai)
#pragma unroll
            for (int m = 0; m < 4; ++m) {
                const int rl = ai * HALF + wr * 64 + m * 16 + fr; const float rs = rstd[ui * 256 + rl];
                const f32x4 h0 = swiglu4(acc[ai][0][m][0] * rs, acc[ai][1][m][0] * rs), h1 = swiglu4(acc[ai][0][m][1] * rs, acc[ai][1][m][1] * rs);
                u32x4 w; w.x = cvt_pk_bf16(h0[0], h0[1]); w.y = cvt_pk_bf16(h0[2], h0[3]); w.z = cvt_pk_bf16(h1[0], h1[1]); w.w = cvt_pk_bf16(h1[2], h1[3]);
                *(u32x4*)(H + (size_t)(u.pm * BM + rl) * DFF + col0) = w;
            }
    }
};
template <bool WRITE_B, bool INPLACE> struct EpiResid {
    static constexpr bool PERM = false, AFTER_DRAIN = false;
    const float* base; float* out; unsigned char* ws; float alpha;
    __device__ __forceinline__ void operator()(const f32x4 (&acc)[2][2][4][2], const Unit& u, int ui, int wr, int wc, int fr, int fq) const {
        const int col0 = u.pn * BM + wc * 32 + 4 * fq;
        unsigned char* w2 = ws; asm volatile("" : "+s"(w2)); const float* bp = INPLACE ? out : base; bf16_t* xb = (bf16_t*)(w2 + WS_XB); float* ssqp = (float*)(w2 + WS_SSQ);
#pragma unroll
        for (int ai = 0; ai < 2; ++ai)
#pragma unroll
            for (int m = 0; m < 4; ++m) {
                const int row = u.pm * BM + ai * HALF + wr * 64 + m * 16 + fr; const size_t off = (size_t)row * DMODEL + col0; float ss = 0.f;
#pragma unroll
                for (int bj = 0; bj < 2; ++bj)
#pragma unroll
                    for (int n = 0; n < 2; ++n) { const size_t o = off + bj * HALF + n * 16; const f32x4 b = *(const f32x4*)(bp + o); const f32x4 v = b + acc[ai][bj][m][n] * alpha;
                        *(f32x4*)(out + o) = v;
                        if (WRITE_B) { ss += (v[0] * v[0] + v[1] * v[1]) + (v[2] * v[2] + v[3] * v[3]); u32x2 w; w.x = cvt_pk_bf16(v[0], v[1]); w.y = cvt_pk_bf16(v[2], v[3]); *(u32x2*)(xb + o) = w; } }
                if (WRITE_B) { ss += __shfl_xor(ss, 16); ss += __shfl_xor(ss, 32); if (fq == 0) ssqp[(size_t)row * 16 + u.pn * 4 + wc] = ss; }
                asm volatile("" ::: "memory");
            }
    }
};
struct EpiInProj {
    static constexpr bool PERM = false, AFTER_DRAIN = false;
    const PG8_LAS float* rstd; const PG8_LAS float* prm; unsigned char* ws;
    __device__ __forceinline__ void operator()(const f32x4 (&acc)[2][2][4][2], const Unit& u, int ui, int wr, int wc, int fr, int fq) const {
        const int G = __builtin_amdgcn_readfirstlane(u.pn * 4 + wc);
        unsigned char* w2 = ws; asm volatile("" : "+s"(w2));
        const bool isv = (G == 10) | (G == 11) | (G >= 28);
        if (!isv) {
            const bool isq = (G < 8) | ((G >= 12) & (G < 20));
            const bool isrope = (G < 10);
            const PG8_LAS float* gp = prm + ((G < 8) ? PRM_GAQ : (G < 10) ? PRM_GAK : (G < 20) ? PRM_GBQ : PRM_GBK) + 4 * fq;
            const float* rope = (const float*)(w2 + WS_ROPE) + 4 * fq;
            const float qs = isq ? 0.125f * 1.4426950408889634f : 1.0f;
            bf16_t* dbase = isq ? ((G < 8) ? (bf16_t*)(w2 + WS_QA) + (size_t)G * MROWS * 64 : (bf16_t*)(w2 + WS_QB) + (size_t)(G - 12) * MROWS * 64)
                                : ((G < 10) ? (bf16_t*)(w2 + WS_KA) + (size_t)(G - 8) * MROWS * 64 : (bf16_t*)(w2 + WS_KB) + (size_t)(G - 20) * MROWS * 64);
#pragma unroll
            for (int ai = 0; ai < 2; ++ai)
#pragma unroll
                for (int m = 0; m < 4; ++m) {
                    const int rl = ai * HALF + wr * 64 + m * 16 + fr; const int t = u.pm * BM + rl; const float rs = rstd[ui * 256 + rl];
                    float ss = 0.f;
#pragma unroll
                    for (int bj = 0; bj < 2; ++bj)
#pragma unroll
                        for (int n = 0; n < 2; ++n) { const f32x4 a = acc[ai][bj][m][n]; ss += (a[0] * a[0] + a[1] * a[1]) + (a[2] * a[2] + a[3] * a[3]); }
                    ss += __shfl_xor(ss, 16); ss += __shfl_xor(ss, 32);
                    const float f = rs / sqrtf(ss * rs * rs * (1.0f / 64.0f) + 1e-6f);
#pragma unroll
                    for (int bj = 0; bj < 2; ++bj) {
                        f32x4 x1 = acc[ai][bj][m][0] * f * *(const PG8_LAS f32x4*)(gp + 32 * bj), x2 = acc[ai][bj][m][1] * f * *(const PG8_LAS f32x4*)(gp + 32 * bj + 16);
                        if (isrope) { const int pos = bj ? (t & 63) : (t >> 6); const float* rp = rope + (bj ? 8192 : 0) + pos * 16;
                            const f32x4 c = *(const f32x4*)rp, s = *(const f32x4*)(rp + (bj ? 1024 : 4096));
                            const f32x4 y1 = x1 * c - x2 * s, y2 = x2 * c + x1 * s; x1 = y1; x2 = y2; }
                        x1 = x1 * qs; x2 = x2 * qs;
                        u32x4 w; w.x = cvt_pk_bf16(x1[0], x1[1]); w.y = cvt_pk_bf16(x1[2], x1[3]); w.z = cvt_pk_bf16(x2[0], x2[1]); w.w = cvt_pk_bf16(x2[2], x2[3]);
                        const int c8 = 4 * bj + fq;
                        bf16_t* dst = isq ? dbase + (size_t)t * 64 + c8 * 8 : dbase + ((size_t)((t >> 6) * 8 + c8) * 64 + (t & 63)) * 8;
                        *(u32x4*)dst = w;
                    }
                    asm volatile("" ::: "memory");
                }
        } else {
            const int DV = (G < 12) ? 64 : 128, dbase = (G < 12) ? 0 : 64 * ((G - 28) & 1);
            bf16_t* V = (G < 12) ? (bf16_t*)(w2 + WS_VA) + (size_t)(G - 10) * MROWS * 64 : (bf16_t*)(w2 + WS_VB) + (size_t)((G - 28) >> 1) * MROWS * 128;
#pragma unroll
            for (int ai = 0; ai < 2; ++ai)
#pragma unroll
                for (int m = 0; m < 4; ++m) {
                    const int rl = ai * HALF + wr * 64 + m * 16 + fr; const int t = u.pm * BM + rl; const float rs = rstd[ui * 256 + rl];
                    const int kk = t & 63, ks = kk >> 4, ko = kk & 15, hi = (ko >> 2) & 1, j = ((ko >> 3) << 2) | (ko & 3);
                    bf16_t* vb = V + ((size_t)(((t >> 6) * 4 + ks) * 2 + hi) * DV + dbase + 4 * fq) * 8 + j;
#pragma unroll
                    for (int bj = 0; bj < 2; ++bj)
#pragma unroll
                        for (int n = 0; n < 2; ++n)
#pragma unroll
                            for (int e = 0; e < 4; ++e) vb[(32 * bj + 16 * n + e) * 8] = f2bf1(acc[ai][bj][m][n][e] * rs);
                    asm volatile("" ::: "memory");
                }
        }
    }
};

template <int KD, class Epi, class Sched, bool ALIGN_EPI = false, bool SP2 = false>
__device__ __forceinline__ void gemm_phase(PG8_LAS unsigned char* lds, const Gemm g, const Sched& S, const Epi& E, int wave_id) {
    int tid_ = wave_id * 64 + lane_id_v(); asm volatile("" : "+v"(tid_));
    const int tid = tid_, wid = __builtin_amdgcn_readfirstlane(tid >> 6), lane = tid & 63, wr = wid >> 2, wc = wid & 3, fr = lane & 15, fq = lane >> 4;
    constexpr int K = KD, nt = K / BK; static_assert(nt % 2 == 0, "even K-tile count");
    unsigned voffA[2], voffB[2];
#pragma unroll
    for (int i = 0; i < 2; ++i) { int R, C; stage_rc(tid * 16 + i * 8192, R, C); const int Rb = Epi::PERM ? ((R & ~31) + perm32(R & 31)) : R;
        voffA[i] = (unsigned)(R * K + C) * 2u; voffB[i] = (unsigned)(Rb * K + C) * 2u; }
    constexpr size_t kstep = (size_t)(BK * 2);
    constexpr size_t hstep = (size_t)HALF * K * 2;
    constexpr size_t tstep = 2 * hstep;
    const unsigned ldsw = (unsigned)wid * 1024u;
    const int aoff = lds_byte(wr * 64 + fr, fq * 8), boff = lds_byte(wc * 32 + fr, fq * 8);
#define PG8_SA(b, h) (((b) * 2 + (h)) * HTB)
#define PG8_SB(b, h) ((4 + (b) * 2 + (h)) * HTB)
#define PG8_STAGE(bufoff, gbase, voff) do { _Pragma("unroll") for (int _i = 0; _i < 2; ++_i) \
        __builtin_amdgcn_global_load_lds((const unsigned*)((const char*)(gbase) + (voff)[_i]), (PG8_LAS unsigned*)(lds + (bufoff) + ldsw + _i * 8192), 16, 0, 0); } while (0)
#define PG8_LDA(dst, b, h) do { _Pragma("unroll") for (int m = 0; m < 4; ++m) _Pragma("unroll") for (int k = 0; k < 2; ++k) dst[m][k] = *(const PG8_LAS bf16x8*)(lds + PG8_SA(b, h) + aoff + m * 2048 + k * 1024); } while (0)
#define PG8_LDB(dst, b, h) do { _Pragma("unroll") for (int n = 0; n < 2; ++n) _Pragma("unroll") for (int k = 0; k < 2; ++k) dst[n][k] = *(const PG8_LAS bf16x8*)(lds + PG8_SB(b, h) + boff + n * 2048 + k * 1024); } while (0)
#define PG8_MMA(ai, bj, At, Bt) do { __builtin_amdgcn_s_setprio(1); _Pragma("unroll") for (int m = 0; m < 4; ++m) _Pragma("unroll") for (int n = 0; n < 2; ++n) _Pragma("unroll") for (int k = 0; k < 2; ++k) \
        acc[ai][bj][m][n] = __builtin_amdgcn_mfma_f32_16x16x32_bf16(Bt[n][k], At[m][k], acc[ai][bj][m][n], 0, 0, 0); __builtin_amdgcn_s_setprio(0); } while (0)
#define PG8_WAIT_V(n) asm volatile("s_waitcnt vmcnt(" #n ")" ::: "memory")
#define PG8_WAIT_L(n) asm volatile("s_waitcnt lgkmcnt(" #n ")" ::: "memory")
#define PG8_BAR __builtin_amdgcn_s_barrier()
#define PG8_SCHED __builtin_amdgcn_sched_barrier(0)
    Unit cur, nxt; int ui = 0;
    if (!S.next(0, cur)) return;
    f32x4 acc[2][2][4][2];
#pragma unroll
    for (int a = 0; a < 2; ++a)
#pragma unroll
        for (int b = 0; b < 2; ++b)
#pragma unroll
            for (int m = 0; m < 4; ++m)
#pragma unroll
                for (int n = 0; n < 2; ++n) acc[a][b][m][n] = (f32x4){0.f, 0.f, 0.f, 0.f};
    bf16x8 At[4][2], B0[2][2], B1[2][2];
    const char* cA = (const char*)g.A + (size_t)cur.pm * tstep; const char* cB = (const char*)g.Bt + (size_t)cur.pn * tstep;
    S.a_ready(cur);
    if constexpr (SP2) {
        PG8_STAGE(PG8_SB(0, 0), cB, voffB); PG8_STAGE(PG8_SB(0, 1), cB + hstep, voffB); PG8_STAGE(PG8_SA(0, 0), cA, voffA); PG8_STAGE(PG8_SA(0, 1), cA + hstep, voffA);
        if (wr == 1) PG8_BAR;
        PG8_WAIT_V(2); PG8_BAR;
        PG8_STAGE(PG8_SB(1, 0), cB + kstep, voffB); PG8_STAGE(PG8_SA(1, 0), cA + kstep, voffA); PG8_STAGE(PG8_SB(1, 1), cB + hstep + kstep, voffB);
        PG8_WAIT_V(6); PG8_BAR;
    } else {
        PG8_STAGE(PG8_SB(0, 0), cB, voffB); PG8_STAGE(PG8_SA(0, 0), cA, voffA); PG8_STAGE(PG8_SB(0, 1), cB + hstep, voffB); PG8_STAGE(PG8_SA(0, 1), cA + hstep, voffA);
        if (wr == 1) PG8_BAR;
        PG8_WAIT_V(4); PG8_BAR;
        PG8_STAGE(PG8_SB(1, 0), cB + kstep, voffB); PG8_STAGE(PG8_SA(1, 0), cA + kstep, voffA); PG8_STAGE(PG8_SB(1, 1), cB + hstep + kstep, voffB);
        PG8_WAIT_V(6); PG8_BAR;
    }
    for (;;) {
        const bool has_next = S.next(ui + 1, nxt);
        const char* nA = has_next ? (const char*)g.A + (size_t)nxt.pm * tstep : cA; const char* nB = has_next ? (const char*)g.Bt + (size_t)nxt.pn * tstep : cB;
        for (int t = 0; t < nt; t += 2) {
            const bool last = (t == nt - 2);
            const char* a1 = cA + (size_t)(t + 1) * kstep;
            const char* a2 = last ? nA : cA + (size_t)(t + 2) * kstep; const char* b2 = last ? nB : cB + (size_t)(t + 2) * kstep;
            const char* a3 = a2 + kstep; const char* b3 = b2 + kstep;
            if (last && has_next) S.a_ready(nxt);
            if constexpr (SP2) {
            PG8_LDB(B0, 0, 0); PG8_LDB(B1, 0, 1); PG8_SCHED; PG8_LDA(At, 0, 0); PG8_STAGE(PG8_SA(1, 1), a1 + hstep, voffA);
            PG8_WAIT_V(8); PG8_WAIT_L(0); PG8_BAR; PG8_MMA(0, 0, At, B0); PG8_MMA(0, 1, At, B1); PG8_BAR; PG8_SCHED;
            PG8_LDA(At, 0, 1); PG8_STAGE(PG8_SB(0, 0), b2, voffB); PG8_STAGE(PG8_SB(0, 1), b2 + hstep, voffB); PG8_STAGE(PG8_SA(0, 0), a2, voffA);
            PG8_WAIT_V(8); PG8_WAIT_L(0); PG8_BAR; PG8_MMA(1, 0, At, B0); PG8_MMA(1, 1, At, B1); PG8_BAR; PG8_SCHED;
            PG8_LDB(B0, 1, 0); PG8_LDB(B1, 1, 1); PG8_SCHED; PG8_LDA(At, 1, 0); PG8_STAGE(PG8_SA(0, 1), a2 + hstep, voffA);
            PG8_WAIT_V(8); PG8_WAIT_L(0); PG8_BAR; PG8_MMA(0, 0, At, B0); PG8_MMA(0, 1, At, B1); PG8_BAR; PG8_SCHED;
            PG8_LDA(At, 1, 1); PG8_STAGE(PG8_SB(1, 0), b3, voffB); PG8_STAGE(PG8_SB(1, 1), b3 + hstep, voffB); PG8_STAGE(PG8_SA(1, 0), a3, voffA);
            PG8_WAIT_V(8); PG8_WAIT_L(0); PG8_BAR; PG8_MMA(1, 0, At, B0); PG8_MMA(1, 1, At, B1); PG8_BAR; PG8_SCHED;
            } else {
            PG8_LDB(B0, 0, 0); PG8_SCHED; PG8_LDA(At, 0, 0); PG8_STAGE(PG8_SA(1, 1), a1 + hstep, voffA);
            PG8_WAIT_L(8); PG8_BAR; PG8_WAIT_L(0); PG8_MMA(0, 0, At, B0); PG8_BAR; PG8_SCHED;
            PG8_LDB(B1, 0, 1); PG8_STAGE(PG8_SB(0, 0), b2, voffB);
            PG8_BAR; PG8_WAIT_L(0); PG8_MMA(0, 1, At, B1); PG8_BAR;
            PG8_LDA(At, 0, 1); PG8_STAGE(PG8_SA(0, 0), a2, voffA);
            PG8_BAR; PG8_WAIT_L(0); PG8_MMA(1, 0, At, B0); PG8_BAR; PG8_SCHED;
            PG8_STAGE(PG8_SB(0, 1), b2 + hstep, voffB);
            PG8_WAIT_V(6); PG8_BAR; PG8_MMA(1, 1, At, B1); PG8_BAR;
            PG8_LDB(B0, 1, 0); PG8_SCHED; PG8_LDA(At, 1, 0); PG8_STAGE(PG8_SA(0, 1), a2 + hstep, voffA);
            PG8_WAIT_L(8); PG8_BAR; PG8_WAIT_L(0); PG8_MMA(0, 0, At, B0); PG8_BAR; PG8_SCHED;
            PG8_LDB(B1, 1, 1); PG8_STAGE(PG8_SB(1, 0), b3, voffB);
            PG8_BAR; PG8_WAIT_L(0); PG8_MMA(0, 1, At, B1); PG8_BAR;
            PG8_LDA(At, 1, 1); PG8_STAGE(PG8_SA(1, 0), a3, voffA);
            PG8_BAR; PG8_WAIT_L(0); PG8_MMA(1, 0, At, B0); PG8_BAR; PG8_SCHED;
            PG8_STAGE(PG8_SB(1, 1), b3 + hstep, voffB);
            PG8_WAIT_V(6); PG8_BAR; PG8_MMA(1, 1, At, B1); PG8_BAR;
            }
        }
        if constexpr (ALIGN_EPI) { if (wr == 0) PG8_BAR; }
        if constexpr (!Epi::AFTER_DRAIN) { E(acc, cur, ui, wr, wc, fr, fq); S.done(cur); }
        if (!has_next) break;
#pragma unroll
        for (int a = 0; a < 2; ++a)
#pragma unroll
            for (int b = 0; b < 2; ++b)
#pragma unroll
                for (int m = 0; m < 4; ++m)
#pragma unroll
                    for (int n = 0; n < 2; ++n) acc[a][b][m][n] = (f32x4){0.f, 0.f, 0.f, 0.f};
        cur = nxt; cA = nA; cB = nB; ++ui;
        if constexpr (ALIGN_EPI) { if (wr == 1) PG8_BAR; }
    }
    PG8_WAIT_V(0);
    if constexpr (!ALIGN_EPI) { if (wr == 0) PG8_BAR; }
    PG8_BAR;
    if constexpr (Epi::AFTER_DRAIN) { E.fused(acc, cur, wr, wc, fr, fq, lds, wid, lane); S.done(cur); }
#undef PG8_SA
#undef PG8_SB
#undef PG8_STAGE
#undef PG8_LDA
#undef PG8_LDB
#undef PG8_MMA
#undef PG8_WAIT_V
#undef PG8_WAIT_L
#undef PG8_BAR
#undef PG8_SCHED
}
}
namespace att {
typedef unsigned short bf16_t;
typedef short bf16x8 __attribute__((ext_vector_type(8)));
typedef float f32x16 __attribute__((ext_vector_type(16)));
typedef float f32x4 __attribute__((ext_vector_type(4)));
typedef unsigned u32x4 __attribute__((ext_vector_type(4)));
#define ALAS __attribute__((address_space(3)))
constexpr int MROWS = M;
constexpr int SLOT = 32768, OFF_V = 16384, NSLOT = 3, WSF_OFF = NSLOT * SLOT;
constexpr int LDS_NEED = WSF_OFF + 8 * 256;
__device__ __forceinline__ int crow(int r, int hi) { return (r & 3) + 8 * (r >> 2) + 4 * hi; }
__device__ __forceinline__ void glds16(const void* gsrc, unsigned lds_dst) { unsigned keep;
    asm volatile("s_mov_b32 %0, m0\n\ts_mov_b32 m0, %2\n\ts_nop 0\n\tglobal_load_lds_dwordx4 %1, off\n\ts_mov_b32 m0, %0" : "=&s"(keep) : "v"(gsrc), "s"(lds_dst) : "memory"); }
typedef float f32x2_t __attribute__((ext_vector_type(2))); typedef __bf16 bf16x2_t __attribute__((ext_vector_type(2)));
__device__ __forceinline__ unsigned cvtpk(float lo, float hi) { f32x2_t v = {lo, hi}; bf16x2_t b = __builtin_convertvector(v, bf16x2_t); return __builtin_bit_cast(unsigned, b); }
#define ATT_WAIT_BAR(N) asm volatile("s_waitcnt vmcnt(" #N ") lgkmcnt(0)\n\ts_barrier" ::: "memory")
#define ATT_MFMA(a, b, c) __builtin_amdgcn_mfma_f32_32x32x16_bf16(a, b, c, 0, 0, 0)

struct Tensors { const bf16_t *QA, *KA, *VA, *QB, *KB, *VB; bf16_t* MIX; const ALAS float* subln; };
__device__ __forceinline__ Tensors make_tensors(unsigned char* ws, const ALAS float* prm) { return Tensors{(const bf16_t*)(ws + WS_QA), (const bf16_t*)(ws + WS_KA), (const bf16_t*)(ws + WS_VA), (const bf16_t*)(ws + WS_QB), (const bf16_t*)(ws + WS_KB), (const bf16_t*)(ws + WS_VB), (bf16_t*)(ws + WS_MIX), prm + PRM_SUBLN}; }

template <bool ISB>
__device__ __forceinline__ void attn_unit(const Tensors& T, int head, int qb, float negM2, float lam, float c2, int dskip, char* shm, int wave_id) {
    constexpr int DV = ISB ? 128 : 64, ND0 = DV / 32;
    int tid_ = wave_id * 64 + lane_id_v(); asm volatile("" : "+v"(tid_));
    const int tid = tid_, lane = tid & 63, r32 = lane & 31, hi = lane >> 5; const int wid = __builtin_amdgcn_readfirstlane(tid >> 6);
    const int mapc = ISB ? (wid >> 2) : 0, wq = ISB ? (wid & 3) : wid;
    const int q0 = ISB ? qb * 128 : qb * 256; const int qrow = q0 + wq * 32 + r32;
    int t0 = 0, t1 = 256;
    if (ISB) { const int lo = q0 - dskip, hi_ = q0 + 127 + dskip; t0 = lo > 0 ? (lo >> 6) : 0; t1 = (hi_ >> 6) + 1; if (t1 > 256) t1 = 256; }
    const unsigned lds0 = (unsigned)(uintptr_t)shm;
    const ALAS char* shm3 = (const ALAS char*)shm;
    const char *k1src, *k2src = nullptr, *vsrc;
    if (ISB) { k1src = (const char*)(T.KB + (size_t)(2 * head) * MROWS * 64) + wid * 1024 + lane * 16; k2src = (const char*)(T.KB + (size_t)(2 * head + 1) * MROWS * 64) + wid * 1024 + lane * 16;
               vsrc = (const char*)(T.VB + (size_t)head * MROWS * 128) + wid * 1024 + lane * 16; }
    else { k1src = (const char*)(T.KA + (size_t)(head >> 2) * MROWS * 64) + wid * 1024 + lane * 16; vsrc = (const char*)(T.VA + (size_t)(head >> 2) * MROWS * 64) + wid * 1024 + lane * 16; }
    const unsigned dst0 = lds0 + wid * 1024;
#define ATT_DMA(t, so) do { if (ISB) { glds16(k1src + (size_t)(t) * 8192, (unsigned)__builtin_amdgcn_readfirstlane(dst0 + (so))); glds16(k2src + (size_t)(t) * 8192, (unsigned)__builtin_amdgcn_readfirstlane(dst0 + (so) + 8192)); \
        glds16(vsrc + (size_t)(t) * 16384, (unsigned)__builtin_amdgcn_readfirstlane(dst0 + (so) + OFF_V)); glds16(vsrc + (size_t)(t) * 16384 + 8192, (unsigned)__builtin_amdgcn_readfirstlane(dst0 + (so) + OFF_V + 8192)); } \
      else { glds16(k1src + (size_t)(t) * 8192, (unsigned)__builtin_amdgcn_readfirstlane(dst0 + (so))); glds16(vsrc + (size_t)(t) * 8192, (unsigned)__builtin_amdgcn_readfirstlane(dst0 + (so) + OFF_V)); } } while (0)
    ATT_DMA(t0, 0); if (t0 + 1 < t1) ATT_DMA(t0 + 1, SLOT);
    const bf16_t* Qw = (ISB ? T.QB + (size_t)(2 * head + mapc) * MROWS * 64 : T.QA + (size_t)head * MROWS * 64) + (size_t)qrow * 64;
    bf16x8 qr[4];
#pragma unroll
    for (int d0 = 0; d0 < 4; ++d0) qr[d0] = *(const bf16x8*)(Qw + d0 * 16 + hi * 8);
    f32x16 o[ND0];
#pragma unroll
    for (int d = 0; d < ND0; ++d) o[d] = f32x16{};
    f32x16 negm;
#pragma unroll
    for (int r = 0; r < 16; ++r) negm[r] = negM2;
    asm volatile("" : "+v"(negm));
    float sacc = 0.f;
    const int koff = (ISB ? mapc * 8192 : 0) + hi * 1024 + r32 * 16;
    const int voff = OFF_V + hi * (DV * 16) + r32 * 16;
    int s0 = 0, s1 = SLOT, s2 = 2 * SLOT;
    for (int t = t0; t < t1; ++t) {
        if (t + 1 < t1) { if (ISB) ATT_WAIT_BAR(4); else ATT_WAIT_BAR(2); } else ATT_WAIT_BAR(0);
        if (t + 2 < t1) ATT_DMA(t + 2, s2);
        const ALAS char* kp = shm3 + s0 + koff; const ALAS char* vp = shm3 + s0 + voff;
        f32x16 p0, p1;
        if (ISB) { const float dl = (float)(64 * t - qrow + 4 * hi); const float nc2 = -c2;
#pragma unroll
            for (int r = 0; r < 16; ++r) { const float cr = (float)((r & 3) + 8 * (r >> 2)); p0[r] = __builtin_fmaf(__builtin_fabsf(dl + cr), nc2, negM2); p1[r] = __builtin_fmaf(__builtin_fabsf(dl + (cr + 32.f)), nc2, negM2); } }
        else { p0 = negm; p1 = negm; }
#pragma unroll
        for (int d0 = 0; d0 < 4; ++d0) {
            const bf16x8 b0 = *(const ALAS bf16x8*)(kp + d0 * 2048), b1 = *(const ALAS bf16x8*)(kp + d0 * 2048 + 512);
            p0 = ATT_MFMA(b0, qr[d0], p0); p1 = ATT_MFMA(b1, qr[d0], p1);
        }
#pragma unroll
        for (int r = 0; r < 16; ++r) { p0[r] = __builtin_amdgcn_exp2f(p0[r]); p1[r] = __builtin_amdgcn_exp2f(p1[r]); }
        { float a = 0.f, b = 0.f;
#pragma unroll
          for (int r = 0; r < 16; ++r) { a += p0[r]; b += p1[r]; }
          sacc += a + b; }
        u32x4 pw[4];
#pragma unroll
        for (int i = 0; i < 4; ++i) { pw[0][i] = cvtpk(p0[2 * i], p0[2 * i + 1]); pw[1][i] = cvtpk(p0[8 + 2 * i], p0[9 + 2 * i]); pw[2][i] = cvtpk(p1[2 * i], p1[2 * i + 1]); pw[3][i] = cvtpk(p1[8 + 2 * i], p1[9 + 2 * i]); }
#pragma unroll
        for (int d = 0; d < ND0; ++d)
#pragma unroll
            for (int ks = 0; ks < 4; ++ks) { const bf16x8 vf = *(const ALAS bf16x8*)(vp + ks * (DV * 32) + d * 512); o[d] = ATT_MFMA(__builtin_bit_cast(bf16x8, pw[ks]), vf, o[d]); }
        { const int tmp = s0; s0 = s1; s1 = s2; s2 = tmp; }
    }
    ATT_WAIT_BAR(0);
    float l = sacc + __shfl_xor(sacc, 32);
    ALAS float* wsf = (ALAS float*)(shm3 + WSF_OFF) + wid * 64;
    if (hi == 0) wsf[r32] = l;
    asm volatile("s_waitcnt lgkmcnt(0)" ::: "memory");
    float rli[16];
#pragma unroll
    for (int r = 0; r < 16; ++r) rli[r] = __builtin_amdgcn_rcpf(wsf[crow(r, hi)]);
    if (!ISB) {
        ALAS bf16_t* stg = (ALAS bf16_t*)shm3 + wid * 2048;
#pragma unroll
        for (int r = 0; r < 16; ++r) { const int orow = crow(r, hi);
#pragma unroll
            for (int d = 0; d < ND0; ++d) stg[orow * 64 + d * 32 + r32] = pg8::f2bf1(o[d][r] * rli[r]); }
        asm volatile("s_waitcnt lgkmcnt(0)" ::: "memory");
#pragma unroll
        for (int i = 0; i < 4; ++i) { const int row = i * 8 + (lane >> 3), ch = lane & 7; const u32x4 v = *(const ALAS u32x4*)(stg + row * 64 + ch * 8);
            *(u32x4*)(T.MIX + (size_t)(q0 + wid * 32 + row) * 1024 + head * 64 + ch * 8) = v; }
    } else {
        ALAS float* X = (ALAS float*)shm3 + wq * 4096;
        const float sc = (mapc == 1) ? lam : 1.0f;
        if (mapc == 1) {
#pragma unroll
            for (int r = 0; r < 16; ++r) { const int orow = crow(r, hi); const float f = rli[r] * sc;
#pragma unroll
                for (int d = 0; d < ND0; ++d) X[orow * 128 + d * 32 + r32] = o[d][r] * f; }
        }
        asm volatile("s_waitcnt lgkmcnt(0)\n\ts_barrier" ::: "memory");
        if (mapc == 0) {
#pragma unroll
            for (int r = 0; r < 16; ++r) { const int orow = crow(r, hi);
#pragma unroll
                for (int d = 0; d < ND0; ++d) { const int idx = orow * 128 + d * 32 + r32; X[idx] = o[d][r] * rli[r] - X[idx]; } }
            asm volatile("s_waitcnt lgkmcnt(0)" ::: "memory");
            const int qq = lane >> 1, hf = lane & 1;
            const ALAS float* rowp = X + qq * 128 + hf * 64;
            f32x4 vv[16]; float ss = 0.f;
#pragma unroll
            for (int i = 0; i < 16; ++i) { vv[i] = *(const ALAS f32x4*)(rowp + 4 * i); ss += (vv[i][0] * vv[i][0] + vv[i][1] * vv[i][1]) + (vv[i][2] * vv[i][2] + vv[i][3] * vv[i][3]); }
            ss += __shfl_xor(ss, 1);
            const float rs = 0.8f / sqrtf(ss * (1.0f / 128.0f) + 1e-6f);
            bf16_t* dst = T.MIX + (size_t)(q0 + wq * 32 + qq) * 1024 + 512 + head * 128 + hf * 64;
            const ALAS float* sl = T.subln + hf * 64;
#pragma unroll
            for (int i = 0; i < 8; ++i) { const f32x4 g0 = *(const ALAS f32x4*)(sl + 8 * i), g1 = *(const ALAS f32x4*)(sl + 8 * i + 4); const f32x4 a = vv[2 * i] * rs * g0, b = vv[2 * i + 1] * rs * g1;
                u32x4 w; w.x = cvtpk(a[0], a[1]); w.y = cvtpk(a[2], a[3]); w.z = cvtpk(b[0], b[1]); w.w = cvtpk(b[2], b[3]); *(u32x4*)(dst + 8 * i) = w; }
        }
    }
    asm volatile("s_waitcnt lgkmcnt(0)\n\ts_barrier" ::: "memory");
#undef ATT_DMA
}
}
static_assert(att::LDS_NEED <= RING_BYTES, "LDS map");

#define GAS __attribute__((address_space(1)))
#define LAS __attribute__((address_space(3)))
typedef unsigned short bf16;
typedef unsigned v4u __attribute__((ext_vector_type(4)));
typedef float f32x4 __attribute__((ext_vector_type(4)));
typedef GAS unsigned gu32;
#define RLX_AGENT __ATOMIC_RELAXED, __HIP_MEMORY_SCOPE_AGENT
#define LDS_WAIT() asm volatile("s_waitcnt lgkmcnt(0)" ::: "memory")
#define VM_WAIT() asm volatile("s_waitcnt vmcnt(0)" ::: "memory")
__device__ __forceinline__ unsigned f2bf(float f) { unsigned u = __builtin_bit_cast(unsigned, f); return (u + 0x7fffu + ((u >> 16) & 1u)) >> 16; }
__device__ __forceinline__ unsigned pk2(float lo, float hi) { return f2bf(lo) | (f2bf(hi) << 16); }
#define XB_TMO      128
#define XB_XCNT(j)  (256  + 64 * (j))
#define XB_XSUB(j)  (1280 + 64 * (j))
#define XB_XGEN(j)  (2304 + 64 * (j))
#define XB_TOP      3328
#define XB_TOPGEN   3392
#define XCD_BAR_WORDS 3456
#define XB_SPIN_CAP (1u << 18)

__device__ __forceinline__ unsigned xb_ld(unsigned* p)              { return __hip_atomic_load(p, __ATOMIC_RELAXED, __HIP_MEMORY_SCOPE_AGENT); }
__device__ __forceinline__ unsigned xb_add(unsigned* p, unsigned v) { return __hip_atomic_fetch_add(p, v, __ATOMIC_RELAXED, __HIP_MEMORY_SCOPE_AGENT); }
__device__ __forceinline__ unsigned xb_xcc_id() { return (unsigned)__builtin_amdgcn_s_getreg((3 << 11) | 20) & 0xFu; }
#define XB_SPIN(cond, bar) do { unsigned _sp = 0; while (cond) { __builtin_amdgcn_s_sleep(1); \
    if ((++_sp & 255u) == 0u) { if (xb_ld(&(bar)[XB_TMO])) break; if (_sp > XB_SPIN_CAP) { atomicAdd(&(bar)[XB_TMO], 1u); break; } } } } while (0)

struct XcdBarrier {
    unsigned* bar; unsigned x;
    volatile LAS unsigned* st;
};

__device__ __forceinline__ XcdBarrier xcd_barrier_post(unsigned* bar, volatile LAS unsigned* st, bool t0) {
    XcdBarrier b; b.bar = bar; b.x = (unsigned)__builtin_amdgcn_readfirstlane((int)xb_xcc_id()); b.st = st;
    if (t0) (void)xb_add(&bar[XB_XCNT(b.x)], 1u);
    return b;
}
__device__ __forceinline__ void xcd_barrier_complete(unsigned* bar, unsigned x, unsigned& nloc, unsigned& nx) {
    const unsigned G = gridDim.x * gridDim.y * gridDim.z;
    unsigned sum, cnt, mine, sp = 0u;
    for (;;) {
        sum = 0u; cnt = 0u; mine = 0u;
#pragma unroll
        for (unsigned j = 0; j < 16; ++j) { const unsigned c = xb_ld(&bar[XB_XCNT(j)]); sum += c; cnt += (c > 0u) ? 1u : 0u; mine = (j == x) ? c : mine; }
        if (sum == G) break;
        __builtin_amdgcn_s_sleep(1);
        if ((++sp & 255u) == 0u) { if (xb_ld(&bar[XB_TMO])) break; if (sp > XB_SPIN_CAP) { atomicAdd(&bar[XB_TMO], 1u); break; } }
    }
    nloc = mine > 0u ? mine : 1u; nx = cnt > 0u ? cnt : 1u;
}

__device__ __forceinline__ void xcd_barrier(const XcdBarrier& b_, int wave_id) {
    XcdBarrier b = b_; asm volatile("" : "+s"(b.bar), "+s"(b.x));
    const bool t0 = (wave_id == 0) && (lane_id_v() == 0);
    asm volatile("s_waitcnt vmcnt(0)" ::: "memory");
    __syncthreads();
    if (t0) {
        unsigned* bar = b.bar;
        __builtin_amdgcn_s_waitcnt(0);
        unsigned nloc = b.st[0], nx = b.st[1];
        if (nloc == 0u) { xcd_barrier_complete(bar, b.x, nloc, nx); b.st[0] = nloc; b.st[1] = nx; }
        const unsigned old = xb_add(&bar[XB_XSUB(b.x)], 1u);
        const unsigned gen = old / nloc;
        if (old + 1u == (gen + 1u) * nloc) {
            __builtin_amdgcn_fence(__ATOMIC_RELEASE, "agent");
            asm volatile("s_waitcnt vmcnt(0)" ::: "memory");
            const unsigned og = xb_add(&bar[XB_TOP], 1u);
            const unsigned tg = og / nx;
            if (og + 1u == (tg + 1u) * nx) xb_add(&bar[XB_TOPGEN], 1u);
            else XB_SPIN(xb_ld(&bar[XB_TOPGEN]) == tg, bar);
            __builtin_amdgcn_fence(__ATOMIC_ACQUIRE, "agent");
            xb_add(&bar[XB_XGEN(b.x)], 1u);
            asm volatile("s_waitcnt vmcnt(0)" ::: "memory");
        } else {
            XB_SPIN(xb_ld(&bar[XB_XGEN(b.x)]) == gen, bar);
            __builtin_amdgcn_fence(__ATOMIC_ACQUIRE, "agent");
            asm volatile("s_waitcnt vmcnt(0)" ::: "memory");
        }
    }
    __syncthreads();
}
#ifndef PHMASK
#define PHMASK 63
#endif

__device__ __forceinline__ float wave_sum(float v) {
#pragma unroll
    for (int o = 1; o < 64; o <<= 1) v += __shfl_xor(v, o);
    return v;
}
__device__ __forceinline__ float wave_max(float v) {
#pragma unroll
    for (int o = 1; o < 64; o <<= 1) v = fmaxf(v, __shfl_xor(v, o));
    return v;
}
__device__ __forceinline__ void tr_item(const float* W, int ldw, int srccol0, const float* gain, bf16* WT, int K, int dstrow0, int k0, LAS float* scr, int lane) {
#pragma unroll 8
    for (int i = 0; i < 32; ++i) { const int kk = 2 * i + (lane >> 5); float w = W[(size_t)(k0 + kk) * ldw + srccol0 + (lane & 31)]; if (gain) w *= gain[k0 + kk]; scr[kk * 33 + (lane & 31)] = w; }
    LDS_WAIT(); asm volatile("" ::: "memory");
    const int c = lane & 7;
#pragma unroll
    for (int j = 0; j < 4; ++j) { const int n = (lane >> 3) + 8 * j; const LAS float* s = scr + (8 * c) * 33 + n;
        v4u o; o.x = pk2(s[0 * 33], s[1 * 33]); o.y = pk2(s[2 * 33], s[3 * 33]); o.z = pk2(s[4 * 33], s[5 * 33]); o.w = pk2(s[6 * 33], s[7 * 33]);
        *(GAS v4u*)(WT + (size_t)(dstrow0 + n) * K + k0 + 8 * c) = o; }
    LDS_WAIT(); asm volatile("" ::: "memory");
}

struct Args { const float* in[21]; float* out; unsigned char* ws; };
#define LAUNDER(p) asm volatile("" : "+s"(p))

__global__ void __launch_bounds__(NWAVES * 64, 2) mk_fwd(Args args) {
    extern __shared__ __attribute__((aligned(16))) unsigned char lds[];
    LAS unsigned char* L = (LAS unsigned char*)lds;
    volatile LAS unsigned* MISC = (volatile LAS unsigned*)(L + MISC_OFF);
    const int wave = __builtin_amdgcn_readfirstlane((int)threadIdx.x >> 6);
    const int G = gridDim.x; const int bx = blockIdx.x;
    unsigned char* ws = args.ws; float* out = args.out;
    { const int tid = wave * 64 + lane_id_v(); for (int u = tid; u < (LDS_BYTES - LDSCTL_OFF) / 4; u += NWAVES * 64) ((LAS unsigned*)(L + LDSCTL_OFF))[u] = 0u; }
    __syncthreads();
    XcdBarrier bar = xcd_barrier_post((unsigned*)((gu32*)(ws + WS_CTL) + CW_BAR), MISC + 8, (wave == 0) && (lane_id_v() == 0));
    LAS float* rstd_tab = (LAS float*)(L + RSTD_OFF);
    LAS float* PRM = (LAS float*)(L + PRM_OFF);
    if (wave == 0) {
        const int lane = lane_id_v();
        const float gaq = args.in[7][lane], gak = args.in[8][lane], gbq = args.in[9][lane], gbk = args.in[10][lane];
        PRM[PRM_GAQ + lane] = gaq; PRM[PRM_GAK + lane] = gak; PRM[PRM_GBQ + lane] = gbq; PRM[PRM_GBK + lane] = gbk;
        PRM[PRM_SUBLN + lane] = args.in[15][lane]; PRM[PRM_SUBLN + 64 + lane] = args.in[15][64 + lane];
        const float maq = wave_max(fabsf(gaq)), mak = wave_max(fabsf(gak)), mbq = wave_max(fabsf(gbq)), mbk = wave_max(fabsf(gbk));
        float lm[4];
#pragma unroll
        for (int h = 0; h < 4; ++h) { const float d1 = wave_sum(args.in[11][h * 64 + lane] * args.in[12][h * 64 + lane]), d2 = wave_sum(args.in[13][h * 64 + lane] * args.in[14][h * 64 + lane]); lm[h] = expf(d1) - expf(d2) + 0.2f; }
        if (lane == 0) { PRM[PRM_NEGM2A] = -(8.0f * 1.4426950408889634f * 1.02f) * maq * mak; PRM[PRM_NEGM2B] = -(8.0f * 1.4426950408889634f * 1.02f) * mbq * mbk;
            PRM[PRM_LAM + 0] = lm[0]; PRM[PRM_LAM + 1] = lm[1]; PRM[PRM_LAM + 2] = lm[2]; PRM[PRM_LAM + 3] = lm[3]; }
    }
    LDS_WAIT(); __syncthreads();

#define BUILD_RSTD(S) do { pg8::Unit u_; const int tid = wave * 64 + lane_id_v(); const float* SSQ_ = (const float*)(ws + WS_SSQ); for (int i_ = 0; i_ < 6 && (S).next(i_, u_); ++i_) if (tid < 256) { const f32x4* p_ = (const f32x4*)(SSQ_ + (size_t)(u_.pm * 256 + tid) * 16); \
        const f32x4 a_ = p_[0], b_ = p_[1], c_ = p_[2], d_ = p_[3]; const float s_ = ((a_[0] + a_[1]) + (a_[2] + a_[3])) + ((b_[0] + b_[1]) + (b_[2] + b_[3])) + ((c_[0] + c_[1]) + (c_[2] + c_[3])) + ((d_[0] + d_[1]) + (d_[2] + d_[3])); \
        rstd_tab[i_ * 256 + tid] = 1.0f / sqrtf(s_ * (1.0f / 1024.0f) + 1e-6f); } LDS_WAIT(); __syncthreads(); } while (0)

#if (PHMASK & 1)
    {
        const int lane = lane_id_v(), tid = wave * 64 + lane;
        const int vcu = (G % 8 == 0) ? (bx % 8) * (G / 8) + bx / 8 : bx;
        bf16 *WGU1 = (bf16*)(ws + WS_WGU1), *WD1 = (bf16*)(ws + WS_WD1), *WIN = (bf16*)(ws + WS_WIN), *WOUT = (bf16*)(ws + WS_WOUT), *WGU2 = (bf16*)(ws + WS_WGU2), *WD2 = (bf16*)(ws + WS_WD2);
        float* ROPE = (float*)(ws + WS_ROPE); float* SSQ = (float*)(ws + WS_SSQ); bf16* XB = (bf16*)(ws + WS_XB); const float* x = args.in[0];
        LAS float* scr = (LAS float*)(L + RING_OFF + wave * 16384);
        const int gw = vcu * NWAVES + wave, NGW = G * NWAVES;
        constexpr int I_GU = (D / 64) * (NGU / 32), I_D = (FF / 64) * (D / 32), I_IN = (D / 64) * (NIN / 32), I_OUT = (D / 64) * (D / 32);
        constexpr int NITEMS = 2 * I_GU + 2 * I_D + I_IN + I_OUT;
        for (int it = gw; it < NITEMS; it += NGW) {
            int r = it;
            if (r < 2 * I_GU) { const int l2 = r >= I_GU; if (l2) r -= I_GU; const int kb = r / (NGU / 32), nb = r % (NGU / 32), n0 = nb * 32, pn = n0 >> 8, j0 = n0 & 255;
                const float* src = (j0 < 128) ? (l2 ? args.in[18] : args.in[2]) : (l2 ? args.in[19] : args.in[3]);
                tr_item(src, FF, pn * 128 + (j0 & 127), l2 ? args.in[17] : args.in[1], l2 ? WGU2 : WGU1, D, n0, kb * 64, scr, lane); continue; }
            r -= 2 * I_GU;
            if (r < 2 * I_D) { const int l2 = r >= I_D; if (l2) r -= I_D; const int kb = r / (D / 32), nb = r % (D / 32);
                tr_item(l2 ? args.in[20] : args.in[4], D, nb * 32, nullptr, l2 ? WD2 : WD1, FF, nb * 32, kb * 64, scr, lane); continue; }
            r -= 2 * I_D;
            if (r < I_IN) { const int kb = r / (NIN / 32), nb = r % (NIN / 32), n0 = nb * 32, pn = n0 >> 8, j0 = n0 & 255, bj = j0 >> 7, wc = (j0 >> 5) & 3;
                tr_item(args.in[6], NIN, pn * 256 + wc * 64 + bj * 32, args.in[5], WIN, D, n0, kb * 64, scr, lane); continue; }
            r -= I_IN;
            { const int kb = r / (D / 32), nb = r % (D / 32); tr_item(args.in[16], D, nb * 32, nullptr, WOUT, D, nb * 32, kb * 64, scr, lane); }
        }
        for (int m = gw; m < M; m += NGW) {
            const GAS f32x4* xr = (const GAS f32x4*)(x + (size_t)m * D) + lane; f32x4 v[4]; float s = 0.f;
#pragma unroll
            for (int j = 0; j < 4; ++j) { v[j] = xr[64 * j]; s += (v[j][0] * v[j][0] + v[j][1] * v[j][1]) + (v[j][2] * v[j][2] + v[j][3] * v[j][3]); }
            s = wave_sum(s);
            GAS unsigned long long* o8 = (GAS unsigned long long*)(XB + (size_t)m * D) + lane;
#pragma unroll
            for (int j = 0; j < 4; ++j) o8[64 * j] = (unsigned long long)pk2(v[j][0], v[j][1]) | ((unsigned long long)pk2(v[j][2], v[j][3]) << 32);
            if (lane < 16) SSQ[(size_t)m * 16 + lane] = (lane == 0) ? s : 0.f;
        }
        for (int e = bx * (NWAVES * 64) + tid; e < 5120; e += G * NWAVES * 64) {
            const int isc = e >= 4096, ee = isc ? e - 4096 : e, pos = ee >> 4, i = ee & 15;
            const float invf = powf(10000.0f, -(float)i * (1.0f / 16.0f)); const float ang = (float)pos * invf; float sn, cs; sincosf(ang, &sn, &cs);
            if (isc) { ROPE[8192 + ee] = cs; ROPE[9216 + ee] = sn; } else { ROPE[ee] = cs; ROPE[4096 + ee] = sn; }
        }
    }
#endif
    xcd_barrier(bar, wave);

    for (int rep = 0; rep < 2; ++rep) {
#if (PHMASK & 2)
        {
            LAUNDER(ws);
            pg8::Gemm g{(const bf16*)(ws + WS_XB), (const bf16*)(ws + (rep ? WS_WGU2 : WS_WGU1)), M, NGU, D}; pg8::StaticOrderT<M, NGU> S; S.init(G, bx);
            BUILD_RSTD(S);
            pg8::EpiSwiGLU E{ws, rstd_tab};
            pg8::gemm_phase<D, pg8::EpiSwiGLU, pg8::StaticOrderT<M, NGU>, true, true>(L + RING_OFF, g, S, E, wave);
        }
#endif
        xcd_barrier(bar, wave);
#if (PHMASK & 4)
        {
            LAUNDER(ws); LAUNDER(out);
            pg8::Gemm g{(const bf16*)(ws + WS_H), (const bf16*)(ws + (rep ? WS_WD2 : WS_WD1)), M, D, FF}; pg8::StaticOrderT<M, D> S; S.init(G, bx);
            if (rep == 0) { pg8::EpiResid<true, false> E{args.in[0], out, ws, 0.5f}; pg8::gemm_phase<FF, pg8::EpiResid<true, false>, pg8::StaticOrderT<M, D>, false, true>(L + RING_OFF, g, S, E, wave); }
            else { pg8::EpiResid<false, true> E{nullptr, out, ws, 0.5f}; pg8::gemm_phase<FF, pg8::EpiResid<false, true>, pg8::StaticOrderT<M, D>, false, true>(L + RING_OFF, g, S, E, wave); }
        }
#endif
        if (rep == 1) break;
        xcd_barrier(bar, wave);
#if (PHMASK & 8)
        {
            LAUNDER(ws);
            pg8::Gemm g{(const bf16*)(ws + WS_XB), (const bf16*)(ws + WS_WIN), M, NIN, D}; pg8::StaticOrderT<M, NIN> S; S.init(G, bx);
            BUILD_RSTD(S);
            pg8::EpiInProj E{rstd_tab, PRM, ws};
            pg8::gemm_phase<D, pg8::EpiInProj, pg8::StaticOrderT<M, NIN>, true, true>(L + RING_OFF, g, S, E, wave);
        }
#endif
        xcd_barrier(bar, wave);
#if (PHMASK & 16)
        {
            LAUNDER(ws);
            gu32* qhead = (gu32*)(ws + WS_CTL) + CW_QUEUE;
            const att::Tensors T = att::make_tensors(ws, PRM); const bool t0 = (wave == 0) && (lane_id_v() == 0);
            for (;;) {
                if (t0) MISC[12] = __hip_atomic_fetch_add(qhead, 1u, RLX_AGENT);
                LDS_WAIT(); __syncthreads();
                const int idx = __builtin_amdgcn_readfirstlane((int)MISC[12]);
                if (idx >= 1024) break;
                if (idx < 256 || idx >= 768) {
                    int h, qb;
                    if (idx < 128) { h = 3; qb = idx; } else if (idx < 256) { const int i = idx - 128; h = 2; qb = (i & 1) ? 63 - (i >> 1) : 64 + (i >> 1); }
                    else if (idx < 896) { h = 1; qb = idx - 768; } else { h = 0; qb = idx - 896; }
                    const float slope = (h == 0) ? 0.25f : (h == 1) ? 0.0625f : (h == 2) ? 0.015625f : 0.00390625f;
                    const float c2 = slope * 1.4426950408889634f; const int dskip = (int)(150.0f / c2) + 1;
                    att::attn_unit<true>(T, h, qb, PRM[PRM_NEGM2B], PRM[PRM_LAM + h], c2, dskip, (char*)lds + RING_OFF, wave);
                } else { const int i = idx - 256; att::attn_unit<false>(T, i >> 6, i & 63, PRM[PRM_NEGM2A], 0.f, 0.f, 0, (char*)lds + RING_OFF, wave); }
            }
        }
#endif
        xcd_barrier(bar, wave);
#if (PHMASK & 32)
        {
            LAUNDER(ws); LAUNDER(out);
            pg8::Gemm g{(const bf16*)(ws + WS_MIX), (const bf16*)(ws + WS_WOUT), M, D, D}; pg8::StaticOrderT<M, D> S; S.init(G, bx);
            pg8::EpiResid<true, true> E{nullptr, out, ws, 1.0f}; pg8::gemm_phase<D, pg8::EpiResid<true, true>, pg8::StaticOrderT<M, D>, false, true>(L + RING_OFF, g, S, E, wave);
        }
#endif
        xcd_barrier(bar, wave);
    }
}

extern "C" void kernel_launch(void* const* d_in, const int* in_sizes, int n_in, void* d_out, int out_size, void* d_ws, size_t ws_size, hipStream_t stream) {
    static int grid = 0;
    if (grid == 0) {
        if (n_in != 21 || in_sizes[0] != M * D || out_size != M * D || ws_size < WS_END) { fprintf(stderr, "kernel_launch: unexpected shapes (n_in %d, in0 %d, out %d, ws %zu)\n", n_in, n_in > 0 ? in_sizes[0] : -1, out_size, ws_size); grid = -1; return; }
        int dev = 0, cus = 0, per_cu = 0;
        if (hipGetDevice(&dev) != hipSuccess || hipDeviceGetAttribute(&cus, hipDeviceAttributeMultiprocessorCount, dev) != hipSuccess) { grid = -1; return; }
        if (hipFuncSetAttribute((const void*)mk_fwd, hipFuncAttributeMaxDynamicSharedMemorySize, LDS_BYTES) != hipSuccess) { fprintf(stderr, "kernel_launch: hipFuncSetAttribute failed\n"); grid = -1; return; }
        if (hipOccupancyMaxActiveBlocksPerMultiprocessor(&per_cu, (const void*)mk_fwd, NWAVES * 64, LDS_BYTES) != hipSuccess || per_cu < 1) { fprintf(stderr, "kernel_launch: occupancy query says %d blocks per CU\n", per_cu); (void)hipGetLastError(); grid = -1; return; }
        grid = cus;
    }
    if (grid < 0) return;
    if (hipMemsetAsync((char*)d_ws + WS_CTL, 0, CTL_ZERO_BYTES, stream) != hipSuccess) { fprintf(stderr, "kernel_launch: memset failed\n"); return; }
    Args a{};
    for (int i = 0; i < 21; ++i) a.in[i] = (const float*)d_in[i];
    a.out = (float*)d_out; a.ws = (unsigned char*)d_ws;
    hipLaunchKernelGGL(mk_fwd, dim3(grid), dim3(NWAVES * 64), LDS_BYTES, stream, a);
    const hipError_t le = hipPeekAtLastError();
    if (le != hipSuccess) fprintf(stderr, "kernel_launch: launch failed: %s\n", hipGetErrorName(le));
}
```

```cpp
#include <hip/hip_runtime.h>
#include <cstdio>
#include <cstdint>

constexpr int NWAVES = 8;
constexpr int M = 16384, D = 1024, FF = 2816, NGU = 2 * FF, NIN = 2304;
constexpr size_t MiB = 1u << 20;
constexpr size_t WS_CTL = 0, CTL_ZERO_BYTES = 64 * 1024;
constexpr size_t WS_WGU1 = 2 * MiB, WS_WD1 = 13 * MiB, WS_WIN = 19 * MiB, WS_WOUT = 24 * MiB, WS_WGU2 = 26 * MiB, WS_WD2 = 37 * MiB;
constexpr size_t WS_ROPE = 43 * MiB, WS_SSQ = 44 * MiB;
constexpr size_t WS_XB = 48 * MiB;
constexpr size_t WS_H = 80 * MiB;
constexpr size_t WS_QA = 80 * MiB, WS_KA = 96 * MiB, WS_VA = 100 * MiB, WS_QB = 104 * MiB, WS_KB = 120 * MiB, WS_VB = 136 * MiB, WS_MIX = 152 * MiB;
constexpr size_t WS_END = 184 * MiB;
static_assert(WS_WGU1 + (size_t)NGU * D * 2 <= WS_WD1 && WS_WD1 + (size_t)D * FF * 2 <= WS_WIN && WS_WIN + (size_t)NIN * D * 2 <= WS_WOUT && WS_WOUT + (size_t)D * D * 2 <= WS_WGU2 &&
              WS_WGU2 + (size_t)NGU * D * 2 <= WS_WD2 && WS_WD2 + (size_t)D * FF * 2 <= WS_ROPE && WS_H + (size_t)M * FF * 2 <= WS_END && WS_MIX + (size_t)M * D * 2 <= WS_END, "d_ws map");
constexpr int CW_BAR = 1024;
constexpr int CW_QUEUE = 8192;
constexpr int RING_OFF = 0, RING_BYTES = 131072;
constexpr int LDSCTL_OFF = RING_BYTES, MISC_OFF = LDSCTL_OFF + 320, RSTD_OFF = LDSCTL_OFF + 1024, PRM_OFF = LDSCTL_OFF + 8192;
constexpr int LDS_BYTES = 147456;
constexpr int PRM_GAQ = 0, PRM_GAK = 64, PRM_GBQ = 128, PRM_GBK = 192, PRM_SUBLN = 256, PRM_NEGM2A = 384, PRM_NEGM2B = 385, PRM_LAM = 388, PRM_WORDS = 392;
static_assert(RSTD_OFF + 6 * 256 * 4 <= PRM_OFF && PRM_OFF + PRM_WORDS * 4 <= LDS_BYTES, "LDS map");

__device__ __forceinline__ int lane_id_v() { int l; asm volatile("v_mbcnt_lo_u32_b32 %0, -1, 0\n\tv_mbcnt_hi_u32_b32 %0, -1, %0" : "=v"(l)); return l; }

template <int MASK> __device__ __forceinline__ float xor_lane(float v) {
    if constexpr (MASK == 32) { const auto rr = __builtin_amdgcn_permlane32_swap(__float_as_uint(v), __float_as_uint(v), false, false); return __uint_as_float(lane_id_v() < 32 ? rr[1] : rr[0]); }
    else return __uint_as_float((unsigned)__builtin_amdgcn_ds_swizzle((int)__float_as_uint(v), (MASK << 10) | 0x1f));
}
__device__ __forceinline__ float sum_x32(float v) { const auto rr = __builtin_amdgcn_permlane32_swap(__float_as_uint(v), __float_as_uint(v), false, false); return __uint_as_float(rr[0]) + __uint_as_float(rr[1]); }
__device__ __forceinline__ float max_x32(float v) { const auto rr = __builtin_amdgcn_permlane32_swap(__float_as_uint(v), __float_as_uint(v), false, false); return fmaxf(__uint_as_float(rr[0]), __uint_as_float(rr[1])); }
namespace pg8 {
#define PG8_LAS __attribute__((address_space(3)))
typedef unsigned short bf16_t;
typedef short bf16x8 __attribute__((ext_vector_type(8)));
typedef float f32x4 __attribute__((ext_vector_type(4)));
typedef unsigned u32x4 __attribute__((ext_vector_type(4)));
constexpr int BM = 256, BK = 64, HALF = 128, HTB = HALF * BK * 2  , STAGE_BYTES = 8 * HTB, NXCD = 8, WGM = 8;

__host__ __device__ __forceinline__ int lds_byte(int r, int c) { const int st = (r >> 4) * 2 + (c >> 5), rr = r & 15, cc = c & 31, ob = rr * 64 + cc * 2; return st * 1024 + (ob ^ (((ob >> 9) & 1) << 5)); }
__host__ __device__ __forceinline__ void stage_rc(int b, int& R, int& C) { const int st = b / 1024, sb = b % 1024, swz = sb ^ (((sb >> 9) & 1) << 5); R = (st >> 1) * 16 + swz / 64; C = (st & 1) * 32 + (swz % 64) / 2; }
__host__ __device__ __forceinline__ int perm32(int rho) { const int n = rho >> 4, i = rho & 15; return 8 * (i >> 2) + 4 * n + (i & 3); }

struct Unit { int pm, pn; };
struct Gemm { const bf16_t* A; const bf16_t* Bt; int M, N, K; };

template <int MD, int ND> struct StaticOrderT {
    static constexpr int nM = MD / BM, nN = ND / BM, nwg = nM * nN;
    int G, c;
    __host__ __device__ void init(int G_, int c_) { G = G_; c = c_; }
    __host__ __device__ bool next(int i, Unit& u) const {
        const int L = i * G + c; if (L >= nwg) return false;
        int wgid = L; { constexpr int q = nwg / NXCD, r = nwg % NXCD; const int xcd = wgid % NXCD, off = wgid / NXCD; wgid = (xcd < r ? xcd * (q + 1) : r * (q + 1) + (xcd - r) * q) + off; }
        constexpr int nig = WGM * nN; const int gid = wgid / nig, fm = gid * WGM, gsz = (nM - fm) < WGM ? (nM - fm) : WGM;
        u.pm = fm + ((wgid % nig) % gsz); u.pn = (wgid % nig) / gsz; return true;
    }
    __device__ __forceinline__ void a_ready(const Unit&) const {}
    __device__ __forceinline__ void done(const Unit&) const {}
};


__device__ __forceinline__ unsigned cvt_pk_bf16(float lo, float hi) { unsigned r; asm volatile("v_cvt_pk_bf16_f32 %0, %1, %2" : "=v"(r) : "v"(lo), "v"(hi)); return r; }
__device__ __forceinline__ unsigned short f2bf1(float f) { unsigned u = __builtin_bit_cast(unsigned, f); return (unsigned short)((u + 0x7fffu + ((u >> 16) & 1u)) >> 16); }
typedef unsigned u32x2 __attribute__((ext_vector_type(2)));
constexpr int MROWS = M, DMODEL = D, DFF = FF;

__device__ __forceinline__ f32x4 swiglu4(f32x4 g, f32x4 u) {
    f32x4 o;
#pragma unroll
    for (int e = 0; e < 4; ++e) { const float ex = __builtin_amdgcn_exp2f(g[e] * -1.4426950408889634f); o[e] = g[e] * u[e] * __builtin_amdgcn_rcpf(1.0f + ex); }
    return o;
}
struct EpiSwiGLU {
    static constexpr bool PERM = true, AFTER_DRAIN = false;
    unsigned char* ws; const PG8_LAS float* rstd;
    __device__ __forceinline__ void operator()(const f32x4 (&acc)[2][2][4][2], const Unit& u, int ui, int wr, int wc, int fr, int fq) const {
        const int col0 = u.pn * 128 + wc * 32 + 8 * fq; unsigned char* w2 = ws; asm volatile("" : "+s"(w2)); bf16_t* H = (bf16_t*)(w2 + WS_H);
#pragma unroll
        for (int ai = 0; ai < 2; ++ai)
#pragma unroll
            for (int m = 0; m < 4; ++m) {
                const int rl = ai * HALF + wr * 64 + m * 16 + fr; const float rs = rstd[ui * 256 + rl];
                const f32x4 h0 = swiglu4(acc[ai][0][m][0] * rs, acc[ai][1][m][0] * rs), h1 = swiglu4(acc[ai][0][m][1] * rs, acc[ai][1][m][1] * rs);
                u32x4 w; w.x = cvt_pk_bf16(h0[0], h0[1]); w.y = cvt_pk_bf16(h0[2], h0[3]); w.z = cvt_pk_bf16(h1[0], h1[1]); w.w = cvt_pk_bf16(h1[2], h1[3]);
                *(u32x4*)(H + (size_t)(u.pm * BM + rl) * DFF + col0) = w;
            }
    }
};
template <bool WRITE_B, bool INPLACE> struct EpiResid {
    static constexpr bool PERM = false, AFTER_DRAIN = false;
    const float* base; float* out; unsigned char* ws; float alpha;
    __device__ __forceinline__ void operator()(const f32x4 (&acc)[2][2][4][2], const Unit& u, int ui, int wr, int wc, int fr, int fq) const {
        const int col0 = u.pn * BM + wc * 32 + 4 * fq;
        unsigned char* w2 = ws; asm volatile("" : "+s"(w2)); const float* bp = INPLACE ? out : base; bf16_t* xb = (bf16_t*)(w2 + WS_XB); float* ssqp = (float*)(w2 + WS_SSQ);
#pragma unroll
        for (int ai = 0; ai < 2; ++ai)
#pragma unroll
            for (int m = 0; m < 4; ++m) {
                const int row = u.pm * BM + ai * HALF + wr * 64 + m * 16 + fr; const size_t off = (size_t)row * DMODEL + col0; float ss = 0.f;
#pragma unroll
                for (int bj = 0; bj < 2; ++bj)
#pragma unroll
                    for (int n = 0; n < 2; ++n) { const size_t o = off + bj * HALF + n * 16; const f32x4 b = *(const f32x4*)(bp + o); const f32x4 v = b + acc[ai][bj][m][n] * alpha;
                        *(f32x4*)(out + o) = v;
                        if (WRITE_B) { ss += (v[0] * v[0] + v[1] * v[1]) + (v[2] * v[2] + v[3] * v[3]); u32x2 w; w.x = cvt_pk_bf16(v[0], v[1]); w.y = cvt_pk_bf16(v[2], v[3]); *(u32x2*)(xb + o) = w; } }
                if (WRITE_B) { ss += xor_lane<16>(ss); ss = sum_x32(ss); if (fq == 0) ssqp[(size_t)row * 16 + u.pn * 4 + wc] = ss; }
                asm volatile("" ::: "memory");
            }
    }
};
struct EpiInProj {
    static constexpr bool PERM = false, AFTER_DRAIN = false;
    const PG8_LAS float* rstd; const PG8_LAS float* prm; unsigned char* ws;
    __device__ __forceinline__ void operator()(const f32x4 (&acc)[2][2][4][2], const Unit& u, int ui, int wr, int wc, int fr, int fq) const {
        const int G = __builtin_amdgcn_readfirstlane(u.pn * 4 + wc);
        unsigned char* w2 = ws; asm volatile("" : "+s"(w2));
        const bool isv = (G == 10) | (G == 11) | (G >= 28);
        if (!isv) {
            const bool isq = (G < 8) | ((G >= 12) & (G < 20));
            const bool isrope = (G < 10);
            const PG8_LAS float* gp = prm + ((G < 8) ? PRM_GAQ : (G < 10) ? PRM_GAK : (G < 20) ? PRM_GBQ : PRM_GBK) + 4 * fq;
            const float* rope = (const float*)(w2 + WS_ROPE) + 4 * fq;
            const float qs = isq ? 0.125f * 1.4426950408889634f : 1.0f;
            bf16_t* dbase = isq ? ((G < 8) ? (bf16_t*)(w2 + WS_QA) + (size_t)G * MROWS * 64 : (bf16_t*)(w2 + WS_QB) + (size_t)(G - 12) * MROWS * 64)
                                : ((G < 10) ? (bf16_t*)(w2 + WS_KA) + (size_t)(G - 8) * MROWS * 64 : (bf16_t*)(w2 + WS_KB) + (size_t)(G - 20) * MROWS * 64);
#pragma unroll
            for (int ai = 0; ai < 2; ++ai)
#pragma unroll
                for (int m = 0; m < 4; ++m) {
                    const int rl = ai * HALF + wr * 64 + m * 16 + fr; const int t = u.pm * BM + rl; const float rs = rstd[ui * 256 + rl];
                    float ss = 0.f;
#pragma unroll
                    for (int bj = 0; bj < 2; ++bj)
#pragma unroll
                        for (int n = 0; n < 2; ++n) { const f32x4 a = acc[ai][bj][m][n]; ss += (a[0] * a[0] + a[1] * a[1]) + (a[2] * a[2] + a[3] * a[3]); }
                    ss += xor_lane<16>(ss); ss = sum_x32(ss);
                    const float f = rs / sqrtf(ss * rs * rs * (1.0f / 64.0f) + 1e-6f);
#pragma unroll
                    for (int bj = 0; bj < 2; ++bj) {
                        f32x4 x1 = acc[ai][bj][m][0] * f * *(const PG8_LAS f32x4*)(gp + 32 * bj), x2 = acc[ai][bj][m][1] * f * *(const PG8_LAS f32x4*)(gp + 32 * bj + 16);
                        if (isrope) { const int pos = bj ? (t & 63) : (t >> 6); const float* rp = rope + (bj ? 8192 : 0) + pos * 16;
                            const f32x4 c = *(const f32x4*)rp, s = *(const f32x4*)(rp + (bj ? 1024 : 4096));
                            const f32x4 y1 = x1 * c - x2 * s, y2 = x2 * c + x1 * s; x1 = y1; x2 = y2; }
                        x1 = x1 * qs; x2 = x2 * qs;
                        u32x4 w; w.x = cvt_pk_bf16(x1[0], x1[1]); w.y = cvt_pk_bf16(x1[2], x1[3]); w.z = cvt_pk_bf16(x2[0], x2[1]); w.w = cvt_pk_bf16(x2[2], x2[3]);
                        const int c8 = 4 * bj + fq;
                        bf16_t* dst = isq ? dbase + (size_t)t * 64 + c8 * 8 : dbase + ((size_t)((t >> 6) * 8 + c8) * 64 + (t & 63)) * 8;
                        *(u32x4*)dst = w;
                    }
                    asm volatile("" ::: "memory");
                }
        } else {
            const int DV = (G < 12) ? 64 : 128, dbase = (G < 12) ? 0 : 64 * ((G - 28) & 1);
            bf16_t* V = (G < 12) ? (bf16_t*)(w2 + WS_VA) + (size_t)(G - 10) * MROWS * 64 : (bf16_t*)(w2 + WS_VB) + (size_t)((G - 28) >> 1) * MROWS * 128;
#pragma unroll
            for (int ai = 0; ai < 2; ++ai)
#pragma unroll
                for (int m = 0; m < 4; ++m) {
                    const int rl = ai * HALF + wr * 64 + m * 16 + fr; const int t = u.pm * BM + rl; const float rs = rstd[ui * 256 + rl];
                    const int kk = t & 63, ks = kk >> 4, ko = kk & 15, hi = (ko >> 2) & 1, j = ((ko >> 3) << 2) | (ko & 3);
                    bf16_t* vb = V + ((size_t)(((t >> 6) * 4 + ks) * 2 + hi) * DV + dbase + 4 * fq) * 8 + j;
#pragma unroll
                    for (int bj = 0; bj < 2; ++bj)
#pragma unroll
                        for (int n = 0; n < 2; ++n)
#pragma unroll
                            for (int e = 0; e < 4; ++e) vb[(32 * bj + 16 * n + e) * 8] = f2bf1(acc[ai][bj][m][n][e] * rs);
                    asm volatile("" ::: "memory");
                }
        }
    }
};

template <int KD, class Epi, class Sched, bool ALIGN_EPI = false, bool SP2 = false>
__device__ __forceinline__ void gemm_phase(PG8_LAS unsigned char* lds, const Gemm g, const Sched& S, const Epi& E, int wave_id) {
    int tid_ = wave_id * 64 + lane_id_v(); asm volatile("" : "+v"(tid_));
    const int tid = tid_, wid = __builtin_amdgcn_readfirstlane(tid >> 6), lane = tid & 63, wr = wid >> 2, wc = wid & 3, fr = lane & 15, fq = lane >> 4;
    constexpr int K = KD, nt = K / BK; static_assert(nt % 2 == 0, "even K-tile count");
    unsigned voffA[2], voffB[2];
#pragma unroll
    for (int i = 0; i < 2; ++i) { int R, C; stage_rc(tid * 16 + i * 8192, R, C); const int Rb = Epi::PERM ? ((R & ~31) + perm32(R & 31)) : R;
        voffA[i] = (unsigned)(R * K + C) * 2u; voffB[i] = (unsigned)(Rb * K + C) * 2u; }
    constexpr size_t kstep = (size_t)(BK * 2);
    constexpr size_t hstep = (size_t)HALF * K * 2;
    constexpr size_t tstep = 2 * hstep;
    const unsigned ldsw = (unsigned)wid * 1024u;
    const int aoff = lds_byte(wr * 64 + fr, fq * 8), boff = lds_byte(wc * 32 + fr, fq * 8);
#define PG8_SA(b, h) (((b) * 2 + (h)) * HTB)
#define PG8_SB(b, h) ((4 + (b) * 2 + (h)) * HTB)
#define PG8_STAGE(bufoff, gbase, voff) do { _Pragma("unroll") for (int _i = 0; _i < 2; ++_i) \
        __builtin_amdgcn_global_load_lds((const unsigned*)((const char*)(gbase) + (voff)[_i]), (PG8_LAS unsigned*)(lds + (bufoff) + ldsw + _i * 8192), 16, 0, 0); } while (0)
#define PG8_LDA(dst, b, h) do { _Pragma("unroll") for (int m = 0; m < 4; ++m) _Pragma("unroll") for (int k = 0; k < 2; ++k) dst[m][k] = *(const PG8_LAS bf16x8*)(lds + PG8_SA(b, h) + aoff + m * 2048 + k * 1024); } while (0)
#define PG8_LDB(dst, b, h) do { _Pragma("unroll") for (int n = 0; n < 2; ++n) _Pragma("unroll") for (int k = 0; k < 2; ++k) dst[n][k] = *(const PG8_LAS bf16x8*)(lds + PG8_SB(b, h) + boff + n * 2048 + k * 1024); } while (0)
#define PG8_MMA(ai, bj, At, Bt) do { __builtin_amdgcn_s_setprio(1); _Pragma("unroll") for (int m = 0; m < 4; ++m) _Pragma("unroll") for (int n = 0; n < 2; ++n) _Pragma("unroll") for (int k = 0; k < 2; ++k) \
        acc[ai][bj][m][n] = __builtin_amdgcn_mfma_f32_16x16x32_bf16(Bt[n][k], At[m][k], acc[ai][bj][m][n], 0, 0, 0); __builtin_amdgcn_s_setprio(0); } while (0)
#define PG8_WAIT_V(n) asm volatile("s_waitcnt vmcnt(" #n ")" ::: "memory")
#define PG8_WAIT_L(n) asm volatile("s_waitcnt lgkmcnt(" #n ")" ::: "memory")
#define PG8_BAR __builtin_amdgcn_s_barrier()
#define PG8_SCHED __builtin_amdgcn_sched_barrier(0)
    Unit cur, nxt; int ui = 0;
    if (!S.next(0, cur)) return;
    f32x4 acc[2][2][4][2];
#pragma unroll
    for (int a = 0; a < 2; ++a)
#pragma unroll
        for (int b = 0; b < 2; ++b)
#pragma unroll
            for (int m = 0; m < 4; ++m)
#pragma unroll
                for (int n = 0; n < 2; ++n) acc[a][b][m][n] = (f32x4){0.f, 0.f, 0.f, 0.f};
    bf16x8 At[4][2], B0[2][2], B1[2][2];
    const char* cA = (const char*)g.A + (size_t)cur.pm * tstep; const char* cB = (const char*)g.Bt + (size_t)cur.pn * tstep;
    S.a_ready(cur);
    if constexpr (SP2) {
        PG8_STAGE(PG8_SB(0, 0), cB, voffB); PG8_STAGE(PG8_SB(0, 1), cB + hstep, voffB); PG8_STAGE(PG8_SA(0, 0), cA, voffA); PG8_STAGE(PG8_SA(0, 1), cA + hstep, voffA);
        if (wr == 1) PG8_BAR;
        PG8_WAIT_V(2); PG8_BAR;
        PG8_STAGE(PG8_SB(1, 0), cB + kstep, voffB); PG8_STAGE(PG8_SA(1, 0), cA + kstep, voffA); PG8_STAGE(PG8_SB(1, 1), cB + hstep + kstep, voffB);
        PG8_WAIT_V(6); PG8_BAR;
    } else {
        PG8_STAGE(PG8_SB(0, 0), cB, voffB); PG8_STAGE(PG8_SA(0, 0), cA, voffA); PG8_STAGE(PG8_SB(0, 1), cB + hstep, voffB); PG8_STAGE(PG8_SA(0, 1), cA + hstep, voffA);
        if (wr == 1) PG8_BAR;
        PG8_WAIT_V(4); PG8_BAR;
        PG8_STAGE(PG8_SB(1, 0), cB + kstep, voffB); PG8_STAGE(PG8_SA(1, 0), cA + kstep, voffA); PG8_STAGE(PG8_SB(1, 1), cB + hstep + kstep, voffB);
        PG8_WAIT_V(6); PG8_BAR;
    }
    for (;;) {
        const bool has_next = S.next(ui + 1, nxt);
        const char* nA = has_next ? (const char*)g.A + (size_t)nxt.pm * tstep : cA; const char* nB = has_next ? (const char*)g.Bt + (size_t)nxt.pn * tstep : cB;
        for (int t = 0; t < nt; t += 2) {
            const bool last = (t == nt - 2);
            const char* a1 = cA + (size_t)(t + 1) * kstep;
            const char* a2 = last ? nA : cA + (size_t)(t + 2) * kstep; const char* b2 = last ? nB : cB + (size_t)(t + 2) * kstep;
            const char* a3 = a2 + kstep; const char* b3 = b2 + kstep;
            if (last && has_next) S.a_ready(nxt);
            if constexpr (SP2) {
            PG8_LDB(B0, 0, 0); PG8_LDB(B1, 0, 1); PG8_SCHED; PG8_LDA(At, 0, 0); PG8_STAGE(PG8_SA(1, 1), a1 + hstep, voffA);
            PG8_WAIT_V(8); PG8_WAIT_L(0); PG8_BAR; PG8_MMA(0, 0, At, B0); PG8_MMA(0, 1, At, B1); PG8_BAR; PG8_SCHED;
            PG8_LDA(At, 0, 1); PG8_STAGE(PG8_SB(0, 0), b2, voffB); PG8_STAGE(PG8_SB(0, 1), b2 + hstep, voffB); PG8_STAGE(PG8_SA(0, 0), a2, voffA);
            PG8_WAIT_V(8); PG8_WAIT_L(0); PG8_BAR; PG8_MMA(1, 0, At, B0); PG8_MMA(1, 1, At, B1); PG8_BAR; PG8_SCHED;
            PG8_LDB(B0, 1, 0); PG8_LDB(B1, 1, 1); PG8_SCHED; PG8_LDA(At, 1, 0); PG8_STAGE(PG8_SA(0, 1), a2 + hstep, voffA);
            PG8_WAIT_V(8); PG8_WAIT_L(0); PG8_BAR; PG8_MMA(0, 0, At, B0); PG8_MMA(0, 1, At, B1); PG8_BAR; PG8_SCHED;
            PG8_LDA(At, 1, 1); PG8_STAGE(PG8_SB(1, 0), b3, voffB); PG8_STAGE(PG8_SB(1, 1), b3 + hstep, voffB); PG8_STAGE(PG8_SA(1, 0), a3, voffA);
            PG8_WAIT_V(8); PG8_WAIT_L(0); PG8_BAR; PG8_MMA(1, 0, At, B0); PG8_MMA(1, 1, At, B1); PG8_BAR; PG8_SCHED;
            } else {
            PG8_LDB(B0, 0, 0); PG8_SCHED; PG8_LDA(At, 0, 0); PG8_STAGE(PG8_SA(1, 1), a1 + hstep, voffA);
            PG8_WAIT_L(8); PG8_BAR; PG8_WAIT_L(0); PG8_MMA(0, 0, At, B0); PG8_BAR; PG8_SCHED;
            PG8_LDB(B1, 0, 1); PG8_STAGE(PG8_SB(0, 0), b2, voffB);
            PG8_BAR; PG8_WAIT_L(0); PG8_MMA(0, 1, At, B1); PG8_BAR;
            PG8_LDA(At, 0, 1); PG8_STAGE(PG8_SA(0, 0), a2, voffA);
            PG8_BAR; PG8_WAIT_L(0); PG8_MMA(1, 0, At, B0); PG8_BAR; PG8_SCHED;
            PG8_STAGE(PG8_SB(0, 1), b2 + hstep, voffB);
            PG8_WAIT_V(6); PG8_BAR; PG8_MMA(1, 1, At, B1); PG8_BAR;
            PG8_LDB(B0, 1, 0); PG8_SCHED; PG8_LDA(At, 1, 0); PG8_STAGE(PG8_SA(0, 1), a2 + hstep, voffA);
            PG8_WAIT_L(8); PG8_BAR; PG8_WAIT_L(0); PG8_MMA(0, 0, At, B0); PG8_BAR; PG8_SCHED;
            PG8_LDB(B1, 1, 1); PG8_STAGE(PG8_SB(1, 0), b3, voffB);
            PG8_BAR; PG8_WAIT_L(0); PG8_MMA(0, 1, At, B1); PG8_BAR;
            PG8_LDA(At, 1, 1); PG8_STAGE(PG8_SA(1, 0), a3, voffA);
            PG8_BAR; PG8_WAIT_L(0); PG8_MMA(1, 0, At, B0); PG8_BAR; PG8_SCHED;
            PG8_STAGE(PG8_SB(1, 1), b3 + hstep, voffB);
            PG8_WAIT_V(6); PG8_BAR; PG8_MMA(1, 1, At, B1); PG8_BAR;
            }
        }
        if constexpr (ALIGN_EPI) { if (wr == 0) PG8_BAR; }
        if constexpr (!Epi::AFTER_DRAIN) { E(acc, cur, ui, wr, wc, fr, fq); S.done(cur); }
        if (!has_next) break;
#pragma unroll
        for (int a = 0; a < 2; ++a)
#pragma unroll
            for (int b = 0; b < 2; ++b)
#pragma unroll
                for (int m = 0; m < 4; ++m)
#pragma unroll
                    for (int n = 0; n < 2; ++n) acc[a][b][m][n] = (f32x4){0.f, 0.f, 0.f, 0.f};
        cur = nxt; cA = nA; cB = nB; ++ui;
        if constexpr (ALIGN_EPI) { if (wr == 1) PG8_BAR; }
    }
    PG8_WAIT_V(0);
    if constexpr (!ALIGN_EPI) { if (wr == 0) PG8_BAR; }
    PG8_BAR;
    if constexpr (Epi::AFTER_DRAIN) { E.fused(acc, cur, wr, wc, fr, fq, lds, wid, lane); S.done(cur); }
#undef PG8_SA
#undef PG8_SB
#undef PG8_STAGE
#undef PG8_LDA
#undef PG8_LDB
#undef PG8_MMA
#undef PG8_WAIT_V
#undef PG8_WAIT_L
#undef PG8_BAR
#undef PG8_SCHED
}
}
namespace att {
typedef unsigned short bf16_t;
typedef short bf16x8 __attribute__((ext_vector_type(8)));
typedef float f32x16 __attribute__((ext_vector_type(16)));
typedef float f32x4 __attribute__((ext_vector_type(4)));
typedef unsigned u32x4 __attribute__((ext_vector_type(4)));
#define ALAS __attribute__((address_space(3)))
constexpr int MROWS = M;
constexpr int WSF_OFF = 98304;
constexpr int LDS_NEED = WSF_OFF + 8 * 256;
__device__ __forceinline__ int crow(int r, int hi) { return (r & 3) + 8 * (r >> 2) + 4 * hi; }
__device__ __forceinline__ void glds16(const void* gsrc, unsigned lds_dst) { unsigned keep;
    asm volatile("s_mov_b32 %0, m0\n\ts_mov_b32 m0, %2\n\ts_nop 0\n\tglobal_load_lds_dwordx4 %1, off\n\ts_mov_b32 m0, %0" : "=&s"(keep) : "v"(gsrc), "s"(lds_dst) : "memory"); }
typedef float f32x2_t __attribute__((ext_vector_type(2))); typedef __bf16 bf16x2_t __attribute__((ext_vector_type(2)));
__device__ __forceinline__ unsigned cvtpk(float lo, float hi) { f32x2_t v = {lo, hi}; bf16x2_t b = __builtin_convertvector(v, bf16x2_t); return __builtin_bit_cast(unsigned, b); }
__device__ __forceinline__ void glds16s(const void* sbase, unsigned voff, unsigned lds_dst) { unsigned keep;
    asm volatile("s_mov_b32 %0, m0\n\ts_mov_b32 m0, %3\n\ts_nop 0\n\tglobal_load_lds_dwordx4 %1, %2\n\ts_mov_b32 m0, %0" : "=&s"(keep) : "v"(voff), "s"(sbase), "s"(lds_dst) : "memory"); }
#define ATT_WAIT_BAR(N) asm volatile("s_waitcnt vmcnt(" #N ") lgkmcnt(0)\n\ts_barrier" ::: "memory")
#define ATT_MFMA(a, b, c) __builtin_amdgcn_mfma_f32_32x32x16_bf16(a, b, c, 0, 0, 0)

struct Tensors { unsigned char* ws; const ALAS float* subln; };
__device__ __forceinline__ Tensors make_tensors(unsigned char* ws, const ALAS float* prm) { return Tensors{ws, prm + PRM_SUBLN}; }
#define T_QA ((const bf16_t*)(T.ws + WS_QA))
#define T_KA ((const bf16_t*)(T.ws + WS_KA))
#define T_VA ((const bf16_t*)(T.ws + WS_VA))
#define T_QB ((const bf16_t*)(T.ws + WS_QB))
#define T_KB ((const bf16_t*)(T.ws + WS_KB))
#define T_VB ((const bf16_t*)(T.ws + WS_VB))
#define T_MIX ((bf16_t*)(T.ws + WS_MIX))

#define SBAR() __builtin_amdgcn_sched_barrier(0)
#define PIN(x) asm volatile("" : "+v"(x))
#define PKW(P, B) cvtpk(P[B], P[(B) + 1])
#define EX(v) __builtin_amdgcn_exp2f(v)
#define WB_SEL(n) do { switch (n) { case 0: ATT_WAIT_BAR(0); break; case 1: ATT_WAIT_BAR(1); break; case 2: ATT_WAIT_BAR(2); break; case 3: ATT_WAIT_BAR(3); break; case 4: ATT_WAIT_BAR(4); break; default: ATT_WAIT_BAR(6); } } while (0)
template <bool ISB>
__device__ __forceinline__ void attn_unit(const Tensors& T, int head, int qb, float negM2, float lam, float c2, int dskip, char* shm, int wave_id) {
    constexpr int DV = ISB ? 128 : 64, ND0 = DV / 32, NK = ISB ? 2 : 1, NV = ISB ? 2 : 1;
    constexpr int KSLOT = ISB ? 16384 : 8192, VSLOT = ISB ? 16384 : 8192, LDS_K = 0, LDS_V = 3 * KSLOT;
    int tid_ = wave_id * 64 + lane_id_v(); asm volatile("" : "+v"(tid_));
    const int tid = tid_, lane = tid & 63, r32 = lane & 31, hi = lane >> 5; const int wid = __builtin_amdgcn_readfirstlane(tid >> 6);
    const int mapc = ISB ? (wid >> 2) : 0, wq = ISB ? (wid & 3) : wid;
    const int q0 = ISB ? qb * 128 : qb * 256; const int qrow = q0 + wq * 32 + r32;
    int t0 = 0, t1 = 256;
    if (ISB) { const int lo = q0 - dskip, hi_ = q0 + 127 + dskip; t0 = lo > 0 ? (lo >> 6) : 0; t1 = (hi_ >> 6) + 1; if (t1 > 256) t1 = 256;
        if ((t1 - t0) & 1) { if (t0 > 0) --t0; else ++t1; } }
    const int n = t1 - t0;
    const unsigned lds0 = (unsigned)(uintptr_t)shm;
    const ALAS char* shm3 = (const ALAS char*)shm;
    const char* k1b = ISB ? (const char*)(T_KB + (size_t)(2 * head) * MROWS * 64) + (size_t)t0 * 8192 : (const char*)(T_KA + (size_t)(head >> 2) * MROWS * 64);
    const char* k2b = ISB ? (const char*)(T_KB + (size_t)(2 * head + 1) * MROWS * 64) + (size_t)t0 * 8192 : nullptr;
    const char* vb_ = ISB ? (const char*)(T_VB + (size_t)head * MROWS * 128) + (size_t)t0 * 16384 : (const char*)(T_VA + (size_t)(head >> 2) * MROWS * 64);
    const unsigned dvo = (unsigned)(wid * 1024 + lane * 16);
    const unsigned kdst = lds0 + LDS_K + wid * 1024, vdst = lds0 + LDS_V + wid * 1024;
#define DMA_K(i, so) do { glds16s(k1b + (size_t)(i) * 8192, dvo, (unsigned)__builtin_amdgcn_readfirstlane(kdst + (so))); if (ISB) glds16s(k2b + (size_t)(i) * 8192, dvo, (unsigned)__builtin_amdgcn_readfirstlane(kdst + (so) + 8192)); } while (0)
#define DMA_V(i, so) do { if (ISB) { glds16s(vb_ + (size_t)(i) * 16384, dvo, (unsigned)__builtin_amdgcn_readfirstlane(vdst + (so))); glds16s(vb_ + (size_t)(i) * 16384 + 8192, dvo, (unsigned)__builtin_amdgcn_readfirstlane(vdst + (so) + 8192)); } \
      else glds16s(vb_ + (size_t)(i) * 8192, dvo, (unsigned)__builtin_amdgcn_readfirstlane(vdst + (so))); } while (0)
    DMA_K(0, 0); DMA_V(0, 0); DMA_K(1, KSLOT);
    const bf16_t* Qw = (ISB ? T_QB + (size_t)(2 * head + mapc) * MROWS * 64 : T_QA + (size_t)head * MROWS * 64) + (size_t)qrow * 64;
    bf16x8 qr[4];
#pragma unroll
    for (int d0 = 0; d0 < 4; ++d0) qr[d0] = *(const bf16x8*)(Qw + d0 * 16 + hi * 8);
    f32x16 o[ND0];
#pragma unroll
    for (int d = 0; d < ND0; ++d) o[d] = f32x16{};
    f32x16 negm;
#pragma unroll
    for (int r = 0; r < 16; ++r) negm[r] = negM2;
    asm volatile("" : "+v"(negm));
    float l_reg = 0.f;
    const ALAS char* kp0 = shm3 + LDS_K + (ISB ? mapc * 8192 : 0) + hi * 1024 + r32 * 16;
    const ALAS char* vp0 = shm3 + LDS_V + hi * (DV * 16) + r32 * 16;
    const float nc2 = -c2; const float dl0 = (float)(64 * t0 - qrow + 4 * hi);
#define BIAS4(X, B, DL, OFS) do { _Pragma("unroll") for (int r_ = (B); r_ < (B) + 4; ++r_) { const float cr_ = (float)((r_ & 3) + 8 * (r_ >> 2)) + (OFS); X[r_] = __builtin_fmaf(__builtin_fabsf((DL) + cr_), nc2, negM2); } } while (0)
#define BIAS_ALL(X0, X1, DL) do { _Pragma("unroll") for (int b_ = 0; b_ < 16; b_ += 4) { BIAS4(X0, b_, DL, 0.f); BIAS4(X1, b_, DL, 32.f); } } while (0)
    f32x16 pA0, pA1, pB0, pB1;
    bf16x8 kf[8], vf[8]; u32x4 pw0, pw1, pw2, pw3;
    int ks_prev = 0, ks_cur = 0, ks_next = KSLOT, vs_prev = 0, vs_cur = 0, vs_next = VSLOT;
#define ROT() do { ks_prev = ks_cur; ks_cur = ks_next; ks_next = (ks_next == 2 * KSLOT) ? 0 : ks_next + KSLOT; vs_prev = vs_cur; vs_cur = vs_next; vs_next = (vs_next == 2 * VSLOT) ? 0 : vs_next + VSLOT; } while (0)
    DMA_K(2, 2 * KSLOT);
    WB_SEL(NV + 2 * NK);
    if (ISB) { BIAS_ALL(pA0, pA1, dl0); } else { pA0 = negm; pA1 = negm; }
    {
        const ALAS char* kp = kp0;
#pragma unroll
        for (int d0 = 0; d0 < 4; ++d0) { const bf16x8 b0 = *(const ALAS bf16x8*)(kp + d0 * 2048), b1 = *(const ALAS bf16x8*)(kp + d0 * 2048 + 512);
            pA0 = ATT_MFMA(b0, qr[d0], pA0); pA1 = ATT_MFMA(b1, qr[d0], pA1); }
#pragma unroll
        for (int r = 0; r < 16; ++r) { pA0[r] = EX(pA0[r]); pA1[r] = EX(pA1[r]); }
    }
    WB_SEL(0);
    DMA_K(3, 0); DMA_V(1, VSLOT);
    ROT();
#define KLOAD2(base, j) do { kf[2 * (j)] = *(const ALAS bf16x8*)((base) + (j) * 2048); kf[2 * (j) + 1] = *(const ALAS bf16x8*)((base) + (j) * 2048 + 512); } while (0)
    { const ALAS char* kb_ = kp0 + ks_cur; KLOAD2(kb_, 0); KLOAD2(kb_, 1); KLOAD2(kb_, 2); KLOAD2(kb_, 3); }
    if (ISB) { BIAS_ALL(pB0, pB1, dl0 + 64.f); }
    WB_SEL(NK + NV);
#define PAF(k) __builtin_bit_cast(bf16x8, pw##k)
#define GAPA(MF, A0, A1, A2, A3, W0, W1, PW) do { MF; sacc += A0; sacc += A1; sacc += A2; sacc += A3; PIN(sacc); W0; W1; PIN(PW); SBAR(); } while (0)
#define GAPB(MF, X, B) do { MF; X[B] = EX(X[B]); X[(B) + 1] = EX(X[(B) + 1]); X[(B) + 2] = EX(X[(B) + 2]); X[(B) + 3] = EX(X[(B) + 3]); PIN(X); SBAR(); } while (0)
#define GAPC(MF, G, X, B, OFS) do { MF; if (G) { BIAS4(X, B, dln_, OFS); PIN(X); } SBAR(); } while (0)
#define VRD(i) do { vf[i] = *(const ALAS bf16x8*)(vp_ + ((i) & 3) * (DV * 32) + ((i) >> 2) * 512); } while (0)
#define VRD2(i) do { vf[i] = *(const ALAS bf16x8*)(vp_ + ((i) & 3) * (DV * 32) + (((i) >> 2) + 2) * 512); } while (0)
#define KRD(G, j) do { if (G) { KLOAD2(kn_, j); SBAR(); } } while (0)
#define KRD1(G, j) do { if (G) { kf[j] = *(const ALAS bf16x8*)(kn_ + ((j) >> 1) * 2048 + ((j) & 1) * 512); SBAR(); } } while (0)
#define CIN(C) (ISB ? C : negm)
#define STEP(C0, C1, P0, P1, i, GK, GV, GL) do { SBAR(); \
    const ALAS char* vp_ = vp0 + vs_prev; const ALAS char* kn_ = kp0 + ks_next; const float dln_ = dl0 + 64.f * (float)((i) + 1); \
    VRD(0); SBAR(); float sacc = P0[0] + P0[1]; \
    GAPA(C0 = ATT_MFMA(kf[0], qr[0], CIN(C0)), P0[2], P0[3], P0[4], P0[5],     pw0[0] = PKW(P0, 0), pw0[1] = PKW(P0, 2), pw0); \
    VRD(4); SBAR(); GAPA(C1 = ATT_MFMA(kf[1], qr[0], CIN(C1)), P0[6], P0[7], P0[8], P0[9],     pw0[2] = PKW(P0, 4), pw0[3] = PKW(P0, 6), pw0); \
    VRD(1); SBAR(); GAPA(C0 = ATT_MFMA(kf[2], qr[1], C0),   P0[10], P0[11], P0[12], P0[13], pw1[0] = PKW(P0, 8), pw1[1] = PKW(P0, 10), pw1); \
    VRD(5); SBAR(); GAPA(C1 = ATT_MFMA(kf[3], qr[1], C1),   P0[14], P0[15], P1[0], P1[1],   pw1[2] = PKW(P0, 12), pw1[3] = PKW(P0, 14), pw1); \
    VRD(2); SBAR(); GAPA(C0 = ATT_MFMA(kf[4], qr[2], C0),   P1[2], P1[3], P1[4], P1[5],     pw2[0] = PKW(P1, 0), pw2[1] = PKW(P1, 2), pw2); \
    VRD(6); SBAR(); GAPA(C1 = ATT_MFMA(kf[5], qr[2], C1),   P1[6], P1[7], P1[8], P1[9],     pw2[2] = PKW(P1, 4), pw2[3] = PKW(P1, 6), pw2); \
    VRD(3); SBAR(); GAPA(C0 = ATT_MFMA(kf[6], qr[3], C0),   P1[10], P1[11], P1[12], P1[13], pw3[0] = PKW(P1, 8), pw3[1] = PKW(P1, 10), pw3); \
    VRD(7); SBAR(); GAPA(C1 = ATT_MFMA(kf[7], qr[3], C1),   P1[14], P1[15], 0.f, 0.f,       pw3[2] = PKW(P1, 12), pw3[3] = PKW(P1, 14), pw3); \
    l_reg += sacc; \
    if (GK) { DMA_K((i) + 3, ks_cur); } if (GV) { DMA_V((i) + 1, vs_next); } \
    SBAR(); \
    if (!ISB) { \
        GAPB(o[0] = ATT_MFMA(PAF(0), vf[0], o[0]), C0, 0); \
        GAPB(o[1] = ATT_MFMA(PAF(0), vf[4], o[1]), C0, 4); \
        KRD(GL, 0); GAPB(o[0] = ATT_MFMA(PAF(1), vf[1], o[0]), C0, 8); \
        KRD(GL, 1); GAPB(o[1] = ATT_MFMA(PAF(1), vf[5], o[1]), C0, 12); \
        KRD(GL, 2); GAPB(o[0] = ATT_MFMA(PAF(2), vf[2], o[0]), C1, 0); \
        KRD(GL, 3); GAPB(o[1] = ATT_MFMA(PAF(2), vf[6], o[1]), C1, 4); \
        GAPB(o[0] = ATT_MFMA(PAF(3), vf[3], o[0]), C1, 8); \
        GAPB(o[1] = ATT_MFMA(PAF(3), vf[7], o[1]), C1, 12); \
    } else { \
        GAPB(o[0] = ATT_MFMA(PAF(0), vf[0], o[0]), C0, 0); \
        VRD2(0); SBAR(); GAPB(o[1] = ATT_MFMA(PAF(0), vf[4], o[1]), C0, 4); \
        VRD2(4); SBAR(); GAPB(o[0] = ATT_MFMA(PAF(1), vf[1], o[0]), C0, 8); \
        VRD2(1); SBAR(); GAPB(o[1] = ATT_MFMA(PAF(1), vf[5], o[1]), C0, 12); \
        VRD2(5); SBAR(); GAPB(o[0] = ATT_MFMA(PAF(2), vf[2], o[0]), C1, 0); \
        VRD2(2); SBAR(); GAPB(o[1] = ATT_MFMA(PAF(2), vf[6], o[1]), C1, 4); \
        VRD2(6); SBAR(); GAPB(o[0] = ATT_MFMA(PAF(3), vf[3], o[0]), C1, 8); \
        VRD2(3); SBAR(); GAPB(o[1] = ATT_MFMA(PAF(3), vf[7], o[1]), C1, 12); \
        VRD2(7); SBAR(); \
        KRD1(GL, 0); GAPC(o[ND0 - 2] = ATT_MFMA(PAF(0), vf[0], o[ND0 - 2]), GL, P0, 0, 0.f); \
        KRD1(GL, 1); GAPC(o[ND0 - 1] = ATT_MFMA(PAF(0), vf[4], o[ND0 - 1]), GL, P0, 4, 0.f); \
        KRD1(GL, 2); GAPC(o[ND0 - 2] = ATT_MFMA(PAF(1), vf[1], o[ND0 - 2]), GL, P0, 8, 0.f); \
        KRD1(GL, 3); GAPC(o[ND0 - 1] = ATT_MFMA(PAF(1), vf[5], o[ND0 - 1]), GL, P0, 12, 0.f); \
        KRD1(GL, 4); GAPC(o[ND0 - 2] = ATT_MFMA(PAF(2), vf[2], o[ND0 - 2]), GL, P1, 0, 32.f); \
        KRD1(GL, 5); GAPC(o[ND0 - 1] = ATT_MFMA(PAF(2), vf[6], o[ND0 - 1]), GL, P1, 4, 32.f); \
        KRD1(GL, 6); GAPC(o[ND0 - 2] = ATT_MFMA(PAF(3), vf[3], o[ND0 - 2]), GL, P1, 8, 32.f); \
        KRD1(GL, 7); GAPC(o[ND0 - 1] = ATT_MFMA(PAF(3), vf[7], o[ND0 - 1]), GL, P1, 12, 32.f); \
    } } while (0)
    int i = 1;
    for (; i + 5 < n; i += 2) {
        STEP(pB0, pB1, pA0, pA1, i, true, true, true);     WB_SEL(NK + NV); ROT();
        STEP(pA0, pA1, pB0, pB1, i + 1, true, true, true); WB_SEL(NK + NV); ROT();
    }
#define ENDW(ii) do { if ((ii) + 3 < n) { WB_SEL(NK + NV); } else if ((ii) + 2 < n) { WB_SEL(NV); } else { WB_SEL(0); } } while (0)
    for (; i + 1 < n; i += 2) {
        STEP(pB0, pB1, pA0, pA1, i, (i + 3 < n), (i + 1 < n), (i + 1 < n));         ENDW(i);     ROT();
        STEP(pA0, pA1, pB0, pB1, i + 1, (i + 4 < n), (i + 2 < n), (i + 2 < n));     ENDW(i + 1); ROT();
    }
    STEP(pB0, pB1, pA0, pA1, n - 1, false, false, false);
    { float sacc = pB0[0] + pB0[1];
#pragma unroll
      for (int r = 2; r < 16; ++r) sacc += pB0[r];
#pragma unroll
      for (int r = 0; r < 16; ++r) sacc += pB1[r];
      l_reg += sacc;
      pw0 = (u32x4){PKW(pB0, 0), PKW(pB0, 2), PKW(pB0, 4), PKW(pB0, 6)}; pw1 = (u32x4){PKW(pB0, 8), PKW(pB0, 10), PKW(pB0, 12), PKW(pB0, 14)};
      pw2 = (u32x4){PKW(pB1, 0), PKW(pB1, 2), PKW(pB1, 4), PKW(pB1, 6)}; pw3 = (u32x4){PKW(pB1, 8), PKW(pB1, 10), PKW(pB1, 12), PKW(pB1, 14)};
      SBAR();
      const ALAS char* vp_ = vp0 + vs_cur;
#pragma unroll
      for (int d = 0; d < ND0; ++d) {
          const bf16x8 v0 = *(const ALAS bf16x8*)(vp_ + 0 * (DV * 32) + d * 512), v1 = *(const ALAS bf16x8*)(vp_ + 1 * (DV * 32) + d * 512), v2 = *(const ALAS bf16x8*)(vp_ + 2 * (DV * 32) + d * 512), v3 = *(const ALAS bf16x8*)(vp_ + 3 * (DV * 32) + d * 512);
          o[d] = ATT_MFMA(PAF(0), v0, o[d]); o[d] = ATT_MFMA(PAF(1), v1, o[d]); o[d] = ATT_MFMA(PAF(2), v2, o[d]); o[d] = ATT_MFMA(PAF(3), v3, o[d]); } }
    const float sacc = l_reg;
    const int lane_e = lane_id_v();
    ATT_WAIT_BAR(0);
    {
    const int lane = lane_e, r32 = lane & 31, hi = lane >> 5; const int q0 = ISB ? qb * 128 : qb * 256;
    float l = sum_x32(sacc);
    ALAS float* wsf = (ALAS float*)(shm3 + WSF_OFF) + wid * 64;
    if (hi == 0) wsf[r32] = l;
    asm volatile("s_waitcnt lgkmcnt(0)" ::: "memory");
    float rli[16];
#pragma unroll
    for (int r = 0; r < 16; ++r) rli[r] = __builtin_amdgcn_rcpf(wsf[crow(r, hi)]);
    if (!ISB) {
        ALAS bf16_t* stg = (ALAS bf16_t*)shm3 + wid * 2048;
#pragma unroll
        for (int r = 0; r < 16; ++r) { const int orow = crow(r, hi);
#pragma unroll
            for (int d = 0; d < ND0; ++d) stg[orow * 64 + d * 32 + r32] = pg8::f2bf1(o[d][r] * rli[r]); }
        asm volatile("s_waitcnt lgkmcnt(0)" ::: "memory");
#pragma unroll
        for (int i = 0; i < 4; ++i) { const int row = i * 8 + (lane >> 3), ch = lane & 7; const u32x4 v = *(const ALAS u32x4*)(stg + row * 64 + ch * 8);
            *(u32x4*)(T_MIX + (size_t)(q0 + wid * 32 + row) * 1024 + head * 64 + ch * 8) = v; }
    } else {
        ALAS float* X = (ALAS float*)shm3 + wq * 4096;
        const float sc = (mapc == 1) ? lam : 1.0f;
        if (mapc == 1) {
#pragma unroll
            for (int r = 0; r < 16; ++r) { const int orow = crow(r, hi); const float f = rli[r] * sc;
#pragma unroll
                for (int d = 0; d < ND0; ++d) X[orow * 128 + d * 32 + r32] = o[d][r] * f; }
        }
        asm volatile("s_waitcnt lgkmcnt(0)\n\ts_barrier" ::: "memory");
        if (mapc == 0) {
#pragma unroll
            for (int r = 0; r < 16; ++r) { const int orow = crow(r, hi);
#pragma unroll
                for (int d = 0; d < ND0; ++d) { const int idx = orow * 128 + d * 32 + r32; X[idx] = o[d][r] * rli[r] - X[idx]; } }
            asm volatile("s_waitcnt lgkmcnt(0)" ::: "memory");
            const int qq = lane >> 1, hf = lane & 1;
            const ALAS float* rowp = X + qq * 128 + hf * 64;
            f32x4 vv[16]; float ss = 0.f;
#pragma unroll
            for (int i = 0; i < 16; ++i) { vv[i] = *(const ALAS f32x4*)(rowp + 4 * i); ss += (vv[i][0] * vv[i][0] + vv[i][1] * vv[i][1]) + (vv[i][2] * vv[i][2] + vv[i][3] * vv[i][3]); }
            ss += xor_lane<1>(ss);
            const float rs = 0.8f / sqrtf(ss * (1.0f / 128.0f) + 1e-6f);
            bf16_t* dst = T_MIX + (size_t)(q0 + wq * 32 + qq) * 1024 + 512 + head * 128 + hf * 64;
            const ALAS float* sl = T.subln + hf * 64;
#pragma unroll
            for (int i = 0; i < 8; ++i) { const f32x4 g0 = *(const ALAS f32x4*)(sl + 8 * i), g1 = *(const ALAS f32x4*)(sl + 8 * i + 4); const f32x4 a = vv[2 * i] * rs * g0, b = vv[2 * i + 1] * rs * g1;
                u32x4 w; w.x = cvtpk(a[0], a[1]); w.y = cvtpk(a[2], a[3]); w.z = cvtpk(b[0], b[1]); w.w = cvtpk(b[2], b[3]); *(u32x4*)(dst + 8 * i) = w; }
        }
    }
    }
    asm volatile("s_waitcnt lgkmcnt(0)\n\ts_barrier" ::: "memory");
#undef DMA_K
#undef DMA_V
#undef ROT
#undef STEP
#undef ENDW
#undef GAPA
#undef GAPB
#undef GAPC
#undef VRD
#undef VRD2
#undef KRD
#undef KRD1
#undef CIN
#undef PAF
#undef KLOAD2
#undef BIAS4
#undef BIAS_ALL
}
}
static_assert(att::LDS_NEED <= RING_BYTES, "LDS map");

#define GAS __attribute__((address_space(1)))
#define LAS __attribute__((address_space(3)))
typedef unsigned short bf16;
typedef unsigned v4u __attribute__((ext_vector_type(4)));
typedef float f32x4 __attribute__((ext_vector_type(4)));
typedef GAS unsigned gu32;
#define RLX_AGENT __ATOMIC_RELAXED, __HIP_MEMORY_SCOPE_AGENT
#define LDS_WAIT() asm volatile("s_waitcnt lgkmcnt(0)" ::: "memory")
#define VM_WAIT() asm volatile("s_waitcnt vmcnt(0)" ::: "memory")
__device__ __forceinline__ unsigned f2bf(float f) { unsigned u = __builtin_bit_cast(unsigned, f); return (u + 0x7fffu + ((u >> 16) & 1u)) >> 16; }
__device__ __forceinline__ unsigned pk2(float lo, float hi) { return f2bf(lo) | (f2bf(hi) << 16); }
#define XB_TMO      128
#define XB_XCNT(j)  (256  + 64 * (j))
#define XB_XSUB(j)  (1280 + 64 * (j))
#define XB_XGEN(j)  (2304 + 64 * (j))
#define XB_TOP      3328
#define XB_TOPGEN   3392
#define XCD_BAR_WORDS 3456
#define XB_SPIN_CAP (1u << 18)

__device__ __forceinline__ unsigned xb_ld(unsigned* p)              { return __hip_atomic_load(p, __ATOMIC_RELAXED, __HIP_MEMORY_SCOPE_AGENT); }
__device__ __forceinline__ unsigned xb_add(unsigned* p, unsigned v) { return __hip_atomic_fetch_add(p, v, __ATOMIC_RELAXED, __HIP_MEMORY_SCOPE_AGENT); }
__device__ __forceinline__ unsigned xb_xcc_id() { return (unsigned)__builtin_amdgcn_s_getreg((3 << 11) | 20) & 0xFu; }
#define XB_SPIN(cond, bar) do { unsigned _sp = 0; while (cond) { __builtin_amdgcn_s_sleep(1); \
    if ((++_sp & 255u) == 0u) { if (xb_ld(&(bar)[XB_TMO])) break; if (_sp > XB_SPIN_CAP) { atomicAdd(&(bar)[XB_TMO], 1u); break; } } } } while (0)

struct XcdBarrier {
    unsigned* bar; unsigned x;
    volatile LAS unsigned* st;
};

__device__ __forceinline__ XcdBarrier xcd_barrier_post(unsigned* bar, volatile LAS unsigned* st, bool t0) {
    XcdBarrier b; b.bar = bar; b.x = (unsigned)__builtin_amdgcn_readfirstlane((int)xb_xcc_id()); b.st = st;
    if (t0) (void)xb_add(&bar[XB_XCNT(b.x)], 1u);
    return b;
}
__device__ __forceinline__ void xcd_barrier_complete(unsigned* bar, unsigned x, unsigned& nloc, unsigned& nx) {
    const unsigned G = gridDim.x * gridDim.y * gridDim.z;
    unsigned sum, cnt, mine, sp = 0u;
    for (;;) {
        sum = 0u; cnt = 0u; mine = 0u;
#pragma unroll
        for (unsigned j = 0; j < 16; ++j) { const unsigned c = xb_ld(&bar[XB_XCNT(j)]); sum += c; cnt += (c > 0u) ? 1u : 0u; mine = (j == x) ? c : mine; }
        if (sum == G) break;
        __builtin_amdgcn_s_sleep(1);
        if ((++sp & 255u) == 0u) { if (xb_ld(&bar[XB_TMO])) break; if (sp > XB_SPIN_CAP) { atomicAdd(&bar[XB_TMO], 1u); break; } }
    }
    nloc = mine > 0u ? mine : 1u; nx = cnt > 0u ? cnt : 1u;
}

__device__ __forceinline__ void xcd_barrier(const XcdBarrier& b_, int wave_id) {
    XcdBarrier b = b_; asm volatile("" : "+s"(b.bar), "+s"(b.x));
    const bool t0 = (wave_id == 0) && (lane_id_v() == 0);
    asm volatile("s_waitcnt vmcnt(0)" ::: "memory");
    __syncthreads();
    if (t0) {
        unsigned* bar = b.bar;
        __builtin_amdgcn_s_waitcnt(0);
        unsigned nloc = b.st[0], nx = b.st[1];
        if (nloc == 0u) { xcd_barrier_complete(bar, b.x, nloc, nx); b.st[0] = nloc; b.st[1] = nx; }
        const unsigned old = xb_add(&bar[XB_XSUB(b.x)], 1u);
        const unsigned gen = old / nloc;
        if (old + 1u == (gen + 1u) * nloc) {
            __builtin_amdgcn_fence(__ATOMIC_RELEASE, "agent");
            asm volatile("s_waitcnt vmcnt(0)" ::: "memory");
            const unsigned og = xb_add(&bar[XB_TOP], 1u);
            const unsigned tg = og / nx;
            if (og + 1u == (tg + 1u) * nx) xb_add(&bar[XB_TOPGEN], 1u);
            else XB_SPIN(xb_ld(&bar[XB_TOPGEN]) == tg, bar);
            __builtin_amdgcn_fence(__ATOMIC_ACQUIRE, "agent");
            xb_add(&bar[XB_XGEN(b.x)], 1u);
            asm volatile("s_waitcnt vmcnt(0)" ::: "memory");
        } else {
            XB_SPIN(xb_ld(&bar[XB_XGEN(b.x)]) == gen, bar);
            __builtin_amdgcn_fence(__ATOMIC_ACQUIRE, "agent");
            asm volatile("s_waitcnt vmcnt(0)" ::: "memory");
        }
    }
    __syncthreads();
}
#ifndef PHMASK
#define PHMASK 63
#endif
#ifndef ATT_DUP
#define ATT_DUP 1
#endif
#ifndef GU_DUP
#define GU_DUP 1
#endif

__device__ __forceinline__ float wave_sum(float v) { v += xor_lane<1>(v); v += xor_lane<2>(v); v += xor_lane<4>(v); v += xor_lane<8>(v); v += xor_lane<16>(v); return sum_x32(v); }
__device__ __forceinline__ float wave_max(float v) { v = fmaxf(v, xor_lane<1>(v)); v = fmaxf(v, xor_lane<2>(v)); v = fmaxf(v, xor_lane<4>(v)); v = fmaxf(v, xor_lane<8>(v)); v = fmaxf(v, xor_lane<16>(v)); return max_x32(v); }
__device__ __forceinline__ void tr_item(const float* W, int ldw, int srccol0, const float* gain, bf16* WT, int K, int dstrow0, int k0, LAS float* scr, int lane) {
#pragma unroll 8
    for (int i = 0; i < 32; ++i) { const int kk = 2 * i + (lane >> 5); float w = W[(size_t)(k0 + kk) * ldw + srccol0 + (lane & 31)]; if (gain) w *= gain[k0 + kk]; scr[kk * 33 + (lane & 31)] = w; }
    LDS_WAIT(); asm volatile("" ::: "memory");
    const int c = lane & 7;
#pragma unroll
    for (int j = 0; j < 4; ++j) { const int n = (lane >> 3) + 8 * j; const LAS float* s = scr + (8 * c) * 33 + n;
        v4u o; o.x = pk2(s[0 * 33], s[1 * 33]); o.y = pk2(s[2 * 33], s[3 * 33]); o.z = pk2(s[4 * 33], s[5 * 33]); o.w = pk2(s[6 * 33], s[7 * 33]);
        *(GAS v4u*)(WT + (size_t)(dstrow0 + n) * K + k0 + 8 * c) = o; }
    LDS_WAIT(); asm volatile("" ::: "memory");
}

struct Args { const float* in[21]; float* out; unsigned char* ws; };
#define LAUNDER(p) asm volatile("" : "+s"(p))

__global__ void __launch_bounds__(NWAVES * 64, 2) mk_fwd(Args args) {
    extern __shared__ __attribute__((aligned(16))) unsigned char lds[];
    LAS unsigned char* L = (LAS unsigned char*)lds;
    volatile LAS unsigned* MISC = (volatile LAS unsigned*)(L + MISC_OFF);
    const int wave = __builtin_amdgcn_readfirstlane((int)threadIdx.x >> 6);
    const int G = gridDim.x; const int bx = blockIdx.x;
    unsigned char* ws = args.ws; float* out = args.out;
    { const int tid = wave * 64 + lane_id_v(); for (int u = tid; u < (LDS_BYTES - LDSCTL_OFF) / 4; u += NWAVES * 64) ((LAS unsigned*)(L + LDSCTL_OFF))[u] = 0u; }
    __syncthreads();
    XcdBarrier bar = xcd_barrier_post((unsigned*)((gu32*)(ws + WS_CTL) + CW_BAR), MISC + 8, (wave == 0) && (lane_id_v() == 0));
    LAS float* rstd_tab = (LAS float*)(L + RSTD_OFF);
    LAS float* PRM = (LAS float*)(L + PRM_OFF);
    if (wave == 0) {
        const int lane = lane_id_v();
        const float gaq = args.in[7][lane], gak = args.in[8][lane], gbq = args.in[9][lane], gbk = args.in[10][lane];
        PRM[PRM_GAQ + lane] = gaq; PRM[PRM_GAK + lane] = gak; PRM[PRM_GBQ + lane] = gbq; PRM[PRM_GBK + lane] = gbk;
        PRM[PRM_SUBLN + lane] = args.in[15][lane]; PRM[PRM_SUBLN + 64 + lane] = args.in[15][64 + lane];
        const float maq = wave_max(fabsf(gaq)), mak = wave_max(fabsf(gak)), mbq = wave_max(fabsf(gbq)), mbk = wave_max(fabsf(gbk));
        float lm[4];
#pragma unroll
        for (int h = 0; h < 4; ++h) { const float d1 = wave_sum(args.in[11][h * 64 + lane] * args.in[12][h * 64 + lane]), d2 = wave_sum(args.in[13][h * 64 + lane] * args.in[14][h * 64 + lane]); lm[h] = expf(d1) - expf(d2) + 0.2f; }
        if (lane == 0) { PRM[PRM_NEGM2A] = -(8.0f * 1.4426950408889634f * 1.02f) * maq * mak; PRM[PRM_NEGM2B] = -(8.0f * 1.4426950408889634f * 1.02f) * mbq * mbk;
            PRM[PRM_LAM + 0] = lm[0]; PRM[PRM_LAM + 1] = lm[1]; PRM[PRM_LAM + 2] = lm[2]; PRM[PRM_LAM + 3] = lm[3]; }
    }
    LDS_WAIT(); __syncthreads();

#define BUILD_RSTD(S) do { pg8::Unit u_; const int tid = wave * 64 + lane_id_v(); const float* SSQ_ = (const float*)(ws + WS_SSQ); for (int i_ = 0; i_ < 6 && (S).next(i_, u_); ++i_) if (tid < 256) { const f32x4* p_ = (const f32x4*)(SSQ_ + (size_t)(u_.pm * 256 + tid) * 16); \
        const f32x4 a_ = p_[0], b_ = p_[1], c_ = p_[2], d_ = p_[3]; const float s_ = ((a_[0] + a_[1]) + (a_[2] + a_[3])) + ((b_[0] + b_[1]) + (b_[2] + b_[3])) + ((c_[0] + c_[1]) + (c_[2] + c_[3])) + ((d_[0] + d_[1]) + (d_[2] + d_[3])); \
        rstd_tab[i_ * 256 + tid] = 1.0f / sqrtf(s_ * (1.0f / 1024.0f) + 1e-6f); } LDS_WAIT(); __syncthreads(); } while (0)

#if (PHMASK & 1)
    {
        const int lane = lane_id_v(), tid = wave * 64 + lane;
        const int vcu = (G % 8 == 0) ? (bx % 8) * (G / 8) + bx / 8 : bx;
        bf16 *WGU1 = (bf16*)(ws + WS_WGU1), *WD1 = (bf16*)(ws + WS_WD1), *WIN = (bf16*)(ws + WS_WIN), *WOUT = (bf16*)(ws + WS_WOUT), *WGU2 = (bf16*)(ws + WS_WGU2), *WD2 = (bf16*)(ws + WS_WD2);
        float* ROPE = (float*)(ws + WS_ROPE); float* SSQ = (float*)(ws + WS_SSQ); bf16* XB = (bf16*)(ws + WS_XB); const float* x = args.in[0];
        LAS float* scr = (LAS float*)(L + RING_OFF + wave * 16384);
        const int gw = vcu * NWAVES + wave, NGW = G * NWAVES;
        constexpr int I_GU = (D / 64) * (NGU / 32), I_D = (FF / 64) * (D / 32), I_IN = (D / 64) * (NIN / 32), I_OUT = (D / 64) * (D / 32);
        constexpr int NITEMS = 2 * I_GU + 2 * I_D + I_IN + I_OUT;
        for (int it = gw; it < NITEMS; it += NGW) {
            int r = it;
            if (r < 2 * I_GU) { const int l2 = r >= I_GU; if (l2) r -= I_GU; const int kb = r / (NGU / 32), nb = r % (NGU / 32), n0 = nb * 32, pn = n0 >> 8, j0 = n0 & 255;
                const float* src = (j0 < 128) ? (l2 ? args.in[18] : args.in[2]) : (l2 ? args.in[19] : args.in[3]);
                tr_item(src, FF, pn * 128 + (j0 & 127), l2 ? args.in[17] : args.in[1], l2 ? WGU2 : WGU1, D, n0, kb * 64, scr, lane); continue; }
            r -= 2 * I_GU;
            if (r < 2 * I_D) { const int l2 = r >= I_D; if (l2) r -= I_D; const int kb = r / (D / 32), nb = r % (D / 32);
                tr_item(l2 ? args.in[20] : args.in[4], D, nb * 32, nullptr, l2 ? WD2 : WD1, FF, nb * 32, kb * 64, scr, lane); continue; }
            r -= 2 * I_D;
            if (r < I_IN) { const int kb = r / (NIN / 32), nb = r % (NIN / 32), n0 = nb * 32, pn = n0 >> 8, j0 = n0 & 255, bj = j0 >> 7, wc = (j0 >> 5) & 3;
                tr_item(args.in[6], NIN, pn * 256 + wc * 64 + bj * 32, args.in[5], WIN, D, n0, kb * 64, scr, lane); continue; }
            r -= I_IN;
            { const int kb = r / (D / 32), nb = r % (D / 32); tr_item(args.in[16], D, nb * 32, nullptr, WOUT, D, nb * 32, kb * 64, scr, lane); }
        }
        for (int m = gw; m < M; m += NGW) {
            const GAS f32x4* xr = (const GAS f32x4*)(x + (size_t)m * D) + lane; f32x4 v[4]; float s = 0.f;
#pragma unroll
            for (int j = 0; j < 4; ++j) { v[j] = xr[64 * j]; s += (v[j][0] * v[j][0] + v[j][1] * v[j][1]) + (v[j][2] * v[j][2] + v[j][3] * v[j][3]); }
            s = wave_sum(s);
            GAS unsigned long long* o8 = (GAS unsigned long long*)(XB + (size_t)m * D) + lane;
#pragma unroll
            for (int j = 0; j < 4; ++j) o8[64 * j] = (unsigned long long)pk2(v[j][0], v[j][1]) | ((unsigned long long)pk2(v[j][2], v[j][3]) << 32);
            if (lane < 16) SSQ[(size_t)m * 16 + lane] = (lane == 0) ? s : 0.f;
        }
        for (int e = bx * (NWAVES * 64) + tid; e < 5120; e += G * NWAVES * 64) {
            const int isc = e >= 4096, ee = isc ? e - 4096 : e, pos = ee >> 4, i = ee & 15;
            const float invf = powf(10000.0f, -(float)i * (1.0f / 16.0f)); const float ang = (float)pos * invf; float sn, cs; sincosf(ang, &sn, &cs);
            if (isc) { ROPE[8192 + ee] = cs; ROPE[9216 + ee] = sn; } else { ROPE[ee] = cs; ROPE[4096 + ee] = sn; }
        }
    }
#endif
    xcd_barrier(bar, wave);

    for (int rep = 0; rep < 2; ++rep) {
#if (PHMASK & 2)
        {
            LAUNDER(ws);
            pg8::Gemm g{(const bf16*)(ws + WS_XB), (const bf16*)(ws + (rep ? WS_WGU2 : WS_WGU1)), M, NGU, D}; pg8::StaticOrderT<M, NGU> S; S.init(G, bx);
            BUILD_RSTD(S);
            pg8::EpiSwiGLU E{ws, rstd_tab};
            for (int dup = 0; dup < GU_DUP; ++dup) { if (dup) xcd_barrier(bar, wave);
            pg8::gemm_phase<D, pg8::EpiSwiGLU, pg8::StaticOrderT<M, NGU>, true, true>(L + RING_OFF, g, S, E, wave); }
        }
#endif
        xcd_barrier(bar, wave);
#if (PHMASK & 4)
        {
            LAUNDER(ws); LAUNDER(out);
            pg8::Gemm g{(const bf16*)(ws + WS_H), (const bf16*)(ws + (rep ? WS_WD2 : WS_WD1)), M, D, FF}; pg8::StaticOrderT<M, D> S; S.init(G, bx);
            if (rep == 0) { pg8::EpiResid<true, false> E{args.in[0], out, ws, 0.5f}; pg8::gemm_phase<FF, pg8::EpiResid<true, false>, pg8::StaticOrderT<M, D>, false, true>(L + RING_OFF, g, S, E, wave); }
            else { pg8::EpiResid<false, true> E{nullptr, out, ws, 0.5f}; pg8::gemm_phase<FF, pg8::EpiResid<false, true>, pg8::StaticOrderT<M, D>, false, true>(L + RING_OFF, g, S, E, wave); }
        }
#endif
        if (rep == 1) break;
        xcd_barrier(bar, wave);
#if (PHMASK & 8)
        {
            LAUNDER(ws);
            pg8::Gemm g{(const bf16*)(ws + WS_XB), (const bf16*)(ws + WS_WIN), M, NIN, D}; pg8::StaticOrderT<M, NIN> S; S.init(G, bx);
            BUILD_RSTD(S);
            pg8::EpiInProj E{rstd_tab, PRM, ws};
            pg8::gemm_phase<D, pg8::EpiInProj, pg8::StaticOrderT<M, NIN>, true, true>(L + RING_OFF, g, S, E, wave);
        }
#endif
        xcd_barrier(bar, wave);
#if (PHMASK & 16)
        for (int dup = 0; dup < ATT_DUP; ++dup) {
            LAUNDER(ws);
            if (dup) xcd_barrier(bar, wave);
            gu32* qhead = (gu32*)(ws + WS_CTL) + CW_QUEUE + 64 * dup;
            const att::Tensors T = att::make_tensors(ws, PRM);
            for (;;) {
                if ((wave == 0) && (lane_id_v() == 0)) MISC[12] = __hip_atomic_fetch_add(qhead, 1u, RLX_AGENT);
                LDS_WAIT(); __syncthreads();
                const int idx = __builtin_amdgcn_readfirstlane((int)MISC[12]);
                if (idx >= 1024) break;
                if (idx < 256 || idx >= 768) {
                    int h, qb;
                    if (idx < 128) { h = 3; qb = idx; } else if (idx < 256) { const int i = idx - 128; h = 2; qb = (i & 1) ? 63 - (i >> 1) : 64 + (i >> 1); }
                    else if (idx < 896) { h = 1; qb = idx - 768; } else { h = 0; qb = idx - 896; }
                    const float slope = (h == 0) ? 0.25f : (h == 1) ? 0.0625f : (h == 2) ? 0.015625f : 0.00390625f;
                    const float c2 = slope * 1.4426950408889634f; const int dskip = (int)(150.0f / c2) + 1;
                    att::attn_unit<true>(T, h, qb, PRM[PRM_NEGM2B], PRM[PRM_LAM + h], c2, dskip, (char*)lds + RING_OFF, wave);
                } else { const int i = idx - 256; att::attn_unit<false>(T, i >> 6, i & 63, PRM[PRM_NEGM2A], 0.f, 0.f, 0, (char*)lds + RING_OFF, wave); }
            }
        }
#endif
        xcd_barrier(bar, wave);
#if (PHMASK & 32)
        {
            LAUNDER(ws); LAUNDER(out);
            pg8::Gemm g{(const bf16*)(ws + WS_MIX), (const bf16*)(ws + WS_WOUT), M, D, D}; pg8::StaticOrderT<M, D> S; S.init(G, bx);
            pg8::EpiResid<true, true> E{nullptr, out, ws, 1.0f}; pg8::gemm_phase<D, pg8::EpiResid<true, true>, pg8::StaticOrderT<M, D>, false, true>(L + RING_OFF, g, S, E, wave);
        }
#endif
        xcd_barrier(bar, wave);
    }
}

extern "C" void kernel_launch(void* const* d_in, const int* in_sizes, int n_in, void* d_out, int out_size, void* d_ws, size_t ws_size, hipStream_t stream) {
    static int grid = 0;
    if (grid == 0) {
        if (n_in != 21 || in_sizes[0] != M * D || out_size != M * D || ws_size < WS_END) { fprintf(stderr, "kernel_launch: unexpected shapes (n_in %d, in0 %d, out %d, ws %zu)\n", n_in, n_in > 0 ? in_sizes[0] : -1, out_size, ws_size); grid = -1; return; }
        int dev = 0, cus = 0, per_cu = 0;
        if (hipGetDevice(&dev) != hipSuccess || hipDeviceGetAttribute(&cus, hipDeviceAttributeMultiprocessorCount, dev) != hipSuccess) { grid = -1; return; }
        if (hipFuncSetAttribute((const void*)mk_fwd, hipFuncAttributeMaxDynamicSharedMemorySize, LDS_BYTES) != hipSuccess) { fprintf(stderr, "kernel_launch: hipFuncSetAttribute failed\n"); grid = -1; return; }
        if (hipOccupancyMaxActiveBlocksPerMultiprocessor(&per_cu, (const void*)mk_fwd, NWAVES * 64, LDS_BYTES) != hipSuccess || per_cu < 1) { fprintf(stderr, "kernel_launch: occupancy query says %d blocks per CU\n", per_cu); (void)hipGetLastError(); grid = -1; return; }
        grid = cus;
    }
    if (grid < 0) return;
    if (hipMemsetAsync((char*)d_ws + WS_CTL, 0, CTL_ZERO_BYTES, stream) != hipSuccess) { fprintf(stderr, "kernel_launch: memset failed\n"); return; }
    Args a{};
    for (int i = 0; i < 21; ++i) a.in[i] = (const float*)d_in[i];
    a.out = (float*)d_out; a.ws = (unsigned char*)d_ws;
    hipLaunchKernelGGL(mk_fwd, dim3(grid), dim3(NWAVES * 64), LDS_BYTES, stream, a);
    const hipError_t le = hipPeekAtLastError();
    if (le != hipSuccess) fprintf(stderr, "kernel_launch: launch failed: %s\n", hipGetErrorName(le));
}
```

```cpp
#include <hip/hip_runtime.h>
#include <cstdio>
#include <cstdint>
#ifndef BDMA_MODE
#define BDMA_MODE 0
#endif
#ifndef A8U
#define A8U 4
#endif
#ifndef A8_NOBF8
#define A8_BF8 1
#endif

constexpr int NWAVES = 8;
constexpr int M = 16384, D = 1024, FF = 2816, NGU = 2 * FF, NIN = 2304;
constexpr size_t MiB = 1u << 20;
constexpr size_t WS_CTL = 0, CTL_ZERO_BYTES = 64 * 1024;
constexpr size_t WS_WGU1 = 2 * MiB, WS_WD1 = 13 * MiB, WS_WIN = 19 * MiB, WS_WOUT = 24 * MiB, WS_WGU2 = 26 * MiB, WS_WD2 = 37 * MiB;
constexpr size_t WS_ROPE = 43 * MiB, WS_SSQ = 44 * MiB;
constexpr size_t WS_XB = 48 * MiB;
constexpr size_t WS_H = 80 * MiB;
constexpr size_t WS_QA = 80 * MiB, WS_KA = 96 * MiB, WS_VA = 100 * MiB, WS_QB = 104 * MiB, WS_KB = 120 * MiB, WS_VB = 136 * MiB, WS_MIX = 152 * MiB;
constexpr size_t WS_END = 184 * MiB;
static_assert(WS_WGU1 + (size_t)NGU * D * 2 <= WS_WD1 && WS_WD1 + (size_t)D * FF * 2 <= WS_WIN && WS_WIN + (size_t)NIN * D * 2 <= WS_WOUT && WS_WOUT + (size_t)D * D * 2 <= WS_WGU2 &&
              WS_WGU2 + (size_t)NGU * D * 2 <= WS_WD2 && WS_WD2 + (size_t)D * FF * 2 <= WS_ROPE && WS_H + (size_t)M * FF * 2 <= WS_END && WS_MIX + (size_t)M * D * 2 <= WS_END, "d_ws map");
constexpr int CW_BAR = 1024;
constexpr int CW_XFLAG = 9216;
constexpr size_t WS_XCH = 184 * MiB;
constexpr int CW_QUEUE = 8192;
constexpr int RING_OFF = 0, RING_BYTES = 131072;
constexpr int LDSCTL_OFF = RING_BYTES, MISC_OFF = LDSCTL_OFF + 320, RSTD_OFF = LDSCTL_OFF + 1024, PRM_OFF = LDSCTL_OFF + 8192;
constexpr int LDS_BYTES = 147456;
constexpr int PRM_GAQ = 0, PRM_GAK = 64, PRM_GBQ = 128, PRM_GBK = 192, PRM_SUBLN = 256, PRM_NEGM2A = 384, PRM_NEGM2B = 385, PRM_LAM = 388, PRM_WORDS = 392;
static_assert(RSTD_OFF + 6 * 256 * 4 <= PRM_OFF && PRM_OFF + PRM_WORDS * 4 <= LDS_BYTES, "LDS map");

__device__ __forceinline__ int lane_id_v() { int l; asm volatile("v_mbcnt_lo_u32_b32 %0, -1, 0\n\tv_mbcnt_hi_u32_b32 %0, -1, %0" : "=v"(l)); return l; }

template <int MASK> __device__ __forceinline__ float xor_lane(float v) {
    if constexpr (MASK == 32) { const auto rr = __builtin_amdgcn_permlane32_swap(__float_as_uint(v), __float_as_uint(v), false, false); return __uint_as_float(lane_id_v() < 32 ? rr[1] : rr[0]); }
    else return __uint_as_float((unsigned)__builtin_amdgcn_ds_swizzle((int)__float_as_uint(v), (MASK << 10) | 0x1f));
}
__device__ __forceinline__ float sum_x32(float v) { const auto rr = __builtin_amdgcn_permlane32_swap(__float_as_uint(v), __float_as_uint(v), false, false); return __uint_as_float(rr[0]) + __uint_as_float(rr[1]); }
__device__ __forceinline__ float max_x32(float v) { const auto rr = __builtin_amdgcn_permlane32_swap(__float_as_uint(v), __float_as_uint(v), false, false); return fmaxf(__uint_as_float(rr[0]), __uint_as_float(rr[1])); }

#define LAUNDER_G(p) do { __attribute__((address_space(1))) void* g_ = (__attribute__((address_space(1))) void*)(p); asm volatile("" : "+s"(g_)); (p) = (decltype(p))g_; } while (0)
namespace pg8 {
#define PG8_LAS __attribute__((address_space(3)))
typedef unsigned short bf16_t;
typedef short bf16x8 __attribute__((ext_vector_type(8)));
typedef float f32x4 __attribute__((ext_vector_type(4)));
typedef unsigned u32x4 __attribute__((ext_vector_type(4)));
constexpr int BM = 256, BK = 64, HALF = 128, HTB = HALF * BK * 2  , STAGE_BYTES = 8 * HTB, NXCD = 8, WGM = 8;

__host__ __device__ __forceinline__ int lds_byte(int r, int c) { const int st = (r >> 4) * 2 + (c >> 5), rr = r & 15, cc = c & 31, ob = rr * 64 + cc * 2; return st * 1024 + (ob ^ (((ob >> 9) & 1) << 5)); }
__host__ __device__ __forceinline__ void stage_rc(int b, int& R, int& C) { const int st = b / 1024, sb = b % 1024, swz = sb ^ (((sb >> 9) & 1) << 5); R = (st >> 1) * 16 + swz / 64; C = (st & 1) * 32 + (swz % 64) / 2; }
__host__ __device__ __forceinline__ int perm32(int rho) { const int n = rho >> 4, i = rho & 15; return 8 * (i >> 2) + 4 * n + (i & 3); }

struct Unit { int pm, pn; int kofs, nt; };
struct Gemm { const bf16_t* A; const bf16_t* Bt; int M, N, K; };

template <int MD, int ND> struct StaticOrderT {
    static constexpr int nM = MD / BM, nN = ND / BM, nwg = nM * nN;
    int G, c;
    __host__ __device__ void init(int G_, int c_) { G = G_; c = c_; }
    __host__ __device__ bool next(int i, Unit& u) const { return at(i * G + c, u); }
    __host__ __device__ bool at(int L, Unit& u) const {
        if (L >= nwg) return false;
        int wgid = L; { constexpr int q = nwg / NXCD, r = nwg % NXCD; const int xcd = wgid % NXCD, off = wgid / NXCD; wgid = (xcd < r ? xcd * (q + 1) : r * (q + 1) + (xcd - r) * q) + off; }
        constexpr int nig = WGM * nN; const int gid = wgid / nig, fm = gid * WGM, gsz = (nM - fm) < WGM ? (nM - fm) : WGM;
        u.pm = fm + ((wgid % nig) % gsz); u.pn = (wgid % nig) / gsz; u.kofs = 0; u.nt = 0; return true;
    }
    __device__ __forceinline__ void a_ready(const Unit&) const {}
    __device__ __forceinline__ void done(const Unit&) const {}
};
template <class S0, int RT, int NTF> struct SplitTailOrderT { S0 s; bool sk;
    __host__ __device__ bool next(int i, Unit& u) const {
        if (!sk || i < RT) { const bool r = s.next(i, u); u.kofs = 0; u.nt = NTF; return r; }
        if (i > RT) return false;
        const int h = s.G >> 1; s.at(RT * s.G + (s.c % h), u); u.kofs = (s.c / h) * (NTF / 2) * BK * 2; u.nt = NTF / 2; return true; }
    __device__ __forceinline__ void a_ready(const Unit&) const {} __device__ __forceinline__ void done(const Unit&) const {} };


__device__ __forceinline__ unsigned cvt_pk_bf16(float lo, float hi) { unsigned r; asm volatile("v_cvt_pk_bf16_f32 %0, %1, %2" : "=v"(r) : "v"(lo), "v"(hi)); return r; }
__device__ __forceinline__ unsigned short f2bf1(float f) { unsigned u = __builtin_bit_cast(unsigned, f); return (unsigned short)((u + 0x7fffu + ((u >> 16) & 1u)) >> 16); }
typedef unsigned u32x2 __attribute__((ext_vector_type(2)));
constexpr int MROWS = M, DMODEL = D, DFF = FF;

typedef float f32x2 __attribute__((ext_vector_type(2)));
__device__ __forceinline__ f32x2 swiglu2(f32x2 ag, f32x2 au, float k1, float rs2) {
    const f32x2 t = ag * k1; f32x2 ex; ex.x = __builtin_amdgcn_exp2f(t.x); ex.y = __builtin_amdgcn_exp2f(t.y);
    const f32x2 d = ex + 1.0f; f32x2 r; r.x = __builtin_amdgcn_rcpf(d.x); r.y = __builtin_amdgcn_rcpf(d.y);
    return ((ag * au) * rs2) * r;
}
__device__ __forceinline__ f32x4 swiglu4(f32x4 ag, f32x4 au, float k1, float rs2) {
    const f32x2 a = swiglu2((f32x2){ag[0], ag[1]}, (f32x2){au[0], au[1]}, k1, rs2), b = swiglu2((f32x2){ag[2], ag[3]}, (f32x2){au[2], au[3]}, k1, rs2);
    return (f32x4){a.x, a.y, b.x, b.y};
}
struct EpiSwiGLU {
    static constexpr bool PERM = true, AFTER_DRAIN = false;
    unsigned char* ws; const PG8_LAS float* rstd;
    __device__ __forceinline__ void operator()(const f32x4 (&acc)[2][2][4][2], const Unit& u, int ui, int wr, int wc, int fr, int fq) const {
        asm volatile("" : "+v"(fr), "+v"(fq));
        const int col0 = u.pn * 128 + wc * 32 + 8 * fq; unsigned char* w2 = ws; LAUNDER_G(w2); bf16_t* H = (bf16_t*)(w2 + WS_H);
#pragma unroll
        for (int ai = 0; ai < 2; ++ai)
#pragma unroll
            for (int m = 0; m < 4; ++m) {
                const int rl = ai * HALF + wr * 64 + m * 16 + fr; const float rs = rstd[ui * 256 + rl];
                const float k1 = rs * -1.4426950408889634f, rs2 = rs * rs;
                const f32x4 h0 = swiglu4(acc[ai][0][m][0], acc[ai][1][m][0], k1, rs2), h1 = swiglu4(acc[ai][0][m][1], acc[ai][1][m][1], k1, rs2);
                u32x4 w; w.x = cvt_pk_bf16(h0[0], h0[1]); w.y = cvt_pk_bf16(h0[2], h0[3]); w.z = cvt_pk_bf16(h1[0], h1[1]); w.w = cvt_pk_bf16(h1[2], h1[3]);
                *(u32x4*)(H + (size_t)(u.pm * BM + rl) * DFF + col0) = w;
            }
    }
};
struct EpiSwiGLUSplit {
    static constexpr bool PERM = true, AFTER_DRAIN = false;
    unsigned char* ws; const PG8_LAS float* rstd;
    typedef unsigned long long u64;
    __device__ __forceinline__ static void put(u64* p, const f32x4& v) {
        __hip_atomic_store(p, ((u64)__float_as_uint(v[1]) << 32) | __float_as_uint(v[0]), __ATOMIC_RELAXED, __HIP_MEMORY_SCOPE_AGENT);
        __hip_atomic_store(p + 1, ((u64)__float_as_uint(v[3]) << 32) | __float_as_uint(v[2]), __ATOMIC_RELAXED, __HIP_MEMORY_SCOPE_AGENT); }
    __device__ __forceinline__ static f32x4 get(const u64* p) {
        const u64 a = __hip_atomic_load(p, __ATOMIC_RELAXED, __HIP_MEMORY_SCOPE_AGENT), b = __hip_atomic_load(p + 1, __ATOMIC_RELAXED, __HIP_MEMORY_SCOPE_AGENT);
        return (f32x4){__uint_as_float((unsigned)a), __uint_as_float((unsigned)(a >> 32)), __uint_as_float((unsigned)b), __uint_as_float((unsigned)(b >> 32))}; }
    template <int SS> __device__ __forceinline__ void run(const f32x4 (&acc)[2][2][4][2], const Unit& u, int wr, int wc, int fr, int fq) const {
        unsigned char* w2 = ws; LAUNDER_G(w2);
        const int pair = (int)(__builtin_amdgcn_workgroup_id_x() & 127u); constexpr int rslot = 5;
        const unsigned tid = (unsigned)((wr * 4 + wc) * 64 + fq * 16 + fr);
        unsigned char* xb_ = w2 + WS_XCH + (size_t)pair * (2 * 16 * 512 * 16);
        u64* xo = (u64*)(xb_ + (size_t)(1 - SS) * (16 * 512 * 16) + tid * 16u);
        const u64* xi = (const u64*)(xb_ + (size_t)SS * (16 * 512 * 16) + tid * 16u);
        unsigned* flg = (unsigned*)(w2 + WS_CTL) + CW_XFLAG + pair * 2;
#pragma unroll
        for (int bj = 0; bj < 2; ++bj)
#pragma unroll
            for (int m = 0; m < 4; ++m)
#pragma unroll
                for (int n = 0; n < 2; ++n) put(xo + (size_t)((bj * 4 + m) * 2 + n) * 1024, acc[1 - SS][bj][m][n]);
        asm volatile("s_waitcnt vmcnt(0)" ::: "memory");
        __syncthreads();
        if (tid == 0) { __hip_atomic_store(flg + (1 - SS), 1u, __ATOMIC_RELAXED, __HIP_MEMORY_SCOPE_AGENT);
            unsigned sp = 0; while (__hip_atomic_load(flg + SS, __ATOMIC_RELAXED, __HIP_MEMORY_SCOPE_AGENT) == 0u) { __builtin_amdgcn_s_sleep(1); if (++sp > (1u << 20)) break; } }
        __syncthreads();
        bf16_t* H = (bf16_t*)(w2 + WS_H); const int col0 = u.pn * 128 + wc * 32 + 8 * fq;
#pragma unroll
        for (int m = 0; m < 4; ++m) {
            const f32x4 g0 = acc[SS][0][m][0] + get(xi + (size_t)((0 * 4 + m) * 2 + 0) * 1024), g1 = acc[SS][0][m][1] + get(xi + (size_t)((0 * 4 + m) * 2 + 1) * 1024);
            const f32x4 u0 = acc[SS][1][m][0] + get(xi + (size_t)((1 * 4 + m) * 2 + 0) * 1024), u1 = acc[SS][1][m][1] + get(xi + (size_t)((1 * 4 + m) * 2 + 1) * 1024);
            const int rl = SS * HALF + wr * 64 + m * 16 + fr; const float rs = rstd[rslot * 256 + rl];
            const float k1 = rs * -1.4426950408889634f, rs2 = rs * rs;
            const f32x4 h0 = swiglu4(g0, u0, k1, rs2), h1 = swiglu4(g1, u1, k1, rs2);
            u32x4 w; w.x = cvt_pk_bf16(h0[0], h0[1]); w.y = cvt_pk_bf16(h0[2], h0[3]); w.z = cvt_pk_bf16(h1[0], h1[1]); w.w = cvt_pk_bf16(h1[2], h1[3]);
            *(u32x4*)(H + (size_t)(u.pm * BM + rl) * DFF + col0) = w;
        }
    }
    __device__ __forceinline__ void operator()(const f32x4 (&acc)[2][2][4][2], const Unit& u, int ui, int wr, int wc, int fr, int fq) const {
        if (u.nt == (D / BK) / 2) { asm volatile("" : "+v"(fr), "+v"(fq));
            if (__builtin_amdgcn_workgroup_id_x() >> 7) run<1>(acc, u, wr, wc, fr, fq); else run<0>(acc, u, wr, wc, fr, fq); }
        else { EpiSwiGLU E0{ws, rstd}; E0(acc, u, ui, wr, wc, fr, fq); }
    }
};
template <bool SRC_B, bool WRITE_B, bool WRITE_F, int PROBE = 0> struct EpiResid {
    static constexpr bool PERM = true, AFTER_DRAIN = false;
    const float* base; float* out; unsigned char* ws; float alpha;
    __device__ __forceinline__ static f32x4 up4(unsigned a, unsigned b) { return (f32x4){__uint_as_float(a << 16), __uint_as_float(a & 0xffff0000u), __uint_as_float(b << 16), __uint_as_float(b & 0xffff0000u)}; }
    __device__ __forceinline__ void operator()(const f32x4 (&acc)[2][2][4][2], const Unit& u, int ui, int wr, int wc, int fr, int fq) const {
        asm volatile("" : "+v"(fr), "+v"(fq));
        const int col0 = u.pn * BM + wc * 32 + 8 * fq;
        unsigned char* w2 = ws; LAUNDER_G(w2); bf16_t* xb = (bf16_t*)(w2 + WS_XB); float* ssqp = (float*)(w2 + WS_SSQ);
#pragma unroll
        for (int ai = 0; ai < 2; ++ai) {
            f32x4 rb[4][2][2];
#pragma unroll
            for (int m = 0; m < 4; ++m) { const size_t off = (size_t)(u.pm * BM + ai * HALF + wr * 64 + m * 16 + fr) * DMODEL + col0;
#pragma unroll
                for (int bj = 0; bj < 2; ++bj) {
                    if (PROBE == 1) { rb[m][bj][0] = (f32x4){0.f, 0.f, 0.f, 0.f}; rb[m][bj][1] = rb[m][bj][0]; }
                    else if (SRC_B) { const u32x4 r = *(const u32x4*)(xb + off + bj * HALF); rb[m][bj][0] = __builtin_bit_cast(f32x4, r); }
                    else { rb[m][bj][0] = *(const f32x4*)(base + off + bj * HALF); rb[m][bj][1] = *(const f32x4*)(base + off + bj * HALF + 4); } } }
#pragma unroll
            for (int m = 0; m < 4; ++m) {
                const int row = u.pm * BM + ai * HALF + wr * 64 + m * 16 + fr; const size_t off = (size_t)row * DMODEL + col0; float ss = 0.f;
#pragma unroll
                for (int bj = 0; bj < 2; ++bj) { const size_t o = off + bj * HALF;
                    f32x4 b0, b1;
                    if (SRC_B) { const u32x4 r = __builtin_bit_cast(u32x4, rb[m][bj][0]); b0 = up4(r[0], r[1]); b1 = up4(r[2], r[3]); } else { b0 = rb[m][bj][0]; b1 = rb[m][bj][1]; }
                    const f32x4 v0 = b0 + acc[ai][bj][m][0] * alpha, v1 = b1 + acc[ai][bj][m][1] * alpha;
                    if (PROBE == 2) { asm volatile("" :: "v"(v0), "v"(v1)); }
                    if (WRITE_F && PROBE != 2) { *(f32x4*)(out + o) = v0; *(f32x4*)(out + o + 4) = v1; }
                    if (WRITE_B && PROBE != 2) { ss += ((v0[0] * v0[0] + v0[1] * v0[1]) + (v0[2] * v0[2] + v0[3] * v0[3])) + ((v1[0] * v1[0] + v1[1] * v1[1]) + (v1[2] * v1[2] + v1[3] * v1[3]));
                        u32x4 w; w.x = cvt_pk_bf16(v0[0], v0[1]); w.y = cvt_pk_bf16(v0[2], v0[3]); w.z = cvt_pk_bf16(v1[0], v1[1]); w.w = cvt_pk_bf16(v1[2], v1[3]); *(u32x4*)(xb + o) = w; } }
                if (WRITE_B && PROBE != 2) { ss += xor_lane<16>(ss); ss = sum_x32(ss); if (fq == 0) ssqp[(size_t)row * 16 + u.pn * 4 + wc] = ss; }
            }
            asm volatile("" ::: "memory");
        }
    }
};
template <bool WRITE_B, bool WRITE_F> struct EpiResidStaged {
    static constexpr bool PERM = true, AFTER_DRAIN = true;
    float* out; unsigned char* ws; float alpha; unsigned char* wsw;
    __device__ __forceinline__ static f32x4 up4(unsigned a, unsigned b) { return (f32x4){__uint_as_float(a << 16), __uint_as_float(a & 0xffff0000u), __uint_as_float(b << 16), __uint_as_float(b & 0xffff0000u)}; }
    __device__ __forceinline__ void fused(f32x4 (&acc)[2][2][4][2], const Unit& u, int wr, int wc, int fr, int fq, PG8_LAS unsigned char* lds, int wid, int lane) const {
        unsigned char* w2 = ws; LAUNDER_G(w2); const bf16_t* xb = (const bf16_t*)(w2 + WS_XB); unsigned char* w3 = wsw; LAUNDER_G(w3); bf16_t* xbw = (bf16_t*)(w3 + WS_XB); float* ssqp = (float*)(w3 + WS_SSQ);
        {
            const int tid = wid * 64 + lane, c = tid & 31, r0 = tid >> 5;
            const bf16_t* src = xb + (size_t)(u.pm * BM + r0) * DMODEL + u.pn * BM + c * 8;
            u32x4 t[16];
#pragma unroll
            for (int p = 0; p < 16; ++p) t[p] = *(const u32x4*)(src + (size_t)(p * 16) * DMODEL);
#pragma unroll
            for (int p = 0; p < 16; ++p) { const int r = p * 16 + r0; *(PG8_LAS u32x4*)(lds + r * 512 + ((c ^ (r & 15)) << 4)) = t[p]; }
        }
        asm volatile("s_waitcnt vmcnt(0) lgkmcnt(0)\n\ts_barrier" ::: "memory");
        asm volatile("" : "+v"(fr), "+v"(fq));
        const int col0 = u.pn * BM + wc * 32 + 8 * fq;
#pragma unroll
        for (int ai = 0; ai < 2; ++ai)
#pragma unroll
            for (int m = 0; m < 4; ++m) {
                const int rl = ai * HALF + wr * 64 + m * 16 + fr; const int row = u.pm * BM + rl; const size_t off = (size_t)row * DMODEL + col0; float ss = 0.f;
#pragma unroll
                for (int bj = 0; bj < 2; ++bj) { const size_t o = off + bj * HALF;
                    const int chunk = 16 * bj + 4 * wc + fq;
                    const u32x4 r = *(const PG8_LAS u32x4*)(lds + rl * 512 + ((chunk ^ (rl & 15)) << 4));
                    const f32x4 b0 = up4(r[0], r[1]), b1 = up4(r[2], r[3]);
                    const f32x4 v0 = b0 + acc[ai][bj][m][0] * alpha, v1 = b1 + acc[ai][bj][m][1] * alpha;
                    if (WRITE_F) { *(f32x4*)(out + o) = v0; *(f32x4*)(out + o + 4) = v1; }
                    if (WRITE_B) { ss += ((v0[0] * v0[0] + v0[1] * v0[1]) + (v0[2] * v0[2] + v0[3] * v0[3])) + ((v1[0] * v1[0] + v1[1] * v1[1]) + (v1[2] * v1[2] + v1[3] * v1[3]));
                        u32x4 w; w.x = cvt_pk_bf16(v0[0], v0[1]); w.y = cvt_pk_bf16(v0[2], v0[3]); w.z = cvt_pk_bf16(v1[0], v1[1]); w.w = cvt_pk_bf16(v1[2], v1[3]); *(u32x4*)(xbw + o) = w; } }
                if (WRITE_B) { ss += xor_lane<16>(ss); ss = sum_x32(ss); if (fq == 0) ssqp[(size_t)row * 16 + u.pn * 4 + wc] = ss; }
            }
    }
};
struct EpiNull {
    static constexpr bool PERM = true, AFTER_DRAIN = false;
    __device__ __forceinline__ void operator()(const f32x4 (&acc)[2][2][4][2], const Unit& u, int ui, int wr, int wc, int fr, int fq) const {
#pragma unroll
        for (int ai = 0; ai < 2; ++ai)
#pragma unroll
            for (int bj = 0; bj < 2; ++bj)
#pragma unroll
                for (int m = 0; m < 4; ++m)
#pragma unroll
                    for (int n = 0; n < 2; ++n) { f32x4 t = acc[ai][bj][m][n]; asm volatile("" :: "v"(t)); }
    }
};
struct EpiInProj {
    static constexpr bool PERM = false, AFTER_DRAIN = false;
    const PG8_LAS float* rstd; const PG8_LAS float* prm; unsigned char* ws;
    __device__ __forceinline__ static float head_f(const f32x4 (&acc)[2][2][4][2], int ai, int m, float rs) {
        float ss = 0.f;
#pragma unroll
        for (int bj = 0; bj < 2; ++bj)
#pragma unroll
            for (int n = 0; n < 2; ++n) { const f32x4 a = acc[ai][bj][m][n]; ss += (a[0] * a[0] + a[1] * a[1]) + (a[2] * a[2] + a[3] * a[3]); }
        ss += xor_lane<16>(ss); ss = sum_x32(ss);
        return rs / sqrtf(ss * rs * rs * (1.0f / 64.0f) + 1e-6f);
    }
    __device__ __forceinline__ void operator()(const f32x4 (&acc)[2][2][4][2], const Unit& u, int ui, int wr, int wc, int fr, int fq) const {
        const int G = __builtin_amdgcn_readfirstlane(u.pn * 4 + wc);
        unsigned char* w2 = ws; LAUNDER_G(w2);
        asm volatile("" : "+v"(fr), "+v"(fq));
        const int row0 = wr * 64 + fr;
        if (G < 10) {
            const bool isq = G < 8;
            const PG8_LAS float* gp = prm + (isq ? PRM_GAQ : PRM_GAK) + 4 * fq;
            const float* rope = (const float*)(w2 + WS_ROPE) + 4 * fq;
            const float qs = isq ? 0.125f * 1.4426950408889634f : 1.0f;
            unsigned char* db = isq ? (w2 + WS_QA) + (size_t)G * MROWS * 64 + 8 * fq : (w2 + WS_KA) + (size_t)(G - 8) * MROWS * 64 + (fq >> 1) * 512 + 8 * (fq & 1);
#pragma unroll
            for (int ai = 0; ai < 2; ++ai)
#pragma unroll
                for (int m = 0; m < 4; ++m) {
                    const int rl = ai * HALF + m * 16 + row0; const int t = u.pm * BM + rl; const float f = head_f(acc, ai, m, rstd[ui * 256 + rl]) * qs;
                    unsigned char* dt = isq ? db + (size_t)t * 64 : db + (size_t)(t >> 6) * 4096 + ((t & 63) >> 5) * 2048 + (t & 31) * 16;
#pragma unroll
                    for (int bj = 0; bj < 2; ++bj) {
                        const f32x4 x1 = acc[ai][bj][m][0] * f * *(const PG8_LAS f32x4*)(gp + 32 * bj), x2 = acc[ai][bj][m][1] * f * *(const PG8_LAS f32x4*)(gp + 32 * bj + 16);
                        const int pos = bj ? (t & 63) : (t >> 6); const float* rp = rope + (bj ? 8192 : 0) + pos * 16;
                        const f32x4 c = *(const f32x4*)rp, s = *(const f32x4*)(rp + (bj ? 1024 : 4096));
                        const f32x4 y1 = x1 * c - x2 * s, y2 = x2 * c + x1 * s;
                        int lo = __builtin_amdgcn_cvt_pk_fp8_f32(y1[0], y1[1], 0, false); lo = __builtin_amdgcn_cvt_pk_fp8_f32(y1[2], y1[3], lo, true);
                        int hi = __builtin_amdgcn_cvt_pk_fp8_f32(y2[0], y2[1], 0, false); hi = __builtin_amdgcn_cvt_pk_fp8_f32(y2[2], y2[3], hi, true);
                        u32x2 w; w.x = (unsigned)lo; w.y = (unsigned)hi;
                        *(u32x2*)(dt + (isq ? 32 * bj : 1024 * bj)) = w;
                    }
                    asm volatile("" ::: "memory");
                }
        } else if (G < 12) {
            unsigned char* V8 = (w2 + WS_VA) + (size_t)(G - 10) * MROWS * 64 + (4 * fq) * 16;
#pragma unroll
            for (int ai = 0; ai < 2; ++ai)
#pragma unroll
                for (int m = 0; m < 4; ++m) {
                    const int rl = ai * HALF + m * 16 + row0; const int t = u.pm * BM + rl; const float rs = rstd[ui * 256 + rl];
                    const int kk = t & 63, c = kk >> 5, r = kk & 31, h = (r >> 2) & 1, jj = (r & 3) + 4 * (r >> 3);
                    unsigned char* vb = V8 + (size_t)(t >> 6) * 4096 + h * 1024 + c * 512 + jj;
#pragma unroll
                    for (int bj = 0; bj < 2; ++bj)
#pragma unroll
                        for (int n = 0; n < 2; ++n) { const f32x4 v = acc[ai][bj][m][n] * rs;
                            const int p01 = __builtin_amdgcn_cvt_pk_fp8_f32(v[0], v[1], 0, false), p23 = __builtin_amdgcn_cvt_pk_fp8_f32(v[2], v[3], 0, false);
                            unsigned char* q = vb + bj * 2048 + (16 * n) * 16;
                            q[0] = (unsigned char)(p01 & 0xff); q[16] = (unsigned char)((p01 >> 8) & 0xff); q[32] = (unsigned char)(p23 & 0xff); q[48] = (unsigned char)((p23 >> 8) & 0xff); }
                    asm volatile("" ::: "memory");
                }
        } else if (G < 28) {
            const bool isq = G < 20;
            const PG8_LAS float* gp = prm + (isq ? PRM_GBQ : PRM_GBK) + 4 * fq;
            const float qs = isq ? 0.125f * 1.4426950408889634f : 1.0f;
            bf16_t* db = isq ? (bf16_t*)(w2 + WS_QB) + (size_t)(G - 12) * MROWS * 64 + 8 * fq : (bf16_t*)(w2 + WS_KB) + (size_t)(G - 20) * MROWS * 64 + (size_t)fq * 512;
#pragma unroll
            for (int ai = 0; ai < 2; ++ai)
#pragma unroll
                for (int m = 0; m < 4; ++m) {
                    const int rl = ai * HALF + m * 16 + row0; const int t = u.pm * BM + rl; const float f = head_f(acc, ai, m, rstd[ui * 256 + rl]) * qs;
                    bf16_t* dt = isq ? db + (size_t)t * 64 : db + (size_t)(t >> 6) * 4096 + (t & 63) * 8;
#pragma unroll
                    for (int bj = 0; bj < 2; ++bj) {
                        const f32x4 x1 = acc[ai][bj][m][0] * f * *(const PG8_LAS f32x4*)(gp + 32 * bj), x2 = acc[ai][bj][m][1] * f * *(const PG8_LAS f32x4*)(gp + 32 * bj + 16);
                        u32x4 w; w.x = cvt_pk_bf16(x1[0], x1[1]); w.y = cvt_pk_bf16(x1[2], x1[3]); w.z = cvt_pk_bf16(x2[0], x2[1]); w.w = cvt_pk_bf16(x2[2], x2[3]);
                        *(u32x4*)(dt + (isq ? 32 * bj : 2048 * bj)) = w;
                    }
                    asm volatile("" ::: "memory");
                }
        } else {
            bf16_t* V = (bf16_t*)(w2 + WS_VB) + (size_t)((G - 28) >> 1) * MROWS * 128 + (64 * ((G - 28) & 1) + 4 * fq) * 8;
#pragma unroll
            for (int ai = 0; ai < 2; ++ai)
#pragma unroll
                for (int m = 0; m < 4; ++m) {
                    const int rl = ai * HALF + m * 16 + row0; const int t = u.pm * BM + rl; const float rs = rstd[ui * 256 + rl];
                    const int kk = t & 63, ks = kk >> 4, ko = kk & 15, hi = (ko >> 2) & 1, j = ((ko >> 3) << 2) | (ko & 3);
                    bf16_t* vb = V + (size_t)(((t >> 6) * 4 + ks) * 2 + hi) * 1024 + j;
#pragma unroll
                    for (int bj = 0; bj < 2; ++bj)
#pragma unroll
                        for (int n = 0; n < 2; ++n)
#pragma unroll
                            for (int e = 0; e < 4; ++e) vb[(32 * bj + 16 * n + e) * 8] = f2bf1(acc[ai][bj][m][n][e] * rs);
                    asm volatile("" ::: "memory");
                }
        }
    }
};

template <int KD, class Epi, class Sched, bool ALIGN_EPI = false, bool SP2 = false, int LD = KD, bool VARK = false>
__device__ __forceinline__ void gemm_phase(PG8_LAS unsigned char* lds, const Gemm g, const Sched& S, const Epi& E, int wave_id) {
    int tid_ = wave_id * 64 + lane_id_v(); asm volatile("" : "+v"(tid_));
    const int tid = tid_, wid = __builtin_amdgcn_readfirstlane(tid >> 6), lane = tid & 63, wr = wid >> 2, wc = wid & 3, fr = lane & 15, fq = lane >> 4;
    constexpr int K = KD, ntc = K / BK; static_assert(ntc % 2 == 0, "even K-tile count");
    unsigned voffA[2], voffB[2];
#pragma unroll
    for (int i = 0; i < 2; ++i) { int R, C; stage_rc(tid * 16 + i * 8192, R, C); const int Rb = Epi::PERM ? ((R & ~31) + perm32(R & 31)) : R;
        voffA[i] = (unsigned)(R * LD + C) * 2u; voffB[i] = (unsigned)(Rb * LD + C) * 2u; }
    constexpr size_t kstep = (size_t)(BK * 2);
    constexpr size_t hstep = (size_t)HALF * LD * 2;
    constexpr size_t tstep = 2 * hstep;
    const unsigned ldsw = (unsigned)wid * 1024u;
    const int aoff = lds_byte(wr * 64 + fr, fq * 8), boff = lds_byte(wc * 32 + fr, fq * 8);
#define PG8_SA(b, h) (((b) * 2 + (h)) * HTB)
#define PG8_SB(b, h) ((4 + (b) * 2 + (h)) * HTB)
#define PG8_STAGE(bufoff, gbase, voff) do { _Pragma("unroll") for (int _i = 0; _i < 2; ++_i) \
        __builtin_amdgcn_global_load_lds((const unsigned*)((const char*)(gbase) + (voff)[_i]), (PG8_LAS unsigned*)(lds + (bufoff) + ldsw + _i * 8192), 16, 0, 0); } while (0)
#define PG8_LDA(dst, b, h) do { _Pragma("unroll") for (int m = 0; m < 4; ++m) _Pragma("unroll") for (int k = 0; k < 2; ++k) dst[m][k] = *(const PG8_LAS bf16x8*)(lds + PG8_SA(b, h) + aoff + m * 2048 + k * 1024); } while (0)
#define PG8_LDB(dst, b, h) do { _Pragma("unroll") for (int n = 0; n < 2; ++n) _Pragma("unroll") for (int k = 0; k < 2; ++k) dst[n][k] = *(const PG8_LAS bf16x8*)(lds + PG8_SB(b, h) + boff + n * 2048 + k * 1024); } while (0)
#define PG8_MMA(ai, bj, At, Bt) do { __builtin_amdgcn_s_setprio(1); _Pragma("unroll") for (int m = 0; m < 4; ++m) _Pragma("unroll") for (int n = 0; n < 2; ++n) _Pragma("unroll") for (int k = 0; k < 2; ++k) \
        acc[ai][bj][m][n] = __builtin_amdgcn_mfma_f32_16x16x32_bf16(Bt[n][k], At[m][k], acc[ai][bj][m][n], 0, 0, 0); __builtin_amdgcn_s_setprio(0); } while (0)
#define PG8_WAIT_V(n) asm volatile("s_waitcnt vmcnt(" #n ")" ::: "memory")
#define PG8_WAIT_L(n) asm volatile("s_waitcnt lgkmcnt(" #n ")" ::: "memory")
#define PG8_BAR __builtin_amdgcn_s_barrier()
#define PG8_SCHED __builtin_amdgcn_sched_barrier(0)
    Unit cur, nxt; int ui = 0;
    if (!S.next(0, cur)) return;
    f32x4 acc[2][2][4][2];
#pragma unroll
    for (int a = 0; a < 2; ++a)
#pragma unroll
        for (int b = 0; b < 2; ++b)
#pragma unroll
            for (int m = 0; m < 4; ++m)
#pragma unroll
                for (int n = 0; n < 2; ++n) acc[a][b][m][n] = (f32x4){0.f, 0.f, 0.f, 0.f};
    bf16x8 At[4][2], B0[2][2], B1[2][2];
    const char* cA = (const char*)g.A + (size_t)cur.pm * tstep + (VARK ? cur.kofs : 0); const char* cB = (const char*)g.Bt + (size_t)cur.pn * tstep + (VARK ? cur.kofs : 0);
    S.a_ready(cur);
    if constexpr (SP2) {
        PG8_STAGE(PG8_SB(0, 0), cB, voffB); PG8_STAGE(PG8_SB(0, 1), cB + hstep, voffB); PG8_STAGE(PG8_SA(0, 0), cA, voffA); PG8_STAGE(PG8_SA(0, 1), cA + hstep, voffA);
        if (wr == 1) PG8_BAR;
        PG8_WAIT_V(2); PG8_BAR;
        PG8_STAGE(PG8_SB(1, 0), cB + kstep, voffB); PG8_STAGE(PG8_SA(1, 0), cA + kstep, voffA); PG8_STAGE(PG8_SB(1, 1), cB + hstep + kstep, voffB);
        PG8_WAIT_V(6); PG8_BAR;
    } else {
        PG8_STAGE(PG8_SB(0, 0), cB, voffB); PG8_STAGE(PG8_SA(0, 0), cA, voffA); PG8_STAGE(PG8_SB(0, 1), cB + hstep, voffB); PG8_STAGE(PG8_SA(0, 1), cA + hstep, voffA);
        if (wr == 1) PG8_BAR;
        PG8_WAIT_V(4); PG8_BAR;
        PG8_STAGE(PG8_SB(1, 0), cB + kstep, voffB); PG8_STAGE(PG8_SA(1, 0), cA + kstep, voffA); PG8_STAGE(PG8_SB(1, 1), cB + hstep + kstep, voffB);
        PG8_WAIT_V(6); PG8_BAR;
    }
    for (;;) {
        const bool has_next = S.next(ui + 1, nxt);
        const char* nA = has_next ? (const char*)g.A + (size_t)nxt.pm * tstep + (VARK ? nxt.kofs : 0) : cA; const char* nB = has_next ? (const char*)g.Bt + (size_t)nxt.pn * tstep + (VARK ? nxt.kofs : 0) : cB;
        const int nt = VARK ? cur.nt : ntc;
        for (int t = 0; t < nt; t += 2) {
            const bool last = (t == nt - 2);
            const char* a1 = cA + (size_t)(t + 1) * kstep;
            const char* a2 = last ? nA : cA + (size_t)(t + 2) * kstep; const char* b2 = last ? nB : cB + (size_t)(t + 2) * kstep;
            const char* a3 = a2 + kstep; const char* b3 = b2 + kstep;
            if (last && has_next) S.a_ready(nxt);
            if constexpr (SP2) {
            PG8_LDB(B0, 0, 0); PG8_LDB(B1, 0, 1); PG8_SCHED; PG8_LDA(At, 0, 0); PG8_STAGE(PG8_SA(1, 1), a1 + hstep, voffA);
            PG8_WAIT_V(8); PG8_WAIT_L(0); PG8_BAR; PG8_MMA(0, 0, At, B0); PG8_MMA(0, 1, At, B1); PG8_BAR; PG8_SCHED;
            PG8_LDA(At, 0, 1); PG8_STAGE(PG8_SB(0, 0), b2, voffB); PG8_STAGE(PG8_SB(0, 1), b2 + hstep, voffB); PG8_STAGE(PG8_SA(0, 0), a2, voffA);
            PG8_WAIT_V(8); PG8_WAIT_L(0); PG8_BAR; PG8_MMA(1, 0, At, B0); PG8_MMA(1, 1, At, B1); PG8_BAR; PG8_SCHED;
            PG8_LDB(B0, 1, 0); PG8_LDB(B1, 1, 1); PG8_SCHED; PG8_LDA(At, 1, 0); PG8_STAGE(PG8_SA(0, 1), a2 + hstep, voffA);
            PG8_WAIT_V(8); PG8_WAIT_L(0); PG8_BAR; PG8_MMA(0, 0, At, B0); PG8_MMA(0, 1, At, B1); PG8_BAR; PG8_SCHED;
            PG8_LDA(At, 1, 1); PG8_STAGE(PG8_SB(1, 0), b3, voffB); PG8_STAGE(PG8_SB(1, 1), b3 + hstep, voffB); PG8_STAGE(PG8_SA(1, 0), a3, voffA);
            PG8_WAIT_V(8); PG8_WAIT_L(0); PG8_BAR; PG8_MMA(1, 0, At, B0); PG8_MMA(1, 1, At, B1); PG8_BAR; PG8_SCHED;
            } else {
            PG8_LDB(B0, 0, 0); PG8_SCHED; PG8_LDA(At, 0, 0); PG8_STAGE(PG8_SA(1, 1), a1 + hstep, voffA);
            PG8_WAIT_L(8); PG8_BAR; PG8_WAIT_L(0); PG8_MMA(0, 0, At, B0); PG8_BAR; PG8_SCHED;
            PG8_LDB(B1, 0, 1); PG8_STAGE(PG8_SB(0, 0), b2, voffB);
            PG8_BAR; PG8_WAIT_L(0); PG8_MMA(0, 1, At, B1); PG8_BAR;
            PG8_LDA(At, 0, 1); PG8_STAGE(PG8_SA(0, 0), a2, voffA);
            PG8_BAR; PG8_WAIT_L(0); PG8_MMA(1, 0, At, B0); PG8_BAR; PG8_SCHED;
            PG8_STAGE(PG8_SB(0, 1), b2 + hstep, voffB);
            PG8_WAIT_V(6); PG8_BAR; PG8_MMA(1, 1, At, B1); PG8_BAR;
            PG8_LDB(B0, 1, 0); PG8_SCHED; PG8_LDA(At, 1, 0); PG8_STAGE(PG8_SA(0, 1), a2 + hstep, voffA);
            PG8_WAIT_L(8); PG8_BAR; PG8_WAIT_L(0); PG8_MMA(0, 0, At, B0); PG8_BAR; PG8_SCHED;
            PG8_LDB(B1, 1, 1); PG8_STAGE(PG8_SB(1, 0), b3, voffB);
            PG8_BAR; PG8_WAIT_L(0); PG8_MMA(0, 1, At, B1); PG8_BAR;
            PG8_LDA(At, 1, 1); PG8_STAGE(PG8_SA(1, 0), a3, voffA);
            PG8_BAR; PG8_WAIT_L(0); PG8_MMA(1, 0, At, B0); PG8_BAR; PG8_SCHED;
            PG8_STAGE(PG8_SB(1, 1), b3 + hstep, voffB);
            PG8_WAIT_V(6); PG8_BAR; PG8_MMA(1, 1, At, B1); PG8_BAR;
            }
        }
        if constexpr (ALIGN_EPI) { if (wr == 0) PG8_BAR; }
        if constexpr (!Epi::AFTER_DRAIN) { E(acc, cur, ui, wr, wc, fr, fq); S.done(cur); }
        if (!has_next) break;
#pragma unroll
        for (int a = 0; a < 2; ++a)
#pragma unroll
            for (int b = 0; b < 2; ++b)
#pragma unroll
                for (int m = 0; m < 4; ++m)
#pragma unroll
                    for (int n = 0; n < 2; ++n) acc[a][b][m][n] = (f32x4){0.f, 0.f, 0.f, 0.f};
        cur = nxt; cA = nA; cB = nB; ++ui;
        if constexpr (ALIGN_EPI) { if (wr == 1) PG8_BAR; }
    }
    PG8_WAIT_V(0);
    if constexpr (!ALIGN_EPI) { if (wr == 0) PG8_BAR; }
    PG8_BAR;
    if constexpr (Epi::AFTER_DRAIN) { E.fused(acc, cur, wr, wc, fr, fq, lds, wid, lane); S.done(cur); }
#undef PG8_SA
#undef PG8_SB
#undef PG8_STAGE
#undef PG8_LDA
#undef PG8_LDB
#undef PG8_MMA
#undef PG8_WAIT_V
#undef PG8_WAIT_L
#undef PG8_BAR
#undef PG8_SCHED
}
}
namespace att {
typedef unsigned short bf16_t;
typedef short bf16x8 __attribute__((ext_vector_type(8)));
typedef float f32x16 __attribute__((ext_vector_type(16)));
typedef float f32x4 __attribute__((ext_vector_type(4)));
typedef unsigned u32x4 __attribute__((ext_vector_type(4)));
#define ALAS __attribute__((address_space(3)))
constexpr int MROWS = M;
constexpr int WSF_OFF = 114688;
constexpr int LDS_NEED = WSF_OFF + 8 * 256;
__device__ __forceinline__ int crow(int r, int hi) { return (r & 3) + 8 * (r >> 2) + 4 * hi; }
__device__ __forceinline__ void glds16(const void* gsrc, unsigned lds_dst) { unsigned keep;
    asm volatile("s_mov_b32 %0, m0\n\ts_mov_b32 m0, %2\n\ts_nop 0\n\tglobal_load_lds_dwordx4 %1, off\n\ts_mov_b32 m0, %0" : "=&s"(keep) : "v"(gsrc), "s"(lds_dst) : "memory"); }
typedef float f32x2_t __attribute__((ext_vector_type(2))); typedef __bf16 bf16x2_t __attribute__((ext_vector_type(2)));
__device__ __forceinline__ unsigned cvtpk(float lo, float hi) { f32x2_t v = {lo, hi}; bf16x2_t b = __builtin_convertvector(v, bf16x2_t); return __builtin_bit_cast(unsigned, b); }
__device__ __forceinline__ void glds16s(const void* sbase, unsigned voff, unsigned lds_dst) { unsigned keep;
    asm volatile("s_mov_b32 %0, m0\n\ts_mov_b32 m0, %3\n\ts_nop 0\n\tglobal_load_lds_dwordx4 %1, %2\n\ts_mov_b32 m0, %0" : "=&s"(keep) : "v"(voff), "s"(sbase), "s"(lds_dst) : "memory"); }
#define ATT_WAIT_BAR(N) asm volatile("s_waitcnt vmcnt(" #N ") lgkmcnt(0)\n\ts_barrier" ::: "memory")
#define ATT_MFMA(a, b, c) __builtin_amdgcn_mfma_f32_32x32x16_bf16(a, b, c, 0, 0, 0)

struct Tensors { unsigned char* ws; const ALAS float* subln; };
__device__ __forceinline__ Tensors make_tensors(unsigned char* ws, const ALAS float* prm) { return Tensors{ws, prm + PRM_SUBLN}; }
#define T_QA ((const bf16_t*)(tws_ + WS_QA))
#define T_KA ((const bf16_t*)(tws_ + WS_KA))
#define T_VA ((const bf16_t*)(tws_ + WS_VA))
#define T_QB ((const bf16_t*)(tws_ + WS_QB))
#define T_KB ((const bf16_t*)(tws_ + WS_KB))
#define T_VB ((const bf16_t*)(tws_ + WS_VB))
#define T_MIX ((bf16_t*)(tws_ + WS_MIX))

#define SBAR() __builtin_amdgcn_sched_barrier(0)
#define PIN(x) asm volatile("" : "+v"(x))
#define PKW(P, B) cvtpk(P[B], P[(B) + 1])
#define EX(v) __builtin_amdgcn_exp2f(v)
#define WB_SEL(n) do { switch (n) { case 0: ATT_WAIT_BAR(0); break; case 1: ATT_WAIT_BAR(1); break; case 2: ATT_WAIT_BAR(2); break; case 3: ATT_WAIT_BAR(3); break; case 4: ATT_WAIT_BAR(4); break; case 6: ATT_WAIT_BAR(6); break; default: ATT_WAIT_BAR(8); } } while (0)
template <bool ISB>
__device__ __forceinline__ void attn_unit(const Tensors& T, int head, int qb, float negM2, float lam, float c2, int dskip, char* shm, int wave_id) {
    unsigned char* tws_ = T.ws; LAUNDER_G(tws_);
    constexpr int DV = ISB ? 128 : 64, ND0 = DV / 32, NK = ISB ? 2 : 1, NV = ISB ? 2 : 1;
    constexpr int KSLOT = ISB ? 16384 : 8192, VSLOT = ISB ? 16384 : 8192, LDS_K = 0, LDS_V = 3 * KSLOT;
    int tid_ = wave_id * 64 + lane_id_v(); asm volatile("" : "+v"(tid_));
    const int tid = tid_, lane = tid & 63, r32 = lane & 31, hi = lane >> 5; const int wid = __builtin_amdgcn_readfirstlane(tid >> 6);
    const int mapc = ISB ? (wid >> 2) : 0, wq = ISB ? (wid & 3) : wid;
    const int q0 = ISB ? qb * 128 : qb * 256; const int qrow = q0 + wq * 32 + r32;
    int t0 = 0, t1 = 256;
    if (ISB) { const int lo = q0 - dskip, hi_ = q0 + 127 + dskip; t0 = lo > 0 ? (lo >> 6) : 0; t1 = (hi_ >> 6) + 1; if (t1 > 256) t1 = 256;
        if ((t1 - t0) & 1) { if (t0 > 0) --t0; else ++t1; } }
    const int n = t1 - t0;
    const unsigned lds0 = (unsigned)(uintptr_t)shm;
    const ALAS char* shm3 = (const ALAS char*)shm;
    const char* k1b = ISB ? (const char*)(T_KB + (size_t)(2 * head) * MROWS * 64) + (size_t)t0 * 8192 : (const char*)(T_KA + (size_t)(head >> 2) * MROWS * 64);
    const char* k2b = ISB ? (const char*)(T_KB + (size_t)(2 * head + 1) * MROWS * 64) + (size_t)t0 * 8192 : nullptr;
    const char* vb_ = ISB ? (const char*)(T_VB + (size_t)head * MROWS * 128) + (size_t)t0 * 16384 : (const char*)(T_VA + (size_t)(head >> 2) * MROWS * 64);
    const unsigned dvo = (unsigned)(wid * 1024 + lane * 16);
    const unsigned kdst = lds0 + LDS_K + wid * 1024, vdst = lds0 + LDS_V + wid * 1024;
#define DMA_K(i, so) do { glds16s(k1b + (size_t)(i) * 8192, dvo, (unsigned)__builtin_amdgcn_readfirstlane(kdst + (so))); if (ISB) glds16s(k2b + (size_t)(i) * 8192, dvo, (unsigned)__builtin_amdgcn_readfirstlane(kdst + (so) + 8192)); } while (0)
#define DMA_V(i, so) do { if (ISB) { glds16s(vb_ + (size_t)(i) * 16384, dvo, (unsigned)__builtin_amdgcn_readfirstlane(vdst + (so))); glds16s(vb_ + (size_t)(i) * 16384 + 8192, dvo, (unsigned)__builtin_amdgcn_readfirstlane(vdst + (so) + 8192)); } \
      else glds16s(vb_ + (size_t)(i) * 8192, dvo, (unsigned)__builtin_amdgcn_readfirstlane(vdst + (so))); } while (0)
    DMA_K(0, 0); DMA_V(0, 0); DMA_K(1, KSLOT); DMA_V(1, VSLOT);
    const bf16_t* Qw = (ISB ? T_QB + (size_t)(2 * head + mapc) * MROWS * 64 : T_QA + (size_t)head * MROWS * 64) + (size_t)qrow * 64;
    bf16x8 qr[4];
#pragma unroll
    for (int d0 = 0; d0 < 4; ++d0) qr[d0] = *(const bf16x8*)(Qw + d0 * 16 + hi * 8);
    f32x16 o[ND0];
#pragma unroll
    for (int d = 0; d < ND0; ++d) o[d] = f32x16{};
    f32x16 negm;
#pragma unroll
    for (int r = 0; r < 16; ++r) negm[r] = negM2;
    asm volatile("" : "+v"(negm));
    float l_reg = 0.f;
    f32x16 osum = f32x16{}; bf16x8 ones; { const short o1 = (short)0x3f80; ones = (bf16x8){o1, o1, o1, o1, o1, o1, o1, o1}; } asm volatile("" : "+v"(ones));
    const ALAS char* kp0 = shm3 + LDS_K + (ISB ? mapc * 8192 : 0) + hi * 1024 + r32 * 16;
    const ALAS char* vp0 = shm3 + LDS_V + hi * (DV * 16) + r32 * 16;
    const int qw_lo = q0 + wq * 32, qw_hi = qw_lo + 31;
    const float nc2 = -c2; const float dl0 = (float)(64 * t0 - qrow + 4 * hi);
#define BIAS_GEN4(X, B, DC) do { const float e1_ = (DC) + 1.0f, e2_ = (DC) + 2.0f, e3_ = e1_ + 2.0f; \
        X[B] = __builtin_fmaf(__builtin_fabsf(DC), nc2, negM2); X[(B) + 1] = __builtin_fmaf(__builtin_fabsf(e1_), nc2, negM2); X[(B) + 2] = __builtin_fmaf(__builtin_fabsf(e2_), nc2, negM2); X[(B) + 3] = __builtin_fmaf(__builtin_fabsf(e3_), nc2, negM2); DC += 8.0f; } while (0)
#define BIAS_FAST4(X, B, DC) do { X[B] = __builtin_fmaf(sc1_, (DC), negM2); float t1_ = X[B] + sc1_; asm volatile("" : "+v"(t1_)); float t2_ = X[B] + sc2_; asm volatile("" : "+v"(t2_)); X[(B) + 1] = t1_; X[(B) + 2] = t2_; X[(B) + 3] = X[B] + sc3_; DC += 8.0f; } while (0)
#define BIAS_ALL(X0, X1, DL) do { float dc_ = (DL); BIAS_GEN4(X0, 0, dc_); BIAS_GEN4(X0, 4, dc_); BIAS_GEN4(X0, 8, dc_); BIAS_GEN4(X0, 12, dc_); BIAS_GEN4(X1, 0, dc_); BIAS_GEN4(X1, 4, dc_); BIAS_GEN4(X1, 8, dc_); BIAS_GEN4(X1, 12, dc_); } while (0)
#ifdef BIAS_CONST
    float cst[32];
#pragma unroll
    for (int e = 0; e < 32; ++e) { float cv_ = c2 * (float)(8 * (e >> 2) + (e & 3)); asm volatile("" : "+v"(cv_)); cst[e] = __builtin_bit_cast(float, __builtin_amdgcn_readfirstlane(__builtin_bit_cast(int, cv_))); }
#define BIAS_STEP_SETUP() const float base_ = __builtin_fmaf(sc1_, dcn_, negM2); float sgn_ = above_ ? -1.0f : 1.0f; asm volatile("" : "+v"(sgn_))
#else
#define BIAS_STEP_SETUP() do {} while (0)
#endif
    f32x16 pA0, pA1, pB0, pB1;
    bf16x8 kf[8], vf[4]; u32x4 pw0, pw1, pw2, pw3;
    int ks_prev = 0, ks_cur = 0, ks_next = KSLOT, vs_prev = 0, vs_cur = VSLOT, vs_next = 2 * VSLOT, vs_n2 = 3 * VSLOT;
#define ROTK() do { ks_prev = ks_cur; ks_cur = ks_next; ks_next = (ks_next == 2 * KSLOT) ? 0 : ks_next + KSLOT; } while (0)
#define ROT() do { ROTK(); const int tv_ = vs_prev; vs_prev = vs_cur; vs_cur = vs_next; vs_next = vs_n2; vs_n2 = tv_; } while (0)
    DMA_K(2, 2 * KSLOT);
    WB_SEL(2 * NV + 2 * NK);
    if (ISB) { BIAS_ALL(pA0, pA1, dl0); } else { pA0 = negm; pA1 = negm; }
    {
        const ALAS char* kp = kp0;
#pragma unroll
        for (int d0 = 0; d0 < 4; ++d0) { const bf16x8 b0 = *(const ALAS bf16x8*)(kp + d0 * 2048), b1 = *(const ALAS bf16x8*)(kp + d0 * 2048 + 512);
            pA0 = ATT_MFMA(b0, qr[d0], pA0); pA1 = ATT_MFMA(b1, qr[d0], pA1); }
#pragma unroll
        for (int r = 0; r < 16; ++r) { pA0[r] = EX(pA0[r]); pA1[r] = EX(pA1[r]); }
    }
    WB_SEL(0);
    DMA_K(3, 0); DMA_V(2, 2 * VSLOT);
    ROTK();
#define KLOAD2(base, j) do { kf[2 * (j)] = *(const ALAS bf16x8*)((base) + (j) * 2048); kf[2 * (j) + 1] = *(const ALAS bf16x8*)((base) + (j) * 2048 + 512); } while (0)
    { const ALAS char* kb_ = kp0 + ks_cur; KLOAD2(kb_, 0); KLOAD2(kb_, 1); KLOAD2(kb_, 2); KLOAD2(kb_, 3); }
    if (ISB) { BIAS_ALL(pB0, pB1, dl0 + 64.f); }
    WB_SEL(NK + NV);
#define PAF(k) __builtin_bit_cast(bf16x8, pw##k)
#define GAPA(MF, A0, A1, A2, A3, W0, W1, PW) do { MF; if (ISB) { sacc += A0; sacc += A1; sacc += A2; sacc += A3; PIN(sacc); } W0; W1; PIN(PW); SBAR(); } while (0)
#define GAPB(MF, X, B) do { MF; X[B] = EX(X[B]); X[(B) + 1] = EX(X[(B) + 1]); X[(B) + 2] = EX(X[(B) + 2]); X[(B) + 3] = EX(X[(B) + 3]); PIN(X); SBAR(); } while (0)
#define GAPX(MF, EXS, X) do { MF; EXS; PIN(X); SBAR(); } while (0)
#define EXE(C0, C1, k) do { if ((k) < 16) C0[(k) & 15] = EX(C0[(k) & 15]); else C1[(k) & 15] = EX(C1[(k) & 15]); } while (0)
#define EXN(C0, C1, k, N) do { EXE(C0, C1, k); if ((N) > 1) EXE(C0, C1, (k) + 1); if ((N) > 2) EXE(C0, C1, (k) + 2); } while (0)
#define GAPEN(MF, C0, C1, k, N) do { MF; EXN(C0, C1, k, N); PIN(C0); PIN(C1); SBAR(); } while (0)
#define GAPE3(MF, C0, C1, k) do { MF; EXE(C0, C1, k); EXE(C0, C1, (k) + 1); EXE(C0, C1, (k) + 2); PIN(C0); PIN(C1); SBAR(); } while (0)
#ifdef BIAS_CONST
#define GAPC(MF, G, X, B, E0) do { MF; if (G) { { float a0_ = __builtin_fmaf(sgn_, cst[(E0) + (B)], base_), a1_ = __builtin_fmaf(sgn_, cst[(E0) + (B) + 1], base_), a2_ = __builtin_fmaf(sgn_, cst[(E0) + (B) + 2], base_), a3_ = __builtin_fmaf(sgn_, cst[(E0) + (B) + 3], base_); asm volatile("" : "+v"(a0_), "+v"(a1_), "+v"(a2_), "+v"(a3_)); X[B] = a0_; X[(B) + 1] = a1_; X[(B) + 2] = a2_; X[(B) + 3] = a3_; } \
        if (__builtin_expect(!fastb_, 0)) { float dg_ = dcn_ + (float)(8 * (((E0) + (B)) >> 2)); BIAS_GEN4(X, B, dg_); } PIN(X); } SBAR(); } while (0)
#else
#define GAPC(MF, G, X, B, E0) do { MF; if (G) { BIAS_FAST4(X, B, dcn_); if (__builtin_expect(!fastb_, 0)) { float dg_ = dcn_ - 8.0f; BIAS_GEN4(X, B, dg_); } PIN(X); } SBAR(); } while (0)
#endif
#define VRD(i) do { vf[i] = *(const ALAS bf16x8*)(vp_ + ((i) & 3) * (DV * 32) + ((i) >> 2) * 512); } while (0)
#define VRDN(i, d) do { vf[i] = *(const ALAS bf16x8*)(vp_ + (i) * (DV * 32) + (d) * 512); } while (0)
#define VRDA(i) do { vf[i] = *(const ALAS bf16x8*)(vp_ + (i) * (DV * 32) + 512); } while (0)
#define VRD2(i) do { vf[i] = *(const ALAS bf16x8*)(vp_ + ((i) & 3) * (DV * 32) + (((i) >> 2) + 2) * 512); } while (0)
#define KRD(G, j) do { if (G) { KLOAD2(kn_, j); SBAR(); } } while (0)
#define KRD1(G, j) do { if (G) { kf[j] = *(const ALAS bf16x8*)(kn_ + ((j) >> 1) * 2048 + ((j) & 1) * 512); SBAR(); } } while (0)
#define CIN(C) (ISB ? C : negm)
#define STEP(C0, C1, P0, P1, i, GK, GV, GL) do { SBAR(); \
    const ALAS char* vp_ = vp0 + vs_prev; const ALAS char* kn_ = kp0 + ks_next; float dcn_ = dl0 + 64.f * (float)((i) + 1); const int kt_ = 64 * (t0 + (i) + 1); const bool above_ = kt_ > qw_hi, fastb_ = above_ || (kt_ + 63 < qw_lo); \
    const float sc1_ = above_ ? nc2 : c2, sc2_ = sc1_ + sc1_, sc3_ = sc2_ + sc1_; BIAS_STEP_SETUP(); \
    VRD(0); SBAR(); float sacc = P0[0] + P0[1]; \
    GAPA(C0 = ATT_MFMA(kf[0], qr[0], CIN(C0)), P0[2], P0[3], P0[4], P0[5],     pw0[0] = PKW(P0, 0), pw0[1] = PKW(P0, 2), pw0); \
    SBAR(); GAPA(C1 = ATT_MFMA(kf[1], qr[0], CIN(C1)), P0[6], P0[7], P0[8], P0[9],     pw0[2] = PKW(P0, 4), pw0[3] = PKW(P0, 6), pw0); \
    VRD(1); SBAR(); GAPA(C0 = ATT_MFMA(kf[2], qr[1], C0),   P0[10], P0[11], P0[12], P0[13], pw1[0] = PKW(P0, 8), pw1[1] = PKW(P0, 10), pw1); \
    SBAR(); GAPA(C1 = ATT_MFMA(kf[3], qr[1], C1),   P0[14], P0[15], P1[0], P1[1],   pw1[2] = PKW(P0, 12), pw1[3] = PKW(P0, 14), pw1); \
    VRD(2); SBAR(); GAPA(C0 = ATT_MFMA(kf[4], qr[2], C0),   P1[2], P1[3], P1[4], P1[5],     pw2[0] = PKW(P1, 0), pw2[1] = PKW(P1, 2), pw2); \
    SBAR(); GAPA(C1 = ATT_MFMA(kf[5], qr[2], C1),   P1[6], P1[7], P1[8], P1[9],     pw2[2] = PKW(P1, 4), pw2[3] = PKW(P1, 6), pw2); \
    VRD(3); SBAR(); GAPA(C0 = ATT_MFMA(kf[6], qr[3], C0),   P1[10], P1[11], P1[12], P1[13], pw3[0] = PKW(P1, 8), pw3[1] = PKW(P1, 10), pw3); \
    SBAR(); GAPA(C1 = ATT_MFMA(kf[7], qr[3], C1),   P1[14], P1[15], 0.f, 0.f,       pw3[2] = PKW(P1, 12), pw3[3] = PKW(P1, 14), pw3); \
    l_reg += sacc; \
    if (BDMA_MODE < 4) { if (GK) { DMA_K((i) + 3, ks_cur); } } if (BDMA_MODE == 0 || BDMA_MODE == 4) { if (GV) { DMA_V((i) + 2, vs_n2); } } \
    SBAR(); \
    if (!ISB) { \
        GAPX(o[0] = ATT_MFMA(PAF(0), vf[0], o[0]), C0[0] = EX(C0[0]); C0[1] = EX(C0[1]); C0[2] = EX(C0[2]), C0); \
        VRDA(0); SBAR(); GAPX(o[0] = ATT_MFMA(PAF(1), vf[1], o[0]), C0[3] = EX(C0[3]); C0[4] = EX(C0[4]); C0[5] = EX(C0[5]), C0); \
        VRDA(1); SBAR(); GAPX(osum = ATT_MFMA(PAF(0), ones, osum),  C0[6] = EX(C0[6]); C0[7] = EX(C0[7]); C0[8] = EX(C0[8]), C0); \
        GAPX(o[0] = ATT_MFMA(PAF(2), vf[2], o[0]), C0[9] = EX(C0[9]); C0[10] = EX(C0[10]); C0[11] = EX(C0[11]), C0); \
        VRDA(2); SBAR(); GAPX(o[0] = ATT_MFMA(PAF(3), vf[3], o[0]), C0[12] = EX(C0[12]); C0[13] = EX(C0[13]); C0[14] = EX(C0[14]), C0); \
        VRDA(3); SBAR(); GAPX(osum = ATT_MFMA(PAF(1), ones, osum),  C0[15] = EX(C0[15]); C1[0] = EX(C1[0]); C1[1] = EX(C1[1]), C1); PIN(C0); \
        KRD(GL, 0); GAPX(o[1] = ATT_MFMA(PAF(0), vf[0], o[1]), C1[2] = EX(C1[2]); C1[3] = EX(C1[3]); C1[4] = EX(C1[4]), C1); \
        KRD(GL, 1); GAPX(o[1] = ATT_MFMA(PAF(1), vf[1], o[1]), C1[5] = EX(C1[5]); C1[6] = EX(C1[6]); C1[7] = EX(C1[7]), C1); \
        KRD(GL, 2); GAPX(osum = ATT_MFMA(PAF(2), ones, osum),  C1[8] = EX(C1[8]); C1[9] = EX(C1[9]); C1[10] = EX(C1[10]), C1); \
        KRD(GL, 3); GAPX(o[1] = ATT_MFMA(PAF(2), vf[2], o[1]), C1[11] = EX(C1[11]); C1[12] = EX(C1[12]), C1); \
        GAPX(o[1] = ATT_MFMA(PAF(3), vf[3], o[1]), C1[13] = EX(C1[13]); C1[14] = EX(C1[14]), C1); \
        GAPX(osum = ATT_MFMA(PAF(3), ones, osum),  C1[15] = EX(C1[15]), C1); \
    } else { \
        GAPEN(o[0] = ATT_MFMA(PAF(0), vf[0], o[0]), C0, C1, 0, 3);  VRDN(0, 1); KRD1(GL, 0); SBAR(); \
        GAPEN(o[0] = ATT_MFMA(PAF(1), vf[1], o[0]), C0, C1, 3, 2);  VRDN(1, 1); KRD1(GL, 1); SBAR(); \
        GAPEN(o[0] = ATT_MFMA(PAF(2), vf[2], o[0]), C0, C1, 5, 3);  VRDN(2, 1); KRD1(GL, 2); SBAR(); \
        GAPEN(o[0] = ATT_MFMA(PAF(3), vf[3], o[0]), C0, C1, 8, 2);  VRDN(3, 1); KRD1(GL, 3); SBAR(); \
        if (BDMA_MODE == 2) { if (GV) { DMA_V((i) + 2, vs_n2); } SBAR(); } \
        GAPEN(o[1] = ATT_MFMA(PAF(0), vf[0], o[1]), C0, C1, 10, 3); VRDN(0, 2); KRD1(GL, 4); SBAR(); \
        GAPEN(o[1] = ATT_MFMA(PAF(1), vf[1], o[1]), C0, C1, 13, 2); VRDN(1, 2); KRD1(GL, 5); SBAR(); \
        GAPEN(o[1] = ATT_MFMA(PAF(2), vf[2], o[1]), C0, C1, 15, 3); VRDN(2, 2); KRD1(GL, 6); SBAR(); \
        GAPEN(o[1] = ATT_MFMA(PAF(3), vf[3], o[1]), C0, C1, 18, 2); VRDN(3, 2); KRD1(GL, 7); SBAR(); \
        if (BDMA_MODE == 1 || BDMA_MODE == 5) { if (GV) { DMA_V((i) + 2, vs_n2); } SBAR(); } if (BDMA_MODE == 4 || BDMA_MODE == 5) { if (GK) { DMA_K((i) + 3, ks_cur); } SBAR(); } \
        GAPC(o[ND0 - 2] = ATT_MFMA(PAF(0), vf[0], o[ND0 - 2]); EXN(C0, C1, 20, 2), GL, P0, 0, 0);  VRDN(0, 3); SBAR(); \
        GAPC(o[ND0 - 2] = ATT_MFMA(PAF(1), vf[1], o[ND0 - 2]); EXN(C0, C1, 22, 1), GL, P0, 4, 0);  VRDN(1, 3); SBAR(); \
        GAPC(o[ND0 - 2] = ATT_MFMA(PAF(2), vf[2], o[ND0 - 2]); EXN(C0, C1, 23, 2), GL, P0, 8, 0);  VRDN(2, 3); SBAR(); \
        GAPC(o[ND0 - 2] = ATT_MFMA(PAF(3), vf[3], o[ND0 - 2]); EXN(C0, C1, 25, 1), GL, P0, 12, 0); VRDN(3, 3); SBAR(); \
        GAPC(o[ND0 - 1] = ATT_MFMA(PAF(0), vf[0], o[ND0 - 1]); EXN(C0, C1, 26, 2), GL, P1, 0, 16); \
        GAPC(o[ND0 - 1] = ATT_MFMA(PAF(1), vf[1], o[ND0 - 1]); EXN(C0, C1, 28, 1), GL, P1, 4, 16); \
        GAPC(o[ND0 - 1] = ATT_MFMA(PAF(2), vf[2], o[ND0 - 1]); EXN(C0, C1, 29, 2), GL, P1, 8, 16); \
        GAPC(o[ND0 - 1] = ATT_MFMA(PAF(3), vf[3], o[ND0 - 1]); EXN(C0, C1, 31, 1); PIN(C1), GL, P1, 12, 16); \
        if (BDMA_MODE == 3) { if (GV) { DMA_V((i) + 2, vs_n2); } SBAR(); } \
    } } while (0)
    int i = 1;
    for (; i + 5 < n; i += 2) {
        STEP(pB0, pB1, pA0, pA1, i, true, true, true);     WB_SEL(NK + 2 * NV); ROT();
        STEP(pA0, pA1, pB0, pB1, i + 1, true, true, true); WB_SEL(NK + 2 * NV); ROT();
    }
#define ENDW(ii) do { if ((ii) + 3 < n) { WB_SEL(NK + 2 * NV); } else if ((ii) + 2 < n) { WB_SEL(2 * NV); } else { WB_SEL(0); } } while (0)
    for (; i + 1 < n; i += 2) {
        STEP(pB0, pB1, pA0, pA1, i, (i + 3 < n), (i + 2 < n), (i + 1 < n));         ENDW(i);     ROT();
        STEP(pA0, pA1, pB0, pB1, i + 1, (i + 4 < n), (i + 3 < n), (i + 2 < n));     ENDW(i + 1); ROT();
    }
    STEP(pB0, pB1, pA0, pA1, n - 1, false, false, false);
    { if (ISB) { float sacc = pB0[0] + pB0[1];
#pragma unroll
      for (int r = 2; r < 16; ++r) sacc += pB0[r];
#pragma unroll
      for (int r = 0; r < 16; ++r) sacc += pB1[r];
      l_reg += sacc; }
      pw0 = (u32x4){PKW(pB0, 0), PKW(pB0, 2), PKW(pB0, 4), PKW(pB0, 6)}; pw1 = (u32x4){PKW(pB0, 8), PKW(pB0, 10), PKW(pB0, 12), PKW(pB0, 14)};
      pw2 = (u32x4){PKW(pB1, 0), PKW(pB1, 2), PKW(pB1, 4), PKW(pB1, 6)}; pw3 = (u32x4){PKW(pB1, 8), PKW(pB1, 10), PKW(pB1, 12), PKW(pB1, 14)};
      SBAR();
      const ALAS char* vp_ = vp0 + vs_cur;
#pragma unroll
      for (int d = 0; d < ND0; ++d) {
          const bf16x8 v0 = *(const ALAS bf16x8*)(vp_ + 0 * (DV * 32) + d * 512), v1 = *(const ALAS bf16x8*)(vp_ + 1 * (DV * 32) + d * 512), v2 = *(const ALAS bf16x8*)(vp_ + 2 * (DV * 32) + d * 512), v3 = *(const ALAS bf16x8*)(vp_ + 3 * (DV * 32) + d * 512);
          o[d] = ATT_MFMA(PAF(0), v0, o[d]); o[d] = ATT_MFMA(PAF(1), v1, o[d]); o[d] = ATT_MFMA(PAF(2), v2, o[d]); o[d] = ATT_MFMA(PAF(3), v3, o[d]); }
      if (!ISB) { osum = ATT_MFMA(PAF(0), ones, osum); osum = ATT_MFMA(PAF(1), ones, osum); osum = ATT_MFMA(PAF(2), ones, osum); osum = ATT_MFMA(PAF(3), ones, osum); } }
    const float sacc = l_reg;
    const int lane_e = lane_id_v();
    ATT_WAIT_BAR(0);
    {
    const int lane = lane_e, r32 = lane & 31, hi = lane >> 5; const int q0 = ISB ? qb * 128 : qb * 256;
    float rli[16];
    ALAS float* wsf = (ALAS float*)(shm3 + WSF_OFF) + wid * 64;
    if (ISB) {
        const float l = sum_x32(sacc);
        if (hi == 0) wsf[r32] = l;
        asm volatile("s_waitcnt lgkmcnt(0)" ::: "memory");
#pragma unroll
        for (int r = 0; r < 16; ++r) rli[r] = __builtin_amdgcn_rcpf(wsf[crow(r, hi)]);
    } else {
#pragma unroll
        for (int r = 0; r < 16; ++r) rli[r] = __builtin_amdgcn_rcpf(osum[r]);
    }
    if (!ISB) {
        ALAS bf16_t* stg = (ALAS bf16_t*)shm3 + wid * 2048;
#pragma unroll
        for (int r = 0; r < 16; ++r) { const int orow = crow(r, hi);
#pragma unroll
            for (int d = 0; d < ND0; ++d) stg[orow * 64 + d * 32 + r32] = pg8::f2bf1(o[d][r] * rli[r]); }
        asm volatile("s_waitcnt lgkmcnt(0)" ::: "memory");
#pragma unroll
        for (int i = 0; i < 4; ++i) { const int row = i * 8 + (lane >> 3), ch = lane & 7; const u32x4 v = *(const ALAS u32x4*)(stg + row * 64 + ch * 8);
            *(u32x4*)(T_MIX + (size_t)(q0 + wid * 32 + row) * 1024 + head * 64 + ch * 8) = v; }
    } else {
        ALAS float* X = (ALAS float*)shm3 + wq * 4096;
        const float sc = (mapc == 1) ? lam : 1.0f;
        if (mapc == 1) {
#pragma unroll
            for (int r = 0; r < 16; ++r) { const int orow = crow(r, hi); const float f = rli[r] * sc;
#pragma unroll
                for (int d = 0; d < ND0; ++d) X[orow * 128 + d * 32 + r32] = o[d][r] * f; }
        }
        asm volatile("s_waitcnt lgkmcnt(0)\n\ts_barrier" ::: "memory");
        if (mapc == 0) {
#pragma unroll
            for (int r = 0; r < 16; ++r) { const int orow = crow(r, hi);
#pragma unroll
                for (int d = 0; d < ND0; ++d) { const int idx = orow * 128 + d * 32 + r32; X[idx] = o[d][r] * rli[r] - X[idx]; } }
            asm volatile("s_waitcnt lgkmcnt(0)" ::: "memory");
            const int qq = lane >> 1, hf = lane & 1;
            const ALAS float* rowp = X + qq * 128 + hf * 64;
            f32x4 vv[16]; float ss = 0.f;
#pragma unroll
            for (int i = 0; i < 16; ++i) { vv[i] = *(const ALAS f32x4*)(rowp + 4 * i); ss += (vv[i][0] * vv[i][0] + vv[i][1] * vv[i][1]) + (vv[i][2] * vv[i][2] + vv[i][3] * vv[i][3]); }
            ss += xor_lane<1>(ss);
            const float rs = 0.8f / sqrtf(ss * (1.0f / 128.0f) + 1e-6f);
            bf16_t* dst = T_MIX + (size_t)(q0 + wq * 32 + qq) * 1024 + 512 + head * 128 + hf * 64;
            const ALAS float* sl = T.subln + hf * 64;
#pragma unroll
            for (int i = 0; i < 8; ++i) { const f32x4 g0 = *(const ALAS f32x4*)(sl + 8 * i), g1 = *(const ALAS f32x4*)(sl + 8 * i + 4); const f32x4 a = vv[2 * i] * rs * g0, b = vv[2 * i + 1] * rs * g1;
                u32x4 w; w.x = cvtpk(a[0], a[1]); w.y = cvtpk(a[2], a[3]); w.z = cvtpk(b[0], b[1]); w.w = cvtpk(b[2], b[3]); *(u32x4*)(dst + 8 * i) = w; }
        }
    }
    }
    asm volatile("s_waitcnt lgkmcnt(0)\n\ts_barrier" ::: "memory");
#undef DMA_K
#undef DMA_V
#undef ROT
#undef STEP
#undef ENDW
#undef GAPA
#undef GAPB
#undef GAPC
#undef GAPE3
#undef GAPEN
#undef EXN
#undef EXE
#undef GAPX
#undef VRD
#undef VRD2
#undef VRDA
#undef VRDN
#undef KRD
#undef KRD1
#undef CIN
#undef PAF
#undef KLOAD2
#undef BIAS_GEN4
#undef BIAS_FAST4
#undef BIAS_ALL
#undef BIAS_STEP_SETUP
}

typedef int i32x8 __attribute__((ext_vector_type(8)));
typedef unsigned u32x8 __attribute__((ext_vector_type(8)));
#define MFMA8(a, b, c) __builtin_amdgcn_mfma_scale_f32_32x32x64_f8f6f4(a, b, c, 0, 0, 0, 0, 0, 0)
__device__ __forceinline__ void attn_unit_a8(const Tensors& T, int head, int qb, float negM2s, char* shm, int wave_id) {
    unsigned char* tws_ = T.ws; LAUNDER_G(tws_);
    constexpr int KSLOT = 4096, VSLOT = 4096, LDS_K = 0, LDS_V = 3 * KSLOT, n = 256;
    int tid_ = wave_id * 64 + lane_id_v(); asm volatile("" : "+v"(tid_));
    const int tid = tid_, lane = tid & 63, r32 = lane & 31, hi = lane >> 5; const int wid = __builtin_amdgcn_readfirstlane(tid >> 6);
    const int q0 = qb * 256; const int qrow = q0 + wid * 32 + r32;
    const unsigned lds0 = (unsigned)(uintptr_t)shm;
    const ALAS char* shm3 = (const ALAS char*)shm;
    const bool kw = wid < 4;
    const char* sb = (const char*)(tws_ + (kw ? WS_KA : WS_VA)) + (size_t)(head >> 2) * MROWS * 64 + (wid & 3) * 1024;
    const unsigned dvo = (unsigned)(lane * 16);
    const unsigned ddst = lds0 + (kw ? LDS_K : LDS_V) + (wid & 3) * 1024;
#define DMA8(i, so) glds16s(sb + (size_t)(i) * 4096, dvo, (unsigned)__builtin_amdgcn_readfirstlane(ddst + (so)))
#define WB8(NKW, NVW) do { if (kw) { WB_SEL(NKW); } else { WB_SEL(NVW); } } while (0)
    if (kw) { DMA8(0, 0); DMA8(1, KSLOT); DMA8(2, 2 * KSLOT); } else { DMA8(0, 0); DMA8(1, VSLOT); }
    const unsigned char* Qw = (tws_ + WS_QA) + ((size_t)head * MROWS + qrow) * 64 + hi * 32;
    i32x8 qf; { const u32x4 a_ = *(const u32x4*)Qw, b_ = *(const u32x4*)(Qw + 16); qf = (i32x8){(int)a_[0], (int)a_[1], (int)a_[2], (int)a_[3], (int)b_[0], (int)b_[1], (int)b_[2], (int)b_[3]}; }
    f32x16 o0 = f32x16{}, o1 = f32x16{}, osum = f32x16{};
    f32x16 negm;
#pragma unroll
    for (int r = 0; r < 16; ++r) negm[r] = negM2s;
    asm volatile("" : "+v"(negm));
    i32x8 ones; { const int o4 = 0x38383838; ones = (i32x8){o4, o4, o4, o4, o4, o4, o4, o4}; } asm volatile("" : "+v"(ones));
    const ALAS char* kp0 = shm3 + LDS_K + hi * 1024 + r32 * 16;
    const ALAS char* vp0 = shm3 + LDS_V + hi * 1024 + r32 * 16;
    f32x16 pA0, pA1, pB0, pB1;
    i32x8 kf0, kf1, vf0, vf1, pf = (i32x8){0, 0, 0, 0, 0, 0, 0, 0};
    int ks_prev = 0, ks_cur = 0, ks_next = KSLOT, vs_prev = 0, vs_cur = VSLOT, vs_next = 2 * VSLOT, vs_n2 = 3 * VSLOT;
#define ROTK8() do { ks_prev = ks_cur; ks_cur = ks_next; ks_next = (ks_next == 2 * KSLOT) ? 0 : ks_next + KSLOT; } while (0)
#define ROT8() do { ROTK8(); const int tv_ = vs_prev; vs_prev = vs_cur; vs_cur = vs_next; vs_next = vs_n2; vs_n2 = tv_; } while (0)
#define LD32(dst, p) do { const u32x4 a_ = *(const ALAS u32x4*)(p), b_ = *(const ALAS u32x4*)((p) + 512); dst = (i32x8){(int)a_[0], (int)a_[1], (int)a_[2], (int)a_[3], (int)b_[0], (int)b_[1], (int)b_[2], (int)b_[3]}; } while (0)
#define PK8(P, B, OLD) __builtin_amdgcn_cvt_pk_fp8_f32(P[(B) + 2], P[(B) + 3], __builtin_amdgcn_cvt_pk_fp8_f32(P[B], P[(B) + 1], OLD, false), true)
    WB8(2, 2);
    { LD32(kf0, kp0); LD32(kf1, kp0 + 2048);
      pA0 = MFMA8(kf0, qf, negm); pA1 = MFMA8(kf1, qf, negm);
#pragma unroll
      for (int r = 0; r < 16; ++r) { pA0[r] = EX(pA0[r]); pA1[r] = EX(pA1[r]); } }
    WB_SEL(0);
    if (kw) { DMA8(3, 0); } else { DMA8(2, 2 * VSLOT); }
    ROTK8();
    { const ALAS char* kb_ = kp0 + ks_cur; LD32(kf0, kb_); LD32(kf1, kb_ + 2048); }
    WB_SEL(1);
#define STEP8(C0, C1, P0, P1, i, GK, GV, GL) do { SBAR(); \
    const ALAS char* vp_ = vp0 + vs_prev; const ALAS char* kn_ = kp0 + ks_next; \
    LD32(vf0, vp_); LD32(vf1, vp_ + 2048); SBAR(); \
    C0 = MFMA8(kf0, qf, negm); \
    pf[0] = PK8(P0, 0, pf[0]); pf[1] = PK8(P0, 4, pf[1]); pf[2] = PK8(P0, 8, pf[2]); pf[3] = PK8(P0, 12, pf[3]); PIN(pf); SBAR(); \
    C1 = MFMA8(kf1, qf, negm); \
    pf[4] = PK8(P1, 0, pf[4]); pf[5] = PK8(P1, 4, pf[5]); pf[6] = PK8(P1, 8, pf[6]); pf[7] = PK8(P1, 12, pf[7]); PIN(pf); SBAR(); \
    if (kw) { if (GK) { DMA8((i) + 3, ks_cur); } } else { if (GV) { DMA8((i) + 2, vs_n2); } } \
    SBAR(); \
    o0 = MFMA8(pf, vf0, o0); \
    _Pragma("unroll") for (int r_ = 0; r_ < 16; ++r_) C0[r_] = EX(C0[r_]); PIN(C0); SBAR(); \
    if (GL) { LD32(kf0, kn_); LD32(kf1, kn_ + 2048); SBAR(); } \
    o1 = MFMA8(pf, vf1, o1); \
    _Pragma("unroll") for (int r_ = 0; r_ < 8; ++r_) C1[r_] = EX(C1[r_]); PIN(C1); SBAR(); \
    osum = MFMA8(pf, ones, osum); \
    _Pragma("unroll") for (int r_ = 8; r_ < 16; ++r_) C1[r_] = EX(C1[r_]); PIN(C1); SBAR(); \
    } while (0)
    int i = 1;
    for (; i + 5 < n; i += 2) {
        STEP8(pB0, pB1, pA0, pA1, i, true, true, true);     WB8(1, 2); ROT8();
        STEP8(pA0, pA1, pB0, pB1, i + 1, true, true, true); WB8(1, 2); ROT8();
    }
#define ENDW8(ii) do { if ((ii) + 3 < n) { WB8(1, 2); } else if ((ii) + 2 < n) { WB8(0, 2); } else { WB_SEL(0); } } while (0)
    for (; i + 1 < n; i += 2) {
        STEP8(pB0, pB1, pA0, pA1, i, (i + 3 < n), (i + 2 < n), (i + 1 < n));         ENDW8(i);     ROT8();
        STEP8(pA0, pA1, pB0, pB1, i + 1, (i + 4 < n), (i + 3 < n), (i + 2 < n));     ENDW8(i + 1); ROT8();
    }
    STEP8(pB0, pB1, pA0, pA1, n - 1, false, false, false);
    { pf[0] = PK8(pB0, 0, pf[0]); pf[1] = PK8(pB0, 4, pf[1]); pf[2] = PK8(pB0, 8, pf[2]); pf[3] = PK8(pB0, 12, pf[3]); pf[4] = PK8(pB1, 0, pf[4]); pf[5] = PK8(pB1, 4, pf[5]); pf[6] = PK8(pB1, 8, pf[6]); pf[7] = PK8(pB1, 12, pf[7]);
      const ALAS char* vp_ = vp0 + vs_cur; LD32(vf0, vp_); LD32(vf1, vp_ + 2048);
      o0 = MFMA8(pf, vf0, o0); o1 = MFMA8(pf, vf1, o1); osum = MFMA8(pf, ones, osum); }
    ATT_WAIT_BAR(0);
    {
        const int lane_e = lane_id_v(), l32 = lane_e & 31, hh = lane_e >> 5;
        ALAS bf16_t* stg = (ALAS bf16_t*)shm3 + wid * 2048;
#pragma unroll
        for (int r = 0; r < 16; ++r) { const int orow = crow(r, hh); const float rl = __builtin_amdgcn_rcpf(osum[r]);
            stg[orow * 64 + l32] = pg8::f2bf1(o0[r] * rl); stg[orow * 64 + 32 + l32] = pg8::f2bf1(o1[r] * rl); }
        asm volatile("s_waitcnt lgkmcnt(0)" ::: "memory");
#pragma unroll
        for (int i2 = 0; i2 < 4; ++i2) { const int row = i2 * 8 + (lane_e >> 3), ch = lane_e & 7; const u32x4 v = *(const ALAS u32x4*)(stg + row * 64 + ch * 8);
            *(u32x4*)(T_MIX + (size_t)(qb * 256 + wid * 32 + row) * 1024 + head * 64 + ch * 8) = v; }
    }
    asm volatile("s_waitcnt lgkmcnt(0)\n\ts_barrier" ::: "memory");
#undef DMA8
#undef EXPBLK
#undef PACK8
#undef WB8
#undef ROTK8
#undef ROT8
#undef LD32
#undef PK8
#undef STEP8
#undef ENDW8
}

typedef short v2i16_t __attribute__((ext_vector_type(2)));
template<int U>
__device__ __forceinline__ void attn_unit_a8x2(const Tensors& T, int head, int qb, float negM2s, char* shm, int wave_id) {
    unsigned char* tws_ = T.ws; LAUNDER_G(tws_);
    constexpr int KSLOT = 4096, VSLOT = 4096, RS = 3 * U * 4096, LDS_K = 0, LDS_V = RS, n = 256;
    int tid_ = wave_id * 64 + lane_id_v(); asm volatile("" : "+v"(tid_));
    const int tid = tid_, lane = tid & 63, r32 = lane & 31, hi = lane >> 5; const int wid = __builtin_amdgcn_readfirstlane(tid >> 6);
    const int q0 = qb * 512; const int qrow = q0 + wid * 64 + r32;
    const unsigned lds0 = (unsigned)(uintptr_t)shm;
    const ALAS char* shm3 = (const ALAS char*)shm;
    const bool kw = wid < 4;
    const char* sb = (const char*)(tws_ + (kw ? WS_KA : WS_VA)) + (size_t)(head >> 2) * MROWS * 64 + (wid & 3) * 1024;
    const unsigned dvo = (unsigned)(lane * 16);
    const unsigned ddst = lds0 + (kw ? LDS_K : LDS_V) + (wid & 3) * 1024;
#define DMA8(i, so) glds16s(sb + (size_t)(i) * 4096, dvo, (unsigned)__builtin_amdgcn_readfirstlane(ddst + (so)))
#pragma unroll
    for (int i0 = 0; i0 < 2 * U; ++i0) DMA8(i0, i0 * 4096);
    if (kw) DMA8(2 * U, 2 * U * 4096);
    const unsigned char* Qw = (tws_ + WS_QA) + ((size_t)head * MROWS + qrow) * 64 + hi * 32;
    i32x8 qfa, qfb;
    { const u32x4 a_ = *(const u32x4*)Qw, b_ = *(const u32x4*)(Qw + 16); qfa = (i32x8){(int)a_[0], (int)a_[1], (int)a_[2], (int)a_[3], (int)b_[0], (int)b_[1], (int)b_[2], (int)b_[3]}; }
    { const u32x4 a_ = *(const u32x4*)(Qw + 32 * 64), b_ = *(const u32x4*)(Qw + 32 * 64 + 16); qfb = (i32x8){(int)a_[0], (int)a_[1], (int)a_[2], (int)a_[3], (int)b_[0], (int)b_[1], (int)b_[2], (int)b_[3]}; }
    f32x16 oa0 = f32x16{}, oa1 = f32x16{}, osa = f32x16{}, ob0 = f32x16{}, ob1 = f32x16{}, osb = f32x16{};
    f32x16 negm;
#pragma unroll
    for (int r = 0; r < 16; ++r) negm[r] = negM2s;
    asm volatile("" : "+v"(negm));
    i32x8 ones; { const int o4 = 0x38383838; ones = (i32x8){o4, o4, o4, o4, o4, o4, o4, o4}; } asm volatile("" : "+v"(ones));
    const ALAS char* kp0 = shm3 + LDS_K + hi * 1024 + r32 * 16;
    const ALAS char* vp0 = shm3 + LDS_V + hi * 1024 + r32 * 16;
    f32x16 Ca0, Ca1, Cb0, Cb1;
#ifdef A8_EXPH
#define EXPBLK(H, C, b) do { const unsigned h0_ = __builtin_bit_cast(unsigned, __builtin_amdgcn_cvt_pkrtz(C[b], C[(b) + 1])), h1_ = __builtin_bit_cast(unsigned, __builtin_amdgcn_cvt_pkrtz(C[(b) + 2], C[(b) + 3])), \
        h2_ = __builtin_bit_cast(unsigned, __builtin_amdgcn_cvt_pkrtz(C[(b) + 4], C[(b) + 5])), h3_ = __builtin_bit_cast(unsigned, __builtin_amdgcn_cvt_pkrtz(C[(b) + 6], C[(b) + 7])); unsigned d0_, d1_, d2_, d3_; \
        asm volatile("v_exp_f16_e32 %0, %4\n\tv_exp_f16_e32 %1, %5\n\tv_exp_f16_e32 %2, %6\n\tv_exp_f16_e32 %3, %7\n\t" \
                     "v_exp_f16_sdwa %0, %4 dst_sel:WORD_1 dst_unused:UNUSED_PRESERVE src0_sel:WORD_1\n\tv_exp_f16_sdwa %1, %5 dst_sel:WORD_1 dst_unused:UNUSED_PRESERVE src0_sel:WORD_1\n\t" \
                     "v_exp_f16_sdwa %2, %6 dst_sel:WORD_1 dst_unused:UNUSED_PRESERVE src0_sel:WORD_1\n\tv_exp_f16_sdwa %3, %7 dst_sel:WORD_1 dst_unused:UNUSED_PRESERVE src0_sel:WORD_1" \
                     : "=&v"(d0_), "=&v"(d1_), "=&v"(d2_), "=&v"(d3_) : "v"(h0_), "v"(h1_), "v"(h2_), "v"(h3_)); \
        C[(b) / 2] = __builtin_bit_cast(float, d0_); C[(b) / 2 + 1] = __builtin_bit_cast(float, d1_); C[(b) / 2 + 2] = __builtin_bit_cast(float, d2_); C[(b) / 2 + 3] = __builtin_bit_cast(float, d3_); PIN(C); } while (0)
#define PKH(C, j) (int)__builtin_amdgcn_perm(__builtin_bit_cast(unsigned, C[2 * (j) + 1]), __builtin_bit_cast(unsigned, C[2 * (j)]), 0x07050301u)
#define PACK8(H0, H1, C0, C1) do { pf[0] = PKH(C0, 0); pf[1] = PKH(C0, 1); pf[2] = PKH(C0, 2); pf[3] = PKH(C0, 3); pf[4] = PKH(C1, 0); pf[5] = PKH(C1, 1); pf[6] = PKH(C1, 2); pf[7] = PKH(C1, 3); PIN(pf); } while (0)
#else
#define EXPBLK(H, C, b) do { _Pragma("unroll") for (int r_ = (b); r_ < (b) + 8; ++r_) C[r_] = EX(C[r_]); PIN(C); } while (0)
#define PACK8(H0, H1, C0, C1) do { pf[0] = PK8(C0, 0, pf[0]); pf[1] = PK8(C0, 4, pf[1]); pf[2] = PK8(C0, 8, pf[2]); pf[3] = PK8(C0, 12, pf[3]); pf[4] = PK8(C1, 0, pf[4]); pf[5] = PK8(C1, 4, pf[5]); pf[6] = PK8(C1, 8, pf[6]); pf[7] = PK8(C1, 12, pf[7]); PIN(pf); } while (0)
#endif
    i32x8 kf0, kf1, vf0, vf1, pf = (i32x8){0, 0, 0, 0, 0, 0, 0, 0};
#define LD32(dst, p) do { const u32x4 a_ = *(const ALAS u32x4*)(p), b_ = *(const ALAS u32x4*)((p) + 512); dst = (i32x8){(int)a_[0], (int)a_[1], (int)a_[2], (int)a_[3], (int)b_[0], (int)b_[1], (int)b_[2], (int)b_[3]}; } while (0)
#ifdef A8_BF8
#define PK8(P, B, OLD) (int)__builtin_amdgcn_perm(__builtin_bit_cast(unsigned, __builtin_amdgcn_cvt_pkrtz(P[(B) + 2], P[(B) + 3])), __builtin_bit_cast(unsigned, __builtin_amdgcn_cvt_pkrtz(P[B], P[(B) + 1])), 0x07050301u)
#define MFMA8P(a, b, c) __builtin_amdgcn_mfma_scale_f32_32x32x64_f8f6f4(a, b, c, 1, 0, 0, 0, 0, 0)
#elif defined(A8_SCALECVT)
#define MFMA8P(a, b, c) MFMA8(a, b, c)
#define PK8(P, B, OLD) __builtin_bit_cast(int, __builtin_amdgcn_cvt_scalef32_pk_fp8_f32(__builtin_amdgcn_cvt_scalef32_pk_fp8_f32(__builtin_bit_cast(v2i16_t, (int)(OLD)), P[B], P[(B) + 1], 1.0f, false), P[(B) + 2], P[(B) + 3], 1.0f, true))
#else
#define MFMA8P(a, b, c) MFMA8(a, b, c)
#define PK8(P, B, OLD) __builtin_amdgcn_cvt_pk_fp8_f32(P[(B) + 2], P[(B) + 3], __builtin_amdgcn_cvt_pk_fp8_f32(P[B], P[(B) + 1], OLD, false), true)
#endif
    if (kw) { WB_SEL(U); } else { WB_SEL(U); }
    { LD32(kf0, kp0); LD32(kf1, kp0 + 2048);
      Ca0 = MFMA8(kf0, qfa, negm); Ca1 = MFMA8(kf1, qfa, negm); Cb0 = MFMA8(kf0, qfb, negm); Cb1 = MFMA8(kf1, qfb, negm);
      EXPBLK(Ha0, Ca0, 0); EXPBLK(Ha0, Ca0, 8); EXPBLK(Ha1, Ca1, 0); EXPBLK(Ha1, Ca1, 8); }
    asm volatile("s_waitcnt lgkmcnt(0)\n\ts_barrier" ::: "memory");
    int ks = 0, vs = 0;
#define ADV(x, k) (((x) + (k) * 4096 >= RS) ? (x) + (k) * 4096 - RS : (x) + (k) * 4096)
    for (int t0 = 0; t0 < n; t0 += U) {
#pragma unroll
      for (int j = 0; j < U; ++j) {
        const int t = t0 + j;
        const bool GK = t + 1 + 2 * U < n, GV = t + 2 * U < n, GL = t + 1 < n;
        const int ksn = ADV(ks, 1);
        SBAR();
        { const ALAS char* vp_ = vp0 + vs; LD32(vf0, vp_); LD32(vf1, vp_ + 2048); }
        if (GL) { const ALAS char* kn_ = kp0 + ksn; LD32(kf0, kn_); LD32(kf1, kn_ + 2048); } SBAR();
        PACK8(Ha0, Ha1, Ca0, Ca1); SBAR();
#ifdef A8_EXPH_DUP
        {
#pragma unroll
          for (int r = 0; r < 16; ++r) { float x_ = Ca0[r], y_ = Ca1[r]; asm volatile("v_exp_f16_e32 %0, %0\n\tv_exp_f16_e32 %1, %1" : "+v"(x_), "+v"(y_)); Ca0[r] = x_; Ca1[r] = y_; }
          SBAR(); }
#endif
#ifdef A8_CVT_DUP
        { int d0_ = 0, d1_ = 0, d2_ = 0, d3_ = 0;
#pragma unroll
          for (int r = 0; r < 16; r += 4) { d0_ = PK8(Ca0, r, d0_); d1_ = PK8(Ca1, r, d1_); d2_ = PK8(Ca0, r, d2_); d3_ = PK8(Ca1, r, d3_); asm volatile("" : "+v"(d0_), "+v"(d1_), "+v"(d2_), "+v"(d3_)); }
          SBAR(); }
#endif
        oa0 = MFMA8P(pf, vf0, oa0);
        EXPBLK(Hb0, Cb0, 0); SBAR();
        oa1 = MFMA8P(pf, vf1, oa1);
        EXPBLK(Hb0, Cb0, 8); SBAR();
        osa = MFMA8P(pf, ones, osa);
        EXPBLK(Hb1, Cb1, 0); SBAR();
        if (GL) { Ca0 = MFMA8(kf0, qfa, negm); }
        EXPBLK(Hb1, Cb1, 8); SBAR();
        if (GL) { Ca1 = MFMA8(kf1, qfa, negm); }
        if (kw) { if (GK) { DMA8(t + 1 + 2 * U, ADV(ks, 2 * U + 1)); } } else { if (GV) { DMA8(t + 2 * U, ADV(vs, 2 * U)); } }
        SBAR();
        PACK8(Hb0, Hb1, Cb0, Cb1); SBAR();
        ob0 = MFMA8P(pf, vf0, ob0);
        if (GL) {
            EXPBLK(Ha0, Ca0, 0); }
        SBAR();
        ob1 = MFMA8P(pf, vf1, ob1);
        if (GL) {
            EXPBLK(Ha0, Ca0, 8); }
        SBAR();
        osb = MFMA8P(pf, ones, osb);
        if (GL) {
            EXPBLK(Ha1, Ca1, 0); }
        SBAR();
        if (GL) { Cb0 = MFMA8(kf0, qfb, negm);
            EXPBLK(Ha1, Ca1, 8); }
        SBAR();
        if (GL) { Cb1 = MFMA8(kf1, qfb, negm); }
        if (j == U - 1) { if (kw ? GK : GV) { WB_SEL(U); } else { WB_SEL(0); }
#ifdef A8_LAG
            if (!kw) __builtin_amdgcn_s_sleep(A8_LAG);
#endif
        }
        ks = ksn; vs = ADV(vs, 1);
      }
    }
#undef ADV
    {
        const int lane_e = lane_id_v(), l32 = lane_e & 31, hh = lane_e >> 5;
        ALAS bf16_t* stg = (ALAS bf16_t*)shm3 + wid * 4096;
#pragma unroll
        for (int r = 0; r < 16; ++r) { const int orow = crow(r, hh); const float ra = __builtin_amdgcn_rcpf(osa[r]), rb = __builtin_amdgcn_rcpf(osb[r]);
            stg[orow * 64 + l32] = pg8::f2bf1(oa0[r] * ra); stg[orow * 64 + 32 + l32] = pg8::f2bf1(oa1[r] * ra);
            stg[2048 + orow * 64 + l32] = pg8::f2bf1(ob0[r] * rb); stg[2048 + orow * 64 + 32 + l32] = pg8::f2bf1(ob1[r] * rb); }
        asm volatile("s_waitcnt lgkmcnt(0)" ::: "memory");
#pragma unroll
        for (int i2 = 0; i2 < 8; ++i2) { const int row = i2 * 8 + (lane_e >> 3), ch = lane_e & 7; const u32x4 v = *(const ALAS u32x4*)(stg + row * 64 + ch * 8);
            *(u32x4*)(T_MIX + (size_t)(qb * 512 + wid * 64 + row) * 1024 + head * 64 + ch * 8) = v; }
    }
    asm volatile("s_waitcnt lgkmcnt(0)\n\ts_barrier" ::: "memory");
#undef DMA8
#undef LD32
#undef PK8
}
}
static_assert(att::LDS_NEED <= RING_BYTES, "LDS map");

#define GAS __attribute__((address_space(1)))
#define LAS __attribute__((address_space(3)))
typedef unsigned short bf16;
typedef unsigned v4u __attribute__((ext_vector_type(4)));
typedef float f32x4 __attribute__((ext_vector_type(4)));
typedef GAS unsigned gu32;
#define RLX_AGENT __ATOMIC_RELAXED, __HIP_MEMORY_SCOPE_AGENT
#define LDS_WAIT() asm volatile("s_waitcnt lgkmcnt(0)" ::: "memory")
#define VM_WAIT() asm volatile("s_waitcnt vmcnt(0)" ::: "memory")
__device__ __forceinline__ unsigned f2bf(float f) { unsigned u = __builtin_bit_cast(unsigned, f); return (u + 0x7fffu + ((u >> 16) & 1u)) >> 16; }
__device__ __forceinline__ unsigned pk2(float lo, float hi) { return f2bf(lo) | (f2bf(hi) << 16); }
#define XB_TMO      128
#define XB_XCNT(j)  (256  + 64 * (j))
#define XB_XSUB(j)  (1280 + 64 * (j))
#define XB_XGEN(j)  (2304 + 64 * (j))
#define XB_TOP      3328
#define XB_TOPGEN   3392
#define XCD_BAR_WORDS 3456
#define XB_SPIN_CAP (1u << 18)

__device__ __forceinline__ unsigned xb_ld(unsigned* p)              { return __hip_atomic_load(p, __ATOMIC_RELAXED, __HIP_MEMORY_SCOPE_AGENT); }
__device__ __forceinline__ unsigned xb_add(unsigned* p, unsigned v) { return __hip_atomic_fetch_add(p, v, __ATOMIC_RELAXED, __HIP_MEMORY_SCOPE_AGENT); }
__device__ __forceinline__ unsigned xb_xcc_id() { return (unsigned)__builtin_amdgcn_s_getreg((3 << 11) | 20) & 0xFu; }
#define XB_SPIN(cond, bar) do { unsigned _sp = 0; while (cond) { __builtin_amdgcn_s_sleep(1); \
    if ((++_sp & 255u) == 0u) { if (xb_ld(&(bar)[XB_TMO])) break; if (_sp > XB_SPIN_CAP) { atomicAdd(&(bar)[XB_TMO], 1u); break; } } } } while (0)

struct XcdBarrier {
    unsigned* bar; unsigned x;
    volatile LAS unsigned* st;
};

__device__ __forceinline__ XcdBarrier xcd_barrier_post(unsigned* bar, volatile LAS unsigned* st, bool t0) {
    XcdBarrier b; b.bar = bar; b.x = (unsigned)__builtin_amdgcn_readfirstlane((int)xb_xcc_id()); b.st = st;
    if (t0) (void)xb_add(&bar[XB_XCNT(b.x)], 1u);
    return b;
}
__device__ __forceinline__ void xcd_barrier_complete(unsigned* bar, unsigned x, unsigned& nloc, unsigned& nx) {
    const unsigned G = gridDim.x * gridDim.y * gridDim.z;
    unsigned sum, cnt, mine, sp = 0u;
    for (;;) {
        sum = 0u; cnt = 0u; mine = 0u;
#pragma unroll
        for (unsigned j = 0; j < 16; ++j) { const unsigned c = xb_ld(&bar[XB_XCNT(j)]); sum += c; cnt += (c > 0u) ? 1u : 0u; mine = (j == x) ? c : mine; }
        if (sum == G) break;
        __builtin_amdgcn_s_sleep(1);
        if ((++sp & 255u) == 0u) { if (xb_ld(&bar[XB_TMO])) break; if (sp > XB_SPIN_CAP) { atomicAdd(&bar[XB_TMO], 1u); break; } }
    }
    nloc = mine > 0u ? mine : 1u; nx = cnt > 0u ? cnt : 1u;
}

__device__ __forceinline__ void xcd_barrier(const XcdBarrier& b_, int wave_id) {
    XcdBarrier b = b_; asm volatile("" : "+s"(b.bar), "+s"(b.x));
    const bool t0 = (wave_id == 0) && (lane_id_v() == 0);
    asm volatile("s_waitcnt vmcnt(0)" ::: "memory");
    __syncthreads();
    if (t0) {
        unsigned* bar = b.bar;
        __builtin_amdgcn_s_waitcnt(0);
        unsigned nloc = b.st[0], nx = b.st[1];
        if (nloc == 0u) { xcd_barrier_complete(bar, b.x, nloc, nx); b.st[0] = nloc; b.st[1] = nx; }
        const unsigned old = xb_add(&bar[XB_XSUB(b.x)], 1u);
        const unsigned gen = old / nloc;
        if (old + 1u == (gen + 1u) * nloc) {
            __builtin_amdgcn_fence(__ATOMIC_RELEASE, "agent");
            asm volatile("s_waitcnt vmcnt(0)" ::: "memory");
            const unsigned og = xb_add(&bar[XB_TOP], 1u);
            const unsigned tg = og / nx;
            if (og + 1u == (tg + 1u) * nx) xb_add(&bar[XB_TOPGEN], 1u);
            else XB_SPIN(xb_ld(&bar[XB_TOPGEN]) == tg, bar);
            __builtin_amdgcn_fence(__ATOMIC_ACQUIRE, "agent");
            xb_add(&bar[XB_XGEN(b.x)], 1u);
            asm volatile("s_waitcnt vmcnt(0)" ::: "memory");
        } else {
            XB_SPIN(xb_ld(&bar[XB_XGEN(b.x)]) == gen, bar);
            __builtin_amdgcn_fence(__ATOMIC_ACQUIRE, "agent");
            asm volatile("s_waitcnt vmcnt(0)" ::: "memory");
        }
    }
    __syncthreads();
}
#ifndef PHMASK
#define PHMASK 63
#endif
#ifndef ATT_DUP
#define ATT_DUP 1
#endif
#ifndef GU_DUP
#define GU_DUP 1
#endif
#ifndef IN_DUP
#define IN_DUP 1
#endif
#ifndef D1_DUP
#define D1_DUP 1
#endif
#ifndef P0_DUP
#define P0_DUP 1
#endif
#ifndef NODEFER
#define DEFER_OK (G == 256)
#else
#define DEFER_OK false
#endif

__device__ __forceinline__ float wave_sum(float v) { v += xor_lane<1>(v); v += xor_lane<2>(v); v += xor_lane<4>(v); v += xor_lane<8>(v); v += xor_lane<16>(v); return sum_x32(v); }
__device__ __forceinline__ float wave_max(float v) { v = fmaxf(v, xor_lane<1>(v)); v = fmaxf(v, xor_lane<2>(v)); v = fmaxf(v, xor_lane<4>(v)); v = fmaxf(v, xor_lane<8>(v)); v = fmaxf(v, xor_lane<16>(v)); return max_x32(v); }
__device__ __forceinline__ void tr_item(const float* W, int ldw, int srccol0, const float* gain, bf16* WT, int K, int dstrow0, int k0, LAS float* scr, int lane) {
    const int kq = lane >> 3, nq = lane & 7;
    f32x4 w[8]; float g[8];
#pragma unroll
    for (int i = 0; i < 8; ++i) { const int kk = 8 * i + kq; w[i] = *(const GAS f32x4*)(W + (size_t)(k0 + kk) * ldw + srccol0 + 4 * nq); g[i] = gain ? gain[k0 + kk] : 1.0f; }
#pragma unroll
    for (int i = 0; i < 8; ++i) { const int kk = 8 * i + kq; LAS float* s = scr + kk * 33 + 4 * nq; s[0] = w[i][0] * g[i]; s[1] = w[i][1] * g[i]; s[2] = w[i][2] * g[i]; s[3] = w[i][3] * g[i]; }
    LDS_WAIT(); asm volatile("" ::: "memory");
    const int c = lane & 7;
#pragma unroll
    for (int j = 0; j < 4; ++j) { const int n = (lane >> 3) + 8 * j; const LAS float* s = scr + (8 * c) * 33 + n;
        v4u o; o.x = pk2(s[0 * 33], s[1 * 33]); o.y = pk2(s[2 * 33], s[3 * 33]); o.z = pk2(s[4 * 33], s[5 * 33]); o.w = pk2(s[6 * 33], s[7 * 33]);
        *(GAS v4u*)(WT + (size_t)(dstrow0 + n) * K + k0 + 8 * c) = o; }
    LDS_WAIT(); asm volatile("" ::: "memory");
}

#define TR_ONE(it_) do { int r = (it_); \
        if (r < 2 * I_GU) { const int l2 = r >= I_GU; if (l2) r -= I_GU; const int kb = r / (NGU / 32), nb = r % (NGU / 32), n0 = nb * 32, pn = n0 >> 8, j0 = n0 & 255; \
            const float* src = (j0 < 128) ? (l2 ? args.in[18] : args.in[2]) : (l2 ? args.in[19] : args.in[3]); \
            tr_item(src, FF, pn * 128 + (j0 & 127), l2 ? args.in[17] : args.in[1], (bf16*)(ws + (l2 ? WS_WGU2 : WS_WGU1)), D, n0, kb * 64, scr, lane); break; } \
        r -= 2 * I_GU; \
        if (r < 2 * I_D) { const int l2 = r >= I_D; if (l2) r -= I_D; const int kb = r / (D / 32), nb = r % (D / 32); \
            tr_item(l2 ? args.in[20] : args.in[4], D, nb * 32, nullptr, (bf16*)(ws + (l2 ? WS_WD2 : WS_WD1)), FF, nb * 32, kb * 64, scr, lane); break; } \
        r -= 2 * I_D; \
        if (r < I_IN) { const int kb = r / (NIN / 32), nb = r % (NIN / 32), n0 = nb * 32, pn = n0 >> 8, j0 = n0 & 255, bj = j0 >> 7, wc = (j0 >> 5) & 3; \
            tr_item(args.in[6], NIN, pn * 256 + wc * 64 + bj * 32, args.in[5], (bf16*)(ws + WS_WIN), D, n0, kb * 64, scr, lane); break; } \
        r -= I_IN; \
        { const int kb = r / (D / 32), nb = r % (D / 32); tr_item(args.in[16], D, nb * 32, nullptr, (bf16*)(ws + WS_WOUT), D, nb * 32, kb * 64, scr, lane); } } while (0)
constexpr int I_GU = (D / 64) * (NGU / 32), I_D = (FF / 64) * (D / 32), I_IN = (D / 64) * (NIN / 32), I_OUT = (D / 64) * (D / 32);
#define TR_DEFERRED(first_idle, IT0, IT1) do { if (bx >= (first_idle)) { const int lane = lane_id_v(); LAS float* scr = (LAS float*)(L + RING_OFF + wave * 16384); \
        const int nw_ = (G - (first_idle)) * NWAVES; for (int it = (IT0) + (bx - (first_idle)) * NWAVES + wave; it < (IT1); it += nw_) { TR_ONE(it); } } } while (0)
struct Args { const float* in[21]; float* out; unsigned char* ws; };
#define LAUNDER(p) asm volatile("" : "+s"(p))

__global__ void __launch_bounds__(NWAVES * 64, 2) mk_fwd(Args args) {
    extern __shared__ __attribute__((aligned(16))) unsigned char lds[];
    LAS unsigned char* L = (LAS unsigned char*)lds;
    volatile LAS unsigned* MISC = (volatile LAS unsigned*)(L + MISC_OFF);
    const int wave = __builtin_amdgcn_readfirstlane((int)threadIdx.x >> 6);
    const int G = gridDim.x; const int bx = blockIdx.x;
    unsigned char* ws = args.ws; float* out = args.out; LAUNDER_G(ws); LAUNDER_G(out);
    { const int tid = wave * 64 + lane_id_v(); for (int u = tid; u < (LDS_BYTES - LDSCTL_OFF) / 4; u += NWAVES * 64) ((LAS unsigned*)(L + LDSCTL_OFF))[u] = 0u; }
    __syncthreads();
    XcdBarrier bar = xcd_barrier_post((unsigned*)((gu32*)(ws + WS_CTL) + CW_BAR), MISC + 8, (wave == 0) && (lane_id_v() == 0));
    LAS float* rstd_tab = (LAS float*)(L + RSTD_OFF);
    LAS float* PRM = (LAS float*)(L + PRM_OFF);
    if (wave == 0) {
        const int lane = lane_id_v();
        const float gaq = args.in[7][lane], gak = args.in[8][lane], gbq = args.in[9][lane], gbk = args.in[10][lane];
        PRM[PRM_GAQ + lane] = gaq; PRM[PRM_GAK + lane] = gak; PRM[PRM_GBQ + lane] = gbq; PRM[PRM_GBK + lane] = gbk;
        PRM[PRM_SUBLN + lane] = args.in[15][lane]; PRM[PRM_SUBLN + 64 + lane] = args.in[15][64 + lane];
        const float maq = wave_max(fabsf(gaq)), mak = wave_max(fabsf(gak)), mbq = wave_max(fabsf(gbq)), mbk = wave_max(fabsf(gbk));
        float lm[4];
#pragma unroll
        for (int h = 0; h < 4; ++h) { const float d1 = wave_sum(args.in[11][h * 64 + lane] * args.in[12][h * 64 + lane]), d2 = wave_sum(args.in[13][h * 64 + lane] * args.in[14][h * 64 + lane]); lm[h] = expf(d1) - expf(d2) + 0.2f; }
        if (lane == 0) { PRM[PRM_NEGM2A] = -(8.0f * 1.4426950408889634f * 1.02f) * maq * mak; PRM[PRM_NEGM2B] = -(8.0f * 1.4426950408889634f * 1.02f) * mbq * mbk;
            PRM[PRM_LAM + 0] = lm[0]; PRM[PRM_LAM + 1] = lm[1]; PRM[PRM_LAM + 2] = lm[2]; PRM[PRM_LAM + 3] = lm[3]; }
    }
    LDS_WAIT(); __syncthreads();

#define BUILD_RSTD(S) do { pg8::Unit u_; const int tid = wave * 64 + lane_id_v(); const float* SSQ_ = (const float*)(ws + WS_SSQ); for (int i_ = 0; i_ < 6 && (S).next(i_, u_); ++i_) if (tid < 256) { const f32x4* p_ = (const f32x4*)(SSQ_ + (size_t)(u_.pm * 256 + tid) * 16); \
        const f32x4 a_ = p_[0], b_ = p_[1], c_ = p_[2], d_ = p_[3]; const float s_ = ((a_[0] + a_[1]) + (a_[2] + a_[3])) + ((b_[0] + b_[1]) + (b_[2] + b_[3])) + ((c_[0] + c_[1]) + (c_[2] + c_[3])) + ((d_[0] + d_[1]) + (d_[2] + d_[3])); \
        rstd_tab[i_ * 256 + tid] = 1.0f / sqrtf(s_ * (1.0f / 1024.0f) + 1e-6f); } LDS_WAIT(); __syncthreads(); } while (0)

#if (PHMASK & 1)
    for (int dup0 = 0; dup0 < P0_DUP; ++dup0) {
        if (dup0) xcd_barrier(bar, wave);
        const int lane = lane_id_v(), tid = wave * 64 + lane;
        const int vcu = (G % 8 == 0) ? (bx % 8) * (G / 8) + bx / 8 : bx;
        float* ROPE = (float*)(ws + WS_ROPE); float* SSQ = (float*)(ws + WS_SSQ); bf16* XB = (bf16*)(ws + WS_XB); const float* x = args.in[0];
        LAS float* scr = (LAS float*)(L + RING_OFF + wave * 16384);
        const int gw = vcu * NWAVES + wave, NGW = G * NWAVES;
        for (int it = gw; it < ((DEFER_OK) ? I_GU : 2 * I_GU + 2 * I_D + I_IN + I_OUT); it += NGW) { TR_ONE(it); }
        for (int m = gw; m < M; m += NGW) {
            const GAS f32x4* xr = (const GAS f32x4*)(x + (size_t)m * D) + lane; f32x4 v[4]; float s = 0.f;
#pragma unroll
            for (int j = 0; j < 4; ++j) { v[j] = xr[64 * j]; s += (v[j][0] * v[j][0] + v[j][1] * v[j][1]) + (v[j][2] * v[j][2] + v[j][3] * v[j][3]); }
            s = wave_sum(s);
            GAS unsigned long long* o8 = (GAS unsigned long long*)(XB + (size_t)m * D) + lane;
#pragma unroll
            for (int j = 0; j < 4; ++j) o8[64 * j] = (unsigned long long)pk2(v[j][0], v[j][1]) | ((unsigned long long)pk2(v[j][2], v[j][3]) << 32);
            if (lane < 16) SSQ[(size_t)m * 16 + lane] = (lane == 0) ? s : 0.f;
        }
        for (int e = bx * (NWAVES * 64) + tid; e < 5120; e += G * NWAVES * 64) {
            const int isc = e >= 4096, ee = isc ? e - 4096 : e, pos = ee >> 4, i = ee & 15;
            const float invf = powf(10000.0f, -(float)i * (1.0f / 16.0f)); const float ang = (float)pos * invf; float sn, cs; sincosf(ang, &sn, &cs);
            if (isc) { ROPE[8192 + ee] = cs; ROPE[9216 + ee] = sn; } else { ROPE[ee] = cs; ROPE[4096 + ee] = sn; }
        }
    }
#endif
    xcd_barrier(bar, wave);

    for (int rep = 0; rep < 2; ++rep) {
#if (PHMASK & 2)
        {
            LAUNDER_G(ws);
            pg8::Gemm g{(const bf16*)(ws + WS_XB), (const bf16*)(ws + (rep ? WS_WGU2 : WS_WGU1)), M, NGU, D}; pg8::StaticOrderT<M, NGU> S; int bxs_ = bx, Gs_ = G; LAUNDER(bxs_); LAUNDER(Gs_); S.init(Gs_, bxs_);
#if defined(SPLITK_GU2)
            { pg8::SplitTailOrderT<pg8::StaticOrderT<M, NGU>, 5, D / 64> SKr{S, (rep == 1) && (G == 256)}; BUILD_RSTD(SKr); }
#else
            BUILD_RSTD(S);
#endif
            pg8::EpiSwiGLU E{ws, rstd_tab};
            for (int dup = 0; dup < GU_DUP; ++dup) { if (dup) xcd_barrier(bar, wave);
#if defined(CLK_PROBE_GU)
            unsigned long long c0_ = __builtin_amdgcn_s_memtime(), r0_ = __builtin_amdgcn_s_memrealtime();
#endif
#if defined(SPLITK_GU2)
            {
                typedef pg8::SplitTailOrderT<pg8::StaticOrderT<M, NGU>, 5, D / 64> SKO; SKO SK{S, (rep == 1) && (G == 256)};
                pg8::EpiSwiGLUSplit E2{ws, rstd_tab};
                pg8::gemm_phase<D, pg8::EpiSwiGLUSplit, SKO, true, true, D, true>(L + RING_OFF, g, SK, E2, wave);
            }
#else
            pg8::gemm_phase<D, pg8::EpiSwiGLU, pg8::StaticOrderT<M, NGU>, true, true>(L + RING_OFF, g, S, E, wave);
#endif
            if (rep == 0 && dup == 0 && DEFER_OK) { TR_DEFERRED(128, 2 * I_GU, 2 * I_GU + I_D); TR_DEFERRED(128, 2 * I_GU + 2 * I_D, 2 * I_GU + 2 * I_D + I_IN); }
#if defined(CLK_PROBE_GU)
            if (rep == 0 && bx == 0) { const unsigned long long c1_ = __builtin_amdgcn_s_memtime(), r1_ = __builtin_amdgcn_s_memrealtime(); const unsigned long long spin_ = 1000ull * (c1_ - c0_) / (r1_ - r0_); while (__builtin_amdgcn_s_memrealtime() - r1_ < spin_) __builtin_amdgcn_s_sleep(8); }
#endif
            }
        }
#endif
        xcd_barrier(bar, wave);
#if (PHMASK & 4)
        {
            LAUNDER_G(ws); LAUNDER_G(out);
            pg8::Gemm g{(const bf16*)(ws + WS_H), (const bf16*)(ws + (rep ? WS_WD2 : WS_WD1)), M, D, FF}; pg8::StaticOrderT<M, D> S; int bxs_ = bx, Gs_ = G; LAUNDER(bxs_); LAUNDER(Gs_); S.init(Gs_, bxs_);
            if (rep == 0) { pg8::EpiResid<true, true, false> E{nullptr, nullptr, ws, 0.5f}; for (int dup = 0; dup < D1_DUP; ++dup) { if (dup) xcd_barrier(bar, wave);
#if defined(D1_NULLEPI)
                if (dup) { pg8::EpiNull EN; pg8::gemm_phase<FF, pg8::EpiNull, pg8::StaticOrderT<M, D>, true, true>(L + RING_OFF, g, S, EN, wave); continue; }
#endif
#if defined(D1_SCRATCH)
                if (dup) { pg8::EpiResidStaged<true, false> ES{nullptr, ws, 0.5f, ws + (140u << 20)}; pg8::gemm_phase<FF, pg8::EpiResidStaged<true, false>, pg8::StaticOrderT<M, D>, false, true>(L + RING_OFF, g, S, ES, wave); continue; }
#endif
                pg8::gemm_phase<FF, pg8::EpiResid<true, true, false>, pg8::StaticOrderT<M, D>, true, true>(L + RING_OFF, g, S, E, wave); } }
            else {
#if defined(D7_DUP) && defined(D7_PROBE1)
                for (int dup = 0; dup < D7_DUP; ++dup) { if (dup) xcd_barrier(bar, wave);
                    if (dup < D7_DUP - 1) { pg8::EpiResid<true, false, true, 1> EP{nullptr, out, ws, 0.5f}; pg8::gemm_phase<FF, pg8::EpiResid<true, false, true, 1>, pg8::StaticOrderT<M, D>, true, true>(L + RING_OFF, g, S, EP, wave); }
                    else { pg8::EpiResid<true, false, true> E{nullptr, out, ws, 0.5f}; pg8::gemm_phase<FF, pg8::EpiResid<true, false, true>, pg8::StaticOrderT<M, D>, true, true>(L + RING_OFF, g, S, E, wave); } }
#elif defined(D7_DUP)
                pg8::EpiResid<true, false, true> E{nullptr, out, ws, 0.5f};
#pragma unroll 1
                for (int dup = 0; dup < D7_DUP; ++dup) { if (dup) xcd_barrier(bar, wave); pg8::gemm_phase<FF, pg8::EpiResid<true, false, true>, pg8::StaticOrderT<M, D>, true, true>(L + RING_OFF, g, S, E, wave); }
#else
                pg8::EpiResid<true, false, true> E{nullptr, out, ws, 0.5f}; pg8::gemm_phase<FF, pg8::EpiResid<true, false, true>, pg8::StaticOrderT<M, D>, true, true>(L + RING_OFF, g, S, E, wave);
#endif
            }
        }
#endif
        if (rep == 1) break;
        xcd_barrier(bar, wave);
#if (PHMASK & 8)
        {
            LAUNDER_G(ws);
            pg8::Gemm g{(const bf16*)(ws + WS_XB), (const bf16*)(ws + WS_WIN), M, NIN, D}; pg8::StaticOrderT<M, NIN> S; int bxs_ = bx, Gs_ = G; LAUNDER(bxs_); LAUNDER(Gs_); S.init(Gs_, bxs_);
            BUILD_RSTD(S);
            pg8::EpiInProj E{rstd_tab, PRM, ws};
            for (int dup = 0; dup < IN_DUP; ++dup) { if (dup) xcd_barrier(bar, wave);
            pg8::gemm_phase<D, pg8::EpiInProj, pg8::StaticOrderT<M, NIN>, true, true>(L + RING_OFF, g, S, E, wave);
            if (dup == 0 && DEFER_OK) { TR_DEFERRED(64, I_GU, 2 * I_GU); TR_DEFERRED(64, 2 * I_GU + I_D, 2 * I_GU + 2 * I_D); TR_DEFERRED(64, 2 * I_GU + 2 * I_D + I_IN, 2 * I_GU + 2 * I_D + I_IN + I_OUT); } }
        }
#endif
        xcd_barrier(bar, wave);
#if (PHMASK & 16)
        for (int dup = 0; dup < ATT_DUP; ++dup) {
            LAUNDER_G(ws);
            if (dup) xcd_barrier(bar, wave);
            gu32* qhead = (gu32*)(ws + WS_CTL) + CW_QUEUE + 64 * dup;
#if defined(CLK_PROBE)
            unsigned long long c0_ = __builtin_amdgcn_s_memtime(), r0_ = __builtin_amdgcn_s_memrealtime();
#endif
            const att::Tensors T = att::make_tensors(ws, PRM);
            const bool st = (G == 256);
            const int xg = bx & 7, cg = bx >> 3;
            for (int step = 0;; ++step) {
                int kind, h, qb;
                if (st && step < 2) {
                    if (step < 1) { kind = 0; h = xg; qb = cg; }
                    else { kind = 1; h = (xg < 4) ? 3 : 2; qb = 32 * (xg & 3) + cg; }
                } else {
                    if ((wave == 0) && (lane_id_v() == 0)) MISC[12] = __hip_atomic_fetch_add(qhead, 1u, RLX_AGENT);
                    LDS_WAIT(); __syncthreads();
                    int idx = __builtin_amdgcn_readfirstlane((int)MISC[12]);
                    if (st) idx += 512;
                    if (idx >= 768) break;
                    if (idx < 256 || idx >= 512) { kind = 1;
                        if (idx < 128) { h = 3; qb = idx; } else if (idx < 256) { const int i = idx - 128; h = 2; qb = (i & 1) ? 63 - (i >> 1) : 64 + (i >> 1); }
                        else if (idx < 640) { h = 1; qb = idx - 512; } else { h = 0; qb = idx - 640; }
                    } else { kind = 0; const int i = idx - 256; h = i >> 5; qb = i & 31; }
                }
#if defined(DUP_ONLY_A)
                if (dup && kind) continue;
#elif defined(DUP_ONLY_B)
                if (dup && !kind) continue;
#endif
                if (kind) {
                    const float slope = (h == 0) ? 0.25f : (h == 1) ? 0.0625f : (h == 2) ? 0.015625f : 0.00390625f;
                    const float c2 = slope * 1.4426950408889634f; const int dskip = (int)(150.0f / c2) + 1;
                    att::attn_unit<true>(T, h, qb, PRM[PRM_NEGM2B], PRM[PRM_LAM + h], c2, dskip, (char*)lds + RING_OFF, wave);
                } else att::attn_unit_a8x2<A8U>(T, h, qb, PRM[PRM_NEGM2A] + 8.0f, (char*)lds + RING_OFF, wave);
            }
#if defined(CLK_PROBE)
            if (dup == ATT_DUP - 1 && bx == 0) { const unsigned long long c1_ = __builtin_amdgcn_s_memtime(), r1_ = __builtin_amdgcn_s_memrealtime(); const unsigned long long spin_ = 1000ull * (c1_ - c0_) / (r1_ - r0_); while (__builtin_amdgcn_s_memrealtime() - r1_ < spin_) __builtin_amdgcn_s_sleep(8); }
#endif
        }
#endif
        xcd_barrier(bar, wave);
#if (PHMASK & 32)
        {
            LAUNDER_G(ws); LAUNDER_G(out);
            pg8::Gemm g{(const bf16*)(ws + WS_MIX), (const bf16*)(ws + WS_WOUT), M, D, D}; pg8::StaticOrderT<M, D> S; int bxs_ = bx, Gs_ = G; LAUNDER(bxs_); LAUNDER(Gs_); S.init(Gs_, bxs_);
            pg8::EpiResid<true, true, false> E{nullptr, nullptr, ws, 1.0f}; pg8::gemm_phase<D, pg8::EpiResid<true, true, false>, pg8::StaticOrderT<M, D>, true, true>(L + RING_OFF, g, S, E, wave);
        }
#endif
        xcd_barrier(bar, wave);
    }
}

extern "C" void kernel_launch(void* const* d_in, const int* in_sizes, int n_in, void* d_out, int out_size, void* d_ws, size_t ws_size, hipStream_t stream) {
    static int grid = 0;
    if (grid == 0) {
        if (n_in != 21 || in_sizes[0] != M * D || out_size != M * D || ws_size < WS_END) { fprintf(stderr, "kernel_launch: unexpected shapes (n_in %d, in0 %d, out %d, ws %zu)\n", n_in, n_in > 0 ? in_sizes[0] : -1, out_size, ws_size); grid = -1; return; }
        int dev = 0, cus = 0, per_cu = 0;
        if (hipGetDevice(&dev) != hipSuccess || hipDeviceGetAttribute(&cus, hipDeviceAttributeMultiprocessorCount, dev) != hipSuccess) { grid = -1; return; }
        if (hipFuncSetAttribute((const void*)mk_fwd, hipFuncAttributeMaxDynamicSharedMemorySize, LDS_BYTES) != hipSuccess) { fprintf(stderr, "kernel_launch: hipFuncSetAttribute failed\n"); grid = -1; return; }
        if (hipOccupancyMaxActiveBlocksPerMultiprocessor(&per_cu, (const void*)mk_fwd, NWAVES * 64, LDS_BYTES) != hipSuccess || per_cu < 1) { fprintf(stderr, "kernel_launch: occupancy query says %d blocks per CU\n", per_cu); (void)hipGetLastError(); grid = -1; return; }
        grid = cus;
    }
    if (grid < 0) return;
    if (hipMemsetAsync((char*)d_ws + WS_CTL, 0, CTL_ZERO_BYTES, stream) != hipSuccess) { fprintf(stderr, "kernel_launch: memset failed\n"); return; }
    Args a{};
    for (int i = 0; i < 21; ++i) a.in[i] = (const float*)d_in[i];
    a.out = (float*)d_out; a.ws = (unsigned char*)d_ws;
    hipLaunchKernelGGL(mk_fwd, dim3(grid), dim3(NWAVES * 64), LDS_BYTES, stream, a);
    const hipError_t le = hipPeekAtLastError();
    if (le != hipSuccess) fprintf(stderr, "kernel_launch: launch failed: %s\n", hipGetErrorName(le));
}
```

```cpp
#include <hip/hip_runtime.h>
#include <cstdio>
#include <cstdint>
#define NOTAIL 1
#ifndef A8_VPREF
#define A8_VPREF 0
#endif
#ifndef BDMA_MODE
#define BDMA_MODE 0
#endif
#ifndef A8U
#define A8U 4
#endif
#ifndef A8_NOBF8
#define A8_BF8 1
#endif

constexpr int NWAVES = 8;
constexpr int M = 16384, D = 1024, FF = 2816, NGU = 2 * FF, NIN = 2304;
constexpr size_t MiB = 1u << 20;
constexpr size_t WS_CTL = 0, CTL_ZERO_BYTES = 64 * 1024;
constexpr size_t WS_WGU1 = 2 * MiB, WS_WD1 = 13 * MiB, WS_WIN = 19 * MiB, WS_WOUT = 24 * MiB, WS_WGU2 = 26 * MiB, WS_WD2 = 37 * MiB;
constexpr size_t WS_ROPE = 43 * MiB, WS_SSQ = 44 * MiB;
constexpr size_t WS_XB = 48 * MiB;
constexpr size_t WS_H = 80 * MiB;
constexpr size_t WS_QA = 80 * MiB, WS_KA = 96 * MiB, WS_VA = 100 * MiB, WS_QB = 104 * MiB, WS_KB = 120 * MiB, WS_VB = 136 * MiB, WS_MIX = 152 * MiB;
constexpr size_t WS_END = 184 * MiB;
static_assert(WS_WGU1 + (size_t)NGU * D * 2 <= WS_WD1 && WS_WD1 + (size_t)D * FF * 2 <= WS_WIN && WS_WIN + (size_t)NIN * D * 2 <= WS_WOUT && WS_WOUT + (size_t)D * D * 2 <= WS_WGU2 &&
              WS_WGU2 + (size_t)NGU * D * 2 <= WS_WD2 && WS_WD2 + (size_t)D * FF * 2 <= WS_ROPE && WS_H + (size_t)M * FF * 2 <= WS_END && WS_MIX + (size_t)M * D * 2 <= WS_END, "d_ws map");
constexpr int CW_BAR = 1024;
constexpr int CW_XFLAG = 9216;
constexpr size_t WS_XCH = 184 * MiB;
constexpr int CW_QUEUE = 8192;
constexpr int RING_OFF = 0, RING_BYTES = 131072;
constexpr int LDSCTL_OFF = RING_BYTES, MISC_OFF = LDSCTL_OFF + 320, RSTD_OFF = LDSCTL_OFF + 1024, PRM_OFF = LDSCTL_OFF + 8192;
constexpr int LDS_BYTES = 147456;
constexpr int PRM_GAQ = 0, PRM_GAK = 64, PRM_GBQ = 128, PRM_GBK = 192, PRM_SUBLN = 256, PRM_NEGM2A = 384, PRM_NEGM2B = 385, PRM_LAM = 388, PRM_WORDS = 392;
static_assert(RSTD_OFF + 6 * 256 * 4 <= PRM_OFF && PRM_OFF + PRM_WORDS * 4 <= LDS_BYTES, "LDS map");

__device__ __forceinline__ int lane_id_v() { int l; asm volatile("v_mbcnt_lo_u32_b32 %0, -1, 0\n\tv_mbcnt_hi_u32_b32 %0, -1, %0" : "=v"(l)); return l; }

template <int MASK> __device__ __forceinline__ float xor_lane(float v) {
    if constexpr (MASK == 32) { const auto rr = __builtin_amdgcn_permlane32_swap(__float_as_uint(v), __float_as_uint(v), false, false); return __uint_as_float(lane_id_v() < 32 ? rr[1] : rr[0]); }
    else return __uint_as_float((unsigned)__builtin_amdgcn_ds_swizzle((int)__float_as_uint(v), (MASK << 10) | 0x1f));
}
__device__ __forceinline__ float sum_x32(float v) { const auto rr = __builtin_amdgcn_permlane32_swap(__float_as_uint(v), __float_as_uint(v), false, false); return __uint_as_float(rr[0]) + __uint_as_float(rr[1]); }
__device__ __forceinline__ float max_x32(float v) { const auto rr = __builtin_amdgcn_permlane32_swap(__float_as_uint(v), __float_as_uint(v), false, false); return fmaxf(__uint_as_float(rr[0]), __uint_as_float(rr[1])); }

#define LAUNDER_G(p) do { __attribute__((address_space(1))) void* g_ = (__attribute__((address_space(1))) void*)(p); asm volatile("" : "+s"(g_)); (p) = (decltype(p))g_; } while (0)
namespace pg8 {
#define PG8_LAS __attribute__((address_space(3)))
typedef unsigned short bf16_t;
typedef short bf16x8 __attribute__((ext_vector_type(8)));
typedef float f32x4 __attribute__((ext_vector_type(4)));
typedef unsigned u32x4 __attribute__((ext_vector_type(4)));
constexpr int BM = 256, BK = 64, HALF = 128, HTB = HALF * BK * 2  , STAGE_BYTES = 8 * HTB, NXCD = 8, WGM = 8;

__host__ __device__ __forceinline__ int lds_byte(int r, int c) { const int st = (r >> 4) * 2 + (c >> 5), rr = r & 15, cc = c & 31, ob = rr * 64 + cc * 2; return st * 1024 + (ob ^ (((ob >> 9) & 1) << 5)); }
__host__ __device__ __forceinline__ void stage_rc(int b, int& R, int& C) { const int st = b / 1024, sb = b % 1024, swz = sb ^ (((sb >> 9) & 1) << 5); R = (st >> 1) * 16 + swz / 64; C = (st & 1) * 32 + (swz % 64) / 2; }
__host__ __device__ __forceinline__ int perm32(int rho) { const int n = rho >> 4, i = rho & 15; return 8 * (i >> 2) + 4 * n + (i & 3); }

struct Unit { int pm, pn; int kofs, nt; };
struct Gemm { const bf16_t* A; const bf16_t* Bt; int M, N, K; };

template <int MD, int ND> struct StaticOrderT {
    static constexpr int nM = MD / BM, nN = ND / BM, nwg = nM * nN;
    int G, c;
    __host__ __device__ void init(int G_, int c_) { G = G_; c = c_; }
    __host__ __device__ bool next(int i, Unit& u) const { return at(i * G + c, u); }
    __host__ __device__ bool at(int L, Unit& u) const {
        if (L >= nwg) return false;
        int wgid = L; { constexpr int q = nwg / NXCD, r = nwg % NXCD; const int xcd = wgid % NXCD, off = wgid / NXCD; wgid = (xcd < r ? xcd * (q + 1) : r * (q + 1) + (xcd - r) * q) + off; }
        constexpr int nig = WGM * nN; const int gid = wgid / nig, fm = gid * WGM, gsz = (nM - fm) < WGM ? (nM - fm) : WGM;
        u.pm = fm + ((wgid % nig) % gsz); u.pn = (wgid % nig) / gsz; u.kofs = 0; u.nt = 0; return true;
    }
    __device__ __forceinline__ void a_ready(const Unit&) const {}
    __device__ __forceinline__ void done(const Unit&) const {}
};
template <class S0, int RT, int NTF> struct SplitTailOrderT { S0 s; bool sk;
    __host__ __device__ bool next(int i, Unit& u) const {
        if (!sk || i < RT) { const bool r = s.next(i, u); u.kofs = 0; u.nt = NTF; return r; }
        if (i > RT) return false;
        const int h = s.G >> 1; s.at(RT * s.G + (s.c % h), u); u.kofs = (s.c / h) * (NTF / 2) * BK * 2; u.nt = NTF / 2; return true; }
    __device__ __forceinline__ void a_ready(const Unit&) const {} __device__ __forceinline__ void done(const Unit&) const {} };


__device__ __forceinline__ unsigned cvt_pk_bf16(float lo, float hi) { unsigned r; asm volatile("v_cvt_pk_bf16_f32 %0, %1, %2" : "=v"(r) : "v"(lo), "v"(hi)); return r; }
__device__ __forceinline__ unsigned short f2bf1(float f) { unsigned u = __builtin_bit_cast(unsigned, f); return (unsigned short)((u + 0x7fffu + ((u >> 16) & 1u)) >> 16); }
typedef unsigned u32x2 __attribute__((ext_vector_type(2)));
constexpr int MROWS = M, DMODEL = D, DFF = FF;

typedef float f32x2 __attribute__((ext_vector_type(2)));
__device__ __forceinline__ f32x2 swiglu2(f32x2 ag, f32x2 au, float k1, float rs2) {
    const f32x2 t = ag * k1; f32x2 ex; ex.x = __builtin_amdgcn_exp2f(t.x); ex.y = __builtin_amdgcn_exp2f(t.y);
    const f32x2 d = ex + 1.0f; f32x2 r; r.x = __builtin_amdgcn_rcpf(d.x); r.y = __builtin_amdgcn_rcpf(d.y);
    return ((ag * au) * rs2) * r;
}
__device__ __forceinline__ f32x4 swiglu4(f32x4 ag, f32x4 au, float k1, float rs2) {
    const f32x2 a = swiglu2((f32x2){ag[0], ag[1]}, (f32x2){au[0], au[1]}, k1, rs2), b = swiglu2((f32x2){ag[2], ag[3]}, (f32x2){au[2], au[3]}, k1, rs2);
    return (f32x4){a.x, a.y, b.x, b.y};
}
struct EpiSwiGLU {
    static constexpr bool PERM = true, AFTER_DRAIN = false;
    unsigned char* ws; const PG8_LAS float* rstd;
    __device__ __forceinline__ void operator()(const f32x4 (&acc)[2][2][4][2], const Unit& u, int ui, int wr, int wc, int fr, int fq) const {
        asm volatile("" : "+v"(fr), "+v"(fq));
        const int col0 = u.pn * 128 + wc * 32 + 8 * fq; unsigned char* w2 = ws; LAUNDER_G(w2); bf16_t* H = (bf16_t*)(w2 + WS_H);
#pragma unroll
        for (int ai = 0; ai < 2; ++ai)
#pragma unroll
            for (int m = 0; m < 4; ++m) {
                const int rl = ai * HALF + wr * 64 + m * 16 + fr; const float rs = rstd[ui * 256 + rl];
                const float k1 = rs * -1.4426950408889634f, rs2 = rs * rs;
                const f32x4 h0 = swiglu4(acc[ai][0][m][0], acc[ai][1][m][0], k1, rs2), h1 = swiglu4(acc[ai][0][m][1], acc[ai][1][m][1], k1, rs2);
                u32x4 w; w.x = cvt_pk_bf16(h0[0], h0[1]); w.y = cvt_pk_bf16(h0[2], h0[3]); w.z = cvt_pk_bf16(h1[0], h1[1]); w.w = cvt_pk_bf16(h1[2], h1[3]);
                *(u32x4*)(H + (size_t)(u.pm * BM + rl) * DFF + col0) = w;
            }
    }
};
struct EpiSwiGLUSplit {
    static constexpr bool PERM = true, AFTER_DRAIN = false;
    unsigned char* ws; const PG8_LAS float* rstd;
    typedef unsigned long long u64;
    __device__ __forceinline__ static void put(u64* p, const f32x4& v) {
        __hip_atomic_store(p, ((u64)__float_as_uint(v[1]) << 32) | __float_as_uint(v[0]), __ATOMIC_RELAXED, __HIP_MEMORY_SCOPE_AGENT);
        __hip_atomic_store(p + 1, ((u64)__float_as_uint(v[3]) << 32) | __float_as_uint(v[2]), __ATOMIC_RELAXED, __HIP_MEMORY_SCOPE_AGENT); }
    __device__ __forceinline__ static f32x4 get(const u64* p) {
        const u64 a = __hip_atomic_load(p, __ATOMIC_RELAXED, __HIP_MEMORY_SCOPE_AGENT), b = __hip_atomic_load(p + 1, __ATOMIC_RELAXED, __HIP_MEMORY_SCOPE_AGENT);
        return (f32x4){__uint_as_float((unsigned)a), __uint_as_float((unsigned)(a >> 32)), __uint_as_float((unsigned)b), __uint_as_float((unsigned)(b >> 32))}; }
    template <int SS> __device__ __forceinline__ void run(const f32x4 (&acc)[2][2][4][2], const Unit& u, int wr, int wc, int fr, int fq) const {
        unsigned char* w2 = ws; LAUNDER_G(w2);
        const int pair = (int)(__builtin_amdgcn_workgroup_id_x() & 127u); constexpr int rslot = 5;
        const unsigned tid = (unsigned)((wr * 4 + wc) * 64 + fq * 16 + fr);
        unsigned char* xb_ = w2 + WS_XCH + (size_t)pair * (2 * 16 * 512 * 16);
        u64* xo = (u64*)(xb_ + (size_t)(1 - SS) * (16 * 512 * 16) + tid * 16u);
        const u64* xi = (const u64*)(xb_ + (size_t)SS * (16 * 512 * 16) + tid * 16u);
        unsigned* flg = (unsigned*)(w2 + WS_CTL) + CW_XFLAG + pair * 2;
#pragma unroll
        for (int bj = 0; bj < 2; ++bj)
#pragma unroll
            for (int m = 0; m < 4; ++m)
#pragma unroll
                for (int n = 0; n < 2; ++n) put(xo + (size_t)((bj * 4 + m) * 2 + n) * 1024, acc[1 - SS][bj][m][n]);
        asm volatile("s_waitcnt vmcnt(0)" ::: "memory");
        __syncthreads();
        if (tid == 0) { __hip_atomic_store(flg + (1 - SS), 1u, __ATOMIC_RELAXED, __HIP_MEMORY_SCOPE_AGENT);
            unsigned sp = 0; while (__hip_atomic_load(flg + SS, __ATOMIC_RELAXED, __HIP_MEMORY_SCOPE_AGENT) == 0u) { __builtin_amdgcn_s_sleep(1); if (++sp > (1u << 20)) break; } }
        __syncthreads();
        bf16_t* H = (bf16_t*)(w2 + WS_H); const int col0 = u.pn * 128 + wc * 32 + 8 * fq;
#pragma unroll
        for (int m = 0; m < 4; ++m) {
            const f32x4 g0 = acc[SS][0][m][0] + get(xi + (size_t)((0 * 4 + m) * 2 + 0) * 1024), g1 = acc[SS][0][m][1] + get(xi + (size_t)((0 * 4 + m) * 2 + 1) * 1024);
            const f32x4 u0 = acc[SS][1][m][0] + get(xi + (size_t)((1 * 4 + m) * 2 + 0) * 1024), u1 = acc[SS][1][m][1] + get(xi + (size_t)((1 * 4 + m) * 2 + 1) * 1024);
            const int rl = SS * HALF + wr * 64 + m * 16 + fr; const float rs = rstd[rslot * 256 + rl];
            const float k1 = rs * -1.4426950408889634f, rs2 = rs * rs;
            const f32x4 h0 = swiglu4(g0, u0, k1, rs2), h1 = swiglu4(g1, u1, k1, rs2);
            u32x4 w; w.x = cvt_pk_bf16(h0[0], h0[1]); w.y = cvt_pk_bf16(h0[2], h0[3]); w.z = cvt_pk_bf16(h1[0], h1[1]); w.w = cvt_pk_bf16(h1[2], h1[3]);
            *(u32x4*)(H + (size_t)(u.pm * BM + rl) * DFF + col0) = w;
        }
    }
    __device__ __forceinline__ void operator()(const f32x4 (&acc)[2][2][4][2], const Unit& u, int ui, int wr, int wc, int fr, int fq) const {
        if (u.nt == (D / BK) / 2) { asm volatile("" : "+v"(fr), "+v"(fq));
            if (__builtin_amdgcn_workgroup_id_x() >> 7) run<1>(acc, u, wr, wc, fr, fq); else run<0>(acc, u, wr, wc, fr, fq); }
        else { EpiSwiGLU E0{ws, rstd}; E0(acc, u, ui, wr, wc, fr, fq); }
    }
};
template <bool SRC_B, bool WRITE_B, bool WRITE_F, int PROBE = 0> struct EpiResid {
    static constexpr bool PERM = true, AFTER_DRAIN = false;
    const float* base; float* out; unsigned char* ws; float alpha;
    __device__ __forceinline__ static f32x4 up4(unsigned a, unsigned b) { return (f32x4){__uint_as_float(a << 16), __uint_as_float(a & 0xffff0000u), __uint_as_float(b << 16), __uint_as_float(b & 0xffff0000u)}; }
    __device__ __forceinline__ void operator()(const f32x4 (&acc)[2][2][4][2], const Unit& u, int ui, int wr, int wc, int fr, int fq) const {
        asm volatile("" : "+v"(fr), "+v"(fq));
        const int col0 = u.pn * BM + wc * 32 + 8 * fq;
        unsigned char* w2 = ws; LAUNDER_G(w2); bf16_t* xb = (bf16_t*)(w2 + WS_XB); float* ssqp = (float*)(w2 + WS_SSQ);
#pragma unroll
        for (int ai = 0; ai < 2; ++ai) {
            f32x4 rb[4][2][2];
#pragma unroll
            for (int m = 0; m < 4; ++m) { const size_t off = (size_t)(u.pm * BM + ai * HALF + wr * 64 + m * 16 + fr) * DMODEL + col0;
#pragma unroll
                for (int bj = 0; bj < 2; ++bj) {
                    if (PROBE == 1) { rb[m][bj][0] = (f32x4){0.f, 0.f, 0.f, 0.f}; rb[m][bj][1] = rb[m][bj][0]; }
                    else if (SRC_B) { const u32x4 r = *(const u32x4*)(xb + off + bj * HALF); rb[m][bj][0] = __builtin_bit_cast(f32x4, r); }
                    else { rb[m][bj][0] = *(const f32x4*)(base + off + bj * HALF); rb[m][bj][1] = *(const f32x4*)(base + off + bj * HALF + 4); } } }
#pragma unroll
            for (int m = 0; m < 4; ++m) {
                const int row = u.pm * BM + ai * HALF + wr * 64 + m * 16 + fr; const size_t off = (size_t)row * DMODEL + col0; float ss = 0.f;
#pragma unroll
                for (int bj = 0; bj < 2; ++bj) { const size_t o = off + bj * HALF;
                    f32x4 b0, b1;
                    if (SRC_B) { const u32x4 r = __builtin_bit_cast(u32x4, rb[m][bj][0]); b0 = up4(r[0], r[1]); b1 = up4(r[2], r[3]); } else { b0 = rb[m][bj][0]; b1 = rb[m][bj][1]; }
                    const f32x4 v0 = b0 + acc[ai][bj][m][0] * alpha, v1 = b1 + acc[ai][bj][m][1] * alpha;
                    if (PROBE == 2) { asm volatile("" :: "v"(v0), "v"(v1)); }
#ifdef OUT_NT
                    if (WRITE_F && PROBE != 2) { __builtin_nontemporal_store(v0, (f32x4*)(out + o)); __builtin_nontemporal_store(v1, (f32x4*)(out + o + 4)); }
#else
                    if (WRITE_F && PROBE != 2) { *(f32x4*)(out + o) = v0; *(f32x4*)(out + o + 4) = v1; }
#endif
                    if (WRITE_B && PROBE != 2) { ss += ((v0[0] * v0[0] + v0[1] * v0[1]) + (v0[2] * v0[2] + v0[3] * v0[3])) + ((v1[0] * v1[0] + v1[1] * v1[1]) + (v1[2] * v1[2] + v1[3] * v1[3]));
                        u32x4 w; w.x = cvt_pk_bf16(v0[0], v0[1]); w.y = cvt_pk_bf16(v0[2], v0[3]); w.z = cvt_pk_bf16(v1[0], v1[1]); w.w = cvt_pk_bf16(v1[2], v1[3]); *(u32x4*)(xb + o) = w; } }
                if (WRITE_B && PROBE != 2) { ss += xor_lane<16>(ss); ss = sum_x32(ss); if (fq == 0) ssqp[(size_t)row * 16 + u.pn * 4 + wc] = ss; }
            }
            asm volatile("" ::: "memory");
        }
    }
};
template <bool WRITE_B, bool WRITE_F> struct EpiResidStaged {
    static constexpr bool PERM = true, AFTER_DRAIN = true;
    float* out; unsigned char* ws; float alpha; unsigned char* wsw;
    __device__ __forceinline__ static f32x4 up4(unsigned a, unsigned b) { return (f32x4){__uint_as_float(a << 16), __uint_as_float(a & 0xffff0000u), __uint_as_float(b << 16), __uint_as_float(b & 0xffff0000u)}; }
    __device__ __forceinline__ void fused(f32x4 (&acc)[2][2][4][2], const Unit& u, int wr, int wc, int fr, int fq, PG8_LAS unsigned char* lds, int wid, int lane) const {
        unsigned char* w2 = ws; LAUNDER_G(w2); const bf16_t* xb = (const bf16_t*)(w2 + WS_XB); unsigned char* w3 = wsw; LAUNDER_G(w3); bf16_t* xbw = (bf16_t*)(w3 + WS_XB); float* ssqp = (float*)(w3 + WS_SSQ);
        {
            const int tid = wid * 64 + lane, c = tid & 31, r0 = tid >> 5;
            const bf16_t* src = xb + (size_t)(u.pm * BM + r0) * DMODEL + u.pn * BM + c * 8;
            u32x4 t[16];
#pragma unroll
            for (int p = 0; p < 16; ++p) t[p] = *(const u32x4*)(src + (size_t)(p * 16) * DMODEL);
#pragma unroll
            for (int p = 0; p < 16; ++p) { const int r = p * 16 + r0; *(PG8_LAS u32x4*)(lds + r * 512 + ((c ^ (r & 15)) << 4)) = t[p]; }
        }
        asm volatile("s_waitcnt vmcnt(0) lgkmcnt(0)\n\ts_barrier" ::: "memory");
        asm volatile("" : "+v"(fr), "+v"(fq));
        const int col0 = u.pn * BM + wc * 32 + 8 * fq;
#pragma unroll
        for (int ai = 0; ai < 2; ++ai)
#pragma unroll
            for (int m = 0; m < 4; ++m) {
                const int rl = ai * HALF + wr * 64 + m * 16 + fr; const int row = u.pm * BM + rl; const size_t off = (size_t)row * DMODEL + col0; float ss = 0.f;
#pragma unroll
                for (int bj = 0; bj < 2; ++bj) { const size_t o = off + bj * HALF;
                    const int chunk = 16 * bj + 4 * wc + fq;
                    const u32x4 r = *(const PG8_LAS u32x4*)(lds + rl * 512 + ((chunk ^ (rl & 15)) << 4));
                    const f32x4 b0 = up4(r[0], r[1]), b1 = up4(r[2], r[3]);
                    const f32x4 v0 = b0 + acc[ai][bj][m][0] * alpha, v1 = b1 + acc[ai][bj][m][1] * alpha;
                    if (WRITE_F) { *(f32x4*)(out + o) = v0; *(f32x4*)(out + o + 4) = v1; }
                    if (WRITE_B) { ss += ((v0[0] * v0[0] + v0[1] * v0[1]) + (v0[2] * v0[2] + v0[3] * v0[3])) + ((v1[0] * v1[0] + v1[1] * v1[1]) + (v1[2] * v1[2] + v1[3] * v1[3]));
                        u32x4 w; w.x = cvt_pk_bf16(v0[0], v0[1]); w.y = cvt_pk_bf16(v0[2], v0[3]); w.z = cvt_pk_bf16(v1[0], v1[1]); w.w = cvt_pk_bf16(v1[2], v1[3]); *(u32x4*)(xbw + o) = w; } }
                if (WRITE_B) { ss += xor_lane<16>(ss); ss = sum_x32(ss); if (fq == 0) ssqp[(size_t)row * 16 + u.pn * 4 + wc] = ss; }
            }
    }
};
struct EpiNull {
    static constexpr bool PERM = true, AFTER_DRAIN = false;
    __device__ __forceinline__ void operator()(const f32x4 (&acc)[2][2][4][2], const Unit& u, int ui, int wr, int wc, int fr, int fq) const {
#pragma unroll
        for (int ai = 0; ai < 2; ++ai)
#pragma unroll
            for (int bj = 0; bj < 2; ++bj)
#pragma unroll
                for (int m = 0; m < 4; ++m)
#pragma unroll
                    for (int n = 0; n < 2; ++n) { f32x4 t = acc[ai][bj][m][n]; asm volatile("" :: "v"(t)); }
    }
};
struct EpiInProj {
    static constexpr bool PERM = false, AFTER_DRAIN = false;
    const PG8_LAS float* rstd; const PG8_LAS float* prm; unsigned char* ws;
    __device__ __forceinline__ static float head_f(const f32x4 (&acc)[2][2][4][2], int ai, int m, float rs) {
        float ss = 0.f;
#pragma unroll
        for (int bj = 0; bj < 2; ++bj)
#pragma unroll
            for (int n = 0; n < 2; ++n) { const f32x4 a = acc[ai][bj][m][n]; ss += (a[0] * a[0] + a[1] * a[1]) + (a[2] * a[2] + a[3] * a[3]); }
        ss += xor_lane<16>(ss); ss = sum_x32(ss);
        return rs / sqrtf(ss * rs * rs * (1.0f / 64.0f) + 1e-6f);
    }
    __device__ __forceinline__ void operator()(const f32x4 (&acc)[2][2][4][2], const Unit& u, int ui, int wr, int wc, int fr, int fq) const {
        const int G = __builtin_amdgcn_readfirstlane(u.pn * 4 + wc);
        unsigned char* w2 = ws; LAUNDER_G(w2);
        asm volatile("" : "+v"(fr), "+v"(fq));
        const int row0 = wr * 64 + fr;
        if (G < 10) {
            const bool isq = G < 8;
            const PG8_LAS float* gp = prm + (isq ? PRM_GAQ : PRM_GAK) + 4 * fq;
            const float* rope = (const float*)(w2 + WS_ROPE) + 4 * fq;
            const float qs = isq ? 0.125f * 1.4426950408889634f : 1.0f;
            unsigned char* db = isq ? (w2 + WS_QA) + (size_t)G * MROWS * 64 + 8 * fq : (w2 + WS_KA) + (size_t)(G - 8) * MROWS * 64 + (fq >> 1) * 512 + 8 * (fq & 1);
#pragma unroll
            for (int ai = 0; ai < 2; ++ai)
#pragma unroll
                for (int m = 0; m < 4; ++m) {
                    const int rl = ai * HALF + m * 16 + row0; const int t = u.pm * BM + rl; const float f = head_f(acc, ai, m, rstd[ui * 256 + rl]) * qs;
                    unsigned char* dt = isq ? db + (size_t)t * 64 : db + (size_t)(t >> 6) * 4096 + ((t & 63) >> 5) * 2048 + (t & 31) * 16;
#pragma unroll
                    for (int bj = 0; bj < 2; ++bj) {
                        const f32x4 x1 = acc[ai][bj][m][0] * f * *(const PG8_LAS f32x4*)(gp + 32 * bj), x2 = acc[ai][bj][m][1] * f * *(const PG8_LAS f32x4*)(gp + 32 * bj + 16);
                        const int pos = bj ? (t & 63) : (t >> 6); const float* rp = rope + (bj ? 8192 : 0) + pos * 16;
                        const f32x4 c = *(const f32x4*)rp, s = *(const f32x4*)(rp + (bj ? 1024 : 4096));
                        const f32x4 y1 = x1 * c - x2 * s, y2 = x2 * c + x1 * s;
                        int lo = __builtin_amdgcn_cvt_pk_fp8_f32(y1[0], y1[1], 0, false); lo = __builtin_amdgcn_cvt_pk_fp8_f32(y1[2], y1[3], lo, true);
                        int hi = __builtin_amdgcn_cvt_pk_fp8_f32(y2[0], y2[1], 0, false); hi = __builtin_amdgcn_cvt_pk_fp8_f32(y2[2], y2[3], hi, true);
                        u32x2 w; w.x = (unsigned)lo; w.y = (unsigned)hi;
                        *(u32x2*)(dt + (isq ? 32 * bj : 1024 * bj)) = w;
                    }
                    asm volatile("" ::: "memory");
                }
        } else if (G < 12) {
            unsigned char* V8 = (w2 + WS_VA) + (size_t)(G - 10) * MROWS * 64 + (4 * fq) * 16;
#pragma unroll
            for (int ai = 0; ai < 2; ++ai)
#pragma unroll
                for (int m = 0; m < 4; ++m) {
                    const int rl = ai * HALF + m * 16 + row0; const int t = u.pm * BM + rl; const float rs = rstd[ui * 256 + rl];
                    const int kk = t & 63, c = kk >> 5, r = kk & 31, h = (r >> 2) & 1, jj = (r & 3) + 4 * (r >> 3);
                    unsigned char* vb = V8 + (size_t)(t >> 6) * 4096 + h * 1024 + c * 512 + jj;
#pragma unroll
                    for (int bj = 0; bj < 2; ++bj)
#pragma unroll
                        for (int n = 0; n < 2; ++n) { const f32x4 v = acc[ai][bj][m][n] * rs;
                            const int p01 = __builtin_amdgcn_cvt_pk_fp8_f32(v[0], v[1], 0, false), p23 = __builtin_amdgcn_cvt_pk_fp8_f32(v[2], v[3], 0, false);
                            unsigned char* q = vb + bj * 2048 + (16 * n) * 16;
                            q[0] = (unsigned char)(p01 & 0xff); q[16] = (unsigned char)((p01 >> 8) & 0xff); q[32] = (unsigned char)(p23 & 0xff); q[48] = (unsigned char)((p23 >> 8) & 0xff); }
                    asm volatile("" ::: "memory");
                }
        } else if (G < 28) {
            const bool isq = G < 20;
            const PG8_LAS float* gp = prm + (isq ? PRM_GBQ : PRM_GBK) + 4 * fq;
            const float qs = isq ? 0.125f * 1.4426950408889634f : 1.0f;
            bf16_t* db = isq ? (bf16_t*)(w2 + WS_QB) + (size_t)(G - 12) * MROWS * 64 + 8 * fq : (bf16_t*)(w2 + WS_KB) + (size_t)(G - 20) * MROWS * 64 + (size_t)fq * 512;
#pragma unroll
            for (int ai = 0; ai < 2; ++ai)
#pragma unroll
                for (int m = 0; m < 4; ++m) {
                    const int rl = ai * HALF + m * 16 + row0; const int t = u.pm * BM + rl; const float f = head_f(acc, ai, m, rstd[ui * 256 + rl]) * qs;
                    bf16_t* dt = isq ? db + (size_t)t * 64 : db + (size_t)(t >> 6) * 4096 + (t & 63) * 8;
#pragma unroll
                    for (int bj = 0; bj < 2; ++bj) {
                        const f32x4 x1 = acc[ai][bj][m][0] * f * *(const PG8_LAS f32x4*)(gp + 32 * bj), x2 = acc[ai][bj][m][1] * f * *(const PG8_LAS f32x4*)(gp + 32 * bj + 16);
                        u32x4 w; w.x = cvt_pk_bf16(x1[0], x1[1]); w.y = cvt_pk_bf16(x1[2], x1[3]); w.z = cvt_pk_bf16(x2[0], x2[1]); w.w = cvt_pk_bf16(x2[2], x2[3]);
                        *(u32x4*)(dt + (isq ? 32 * bj : 2048 * bj)) = w;
                    }
                    asm volatile("" ::: "memory");
                }
        } else {
            bf16_t* V = (bf16_t*)(w2 + WS_VB) + (size_t)((G - 28) >> 1) * MROWS * 128 + (64 * ((G - 28) & 1) + 4 * fq) * 8;
#pragma unroll
            for (int ai = 0; ai < 2; ++ai)
#pragma unroll
                for (int m = 0; m < 4; ++m) {
                    const int rl = ai * HALF + m * 16 + row0; const int t = u.pm * BM + rl; const float rs = rstd[ui * 256 + rl];
                    const int kk = t & 63, ks = kk >> 4, ko = kk & 15, hi = (ko >> 2) & 1, j = ((ko >> 3) << 2) | (ko & 3);
                    bf16_t* vb = V + (size_t)(((t >> 6) * 4 + ks) * 2 + hi) * 1024 + j;
#pragma unroll
                    for (int bj = 0; bj < 2; ++bj)
#pragma unroll
                        for (int n = 0; n < 2; ++n)
#pragma unroll
                            for (int e = 0; e < 4; ++e) vb[(32 * bj + 16 * n + e) * 8] = f2bf1(acc[ai][bj][m][n][e] * rs);
                    asm volatile("" ::: "memory");
                }
        }
    }
};

#ifndef NOTAIL
#define NOTAIL 0
#endif
template <int KD, class Epi, class Sched, bool ALIGN_EPI = false, bool SP2 = false, int LD = KD, bool VARK = false>
__device__ __forceinline__ void gemm_phase(PG8_LAS unsigned char* lds, const Gemm g, const Sched& S, const Epi& E, int wave_id) {
    int tid_ = wave_id * 64 + lane_id_v(); asm volatile("" : "+v"(tid_));
    const int tid = tid_, wid = __builtin_amdgcn_readfirstlane(tid >> 6), lane = tid & 63, wr = wid >> 2, wc = wid & 3, fr = lane & 15, fq = lane >> 4;
    constexpr int K = KD, ntc = K / BK; static_assert(ntc % 2 == 0, "even K-tile count");
    unsigned voffA[2], voffB[2];
#pragma unroll
    for (int i = 0; i < 2; ++i) { int R, C; stage_rc(tid * 16 + i * 8192, R, C); const int Rb = Epi::PERM ? ((R & ~31) + perm32(R & 31)) : R;
        voffA[i] = (unsigned)(R * LD + C) * 2u; voffB[i] = (unsigned)(Rb * LD + C) * 2u; }
    constexpr size_t kstep = (size_t)(BK * 2);
    constexpr size_t hstep = (size_t)HALF * LD * 2;
    constexpr size_t tstep = 2 * hstep;
    const unsigned ldsw = (unsigned)wid * 1024u;
    const int aoff = lds_byte(wr * 64 + fr, fq * 8), boff = lds_byte(wc * 32 + fr, fq * 8);
#define PG8_SA(b, h) (((b) * 2 + (h)) * HTB)
#define PG8_SB(b, h) ((4 + (b) * 2 + (h)) * HTB)
#define PG8_STAGE(bufoff, gbase, voff) do { _Pragma("unroll") for (int _i = 0; _i < 2; ++_i) \
        __builtin_amdgcn_global_load_lds((const unsigned*)((const char*)(gbase) + (voff)[_i]), (PG8_LAS unsigned*)(lds + (bufoff) + ldsw + _i * 8192), 16, 0, 0); } while (0)
#define PG8_LDA(dst, b, h) do { _Pragma("unroll") for (int m = 0; m < 4; ++m) _Pragma("unroll") for (int k = 0; k < 2; ++k) dst[m][k] = *(const PG8_LAS bf16x8*)(lds + PG8_SA(b, h) + aoff + m * 2048 + k * 1024); } while (0)
#define PG8_LDB(dst, b, h) do { _Pragma("unroll") for (int n = 0; n < 2; ++n) _Pragma("unroll") for (int k = 0; k < 2; ++k) dst[n][k] = *(const PG8_LAS bf16x8*)(lds + PG8_SB(b, h) + boff + n * 2048 + k * 1024); } while (0)
#define PG8_MMA(ai, bj, At, Bt) do { __builtin_amdgcn_s_setprio(1); _Pragma("unroll") for (int m = 0; m < 4; ++m) _Pragma("unroll") for (int n = 0; n < 2; ++n) _Pragma("unroll") for (int k = 0; k < 2; ++k) \
        acc[ai][bj][m][n] = __builtin_amdgcn_mfma_f32_16x16x32_bf16(Bt[n][k], At[m][k], acc[ai][bj][m][n], 0, 0, 0); __builtin_amdgcn_s_setprio(0); } while (0)
#define PG8_WAIT_V(n) asm volatile("s_waitcnt vmcnt(" #n ")" ::: "memory")
#define PG8_WAIT_L(n) asm volatile("s_waitcnt lgkmcnt(" #n ")" ::: "memory")
#define PG8_BAR __builtin_amdgcn_s_barrier()
#define PG8_SCHED __builtin_amdgcn_sched_barrier(0)
    Unit cur, nxt; int ui = 0;
    if (!S.next(0, cur)) return;
    f32x4 acc[2][2][4][2];
#pragma unroll
    for (int a = 0; a < 2; ++a)
#pragma unroll
        for (int b = 0; b < 2; ++b)
#pragma unroll
            for (int m = 0; m < 4; ++m)
#pragma unroll
                for (int n = 0; n < 2; ++n) acc[a][b][m][n] = (f32x4){0.f, 0.f, 0.f, 0.f};
    bf16x8 At[4][2], B0[2][2], B1[2][2];
    const char* cA = (const char*)g.A + (size_t)cur.pm * tstep + (VARK ? cur.kofs : 0); const char* cB = (const char*)g.Bt + (size_t)cur.pn * tstep + (VARK ? cur.kofs : 0);
    S.a_ready(cur);
    if constexpr (SP2) {
        PG8_STAGE(PG8_SB(0, 0), cB, voffB); PG8_STAGE(PG8_SB(0, 1), cB + hstep, voffB); PG8_STAGE(PG8_SA(0, 0), cA, voffA); PG8_STAGE(PG8_SA(0, 1), cA + hstep, voffA);
        if (wr == 1) PG8_BAR;
        PG8_WAIT_V(2); PG8_BAR;
        PG8_STAGE(PG8_SB(1, 0), cB + kstep, voffB); PG8_STAGE(PG8_SA(1, 0), cA + kstep, voffA); PG8_STAGE(PG8_SB(1, 1), cB + hstep + kstep, voffB);
        PG8_WAIT_V(6); PG8_BAR;
    } else {
        PG8_STAGE(PG8_SB(0, 0), cB, voffB); PG8_STAGE(PG8_SA(0, 0), cA, voffA); PG8_STAGE(PG8_SB(0, 1), cB + hstep, voffB); PG8_STAGE(PG8_SA(0, 1), cA + hstep, voffA);
        if (wr == 1) PG8_BAR;
        PG8_WAIT_V(4); PG8_BAR;
        PG8_STAGE(PG8_SB(1, 0), cB + kstep, voffB); PG8_STAGE(PG8_SA(1, 0), cA + kstep, voffA); PG8_STAGE(PG8_SB(1, 1), cB + hstep + kstep, voffB);
        PG8_WAIT_V(6); PG8_BAR;
    }
    for (;;) {
        const bool has_next = S.next(ui + 1, nxt);
        const char* nA = has_next ? (const char*)g.A + (size_t)nxt.pm * tstep + (VARK ? nxt.kofs : 0) : cA; const char* nB = has_next ? (const char*)g.Bt + (size_t)nxt.pn * tstep + (VARK ? nxt.kofs : 0) : cB;
        const int nt = VARK ? cur.nt : ntc;
        for (int t = 0; t < nt; t += 2) {
            const bool last = (t == nt - 2); const bool fin = last && !has_next;
            const char* a1 = cA + (size_t)(t + 1) * kstep;
            const char* a2 = last ? nA : cA + (size_t)(t + 2) * kstep; const char* b2 = last ? nB : cB + (size_t)(t + 2) * kstep;
            const char* a3 = a2 + kstep; const char* b3 = b2 + kstep;
            if (last && has_next) S.a_ready(nxt);
            if constexpr (SP2) {
            PG8_LDB(B0, 0, 0); PG8_LDB(B1, 0, 1); PG8_SCHED; PG8_LDA(At, 0, 0); PG8_STAGE(PG8_SA(1, 1), a1 + hstep, voffA);
            PG8_WAIT_V(8); PG8_WAIT_L(0); PG8_BAR; PG8_MMA(0, 0, At, B0); PG8_MMA(0, 1, At, B1); PG8_BAR; PG8_SCHED;
            PG8_LDA(At, 0, 1); if (NOTAIL && fin) { PG8_WAIT_V(2); } else { PG8_STAGE(PG8_SB(0, 0), b2, voffB); PG8_STAGE(PG8_SB(0, 1), b2 + hstep, voffB); PG8_STAGE(PG8_SA(0, 0), a2, voffA); PG8_WAIT_V(8); }
            PG8_WAIT_L(0); PG8_BAR; PG8_MMA(1, 0, At, B0); PG8_MMA(1, 1, At, B1); PG8_BAR; PG8_SCHED;
            PG8_LDB(B0, 1, 0); PG8_LDB(B1, 1, 1); PG8_SCHED; PG8_LDA(At, 1, 0); if (NOTAIL && fin) { PG8_WAIT_V(0); } else { PG8_STAGE(PG8_SA(0, 1), a2 + hstep, voffA); PG8_WAIT_V(8); }
            PG8_WAIT_L(0); PG8_BAR; PG8_MMA(0, 0, At, B0); PG8_MMA(0, 1, At, B1); PG8_BAR; PG8_SCHED;
            PG8_LDA(At, 1, 1); if (!(NOTAIL && fin)) { PG8_STAGE(PG8_SB(1, 0), b3, voffB); PG8_STAGE(PG8_SB(1, 1), b3 + hstep, voffB); PG8_STAGE(PG8_SA(1, 0), a3, voffA); PG8_WAIT_V(8); }
            PG8_WAIT_L(0); PG8_BAR; PG8_MMA(1, 0, At, B0); PG8_MMA(1, 1, At, B1); PG8_BAR; PG8_SCHED;
            } else {
            PG8_LDB(B0, 0, 0); PG8_SCHED; PG8_LDA(At, 0, 0); PG8_STAGE(PG8_SA(1, 1), a1 + hstep, voffA);
            PG8_WAIT_L(8); PG8_BAR; PG8_WAIT_L(0); PG8_MMA(0, 0, At, B0); PG8_BAR; PG8_SCHED;
            PG8_LDB(B1, 0, 1); PG8_STAGE(PG8_SB(0, 0), b2, voffB);
            PG8_BAR; PG8_WAIT_L(0); PG8_MMA(0, 1, At, B1); PG8_BAR;
            PG8_LDA(At, 0, 1); PG8_STAGE(PG8_SA(0, 0), a2, voffA);
            PG8_BAR; PG8_WAIT_L(0); PG8_MMA(1, 0, At, B0); PG8_BAR; PG8_SCHED;
            PG8_STAGE(PG8_SB(0, 1), b2 + hstep, voffB);
            PG8_WAIT_V(6); PG8_BAR; PG8_MMA(1, 1, At, B1); PG8_BAR;
            PG8_LDB(B0, 1, 0); PG8_SCHED; PG8_LDA(At, 1, 0); PG8_STAGE(PG8_SA(0, 1), a2 + hstep, voffA);
            PG8_WAIT_L(8); PG8_BAR; PG8_WAIT_L(0); PG8_MMA(0, 0, At, B0); PG8_BAR; PG8_SCHED;
            PG8_LDB(B1, 1, 1); PG8_STAGE(PG8_SB(1, 0), b3, voffB);
            PG8_BAR; PG8_WAIT_L(0); PG8_MMA(0, 1, At, B1); PG8_BAR;
            PG8_LDA(At, 1, 1); PG8_STAGE(PG8_SA(1, 0), a3, voffA);
            PG8_BAR; PG8_WAIT_L(0); PG8_MMA(1, 0, At, B0); PG8_BAR; PG8_SCHED;
            PG8_STAGE(PG8_SB(1, 1), b3 + hstep, voffB);
            PG8_WAIT_V(6); PG8_BAR; PG8_MMA(1, 1, At, B1); PG8_BAR;
            }
        }
        if constexpr (ALIGN_EPI) { if (wr == 0) PG8_BAR; }
        if constexpr (!Epi::AFTER_DRAIN) { E(acc, cur, ui, wr, wc, fr, fq); S.done(cur); }
        if (!has_next) break;
#pragma unroll
        for (int a = 0; a < 2; ++a)
#pragma unroll
            for (int b = 0; b < 2; ++b)
#pragma unroll
                for (int m = 0; m < 4; ++m)
#pragma unroll
                    for (int n = 0; n < 2; ++n) acc[a][b][m][n] = (f32x4){0.f, 0.f, 0.f, 0.f};
        cur = nxt; cA = nA; cB = nB; ++ui;
        if constexpr (ALIGN_EPI) { if (wr == 1) PG8_BAR; }
    }
    PG8_WAIT_V(0);
    if constexpr (!ALIGN_EPI) { if (wr == 0) PG8_BAR; }
    PG8_BAR;
    if constexpr (Epi::AFTER_DRAIN) { E.fused(acc, cur, wr, wc, fr, fq, lds, wid, lane); S.done(cur); }
#undef PG8_SA
#undef PG8_SB
#undef PG8_STAGE
#undef PG8_LDA
#undef PG8_LDB
#undef PG8_MMA
#undef PG8_WAIT_V
#undef PG8_WAIT_L
#undef PG8_BAR
#undef PG8_SCHED
}
}
namespace att {
typedef unsigned short bf16_t;
typedef short bf16x8 __attribute__((ext_vector_type(8)));
typedef float f32x16 __attribute__((ext_vector_type(16)));
typedef float f32x4 __attribute__((ext_vector_type(4)));
typedef unsigned u32x4 __attribute__((ext_vector_type(4)));
#define ALAS __attribute__((address_space(3)))
constexpr int MROWS = M;
constexpr int WSF_OFF = 114688;
constexpr int LDS_NEED = WSF_OFF + 8 * 256;
__device__ __forceinline__ int crow(int r, int hi) { return (r & 3) + 8 * (r >> 2) + 4 * hi; }
__device__ __forceinline__ void glds16(const void* gsrc, unsigned lds_dst) { unsigned keep;
    asm volatile("s_mov_b32 %0, m0\n\ts_mov_b32 m0, %2\n\ts_nop 0\n\tglobal_load_lds_dwordx4 %1, off\n\ts_mov_b32 m0, %0" : "=&s"(keep) : "v"(gsrc), "s"(lds_dst) : "memory"); }
typedef float f32x2_t __attribute__((ext_vector_type(2))); typedef __bf16 bf16x2_t __attribute__((ext_vector_type(2)));
__device__ __forceinline__ unsigned cvtpk(float lo, float hi) { f32x2_t v = {lo, hi}; bf16x2_t b = __builtin_convertvector(v, bf16x2_t); return __builtin_bit_cast(unsigned, b); }
__device__ __forceinline__ void glds16s(const void* sbase, unsigned voff, unsigned lds_dst) { unsigned keep;
    asm volatile("s_mov_b32 %0, m0\n\ts_mov_b32 m0, %3\n\ts_nop 0\n\tglobal_load_lds_dwordx4 %1, %2\n\ts_mov_b32 m0, %0" : "=&s"(keep) : "v"(voff), "s"(sbase), "s"(lds_dst) : "memory"); }
#define ATT_WAIT_BAR(N) asm volatile("s_waitcnt vmcnt(" #N ") lgkmcnt(0)\n\ts_barrier" ::: "memory")
#define ATT_MFMA(a, b, c) __builtin_amdgcn_mfma_f32_32x32x16_bf16(a, b, c, 0, 0, 0)

struct Tensors { unsigned char* ws; const ALAS float* subln; };
__device__ __forceinline__ Tensors make_tensors(unsigned char* ws, const ALAS float* prm) { return Tensors{ws, prm + PRM_SUBLN}; }
#define T_QA ((const bf16_t*)(tws_ + WS_QA))
#define T_KA ((const bf16_t*)(tws_ + WS_KA))
#define T_VA ((const bf16_t*)(tws_ + WS_VA))
#define T_QB ((const bf16_t*)(tws_ + WS_QB))
#define T_KB ((const bf16_t*)(tws_ + WS_KB))
#define T_VB ((const bf16_t*)(tws_ + WS_VB))
#define T_MIX ((bf16_t*)(tws_ + WS_MIX))

#define SBAR() __builtin_amdgcn_sched_barrier(0)
#define PIN(x) asm volatile("" : "+v"(x))
#define PKW(P, B) cvtpk(P[B], P[(B) + 1])
#define EX(v) __builtin_amdgcn_exp2f(v)
#define WB_SEL(n) do { switch (n) { case 0: ATT_WAIT_BAR(0); break; case 1: ATT_WAIT_BAR(1); break; case 2: ATT_WAIT_BAR(2); break; case 3: ATT_WAIT_BAR(3); break; case 4: ATT_WAIT_BAR(4); break; case 6: ATT_WAIT_BAR(6); break; default: ATT_WAIT_BAR(8); } } while (0)
template <bool ISB>
__device__ __forceinline__ void attn_unit(const Tensors& T, int head, int qb, float negM2, float lam, float c2, int dskip, char* shm, int wave_id) {
    unsigned char* tws_ = T.ws; LAUNDER_G(tws_);
    constexpr int DV = ISB ? 128 : 64, ND0 = DV / 32, NK = ISB ? 2 : 1, NV = ISB ? 2 : 1;
    constexpr int KSLOT = ISB ? 16384 : 8192, VSLOT = ISB ? 16384 : 8192, LDS_K = 0, LDS_V = 3 * KSLOT;
    int tid_ = wave_id * 64 + lane_id_v(); asm volatile("" : "+v"(tid_));
    const int tid = tid_, lane = tid & 63, r32 = lane & 31, hi = lane >> 5; const int wid = __builtin_amdgcn_readfirstlane(tid >> 6);
    const int mapc = ISB ? (wid >> 2) : 0, wq = ISB ? (wid & 3) : wid;
    const int q0 = ISB ? qb * 128 : qb * 256; const int qrow = q0 + wq * 32 + r32;
    int t0 = 0, t1 = 256;
    if (ISB) { const int lo = q0 - dskip, hi_ = q0 + 127 + dskip; t0 = lo > 0 ? (lo >> 6) : 0; t1 = (hi_ >> 6) + 1; if (t1 > 256) t1 = 256;
        if ((t1 - t0) & 1) { if (t0 > 0) --t0; else ++t1; } }
    const int n = t1 - t0;
    const unsigned lds0 = (unsigned)(uintptr_t)shm;
    const ALAS char* shm3 = (const ALAS char*)shm;
    const char* k1b = ISB ? (const char*)(T_KB + (size_t)(2 * head) * MROWS * 64) + (size_t)t0 * 8192 : (const char*)(T_KA + (size_t)(head >> 2) * MROWS * 64);
    const char* k2b = ISB ? (const char*)(T_KB + (size_t)(2 * head + 1) * MROWS * 64) + (size_t)t0 * 8192 : nullptr;
    const char* vb_ = ISB ? (const char*)(T_VB + (size_t)head * MROWS * 128) + (size_t)t0 * 16384 : (const char*)(T_VA + (size_t)(head >> 2) * MROWS * 64);
    const unsigned dvo = (unsigned)(wid * 1024 + lane * 16);
    const unsigned kdst = lds0 + LDS_K + wid * 1024, vdst = lds0 + LDS_V + wid * 1024;
#define DMA_K(i, so) do { glds16s(k1b + (size_t)(i) * 8192, dvo, (unsigned)__builtin_amdgcn_readfirstlane(kdst + (so))); if (ISB) glds16s(k2b + (size_t)(i) * 8192, dvo, (unsigned)__builtin_amdgcn_readfirstlane(kdst + (so) + 8192)); } while (0)
#define DMA_V(i, so) do { if (ISB) { glds16s(vb_ + (size_t)(i) * 16384, dvo, (unsigned)__builtin_amdgcn_readfirstlane(vdst + (so))); glds16s(vb_ + (size_t)(i) * 16384 + 8192, dvo, (unsigned)__builtin_amdgcn_readfirstlane(vdst + (so) + 8192)); } \
      else glds16s(vb_ + (size_t)(i) * 8192, dvo, (unsigned)__builtin_amdgcn_readfirstlane(vdst + (so))); } while (0)
    DMA_K(0, 0); DMA_V(0, 0); DMA_K(1, KSLOT); DMA_V(1, VSLOT);
    const bf16_t* Qw = (ISB ? T_QB + (size_t)(2 * head + mapc) * MROWS * 64 : T_QA + (size_t)head * MROWS * 64) + (size_t)qrow * 64;
    bf16x8 qr[4];
#pragma unroll
    for (int d0 = 0; d0 < 4; ++d0) qr[d0] = *(const bf16x8*)(Qw + d0 * 16 + hi * 8);
    f32x16 o[ND0];
#pragma unroll
    for (int d = 0; d < ND0; ++d) o[d] = f32x16{};
    f32x16 negm;
#pragma unroll
    for (int r = 0; r < 16; ++r) negm[r] = negM2;
    asm volatile("" : "+v"(negm));
    float l_reg = 0.f;
    f32x16 osum = f32x16{}; bf16x8 ones; { const short o1 = (short)0x3f80; ones = (bf16x8){o1, o1, o1, o1, o1, o1, o1, o1}; } asm volatile("" : "+v"(ones));
    const ALAS char* kp0 = shm3 + LDS_K + (ISB ? mapc * 8192 : 0) + hi * 1024 + r32 * 16;
    const ALAS char* vp0 = shm3 + LDS_V + hi * (DV * 16) + r32 * 16;
    const int qw_lo = q0 + wq * 32, qw_hi = qw_lo + 31;
    const float nc2 = -c2; const float dl0 = (float)(64 * t0 - qrow + 4 * hi);
#define BIAS_GEN4(X, B, DC) do { const float e1_ = (DC) + 1.0f, e2_ = (DC) + 2.0f, e3_ = e1_ + 2.0f; \
        X[B] = __builtin_fmaf(__builtin_fabsf(DC), nc2, negM2); X[(B) + 1] = __builtin_fmaf(__builtin_fabsf(e1_), nc2, negM2); X[(B) + 2] = __builtin_fmaf(__builtin_fabsf(e2_), nc2, negM2); X[(B) + 3] = __builtin_fmaf(__builtin_fabsf(e3_), nc2, negM2); DC += 8.0f; } while (0)
#define BIAS_FAST4(X, B, DC) do { X[B] = __builtin_fmaf(sc1_, (DC), negM2); float t1_ = X[B] + sc1_; asm volatile("" : "+v"(t1_)); float t2_ = X[B] + sc2_; asm volatile("" : "+v"(t2_)); X[(B) + 1] = t1_; X[(B) + 2] = t2_; X[(B) + 3] = X[B] + sc3_; DC += 8.0f; } while (0)
#define BIAS_ALL(X0, X1, DL) do { float dc_ = (DL); BIAS_GEN4(X0, 0, dc_); BIAS_GEN4(X0, 4, dc_); BIAS_GEN4(X0, 8, dc_); BIAS_GEN4(X0, 12, dc_); BIAS_GEN4(X1, 0, dc_); BIAS_GEN4(X1, 4, dc_); BIAS_GEN4(X1, 8, dc_); BIAS_GEN4(X1, 12, dc_); } while (0)
#ifdef BIAS_CONST
    float cst[32];
#pragma unroll
    for (int e = 0; e < 32; ++e) { float cv_ = c2 * (float)(8 * (e >> 2) + (e & 3)); asm volatile("" : "+v"(cv_)); cst[e] = __builtin_bit_cast(float, __builtin_amdgcn_readfirstlane(__builtin_bit_cast(int, cv_))); }
#define BIAS_STEP_SETUP() const float base_ = __builtin_fmaf(sc1_, dcn_, negM2); float sgn_ = above_ ? -1.0f : 1.0f; asm volatile("" : "+v"(sgn_))
#else
#define BIAS_STEP_SETUP() do {} while (0)
#endif
    f32x16 pA0, pA1, pB0, pB1;
    bf16x8 kf[8], vf[4]; u32x4 pw0, pw1, pw2, pw3;
    int ks_prev = 0, ks_cur = 0, ks_next = KSLOT, vs_prev = 0, vs_cur = VSLOT, vs_next = 2 * VSLOT, vs_n2 = 3 * VSLOT;
#define ROTK() do { ks_prev = ks_cur; ks_cur = ks_next; ks_next = (ks_next == 2 * KSLOT) ? 0 : ks_next + KSLOT; } while (0)
#define ROT() do { ROTK(); const int tv_ = vs_prev; vs_prev = vs_cur; vs_cur = vs_next; vs_next = vs_n2; vs_n2 = tv_; } while (0)
    DMA_K(2, 2 * KSLOT);
    WB_SEL(2 * NV + 2 * NK);
    if (ISB) { BIAS_ALL(pA0, pA1, dl0); } else { pA0 = negm; pA1 = negm; }
    {
        const ALAS char* kp = kp0;
#pragma unroll
        for (int d0 = 0; d0 < 4; ++d0) { const bf16x8 b0 = *(const ALAS bf16x8*)(kp + d0 * 2048), b1 = *(const ALAS bf16x8*)(kp + d0 * 2048 + 512);
            pA0 = ATT_MFMA(b0, qr[d0], pA0); pA1 = ATT_MFMA(b1, qr[d0], pA1); }
#pragma unroll
        for (int r = 0; r < 16; ++r) { pA0[r] = EX(pA0[r]); pA1[r] = EX(pA1[r]); }
    }
    WB_SEL(0);
    DMA_K(3, 0); DMA_V(2, 2 * VSLOT);
    ROTK();
#define KLOAD2(base, j) do { kf[2 * (j)] = *(const ALAS bf16x8*)((base) + (j) * 2048); kf[2 * (j) + 1] = *(const ALAS bf16x8*)((base) + (j) * 2048 + 512); } while (0)
    { const ALAS char* kb_ = kp0 + ks_cur; KLOAD2(kb_, 0); KLOAD2(kb_, 1); KLOAD2(kb_, 2); KLOAD2(kb_, 3); }
    if (ISB) { BIAS_ALL(pB0, pB1, dl0 + 64.f); }
    WB_SEL(NK + NV);
#define PAF(k) __builtin_bit_cast(bf16x8, pw##k)
#define GAPA(MF, A0, A1, A2, A3, W0, W1, PW) do { MF; if (ISB) { sacc += A0; sacc += A1; sacc += A2; sacc += A3; PIN(sacc); } W0; W1; PIN(PW); SBAR(); } while (0)
#define GAPB(MF, X, B) do { MF; X[B] = EX(X[B]); X[(B) + 1] = EX(X[(B) + 1]); X[(B) + 2] = EX(X[(B) + 2]); X[(B) + 3] = EX(X[(B) + 3]); PIN(X); SBAR(); } while (0)
#define GAPX(MF, EXS, X) do { MF; EXS; PIN(X); SBAR(); } while (0)
#define EXE(C0, C1, k) do { if ((k) < 16) C0[(k) & 15] = EX(C0[(k) & 15]); else C1[(k) & 15] = EX(C1[(k) & 15]); } while (0)
#define EXN(C0, C1, k, N) do { EXE(C0, C1, k); if ((N) > 1) EXE(C0, C1, (k) + 1); if ((N) > 2) EXE(C0, C1, (k) + 2); } while (0)
#define GAPEN(MF, C0, C1, k, N) do { MF; EXN(C0, C1, k, N); PIN(C0); PIN(C1); SBAR(); } while (0)
#define GAPE3(MF, C0, C1, k) do { MF; EXE(C0, C1, k); EXE(C0, C1, (k) + 1); EXE(C0, C1, (k) + 2); PIN(C0); PIN(C1); SBAR(); } while (0)
#ifdef BIAS_CONST
#define GAPC(MF, G, X, B, E0) do { MF; if (G) { { float a0_ = __builtin_fmaf(sgn_, cst[(E0) + (B)], base_), a1_ = __builtin_fmaf(sgn_, cst[(E0) + (B) + 1], base_), a2_ = __builtin_fmaf(sgn_, cst[(E0) + (B) + 2], base_), a3_ = __builtin_fmaf(sgn_, cst[(E0) + (B) + 3], base_); asm volatile("" : "+v"(a0_), "+v"(a1_), "+v"(a2_), "+v"(a3_)); X[B] = a0_; X[(B) + 1] = a1_; X[(B) + 2] = a2_; X[(B) + 3] = a3_; } \
        if (__builtin_expect(!fastb_, 0)) { float dg_ = dcn_ + (float)(8 * (((E0) + (B)) >> 2)); BIAS_GEN4(X, B, dg_); } PIN(X); } SBAR(); } while (0)
#else
#define GAPC(MF, G, X, B, E0) do { MF; if (G) { BIAS_FAST4(X, B, dcn_); if (__builtin_expect(!fastb_, 0)) { float dg_ = dcn_ - 8.0f; BIAS_GEN4(X, B, dg_); } PIN(X); } SBAR(); } while (0)
#endif
#define VRD(i) do { vf[i] = *(const ALAS bf16x8*)(vp_ + ((i) & 3) * (DV * 32) + ((i) >> 2) * 512); } while (0)
#define VRDN(i, d) do { vf[i] = *(const ALAS bf16x8*)(vp_ + (i) * (DV * 32) + (d) * 512); } while (0)
#define VRDA(i) do { vf[i] = *(const ALAS bf16x8*)(vp_ + (i) * (DV * 32) + 512); } while (0)
#define VRD2(i) do { vf[i] = *(const ALAS bf16x8*)(vp_ + ((i) & 3) * (DV * 32) + (((i) >> 2) + 2) * 512); } while (0)
#define KRD(G, j) do { if (G) { KLOAD2(kn_, j); SBAR(); } } while (0)
#define KRD1(G, j) do { if (G) { kf[j] = *(const ALAS bf16x8*)(kn_ + ((j) >> 1) * 2048 + ((j) & 1) * 512); SBAR(); } } while (0)
#define CIN(C) (ISB ? C : negm)
#define STEP(C0, C1, P0, P1, i, GK, GV, GL) do { SBAR(); \
    const ALAS char* vp_ = vp0 + vs_prev; const ALAS char* kn_ = kp0 + ks_next; float dcn_ = dl0 + 64.f * (float)((i) + 1); const int kt_ = 64 * (t0 + (i) + 1); const bool above_ = kt_ > qw_hi, fastb_ = above_ || (kt_ + 63 < qw_lo); \
    const float sc1_ = above_ ? nc2 : c2, sc2_ = sc1_ + sc1_, sc3_ = sc2_ + sc1_; BIAS_STEP_SETUP(); \
    VRD(0); SBAR(); float sacc = P0[0] + P0[1]; \
    GAPA(C0 = ATT_MFMA(kf[0], qr[0], CIN(C0)), P0[2], P0[3], P0[4], P0[5],     pw0[0] = PKW(P0, 0), pw0[1] = PKW(P0, 2), pw0); \
    SBAR(); GAPA(C1 = ATT_MFMA(kf[1], qr[0], CIN(C1)), P0[6], P0[7], P0[8], P0[9],     pw0[2] = PKW(P0, 4), pw0[3] = PKW(P0, 6), pw0); \
    VRD(1); SBAR(); GAPA(C0 = ATT_MFMA(kf[2], qr[1], C0),   P0[10], P0[11], P0[12], P0[13], pw1[0] = PKW(P0, 8), pw1[1] = PKW(P0, 10), pw1); \
    SBAR(); GAPA(C1 = ATT_MFMA(kf[3], qr[1], C1),   P0[14], P0[15], P1[0], P1[1],   pw1[2] = PKW(P0, 12), pw1[3] = PKW(P0, 14), pw1); \
    VRD(2); SBAR(); GAPA(C0 = ATT_MFMA(kf[4], qr[2], C0),   P1[2], P1[3], P1[4], P1[5],     pw2[0] = PKW(P1, 0), pw2[1] = PKW(P1, 2), pw2); \
    SBAR(); GAPA(C1 = ATT_MFMA(kf[5], qr[2], C1),   P1[6], P1[7], P1[8], P1[9],     pw2[2] = PKW(P1, 4), pw2[3] = PKW(P1, 6), pw2); \
    VRD(3); SBAR(); GAPA(C0 = ATT_MFMA(kf[6], qr[3], C0),   P1[10], P1[11], P1[12], P1[13], pw3[0] = PKW(P1, 8), pw3[1] = PKW(P1, 10), pw3); \
    SBAR(); GAPA(C1 = ATT_MFMA(kf[7], qr[3], C1),   P1[14], P1[15], 0.f, 0.f,       pw3[2] = PKW(P1, 12), pw3[3] = PKW(P1, 14), pw3); \
    l_reg += sacc; \
    if (BDMA_MODE < 4) { if (GK) { DMA_K((i) + 3, ks_cur); } } if (BDMA_MODE == 0 || BDMA_MODE == 4) { if (GV) { DMA_V((i) + 2, vs_n2); } } \
    SBAR(); \
    if (!ISB) { \
        GAPX(o[0] = ATT_MFMA(PAF(0), vf[0], o[0]), C0[0] = EX(C0[0]); C0[1] = EX(C0[1]); C0[2] = EX(C0[2]), C0); \
        VRDA(0); SBAR(); GAPX(o[0] = ATT_MFMA(PAF(1), vf[1], o[0]), C0[3] = EX(C0[3]); C0[4] = EX(C0[4]); C0[5] = EX(C0[5]), C0); \
        VRDA(1); SBAR(); GAPX(osum = ATT_MFMA(PAF(0), ones, osum),  C0[6] = EX(C0[6]); C0[7] = EX(C0[7]); C0[8] = EX(C0[8]), C0); \
        GAPX(o[0] = ATT_MFMA(PAF(2), vf[2], o[0]), C0[9] = EX(C0[9]); C0[10] = EX(C0[10]); C0[11] = EX(C0[11]), C0); \
        VRDA(2); SBAR(); GAPX(o[0] = ATT_MFMA(PAF(3), vf[3], o[0]), C0[12] = EX(C0[12]); C0[13] = EX(C0[13]); C0[14] = EX(C0[14]), C0); \
        VRDA(3); SBAR(); GAPX(osum = ATT_MFMA(PAF(1), ones, osum),  C0[15] = EX(C0[15]); C1[0] = EX(C1[0]); C1[1] = EX(C1[1]), C1); PIN(C0); \
        KRD(GL, 0); GAPX(o[1] = ATT_MFMA(PAF(0), vf[0], o[1]), C1[2] = EX(C1[2]); C1[3] = EX(C1[3]); C1[4] = EX(C1[4]), C1); \
        KRD(GL, 1); GAPX(o[1] = ATT_MFMA(PAF(1), vf[1], o[1]), C1[5] = EX(C1[5]); C1[6] = EX(C1[6]); C1[7] = EX(C1[7]), C1); \
        KRD(GL, 2); GAPX(osum = ATT_MFMA(PAF(2), ones, osum),  C1[8] = EX(C1[8]); C1[9] = EX(C1[9]); C1[10] = EX(C1[10]), C1); \
        KRD(GL, 3); GAPX(o[1] = ATT_MFMA(PAF(2), vf[2], o[1]), C1[11] = EX(C1[11]); C1[12] = EX(C1[12]), C1); \
        GAPX(o[1] = ATT_MFMA(PAF(3), vf[3], o[1]), C1[13] = EX(C1[13]); C1[14] = EX(C1[14]), C1); \
        GAPX(osum = ATT_MFMA(PAF(3), ones, osum),  C1[15] = EX(C1[15]), C1); \
    } else { \
        GAPEN(o[0] = ATT_MFMA(PAF(0), vf[0], o[0]), C0, C1, 0, 3);  VRDN(0, 1); KRD1(GL, 0); SBAR(); \
        GAPEN(o[0] = ATT_MFMA(PAF(1), vf[1], o[0]), C0, C1, 3, 2);  VRDN(1, 1); KRD1(GL, 1); SBAR(); \
        GAPEN(o[0] = ATT_MFMA(PAF(2), vf[2], o[0]), C0, C1, 5, 3);  VRDN(2, 1); KRD1(GL, 2); SBAR(); \
        GAPEN(o[0] = ATT_MFMA(PAF(3), vf[3], o[0]), C0, C1, 8, 2);  VRDN(3, 1); KRD1(GL, 3); SBAR(); \
        if (BDMA_MODE == 2) { if (GV) { DMA_V((i) + 2, vs_n2); } SBAR(); } \
        GAPEN(o[1] = ATT_MFMA(PAF(0), vf[0], o[1]), C0, C1, 10, 3); VRDN(0, 2); KRD1(GL, 4); SBAR(); \
        GAPEN(o[1] = ATT_MFMA(PAF(1), vf[1], o[1]), C0, C1, 13, 2); VRDN(1, 2); KRD1(GL, 5); SBAR(); \
        GAPEN(o[1] = ATT_MFMA(PAF(2), vf[2], o[1]), C0, C1, 15, 3); VRDN(2, 2); KRD1(GL, 6); SBAR(); \
        GAPEN(o[1] = ATT_MFMA(PAF(3), vf[3], o[1]), C0, C1, 18, 2); VRDN(3, 2); KRD1(GL, 7); SBAR(); \
        if (BDMA_MODE == 1 || BDMA_MODE == 5) { if (GV) { DMA_V((i) + 2, vs_n2); } SBAR(); } if (BDMA_MODE == 4 || BDMA_MODE == 5) { if (GK) { DMA_K((i) + 3, ks_cur); } SBAR(); } \
        GAPC(o[ND0 - 2] = ATT_MFMA(PAF(0), vf[0], o[ND0 - 2]); EXN(C0, C1, 20, 2), GL, P0, 0, 0);  VRDN(0, 3); SBAR(); \
        GAPC(o[ND0 - 2] = ATT_MFMA(PAF(1), vf[1], o[ND0 - 2]); EXN(C0, C1, 22, 1), GL, P0, 4, 0);  VRDN(1, 3); SBAR(); \
        GAPC(o[ND0 - 2] = ATT_MFMA(PAF(2), vf[2], o[ND0 - 2]); EXN(C0, C1, 23, 2), GL, P0, 8, 0);  VRDN(2, 3); SBAR(); \
        GAPC(o[ND0 - 2] = ATT_MFMA(PAF(3), vf[3], o[ND0 - 2]); EXN(C0, C1, 25, 1), GL, P0, 12, 0); VRDN(3, 3); SBAR(); \
        GAPC(o[ND0 - 1] = ATT_MFMA(PAF(0), vf[0], o[ND0 - 1]); EXN(C0, C1, 26, 2), GL, P1, 0, 16); \
        GAPC(o[ND0 - 1] = ATT_MFMA(PAF(1), vf[1], o[ND0 - 1]); EXN(C0, C1, 28, 1), GL, P1, 4, 16); \
        GAPC(o[ND0 - 1] = ATT_MFMA(PAF(2), vf[2], o[ND0 - 1]); EXN(C0, C1, 29, 2), GL, P1, 8, 16); \
        GAPC(o[ND0 - 1] = ATT_MFMA(PAF(3), vf[3], o[ND0 - 1]); EXN(C0, C1, 31, 1); PIN(C1), GL, P1, 12, 16); \
        if (BDMA_MODE == 3) { if (GV) { DMA_V((i) + 2, vs_n2); } SBAR(); } \
    } } while (0)
    int i = 1;
    for (; i + 5 < n; i += 2) {
        STEP(pB0, pB1, pA0, pA1, i, true, true, true);     WB_SEL(NK + 2 * NV); ROT();
        STEP(pA0, pA1, pB0, pB1, i + 1, true, true, true); WB_SEL(NK + 2 * NV); ROT();
    }
#define ENDW(ii) do { if ((ii) + 3 < n) { WB_SEL(NK + 2 * NV); } else if ((ii) + 2 < n) { WB_SEL(2 * NV); } else { WB_SEL(0); } } while (0)
    for (; i + 1 < n; i += 2) {
        STEP(pB0, pB1, pA0, pA1, i, (i + 3 < n), (i + 2 < n), (i + 1 < n));         ENDW(i);     ROT();
        STEP(pA0, pA1, pB0, pB1, i + 1, (i + 4 < n), (i + 3 < n), (i + 2 < n));     ENDW(i + 1); ROT();
    }
    STEP(pB0, pB1, pA0, pA1, n - 1, false, false, false);
    { if (ISB) { float sacc = pB0[0] + pB0[1];
#pragma unroll
      for (int r = 2; r < 16; ++r) sacc += pB0[r];
#pragma unroll
      for (int r = 0; r < 16; ++r) sacc += pB1[r];
      l_reg += sacc; }
      pw0 = (u32x4){PKW(pB0, 0), PKW(pB0, 2), PKW(pB0, 4), PKW(pB0, 6)}; pw1 = (u32x4){PKW(pB0, 8), PKW(pB0, 10), PKW(pB0, 12), PKW(pB0, 14)};
      pw2 = (u32x4){PKW(pB1, 0), PKW(pB1, 2), PKW(pB1, 4), PKW(pB1, 6)}; pw3 = (u32x4){PKW(pB1, 8), PKW(pB1, 10), PKW(pB1, 12), PKW(pB1, 14)};
      SBAR();
      const ALAS char* vp_ = vp0 + vs_cur;
#pragma unroll
      for (int d = 0; d < ND0; ++d) {
          const bf16x8 v0 = *(const ALAS bf16x8*)(vp_ + 0 * (DV * 32) + d * 512), v1 = *(const ALAS bf16x8*)(vp_ + 1 * (DV * 32) + d * 512), v2 = *(const ALAS bf16x8*)(vp_ + 2 * (DV * 32) + d * 512), v3 = *(const ALAS bf16x8*)(vp_ + 3 * (DV * 32) + d * 512);
          o[d] = ATT_MFMA(PAF(0), v0, o[d]); o[d] = ATT_MFMA(PAF(1), v1, o[d]); o[d] = ATT_MFMA(PAF(2), v2, o[d]); o[d] = ATT_MFMA(PAF(3), v3, o[d]); }
      if (!ISB) { osum = ATT_MFMA(PAF(0), ones, osum); osum = ATT_MFMA(PAF(1), ones, osum); osum = ATT_MFMA(PAF(2), ones, osum); osum = ATT_MFMA(PAF(3), ones, osum); } }
    const float sacc = l_reg;
    const int lane_e = lane_id_v();
    ATT_WAIT_BAR(0);
    {
    const int lane = lane_e, r32 = lane & 31, hi = lane >> 5; const int q0 = ISB ? qb * 128 : qb * 256;
    float rli[16];
    ALAS float* wsf = (ALAS float*)(shm3 + WSF_OFF) + wid * 64;
    if (ISB) {
        const float l = sum_x32(sacc);
        if (hi == 0) wsf[r32] = l;
        asm volatile("s_waitcnt lgkmcnt(0)" ::: "memory");
#pragma unroll
        for (int r = 0; r < 16; ++r) rli[r] = __builtin_amdgcn_rcpf(wsf[crow(r, hi)]);
    } else {
#pragma unroll
        for (int r = 0; r < 16; ++r) rli[r] = __builtin_amdgcn_rcpf(osum[r]);
    }
    if (!ISB) {
        ALAS bf16_t* stg = (ALAS bf16_t*)shm3 + wid * 2048;
#pragma unroll
        for (int r = 0; r < 16; ++r) { const int orow = crow(r, hi);
#pragma unroll
            for (int d = 0; d < ND0; ++d) stg[orow * 64 + d * 32 + r32] = pg8::f2bf1(o[d][r] * rli[r]); }
        asm volatile("s_waitcnt lgkmcnt(0)" ::: "memory");
#pragma unroll
        for (int i = 0; i < 4; ++i) { const int row = i * 8 + (lane >> 3), ch = lane & 7; const u32x4 v = *(const ALAS u32x4*)(stg + row * 64 + ch * 8);
            *(u32x4*)(T_MIX + (size_t)(q0 + wid * 32 + row) * 1024 + head * 64 + ch * 8) = v; }
    } else {
        ALAS float* X = (ALAS float*)shm3 + wq * 4096;
        const float sc = (mapc == 1) ? lam : 1.0f;
        if (mapc == 1) {
#pragma unroll
            for (int r = 0; r < 16; ++r) { const int orow = crow(r, hi); const float f = rli[r] * sc;
#pragma unroll
                for (int d = 0; d < ND0; ++d) X[orow * 128 + d * 32 + r32] = o[d][r] * f; }
        }
        asm volatile("s_waitcnt lgkmcnt(0)\n\ts_barrier" ::: "memory");
        if (mapc == 0) {
#pragma unroll
            for (int r = 0; r < 16; ++r) { const int orow = crow(r, hi);
#pragma unroll
                for (int d = 0; d < ND0; ++d) { const int idx = orow * 128 + d * 32 + r32; X[idx] = o[d][r] * rli[r] - X[idx]; } }
            asm volatile("s_waitcnt lgkmcnt(0)" ::: "memory");
            const int qq = lane >> 1, hf = lane & 1;
            const ALAS float* rowp = X + qq * 128 + hf * 64;
            f32x4 vv[16]; float ss = 0.f;
#pragma unroll
            for (int i = 0; i < 16; ++i) { vv[i] = *(const ALAS f32x4*)(rowp + 4 * i); ss += (vv[i][0] * vv[i][0] + vv[i][1] * vv[i][1]) + (vv[i][2] * vv[i][2] + vv[i][3] * vv[i][3]); }
            ss += xor_lane<1>(ss);
            const float rs = 0.8f / sqrtf(ss * (1.0f / 128.0f) + 1e-6f);
            bf16_t* dst = T_MIX + (size_t)(q0 + wq * 32 + qq) * 1024 + 512 + head * 128 + hf * 64;
            const ALAS float* sl = T.subln + hf * 64;
#pragma unroll
            for (int i = 0; i < 8; ++i) { const f32x4 g0 = *(const ALAS f32x4*)(sl + 8 * i), g1 = *(const ALAS f32x4*)(sl + 8 * i + 4); const f32x4 a = vv[2 * i] * rs * g0, b = vv[2 * i + 1] * rs * g1;
                u32x4 w; w.x = cvtpk(a[0], a[1]); w.y = cvtpk(a[2], a[3]); w.z = cvtpk(b[0], b[1]); w.w = cvtpk(b[2], b[3]); *(u32x4*)(dst + 8 * i) = w; }
        }
    }
    }
    asm volatile("s_waitcnt lgkmcnt(0)\n\ts_barrier" ::: "memory");
#undef DMA_K
#undef DMA_V
#undef ROT
#undef STEP
#undef ENDW
#undef GAPA
#undef GAPB
#undef GAPC
#undef GAPE3
#undef GAPEN
#undef EXN
#undef EXE
#undef GAPX
#undef VRD
#undef VRD2
#undef VRDA
#undef VRDN
#undef KRD
#undef KRD1
#undef CIN
#undef PAF
#undef KLOAD2
#undef BIAS_GEN4
#undef BIAS_FAST4
#undef BIAS_ALL
#undef BIAS_STEP_SETUP
}

typedef int i32x8 __attribute__((ext_vector_type(8)));
typedef unsigned u32x8 __attribute__((ext_vector_type(8)));
#define MFMA8(a, b, c) __builtin_amdgcn_mfma_scale_f32_32x32x64_f8f6f4(a, b, c, 0, 0, 0, 0, 0, 0)
__device__ __forceinline__ void attn_unit_a8(const Tensors& T, int head, int qb, float negM2s, char* shm, int wave_id) {
    unsigned char* tws_ = T.ws; LAUNDER_G(tws_);
    constexpr int KSLOT = 4096, VSLOT = 4096, LDS_K = 0, LDS_V = 3 * KSLOT, n = 256;
    int tid_ = wave_id * 64 + lane_id_v(); asm volatile("" : "+v"(tid_));
    const int tid = tid_, lane = tid & 63, r32 = lane & 31, hi = lane >> 5; const int wid = __builtin_amdgcn_readfirstlane(tid >> 6);
    const int q0 = qb * 256; const int qrow = q0 + wid * 32 + r32;
    const unsigned lds0 = (unsigned)(uintptr_t)shm;
    const ALAS char* shm3 = (const ALAS char*)shm;
    const bool kw = wid < 4;
    const char* sb = (const char*)(tws_ + (kw ? WS_KA : WS_VA)) + (size_t)(head >> 2) * MROWS * 64 + (wid & 3) * 1024;
    const unsigned dvo = (unsigned)(lane * 16);
    const unsigned ddst = lds0 + (kw ? LDS_K : LDS_V) + (wid & 3) * 1024;
#define DMA8(i, so) glds16s(sb + (size_t)(i) * 4096, dvo, (unsigned)__builtin_amdgcn_readfirstlane(ddst + (so)))
#define WB8(NKW, NVW) do { if (kw) { WB_SEL(NKW); } else { WB_SEL(NVW); } } while (0)
    if (kw) { DMA8(0, 0); DMA8(1, KSLOT); DMA8(2, 2 * KSLOT); } else { DMA8(0, 0); DMA8(1, VSLOT); }
    const unsigned char* Qw = (tws_ + WS_QA) + ((size_t)head * MROWS + qrow) * 64 + hi * 32;
    i32x8 qf; { const u32x4 a_ = *(const u32x4*)Qw, b_ = *(const u32x4*)(Qw + 16); qf = (i32x8){(int)a_[0], (int)a_[1], (int)a_[2], (int)a_[3], (int)b_[0], (int)b_[1], (int)b_[2], (int)b_[3]}; }
    f32x16 o0 = f32x16{}, o1 = f32x16{}, osum = f32x16{};
    f32x16 negm;
#pragma unroll
    for (int r = 0; r < 16; ++r) negm[r] = negM2s;
    asm volatile("" : "+v"(negm));
    i32x8 ones; { const int o4 = 0x38383838; ones = (i32x8){o4, o4, o4, o4, o4, o4, o4, o4}; } asm volatile("" : "+v"(ones));
    const ALAS char* kp0 = shm3 + LDS_K + hi * 1024 + r32 * 16;
    const ALAS char* vp0 = shm3 + LDS_V + hi * 1024 + r32 * 16;
    f32x16 pA0, pA1, pB0, pB1;
    i32x8 kf0, kf1, vf0, vf1, pf = (i32x8){0, 0, 0, 0, 0, 0, 0, 0};
    int ks_prev = 0, ks_cur = 0, ks_next = KSLOT, vs_prev = 0, vs_cur = VSLOT, vs_next = 2 * VSLOT, vs_n2 = 3 * VSLOT;
#define ROTK8() do { ks_prev = ks_cur; ks_cur = ks_next; ks_next = (ks_next == 2 * KSLOT) ? 0 : ks_next + KSLOT; } while (0)
#define ROT8() do { ROTK8(); const int tv_ = vs_prev; vs_prev = vs_cur; vs_cur = vs_next; vs_next = vs_n2; vs_n2 = tv_; } while (0)
#define LD32(dst, p) do { const u32x4 a_ = *(const ALAS u32x4*)(p), b_ = *(const ALAS u32x4*)((p) + 512); dst = (i32x8){(int)a_[0], (int)a_[1], (int)a_[2], (int)a_[3], (int)b_[0], (int)b_[1], (int)b_[2], (int)b_[3]}; } while (0)
#define PK8(P, B, OLD) __builtin_amdgcn_cvt_pk_fp8_f32(P[(B) + 2], P[(B) + 3], __builtin_amdgcn_cvt_pk_fp8_f32(P[B], P[(B) + 1], OLD, false), true)
    WB8(2, 2);
    { LD32(kf0, kp0); LD32(kf1, kp0 + 2048);
      pA0 = MFMA8(kf0, qf, negm); pA1 = MFMA8(kf1, qf, negm);
#pragma unroll
      for (int r = 0; r < 16; ++r) { pA0[r] = EX(pA0[r]); pA1[r] = EX(pA1[r]); } }
    WB_SEL(0);
    if (kw) { DMA8(3, 0); } else { DMA8(2, 2 * VSLOT); }
    ROTK8();
    { const ALAS char* kb_ = kp0 + ks_cur; LD32(kf0, kb_); LD32(kf1, kb_ + 2048); }
    WB_SEL(1);
#define STEP8(C0, C1, P0, P1, i, GK, GV, GL) do { SBAR(); \
    const ALAS char* vp_ = vp0 + vs_prev; const ALAS char* kn_ = kp0 + ks_next; \
    LD32(vf0, vp_); LD32(vf1, vp_ + 2048); SBAR(); \
    C0 = MFMA8(kf0, qf, negm); \
    pf[0] = PK8(P0, 0, pf[0]); pf[1] = PK8(P0, 4, pf[1]); pf[2] = PK8(P0, 8, pf[2]); pf[3] = PK8(P0, 12, pf[3]); PIN(pf); SBAR(); \
    C1 = MFMA8(kf1, qf, negm); \
    pf[4] = PK8(P1, 0, pf[4]); pf[5] = PK8(P1, 4, pf[5]); pf[6] = PK8(P1, 8, pf[6]); pf[7] = PK8(P1, 12, pf[7]); PIN(pf); SBAR(); \
    if (kw) { if (GK) { DMA8((i) + 3, ks_cur); } } else { if (GV) { DMA8((i) + 2, vs_n2); } } \
    SBAR(); \
    o0 = MFMA8(pf, vf0, o0); \
    _Pragma("unroll") for (int r_ = 0; r_ < 16; ++r_) C0[r_] = EX(C0[r_]); PIN(C0); SBAR(); \
    if (GL) { LD32(kf0, kn_); LD32(kf1, kn_ + 2048); SBAR(); } \
    o1 = MFMA8(pf, vf1, o1); \
    _Pragma("unroll") for (int r_ = 0; r_ < 8; ++r_) C1[r_] = EX(C1[r_]); PIN(C1); SBAR(); \
    osum = MFMA8(pf, ones, osum); \
    _Pragma("unroll") for (int r_ = 8; r_ < 16; ++r_) C1[r_] = EX(C1[r_]); PIN(C1); SBAR(); \
    } while (0)
    int i = 1;
    for (; i + 5 < n; i += 2) {
        STEP8(pB0, pB1, pA0, pA1, i, true, true, true);     WB8(1, 2); ROT8();
        STEP8(pA0, pA1, pB0, pB1, i + 1, true, true, true); WB8(1, 2); ROT8();
    }
#define ENDW8(ii) do { if ((ii) + 3 < n) { WB8(1, 2); } else if ((ii) + 2 < n) { WB8(0, 2); } else { WB_SEL(0); } } while (0)
    for (; i + 1 < n; i += 2) {
        STEP8(pB0, pB1, pA0, pA1, i, (i + 3 < n), (i + 2 < n), (i + 1 < n));         ENDW8(i);     ROT8();
        STEP8(pA0, pA1, pB0, pB1, i + 1, (i + 4 < n), (i + 3 < n), (i + 2 < n));     ENDW8(i + 1); ROT8();
    }
    STEP8(pB0, pB1, pA0, pA1, n - 1, false, false, false);
    { pf[0] = PK8(pB0, 0, pf[0]); pf[1] = PK8(pB0, 4, pf[1]); pf[2] = PK8(pB0, 8, pf[2]); pf[3] = PK8(pB0, 12, pf[3]); pf[4] = PK8(pB1, 0, pf[4]); pf[5] = PK8(pB1, 4, pf[5]); pf[6] = PK8(pB1, 8, pf[6]); pf[7] = PK8(pB1, 12, pf[7]);
      const ALAS char* vp_ = vp0 + vs_cur; LD32(vf0, vp_); LD32(vf1, vp_ + 2048);
      o0 = MFMA8(pf, vf0, o0); o1 = MFMA8(pf, vf1, o1); osum = MFMA8(pf, ones, osum); }
    ATT_WAIT_BAR(0);
    {
        const int lane_e = lane_id_v(), l32 = lane_e & 31, hh = lane_e >> 5;
        ALAS bf16_t* stg = (ALAS bf16_t*)shm3 + wid * 2048;
#pragma unroll
        for (int r = 0; r < 16; ++r) { const int orow = crow(r, hh); const float rl = __builtin_amdgcn_rcpf(osum[r]);
            stg[orow * 64 + l32] = pg8::f2bf1(o0[r] * rl); stg[orow * 64 + 32 + l32] = pg8::f2bf1(o1[r] * rl); }
        asm volatile("s_waitcnt lgkmcnt(0)" ::: "memory");
#pragma unroll
        for (int i2 = 0; i2 < 4; ++i2) { const int row = i2 * 8 + (lane_e >> 3), ch = lane_e & 7; const u32x4 v = *(const ALAS u32x4*)(stg + row * 64 + ch * 8);
            *(u32x4*)(T_MIX + (size_t)(qb * 256 + wid * 32 + row) * 1024 + head * 64 + ch * 8) = v; }
    }
    asm volatile("s_waitcnt lgkmcnt(0)\n\ts_barrier" ::: "memory");
#undef DMA8
#undef EXPBLK
#undef PACK8
#undef WB8
#undef ROTK8
#undef ROT8
#undef LD32
#undef PK8
#undef STEP8
#undef ENDW8
}

typedef short v2i16_t __attribute__((ext_vector_type(2)));
template<int U>
__device__ __forceinline__ void attn_unit_a8x2(const Tensors& T, int head, int qb, float negM2s, char* shm, int wave_id) {
    unsigned char* tws_ = T.ws; LAUNDER_G(tws_);
    constexpr int KSLOT = 4096, VSLOT = 4096, RS = 3 * U * 4096, LDS_K = 0, LDS_V = RS, n = 256;
    int tid_ = wave_id * 64 + lane_id_v(); asm volatile("" : "+v"(tid_));
    const int tid = tid_, lane = tid & 63, r32 = lane & 31, hi = lane >> 5; const int wid = __builtin_amdgcn_readfirstlane(tid >> 6);
    const int q0 = qb * 512; const int qrow = q0 + wid * 64 + r32;
    const unsigned lds0 = (unsigned)(uintptr_t)shm;
    const ALAS char* shm3 = (const ALAS char*)shm;
    const bool kw = wid < 4;
    const char* sb = (const char*)(tws_ + (kw ? WS_KA : WS_VA)) + (size_t)(head >> 2) * MROWS * 64 + (wid & 3) * 1024;
    const unsigned dvo = (unsigned)(lane * 16);
    const unsigned ddst = lds0 + (kw ? LDS_K : LDS_V) + (wid & 3) * 1024;
#define DMA8(i, so) glds16s(sb + (size_t)(i) * 4096, dvo, (unsigned)__builtin_amdgcn_readfirstlane(ddst + (so)))
#pragma unroll
    for (int i0 = 0; i0 < 2 * U; ++i0) DMA8(i0, i0 * 4096);
    if (kw) DMA8(2 * U, 2 * U * 4096);
    const unsigned char* Qw = (tws_ + WS_QA) + ((size_t)head * MROWS + qrow) * 64 + hi * 32;
    i32x8 qfa, qfb;
    { const u32x4 a_ = *(const u32x4*)Qw, b_ = *(const u32x4*)(Qw + 16); qfa = (i32x8){(int)a_[0], (int)a_[1], (int)a_[2], (int)a_[3], (int)b_[0], (int)b_[1], (int)b_[2], (int)b_[3]}; }
    { const u32x4 a_ = *(const u32x4*)(Qw + 32 * 64), b_ = *(const u32x4*)(Qw + 32 * 64 + 16); qfb = (i32x8){(int)a_[0], (int)a_[1], (int)a_[2], (int)a_[3], (int)b_[0], (int)b_[1], (int)b_[2], (int)b_[3]}; }
    f32x16 oa0 = f32x16{}, oa1 = f32x16{}, osa = f32x16{}, ob0 = f32x16{}, ob1 = f32x16{}, osb = f32x16{};
    f32x16 negm;
#pragma unroll
    for (int r = 0; r < 16; ++r) negm[r] = negM2s;
    asm volatile("" : "+v"(negm));
    i32x8 ones; { const int o4 = 0x38383838; ones = (i32x8){o4, o4, o4, o4, o4, o4, o4, o4}; } asm volatile("" : "+v"(ones));
    const ALAS char* kp0 = shm3 + LDS_K + hi * 1024 + r32 * 16;
    const ALAS char* vp0 = shm3 + LDS_V + hi * 1024 + r32 * 16;
    f32x16 Ca0, Ca1, Cb0, Cb1;
#ifdef A8_EXPH
#define EXPBLK(H, C, b) do { const unsigned h0_ = __builtin_bit_cast(unsigned, __builtin_amdgcn_cvt_pkrtz(C[b], C[(b) + 1])), h1_ = __builtin_bit_cast(unsigned, __builtin_amdgcn_cvt_pkrtz(C[(b) + 2], C[(b) + 3])), \
        h2_ = __builtin_bit_cast(unsigned, __builtin_amdgcn_cvt_pkrtz(C[(b) + 4], C[(b) + 5])), h3_ = __builtin_bit_cast(unsigned, __builtin_amdgcn_cvt_pkrtz(C[(b) + 6], C[(b) + 7])); unsigned d0_, d1_, d2_, d3_; \
        asm volatile("v_exp_f16_e32 %0, %4\n\tv_exp_f16_e32 %1, %5\n\tv_exp_f16_e32 %2, %6\n\tv_exp_f16_e32 %3, %7\n\t" \
                     "v_exp_f16_sdwa %0, %4 dst_sel:WORD_1 dst_unused:UNUSED_PRESERVE src0_sel:WORD_1\n\tv_exp_f16_sdwa %1, %5 dst_sel:WORD_1 dst_unused:UNUSED_PRESERVE src0_sel:WORD_1\n\t" \
                     "v_exp_f16_sdwa %2, %6 dst_sel:WORD_1 dst_unused:UNUSED_PRESERVE src0_sel:WORD_1\n\tv_exp_f16_sdwa %3, %7 dst_sel:WORD_1 dst_unused:UNUSED_PRESERVE src0_sel:WORD_1" \
                     : "=&v"(d0_), "=&v"(d1_), "=&v"(d2_), "=&v"(d3_) : "v"(h0_), "v"(h1_), "v"(h2_), "v"(h3_)); \
        C[(b) / 2] = __builtin_bit_cast(float, d0_); C[(b) / 2 + 1] = __builtin_bit_cast(float, d1_); C[(b) / 2 + 2] = __builtin_bit_cast(float, d2_); C[(b) / 2 + 3] = __builtin_bit_cast(float, d3_); PIN(C); } while (0)
#define PKH(C, j) (int)__builtin_amdgcn_perm(__builtin_bit_cast(unsigned, C[2 * (j) + 1]), __builtin_bit_cast(unsigned, C[2 * (j)]), 0x07050301u)
#define PACK8(H0, H1, C0, C1) do { pf[0] = PKH(C0, 0); pf[1] = PKH(C0, 1); pf[2] = PKH(C0, 2); pf[3] = PKH(C0, 3); pf[4] = PKH(C1, 0); pf[5] = PKH(C1, 1); pf[6] = PKH(C1, 2); pf[7] = PKH(C1, 3); PIN(pf); } while (0)
#else
#define EXPBLK(H, C, b) do { _Pragma("unroll") for (int r_ = (b); r_ < (b) + 8; ++r_) C[r_] = EX(C[r_]); PIN(C); } while (0)
#define PACK8(H0, H1, C0, C1) do { pf[0] = PK8(C0, 0, pf[0]); pf[1] = PK8(C0, 4, pf[1]); pf[2] = PK8(C0, 8, pf[2]); pf[3] = PK8(C0, 12, pf[3]); pf[4] = PK8(C1, 0, pf[4]); pf[5] = PK8(C1, 4, pf[5]); pf[6] = PK8(C1, 8, pf[6]); pf[7] = PK8(C1, 12, pf[7]); PIN(pf); } while (0)
#endif
    i32x8 kf0, kf1, vf0, vf1, pf = (i32x8){0, 0, 0, 0, 0, 0, 0, 0};
#define LD32(dst, p) do { const u32x4 a_ = *(const ALAS u32x4*)(p), b_ = *(const ALAS u32x4*)((p) + 512); dst = (i32x8){(int)a_[0], (int)a_[1], (int)a_[2], (int)a_[3], (int)b_[0], (int)b_[1], (int)b_[2], (int)b_[3]}; } while (0)
#ifdef A8_BF8
#define PK8(P, B, OLD) (int)__builtin_amdgcn_perm(__builtin_bit_cast(unsigned, __builtin_amdgcn_cvt_pkrtz(P[(B) + 2], P[(B) + 3])), __builtin_bit_cast(unsigned, __builtin_amdgcn_cvt_pkrtz(P[B], P[(B) + 1])), 0x07050301u)
#define MFMA8P(a, b, c) __builtin_amdgcn_mfma_scale_f32_32x32x64_f8f6f4(a, b, c, 1, 0, 0, 0, 0, 0)
#elif defined(A8_SCALECVT)
#define MFMA8P(a, b, c) MFMA8(a, b, c)
#define PK8(P, B, OLD) __builtin_bit_cast(int, __builtin_amdgcn_cvt_scalef32_pk_fp8_f32(__builtin_amdgcn_cvt_scalef32_pk_fp8_f32(__builtin_bit_cast(v2i16_t, (int)(OLD)), P[B], P[(B) + 1], 1.0f, false), P[(B) + 2], P[(B) + 3], 1.0f, true))
#else
#define MFMA8P(a, b, c) MFMA8(a, b, c)
#define PK8(P, B, OLD) __builtin_amdgcn_cvt_pk_fp8_f32(P[(B) + 2], P[(B) + 3], __builtin_amdgcn_cvt_pk_fp8_f32(P[B], P[(B) + 1], OLD, false), true)
#endif
    if (kw) { WB_SEL(U); } else { WB_SEL(U); }
    { LD32(kf0, kp0); LD32(kf1, kp0 + 2048);
      Ca0 = MFMA8(kf0, qfa, negm); Ca1 = MFMA8(kf1, qfa, negm); Cb0 = MFMA8(kf0, qfb, negm); Cb1 = MFMA8(kf1, qfb, negm);
      EXPBLK(Ha0, Ca0, 0); EXPBLK(Ha0, Ca0, 8); EXPBLK(Ha1, Ca1, 0); EXPBLK(Ha1, Ca1, 8); }
    asm volatile("s_waitcnt lgkmcnt(0)\n\ts_barrier" ::: "memory");
    int ks = 0, vs = 0;
#define ADV(x, k) (((x) + (k) * 4096 >= RS) ? (x) + (k) * 4096 - RS : (x) + (k) * 4096)
    for (int t0 = 0; t0 < n; t0 += U) {
#pragma unroll
      for (int j = 0; j < U; ++j) {
        const int t = t0 + j;
        const bool GK = t + 1 + 2 * U < n, GV = t + 2 * U < n, GL = t + 1 < n;
        const int ksn = ADV(ks, 1);
        SBAR();
        if (!A8_VPREF || j == 0) { const ALAS char* vp_ = vp0 + vs; LD32(vf0, vp_); LD32(vf1, vp_ + 2048); }
        if (GL) { const ALAS char* kn_ = kp0 + ksn; LD32(kf0, kn_); LD32(kf1, kn_ + 2048); } SBAR();
        PACK8(Ha0, Ha1, Ca0, Ca1); SBAR();
#ifdef A8_EXPH_DUP
        {
#pragma unroll
          for (int r = 0; r < 16; ++r) { float x_ = Ca0[r], y_ = Ca1[r]; asm volatile("v_exp_f16_e32 %0, %0\n\tv_exp_f16_e32 %1, %1" : "+v"(x_), "+v"(y_)); Ca0[r] = x_; Ca1[r] = y_; }
          SBAR(); }
#endif
#ifdef A8_CVT_DUP
        { int d0_ = 0, d1_ = 0, d2_ = 0, d3_ = 0;
#pragma unroll
          for (int r = 0; r < 16; r += 4) { d0_ = PK8(Ca0, r, d0_); d1_ = PK8(Ca1, r, d1_); d2_ = PK8(Ca0, r, d2_); d3_ = PK8(Ca1, r, d3_); asm volatile("" : "+v"(d0_), "+v"(d1_), "+v"(d2_), "+v"(d3_)); }
          SBAR(); }
#endif
        oa0 = MFMA8P(pf, vf0, oa0);
        EXPBLK(Hb0, Cb0, 0); SBAR();
        oa1 = MFMA8P(pf, vf1, oa1);
        EXPBLK(Hb0, Cb0, 8); SBAR();
        osa = MFMA8P(pf, ones, osa);
        EXPBLK(Hb1, Cb1, 0); SBAR();
        if (GL) { Ca0 = MFMA8(kf0, qfa, negm); }
        EXPBLK(Hb1, Cb1, 8); SBAR();
        if (GL) { Ca1 = MFMA8(kf1, qfa, negm); }
        if (kw) { if (GK) { DMA8(t + 1 + 2 * U, ADV(ks, 2 * U + 1)); } } else { if (GV) { DMA8(t + 2 * U, ADV(vs, 2 * U)); } }
        SBAR();
        PACK8(Hb0, Hb1, Cb0, Cb1); SBAR();
        ob0 = MFMA8P(pf, vf0, ob0);
        if (GL) {
            EXPBLK(Ha0, Ca0, 0); }
        SBAR();
        ob1 = MFMA8P(pf, vf1, ob1);
        if (GL) {
            EXPBLK(Ha0, Ca0, 8); }
        SBAR();
        if (A8_VPREF && j < U - 1) { const ALAS char* vn_ = vp0 + ADV(vs, 1); LD32(vf0, vn_); LD32(vf1, vn_ + 2048); SBAR(); }
        osb = MFMA8P(pf, ones, osb);
        if (GL) {
            EXPBLK(Ha1, Ca1, 0); }
        SBAR();
        if (GL) { Cb0 = MFMA8(kf0, qfb, negm);
            EXPBLK(Ha1, Ca1, 8); }
        SBAR();
        if (GL) { Cb1 = MFMA8(kf1, qfb, negm); }
        if (j == U - 1) { if (kw ? GK : GV) { WB_SEL(U); } else { WB_SEL(0); }
#ifdef A8_LAG
            if (!kw) __builtin_amdgcn_s_sleep(A8_LAG);
#endif
        }
        ks = ksn; vs = ADV(vs, 1);
      }
    }
#undef ADV
    {
        const int lane_e = lane_id_v(), l32 = lane_e & 31, hh = lane_e >> 5;
        ALAS bf16_t* stg = (ALAS bf16_t*)shm3 + wid * 4096;
#pragma unroll
        for (int r = 0; r < 16; ++r) { const int orow = crow(r, hh); const float ra = __builtin_amdgcn_rcpf(osa[r]), rb = __builtin_amdgcn_rcpf(osb[r]);
            stg[orow * 64 + l32] = pg8::f2bf1(oa0[r] * ra); stg[orow * 64 + 32 + l32] = pg8::f2bf1(oa1[r] * ra);
            stg[2048 + orow * 64 + l32] = pg8::f2bf1(ob0[r] * rb); stg[2048 + orow * 64 + 32 + l32] = pg8::f2bf1(ob1[r] * rb); }
        asm volatile("s_waitcnt lgkmcnt(0)" ::: "memory");
#pragma unroll
        for (int i2 = 0; i2 < 8; ++i2) { const int row = i2 * 8 + (lane_e >> 3), ch = lane_e & 7; const u32x4 v = *(const ALAS u32x4*)(stg + row * 64 + ch * 8);
            *(u32x4*)(T_MIX + (size_t)(qb * 512 + wid * 64 + row) * 1024 + head * 64 + ch * 8) = v; }
    }
    asm volatile("s_waitcnt lgkmcnt(0)\n\ts_barrier" ::: "memory");
#undef DMA8
#undef LD32
#undef PK8
}
}
static_assert(att::LDS_NEED <= RING_BYTES, "LDS map");

#define GAS __attribute__((address_space(1)))
#define LAS __attribute__((address_space(3)))
typedef unsigned short bf16;
typedef unsigned v4u __attribute__((ext_vector_type(4)));
typedef float f32x4 __attribute__((ext_vector_type(4)));
typedef GAS unsigned gu32;
#define RLX_AGENT __ATOMIC_RELAXED, __HIP_MEMORY_SCOPE_AGENT
#define LDS_WAIT() asm volatile("s_waitcnt lgkmcnt(0)" ::: "memory")
#define VM_WAIT() asm volatile("s_waitcnt vmcnt(0)" ::: "memory")
__device__ __forceinline__ unsigned f2bf(float f) { unsigned u = __builtin_bit_cast(unsigned, f); return (u + 0x7fffu + ((u >> 16) & 1u)) >> 16; }
__device__ __forceinline__ unsigned pk2(float lo, float hi) { return f2bf(lo) | (f2bf(hi) << 16); }
#define XB_TMO      128
#define XB_XCNT(j)  (256  + 64 * (j))
#define XB_XSUB(j)  (1280 + 64 * (j))
#define XB_XGEN(j)  (2304 + 64 * (j))
#define XB_TOP      3328
#define XB_TOPGEN   3392
#define XCD_BAR_WORDS 3456
#define XB_SPIN_CAP (1u << 18)

__device__ __forceinline__ unsigned xb_ld(unsigned* p)              { return __hip_atomic_load(p, __ATOMIC_RELAXED, __HIP_MEMORY_SCOPE_AGENT); }
__device__ __forceinline__ unsigned xb_add(unsigned* p, unsigned v) { return __hip_atomic_fetch_add(p, v, __ATOMIC_RELAXED, __HIP_MEMORY_SCOPE_AGENT); }
__device__ __forceinline__ unsigned xb_xcc_id() { return (unsigned)__builtin_amdgcn_s_getreg((3 << 11) | 20) & 0xFu; }
#define XB_SPIN(cond, bar) do { unsigned _sp = 0; while (cond) { __builtin_amdgcn_s_sleep(1); \
    if ((++_sp & 255u) == 0u) { if (xb_ld(&(bar)[XB_TMO])) break; if (_sp > XB_SPIN_CAP) { atomicAdd(&(bar)[XB_TMO], 1u); break; } } } } while (0)

struct XcdBarrier {
    unsigned* bar; unsigned x;
    volatile LAS unsigned* st;
};

__device__ __forceinline__ XcdBarrier xcd_barrier_post(unsigned* bar, volatile LAS unsigned* st, bool t0) {
    XcdBarrier b; b.bar = bar; b.x = (unsigned)__builtin_amdgcn_readfirstlane((int)xb_xcc_id()); b.st = st;
    if (t0) (void)xb_add(&bar[XB_XCNT(b.x)], 1u);
    return b;
}
__device__ __forceinline__ void xcd_barrier_complete(unsigned* bar, unsigned x, unsigned& nloc, unsigned& nx) {
    const unsigned G = gridDim.x * gridDim.y * gridDim.z;
    unsigned sum, cnt, mine, sp = 0u;
    for (;;) {
        sum = 0u; cnt = 0u; mine = 0u;
#pragma unroll
        for (unsigned j = 0; j < 16; ++j) { const unsigned c = xb_ld(&bar[XB_XCNT(j)]); sum += c; cnt += (c > 0u) ? 1u : 0u; mine = (j == x) ? c : mine; }
        if (sum == G) break;
        __builtin_amdgcn_s_sleep(1);
        if ((++sp & 255u) == 0u) { if (xb_ld(&bar[XB_TMO])) break; if (sp > XB_SPIN_CAP) { atomicAdd(&bar[XB_TMO], 1u); break; } }
    }
    nloc = mine > 0u ? mine : 1u; nx = cnt > 0u ? cnt : 1u;
}

__device__ __forceinline__ void xcd_barrier(const XcdBarrier& b_, int wave_id) {
    XcdBarrier b = b_; asm volatile("" : "+s"(b.bar), "+s"(b.x));
    const bool t0 = (wave_id == 0) && (lane_id_v() == 0);
    asm volatile("s_waitcnt vmcnt(0)" ::: "memory");
    __syncthreads();
    if (t0) {
        unsigned* bar = b.bar;
        __builtin_amdgcn_s_waitcnt(0);
        unsigned nloc = b.st[0], nx = b.st[1];
        if (nloc == 0u) { xcd_barrier_complete(bar, b.x, nloc, nx); b.st[0] = nloc; b.st[1] = nx; }
        const unsigned old = xb_add(&bar[XB_XSUB(b.x)], 1u);
        const unsigned gen = old / nloc;
        if (old + 1u == (gen + 1u) * nloc) {
            __builtin_amdgcn_fence(__ATOMIC_RELEASE, "agent");
            asm volatile("s_waitcnt vmcnt(0)" ::: "memory");
            const unsigned og = xb_add(&bar[XB_TOP], 1u);
            const unsigned tg = og / nx;
            if (og + 1u == (tg + 1u) * nx) xb_add(&bar[XB_TOPGEN], 1u);
            else XB_SPIN(xb_ld(&bar[XB_TOPGEN]) == tg, bar);
            __builtin_amdgcn_fence(__ATOMIC_ACQUIRE, "agent");
            xb_add(&bar[XB_XGEN(b.x)], 1u);
            asm volatile("s_waitcnt vmcnt(0)" ::: "memory");
        } else {
            XB_SPIN(xb_ld(&bar[XB_XGEN(b.x)]) == gen, bar);
            __builtin_amdgcn_fence(__ATOMIC_ACQUIRE, "agent");
            asm volatile("s_waitcnt vmcnt(0)" ::: "memory");
        }
    }
    __syncthreads();
}
#ifndef PHMASK
#define PHMASK 63
#endif
#ifndef ATT_DUP
#define ATT_DUP 1
#endif
#ifndef GU_DUP
#define GU_DUP 1
#endif
#ifndef IN_DUP
#define IN_DUP 1
#endif
#ifndef D1_DUP
#define D1_DUP 1
#endif
#ifndef P0_DUP
#define P0_DUP 1
#endif
#ifndef NODEFER
#define DEFER_OK (G == 256)
#else
#define DEFER_OK false
#endif

__device__ __forceinline__ float wave_sum(float v) { v += xor_lane<1>(v); v += xor_lane<2>(v); v += xor_lane<4>(v); v += xor_lane<8>(v); v += xor_lane<16>(v); return sum_x32(v); }
__device__ __forceinline__ float wave_max(float v) { v = fmaxf(v, xor_lane<1>(v)); v = fmaxf(v, xor_lane<2>(v)); v = fmaxf(v, xor_lane<4>(v)); v = fmaxf(v, xor_lane<8>(v)); v = fmaxf(v, xor_lane<16>(v)); return max_x32(v); }
__device__ __forceinline__ void tr_item(const float* W, int ldw, int srccol0, const float* gain, bf16* WT, int K, int dstrow0, int k0, LAS float* scr, int lane) {
    const int kq = lane >> 3, nq = lane & 7;
    f32x4 w[8]; float g[8];
#pragma unroll
    for (int i = 0; i < 8; ++i) { const int kk = 8 * i + kq; w[i] = *(const GAS f32x4*)(W + (size_t)(k0 + kk) * ldw + srccol0 + 4 * nq); g[i] = gain ? gain[k0 + kk] : 1.0f; }
#pragma unroll
    for (int i = 0; i < 8; ++i) { const int kk = 8 * i + kq; LAS float* s = scr + kk * 33 + 4 * nq; s[0] = w[i][0] * g[i]; s[1] = w[i][1] * g[i]; s[2] = w[i][2] * g[i]; s[3] = w[i][3] * g[i]; }
    LDS_WAIT(); asm volatile("" ::: "memory");
    const int c = lane & 7;
#pragma unroll
    for (int j = 0; j < 4; ++j) { const int n = (lane >> 3) + 8 * j; const LAS float* s = scr + (8 * c) * 33 + n;
        v4u o; o.x = pk2(s[0 * 33], s[1 * 33]); o.y = pk2(s[2 * 33], s[3 * 33]); o.z = pk2(s[4 * 33], s[5 * 33]); o.w = pk2(s[6 * 33], s[7 * 33]);
        *(GAS v4u*)(WT + (size_t)(dstrow0 + n) * K + k0 + 8 * c) = o; }
    LDS_WAIT(); asm volatile("" ::: "memory");
}

#define TR_ONE(it_) do { int r = (it_); \
        if (r < 2 * I_GU) { const int l2 = r >= I_GU; if (l2) r -= I_GU; const int kb = r / (NGU / 32), nb = r % (NGU / 32), n0 = nb * 32, pn = n0 >> 8, j0 = n0 & 255; \
            const float* src = (j0 < 128) ? (l2 ? args.in[18] : args.in[2]) : (l2 ? args.in[19] : args.in[3]); \
            tr_item(src, FF, pn * 128 + (j0 & 127), l2 ? args.in[17] : args.in[1], (bf16*)(ws + (l2 ? WS_WGU2 : WS_WGU1)), D, n0, kb * 64, scr, lane); break; } \
        r -= 2 * I_GU; \
        if (r < 2 * I_D) { const int l2 = r >= I_D; if (l2) r -= I_D; const int kb = r / (D / 32), nb = r % (D / 32); \
            tr_item(l2 ? args.in[20] : args.in[4], D, nb * 32, nullptr, (bf16*)(ws + (l2 ? WS_WD2 : WS_WD1)), FF, nb * 32, kb * 64, scr, lane); break; } \
        r -= 2 * I_D; \
        if (r < I_IN) { const int kb = r / (NIN / 32), nb = r % (NIN / 32), n0 = nb * 32, pn = n0 >> 8, j0 = n0 & 255, bj = j0 >> 7, wc = (j0 >> 5) & 3; \
            tr_item(args.in[6], NIN, pn * 256 + wc * 64 + bj * 32, args.in[5], (bf16*)(ws + WS_WIN), D, n0, kb * 64, scr, lane); break; } \
        r -= I_IN; \
        { const int kb = r / (D / 32), nb = r % (D / 32); tr_item(args.in[16], D, nb * 32, nullptr, (bf16*)(ws + WS_WOUT), D, nb * 32, kb * 64, scr, lane); } } while (0)
constexpr int I_GU = (D / 64) * (NGU / 32), I_D = (FF / 64) * (D / 32), I_IN = (D / 64) * (NIN / 32), I_OUT = (D / 64) * (D / 32);
#define TR_DEFERRED(first_idle, IT0, IT1) do { if (bx >= (first_idle)) { const int lane = lane_id_v(); LAS float* scr = (LAS float*)(L + RING_OFF + wave * 16384); \
        const int nw_ = (G - (first_idle)) * NWAVES; for (int it = (IT0) + (bx - (first_idle)) * NWAVES + wave; it < (IT1); it += nw_) { TR_ONE(it); } } } while (0)
struct Args { const float* in[21]; float* out; unsigned char* ws; };
#define LAUNDER(p) asm volatile("" : "+s"(p))

__global__ void __launch_bounds__(NWAVES * 64, 2) mk_fwd(Args args) {
    extern __shared__ __attribute__((aligned(16))) unsigned char lds[];
    LAS unsigned char* L = (LAS unsigned char*)lds;
    volatile LAS unsigned* MISC = (volatile LAS unsigned*)(L + MISC_OFF);
    const int wave = __builtin_amdgcn_readfirstlane((int)threadIdx.x >> 6);
    const int G = gridDim.x; const int bx = blockIdx.x;
    unsigned char* ws = args.ws; float* out = args.out; LAUNDER_G(ws); LAUNDER_G(out);
    { const int tid = wave * 64 + lane_id_v(); for (int u = tid; u < (LDS_BYTES - LDSCTL_OFF) / 4; u += NWAVES * 64) ((LAS unsigned*)(L + LDSCTL_OFF))[u] = 0u; }
    __syncthreads();
    XcdBarrier bar = xcd_barrier_post((unsigned*)((gu32*)(ws + WS_CTL) + CW_BAR), MISC + 8, (wave == 0) && (lane_id_v() == 0));
    LAS float* rstd_tab = (LAS float*)(L + RSTD_OFF);
    LAS float* PRM = (LAS float*)(L + PRM_OFF);
    if (wave == 0) {
        const int lane = lane_id_v();
        const float gaq = args.in[7][lane], gak = args.in[8][lane], gbq = args.in[9][lane], gbk = args.in[10][lane];
        PRM[PRM_GAQ + lane] = gaq; PRM[PRM_GAK + lane] = gak; PRM[PRM_GBQ + lane] = gbq; PRM[PRM_GBK + lane] = gbk;
        PRM[PRM_SUBLN + lane] = args.in[15][lane]; PRM[PRM_SUBLN + 64 + lane] = args.in[15][64 + lane];
        const float maq = wave_max(fabsf(gaq)), mak = wave_max(fabsf(gak)), mbq = wave_max(fabsf(gbq)), mbk = wave_max(fabsf(gbk));
        float lm[4];
#pragma unroll
        for (int h = 0; h < 4; ++h) { const float d1 = wave_sum(args.in[11][h * 64 + lane] * args.in[12][h * 64 + lane]), d2 = wave_sum(args.in[13][h * 64 + lane] * args.in[14][h * 64 + lane]); lm[h] = expf(d1) - expf(d2) + 0.2f; }
        if (lane == 0) { PRM[PRM_NEGM2A] = -(8.0f * 1.4426950408889634f * 1.02f) * maq * mak; PRM[PRM_NEGM2B] = -(8.0f * 1.4426950408889634f * 1.02f) * mbq * mbk;
            PRM[PRM_LAM + 0] = lm[0]; PRM[PRM_LAM + 1] = lm[1]; PRM[PRM_LAM + 2] = lm[2]; PRM[PRM_LAM + 3] = lm[3]; }
    }
    LDS_WAIT(); __syncthreads();

#define BUILD_RSTD(S) do { pg8::Unit u_; const int tid = wave * 64 + lane_id_v(); const float* SSQ_ = (const float*)(ws + WS_SSQ); for (int i_ = 0; i_ < 6 && (S).next(i_, u_); ++i_) if (tid < 256) { const f32x4* p_ = (const f32x4*)(SSQ_ + (size_t)(u_.pm * 256 + tid) * 16); \
        const f32x4 a_ = p_[0], b_ = p_[1], c_ = p_[2], d_ = p_[3]; const float s_ = ((a_[0] + a_[1]) + (a_[2] + a_[3])) + ((b_[0] + b_[1]) + (b_[2] + b_[3])) + ((c_[0] + c_[1]) + (c_[2] + c_[3])) + ((d_[0] + d_[1]) + (d_[2] + d_[3])); \
        rstd_tab[i_ * 256 + tid] = 1.0f / sqrtf(s_ * (1.0f / 1024.0f) + 1e-6f); } LDS_WAIT(); __syncthreads(); } while (0)

#if (PHMASK & 1)
    for (int dup0 = 0; dup0 < P0_DUP; ++dup0) {
        if (dup0) xcd_barrier(bar, wave);
        const int lane = lane_id_v(), tid = wave * 64 + lane;
        const int vcu = (G % 8 == 0) ? (bx % 8) * (G / 8) + bx / 8 : bx;
        float* ROPE = (float*)(ws + WS_ROPE); float* SSQ = (float*)(ws + WS_SSQ); bf16* XB = (bf16*)(ws + WS_XB); const float* x = args.in[0];
        LAS float* scr = (LAS float*)(L + RING_OFF + wave * 16384);
        const int gw = vcu * NWAVES + wave, NGW = G * NWAVES;
        for (int it = gw; it < ((DEFER_OK) ? I_GU : 2 * I_GU + 2 * I_D + I_IN + I_OUT); it += NGW) { TR_ONE(it); }
        for (int m = gw; m < M; m += NGW) {
            const GAS f32x4* xr = (const GAS f32x4*)(x + (size_t)m * D) + lane; f32x4 v[4]; float s = 0.f;
#pragma unroll
            for (int j = 0; j < 4; ++j) { v[j] = xr[64 * j]; s += (v[j][0] * v[j][0] + v[j][1] * v[j][1]) + (v[j][2] * v[j][2] + v[j][3] * v[j][3]); }
            s = wave_sum(s);
            GAS unsigned long long* o8 = (GAS unsigned long long*)(XB + (size_t)m * D) + lane;
#pragma unroll
            for (int j = 0; j < 4; ++j) o8[64 * j] = (unsigned long long)pk2(v[j][0], v[j][1]) | ((unsigned long long)pk2(v[j][2], v[j][3]) << 32);
            if (lane < 16) SSQ[(size_t)m * 16 + lane] = (lane == 0) ? s : 0.f;
        }
        for (int e = bx * (NWAVES * 64) + tid; e < 5120; e += G * NWAVES * 64) {
            const int isc = e >= 4096, ee = isc ? e - 4096 : e, pos = ee >> 4, i = ee & 15;
            const float invf = powf(10000.0f, -(float)i * (1.0f / 16.0f)); const float ang = (float)pos * invf; float sn, cs; sincosf(ang, &sn, &cs);
            if (isc) { ROPE[8192 + ee] = cs; ROPE[9216 + ee] = sn; } else { ROPE[ee] = cs; ROPE[4096 + ee] = sn; }
        }
    }
#endif
    xcd_barrier(bar, wave);

    for (int rep = 0; rep < 2; ++rep) {
#if (PHMASK & 2)
        {
            LAUNDER_G(ws);
            pg8::Gemm g{(const bf16*)(ws + WS_XB), (const bf16*)(ws + (rep ? WS_WGU2 : WS_WGU1)), M, NGU, D}; pg8::StaticOrderT<M, NGU> S; int bxs_ = bx, Gs_ = G; LAUNDER(bxs_); LAUNDER(Gs_); S.init(Gs_, bxs_);
#if defined(SPLITK_GU2)
            { pg8::SplitTailOrderT<pg8::StaticOrderT<M, NGU>, 5, D / 64> SKr{S, (rep == 1) && (G == 256)}; BUILD_RSTD(SKr); }
#else
            BUILD_RSTD(S);
#endif
            pg8::EpiSwiGLU E{ws, rstd_tab};
            for (int dup = 0; dup < GU_DUP; ++dup) { if (dup) xcd_barrier(bar, wave);
#if defined(CLK_PROBE_GU)
            unsigned long long c0_ = __builtin_amdgcn_s_memtime(), r0_ = __builtin_amdgcn_s_memrealtime();
#endif
#if defined(SPLITK_GU2)
            {
                typedef pg8::SplitTailOrderT<pg8::StaticOrderT<M, NGU>, 5, D / 64> SKO; SKO SK{S, (rep == 1) && (G == 256)};
                pg8::EpiSwiGLUSplit E2{ws, rstd_tab};
                pg8::gemm_phase<D, pg8::EpiSwiGLUSplit, SKO, true, true, D, true>(L + RING_OFF, g, SK, E2, wave);
            }
#else
            pg8::gemm_phase<D, pg8::EpiSwiGLU, pg8::StaticOrderT<M, NGU>, true, true>(L + RING_OFF, g, S, E, wave);
#endif
            if (rep == 0 && dup == 0 && DEFER_OK) { TR_DEFERRED(128, 2 * I_GU, 2 * I_GU + I_D); TR_DEFERRED(128, 2 * I_GU + 2 * I_D, 2 * I_GU + 2 * I_D + I_IN); }
#if defined(CLK_PROBE_GU)
            if (rep == 0 && bx == 0) { const unsigned long long c1_ = __builtin_amdgcn_s_memtime(), r1_ = __builtin_amdgcn_s_memrealtime(); const unsigned long long spin_ = 1000ull * (c1_ - c0_) / (r1_ - r0_); while (__builtin_amdgcn_s_memrealtime() - r1_ < spin_) __builtin_amdgcn_s_sleep(8); }
#endif
            }
        }
#endif
        xcd_barrier(bar, wave);
#if (PHMASK & 4)
        {
            LAUNDER_G(ws); LAUNDER_G(out);
            pg8::Gemm g{(const bf16*)(ws + WS_H), (const bf16*)(ws + (rep ? WS_WD2 : WS_WD1)), M, D, FF}; pg8::StaticOrderT<M, D> S; int bxs_ = bx, Gs_ = G; LAUNDER(bxs_); LAUNDER(Gs_); S.init(Gs_, bxs_);
            if (rep == 0) { pg8::EpiResid<true, true, false> E{nullptr, nullptr, ws, 0.5f}; for (int dup = 0; dup < D1_DUP; ++dup) { if (dup) xcd_barrier(bar, wave);
#if defined(D1_NULLEPI)
                if (dup) { pg8::EpiNull EN; pg8::gemm_phase<FF, pg8::EpiNull, pg8::StaticOrderT<M, D>, true, true>(L + RING_OFF, g, S, EN, wave); continue; }
#endif
#if defined(D1_SCRATCH)
                if (dup) { pg8::EpiResidStaged<true, false> ES{nullptr, ws, 0.5f, ws + (140u << 20)}; pg8::gemm_phase<FF, pg8::EpiResidStaged<true, false>, pg8::StaticOrderT<M, D>, false, true>(L + RING_OFF, g, S, ES, wave); continue; }
#endif
                pg8::gemm_phase<FF, pg8::EpiResid<true, true, false>, pg8::StaticOrderT<M, D>, true, true>(L + RING_OFF, g, S, E, wave); } }
            else {
#if defined(D7_DUP) && defined(D7_PROBE1)
                for (int dup = 0; dup < D7_DUP; ++dup) { if (dup) xcd_barrier(bar, wave);
                    if (dup < D7_DUP - 1) { pg8::EpiResid<true, false, true, 1> EP{nullptr, out, ws, 0.5f}; pg8::gemm_phase<FF, pg8::EpiResid<true, false, true, 1>, pg8::StaticOrderT<M, D>, true, true>(L + RING_OFF, g, S, EP, wave); }
                    else { pg8::EpiResid<true, false, true> E{nullptr, out, ws, 0.5f}; pg8::gemm_phase<FF, pg8::EpiResid<true, false, true>, pg8::StaticOrderT<M, D>, true, true>(L + RING_OFF, g, S, E, wave); } }
#elif defined(D7_DUP)
                pg8::EpiResid<true, false, true> E{nullptr, out, ws, 0.5f};
#pragma unroll 1
                for (int dup = 0; dup < D7_DUP; ++dup) { if (dup) xcd_barrier(bar, wave); pg8::gemm_phase<FF, pg8::EpiResid<true, false, true>, pg8::StaticOrderT<M, D>, true, true>(L + RING_OFF, g, S, E, wave); }
#else
                pg8::EpiResid<true, false, true> E{nullptr, out, ws, 0.5f}; pg8::gemm_phase<FF, pg8::EpiResid<true, false, true>, pg8::StaticOrderT<M, D>, true, true>(L + RING_OFF, g, S, E, wave);
#endif
            }
        }
#endif
        if (rep == 1) break;
        xcd_barrier(bar, wave);
#if (PHMASK & 8)
        {
            LAUNDER_G(ws);
            pg8::Gemm g{(const bf16*)(ws + WS_XB), (const bf16*)(ws + WS_WIN), M, NIN, D}; pg8::StaticOrderT<M, NIN> S; int bxs_ = bx, Gs_ = G; LAUNDER(bxs_); LAUNDER(Gs_); S.init(Gs_, bxs_);
            BUILD_RSTD(S);
            pg8::EpiInProj E{rstd_tab, PRM, ws};
            for (int dup = 0; dup < IN_DUP; ++dup) { if (dup) xcd_barrier(bar, wave);
            pg8::gemm_phase<D, pg8::EpiInProj, pg8::StaticOrderT<M, NIN>, true, true>(L + RING_OFF, g, S, E, wave);
            if (dup == 0 && DEFER_OK) { TR_DEFERRED(64, I_GU, 2 * I_GU); TR_DEFERRED(64, 2 * I_GU + I_D, 2 * I_GU + 2 * I_D); TR_DEFERRED(64, 2 * I_GU + 2 * I_D + I_IN, 2 * I_GU + 2 * I_D + I_IN + I_OUT); } }
        }
#endif
        xcd_barrier(bar, wave);
#if (PHMASK & 16)
        for (int dup = 0; dup < ATT_DUP; ++dup) {
            LAUNDER_G(ws);
            if (dup) xcd_barrier(bar, wave);
            gu32* qhead = (gu32*)(ws + WS_CTL) + CW_QUEUE + 64 * dup;
#if defined(CLK_PROBE)
            unsigned long long c0_ = __builtin_amdgcn_s_memtime(), r0_ = __builtin_amdgcn_s_memrealtime();
#endif
            const att::Tensors T = att::make_tensors(ws, PRM);
            const bool st = (G == 256);
            const int xg = bx & 7, cg = bx >> 3;
            for (int step = 0;; ++step) {
                int kind, h, qb;
                if (st && step < 2) {
                    if (step < 1) { kind = 0; h = xg; qb = cg; }
                    else { kind = 1; h = (xg < 4) ? 3 : 2; qb = 32 * (xg & 3) + cg; }
                } else {
                    if ((wave == 0) && (lane_id_v() == 0)) MISC[12] = __hip_atomic_fetch_add(qhead, 1u, RLX_AGENT);
                    LDS_WAIT(); __syncthreads();
                    int idx = __builtin_amdgcn_readfirstlane((int)MISC[12]);
                    if (st) idx += 512;
                    if (idx >= 768) break;
                    if (idx < 256 || idx >= 512) { kind = 1;
                        if (idx < 128) { h = 3; qb = idx; } else if (idx < 256) { const int i = idx - 128; h = 2; qb = (i & 1) ? 63 - (i >> 1) : 64 + (i >> 1); }
                        else if (idx < 640) { h = 1; qb = idx - 512; } else { h = 0; qb = idx - 640; }
                    } else { kind = 0; const int i = idx - 256; h = i >> 5; qb = i & 31; }
                }
#if defined(DUP_ONLY_A)
                if (dup && kind) continue;
#elif defined(DUP_ONLY_B)
                if (dup && !kind) continue;
#endif
                if (kind) {
                    const float slope = (h == 0) ? 0.25f : (h == 1) ? 0.0625f : (h == 2) ? 0.015625f : 0.00390625f;
                    const float c2 = slope * 1.4426950408889634f; const int dskip = (int)(150.0f / c2) + 1;
                    att::attn_unit<true>(T, h, qb, PRM[PRM_NEGM2B], PRM[PRM_LAM + h], c2, dskip, (char*)lds + RING_OFF, wave);
                } else att::attn_unit_a8x2<A8U>(T, h, qb, PRM[PRM_NEGM2A] + 8.0f, (char*)lds + RING_OFF, wave);
            }
#if defined(CLK_PROBE)
            if (dup == ATT_DUP - 1 && bx == 0) { const unsigned long long c1_ = __builtin_amdgcn_s_memtime(), r1_ = __builtin_amdgcn_s_memrealtime(); const unsigned long long spin_ = 1000ull * (c1_ - c0_) / (r1_ - r0_); while (__builtin_amdgcn_s_memrealtime() - r1_ < spin_) __builtin_amdgcn_s_sleep(8); }
#endif
        }
#endif
        xcd_barrier(bar, wave);
#if (PHMASK & 32)
        {
            LAUNDER_G(ws); LAUNDER_G(out);
            pg8::Gemm g{(const bf16*)(ws + WS_MIX), (const bf16*)(ws + WS_WOUT), M, D, D}; pg8::StaticOrderT<M, D> S; int bxs_ = bx, Gs_ = G; LAUNDER(bxs_); LAUNDER(Gs_); S.init(Gs_, bxs_);
            pg8::EpiResid<true, true, false> E{nullptr, nullptr, ws, 1.0f}; pg8::gemm_phase<D, pg8::EpiResid<true, true, false>, pg8::StaticOrderT<M, D>, true, true>(L + RING_OFF, g, S, E, wave);
        }
#endif
        xcd_barrier(bar, wave);
    }
}

extern "C" void kernel_launch(void* const* d_in, const int* in_sizes, int n_in, void* d_out, int out_size, void* d_ws, size_t ws_size, hipStream_t stream) {
    static int grid = 0;
    if (grid == 0) {
        if (n_in != 21 || in_sizes[0] != M * D || out_size != M * D || ws_size < WS_END) { fprintf(stderr, "kernel_launch: unexpected shapes (n_in %d, in0 %d, out %d, ws %zu)\n", n_in, n_in > 0 ? in_sizes[0] : -1, out_size, ws_size); grid = -1; return; }
        int dev = 0, cus = 0, per_cu = 0;
        if (hipGetDevice(&dev) != hipSuccess || hipDeviceGetAttribute(&cus, hipDeviceAttributeMultiprocessorCount, dev) != hipSuccess) { grid = -1; return; }
        if (hipFuncSetAttribute((const void*)mk_fwd, hipFuncAttributeMaxDynamicSharedMemorySize, LDS_BYTES) != hipSuccess) { fprintf(stderr, "kernel_launch: hipFuncSetAttribute failed\n"); grid = -1; return; }
        if (hipOccupancyMaxActiveBlocksPerMultiprocessor(&per_cu, (const void*)mk_fwd, NWAVES * 64, LDS_BYTES) != hipSuccess || per_cu < 1) { fprintf(stderr, "kernel_launch: occupancy query says %d blocks per CU\n", per_cu); (void)hipGetLastError(); grid = -1; return; }
        grid = cus;
    }
    if (grid < 0) return;
    if (hipMemsetAsync((char*)d_ws + WS_CTL, 0, CTL_ZERO_BYTES, stream) != hipSuccess) { fprintf(stderr, "kernel_launch: memset failed\n"); return; }
    Args a{};
    for (int i = 0; i < 21; ++i) a.in[i] = (const float*)d_in[i];
    a.out = (float*)d_out; a.ws = (unsigned char*)d_ws;
    hipLaunchKernelGGL(mk_fwd, dim3(grid), dim3(NWAVES * 64), LDS_BYTES, stream, a);
    const hipError_t le = hipPeekAtLastError();
    if (le != hipSuccess) fprintf(stderr, "kernel_launch: launch failed: %s\n", hipGetErrorName(le));
}
```

```cpp
#include <hip/hip_runtime.h>
#include <cstdio>
#include <cstdint>
#define SWIGLU_FMA 1
#define NOTAIL 1
#ifndef B_ORDER
#define B_ORDER 0
#endif
#ifndef A8_VPREF
#define A8_VPREF 0
#endif
#ifndef BDMA_MODE
#define BDMA_MODE 0
#endif
#ifndef A8U
#define A8U 4
#endif
#ifndef A8_NOBF8
#define A8_BF8 1
#endif

constexpr int NWAVES = 8;
constexpr int M = 16384, D = 1024, FF = 2816, NGU = 2 * FF, NIN = 2304;
constexpr size_t MiB = 1u << 20;
constexpr size_t WS_CTL = 0, CTL_ZERO_BYTES = 64 * 1024;
constexpr size_t WS_WGU1 = 2 * MiB, WS_WD1 = 13 * MiB, WS_WIN = 19 * MiB, WS_WOUT = 24 * MiB, WS_WGU2 = 26 * MiB, WS_WD2 = 37 * MiB;
constexpr size_t WS_ROPE = 43 * MiB, WS_SSQ = 44 * MiB;
constexpr size_t WS_XB = 48 * MiB;
constexpr size_t WS_H = 80 * MiB;
constexpr size_t WS_QA = 80 * MiB, WS_KA = 96 * MiB, WS_VA = 100 * MiB, WS_QB = 104 * MiB, WS_KB = 120 * MiB, WS_VB = 136 * MiB, WS_MIX = 152 * MiB;
constexpr size_t WS_END = 184 * MiB;
static_assert(WS_WGU1 + (size_t)NGU * D * 2 <= WS_WD1 && WS_WD1 + (size_t)D * FF * 2 <= WS_WIN && WS_WIN + (size_t)NIN * D * 2 <= WS_WOUT && WS_WOUT + (size_t)D * D * 2 <= WS_WGU2 &&
              WS_WGU2 + (size_t)NGU * D * 2 <= WS_WD2 && WS_WD2 + (size_t)D * FF * 2 <= WS_ROPE && WS_H + (size_t)M * FF * 2 <= WS_END && WS_MIX + (size_t)M * D * 2 <= WS_END, "d_ws map");
constexpr int CW_BAR = 1024;
constexpr int CW_XFLAG = 9216;
constexpr size_t WS_XCH = 184 * MiB;
constexpr int CW_QUEUE = 8192;
constexpr int RING_OFF = 0, RING_BYTES = 131072;
constexpr int LDSCTL_OFF = RING_BYTES, MISC_OFF = LDSCTL_OFF + 320, RSTD_OFF = LDSCTL_OFF + 1024, PRM_OFF = LDSCTL_OFF + 8192;
constexpr int LDS_BYTES = 147456;
constexpr int PRM_GAQ = 0, PRM_GAK = 64, PRM_GBQ = 128, PRM_GBK = 192, PRM_SUBLN = 256, PRM_NEGM2A = 384, PRM_NEGM2B = 385, PRM_LAM = 388, PRM_WORDS = 392;
static_assert(RSTD_OFF + 6 * 256 * 4 <= PRM_OFF && PRM_OFF + PRM_WORDS * 4 <= LDS_BYTES, "LDS map");

__device__ __forceinline__ int lane_id_v() { int l; asm volatile("v_mbcnt_lo_u32_b32 %0, -1, 0\n\tv_mbcnt_hi_u32_b32 %0, -1, %0" : "=v"(l)); return l; }

template <int MASK> __device__ __forceinline__ float xor_lane(float v) {
    if constexpr (MASK == 32) { const auto rr = __builtin_amdgcn_permlane32_swap(__float_as_uint(v), __float_as_uint(v), false, false); return __uint_as_float(lane_id_v() < 32 ? rr[1] : rr[0]); }
    else return __uint_as_float((unsigned)__builtin_amdgcn_ds_swizzle((int)__float_as_uint(v), (MASK << 10) | 0x1f));
}
__device__ __forceinline__ float sum_x32(float v) { const auto rr = __builtin_amdgcn_permlane32_swap(__float_as_uint(v), __float_as_uint(v), false, false); return __uint_as_float(rr[0]) + __uint_as_float(rr[1]); }
__device__ __forceinline__ float max_x32(float v) { const auto rr = __builtin_amdgcn_permlane32_swap(__float_as_uint(v), __float_as_uint(v), false, false); return fmaxf(__uint_as_float(rr[0]), __uint_as_float(rr[1])); }

#define LAUNDER_G(p) do { __attribute__((address_space(1))) void* g_ = (__attribute__((address_space(1))) void*)(p); asm volatile("" : "+s"(g_)); (p) = (decltype(p))g_; } while (0)
namespace pg8 {
#define PG8_LAS __attribute__((address_space(3)))
typedef unsigned short bf16_t;
typedef short bf16x8 __attribute__((ext_vector_type(8)));
typedef float f32x4 __attribute__((ext_vector_type(4)));
typedef unsigned u32x4 __attribute__((ext_vector_type(4)));
constexpr int BM = 256, BK = 64, HALF = 128, HTB = HALF * BK * 2  , STAGE_BYTES = 8 * HTB, NXCD = 8, WGM = 8;

__host__ __device__ __forceinline__ int lds_byte(int r, int c) { const int st = (r >> 4) * 2 + (c >> 5), rr = r & 15, cc = c & 31, ob = rr * 64 + cc * 2; return st * 1024 + (ob ^ (((ob >> 9) & 1) << 5)); }
__host__ __device__ __forceinline__ void stage_rc(int b, int& R, int& C) { const int st = b / 1024, sb = b % 1024, swz = sb ^ (((sb >> 9) & 1) << 5); R = (st >> 1) * 16 + swz / 64; C = (st & 1) * 32 + (swz % 64) / 2; }
__host__ __device__ __forceinline__ int perm32(int rho) { const int n = rho >> 4, i = rho & 15; return 8 * (i >> 2) + 4 * n + (i & 3); }

struct Unit { int pm, pn; int kofs, nt; };
struct Gemm { const bf16_t* A; const bf16_t* Bt; int M, N, K; };

template <int MD, int ND> struct StaticOrderT {
    static constexpr int nM = MD / BM, nN = ND / BM, nwg = nM * nN;
    int G, c;
    __host__ __device__ void init(int G_, int c_) { G = G_; c = c_; }
    __host__ __device__ bool next(int i, Unit& u) const { return at(i * G + c, u); }
    __host__ __device__ bool at(int L, Unit& u) const {
        if (L >= nwg) return false;
        int wgid = L; { constexpr int q = nwg / NXCD, r = nwg % NXCD; const int xcd = wgid % NXCD, off = wgid / NXCD; wgid = (xcd < r ? xcd * (q + 1) : r * (q + 1) + (xcd - r) * q) + off; }
        constexpr int nig = WGM * nN; const int gid = wgid / nig, fm = gid * WGM, gsz = (nM - fm) < WGM ? (nM - fm) : WGM;
        u.pm = fm + ((wgid % nig) % gsz); u.pn = (wgid % nig) / gsz; u.kofs = 0; u.nt = 0; return true;
    }
    __device__ __forceinline__ void a_ready(const Unit&) const {}
    __device__ __forceinline__ void done(const Unit&) const {}
};
template <class S0, int RT, int NTF> struct SplitTailOrderT { S0 s; bool sk;
    __host__ __device__ bool next(int i, Unit& u) const {
        if (!sk || i < RT) { const bool r = s.next(i, u); u.kofs = 0; u.nt = NTF; return r; }
        if (i > RT) return false;
        const int h = s.G >> 1; s.at(RT * s.G + (s.c % h), u); u.kofs = (s.c / h) * (NTF / 2) * BK * 2; u.nt = NTF / 2; return true; }
    __device__ __forceinline__ void a_ready(const Unit&) const {} __device__ __forceinline__ void done(const Unit&) const {} };


__device__ __forceinline__ unsigned cvt_pk_bf16(float lo, float hi) { unsigned r; asm volatile("v_cvt_pk_bf16_f32 %0, %1, %2" : "=v"(r) : "v"(lo), "v"(hi)); return r; }
__device__ __forceinline__ unsigned short f2bf1(float f) { unsigned u = __builtin_bit_cast(unsigned, f); return (unsigned short)((u + 0x7fffu + ((u >> 16) & 1u)) >> 16); }
typedef unsigned u32x2 __attribute__((ext_vector_type(2)));
constexpr int MROWS = M, DMODEL = D, DFF = FF;

typedef float f32x2 __attribute__((ext_vector_type(2)));
#ifdef SWIGLU_FMA
#define SWIGLU_RS2(rs) __builtin_amdgcn_rcpf((rs) * (rs))
#else
#define SWIGLU_RS2(rs) ((rs) * (rs))
#endif
__device__ __forceinline__ f32x2 swiglu2(f32x2 ag, f32x2 au, float k1, float rs2) {
    const f32x2 t = ag * k1; f32x2 ex; ex.x = __builtin_amdgcn_exp2f(t.x); ex.y = __builtin_amdgcn_exp2f(t.y);
#ifdef SWIGLU_FMA
    const f32x2 d = ex * rs2 + rs2; f32x2 r; r.x = __builtin_amdgcn_rcpf(d.x); r.y = __builtin_amdgcn_rcpf(d.y);
    return (ag * au) * r;
#else
    const f32x2 d = ex + 1.0f; f32x2 r; r.x = __builtin_amdgcn_rcpf(d.x); r.y = __builtin_amdgcn_rcpf(d.y);
    return ((ag * au) * rs2) * r;
#endif
}
__device__ __forceinline__ f32x4 swiglu4(f32x4 ag, f32x4 au, float k1, float rs2) {
    const f32x2 a = swiglu2((f32x2){ag[0], ag[1]}, (f32x2){au[0], au[1]}, k1, rs2), b = swiglu2((f32x2){ag[2], ag[3]}, (f32x2){au[2], au[3]}, k1, rs2);
    return (f32x4){a.x, a.y, b.x, b.y};
}
struct EpiSwiGLU {
    static constexpr bool PERM = true, AFTER_DRAIN = false;
    unsigned char* ws; const PG8_LAS float* rstd;
    __device__ __forceinline__ void operator()(const f32x4 (&acc)[2][2][4][2], const Unit& u, int ui, int wr, int wc, int fr, int fq) const {
        asm volatile("" : "+v"(fr), "+v"(fq));
        const int col0 = u.pn * 128 + wc * 32 + 8 * fq; unsigned char* w2 = ws; LAUNDER_G(w2); bf16_t* H = (bf16_t*)(w2 + WS_H);
#pragma unroll
        for (int ai = 0; ai < 2; ++ai)
#pragma unroll
            for (int m = 0; m < 4; ++m) {
                const int rl = ai * HALF + wr * 64 + m * 16 + fr; const float rs = rstd[ui * 256 + rl];
                const float k1 = rs * -1.4426950408889634f, rs2 = SWIGLU_RS2(rs);
                const f32x4 h0 = swiglu4(acc[ai][0][m][0], acc[ai][1][m][0], k1, rs2), h1 = swiglu4(acc[ai][0][m][1], acc[ai][1][m][1], k1, rs2);
                u32x4 w; w.x = cvt_pk_bf16(h0[0], h0[1]); w.y = cvt_pk_bf16(h0[2], h0[3]); w.z = cvt_pk_bf16(h1[0], h1[1]); w.w = cvt_pk_bf16(h1[2], h1[3]);
                *(u32x4*)(H + (size_t)(u.pm * BM + rl) * DFF + col0) = w;
            }
    }
};
struct EpiSwiGLUSplit {
    static constexpr bool PERM = true, AFTER_DRAIN = false;
    unsigned char* ws; const PG8_LAS float* rstd;
    typedef unsigned long long u64;
    __device__ __forceinline__ static void put(u64* p, const f32x4& v) {
        __hip_atomic_store(p, ((u64)__float_as_uint(v[1]) << 32) | __float_as_uint(v[0]), __ATOMIC_RELAXED, __HIP_MEMORY_SCOPE_AGENT);
        __hip_atomic_store(p + 1, ((u64)__float_as_uint(v[3]) << 32) | __float_as_uint(v[2]), __ATOMIC_RELAXED, __HIP_MEMORY_SCOPE_AGENT); }
    __device__ __forceinline__ static f32x4 get(const u64* p) {
        const u64 a = __hip_atomic_load(p, __ATOMIC_RELAXED, __HIP_MEMORY_SCOPE_AGENT), b = __hip_atomic_load(p + 1, __ATOMIC_RELAXED, __HIP_MEMORY_SCOPE_AGENT);
        return (f32x4){__uint_as_float((unsigned)a), __uint_as_float((unsigned)(a >> 32)), __uint_as_float((unsigned)b), __uint_as_float((unsigned)(b >> 32))}; }
    template <int SS> __device__ __forceinline__ void run(const f32x4 (&acc)[2][2][4][2], const Unit& u, int wr, int wc, int fr, int fq) const {
        unsigned char* w2 = ws; LAUNDER_G(w2);
        const int pair = (int)(__builtin_amdgcn_workgroup_id_x() & 127u); constexpr int rslot = 5;
        const unsigned tid = (unsigned)((wr * 4 + wc) * 64 + fq * 16 + fr);
        unsigned char* xb_ = w2 + WS_XCH + (size_t)pair * (2 * 16 * 512 * 16);
        u64* xo = (u64*)(xb_ + (size_t)(1 - SS) * (16 * 512 * 16) + tid * 16u);
        const u64* xi = (const u64*)(xb_ + (size_t)SS * (16 * 512 * 16) + tid * 16u);
        unsigned* flg = (unsigned*)(w2 + WS_CTL) + CW_XFLAG + pair * 2;
#pragma unroll
        for (int bj = 0; bj < 2; ++bj)
#pragma unroll
            for (int m = 0; m < 4; ++m)
#pragma unroll
                for (int n = 0; n < 2; ++n) put(xo + (size_t)((bj * 4 + m) * 2 + n) * 1024, acc[1 - SS][bj][m][n]);
        asm volatile("s_waitcnt vmcnt(0)" ::: "memory");
        __syncthreads();
        if (tid == 0) { __hip_atomic_store(flg + (1 - SS), 1u, __ATOMIC_RELAXED, __HIP_MEMORY_SCOPE_AGENT);
            unsigned sp = 0; while (__hip_atomic_load(flg + SS, __ATOMIC_RELAXED, __HIP_MEMORY_SCOPE_AGENT) == 0u) { __builtin_amdgcn_s_sleep(1); if (++sp > (1u << 20)) break; } }
        __syncthreads();
        bf16_t* H = (bf16_t*)(w2 + WS_H); const int col0 = u.pn * 128 + wc * 32 + 8 * fq;
#pragma unroll
        for (int m = 0; m < 4; ++m) {
            const f32x4 g0 = acc[SS][0][m][0] + get(xi + (size_t)((0 * 4 + m) * 2 + 0) * 1024), g1 = acc[SS][0][m][1] + get(xi + (size_t)((0 * 4 + m) * 2 + 1) * 1024);
            const f32x4 u0 = acc[SS][1][m][0] + get(xi + (size_t)((1 * 4 + m) * 2 + 0) * 1024), u1 = acc[SS][1][m][1] + get(xi + (size_t)((1 * 4 + m) * 2 + 1) * 1024);
            const int rl = SS * HALF + wr * 64 + m * 16 + fr; const float rs = rstd[rslot * 256 + rl];
            const float k1 = rs * -1.4426950408889634f, rs2 = SWIGLU_RS2(rs);
            const f32x4 h0 = swiglu4(g0, u0, k1, rs2), h1 = swiglu4(g1, u1, k1, rs2);
            u32x4 w; w.x = cvt_pk_bf16(h0[0], h0[1]); w.y = cvt_pk_bf16(h0[2], h0[3]); w.z = cvt_pk_bf16(h1[0], h1[1]); w.w = cvt_pk_bf16(h1[2], h1[3]);
            *(u32x4*)(H + (size_t)(u.pm * BM + rl) * DFF + col0) = w;
        }
    }
    __device__ __forceinline__ void operator()(const f32x4 (&acc)[2][2][4][2], const Unit& u, int ui, int wr, int wc, int fr, int fq) const {
        if (u.nt == (D / BK) / 2) { asm volatile("" : "+v"(fr), "+v"(fq));
            if (__builtin_amdgcn_workgroup_id_x() >> 7) run<1>(acc, u, wr, wc, fr, fq); else run<0>(acc, u, wr, wc, fr, fq); }
        else { EpiSwiGLU E0{ws, rstd}; E0(acc, u, ui, wr, wc, fr, fq); }
    }
};
template <bool SRC_B, bool WRITE_B, bool WRITE_F, int PROBE = 0> struct EpiResid {
    static constexpr bool PERM = true, AFTER_DRAIN = false;
    const float* base; float* out; unsigned char* ws; float alpha;
    __device__ __forceinline__ static f32x4 up4(unsigned a, unsigned b) { return (f32x4){__uint_as_float(a << 16), __uint_as_float(a & 0xffff0000u), __uint_as_float(b << 16), __uint_as_float(b & 0xffff0000u)}; }
    __device__ __forceinline__ void operator()(const f32x4 (&acc)[2][2][4][2], const Unit& u, int ui, int wr, int wc, int fr, int fq) const {
        asm volatile("" : "+v"(fr), "+v"(fq));
        const int col0 = u.pn * BM + wc * 32 + 8 * fq;
        unsigned char* w2 = ws; LAUNDER_G(w2); bf16_t* xb = (bf16_t*)(w2 + WS_XB); float* ssqp = (float*)(w2 + WS_SSQ);
#pragma unroll
        for (int ai = 0; ai < 2; ++ai) {
            f32x4 rb[4][2][2];
#pragma unroll
            for (int m = 0; m < 4; ++m) { const size_t off = (size_t)(u.pm * BM + ai * HALF + wr * 64 + m * 16 + fr) * DMODEL + col0;
#pragma unroll
                for (int bj = 0; bj < 2; ++bj) {
                    if (PROBE == 1) { rb[m][bj][0] = (f32x4){0.f, 0.f, 0.f, 0.f}; rb[m][bj][1] = rb[m][bj][0]; }
                    else if (SRC_B) { const u32x4 r = *(const u32x4*)(xb + off + bj * HALF); rb[m][bj][0] = __builtin_bit_cast(f32x4, r); }
                    else { rb[m][bj][0] = *(const f32x4*)(base + off + bj * HALF); rb[m][bj][1] = *(const f32x4*)(base + off + bj * HALF + 4); } } }
#pragma unroll
            for (int m = 0; m < 4; ++m) {
                const int row = u.pm * BM + ai * HALF + wr * 64 + m * 16 + fr; const size_t off = (size_t)row * DMODEL + col0; float ss = 0.f;
#pragma unroll
                for (int bj = 0; bj < 2; ++bj) { const size_t o = off + bj * HALF;
                    f32x4 b0, b1;
                    if (SRC_B) { const u32x4 r = __builtin_bit_cast(u32x4, rb[m][bj][0]); b0 = up4(r[0], r[1]); b1 = up4(r[2], r[3]); } else { b0 = rb[m][bj][0]; b1 = rb[m][bj][1]; }
                    const f32x4 v0 = b0 + acc[ai][bj][m][0] * alpha, v1 = b1 + acc[ai][bj][m][1] * alpha;
                    if (PROBE == 2) { asm volatile("" :: "v"(v0), "v"(v1)); }
#ifdef OUT_NT
                    if (WRITE_F && PROBE != 2) { __builtin_nontemporal_store(v0, (f32x4*)(out + o)); __builtin_nontemporal_store(v1, (f32x4*)(out + o + 4)); }
#else
                    if (WRITE_F && PROBE != 2) { *(f32x4*)(out + o) = v0; *(f32x4*)(out + o + 4) = v1; }
#endif
                    if (WRITE_B && PROBE != 2) { ss += ((v0[0] * v0[0] + v0[1] * v0[1]) + (v0[2] * v0[2] + v0[3] * v0[3])) + ((v1[0] * v1[0] + v1[1] * v1[1]) + (v1[2] * v1[2] + v1[3] * v1[3]));
                        u32x4 w; w.x = cvt_pk_bf16(v0[0], v0[1]); w.y = cvt_pk_bf16(v0[2], v0[3]); w.z = cvt_pk_bf16(v1[0], v1[1]); w.w = cvt_pk_bf16(v1[2], v1[3]); *(u32x4*)(xb + o) = w; } }
                if (WRITE_B && PROBE != 2) { ss += xor_lane<16>(ss); ss = sum_x32(ss); if (fq == 0) ssqp[(size_t)row * 16 + u.pn * 4 + wc] = ss; }
            }
            asm volatile("" ::: "memory");
        }
    }
};
template <bool WRITE_B, bool WRITE_F> struct EpiResidStaged {
    static constexpr bool PERM = true, AFTER_DRAIN = true;
    float* out; unsigned char* ws; float alpha; unsigned char* wsw;
    __device__ __forceinline__ static f32x4 up4(unsigned a, unsigned b) { return (f32x4){__uint_as_float(a << 16), __uint_as_float(a & 0xffff0000u), __uint_as_float(b << 16), __uint_as_float(b & 0xffff0000u)}; }
    __device__ __forceinline__ void fused(f32x4 (&acc)[2][2][4][2], const Unit& u, int wr, int wc, int fr, int fq, PG8_LAS unsigned char* lds, int wid, int lane) const {
        unsigned char* w2 = ws; LAUNDER_G(w2); const bf16_t* xb = (const bf16_t*)(w2 + WS_XB); unsigned char* w3 = wsw; LAUNDER_G(w3); bf16_t* xbw = (bf16_t*)(w3 + WS_XB); float* ssqp = (float*)(w3 + WS_SSQ);
        {
            const int tid = wid * 64 + lane, c = tid & 31, r0 = tid >> 5;
            const bf16_t* src = xb + (size_t)(u.pm * BM + r0) * DMODEL + u.pn * BM + c * 8;
            u32x4 t[16];
#pragma unroll
            for (int p = 0; p < 16; ++p) t[p] = *(const u32x4*)(src + (size_t)(p * 16) * DMODEL);
#pragma unroll
            for (int p = 0; p < 16; ++p) { const int r = p * 16 + r0; *(PG8_LAS u32x4*)(lds + r * 512 + ((c ^ (r & 15)) << 4)) = t[p]; }
        }
        asm volatile("s_waitcnt vmcnt(0) lgkmcnt(0)\n\ts_barrier" ::: "memory");
        asm volatile("" : "+v"(fr), "+v"(fq));
        const int col0 = u.pn * BM + wc * 32 + 8 * fq;
#pragma unroll
        for (int ai = 0; ai < 2; ++ai)
#pragma unroll
            for (int m = 0; m < 4; ++m) {
                const int rl = ai * HALF + wr * 64 + m * 16 + fr; const int row = u.pm * BM + rl; const size_t off = (size_t)row * DMODEL + col0; float ss = 0.f;
#pragma unroll
                for (int bj = 0; bj < 2; ++bj) { const size_t o = off + bj * HALF;
                    const int chunk = 16 * bj + 4 * wc + fq;
                    const u32x4 r = *(const PG8_LAS u32x4*)(lds + rl * 512 + ((chunk ^ (rl & 15)) << 4));
                    const f32x4 b0 = up4(r[0], r[1]), b1 = up4(r[2], r[3]);
                    const f32x4 v0 = b0 + acc[ai][bj][m][0] * alpha, v1 = b1 + acc[ai][bj][m][1] * alpha;
                    if (WRITE_F) { *(f32x4*)(out + o) = v0; *(f32x4*)(out + o + 4) = v1; }
                    if (WRITE_B) { ss += ((v0[0] * v0[0] + v0[1] * v0[1]) + (v0[2] * v0[2] + v0[3] * v0[3])) + ((v1[0] * v1[0] + v1[1] * v1[1]) + (v1[2] * v1[2] + v1[3] * v1[3]));
                        u32x4 w; w.x = cvt_pk_bf16(v0[0], v0[1]); w.y = cvt_pk_bf16(v0[2], v0[3]); w.z = cvt_pk_bf16(v1[0], v1[1]); w.w = cvt_pk_bf16(v1[2], v1[3]); *(u32x4*)(xbw + o) = w; } }
                if (WRITE_B) { ss += xor_lane<16>(ss); ss = sum_x32(ss); if (fq == 0) ssqp[(size_t)row * 16 + u.pn * 4 + wc] = ss; }
            }
    }
};
struct EpiNull {
    static constexpr bool PERM = true, AFTER_DRAIN = false;
    __device__ __forceinline__ void operator()(const f32x4 (&acc)[2][2][4][2], const Unit& u, int ui, int wr, int wc, int fr, int fq) const {
#pragma unroll
        for (int ai = 0; ai < 2; ++ai)
#pragma unroll
            for (int bj = 0; bj < 2; ++bj)
#pragma unroll
                for (int m = 0; m < 4; ++m)
#pragma unroll
                    for (int n = 0; n < 2; ++n) { f32x4 t = acc[ai][bj][m][n]; asm volatile("" :: "v"(t)); }
    }
};
struct EpiInProj {
    static constexpr bool PERM = false, AFTER_DRAIN = false;
    const PG8_LAS float* rstd; const PG8_LAS float* prm; unsigned char* ws;
    __device__ __forceinline__ static float head_f(const f32x4 (&acc)[2][2][4][2], int ai, int m, float rs) {
        float ss = 0.f;
#pragma unroll
        for (int bj = 0; bj < 2; ++bj)
#pragma unroll
            for (int n = 0; n < 2; ++n) { const f32x4 a = acc[ai][bj][m][n]; ss += (a[0] * a[0] + a[1] * a[1]) + (a[2] * a[2] + a[3] * a[3]); }
        ss += xor_lane<16>(ss); ss = sum_x32(ss);
        return rs / sqrtf(ss * rs * rs * (1.0f / 64.0f) + 1e-6f);
    }
    __device__ __forceinline__ void operator()(const f32x4 (&acc)[2][2][4][2], const Unit& u, int ui, int wr, int wc, int fr, int fq) const {
        const int G = __builtin_amdgcn_readfirstlane(u.pn * 4 + wc);
        unsigned char* w2 = ws; LAUNDER_G(w2);
        asm volatile("" : "+v"(fr), "+v"(fq));
        const int row0 = wr * 64 + fr;
        if (G < 10) {
            const bool isq = G < 8;
            const PG8_LAS float* gp = prm + (isq ? PRM_GAQ : PRM_GAK) + 4 * fq;
            const float* rope = (const float*)(w2 + WS_ROPE) + 4 * fq;
            const float qs = isq ? 0.125f * 1.4426950408889634f : 1.0f;
            unsigned char* db = isq ? (w2 + WS_QA) + (size_t)G * MROWS * 64 + 8 * fq : (w2 + WS_KA) + (size_t)(G - 8) * MROWS * 64 + (fq >> 1) * 512 + 8 * (fq & 1);
#pragma unroll
            for (int ai = 0; ai < 2; ++ai)
#pragma unroll
                for (int m = 0; m < 4; ++m) {
                    const int rl = ai * HALF + m * 16 + row0; const int t = u.pm * BM + rl; const float f = head_f(acc, ai, m, rstd[ui * 256 + rl]) * qs;
                    unsigned char* dt = isq ? db + (size_t)t * 64 : db + (size_t)(t >> 6) * 4096 + ((t & 63) >> 5) * 2048 + (t & 31) * 16;
#pragma unroll
                    for (int bj = 0; bj < 2; ++bj) {
                        const f32x4 x1 = acc[ai][bj][m][0] * f * *(const PG8_LAS f32x4*)(gp + 32 * bj), x2 = acc[ai][bj][m][1] * f * *(const PG8_LAS f32x4*)(gp + 32 * bj + 16);
                        const int pos = bj ? (t & 63) : (t >> 6); const float* rp = rope + (bj ? 8192 : 0) + pos * 16;
                        const f32x4 c = *(const f32x4*)rp, s = *(const f32x4*)(rp + (bj ? 1024 : 4096));
                        const f32x4 y1 = x1 * c - x2 * s, y2 = x2 * c + x1 * s;
                        int lo = __builtin_amdgcn_cvt_pk_fp8_f32(y1[0], y1[1], 0, false); lo = __builtin_amdgcn_cvt_pk_fp8_f32(y1[2], y1[3], lo, true);
                        int hi = __builtin_amdgcn_cvt_pk_fp8_f32(y2[0], y2[1], 0, false); hi = __builtin_amdgcn_cvt_pk_fp8_f32(y2[2], y2[3], hi, true);
                        u32x2 w; w.x = (unsigned)lo; w.y = (unsigned)hi;
                        *(u32x2*)(dt + (isq ? 32 * bj : 1024 * bj)) = w;
                    }
                    asm volatile("" ::: "memory");
                }
        } else if (G < 12) {
            unsigned char* V8 = (w2 + WS_VA) + (size_t)(G - 10) * MROWS * 64 + (4 * fq) * 16;
#pragma unroll
            for (int ai = 0; ai < 2; ++ai)
#pragma unroll
                for (int m = 0; m < 4; ++m) {
                    const int rl = ai * HALF + m * 16 + row0; const int t = u.pm * BM + rl; const float rs = rstd[ui * 256 + rl];
                    const int kk = t & 63, c = kk >> 5, r = kk & 31, h = (r >> 2) & 1, jj = (r & 3) + 4 * (r >> 3);
                    unsigned char* vb = V8 + (size_t)(t >> 6) * 4096 + h * 1024 + c * 512 + jj;
#pragma unroll
                    for (int bj = 0; bj < 2; ++bj)
#pragma unroll
                        for (int n = 0; n < 2; ++n) { const f32x4 v = acc[ai][bj][m][n] * rs;
                            const int p01 = __builtin_amdgcn_cvt_pk_fp8_f32(v[0], v[1], 0, false), p23 = __builtin_amdgcn_cvt_pk_fp8_f32(v[2], v[3], 0, false);
                            unsigned char* q = vb + bj * 2048 + (16 * n) * 16;
                            q[0] = (unsigned char)(p01 & 0xff); q[16] = (unsigned char)((p01 >> 8) & 0xff); q[32] = (unsigned char)(p23 & 0xff); q[48] = (unsigned char)((p23 >> 8) & 0xff); }
                    asm volatile("" ::: "memory");
                }
        } else if (G < 28) {
            const bool isq = G < 20;
            const PG8_LAS float* gp = prm + (isq ? PRM_GBQ : PRM_GBK) + 4 * fq;
            const float qs = isq ? 0.125f * 1.4426950408889634f : 1.0f;
            bf16_t* db = isq ? (bf16_t*)(w2 + WS_QB) + (size_t)(G - 12) * MROWS * 64 + 8 * fq : (bf16_t*)(w2 + WS_KB) + (size_t)(G - 20) * MROWS * 64 + (size_t)fq * 512;
#pragma unroll
            for (int ai = 0; ai < 2; ++ai)
#pragma unroll
                for (int m = 0; m < 4; ++m) {
                    const int rl = ai * HALF + m * 16 + row0; const int t = u.pm * BM + rl; const float f = head_f(acc, ai, m, rstd[ui * 256 + rl]) * qs;
                    bf16_t* dt = isq ? db + (size_t)t * 64 : db + (size_t)(t >> 6) * 4096 + (t & 63) * 8;
#pragma unroll
                    for (int bj = 0; bj < 2; ++bj) {
                        const f32x4 x1 = acc[ai][bj][m][0] * f * *(const PG8_LAS f32x4*)(gp + 32 * bj), x2 = acc[ai][bj][m][1] * f * *(const PG8_LAS f32x4*)(gp + 32 * bj + 16);
                        u32x4 w; w.x = cvt_pk_bf16(x1[0], x1[1]); w.y = cvt_pk_bf16(x1[2], x1[3]); w.z = cvt_pk_bf16(x2[0], x2[1]); w.w = cvt_pk_bf16(x2[2], x2[3]);
                        *(u32x4*)(dt + (isq ? 32 * bj : 2048 * bj)) = w;
                    }
                    asm volatile("" ::: "memory");
                }
        } else {
            bf16_t* V = (bf16_t*)(w2 + WS_VB) + (size_t)((G - 28) >> 1) * MROWS * 128 + (64 * ((G - 28) & 1) + 4 * fq) * 8;
#pragma unroll
            for (int ai = 0; ai < 2; ++ai)
#pragma unroll
                for (int m = 0; m < 4; ++m) {
                    const int rl = ai * HALF + m * 16 + row0; const int t = u.pm * BM + rl; const float rs = rstd[ui * 256 + rl];
                    const int kk = t & 63, ks = kk >> 4, ko = kk & 15, hi = (ko >> 2) & 1, j = ((ko >> 3) << 2) | (ko & 3);
                    bf16_t* vb = V + (size_t)(((t >> 6) * 4 + ks) * 2 + hi) * 1024 + j;
#pragma unroll
                    for (int bj = 0; bj < 2; ++bj)
#pragma unroll
                        for (int n = 0; n < 2; ++n)
#pragma unroll
                            for (int e = 0; e < 4; ++e) vb[(32 * bj + 16 * n + e) * 8] = f2bf1(acc[ai][bj][m][n][e] * rs);
                    asm volatile("" ::: "memory");
                }
        }
    }
};

#ifndef NOTAIL
#define NOTAIL 0
#endif
template <int KD, class Epi, class Sched, bool ALIGN_EPI = false, bool SP2 = false, int LD = KD, bool VARK = false>
__device__ __forceinline__ void gemm_phase(PG8_LAS unsigned char* lds, const Gemm g, const Sched& S, const Epi& E, int wave_id) {
    int tid_ = wave_id * 64 + lane_id_v(); asm volatile("" : "+v"(tid_));
    const int tid = tid_, wid = __builtin_amdgcn_readfirstlane(tid >> 6), lane = tid & 63, wr = wid >> 2, wc = wid & 3, fr = lane & 15, fq = lane >> 4;
    constexpr int K = KD, ntc = K / BK; static_assert(ntc % 2 == 0, "even K-tile count");
    unsigned voffA[2], voffB[2];
#pragma unroll
    for (int i = 0; i < 2; ++i) { int R, C; stage_rc(tid * 16 + i * 8192, R, C); const int Rb = Epi::PERM ? ((R & ~31) + perm32(R & 31)) : R;
        voffA[i] = (unsigned)(R * LD + C) * 2u; voffB[i] = (unsigned)(Rb * LD + C) * 2u; }
    constexpr size_t kstep = (size_t)(BK * 2);
    constexpr size_t hstep = (size_t)HALF * LD * 2;
    constexpr size_t tstep = 2 * hstep;
    const unsigned ldsw = (unsigned)wid * 1024u;
    const int aoff = lds_byte(wr * 64 + fr, fq * 8), boff = lds_byte(wc * 32 + fr, fq * 8);
#define PG8_SA(b, h) (((b) * 2 + (h)) * HTB)
#define PG8_SB(b, h) ((4 + (b) * 2 + (h)) * HTB)
#define PG8_STAGE(bufoff, gbase, voff) do { _Pragma("unroll") for (int _i = 0; _i < 2; ++_i) \
        __builtin_amdgcn_global_load_lds((const unsigned*)((const char*)(gbase) + (voff)[_i]), (PG8_LAS unsigned*)(lds + (bufoff) + ldsw + _i * 8192), 16, 0, 0); } while (0)
#define PG8_LDA(dst, b, h) do { _Pragma("unroll") for (int m = 0; m < 4; ++m) _Pragma("unroll") for (int k = 0; k < 2; ++k) dst[m][k] = *(const PG8_LAS bf16x8*)(lds + PG8_SA(b, h) + aoff + m * 2048 + k * 1024); } while (0)
#define PG8_LDB(dst, b, h) do { _Pragma("unroll") for (int n = 0; n < 2; ++n) _Pragma("unroll") for (int k = 0; k < 2; ++k) dst[n][k] = *(const PG8_LAS bf16x8*)(lds + PG8_SB(b, h) + boff + n * 2048 + k * 1024); } while (0)
#define PG8_MMA(ai, bj, At, Bt) do { __builtin_amdgcn_s_setprio(1); _Pragma("unroll") for (int m = 0; m < 4; ++m) _Pragma("unroll") for (int n = 0; n < 2; ++n) _Pragma("unroll") for (int k = 0; k < 2; ++k) \
        acc[ai][bj][m][n] = __builtin_amdgcn_mfma_f32_16x16x32_bf16(Bt[n][k], At[m][k], acc[ai][bj][m][n], 0, 0, 0); __builtin_amdgcn_s_setprio(0); } while (0)
#define PG8_WAIT_V(n) asm volatile("s_waitcnt vmcnt(" #n ")" ::: "memory")
#define PG8_WAIT_L(n) asm volatile("s_waitcnt lgkmcnt(" #n ")" ::: "memory")
#define PG8_BAR __builtin_amdgcn_s_barrier()
#define PG8_SCHED __builtin_amdgcn_sched_barrier(0)
    Unit cur, nxt; int ui = 0;
    if (!S.next(0, cur)) return;
    f32x4 acc[2][2][4][2];
#pragma unroll
    for (int a = 0; a < 2; ++a)
#pragma unroll
        for (int b = 0; b < 2; ++b)
#pragma unroll
            for (int m = 0; m < 4; ++m)
#pragma unroll
                for (int n = 0; n < 2; ++n) acc[a][b][m][n] = (f32x4){0.f, 0.f, 0.f, 0.f};
    bf16x8 At[4][2], B0[2][2], B1[2][2];
    const char* cA = (const char*)g.A + (size_t)cur.pm * tstep + (VARK ? cur.kofs : 0); const char* cB = (const char*)g.Bt + (size_t)cur.pn * tstep + (VARK ? cur.kofs : 0);
    S.a_ready(cur);
    if constexpr (SP2) {
        PG8_STAGE(PG8_SB(0, 0), cB, voffB); PG8_STAGE(PG8_SB(0, 1), cB + hstep, voffB); PG8_STAGE(PG8_SA(0, 0), cA, voffA); PG8_STAGE(PG8_SA(0, 1), cA + hstep, voffA);
        if (wr == 1) PG8_BAR;
        PG8_WAIT_V(2); PG8_BAR;
        PG8_STAGE(PG8_SB(1, 0), cB + kstep, voffB); PG8_STAGE(PG8_SA(1, 0), cA + kstep, voffA); PG8_STAGE(PG8_SB(1, 1), cB + hstep + kstep, voffB);
        PG8_WAIT_V(6); PG8_BAR;
    } else {
        PG8_STAGE(PG8_SB(0, 0), cB, voffB); PG8_STAGE(PG8_SA(0, 0), cA, voffA); PG8_STAGE(PG8_SB(0, 1), cB + hstep, voffB); PG8_STAGE(PG8_SA(0, 1), cA + hstep, voffA);
        if (wr == 1) PG8_BAR;
        PG8_WAIT_V(4); PG8_BAR;
        PG8_STAGE(PG8_SB(1, 0), cB + kstep, voffB); PG8_STAGE(PG8_SA(1, 0), cA + kstep, voffA); PG8_STAGE(PG8_SB(1, 1), cB + hstep + kstep, voffB);
        PG8_WAIT_V(6); PG8_BAR;
    }
    for (;;) {
        const bool has_next = S.next(ui + 1, nxt);
        const char* nA = has_next ? (const char*)g.A + (size_t)nxt.pm * tstep + (VARK ? nxt.kofs : 0) : cA; const char* nB = has_next ? (const char*)g.Bt + (size_t)nxt.pn * tstep + (VARK ? nxt.kofs : 0) : cB;
        const int nt = VARK ? cur.nt : ntc;
        for (int t = 0; t < nt; t += 2) {
            const bool last = (t == nt - 2); const bool fin = last && !has_next;
            const char* a1 = cA + (size_t)(t + 1) * kstep;
            const char* a2 = last ? nA : cA + (size_t)(t + 2) * kstep; const char* b2 = last ? nB : cB + (size_t)(t + 2) * kstep;
            const char* a3 = a2 + kstep; const char* b3 = b2 + kstep;
            if (last && has_next) S.a_ready(nxt);
            if constexpr (SP2) {
            PG8_LDB(B0, 0, 0); PG8_LDB(B1, 0, 1); PG8_SCHED; PG8_LDA(At, 0, 0); PG8_STAGE(PG8_SA(1, 1), a1 + hstep, voffA);
            PG8_WAIT_V(8); PG8_WAIT_L(0); PG8_BAR; PG8_MMA(0, 0, At, B0); PG8_MMA(0, 1, At, B1); PG8_BAR; PG8_SCHED;
            PG8_LDA(At, 0, 1); if (NOTAIL && fin) { PG8_WAIT_V(2); } else { PG8_STAGE(PG8_SB(0, 0), b2, voffB); PG8_STAGE(PG8_SB(0, 1), b2 + hstep, voffB); PG8_STAGE(PG8_SA(0, 0), a2, voffA); PG8_WAIT_V(8); }
            PG8_WAIT_L(0); PG8_BAR; PG8_MMA(1, 0, At, B0); PG8_MMA(1, 1, At, B1); PG8_BAR; PG8_SCHED;
            PG8_LDB(B0, 1, 0); PG8_LDB(B1, 1, 1); PG8_SCHED; PG8_LDA(At, 1, 0); if (NOTAIL && fin) { PG8_WAIT_V(0); } else { PG8_STAGE(PG8_SA(0, 1), a2 + hstep, voffA); PG8_WAIT_V(8); }
            PG8_WAIT_L(0); PG8_BAR; PG8_MMA(0, 0, At, B0); PG8_MMA(0, 1, At, B1); PG8_BAR; PG8_SCHED;
            PG8_LDA(At, 1, 1); if (!(NOTAIL && fin)) { PG8_STAGE(PG8_SB(1, 0), b3, voffB); PG8_STAGE(PG8_SB(1, 1), b3 + hstep, voffB); PG8_STAGE(PG8_SA(1, 0), a3, voffA); PG8_WAIT_V(8); }
            PG8_WAIT_L(0); PG8_BAR; PG8_MMA(1, 0, At, B0); PG8_MMA(1, 1, At, B1); PG8_BAR; PG8_SCHED;
            } else {
            PG8_LDB(B0, 0, 0); PG8_SCHED; PG8_LDA(At, 0, 0); PG8_STAGE(PG8_SA(1, 1), a1 + hstep, voffA);
            PG8_WAIT_L(8); PG8_BAR; PG8_WAIT_L(0); PG8_MMA(0, 0, At, B0); PG8_BAR; PG8_SCHED;
            PG8_LDB(B1, 0, 1); PG8_STAGE(PG8_SB(0, 0), b2, voffB);
            PG8_BAR; PG8_WAIT_L(0); PG8_MMA(0, 1, At, B1); PG8_BAR;
            PG8_LDA(At, 0, 1); PG8_STAGE(PG8_SA(0, 0), a2, voffA);
            PG8_BAR; PG8_WAIT_L(0); PG8_MMA(1, 0, At, B0); PG8_BAR; PG8_SCHED;
            PG8_STAGE(PG8_SB(0, 1), b2 + hstep, voffB);
            PG8_WAIT_V(6); PG8_BAR; PG8_MMA(1, 1, At, B1); PG8_BAR;
            PG8_LDB(B0, 1, 0); PG8_SCHED; PG8_LDA(At, 1, 0); PG8_STAGE(PG8_SA(0, 1), a2 + hstep, voffA);
            PG8_WAIT_L(8); PG8_BAR; PG8_WAIT_L(0); PG8_MMA(0, 0, At, B0); PG8_BAR; PG8_SCHED;
            PG8_LDB(B1, 1, 1); PG8_STAGE(PG8_SB(1, 0), b3, voffB);
            PG8_BAR; PG8_WAIT_L(0); PG8_MMA(0, 1, At, B1); PG8_BAR;
            PG8_LDA(At, 1, 1); PG8_STAGE(PG8_SA(1, 0), a3, voffA);
            PG8_BAR; PG8_WAIT_L(0); PG8_MMA(1, 0, At, B0); PG8_BAR; PG8_SCHED;
            PG8_STAGE(PG8_SB(1, 1), b3 + hstep, voffB);
            PG8_WAIT_V(6); PG8_BAR; PG8_MMA(1, 1, At, B1); PG8_BAR;
            }
        }
        if constexpr (ALIGN_EPI) { if (wr == 0) PG8_BAR; }
        if constexpr (!Epi::AFTER_DRAIN) { E(acc, cur, ui, wr, wc, fr, fq); S.done(cur); }
        if (!has_next) break;
#pragma unroll
        for (int a = 0; a < 2; ++a)
#pragma unroll
            for (int b = 0; b < 2; ++b)
#pragma unroll
                for (int m = 0; m < 4; ++m)
#pragma unroll
                    for (int n = 0; n < 2; ++n) acc[a][b][m][n] = (f32x4){0.f, 0.f, 0.f, 0.f};
        cur = nxt; cA = nA; cB = nB; ++ui;
        if constexpr (ALIGN_EPI) { if (wr == 1) PG8_BAR; }
    }
    PG8_WAIT_V(0);
    if constexpr (!ALIGN_EPI) { if (wr == 0) PG8_BAR; }
    PG8_BAR;
    if constexpr (Epi::AFTER_DRAIN) { E.fused(acc, cur, wr, wc, fr, fq, lds, wid, lane); S.done(cur); }
#undef PG8_SA
#undef PG8_SB
#undef PG8_STAGE
#undef PG8_LDA
#undef PG8_LDB
#undef PG8_MMA
#undef PG8_WAIT_V
#undef PG8_WAIT_L
#undef PG8_BAR
#undef PG8_SCHED
}
}
namespace att {
typedef unsigned short bf16_t;
typedef short bf16x8 __attribute__((ext_vector_type(8)));
typedef float f32x16 __attribute__((ext_vector_type(16)));
typedef float f32x4 __attribute__((ext_vector_type(4)));
typedef unsigned u32x4 __attribute__((ext_vector_type(4)));
#define ALAS __attribute__((address_space(3)))
constexpr int MROWS = M;
constexpr int WSF_OFF = 114688;
constexpr int LDS_NEED = WSF_OFF + 8 * 256;
__device__ __forceinline__ int crow(int r, int hi) { return (r & 3) + 8 * (r >> 2) + 4 * hi; }
__device__ __forceinline__ void glds16(const void* gsrc, unsigned lds_dst) { unsigned keep;
    asm volatile("s_mov_b32 %0, m0\n\ts_mov_b32 m0, %2\n\ts_nop 0\n\tglobal_load_lds_dwordx4 %1, off\n\ts_mov_b32 m0, %0" : "=&s"(keep) : "v"(gsrc), "s"(lds_dst) : "memory"); }
typedef float f32x2_t __attribute__((ext_vector_type(2))); typedef __bf16 bf16x2_t __attribute__((ext_vector_type(2)));
__device__ __forceinline__ unsigned cvtpk(float lo, float hi) { f32x2_t v = {lo, hi}; bf16x2_t b = __builtin_convertvector(v, bf16x2_t); return __builtin_bit_cast(unsigned, b); }
__device__ __forceinline__ void glds16s(const void* sbase, unsigned voff, unsigned lds_dst) { unsigned keep;
    asm volatile("s_mov_b32 %0, m0\n\ts_mov_b32 m0, %3\n\ts_nop 0\n\tglobal_load_lds_dwordx4 %1, %2\n\ts_mov_b32 m0, %0" : "=&s"(keep) : "v"(voff), "s"(sbase), "s"(lds_dst) : "memory"); }
#define ATT_WAIT_BAR(N) asm volatile("s_waitcnt vmcnt(" #N ") lgkmcnt(0)\n\ts_barrier" ::: "memory")
#define ATT_MFMA(a, b, c) __builtin_amdgcn_mfma_f32_32x32x16_bf16(a, b, c, 0, 0, 0)

struct Tensors { unsigned char* ws; const ALAS float* subln; };
__device__ __forceinline__ Tensors make_tensors(unsigned char* ws, const ALAS float* prm) { return Tensors{ws, prm + PRM_SUBLN}; }
#define T_QA ((const bf16_t*)(tws_ + WS_QA))
#define T_KA ((const bf16_t*)(tws_ + WS_KA))
#define T_VA ((const bf16_t*)(tws_ + WS_VA))
#define T_QB ((const bf16_t*)(tws_ + WS_QB))
#define T_KB ((const bf16_t*)(tws_ + WS_KB))
#define T_VB ((const bf16_t*)(tws_ + WS_VB))
#define T_MIX ((bf16_t*)(tws_ + WS_MIX))

#define SBAR() __builtin_amdgcn_sched_barrier(0)
#define PIN(x) asm volatile("" : "+v"(x))
#define PKW(P, B) cvtpk(P[B], P[(B) + 1])
#define EX(v) __builtin_amdgcn_exp2f(v)
#define WB_SEL(n) do { switch (n) { case 0: ATT_WAIT_BAR(0); break; case 1: ATT_WAIT_BAR(1); break; case 2: ATT_WAIT_BAR(2); break; case 3: ATT_WAIT_BAR(3); break; case 4: ATT_WAIT_BAR(4); break; case 6: ATT_WAIT_BAR(6); break; default: ATT_WAIT_BAR(8); } } while (0)
template <bool ISB>
__device__ __forceinline__ void attn_unit(const Tensors& T, int head, int qb, float negM2, float lam, float c2, int dskip, char* shm, int wave_id) {
    unsigned char* tws_ = T.ws; LAUNDER_G(tws_);
    constexpr int DV = ISB ? 128 : 64, ND0 = DV / 32, NK = ISB ? 2 : 1, NV = ISB ? 2 : 1;
    constexpr int KSLOT = ISB ? 16384 : 8192, VSLOT = ISB ? 16384 : 8192, LDS_K = 0, LDS_V = 3 * KSLOT;
    int tid_ = wave_id * 64 + lane_id_v(); asm volatile("" : "+v"(tid_));
    const int tid = tid_, lane = tid & 63, r32 = lane & 31, hi = lane >> 5; const int wid = __builtin_amdgcn_readfirstlane(tid >> 6);
    const int mapc = ISB ? (wid >> 2) : 0, wq = ISB ? (wid & 3) : wid;
    const int q0 = ISB ? qb * 128 : qb * 256; const int qrow = q0 + wq * 32 + r32;
    int t0 = 0, t1 = 256;
    if (ISB) { const int lo = q0 - dskip, hi_ = q0 + 127 + dskip; t0 = lo > 0 ? (lo >> 6) : 0; t1 = (hi_ >> 6) + 1; if (t1 > 256) t1 = 256;
        if ((t1 - t0) & 1) { if (t0 > 0) --t0; else ++t1; } }
    const int n = t1 - t0;
    const unsigned lds0 = (unsigned)(uintptr_t)shm;
    const ALAS char* shm3 = (const ALAS char*)shm;
    const char* k1b = ISB ? (const char*)(T_KB + (size_t)(2 * head) * MROWS * 64) + (size_t)t0 * 8192 : (const char*)(T_KA + (size_t)(head >> 2) * MROWS * 64);
    const char* k2b = ISB ? (const char*)(T_KB + (size_t)(2 * head + 1) * MROWS * 64) + (size_t)t0 * 8192 : nullptr;
    const char* vb_ = ISB ? (const char*)(T_VB + (size_t)head * MROWS * 128) + (size_t)t0 * 16384 : (const char*)(T_VA + (size_t)(head >> 2) * MROWS * 64);
    const unsigned dvo = (unsigned)(wid * 1024 + lane * 16);
    const unsigned kdst = lds0 + LDS_K + wid * 1024, vdst = lds0 + LDS_V + wid * 1024;
#define DMA_K(i, so) do { glds16s(k1b + (size_t)(i) * 8192, dvo, (unsigned)__builtin_amdgcn_readfirstlane(kdst + (so))); if (ISB) glds16s(k2b + (size_t)(i) * 8192, dvo, (unsigned)__builtin_amdgcn_readfirstlane(kdst + (so) + 8192)); } while (0)
#define DMA_V(i, so) do { if (ISB) { glds16s(vb_ + (size_t)(i) * 16384, dvo, (unsigned)__builtin_amdgcn_readfirstlane(vdst + (so))); glds16s(vb_ + (size_t)(i) * 16384 + 8192, dvo, (unsigned)__builtin_amdgcn_readfirstlane(vdst + (so) + 8192)); } \
      else glds16s(vb_ + (size_t)(i) * 8192, dvo, (unsigned)__builtin_amdgcn_readfirstlane(vdst + (so))); } while (0)
    DMA_K(0, 0); DMA_V(0, 0); DMA_K(1, KSLOT); DMA_V(1, VSLOT);
    const bf16_t* Qw = (ISB ? T_QB + (size_t)(2 * head + mapc) * MROWS * 64 : T_QA + (size_t)head * MROWS * 64) + (size_t)qrow * 64;
    bf16x8 qr[4];
#pragma unroll
    for (int d0 = 0; d0 < 4; ++d0) qr[d0] = *(const bf16x8*)(Qw + d0 * 16 + hi * 8);
    f32x16 o[ND0];
#pragma unroll
    for (int d = 0; d < ND0; ++d) o[d] = f32x16{};
    f32x16 negm;
#pragma unroll
    for (int r = 0; r < 16; ++r) negm[r] = negM2;
    asm volatile("" : "+v"(negm));
    float l_reg = 0.f;
    f32x16 osum = f32x16{}; bf16x8 ones; { const short o1 = (short)0x3f80; ones = (bf16x8){o1, o1, o1, o1, o1, o1, o1, o1}; } asm volatile("" : "+v"(ones));
    const ALAS char* kp0 = shm3 + LDS_K + (ISB ? mapc * 8192 : 0) + hi * 1024 + r32 * 16;
    const ALAS char* vp0 = shm3 + LDS_V + hi * (DV * 16) + r32 * 16;
    const int qw_lo = q0 + wq * 32, qw_hi = qw_lo + 31;
    const float nc2 = -c2; const float dl0 = (float)(64 * t0 - qrow + 4 * hi);
#define BIAS_GEN4(X, B, DC) do { const float e1_ = (DC) + 1.0f, e2_ = (DC) + 2.0f, e3_ = e1_ + 2.0f; \
        X[B] = __builtin_fmaf(__builtin_fabsf(DC), nc2, negM2); X[(B) + 1] = __builtin_fmaf(__builtin_fabsf(e1_), nc2, negM2); X[(B) + 2] = __builtin_fmaf(__builtin_fabsf(e2_), nc2, negM2); X[(B) + 3] = __builtin_fmaf(__builtin_fabsf(e3_), nc2, negM2); DC += 8.0f; } while (0)
#define BIAS_FAST4(X, B, DC) do { X[B] = __builtin_fmaf(sc1_, (DC), negM2); float t1_ = X[B] + sc1_; asm volatile("" : "+v"(t1_)); float t2_ = X[B] + sc2_; asm volatile("" : "+v"(t2_)); X[(B) + 1] = t1_; X[(B) + 2] = t2_; X[(B) + 3] = X[B] + sc3_; DC += 8.0f; } while (0)
#define BIAS_ALL(X0, X1, DL) do { float dc_ = (DL); BIAS_GEN4(X0, 0, dc_); BIAS_GEN4(X0, 4, dc_); BIAS_GEN4(X0, 8, dc_); BIAS_GEN4(X0, 12, dc_); BIAS_GEN4(X1, 0, dc_); BIAS_GEN4(X1, 4, dc_); BIAS_GEN4(X1, 8, dc_); BIAS_GEN4(X1, 12, dc_); } while (0)
#ifdef BIAS_CONST
    float cst[32];
#pragma unroll
    for (int e = 0; e < 32; ++e) { float cv_ = c2 * (float)(8 * (e >> 2) + (e & 3)); asm volatile("" : "+v"(cv_)); cst[e] = __builtin_bit_cast(float, __builtin_amdgcn_readfirstlane(__builtin_bit_cast(int, cv_))); }
#define BIAS_STEP_SETUP() const float base_ = __builtin_fmaf(sc1_, dcn_, negM2); float sgn_ = above_ ? -1.0f : 1.0f; asm volatile("" : "+v"(sgn_))
#else
#define BIAS_STEP_SETUP() do {} while (0)
#endif
    f32x16 pA0, pA1, pB0, pB1;
    bf16x8 kf[8], vf[4]; u32x4 pw0, pw1, pw2, pw3;
    int ks_prev = 0, ks_cur = 0, ks_next = KSLOT, vs_prev = 0, vs_cur = VSLOT, vs_next = 2 * VSLOT, vs_n2 = 3 * VSLOT;
#define ROTK() do { ks_prev = ks_cur; ks_cur = ks_next; ks_next = (ks_next == 2 * KSLOT) ? 0 : ks_next + KSLOT; } while (0)
#define ROT() do { ROTK(); const int tv_ = vs_prev; vs_prev = vs_cur; vs_cur = vs_next; vs_next = vs_n2; vs_n2 = tv_; } while (0)
    DMA_K(2, 2 * KSLOT);
    WB_SEL(2 * NV + 2 * NK);
    if (ISB) { BIAS_ALL(pA0, pA1, dl0); } else { pA0 = negm; pA1 = negm; }
    {
        const ALAS char* kp = kp0;
#pragma unroll
        for (int d0 = 0; d0 < 4; ++d0) { const bf16x8 b0 = *(const ALAS bf16x8*)(kp + d0 * 2048), b1 = *(const ALAS bf16x8*)(kp + d0 * 2048 + 512);
            pA0 = ATT_MFMA(b0, qr[d0], pA0); pA1 = ATT_MFMA(b1, qr[d0], pA1); }
#pragma unroll
        for (int r = 0; r < 16; ++r) { pA0[r] = EX(pA0[r]); pA1[r] = EX(pA1[r]); }
    }
    WB_SEL(0);
    DMA_K(3, 0); DMA_V(2, 2 * VSLOT);
    ROTK();
#define KLOAD2(base, j) do { kf[2 * (j)] = *(const ALAS bf16x8*)((base) + (j) * 2048); kf[2 * (j) + 1] = *(const ALAS bf16x8*)((base) + (j) * 2048 + 512); } while (0)
    { const ALAS char* kb_ = kp0 + ks_cur; KLOAD2(kb_, 0); KLOAD2(kb_, 1); KLOAD2(kb_, 2); KLOAD2(kb_, 3); }
    if (ISB) { BIAS_ALL(pB0, pB1, dl0 + 64.f); }
    WB_SEL(NK + NV);
#define PAF(k) __builtin_bit_cast(bf16x8, pw##k)
#if (B_ORDER & 1)
#define GAPA(MF, A0, A1, A2, A3, W0, W1, PW) do { if (ISB) { sacc += A0; sacc += A1; sacc += A2; sacc += A3; PIN(sacc); } W0; W1; PIN(PW); SBAR(); MF; SBAR(); } while (0)
#else
#define GAPA(MF, A0, A1, A2, A3, W0, W1, PW) do { MF; if (ISB) { sacc += A0; sacc += A1; sacc += A2; sacc += A3; PIN(sacc); } W0; W1; PIN(PW); SBAR(); } while (0)
#endif
#define GAPB(MF, X, B) do { MF; X[B] = EX(X[B]); X[(B) + 1] = EX(X[(B) + 1]); X[(B) + 2] = EX(X[(B) + 2]); X[(B) + 3] = EX(X[(B) + 3]); PIN(X); SBAR(); } while (0)
#define GAPX(MF, EXS, X) do { MF; EXS; PIN(X); SBAR(); } while (0)
#define EXE(C0, C1, k) do { if ((k) < 16) C0[(k) & 15] = EX(C0[(k) & 15]); else C1[(k) & 15] = EX(C1[(k) & 15]); } while (0)
#define EXN(C0, C1, k, N) do { EXE(C0, C1, k); if ((N) > 1) EXE(C0, C1, (k) + 1); if ((N) > 2) EXE(C0, C1, (k) + 2); } while (0)
#if (B_ORDER & 2)
#define GAPEN(MF, C0, C1, k, N) do { EXN(C0, C1, k, N); PIN(C0); PIN(C1); SBAR(); MF; SBAR(); } while (0)
#else
#define GAPEN(MF, C0, C1, k, N) do { MF; EXN(C0, C1, k, N); PIN(C0); PIN(C1); SBAR(); } while (0)
#endif
#define GAPE3(MF, C0, C1, k) do { MF; EXE(C0, C1, k); EXE(C0, C1, (k) + 1); EXE(C0, C1, (k) + 2); PIN(C0); PIN(C1); SBAR(); } while (0)
#ifdef BIAS_CONST
#define GAPC(MF, G, X, B, E0) do { MF; if (G) { { float a0_ = __builtin_fmaf(sgn_, cst[(E0) + (B)], base_), a1_ = __builtin_fmaf(sgn_, cst[(E0) + (B) + 1], base_), a2_ = __builtin_fmaf(sgn_, cst[(E0) + (B) + 2], base_), a3_ = __builtin_fmaf(sgn_, cst[(E0) + (B) + 3], base_); asm volatile("" : "+v"(a0_), "+v"(a1_), "+v"(a2_), "+v"(a3_)); X[B] = a0_; X[(B) + 1] = a1_; X[(B) + 2] = a2_; X[(B) + 3] = a3_; } \
        if (__builtin_expect(!fastb_, 0)) { float dg_ = dcn_ + (float)(8 * (((E0) + (B)) >> 2)); BIAS_GEN4(X, B, dg_); } PIN(X); } SBAR(); } while (0)
#else
#define GAPC(MF, G, X, B, E0) do { MF; if (G) { BIAS_FAST4(X, B, dcn_); if (__builtin_expect(!fastb_, 0)) { float dg_ = dcn_ - 8.0f; BIAS_GEN4(X, B, dg_); } PIN(X); } SBAR(); } while (0)
#endif
#define VRD(i) do { vf[i] = *(const ALAS bf16x8*)(vp_ + ((i) & 3) * (DV * 32) + ((i) >> 2) * 512); } while (0)
#define VRDN(i, d) do { vf[i] = *(const ALAS bf16x8*)(vp_ + (i) * (DV * 32) + (d) * 512); } while (0)
#define VRDA(i) do { vf[i] = *(const ALAS bf16x8*)(vp_ + (i) * (DV * 32) + 512); } while (0)
#define VRD2(i) do { vf[i] = *(const ALAS bf16x8*)(vp_ + ((i) & 3) * (DV * 32) + (((i) >> 2) + 2) * 512); } while (0)
#define KRD(G, j) do { if (G) { KLOAD2(kn_, j); SBAR(); } } while (0)
#define KRD1(G, j) do { if (G) { kf[j] = *(const ALAS bf16x8*)(kn_ + ((j) >> 1) * 2048 + ((j) & 1) * 512); SBAR(); } } while (0)
#define CIN(C) (ISB ? C : negm)
#define STEP(C0, C1, P0, P1, i, GK, GV, GL) do { SBAR(); \
    const ALAS char* vp_ = vp0 + vs_prev; const ALAS char* kn_ = kp0 + ks_next; float dcn_ = dl0 + 64.f * (float)((i) + 1); const int kt_ = 64 * (t0 + (i) + 1); const bool above_ = kt_ > qw_hi, fastb_ = above_ || (kt_ + 63 < qw_lo); \
    const float sc1_ = above_ ? nc2 : c2, sc2_ = sc1_ + sc1_, sc3_ = sc2_ + sc1_; BIAS_STEP_SETUP(); \
    VRD(0); SBAR(); float sacc = P0[0] + P0[1]; \
    GAPA(C0 = ATT_MFMA(kf[0], qr[0], CIN(C0)), P0[2], P0[3], P0[4], P0[5],     pw0[0] = PKW(P0, 0), pw0[1] = PKW(P0, 2), pw0); \
    SBAR(); GAPA(C1 = ATT_MFMA(kf[1], qr[0], CIN(C1)), P0[6], P0[7], P0[8], P0[9],     pw0[2] = PKW(P0, 4), pw0[3] = PKW(P0, 6), pw0); \
    VRD(1); SBAR(); GAPA(C0 = ATT_MFMA(kf[2], qr[1], C0),   P0[10], P0[11], P0[12], P0[13], pw1[0] = PKW(P0, 8), pw1[1] = PKW(P0, 10), pw1); \
    SBAR(); GAPA(C1 = ATT_MFMA(kf[3], qr[1], C1),   P0[14], P0[15], P1[0], P1[1],   pw1[2] = PKW(P0, 12), pw1[3] = PKW(P0, 14), pw1); \
    VRD(2); SBAR(); GAPA(C0 = ATT_MFMA(kf[4], qr[2], C0),   P1[2], P1[3], P1[4], P1[5],     pw2[0] = PKW(P1, 0), pw2[1] = PKW(P1, 2), pw2); \
    SBAR(); GAPA(C1 = ATT_MFMA(kf[5], qr[2], C1),   P1[6], P1[7], P1[8], P1[9],     pw2[2] = PKW(P1, 4), pw2[3] = PKW(P1, 6), pw2); \
    VRD(3); SBAR(); GAPA(C0 = ATT_MFMA(kf[6], qr[3], C0),   P1[10], P1[11], P1[12], P1[13], pw3[0] = PKW(P1, 8), pw3[1] = PKW(P1, 10), pw3); \
    SBAR(); GAPA(C1 = ATT_MFMA(kf[7], qr[3], C1),   P1[14], P1[15], 0.f, 0.f,       pw3[2] = PKW(P1, 12), pw3[3] = PKW(P1, 14), pw3); \
    l_reg += sacc; \
    if (BDMA_MODE < 4) { if (GK) { DMA_K((i) + 3, ks_cur); } } if (BDMA_MODE == 0 || BDMA_MODE == 4) { if (GV) { DMA_V((i) + 2, vs_n2); } } \
    SBAR(); \
    if (!ISB) { \
        GAPX(o[0] = ATT_MFMA(PAF(0), vf[0], o[0]), C0[0] = EX(C0[0]); C0[1] = EX(C0[1]); C0[2] = EX(C0[2]), C0); \
        VRDA(0); SBAR(); GAPX(o[0] = ATT_MFMA(PAF(1), vf[1], o[0]), C0[3] = EX(C0[3]); C0[4] = EX(C0[4]); C0[5] = EX(C0[5]), C0); \
        VRDA(1); SBAR(); GAPX(osum = ATT_MFMA(PAF(0), ones, osum),  C0[6] = EX(C0[6]); C0[7] = EX(C0[7]); C0[8] = EX(C0[8]), C0); \
        GAPX(o[0] = ATT_MFMA(PAF(2), vf[2], o[0]), C0[9] = EX(C0[9]); C0[10] = EX(C0[10]); C0[11] = EX(C0[11]), C0); \
        VRDA(2); SBAR(); GAPX(o[0] = ATT_MFMA(PAF(3), vf[3], o[0]), C0[12] = EX(C0[12]); C0[13] = EX(C0[13]); C0[14] = EX(C0[14]), C0); \
        VRDA(3); SBAR(); GAPX(osum = ATT_MFMA(PAF(1), ones, osum),  C0[15] = EX(C0[15]); C1[0] = EX(C1[0]); C1[1] = EX(C1[1]), C1); PIN(C0); \
        KRD(GL, 0); GAPX(o[1] = ATT_MFMA(PAF(0), vf[0], o[1]), C1[2] = EX(C1[2]); C1[3] = EX(C1[3]); C1[4] = EX(C1[4]), C1); \
        KRD(GL, 1); GAPX(o[1] = ATT_MFMA(PAF(1), vf[1], o[1]), C1[5] = EX(C1[5]); C1[6] = EX(C1[6]); C1[7] = EX(C1[7]), C1); \
        KRD(GL, 2); GAPX(osum = ATT_MFMA(PAF(2), ones, osum),  C1[8] = EX(C1[8]); C1[9] = EX(C1[9]); C1[10] = EX(C1[10]), C1); \
        KRD(GL, 3); GAPX(o[1] = ATT_MFMA(PAF(2), vf[2], o[1]), C1[11] = EX(C1[11]); C1[12] = EX(C1[12]), C1); \
        GAPX(o[1] = ATT_MFMA(PAF(3), vf[3], o[1]), C1[13] = EX(C1[13]); C1[14] = EX(C1[14]), C1); \
        GAPX(osum = ATT_MFMA(PAF(3), ones, osum),  C1[15] = EX(C1[15]), C1); \
    } else { \
        GAPEN(o[0] = ATT_MFMA(PAF(0), vf[0], o[0]), C0, C1, 0, 3);  VRDN(0, 1); KRD1(GL, 0); SBAR(); \
        GAPEN(o[0] = ATT_MFMA(PAF(1), vf[1], o[0]), C0, C1, 3, 2);  VRDN(1, 1); KRD1(GL, 1); SBAR(); \
        GAPEN(o[0] = ATT_MFMA(PAF(2), vf[2], o[0]), C0, C1, 5, 3);  VRDN(2, 1); KRD1(GL, 2); SBAR(); \
        GAPEN(o[0] = ATT_MFMA(PAF(3), vf[3], o[0]), C0, C1, 8, 2);  VRDN(3, 1); KRD1(GL, 3); SBAR(); \
        if (BDMA_MODE == 2) { if (GV) { DMA_V((i) + 2, vs_n2); } SBAR(); } \
        GAPEN(o[1] = ATT_MFMA(PAF(0), vf[0], o[1]), C0, C1, 10, 3); VRDN(0, 2); KRD1(GL, 4); SBAR(); \
        GAPEN(o[1] = ATT_MFMA(PAF(1), vf[1], o[1]), C0, C1, 13, 2); VRDN(1, 2); KRD1(GL, 5); SBAR(); \
        GAPEN(o[1] = ATT_MFMA(PAF(2), vf[2], o[1]), C0, C1, 15, 3); VRDN(2, 2); KRD1(GL, 6); SBAR(); \
        GAPEN(o[1] = ATT_MFMA(PAF(3), vf[3], o[1]), C0, C1, 18, 2); VRDN(3, 2); KRD1(GL, 7); SBAR(); \
        if (BDMA_MODE == 1 || BDMA_MODE == 5) { if (GV) { DMA_V((i) + 2, vs_n2); } SBAR(); } if (BDMA_MODE == 4 || BDMA_MODE == 5) { if (GK) { DMA_K((i) + 3, ks_cur); } SBAR(); } \
        GAPC(o[ND0 - 2] = ATT_MFMA(PAF(0), vf[0], o[ND0 - 2]); EXN(C0, C1, 20, 2), GL, P0, 0, 0);  VRDN(0, 3); SBAR(); \
        GAPC(o[ND0 - 2] = ATT_MFMA(PAF(1), vf[1], o[ND0 - 2]); EXN(C0, C1, 22, 1), GL, P0, 4, 0);  VRDN(1, 3); SBAR(); \
        GAPC(o[ND0 - 2] = ATT_MFMA(PAF(2), vf[2], o[ND0 - 2]); EXN(C0, C1, 23, 2), GL, P0, 8, 0);  VRDN(2, 3); SBAR(); \
        GAPC(o[ND0 - 2] = ATT_MFMA(PAF(3), vf[3], o[ND0 - 2]); EXN(C0, C1, 25, 1), GL, P0, 12, 0); VRDN(3, 3); SBAR(); \
        GAPC(o[ND0 - 1] = ATT_MFMA(PAF(0), vf[0], o[ND0 - 1]); EXN(C0, C1, 26, 2), GL, P1, 0, 16); \
        GAPC(o[ND0 - 1] = ATT_MFMA(PAF(1), vf[1], o[ND0 - 1]); EXN(C0, C1, 28, 1), GL, P1, 4, 16); \
        GAPC(o[ND0 - 1] = ATT_MFMA(PAF(2), vf[2], o[ND0 - 1]); EXN(C0, C1, 29, 2), GL, P1, 8, 16); \
        GAPC(o[ND0 - 1] = ATT_MFMA(PAF(3), vf[3], o[ND0 - 1]); EXN(C0, C1, 31, 1); PIN(C1), GL, P1, 12, 16); \
        if (BDMA_MODE == 3) { if (GV) { DMA_V((i) + 2, vs_n2); } SBAR(); } \
    } } while (0)
    int i = 1;
    for (; i + 5 < n; i += 2) {
        STEP(pB0, pB1, pA0, pA1, i, true, true, true);     WB_SEL(NK + 2 * NV); ROT();
        STEP(pA0, pA1, pB0, pB1, i + 1, true, true, true); WB_SEL(NK + 2 * NV); ROT();
    }
#define ENDW(ii) do { if ((ii) + 3 < n) { WB_SEL(NK + 2 * NV); } else if ((ii) + 2 < n) { WB_SEL(2 * NV); } else { WB_SEL(0); } } while (0)
    for (; i + 1 < n; i += 2) {
        STEP(pB0, pB1, pA0, pA1, i, (i + 3 < n), (i + 2 < n), (i + 1 < n));         ENDW(i);     ROT();
        STEP(pA0, pA1, pB0, pB1, i + 1, (i + 4 < n), (i + 3 < n), (i + 2 < n));     ENDW(i + 1); ROT();
    }
    STEP(pB0, pB1, pA0, pA1, n - 1, false, false, false);
    { if (ISB) { float sacc = pB0[0] + pB0[1];
#pragma unroll
      for (int r = 2; r < 16; ++r) sacc += pB0[r];
#pragma unroll
      for (int r = 0; r < 16; ++r) sacc += pB1[r];
      l_reg += sacc; }
      pw0 = (u32x4){PKW(pB0, 0), PKW(pB0, 2), PKW(pB0, 4), PKW(pB0, 6)}; pw1 = (u32x4){PKW(pB0, 8), PKW(pB0, 10), PKW(pB0, 12), PKW(pB0, 14)};
      pw2 = (u32x4){PKW(pB1, 0), PKW(pB1, 2), PKW(pB1, 4), PKW(pB1, 6)}; pw3 = (u32x4){PKW(pB1, 8), PKW(pB1, 10), PKW(pB1, 12), PKW(pB1, 14)};
      SBAR();
      const ALAS char* vp_ = vp0 + vs_cur;
#pragma unroll
      for (int d = 0; d < ND0; ++d) {
          const bf16x8 v0 = *(const ALAS bf16x8*)(vp_ + 0 * (DV * 32) + d * 512), v1 = *(const ALAS bf16x8*)(vp_ + 1 * (DV * 32) + d * 512), v2 = *(const ALAS bf16x8*)(vp_ + 2 * (DV * 32) + d * 512), v3 = *(const ALAS bf16x8*)(vp_ + 3 * (DV * 32) + d * 512);
          o[d] = ATT_MFMA(PAF(0), v0, o[d]); o[d] = ATT_MFMA(PAF(1), v1, o[d]); o[d] = ATT_MFMA(PAF(2), v2, o[d]); o[d] = ATT_MFMA(PAF(3), v3, o[d]); }
      if (!ISB) { osum = ATT_MFMA(PAF(0), ones, osum); osum = ATT_MFMA(PAF(1), ones, osum); osum = ATT_MFMA(PAF(2), ones, osum); osum = ATT_MFMA(PAF(3), ones, osum); } }
    const float sacc = l_reg;
    const int lane_e = lane_id_v();
    ATT_WAIT_BAR(0);
    {
    const int lane = lane_e, r32 = lane & 31, hi = lane >> 5; const int q0 = ISB ? qb * 128 : qb * 256;
    float rli[16];
    ALAS float* wsf = (ALAS float*)(shm3 + WSF_OFF) + wid * 64;
    if (ISB) {
        const float l = sum_x32(sacc);
        if (hi == 0) wsf[r32] = l;
        asm volatile("s_waitcnt lgkmcnt(0)" ::: "memory");
#pragma unroll
        for (int r = 0; r < 16; ++r) rli[r] = __builtin_amdgcn_rcpf(wsf[crow(r, hi)]);
    } else {
#pragma unroll
        for (int r = 0; r < 16; ++r) rli[r] = __builtin_amdgcn_rcpf(osum[r]);
    }
    if (!ISB) {
        ALAS bf16_t* stg = (ALAS bf16_t*)shm3 + wid * 2048;
#pragma unroll
        for (int r = 0; r < 16; ++r) { const int orow = crow(r, hi);
#pragma unroll
            for (int d = 0; d < ND0; ++d) stg[orow * 64 + d * 32 + r32] = pg8::f2bf1(o[d][r] * rli[r]); }
        asm volatile("s_waitcnt lgkmcnt(0)" ::: "memory");
#pragma unroll
        for (int i = 0; i < 4; ++i) { const int row = i * 8 + (lane >> 3), ch = lane & 7; const u32x4 v = *(const ALAS u32x4*)(stg + row * 64 + ch * 8);
            *(u32x4*)(T_MIX + (size_t)(q0 + wid * 32 + row) * 1024 + head * 64 + ch * 8) = v; }
    } else {
        ALAS float* X = (ALAS float*)shm3 + wq * 4096;
        const float sc = (mapc == 1) ? lam : 1.0f;
        if (mapc == 1) {
#pragma unroll
            for (int r = 0; r < 16; ++r) { const int orow = crow(r, hi); const float f = rli[r] * sc;
#pragma unroll
                for (int d = 0; d < ND0; ++d) X[orow * 128 + d * 32 + r32] = o[d][r] * f; }
        }
        asm volatile("s_waitcnt lgkmcnt(0)\n\ts_barrier" ::: "memory");
        if (mapc == 0) {
#pragma unroll
            for (int r = 0; r < 16; ++r) { const int orow = crow(r, hi);
#pragma unroll
                for (int d = 0; d < ND0; ++d) { const int idx = orow * 128 + d * 32 + r32; X[idx] = o[d][r] * rli[r] - X[idx]; } }
            asm volatile("s_waitcnt lgkmcnt(0)" ::: "memory");
            const int qq = lane >> 1, hf = lane & 1;
            const ALAS float* rowp = X + qq * 128 + hf * 64;
            f32x4 vv[16]; float ss = 0.f;
#pragma unroll
            for (int i = 0; i < 16; ++i) { vv[i] = *(const ALAS f32x4*)(rowp + 4 * i); ss += (vv[i][0] * vv[i][0] + vv[i][1] * vv[i][1]) + (vv[i][2] * vv[i][2] + vv[i][3] * vv[i][3]); }
            ss += xor_lane<1>(ss);
            const float rs = 0.8f / sqrtf(ss * (1.0f / 128.0f) + 1e-6f);
            bf16_t* dst = T_MIX + (size_t)(q0 + wq * 32 + qq) * 1024 + 512 + head * 128 + hf * 64;
            const ALAS float* sl = T.subln + hf * 64;
#pragma unroll
            for (int i = 0; i < 8; ++i) { const f32x4 g0 = *(const ALAS f32x4*)(sl + 8 * i), g1 = *(const ALAS f32x4*)(sl + 8 * i + 4); const f32x4 a = vv[2 * i] * rs * g0, b = vv[2 * i + 1] * rs * g1;
                u32x4 w; w.x = cvtpk(a[0], a[1]); w.y = cvtpk(a[2], a[3]); w.z = cvtpk(b[0], b[1]); w.w = cvtpk(b[2], b[3]); *(u32x4*)(dst + 8 * i) = w; }
        }
    }
    }
    asm volatile("s_waitcnt lgkmcnt(0)\n\ts_barrier" ::: "memory");
#undef DMA_K
#undef DMA_V
#undef ROT
#undef STEP
#undef ENDW
#undef GAPA
#undef GAPB
#undef GAPC
#undef GAPE3
#undef GAPEN
#undef EXN
#undef EXE
#undef GAPX
#undef VRD
#undef VRD2
#undef VRDA
#undef VRDN
#undef KRD
#undef KRD1
#undef CIN
#undef PAF
#undef KLOAD2
#undef BIAS_GEN4
#undef BIAS_FAST4
#undef BIAS_ALL
#undef BIAS_STEP_SETUP
}

typedef int i32x8 __attribute__((ext_vector_type(8)));
typedef unsigned u32x8 __attribute__((ext_vector_type(8)));
#define MFMA8(a, b, c) __builtin_amdgcn_mfma_scale_f32_32x32x64_f8f6f4(a, b, c, 0, 0, 0, 0, 0, 0)
__device__ __forceinline__ void attn_unit_a8(const Tensors& T, int head, int qb, float negM2s, char* shm, int wave_id) {
    unsigned char* tws_ = T.ws; LAUNDER_G(tws_);
    constexpr int KSLOT = 4096, VSLOT = 4096, LDS_K = 0, LDS_V = 3 * KSLOT, n = 256;
    int tid_ = wave_id * 64 + lane_id_v(); asm volatile("" : "+v"(tid_));
    const int tid = tid_, lane = tid & 63, r32 = lane & 31, hi = lane >> 5; const int wid = __builtin_amdgcn_readfirstlane(tid >> 6);
    const int q0 = qb * 256; const int qrow = q0 + wid * 32 + r32;
    const unsigned lds0 = (unsigned)(uintptr_t)shm;
    const ALAS char* shm3 = (const ALAS char*)shm;
    const bool kw = wid < 4;
    const char* sb = (const char*)(tws_ + (kw ? WS_KA : WS_VA)) + (size_t)(head >> 2) * MROWS * 64 + (wid & 3) * 1024;
    const unsigned dvo = (unsigned)(lane * 16);
    const unsigned ddst = lds0 + (kw ? LDS_K : LDS_V) + (wid & 3) * 1024;
#define DMA8(i, so) glds16s(sb + (size_t)(i) * 4096, dvo, (unsigned)__builtin_amdgcn_readfirstlane(ddst + (so)))
#define WB8(NKW, NVW) do { if (kw) { WB_SEL(NKW); } else { WB_SEL(NVW); } } while (0)
    if (kw) { DMA8(0, 0); DMA8(1, KSLOT); DMA8(2, 2 * KSLOT); } else { DMA8(0, 0); DMA8(1, VSLOT); }
    const unsigned char* Qw = (tws_ + WS_QA) + ((size_t)head * MROWS + qrow) * 64 + hi * 32;
    i32x8 qf; { const u32x4 a_ = *(const u32x4*)Qw, b_ = *(const u32x4*)(Qw + 16); qf = (i32x8){(int)a_[0], (int)a_[1], (int)a_[2], (int)a_[3], (int)b_[0], (int)b_[1], (int)b_[2], (int)b_[3]}; }
    f32x16 o0 = f32x16{}, o1 = f32x16{}, osum = f32x16{};
    f32x16 negm;
#pragma unroll
    for (int r = 0; r < 16; ++r) negm[r] = negM2s;
    asm volatile("" : "+v"(negm));
    i32x8 ones; { const int o4 = 0x38383838; ones = (i32x8){o4, o4, o4, o4, o4, o4, o4, o4}; } asm volatile("" : "+v"(ones));
    const ALAS char* kp0 = shm3 + LDS_K + hi * 1024 + r32 * 16;
    const ALAS char* vp0 = shm3 + LDS_V + hi * 1024 + r32 * 16;
    f32x16 pA0, pA1, pB0, pB1;
    i32x8 kf0, kf1, vf0, vf1, pf = (i32x8){0, 0, 0, 0, 0, 0, 0, 0};
    int ks_prev = 0, ks_cur = 0, ks_next = KSLOT, vs_prev = 0, vs_cur = VSLOT, vs_next = 2 * VSLOT, vs_n2 = 3 * VSLOT;
#define ROTK8() do { ks_prev = ks_cur; ks_cur = ks_next; ks_next = (ks_next == 2 * KSLOT) ? 0 : ks_next + KSLOT; } while (0)
#define ROT8() do { ROTK8(); const int tv_ = vs_prev; vs_prev = vs_cur; vs_cur = vs_next; vs_next = vs_n2; vs_n2 = tv_; } while (0)
#define LD32(dst, p) do { const u32x4 a_ = *(const ALAS u32x4*)(p), b_ = *(const ALAS u32x4*)((p) + 512); dst = (i32x8){(int)a_[0], (int)a_[1], (int)a_[2], (int)a_[3], (int)b_[0], (int)b_[1], (int)b_[2], (int)b_[3]}; } while (0)
#define PK8(P, B, OLD) __builtin_amdgcn_cvt_pk_fp8_f32(P[(B) + 2], P[(B) + 3], __builtin_amdgcn_cvt_pk_fp8_f32(P[B], P[(B) + 1], OLD, false), true)
    WB8(2, 2);
    { LD32(kf0, kp0); LD32(kf1, kp0 + 2048);
      pA0 = MFMA8(kf0, qf, negm); pA1 = MFMA8(kf1, qf, negm);
#pragma unroll
      for (int r = 0; r < 16; ++r) { pA0[r] = EX(pA0[r]); pA1[r] = EX(pA1[r]); } }
    WB_SEL(0);
    if (kw) { DMA8(3, 0); } else { DMA8(2, 2 * VSLOT); }
    ROTK8();
    { const ALAS char* kb_ = kp0 + ks_cur; LD32(kf0, kb_); LD32(kf1, kb_ + 2048); }
    WB_SEL(1);
#define STEP8(C0, C1, P0, P1, i, GK, GV, GL) do { SBAR(); \
    const ALAS char* vp_ = vp0 + vs_prev; const ALAS char* kn_ = kp0 + ks_next; \
    LD32(vf0, vp_); LD32(vf1, vp_ + 2048); SBAR(); \
    C0 = MFMA8(kf0, qf, negm); \
    pf[0] = PK8(P0, 0, pf[0]); pf[1] = PK8(P0, 4, pf[1]); pf[2] = PK8(P0, 8, pf[2]); pf[3] = PK8(P0, 12, pf[3]); PIN(pf); SBAR(); \
    C1 = MFMA8(kf1, qf, negm); \
    pf[4] = PK8(P1, 0, pf[4]); pf[5] = PK8(P1, 4, pf[5]); pf[6] = PK8(P1, 8, pf[6]); pf[7] = PK8(P1, 12, pf[7]); PIN(pf); SBAR(); \
    if (kw) { if (GK) { DMA8((i) + 3, ks_cur); } } else { if (GV) { DMA8((i) + 2, vs_n2); } } \
    SBAR(); \
    o0 = MFMA8(pf, vf0, o0); \
    _Pragma("unroll") for (int r_ = 0; r_ < 16; ++r_) C0[r_] = EX(C0[r_]); PIN(C0); SBAR(); \
    if (GL) { LD32(kf0, kn_); LD32(kf1, kn_ + 2048); SBAR(); } \
    o1 = MFMA8(pf, vf1, o1); \
    _Pragma("unroll") for (int r_ = 0; r_ < 8; ++r_) C1[r_] = EX(C1[r_]); PIN(C1); SBAR(); \
    osum = MFMA8(pf, ones, osum); \
    _Pragma("unroll") for (int r_ = 8; r_ < 16; ++r_) C1[r_] = EX(C1[r_]); PIN(C1); SBAR(); \
    } while (0)
    int i = 1;
    for (; i + 5 < n; i += 2) {
        STEP8(pB0, pB1, pA0, pA1, i, true, true, true);     WB8(1, 2); ROT8();
        STEP8(pA0, pA1, pB0, pB1, i + 1, true, true, true); WB8(1, 2); ROT8();
    }
#define ENDW8(ii) do { if ((ii) + 3 < n) { WB8(1, 2); } else if ((ii) + 2 < n) { WB8(0, 2); } else { WB_SEL(0); } } while (0)
    for (; i + 1 < n; i += 2) {
        STEP8(pB0, pB1, pA0, pA1, i, (i + 3 < n), (i + 2 < n), (i + 1 < n));         ENDW8(i);     ROT8();
        STEP8(pA0, pA1, pB0, pB1, i + 1, (i + 4 < n), (i + 3 < n), (i + 2 < n));     ENDW8(i + 1); ROT8();
    }
    STEP8(pB0, pB1, pA0, pA1, n - 1, false, false, false);
    { pf[0] = PK8(pB0, 0, pf[0]); pf[1] = PK8(pB0, 4, pf[1]); pf[2] = PK8(pB0, 8, pf[2]); pf[3] = PK8(pB0, 12, pf[3]); pf[4] = PK8(pB1, 0, pf[4]); pf[5] = PK8(pB1, 4, pf[5]); pf[6] = PK8(pB1, 8, pf[6]); pf[7] = PK8(pB1, 12, pf[7]);
      const ALAS char* vp_ = vp0 + vs_cur; LD32(vf0, vp_); LD32(vf1, vp_ + 2048);
      o0 = MFMA8(pf, vf0, o0); o1 = MFMA8(pf, vf1, o1); osum = MFMA8(pf, ones, osum); }
    ATT_WAIT_BAR(0);
    {
        const int lane_e = lane_id_v(), l32 = lane_e & 31, hh = lane_e >> 5;
        ALAS bf16_t* stg = (ALAS bf16_t*)shm3 + wid * 2048;
#pragma unroll
        for (int r = 0; r < 16; ++r) { const int orow = crow(r, hh); const float rl = __builtin_amdgcn_rcpf(osum[r]);
            stg[orow * 64 + l32] = pg8::f2bf1(o0[r] * rl); stg[orow * 64 + 32 + l32] = pg8::f2bf1(o1[r] * rl); }
        asm volatile("s_waitcnt lgkmcnt(0)" ::: "memory");
#pragma unroll
        for (int i2 = 0; i2 < 4; ++i2) { const int row = i2 * 8 + (lane_e >> 3), ch = lane_e & 7; const u32x4 v = *(const ALAS u32x4*)(stg + row * 64 + ch * 8);
            *(u32x4*)(T_MIX + (size_t)(qb * 256 + wid * 32 + row) * 1024 + head * 64 + ch * 8) = v; }
    }
    asm volatile("s_waitcnt lgkmcnt(0)\n\ts_barrier" ::: "memory");
#undef DMA8
#undef EXPBLK
#undef PACK8
#undef WB8
#undef ROTK8
#undef ROT8
#undef LD32
#undef PK8
#undef STEP8
#undef ENDW8
}

typedef short v2i16_t __attribute__((ext_vector_type(2)));
template<int U>
__device__ __forceinline__ void attn_unit_a8x2(const Tensors& T, int head, int qb, float negM2s, char* shm, int wave_id) {
    unsigned char* tws_ = T.ws; LAUNDER_G(tws_);
    constexpr int KSLOT = 4096, VSLOT = 4096, RS = 3 * U * 4096, LDS_K = 0, LDS_V = RS, n = 256;
    int tid_ = wave_id * 64 + lane_id_v(); asm volatile("" : "+v"(tid_));
    const int tid = tid_, lane = tid & 63, r32 = lane & 31, hi = lane >> 5; const int wid = __builtin_amdgcn_readfirstlane(tid >> 6);
    const int q0 = qb * 512; const int qrow = q0 + wid * 64 + r32;
    const unsigned lds0 = (unsigned)(uintptr_t)shm;
    const ALAS char* shm3 = (const ALAS char*)shm;
    const bool kw = wid < 4;
    const char* sb = (const char*)(tws_ + (kw ? WS_KA : WS_VA)) + (size_t)(head >> 2) * MROWS * 64 + (wid & 3) * 1024;
    const unsigned dvo = (unsigned)(lane * 16);
    const unsigned ddst = lds0 + (kw ? LDS_K : LDS_V) + (wid & 3) * 1024;
#define DMA8(i, so) glds16s(sb + (size_t)(i) * 4096, dvo, (unsigned)__builtin_amdgcn_readfirstlane(ddst + (so)))
#pragma unroll
    for (int i0 = 0; i0 < 2 * U; ++i0) DMA8(i0, i0 * 4096);
    if (kw) DMA8(2 * U, 2 * U * 4096);
    const unsigned char* Qw = (tws_ + WS_QA) + ((size_t)head * MROWS + qrow) * 64 + hi * 32;
    i32x8 qfa, qfb;
    { const u32x4 a_ = *(const u32x4*)Qw, b_ = *(const u32x4*)(Qw + 16); qfa = (i32x8){(int)a_[0], (int)a_[1], (int)a_[2], (int)a_[3], (int)b_[0], (int)b_[1], (int)b_[2], (int)b_[3]}; }
    { const u32x4 a_ = *(const u32x4*)(Qw + 32 * 64), b_ = *(const u32x4*)(Qw + 32 * 64 + 16); qfb = (i32x8){(int)a_[0], (int)a_[1], (int)a_[2], (int)a_[3], (int)b_[0], (int)b_[1], (int)b_[2], (int)b_[3]}; }
    f32x16 oa0 = f32x16{}, oa1 = f32x16{}, osa = f32x16{}, ob0 = f32x16{}, ob1 = f32x16{}, osb = f32x16{};
    f32x16 negm;
#pragma unroll
    for (int r = 0; r < 16; ++r) negm[r] = negM2s;
    asm volatile("" : "+v"(negm));
    i32x8 ones; { const int o4 = 0x38383838; ones = (i32x8){o4, o4, o4, o4, o4, o4, o4, o4}; } asm volatile("" : "+v"(ones));
    const ALAS char* kp0 = shm3 + LDS_K + hi * 1024 + r32 * 16;
    const ALAS char* vp0 = shm3 + LDS_V + hi * 1024 + r32 * 16;
    f32x16 Ca0, Ca1, Cb0, Cb1;
#ifdef A8_EXPH
#define EXPBLK(H, C, b) do { const unsigned h0_ = __builtin_bit_cast(unsigned, __builtin_amdgcn_cvt_pkrtz(C[b], C[(b) + 1])), h1_ = __builtin_bit_cast(unsigned, __builtin_amdgcn_cvt_pkrtz(C[(b) + 2], C[(b) + 3])), \
        h2_ = __builtin_bit_cast(unsigned, __builtin_amdgcn_cvt_pkrtz(C[(b) + 4], C[(b) + 5])), h3_ = __builtin_bit_cast(unsigned, __builtin_amdgcn_cvt_pkrtz(C[(b) + 6], C[(b) + 7])); unsigned d0_, d1_, d2_, d3_; \
        asm volatile("v_exp_f16_e32 %0, %4\n\tv_exp_f16_e32 %1, %5\n\tv_exp_f16_e32 %2, %6\n\tv_exp_f16_e32 %3, %7\n\t" \
                     "v_exp_f16_sdwa %0, %4 dst_sel:WORD_1 dst_unused:UNUSED_PRESERVE src0_sel:WORD_1\n\tv_exp_f16_sdwa %1, %5 dst_sel:WORD_1 dst_unused:UNUSED_PRESERVE src0_sel:WORD_1\n\t" \
                     "v_exp_f16_sdwa %2, %6 dst_sel:WORD_1 dst_unused:UNUSED_PRESERVE src0_sel:WORD_1\n\tv_exp_f16_sdwa %3, %7 dst_sel:WORD_1 dst_unused:UNUSED_PRESERVE src0_sel:WORD_1" \
                     : "=&v"(d0_), "=&v"(d1_), "=&v"(d2_), "=&v"(d3_) : "v"(h0_), "v"(h1_), "v"(h2_), "v"(h3_)); \
        C[(b) / 2] = __builtin_bit_cast(float, d0_); C[(b) / 2 + 1] = __builtin_bit_cast(float, d1_); C[(b) / 2 + 2] = __builtin_bit_cast(float, d2_); C[(b) / 2 + 3] = __builtin_bit_cast(float, d3_); PIN(C); } while (0)
#define PKH(C, j) (int)__builtin_amdgcn_perm(__builtin_bit_cast(unsigned, C[2 * (j) + 1]), __builtin_bit_cast(unsigned, C[2 * (j)]), 0x07050301u)
#define PACK8(H0, H1, C0, C1) do { pf[0] = PKH(C0, 0); pf[1] = PKH(C0, 1); pf[2] = PKH(C0, 2); pf[3] = PKH(C0, 3); pf[4] = PKH(C1, 0); pf[5] = PKH(C1, 1); pf[6] = PKH(C1, 2); pf[7] = PKH(C1, 3); PIN(pf); } while (0)
#else
#define EXPBLK(H, C, b) do { _Pragma("unroll") for (int r_ = (b); r_ < (b) + 8; ++r_) C[r_] = EX(C[r_]); PIN(C); } while (0)
#define PACK8(H0, H1, C0, C1) do { pf[0] = PK8(C0, 0, pf[0]); pf[1] = PK8(C0, 4, pf[1]); pf[2] = PK8(C0, 8, pf[2]); pf[3] = PK8(C0, 12, pf[3]); pf[4] = PK8(C1, 0, pf[4]); pf[5] = PK8(C1, 4, pf[5]); pf[6] = PK8(C1, 8, pf[6]); pf[7] = PK8(C1, 12, pf[7]); PIN(pf); } while (0)
#endif
    i32x8 kf0, kf1, vf0, vf1, pf = (i32x8){0, 0, 0, 0, 0, 0, 0, 0};
#define LD32(dst, p) do { const u32x4 a_ = *(const ALAS u32x4*)(p), b_ = *(const ALAS u32x4*)((p) + 512); dst = (i32x8){(int)a_[0], (int)a_[1], (int)a_[2], (int)a_[3], (int)b_[0], (int)b_[1], (int)b_[2], (int)b_[3]}; } while (0)
#ifdef A8_BF8
#define PK8(P, B, OLD) (int)__builtin_amdgcn_perm(__builtin_bit_cast(unsigned, __builtin_amdgcn_cvt_pkrtz(P[(B) + 2], P[(B) + 3])), __builtin_bit_cast(unsigned, __builtin_amdgcn_cvt_pkrtz(P[B], P[(B) + 1])), 0x07050301u)
#define MFMA8P(a, b, c) __builtin_amdgcn_mfma_scale_f32_32x32x64_f8f6f4(a, b, c, 1, 0, 0, 0, 0, 0)
#elif defined(A8_SCALECVT)
#define MFMA8P(a, b, c) MFMA8(a, b, c)
#define PK8(P, B, OLD) __builtin_bit_cast(int, __builtin_amdgcn_cvt_scalef32_pk_fp8_f32(__builtin_amdgcn_cvt_scalef32_pk_fp8_f32(__builtin_bit_cast(v2i16_t, (int)(OLD)), P[B], P[(B) + 1], 1.0f, false), P[(B) + 2], P[(B) + 3], 1.0f, true))
#else
#define MFMA8P(a, b, c) MFMA8(a, b, c)
#define PK8(P, B, OLD) __builtin_amdgcn_cvt_pk_fp8_f32(P[(B) + 2], P[(B) + 3], __builtin_amdgcn_cvt_pk_fp8_f32(P[B], P[(B) + 1], OLD, false), true)
#endif
    if (kw) { WB_SEL(U); } else { WB_SEL(U); }
    { LD32(kf0, kp0); LD32(kf1, kp0 + 2048);
      Ca0 = MFMA8(kf0, qfa, negm); Ca1 = MFMA8(kf1, qfa, negm); Cb0 = MFMA8(kf0, qfb, negm); Cb1 = MFMA8(kf1, qfb, negm);
      EXPBLK(Ha0, Ca0, 0); EXPBLK(Ha0, Ca0, 8); EXPBLK(Ha1, Ca1, 0); EXPBLK(Ha1, Ca1, 8); }
    asm volatile("s_waitcnt lgkmcnt(0)\n\ts_barrier" ::: "memory");
    int ks = 0, vs = 0;
#define ADV(x, k) (((x) + (k) * 4096 >= RS) ? (x) + (k) * 4096 - RS : (x) + (k) * 4096)
    for (int t0 = 0; t0 < n; t0 += U) {
#pragma unroll
      for (int j = 0; j < U; ++j) {
        const int t = t0 + j;
        const bool GK = t + 1 + 2 * U < n, GV = t + 2 * U < n, GL = t + 1 < n;
        const int ksn = ADV(ks, 1);
        SBAR();
        if (!A8_VPREF || j == 0) { const ALAS char* vp_ = vp0 + vs; LD32(vf0, vp_); LD32(vf1, vp_ + 2048); }
        if (GL) { const ALAS char* kn_ = kp0 + ksn; LD32(kf0, kn_); LD32(kf1, kn_ + 2048); } SBAR();
        PACK8(Ha0, Ha1, Ca0, Ca1); SBAR();
#ifdef A8_EXPH_DUP
        {
#pragma unroll
          for (int r = 0; r < 16; ++r) { float x_ = Ca0[r], y_ = Ca1[r]; asm volatile("v_exp_f16_e32 %0, %0\n\tv_exp_f16_e32 %1, %1" : "+v"(x_), "+v"(y_)); Ca0[r] = x_; Ca1[r] = y_; }
          SBAR(); }
#endif
#ifdef A8_CVT_DUP
        { int d0_ = 0, d1_ = 0, d2_ = 0, d3_ = 0;
#pragma unroll
          for (int r = 0; r < 16; r += 4) { d0_ = PK8(Ca0, r, d0_); d1_ = PK8(Ca1, r, d1_); d2_ = PK8(Ca0, r, d2_); d3_ = PK8(Ca1, r, d3_); asm volatile("" : "+v"(d0_), "+v"(d1_), "+v"(d2_), "+v"(d3_)); }
          SBAR(); }
#endif
        oa0 = MFMA8P(pf, vf0, oa0);
        EXPBLK(Hb0, Cb0, 0); SBAR();
        oa1 = MFMA8P(pf, vf1, oa1);
        EXPBLK(Hb0, Cb0, 8); SBAR();
        osa = MFMA8P(pf, ones, osa);
        EXPBLK(Hb1, Cb1, 0); SBAR();
        if (GL) { Ca0 = MFMA8(kf0, qfa, negm); }
        EXPBLK(Hb1, Cb1, 8); SBAR();
        if (GL) { Ca1 = MFMA8(kf1, qfa, negm); }
        if (kw) { if (GK) { DMA8(t + 1 + 2 * U, ADV(ks, 2 * U + 1)); } } else { if (GV) { DMA8(t + 2 * U, ADV(vs, 2 * U)); } }
        SBAR();
        PACK8(Hb0, Hb1, Cb0, Cb1); SBAR();
        ob0 = MFMA8P(pf, vf0, ob0);
        if (GL) {
            EXPBLK(Ha0, Ca0, 0); }
        SBAR();
        ob1 = MFMA8P(pf, vf1, ob1);
        if (GL) {
            EXPBLK(Ha0, Ca0, 8); }
        SBAR();
        if (A8_VPREF && j < U - 1) { const ALAS char* vn_ = vp0 + ADV(vs, 1); LD32(vf0, vn_); LD32(vf1, vn_ + 2048); SBAR(); }
        osb = MFMA8P(pf, ones, osb);
        if (GL) {
            EXPBLK(Ha1, Ca1, 0); }
        SBAR();
        if (GL) { Cb0 = MFMA8(kf0, qfb, negm);
            EXPBLK(Ha1, Ca1, 8); }
        SBAR();
        if (GL) { Cb1 = MFMA8(kf1, qfb, negm); }
        if (j == U - 1) { if (kw ? GK : GV) { WB_SEL(U); } else { WB_SEL(0); }
#ifdef A8_LAG
            if (!kw) __builtin_amdgcn_s_sleep(A8_LAG);
#endif
        }
        ks = ksn; vs = ADV(vs, 1);
      }
    }
#undef ADV
    {
        const int lane_e = lane_id_v(), l32 = lane_e & 31, hh = lane_e >> 5;
        ALAS bf16_t* stg = (ALAS bf16_t*)shm3 + wid * 4096;
#pragma unroll
        for (int r = 0; r < 16; ++r) { const int orow = crow(r, hh); const float ra = __builtin_amdgcn_rcpf(osa[r]), rb = __builtin_amdgcn_rcpf(osb[r]);
            stg[orow * 64 + l32] = pg8::f2bf1(oa0[r] * ra); stg[orow * 64 + 32 + l32] = pg8::f2bf1(oa1[r] * ra);
            stg[2048 + orow * 64 + l32] = pg8::f2bf1(ob0[r] * rb); stg[2048 + orow * 64 + 32 + l32] = pg8::f2bf1(ob1[r] * rb); }
        asm volatile("s_waitcnt lgkmcnt(0)" ::: "memory");
#pragma unroll
        for (int i2 = 0; i2 < 8; ++i2) { const int row = i2 * 8 + (lane_e >> 3), ch = lane_e & 7; const u32x4 v = *(const ALAS u32x4*)(stg + row * 64 + ch * 8);
            *(u32x4*)(T_MIX + (size_t)(qb * 512 + wid * 64 + row) * 1024 + head * 64 + ch * 8) = v; }
    }
    asm volatile("s_waitcnt lgkmcnt(0)\n\ts_barrier" ::: "memory");
#undef DMA8
#undef LD32
#undef PK8
}
}
static_assert(att::LDS_NEED <= RING_BYTES, "LDS map");

#define GAS __attribute__((address_space(1)))
#define LAS __attribute__((address_space(3)))
typedef unsigned short bf16;
typedef unsigned v4u __attribute__((ext_vector_type(4)));
typedef float f32x4 __attribute__((ext_vector_type(4)));
typedef GAS unsigned gu32;
#define RLX_AGENT __ATOMIC_RELAXED, __HIP_MEMORY_SCOPE_AGENT
#define LDS_WAIT() asm volatile("s_waitcnt lgkmcnt(0)" ::: "memory")
#define VM_WAIT() asm volatile("s_waitcnt vmcnt(0)" ::: "memory")
__device__ __forceinline__ unsigned f2bf(float f) { unsigned u = __builtin_bit_cast(unsigned, f); return (u + 0x7fffu + ((u >> 16) & 1u)) >> 16; }
__device__ __forceinline__ unsigned pk2(float lo, float hi) { return f2bf(lo) | (f2bf(hi) << 16); }
#define XB_TMO      128
#define XB_XCNT(j)  (256  + 64 * (j))
#define XB_XSUB(j)  (1280 + 64 * (j))
#define XB_XGEN(j)  (2304 + 64 * (j))
#define XB_TOP      3328
#define XB_TOPGEN   3392
#define XCD_BAR_WORDS 3456
#define XB_SPIN_CAP (1u << 18)

__device__ __forceinline__ unsigned xb_ld(unsigned* p)              { return __hip_atomic_load(p, __ATOMIC_RELAXED, __HIP_MEMORY_SCOPE_AGENT); }
__device__ __forceinline__ unsigned xb_add(unsigned* p, unsigned v) { return __hip_atomic_fetch_add(p, v, __ATOMIC_RELAXED, __HIP_MEMORY_SCOPE_AGENT); }
__device__ __forceinline__ unsigned xb_xcc_id() { return (unsigned)__builtin_amdgcn_s_getreg((3 << 11) | 20) & 0xFu; }
#define XB_SPIN(cond, bar) do { unsigned _sp = 0; while (cond) { __builtin_amdgcn_s_sleep(1); \
    if ((++_sp & 255u) == 0u) { if (xb_ld(&(bar)[XB_TMO])) break; if (_sp > XB_SPIN_CAP) { atomicAdd(&(bar)[XB_TMO], 1u); break; } } } } while (0)

struct XcdBarrier {
    unsigned* bar; unsigned x;
    volatile LAS unsigned* st;
};

__device__ __forceinline__ XcdBarrier xcd_barrier_post(unsigned* bar, volatile LAS unsigned* st, bool t0) {
    XcdBarrier b; b.bar = bar; b.x = (unsigned)__builtin_amdgcn_readfirstlane((int)xb_xcc_id()); b.st = st;
    if (t0) (void)xb_add(&bar[XB_XCNT(b.x)], 1u);
    return b;
}
__device__ __forceinline__ void xcd_barrier_complete(unsigned* bar, unsigned x, unsigned& nloc, unsigned& nx) {
    const unsigned G = gridDim.x * gridDim.y * gridDim.z;
    unsigned sum, cnt, mine, sp = 0u;
    for (;;) {
        sum = 0u; cnt = 0u; mine = 0u;
#pragma unroll
        for (unsigned j = 0; j < 16; ++j) { const unsigned c = xb_ld(&bar[XB_XCNT(j)]); sum += c; cnt += (c > 0u) ? 1u : 0u; mine = (j == x) ? c : mine; }
        if (sum == G) break;
        __builtin_amdgcn_s_sleep(1);
        if ((++sp & 255u) == 0u) { if (xb_ld(&bar[XB_TMO])) break; if (sp > XB_SPIN_CAP) { atomicAdd(&bar[XB_TMO], 1u); break; } }
    }
    nloc = mine > 0u ? mine : 1u; nx = cnt > 0u ? cnt : 1u;
}

__device__ __forceinline__ void xcd_barrier(const XcdBarrier& b_, int wave_id) {
    XcdBarrier b = b_; asm volatile("" : "+s"(b.bar), "+s"(b.x));
    const bool t0 = (wave_id == 0) && (lane_id_v() == 0);
    asm volatile("s_waitcnt vmcnt(0)" ::: "memory");
    __syncthreads();
    if (t0) {
        unsigned* bar = b.bar;
        __builtin_amdgcn_s_waitcnt(0);
        unsigned nloc = b.st[0], nx = b.st[1];
        if (nloc == 0u) { xcd_barrier_complete(bar, b.x, nloc, nx); b.st[0] = nloc; b.st[1] = nx; }
        const unsigned old = xb_add(&bar[XB_XSUB(b.x)], 1u);
        const unsigned gen = old / nloc;
        if (old + 1u == (gen + 1u) * nloc) {
            __builtin_amdgcn_fence(__ATOMIC_RELEASE, "agent");
            asm volatile("s_waitcnt vmcnt(0)" ::: "memory");
            const unsigned og = xb_add(&bar[XB_TOP], 1u);
            const unsigned tg = og / nx;
            if (og + 1u == (tg + 1u) * nx) xb_add(&bar[XB_TOPGEN], 1u);
            else XB_SPIN(xb_ld(&bar[XB_TOPGEN]) == tg, bar);
            __builtin_amdgcn_fence(__ATOMIC_ACQUIRE, "agent");
            xb_add(&bar[XB_XGEN(b.x)], 1u);
            asm volatile("s_waitcnt vmcnt(0)" ::: "memory");
        } else {
            XB_SPIN(xb_ld(&bar[XB_XGEN(b.x)]) == gen, bar);
            __builtin_amdgcn_fence(__ATOMIC_ACQUIRE, "agent");
            asm volatile("s_waitcnt vmcnt(0)" ::: "memory");
        }
    }
    __syncthreads();
}
#ifndef PHMASK
#define PHMASK 63
#endif
#ifndef ATT_DUP
#define ATT_DUP 1
#endif
#ifndef GU_DUP
#define GU_DUP 1
#endif
#ifndef IN_DUP
#define IN_DUP 1
#endif
#ifndef D1_DUP
#define D1_DUP 1
#endif
#ifndef P0_DUP
#define P0_DUP 1
#endif
#ifndef NODEFER
#define DEFER_OK (G == 256)
#else
#define DEFER_OK false
#endif

__device__ __forceinline__ float wave_sum(float v) { v += xor_lane<1>(v); v += xor_lane<2>(v); v += xor_lane<4>(v); v += xor_lane<8>(v); v += xor_lane<16>(v); return sum_x32(v); }
__device__ __forceinline__ float wave_max(float v) { v = fmaxf(v, xor_lane<1>(v)); v = fmaxf(v, xor_lane<2>(v)); v = fmaxf(v, xor_lane<4>(v)); v = fmaxf(v, xor_lane<8>(v)); v = fmaxf(v, xor_lane<16>(v)); return max_x32(v); }
__device__ __forceinline__ void tr_item(const float* W, int ldw, int srccol0, const float* gain, bf16* WT, int K, int dstrow0, int k0, LAS float* scr, int lane) {
    const int kq = lane >> 3, nq = lane & 7;
    f32x4 w[8]; float g[8];
#pragma unroll
    for (int i = 0; i < 8; ++i) { const int kk = 8 * i + kq; w[i] = *(const GAS f32x4*)(W + (size_t)(k0 + kk) * ldw + srccol0 + 4 * nq); g[i] = gain ? gain[k0 + kk] : 1.0f; }
#pragma unroll
    for (int i = 0; i < 8; ++i) { const int kk = 8 * i + kq; LAS float* s = scr + kk * 33 + 4 * nq; s[0] = w[i][0] * g[i]; s[1] = w[i][1] * g[i]; s[2] = w[i][2] * g[i]; s[3] = w[i][3] * g[i]; }
    LDS_WAIT(); asm volatile("" ::: "memory");
    const int c = lane & 7;
#pragma unroll
    for (int j = 0; j < 4; ++j) { const int n = (lane >> 3) + 8 * j; const LAS float* s = scr + (8 * c) * 33 + n;
        v4u o; o.x = pk2(s[0 * 33], s[1 * 33]); o.y = pk2(s[2 * 33], s[3 * 33]); o.z = pk2(s[4 * 33], s[5 * 33]); o.w = pk2(s[6 * 33], s[7 * 33]);
        *(GAS v4u*)(WT + (size_t)(dstrow0 + n) * K + k0 + 8 * c) = o; }
    LDS_WAIT(); asm volatile("" ::: "memory");
}

#define TR_ONE(it_) do { int r = (it_); \
        if (r < 2 * I_GU) { const int l2 = r >= I_GU; if (l2) r -= I_GU; const int kb = r / (NGU / 32), nb = r % (NGU / 32), n0 = nb * 32, pn = n0 >> 8, j0 = n0 & 255; \
            const float* src = (j0 < 128) ? (l2 ? args.in[18] : args.in[2]) : (l2 ? args.in[19] : args.in[3]); \
            tr_item(src, FF, pn * 128 + (j0 & 127), l2 ? args.in[17] : args.in[1], (bf16*)(ws + (l2 ? WS_WGU2 : WS_WGU1)), D, n0, kb * 64, scr, lane); break; } \
        r -= 2 * I_GU; \
        if (r < 2 * I_D) { const int l2 = r >= I_D; if (l2) r -= I_D; const int kb = r / (D / 32), nb = r % (D / 32); \
            tr_item(l2 ? args.in[20] : args.in[4], D, nb * 32, nullptr, (bf16*)(ws + (l2 ? WS_WD2 : WS_WD1)), FF, nb * 32, kb * 64, scr, lane); break; } \
        r -= 2 * I_D; \
        if (r < I_IN) { const int kb = r / (NIN / 32), nb = r % (NIN / 32), n0 = nb * 32, pn = n0 >> 8, j0 = n0 & 255, bj = j0 >> 7, wc = (j0 >> 5) & 3; \
            tr_item(args.in[6], NIN, pn * 256 + wc * 64 + bj * 32, args.in[5], (bf16*)(ws + WS_WIN), D, n0, kb * 64, scr, lane); break; } \
        r -= I_IN; \
        { const int kb = r / (D / 32), nb = r % (D / 32); tr_item(args.in[16], D, nb * 32, nullptr, (bf16*)(ws + WS_WOUT), D, nb * 32, kb * 64, scr, lane); } } while (0)
constexpr int I_GU = (D / 64) * (NGU / 32), I_D = (FF / 64) * (D / 32), I_IN = (D / 64) * (NIN / 32), I_OUT = (D / 64) * (D / 32);
#define TR_DEFERRED(first_idle, IT0, IT1) do { if (bx >= (first_idle)) { const int lane = lane_id_v(); LAS float* scr = (LAS float*)(L + RING_OFF + wave * 16384); \
        const int nw_ = (G - (first_idle)) * NWAVES; for (int it = (IT0) + (bx - (first_idle)) * NWAVES + wave; it < (IT1); it += nw_) { TR_ONE(it); } } } while (0)
struct Args { const float* in[21]; float* out; unsigned char* ws; };
#define LAUNDER(p) asm volatile("" : "+s"(p))

__global__ void __launch_bounds__(NWAVES * 64, 2) mk_fwd(Args args) {
    extern __shared__ __attribute__((aligned(16))) unsigned char lds[];
    LAS unsigned char* L = (LAS unsigned char*)lds;
    volatile LAS unsigned* MISC = (volatile LAS unsigned*)(L + MISC_OFF);
    const int wave = __builtin_amdgcn_readfirstlane((int)threadIdx.x >> 6);
    const int G = gridDim.x; const int bx = blockIdx.x;
    unsigned char* ws = args.ws; float* out = args.out; LAUNDER_G(ws); LAUNDER_G(out);
    { const int tid = wave * 64 + lane_id_v(); for (int u = tid; u < (LDS_BYTES - LDSCTL_OFF) / 4; u += NWAVES * 64) ((LAS unsigned*)(L + LDSCTL_OFF))[u] = 0u; }
    __syncthreads();
    XcdBarrier bar = xcd_barrier_post((unsigned*)((gu32*)(ws + WS_CTL) + CW_BAR), MISC + 8, (wave == 0) && (lane_id_v() == 0));
    LAS float* rstd_tab = (LAS float*)(L + RSTD_OFF);
    LAS float* PRM = (LAS float*)(L + PRM_OFF);
    float pr0_ = 0.f, pr1_ = 0.f, pr2_ = 0.f, pr3_ = 0.f;
    { const int lane = lane_id_v();
      if (wave == 0) { pr0_ = ((const GAS float*)args.in[7])[lane]; pr1_ = ((const GAS float*)args.in[8])[lane]; }
      else if (wave == 1) { pr0_ = ((const GAS float*)args.in[9])[lane]; pr1_ = ((const GAS float*)args.in[10])[lane]; }
      else if (wave == 2) { pr0_ = ((const GAS float*)args.in[15])[lane]; pr1_ = ((const GAS float*)args.in[15])[64 + lane]; }
      else if (wave < 7) { const int h = wave - 3; pr0_ = ((const GAS float*)args.in[11])[h * 64 + lane]; pr1_ = ((const GAS float*)args.in[12])[h * 64 + lane]; pr2_ = ((const GAS float*)args.in[13])[h * 64 + lane]; pr3_ = ((const GAS float*)args.in[14])[h * 64 + lane]; } }
#define PRM_FINISH() do { const int lane = lane_id_v(); \
      if (wave == 0) { PRM[PRM_GAQ + lane] = pr0_; PRM[PRM_GAK + lane] = pr1_; const float ma_ = wave_max(fabsf(pr0_)), mk_ = wave_max(fabsf(pr1_)); if (lane == 0) PRM[PRM_NEGM2A] = -(8.0f * 1.4426950408889634f * 1.02f) * ma_ * mk_; } \
      else if (wave == 1) { PRM[PRM_GBQ + lane] = pr0_; PRM[PRM_GBK + lane] = pr1_; const float ma_ = wave_max(fabsf(pr0_)), mk_ = wave_max(fabsf(pr1_)); if (lane == 0) PRM[PRM_NEGM2B] = -(8.0f * 1.4426950408889634f * 1.02f) * ma_ * mk_; } \
      else if (wave == 2) { PRM[PRM_SUBLN + lane] = pr0_; PRM[PRM_SUBLN + 64 + lane] = pr1_; } \
      else if (wave < 7) { const float d1_ = wave_sum(pr0_ * pr1_), d2_ = wave_sum(pr2_ * pr3_); if (lane == 0) PRM[PRM_LAM + (wave - 3)] = expf(d1_) - expf(d2_) + 0.2f; } \
      LDS_WAIT(); } while (0)

#define BUILD_RSTD(S) do { pg8::Unit u_; const int tid = wave * 64 + lane_id_v(); const float* SSQ_ = (const float*)(ws + WS_SSQ); for (int i_ = 0; i_ < 6 && (S).next(i_, u_); ++i_) if (tid < 256) { const f32x4* p_ = (const f32x4*)(SSQ_ + (size_t)(u_.pm * 256 + tid) * 16); \
        const f32x4 a_ = p_[0], b_ = p_[1], c_ = p_[2], d_ = p_[3]; const float s_ = ((a_[0] + a_[1]) + (a_[2] + a_[3])) + ((b_[0] + b_[1]) + (b_[2] + b_[3])) + ((c_[0] + c_[1]) + (c_[2] + c_[3])) + ((d_[0] + d_[1]) + (d_[2] + d_[3])); \
        rstd_tab[i_ * 256 + tid] = 1.0f / sqrtf(s_ * (1.0f / 1024.0f) + 1e-6f); } LDS_WAIT(); __syncthreads(); } while (0)

#if (PHMASK & 1)
    for (int dup0 = 0; dup0 < P0_DUP; ++dup0) {
        if (dup0) xcd_barrier(bar, wave);
        const int lane = lane_id_v(), tid = wave * 64 + lane;
        const int vcu = (G % 8 == 0) ? (bx % 8) * (G / 8) + bx / 8 : bx;
        float* ROPE = (float*)(ws + WS_ROPE); float* SSQ = (float*)(ws + WS_SSQ); bf16* XB = (bf16*)(ws + WS_XB); const float* x = args.in[0];
        LAS float* scr = (LAS float*)(L + RING_OFF + wave * 16384);
        const int gw = vcu * NWAVES + wave, NGW = G * NWAVES;
        for (int it = gw; it < ((DEFER_OK) ? I_GU : 2 * I_GU + 2 * I_D + I_IN + I_OUT); it += NGW) { TR_ONE(it); }
        for (int m = gw; m < M; m += NGW) {
            const GAS f32x4* xr = (const GAS f32x4*)(x + (size_t)m * D) + lane; f32x4 v[4]; float s = 0.f;
#pragma unroll
            for (int j = 0; j < 4; ++j) { v[j] = xr[64 * j]; s += (v[j][0] * v[j][0] + v[j][1] * v[j][1]) + (v[j][2] * v[j][2] + v[j][3] * v[j][3]); }
            s = wave_sum(s);
            GAS unsigned long long* o8 = (GAS unsigned long long*)(XB + (size_t)m * D) + lane;
#pragma unroll
            for (int j = 0; j < 4; ++j) o8[64 * j] = (unsigned long long)pk2(v[j][0], v[j][1]) | ((unsigned long long)pk2(v[j][2], v[j][3]) << 32);
            if (lane < 16) SSQ[(size_t)m * 16 + lane] = (lane == 0) ? s : 0.f;
        }
        for (int e = bx * (NWAVES * 64) + tid; e < 5120; e += G * NWAVES * 64) {
            const int isc = e >= 4096, ee = isc ? e - 4096 : e, pos = ee >> 4, i = ee & 15;
            const float invf = powf(10000.0f, -(float)i * (1.0f / 16.0f)); const float ang = (float)pos * invf; float sn, cs; sincosf(ang, &sn, &cs);
            if (isc) { ROPE[8192 + ee] = cs; ROPE[9216 + ee] = sn; } else { ROPE[ee] = cs; ROPE[4096 + ee] = sn; }
        }
    }
#endif
    PRM_FINISH();
    xcd_barrier(bar, wave);

    for (int rep = 0; rep < 2; ++rep) {
#if (PHMASK & 2)
        {
            LAUNDER_G(ws);
            pg8::Gemm g{(const bf16*)(ws + WS_XB), (const bf16*)(ws + (rep ? WS_WGU2 : WS_WGU1)), M, NGU, D}; pg8::StaticOrderT<M, NGU> S; int bxs_ = bx, Gs_ = G; LAUNDER(bxs_); LAUNDER(Gs_); S.init(Gs_, bxs_);
#if defined(SPLITK_GU2)
            { pg8::SplitTailOrderT<pg8::StaticOrderT<M, NGU>, 5, D / 64> SKr{S, (rep == 1) && (G == 256)}; BUILD_RSTD(SKr); }
#else
            BUILD_RSTD(S);
#endif
            pg8::EpiSwiGLU E{ws, rstd_tab};
            for (int dup = 0; dup < GU_DUP; ++dup) { if (dup) xcd_barrier(bar, wave);
#if defined(CLK_PROBE_GU)
            unsigned long long c0_ = __builtin_amdgcn_s_memtime(), r0_ = __builtin_amdgcn_s_memrealtime();
#endif
#if defined(SPLITK_GU2)
            {
                typedef pg8::SplitTailOrderT<pg8::StaticOrderT<M, NGU>, 5, D / 64> SKO; SKO SK{S, (rep == 1) && (G == 256)};
                pg8::EpiSwiGLUSplit E2{ws, rstd_tab};
                pg8::gemm_phase<D, pg8::EpiSwiGLUSplit, SKO, true, true, D, true>(L + RING_OFF, g, SK, E2, wave);
            }
#else
            pg8::gemm_phase<D, pg8::EpiSwiGLU, pg8::StaticOrderT<M, NGU>, true, true>(L + RING_OFF, g, S, E, wave);
#endif
            if (rep == 0 && dup == 0 && DEFER_OK) { TR_DEFERRED(128, 2 * I_GU, 2 * I_GU + I_D); TR_DEFERRED(128, 2 * I_GU + 2 * I_D, 2 * I_GU + 2 * I_D + I_IN); }
#if defined(CLK_PROBE_GU)
            if (rep == 0 && bx == 0) { const unsigned long long c1_ = __builtin_amdgcn_s_memtime(), r1_ = __builtin_amdgcn_s_memrealtime(); const unsigned long long spin_ = 1000ull * (c1_ - c0_) / (r1_ - r0_); while (__builtin_amdgcn_s_memrealtime() - r1_ < spin_) __builtin_amdgcn_s_sleep(8); }
#endif
            }
        }
#endif
        xcd_barrier(bar, wave);
#if (PHMASK & 4)
        {
            LAUNDER_G(ws); LAUNDER_G(out);
            pg8::Gemm g{(const bf16*)(ws + WS_H), (const bf16*)(ws + (rep ? WS_WD2 : WS_WD1)), M, D, FF}; pg8::StaticOrderT<M, D> S; int bxs_ = bx, Gs_ = G; LAUNDER(bxs_); LAUNDER(Gs_); S.init(Gs_, bxs_);
            if (rep == 0) { pg8::EpiResid<true, true, false> E{nullptr, nullptr, ws, 0.5f}; for (int dup = 0; dup < D1_DUP; ++dup) { if (dup) xcd_barrier(bar, wave);
#if defined(D1_NULLEPI)
                if (dup) { pg8::EpiNull EN; pg8::gemm_phase<FF, pg8::EpiNull, pg8::StaticOrderT<M, D>, true, true>(L + RING_OFF, g, S, EN, wave); continue; }
#endif
#if defined(D1_SCRATCH)
                if (dup) { pg8::EpiResidStaged<true, false> ES{nullptr, ws, 0.5f, ws + (140u << 20)}; pg8::gemm_phase<FF, pg8::EpiResidStaged<true, false>, pg8::StaticOrderT<M, D>, false, true>(L + RING_OFF, g, S, ES, wave); continue; }
#endif
                pg8::gemm_phase<FF, pg8::EpiResid<true, true, false>, pg8::StaticOrderT<M, D>, true, true>(L + RING_OFF, g, S, E, wave); } }
            else {
#if defined(D7_DUP) && defined(D7_PROBE1)
                for (int dup = 0; dup < D7_DUP; ++dup) { if (dup) xcd_barrier(bar, wave);
                    if (dup < D7_DUP - 1) { pg8::EpiResid<true, false, true, 1> EP{nullptr, out, ws, 0.5f}; pg8::gemm_phase<FF, pg8::EpiResid<true, false, true, 1>, pg8::StaticOrderT<M, D>, true, true>(L + RING_OFF, g, S, EP, wave); }
                    else { pg8::EpiResid<true, false, true> E{nullptr, out, ws, 0.5f}; pg8::gemm_phase<FF, pg8::EpiResid<true, false, true>, pg8::StaticOrderT<M, D>, true, true>(L + RING_OFF, g, S, E, wave); } }
#elif defined(D7_DUP)
                pg8::EpiResid<true, false, true> E{nullptr, out, ws, 0.5f};
#pragma unroll 1
                for (int dup = 0; dup < D7_DUP; ++dup) { if (dup) xcd_barrier(bar, wave); pg8::gemm_phase<FF, pg8::EpiResid<true, false, true>, pg8::StaticOrderT<M, D>, true, true>(L + RING_OFF, g, S, E, wave); }
#else
                pg8::EpiResid<true, false, true> E{nullptr, out, ws, 0.5f}; pg8::gemm_phase<FF, pg8::EpiResid<true, false, true>, pg8::StaticOrderT<M, D>, true, true>(L + RING_OFF, g, S, E, wave);
#endif
            }
        }
#endif
        if (rep == 1) break;
        xcd_barrier(bar, wave);
#if (PHMASK & 8)
        {
            LAUNDER_G(ws);
            pg8::Gemm g{(const bf16*)(ws + WS_XB), (const bf16*)(ws + WS_WIN), M, NIN, D}; pg8::StaticOrderT<M, NIN> S; int bxs_ = bx, Gs_ = G; LAUNDER(bxs_); LAUNDER(Gs_); S.init(Gs_, bxs_);
            BUILD_RSTD(S);
            pg8::EpiInProj E{rstd_tab, PRM, ws};
            for (int dup = 0; dup < IN_DUP; ++dup) { if (dup) xcd_barrier(bar, wave);
            pg8::gemm_phase<D, pg8::EpiInProj, pg8::StaticOrderT<M, NIN>, true, true>(L + RING_OFF, g, S, E, wave);
            if (dup == 0 && DEFER_OK) { TR_DEFERRED(64, I_GU, 2 * I_GU); TR_DEFERRED(64, 2 * I_GU + I_D, 2 * I_GU + 2 * I_D); TR_DEFERRED(64, 2 * I_GU + 2 * I_D + I_IN, 2 * I_GU + 2 * I_D + I_IN + I_OUT); } }
        }
#endif
        xcd_barrier(bar, wave);
#if (PHMASK & 16)
        for (int dup = 0; dup < ATT_DUP; ++dup) {
            LAUNDER_G(ws);
            if (dup) xcd_barrier(bar, wave);
            gu32* qhead = (gu32*)(ws + WS_CTL) + CW_QUEUE + 64 * dup;
#if defined(CLK_PROBE)
            unsigned long long c0_ = __builtin_amdgcn_s_memtime(), r0_ = __builtin_amdgcn_s_memrealtime();
#endif
            const att::Tensors T = att::make_tensors(ws, PRM);
            const bool st = (G == 256);
            const int xg = bx & 7, cg = bx >> 3;
            for (int step = 0;; ++step) {
                int kind, h, qb;
                if (st && step < 2) {
                    if (step < 1) { kind = 0; h = xg; qb = cg; }
                    else { kind = 1; h = (xg < 4) ? 3 : 2; qb = 32 * (xg & 3) + cg; }
                } else {
                    if ((wave == 0) && (lane_id_v() == 0)) MISC[12] = __hip_atomic_fetch_add(qhead, 1u, RLX_AGENT);
                    LDS_WAIT(); __syncthreads();
                    int idx = __builtin_amdgcn_readfirstlane((int)MISC[12]);
                    if (st) idx += 512;
                    if (idx >= 768) break;
                    if (idx < 256 || idx >= 512) { kind = 1;
                        if (idx < 128) { h = 3; qb = idx; } else if (idx < 256) { const int i = idx - 128; h = 2; qb = (i & 1) ? 63 - (i >> 1) : 64 + (i >> 1); }
                        else if (idx < 640) { h = 1; qb = idx - 512; } else { h = 0; qb = idx - 640; }
                    } else { kind = 0; const int i = idx - 256; h = i >> 5; qb = i & 31; }
                }
#if defined(DUP_ONLY_A)
                if (dup && kind) continue;
#elif defined(DUP_ONLY_B)
                if (dup && !kind) continue;
#endif
                if (kind) {
                    const float slope = (h == 0) ? 0.25f : (h == 1) ? 0.0625f : (h == 2) ? 0.015625f : 0.00390625f;
                    const float c2 = slope * 1.4426950408889634f; const int dskip = (int)(150.0f / c2) + 1;
                    att::attn_unit<true>(T, h, qb, PRM[PRM_NEGM2B], PRM[PRM_LAM + h], c2, dskip, (char*)lds + RING_OFF, wave);
                } else att::attn_unit_a8x2<A8U>(T, h, qb, PRM[PRM_NEGM2A] + 8.0f, (char*)lds + RING_OFF, wave);
            }
#if defined(CLK_PROBE)
            if (dup == ATT_DUP - 1 && bx == 0) { const unsigned long long c1_ = __builtin_amdgcn_s_memtime(), r1_ = __builtin_amdgcn_s_memrealtime(); const unsigned long long spin_ = 1000ull * (c1_ - c0_) / (r1_ - r0_); while (__builtin_amdgcn_s_memrealtime() - r1_ < spin_) __builtin_amdgcn_s_sleep(8); }
#endif
        }
#endif
        xcd_barrier(bar, wave);
#if (PHMASK & 32)
        {
            LAUNDER_G(ws); LAUNDER_G(out);
            pg8::Gemm g{(const bf16*)(ws + WS_MIX), (const bf16*)(ws + WS_WOUT), M, D, D}; pg8::StaticOrderT<M, D> S; int bxs_ = bx, Gs_ = G; LAUNDER(bxs_); LAUNDER(Gs_); S.init(Gs_, bxs_);
            pg8::EpiResid<true, true, false> E{nullptr, nullptr, ws, 1.0f}; pg8::gemm_phase<D, pg8::EpiResid<true, true, false>, pg8::StaticOrderT<M, D>, true, true>(L + RING_OFF, g, S, E, wave);
        }
#endif
        xcd_barrier(bar, wave);
    }
}

extern "C" void kernel_launch(void* const* d_in, const int* in_sizes, int n_in, void* d_out, int out_size, void* d_ws, size_t ws_size, hipStream_t stream) {
    static int grid = 0;
    if (grid == 0) {
        if (n_in != 21 || in_sizes[0] != M * D || out_size != M * D || ws_size < WS_END) { fprintf(stderr, "kernel_launch: unexpected shapes (n_in %d, in0 %d, out %d, ws %zu)\n", n_in, n_in > 0 ? in_sizes[0] : -1, out_size, ws_size); grid = -1; return; }
        int dev = 0, cus = 0, per_cu = 0;
        if (hipGetDevice(&dev) != hipSuccess || hipDeviceGetAttribute(&cus, hipDeviceAttributeMultiprocessorCount, dev) != hipSuccess) { grid = -1; return; }
        if (hipFuncSetAttribute((const void*)mk_fwd, hipFuncAttributeMaxDynamicSharedMemorySize, LDS_BYTES) != hipSuccess) { fprintf(stderr, "kernel_launch: hipFuncSetAttribute failed\n"); grid = -1; return; }
        if (hipOccupancyMaxActiveBlocksPerMultiprocessor(&per_cu, (const void*)mk_fwd, NWAVES * 64, LDS_BYTES) != hipSuccess || per_cu < 1) { fprintf(stderr, "kernel_launch: occupancy query says %d blocks per CU\n", per_cu); (void)hipGetLastError(); grid = -1; return; }
        grid = cus;
    }
    if (grid < 0) return;
    if (hipMemsetAsync((char*)d_ws + WS_CTL, 0, CTL_ZERO_BYTES, stream) != hipSuccess) { fprintf(stderr, "kernel_launch: memset failed\n"); return; }
    Args a{};
    for (int i = 0; i < 21; ++i) a.in[i] = (const float*)d_in[i];
    a.out = (float*)d_out; a.ws = (unsigned char*)d_ws;
    hipLaunchKernelGGL(mk_fwd, dim3(grid), dim3(NWAVES * 64), LDS_BYTES, stream, a);
    const hipError_t le = hipPeekAtLastError();
    if (le != hipSuccess) fprintf(stderr, "kernel_launch: launch failed: %s\n", hipGetErrorName(le));
}
```

```cpp
#include <hip/hip_runtime.h>
#include <cstdio>
#include <cstdint>
#define GLDS_M0_CLOBBER 1
#ifndef A8_SUM16
#define A8_SUM16 0
#endif
#ifndef B_ORDER
#define B_ORDER 0
#endif
#ifndef A8_VPREF
#define A8_VPREF 0
#endif
#ifndef BDMA_MODE
#define BDMA_MODE 0
#endif
#ifndef A8U
#define A8U 4
#endif
#ifndef A8_NOBF8
#define A8_BF8 1
#endif

constexpr int NWAVES = 8;
constexpr int M = 16384, D = 1024, FF = 2816, NGU = 2 * FF, NIN = 2304;
constexpr size_t MiB = 1u << 20;
constexpr size_t WS_CTL = 0, CTL_ZERO_BYTES = 64 * 1024;
constexpr size_t WS_WGU1 = 2 * MiB, WS_WD1 = 13 * MiB, WS_WIN = 19 * MiB, WS_WOUT = 24 * MiB, WS_WGU2 = 26 * MiB, WS_WD2 = 37 * MiB;
constexpr size_t WS_ROPE = 43 * MiB, WS_SSQ = 44 * MiB;
constexpr size_t WS_XB = 48 * MiB;
constexpr size_t WS_H = 80 * MiB;
constexpr size_t WS_QA = 80 * MiB, WS_KA = 96 * MiB, WS_VA = 100 * MiB, WS_QB = 104 * MiB, WS_KB = 120 * MiB, WS_VB = 136 * MiB, WS_MIX = 152 * MiB;
constexpr size_t WS_END = 184 * MiB;
static_assert(WS_WGU1 + (size_t)NGU * D * 2 <= WS_WD1 && WS_WD1 + (size_t)D * FF * 2 <= WS_WIN && WS_WIN + (size_t)NIN * D * 2 <= WS_WOUT && WS_WOUT + (size_t)D * D * 2 <= WS_WGU2 &&
              WS_WGU2 + (size_t)NGU * D * 2 <= WS_WD2 && WS_WD2 + (size_t)D * FF * 2 <= WS_ROPE && WS_H + (size_t)M * FF * 2 <= WS_END && WS_MIX + (size_t)M * D * 2 <= WS_END, "d_ws map");
constexpr int CW_BAR = 1024;
constexpr int CW_XFLAG = 9216;
constexpr size_t WS_XCH = 184 * MiB;
constexpr int CW_QUEUE = 8192;
constexpr int RING_OFF = 0, RING_BYTES = 131072;
constexpr int LDSCTL_OFF = RING_BYTES, MISC_OFF = LDSCTL_OFF + 320, RSTD_OFF = LDSCTL_OFF + 1024, PRM_OFF = LDSCTL_OFF + 8192;
constexpr int LDS_BYTES = 147456;
constexpr int PRM_GAQ = 0, PRM_GAK = 64, PRM_GBQ = 128, PRM_GBK = 192, PRM_SUBLN = 256, PRM_NEGM2A = 384, PRM_NEGM2B = 385, PRM_LAM = 388, PRM_WORDS = 392;
static_assert(RSTD_OFF + 6 * 256 * 4 <= PRM_OFF && PRM_OFF + PRM_WORDS * 4 <= LDS_BYTES, "LDS map");

__device__ __forceinline__ int lane_id_v() { int l; asm volatile("v_mbcnt_lo_u32_b32 %0, -1, 0\n\tv_mbcnt_hi_u32_b32 %0, -1, %0" : "=v"(l)); return l; }

template <int MASK> __device__ __forceinline__ float xor_lane(float v) {
    if constexpr (MASK == 32) { const auto rr = __builtin_amdgcn_permlane32_swap(__float_as_uint(v), __float_as_uint(v), false, false); return __uint_as_float(lane_id_v() < 32 ? rr[1] : rr[0]); }
    else return __uint_as_float((unsigned)__builtin_amdgcn_ds_swizzle((int)__float_as_uint(v), (MASK << 10) | 0x1f));
}
__device__ __forceinline__ float sum_x32(float v) { const auto rr = __builtin_amdgcn_permlane32_swap(__float_as_uint(v), __float_as_uint(v), false, false); return __uint_as_float(rr[0]) + __uint_as_float(rr[1]); }
__device__ __forceinline__ float max_x32(float v) { const auto rr = __builtin_amdgcn_permlane32_swap(__float_as_uint(v), __float_as_uint(v), false, false); return fmaxf(__uint_as_float(rr[0]), __uint_as_float(rr[1])); }

#define LAUNDER_G(p) do { __attribute__((address_space(1))) void* g_ = (__attribute__((address_space(1))) void*)(p); asm volatile("" : "+s"(g_)); (p) = (decltype(p))g_; } while (0)
namespace pg8 {
#define PG8_LAS __attribute__((address_space(3)))
typedef unsigned short bf16_t;
typedef short bf16x8 __attribute__((ext_vector_type(8)));
typedef float f32x4 __attribute__((ext_vector_type(4)));
typedef unsigned u32x4 __attribute__((ext_vector_type(4)));
constexpr int BM = 256, BK = 64, HALF = 128, HTB = HALF * BK * 2  , STAGE_BYTES = 8 * HTB, NXCD = 8, WGM = 8;

__host__ __device__ __forceinline__ int lds_byte(int r, int c) { const int st = (r >> 4) * 2 + (c >> 5), rr = r & 15, cc = c & 31, ob = rr * 64 + cc * 2; return st * 1024 + (ob ^ (((ob >> 9) & 1) << 5)); }
__host__ __device__ __forceinline__ void stage_rc(int b, int& R, int& C) { const int st = b / 1024, sb = b % 1024, swz = sb ^ (((sb >> 9) & 1) << 5); R = (st >> 1) * 16 + swz / 64; C = (st & 1) * 32 + (swz % 64) / 2; }
__host__ __device__ __forceinline__ int perm32(int rho) { const int n = rho >> 4, i = rho & 15; return 8 * (i >> 2) + 4 * n + (i & 3); }

struct Unit { int pm, pn; int kofs, nt; };
struct Gemm { const bf16_t* A; const bf16_t* Bt; int M, N, K; };

template <int MD, int ND> struct StaticOrderT {
    static constexpr int nM = MD / BM, nN = ND / BM, nwg = nM * nN;
    int G, c;
    __host__ __device__ void init(int G_, int c_) { G = G_; c = c_; }
    __host__ __device__ bool next(int i, Unit& u) const { return at(i * G + c, u); }
    __host__ __device__ bool at(int L, Unit& u) const {
        if (L >= nwg) return false;
        int wgid = L; { constexpr int q = nwg / NXCD, r = nwg % NXCD; const int xcd = wgid % NXCD, off = wgid / NXCD; wgid = (xcd < r ? xcd * (q + 1) : r * (q + 1) + (xcd - r) * q) + off; }
        constexpr int nig = WGM * nN; const int gid = wgid / nig, fm = gid * WGM, gsz = (nM - fm) < WGM ? (nM - fm) : WGM;
        u.pm = fm + ((wgid % nig) % gsz); u.pn = (wgid % nig) / gsz; u.kofs = 0; u.nt = 0; return true;
    }
    __device__ __forceinline__ void a_ready(const Unit&) const {}
    __device__ __forceinline__ void done(const Unit&) const {}
};
template <class S0, int RT, int NTF> struct SplitTailOrderT { S0 s; bool sk;
    __host__ __device__ bool next(int i, Unit& u) const {
        if (!sk || i < RT) { const bool r = s.next(i, u); u.kofs = 0; u.nt = NTF; return r; }
        if (i > RT) return false;
        const int h = s.G >> 1; s.at(RT * s.G + (s.c % h), u); u.kofs = (s.c / h) * (NTF / 2) * BK * 2; u.nt = NTF / 2; return true; }
    __device__ __forceinline__ void a_ready(const Unit&) const {} __device__ __forceinline__ void done(const Unit&) const {} };


__device__ __forceinline__ unsigned cvt_pk_bf16(float lo, float hi) { unsigned r; asm volatile("v_cvt_pk_bf16_f32 %0, %1, %2" : "=v"(r) : "v"(lo), "v"(hi)); return r; }
__device__ __forceinline__ unsigned short f2bf1(float f) { unsigned u = __builtin_bit_cast(unsigned, f); return (unsigned short)((u + 0x7fffu + ((u >> 16) & 1u)) >> 16); }
typedef unsigned u32x2 __attribute__((ext_vector_type(2)));
constexpr int MROWS = M, DMODEL = D, DFF = FF;

typedef float f32x2 __attribute__((ext_vector_type(2)));
#ifdef SWIGLU_FMA
#define SWIGLU_RS2(rs) __builtin_amdgcn_rcpf((rs) * (rs))
#else
#define SWIGLU_RS2(rs) ((rs) * (rs))
#endif
__device__ __forceinline__ f32x2 swiglu2(f32x2 ag, f32x2 au, float k1, float rs2) {
    const f32x2 t = ag * k1; f32x2 ex; ex.x = __builtin_amdgcn_exp2f(t.x); ex.y = __builtin_amdgcn_exp2f(t.y);
#ifdef SWIGLU_FMA
    const f32x2 d = ex * rs2 + rs2; f32x2 r; r.x = __builtin_amdgcn_rcpf(d.x); r.y = __builtin_amdgcn_rcpf(d.y);
    return (ag * au) * r;
#else
    const f32x2 d = ex + 1.0f; f32x2 r; r.x = __builtin_amdgcn_rcpf(d.x); r.y = __builtin_amdgcn_rcpf(d.y);
    return ((ag * au) * rs2) * r;
#endif
}
__device__ __forceinline__ f32x4 swiglu4(f32x4 ag, f32x4 au, float k1, float rs2) {
    const f32x2 a = swiglu2((f32x2){ag[0], ag[1]}, (f32x2){au[0], au[1]}, k1, rs2), b = swiglu2((f32x2){ag[2], ag[3]}, (f32x2){au[2], au[3]}, k1, rs2);
    return (f32x4){a.x, a.y, b.x, b.y};
}
struct EpiSwiGLU {
    static constexpr bool PERM = true, AFTER_DRAIN = false;
    unsigned char* ws; const PG8_LAS float* rstd;
    __device__ __forceinline__ void operator()(const f32x4 (&acc)[2][2][4][2], const Unit& u, int ui, int wr, int wc, int fr, int fq) const {
        asm volatile("" : "+v"(fr), "+v"(fq));
        const int col0 = u.pn * 128 + wc * 32 + 8 * fq; unsigned char* w2 = ws; LAUNDER_G(w2); bf16_t* H = (bf16_t*)(w2 + WS_H);
#pragma unroll
        for (int ai = 0; ai < 2; ++ai)
#pragma unroll
            for (int m = 0; m < 4; ++m) {
                const int rl = ai * HALF + wr * 64 + m * 16 + fr; const float rs = rstd[ui * 256 + rl];
                const float k1 = rs * -1.4426950408889634f, rs2 = SWIGLU_RS2(rs);
                const f32x4 h0 = swiglu4(acc[ai][0][m][0], acc[ai][1][m][0], k1, rs2), h1 = swiglu4(acc[ai][0][m][1], acc[ai][1][m][1], k1, rs2);
                u32x4 w; w.x = cvt_pk_bf16(h0[0], h0[1]); w.y = cvt_pk_bf16(h0[2], h0[3]); w.z = cvt_pk_bf16(h1[0], h1[1]); w.w = cvt_pk_bf16(h1[2], h1[3]);
                *(u32x4*)(H + (size_t)(u.pm * BM + rl) * DFF + col0) = w;
            }
    }
};
struct EpiSwiGLUSplit {
    static constexpr bool PERM = true, AFTER_DRAIN = false;
    unsigned char* ws; const PG8_LAS float* rstd;
    typedef unsigned long long u64;
    __device__ __forceinline__ static void put(u64* p, const f32x4& v) {
        __hip_atomic_store(p, ((u64)__float_as_uint(v[1]) << 32) | __float_as_uint(v[0]), __ATOMIC_RELAXED, __HIP_MEMORY_SCOPE_AGENT);
        __hip_atomic_store(p + 1, ((u64)__float_as_uint(v[3]) << 32) | __float_as_uint(v[2]), __ATOMIC_RELAXED, __HIP_MEMORY_SCOPE_AGENT); }
    __device__ __forceinline__ static f32x4 get(const u64* p) {
        const u64 a = __hip_atomic_load(p, __ATOMIC_RELAXED, __HIP_MEMORY_SCOPE_AGENT), b = __hip_atomic_load(p + 1, __ATOMIC_RELAXED, __HIP_MEMORY_SCOPE_AGENT);
        return (f32x4){__uint_as_float((unsigned)a), __uint_as_float((unsigned)(a >> 32)), __uint_as_float((unsigned)b), __uint_as_float((unsigned)(b >> 32))}; }
    template <int SS> __device__ __forceinline__ void run(const f32x4 (&acc)[2][2][4][2], const Unit& u, int wr, int wc, int fr, int fq) const {
        unsigned char* w2 = ws; LAUNDER_G(w2);
        const int pair = (int)(__builtin_amdgcn_workgroup_id_x() & 127u); constexpr int rslot = 5;
        const unsigned tid = (unsigned)((wr * 4 + wc) * 64 + fq * 16 + fr);
        unsigned char* xb_ = w2 + WS_XCH + (size_t)pair * (2 * 16 * 512 * 16);
        u64* xo = (u64*)(xb_ + (size_t)(1 - SS) * (16 * 512 * 16) + tid * 16u);
        const u64* xi = (const u64*)(xb_ + (size_t)SS * (16 * 512 * 16) + tid * 16u);
        unsigned* flg = (unsigned*)(w2 + WS_CTL) + CW_XFLAG + pair * 2;
#pragma unroll
        for (int bj = 0; bj < 2; ++bj)
#pragma unroll
            for (int m = 0; m < 4; ++m)
#pragma unroll
                for (int n = 0; n < 2; ++n) put(xo + (size_t)((bj * 4 + m) * 2 + n) * 1024, acc[1 - SS][bj][m][n]);
        asm volatile("s_waitcnt vmcnt(0)" ::: "memory");
        __syncthreads();
        if (tid == 0) { __hip_atomic_store(flg + (1 - SS), 1u, __ATOMIC_RELAXED, __HIP_MEMORY_SCOPE_AGENT);
            unsigned sp = 0; while (__hip_atomic_load(flg + SS, __ATOMIC_RELAXED, __HIP_MEMORY_SCOPE_AGENT) == 0u) { __builtin_amdgcn_s_sleep(1); if (++sp > (1u << 20)) break; } }
        __syncthreads();
        bf16_t* H = (bf16_t*)(w2 + WS_H); const int col0 = u.pn * 128 + wc * 32 + 8 * fq;
#pragma unroll
        for (int m = 0; m < 4; ++m) {
            const f32x4 g0 = acc[SS][0][m][0] + get(xi + (size_t)((0 * 4 + m) * 2 + 0) * 1024), g1 = acc[SS][0][m][1] + get(xi + (size_t)((0 * 4 + m) * 2 + 1) * 1024);
            const f32x4 u0 = acc[SS][1][m][0] + get(xi + (size_t)((1 * 4 + m) * 2 + 0) * 1024), u1 = acc[SS][1][m][1] + get(xi + (size_t)((1 * 4 + m) * 2 + 1) * 1024);
            const int rl = SS * HALF + wr * 64 + m * 16 + fr; const float rs = rstd[rslot * 256 + rl];
            const float k1 = rs * -1.4426950408889634f, rs2 = SWIGLU_RS2(rs);
            const f32x4 h0 = swiglu4(g0, u0, k1, rs2), h1 = swiglu4(g1, u1, k1, rs2);
            u32x4 w; w.x = cvt_pk_bf16(h0[0], h0[1]); w.y = cvt_pk_bf16(h0[2], h0[3]); w.z = cvt_pk_bf16(h1[0], h1[1]); w.w = cvt_pk_bf16(h1[2], h1[3]);
            *(u32x4*)(H + (size_t)(u.pm * BM + rl) * DFF + col0) = w;
        }
    }
    __device__ __forceinline__ void operator()(const f32x4 (&acc)[2][2][4][2], const Unit& u, int ui, int wr, int wc, int fr, int fq) const {
        if (u.nt == (D / BK) / 2) { asm volatile("" : "+v"(fr), "+v"(fq));
            if (__builtin_amdgcn_workgroup_id_x() >> 7) run<1>(acc, u, wr, wc, fr, fq); else run<0>(acc, u, wr, wc, fr, fq); }
        else { EpiSwiGLU E0{ws, rstd}; E0(acc, u, ui, wr, wc, fr, fq); }
    }
};
template <bool SRC_B, bool WRITE_B, bool WRITE_F, int PROBE = 0> struct EpiResid {
    static constexpr bool PERM = true, AFTER_DRAIN = false;
    const float* base; float* out; unsigned char* ws; float alpha;
    __device__ __forceinline__ static f32x4 up4(unsigned a, unsigned b) { return (f32x4){__uint_as_float(a << 16), __uint_as_float(a & 0xffff0000u), __uint_as_float(b << 16), __uint_as_float(b & 0xffff0000u)}; }
    __device__ __forceinline__ void operator()(const f32x4 (&acc)[2][2][4][2], const Unit& u, int ui, int wr, int wc, int fr, int fq) const {
        asm volatile("" : "+v"(fr), "+v"(fq));
        const int col0 = u.pn * BM + wc * 32 + 8 * fq;
        unsigned char* w2 = ws; LAUNDER_G(w2); bf16_t* xb = (bf16_t*)(w2 + WS_XB); float* ssqp = (float*)(w2 + WS_SSQ);
#pragma unroll
        for (int ai = 0; ai < 2; ++ai) {
            f32x4 rb[4][2][2];
#pragma unroll
            for (int m = 0; m < 4; ++m) { const size_t off = (size_t)(u.pm * BM + ai * HALF + wr * 64 + m * 16 + fr) * DMODEL + col0;
#pragma unroll
                for (int bj = 0; bj < 2; ++bj) {
                    if (PROBE == 1) { rb[m][bj][0] = (f32x4){0.f, 0.f, 0.f, 0.f}; rb[m][bj][1] = rb[m][bj][0]; }
                    else if (SRC_B) { const u32x4 r = *(const u32x4*)(xb + off + bj * HALF); rb[m][bj][0] = __builtin_bit_cast(f32x4, r); }
                    else { rb[m][bj][0] = *(const f32x4*)(base + off + bj * HALF); rb[m][bj][1] = *(const f32x4*)(base + off + bj * HALF + 4); } } }
#pragma unroll
            for (int m = 0; m < 4; ++m) {
                const int row = u.pm * BM + ai * HALF + wr * 64 + m * 16 + fr; const size_t off = (size_t)row * DMODEL + col0; float ss = 0.f;
#pragma unroll
                for (int bj = 0; bj < 2; ++bj) { const size_t o = off + bj * HALF;
                    f32x4 b0, b1;
                    if (SRC_B) { const u32x4 r = __builtin_bit_cast(u32x4, rb[m][bj][0]); b0 = up4(r[0], r[1]); b1 = up4(r[2], r[3]); } else { b0 = rb[m][bj][0]; b1 = rb[m][bj][1]; }
                    const f32x4 v0 = b0 + acc[ai][bj][m][0] * alpha, v1 = b1 + acc[ai][bj][m][1] * alpha;
                    if (PROBE == 2) { asm volatile("" :: "v"(v0), "v"(v1)); }
#ifdef OUT_NT
                    if (WRITE_F && PROBE != 2) { __builtin_nontemporal_store(v0, (f32x4*)(out + o)); __builtin_nontemporal_store(v1, (f32x4*)(out + o + 4)); }
#else
                    if (WRITE_F && PROBE != 2) { *(f32x4*)(out + o) = v0; *(f32x4*)(out + o + 4) = v1; }
#endif
                    if (WRITE_B && PROBE != 2) { ss += ((v0[0] * v0[0] + v0[1] * v0[1]) + (v0[2] * v0[2] + v0[3] * v0[3])) + ((v1[0] * v1[0] + v1[1] * v1[1]) + (v1[2] * v1[2] + v1[3] * v1[3]));
                        u32x4 w; w.x = cvt_pk_bf16(v0[0], v0[1]); w.y = cvt_pk_bf16(v0[2], v0[3]); w.z = cvt_pk_bf16(v1[0], v1[1]); w.w = cvt_pk_bf16(v1[2], v1[3]); *(u32x4*)(xb + o) = w; } }
                if (WRITE_B && PROBE != 2) { ss += xor_lane<16>(ss); ss = sum_x32(ss); if (fq == 0) ssqp[(size_t)row * 16 + u.pn * 4 + wc] = ss; }
            }
            asm volatile("" ::: "memory");
        }
    }
};
template <bool WRITE_B, bool WRITE_F> struct EpiResidStaged {
    static constexpr bool PERM = true, AFTER_DRAIN = true;
    float* out; unsigned char* ws; float alpha; unsigned char* wsw;
    __device__ __forceinline__ static f32x4 up4(unsigned a, unsigned b) { return (f32x4){__uint_as_float(a << 16), __uint_as_float(a & 0xffff0000u), __uint_as_float(b << 16), __uint_as_float(b & 0xffff0000u)}; }
    __device__ __forceinline__ void fused(f32x4 (&acc)[2][2][4][2], const Unit& u, int wr, int wc, int fr, int fq, PG8_LAS unsigned char* lds, int wid, int lane) const {
        unsigned char* w2 = ws; LAUNDER_G(w2); const bf16_t* xb = (const bf16_t*)(w2 + WS_XB); unsigned char* w3 = wsw; LAUNDER_G(w3); bf16_t* xbw = (bf16_t*)(w3 + WS_XB); float* ssqp = (float*)(w3 + WS_SSQ);
        {
            const int tid = wid * 64 + lane, c = tid & 31, r0 = tid >> 5;
            const bf16_t* src = xb + (size_t)(u.pm * BM + r0) * DMODEL + u.pn * BM + c * 8;
            u32x4 t[16];
#pragma unroll
            for (int p = 0; p < 16; ++p) t[p] = *(const u32x4*)(src + (size_t)(p * 16) * DMODEL);
#pragma unroll
            for (int p = 0; p < 16; ++p) { const int r = p * 16 + r0; *(PG8_LAS u32x4*)(lds + r * 512 + ((c ^ (r & 15)) << 4)) = t[p]; }
        }
        asm volatile("s_waitcnt vmcnt(0) lgkmcnt(0)\n\ts_barrier" ::: "memory");
        asm volatile("" : "+v"(fr), "+v"(fq));
        const int col0 = u.pn * BM + wc * 32 + 8 * fq;
#pragma unroll
        for (int ai = 0; ai < 2; ++ai)
#pragma unroll
            for (int m = 0; m < 4; ++m) {
                const int rl = ai * HALF + wr * 64 + m * 16 + fr; const int row = u.pm * BM + rl; const size_t off = (size_t)row * DMODEL + col0; float ss = 0.f;
#pragma unroll
                for (int bj = 0; bj < 2; ++bj) { const size_t o = off + bj * HALF;
                    const int chunk = 16 * bj + 4 * wc + fq;
                    const u32x4 r = *(const PG8_LAS u32x4*)(lds + rl * 512 + ((chunk ^ (rl & 15)) << 4));
                    const f32x4 b0 = up4(r[0], r[1]), b1 = up4(r[2], r[3]);
                    const f32x4 v0 = b0 + acc[ai][bj][m][0] * alpha, v1 = b1 + acc[ai][bj][m][1] * alpha;
                    if (WRITE_F) { *(f32x4*)(out + o) = v0; *(f32x4*)(out + o + 4) = v1; }
                    if (WRITE_B) { ss += ((v0[0] * v0[0] + v0[1] * v0[1]) + (v0[2] * v0[2] + v0[3] * v0[3])) + ((v1[0] * v1[0] + v1[1] * v1[1]) + (v1[2] * v1[2] + v1[3] * v1[3]));
                        u32x4 w; w.x = cvt_pk_bf16(v0[0], v0[1]); w.y = cvt_pk_bf16(v0[2], v0[3]); w.z = cvt_pk_bf16(v1[0], v1[1]); w.w = cvt_pk_bf16(v1[2], v1[3]); *(u32x4*)(xbw + o) = w; } }
                if (WRITE_B) { ss += xor_lane<16>(ss); ss = sum_x32(ss); if (fq == 0) ssqp[(size_t)row * 16 + u.pn * 4 + wc] = ss; }
            }
    }
};
struct EpiNull {
    static constexpr bool PERM = true, AFTER_DRAIN = false;
    __device__ __forceinline__ void operator()(const f32x4 (&acc)[2][2][4][2], const Unit& u, int ui, int wr, int wc, int fr, int fq) const {
#pragma unroll
        for (int ai = 0; ai < 2; ++ai)
#pragma unroll
            for (int bj = 0; bj < 2; ++bj)
#pragma unroll
                for (int m = 0; m < 4; ++m)
#pragma unroll
                    for (int n = 0; n < 2; ++n) { f32x4 t = acc[ai][bj][m][n]; asm volatile("" :: "v"(t)); }
    }
};
struct EpiInProj {
    static constexpr bool PERM = false, AFTER_DRAIN = false;
    const PG8_LAS float* rstd; const PG8_LAS float* prm; unsigned char* ws;
    __device__ __forceinline__ static float head_f(const f32x4 (&acc)[2][2][4][2], int ai, int m, float rs) {
        float ss = 0.f;
#pragma unroll
        for (int bj = 0; bj < 2; ++bj)
#pragma unroll
            for (int n = 0; n < 2; ++n) { const f32x4 a = acc[ai][bj][m][n]; ss += (a[0] * a[0] + a[1] * a[1]) + (a[2] * a[2] + a[3] * a[3]); }
        ss += xor_lane<16>(ss); ss = sum_x32(ss);
        return rs / sqrtf(ss * rs * rs * (1.0f / 64.0f) + 1e-6f);
    }
    __device__ __forceinline__ void operator()(const f32x4 (&acc)[2][2][4][2], const Unit& u, int ui, int wr, int wc, int fr, int fq) const {
        const int G = __builtin_amdgcn_readfirstlane(u.pn * 4 + wc);
        unsigned char* w2 = ws; LAUNDER_G(w2);
        asm volatile("" : "+v"(fr), "+v"(fq));
        const int row0 = wr * 64 + fr;
        if (G < 10) {
            const bool isq = G < 8;
            const PG8_LAS float* gp = prm + (isq ? PRM_GAQ : PRM_GAK) + 4 * fq;
            const float* rope = (const float*)(w2 + WS_ROPE) + 4 * fq;
            const float qs = isq ? 0.125f * 1.4426950408889634f : 1.0f;
            unsigned char* db = isq ? (w2 + WS_QA) + (size_t)G * MROWS * 64 + 8 * fq : (w2 + WS_KA) + (size_t)(G - 8) * MROWS * 64 + (fq >> 1) * 512 + 8 * (fq & 1);
#pragma unroll
            for (int ai = 0; ai < 2; ++ai)
#pragma unroll
                for (int m = 0; m < 4; ++m) {
                    const int rl = ai * HALF + m * 16 + row0; const int t = u.pm * BM + rl; const float f = head_f(acc, ai, m, rstd[ui * 256 + rl]) * qs;
                    unsigned char* dt = isq ? db + (size_t)t * 64 : db + (size_t)(t >> 6) * 4096 + ((t & 63) >> 5) * 2048 + (t & 31) * 16;
#pragma unroll
                    for (int bj = 0; bj < 2; ++bj) {
                        const f32x4 x1 = acc[ai][bj][m][0] * f * *(const PG8_LAS f32x4*)(gp + 32 * bj), x2 = acc[ai][bj][m][1] * f * *(const PG8_LAS f32x4*)(gp + 32 * bj + 16);
                        const int pos = bj ? (t & 63) : (t >> 6); const float* rp = rope + (bj ? 8192 : 0) + pos * 16;
                        const f32x4 c = *(const f32x4*)rp, s = *(const f32x4*)(rp + (bj ? 1024 : 4096));
                        const f32x4 y1 = x1 * c - x2 * s, y2 = x2 * c + x1 * s;
                        int lo = __builtin_amdgcn_cvt_pk_fp8_f32(y1[0], y1[1], 0, false); lo = __builtin_amdgcn_cvt_pk_fp8_f32(y1[2], y1[3], lo, true);
                        int hi = __builtin_amdgcn_cvt_pk_fp8_f32(y2[0], y2[1], 0, false); hi = __builtin_amdgcn_cvt_pk_fp8_f32(y2[2], y2[3], hi, true);
                        u32x2 w; w.x = (unsigned)lo; w.y = (unsigned)hi;
                        *(u32x2*)(dt + (isq ? 32 * bj : 1024 * bj)) = w;
                    }
                    asm volatile("" ::: "memory");
                }
        } else if (G < 12) {
            unsigned char* V8 = (w2 + WS_VA) + (size_t)(G - 10) * MROWS * 64 + (4 * fq) * 16;
#pragma unroll
            for (int ai = 0; ai < 2; ++ai)
#pragma unroll
                for (int m = 0; m < 4; ++m) {
                    const int rl = ai * HALF + m * 16 + row0; const int t = u.pm * BM + rl; const float rs = rstd[ui * 256 + rl];
                    const int kk = t & 63, c = kk >> 5, r = kk & 31, h = (r >> 2) & 1, jj = (r & 3) + 4 * (r >> 3);
                    unsigned char* vb = V8 + (size_t)(t >> 6) * 4096 + h * 1024 + c * 512 + jj;
#pragma unroll
                    for (int bj = 0; bj < 2; ++bj)
#pragma unroll
                        for (int n = 0; n < 2; ++n) { const f32x4 v = acc[ai][bj][m][n] * rs;
                            const int p01 = __builtin_amdgcn_cvt_pk_fp8_f32(v[0], v[1], 0, false), p23 = __builtin_amdgcn_cvt_pk_fp8_f32(v[2], v[3], 0, false);
                            unsigned char* q = vb + bj * 2048 + (16 * n) * 16;
                            q[0] = (unsigned char)(p01 & 0xff); q[16] = (unsigned char)((p01 >> 8) & 0xff); q[32] = (unsigned char)(p23 & 0xff); q[48] = (unsigned char)((p23 >> 8) & 0xff); }
                    asm volatile("" ::: "memory");
                }
        } else if (G < 28) {
            const bool isq = G < 20;
            const PG8_LAS float* gp = prm + (isq ? PRM_GBQ : PRM_GBK) + 4 * fq;
            const float qs = isq ? 0.125f * 1.4426950408889634f : 1.0f;
            bf16_t* db = isq ? (bf16_t*)(w2 + WS_QB) + (size_t)(G - 12) * MROWS * 64 + 8 * fq : (bf16_t*)(w2 + WS_KB) + (size_t)(G - 20) * MROWS * 64 + (size_t)fq * 512;
#pragma unroll
            for (int ai = 0; ai < 2; ++ai)
#pragma unroll
                for (int m = 0; m < 4; ++m) {
                    const int rl = ai * HALF + m * 16 + row0; const int t = u.pm * BM + rl; const float f = head_f(acc, ai, m, rstd[ui * 256 + rl]) * qs;
                    bf16_t* dt = isq ? db + (size_t)t * 64 : db + (size_t)(t >> 6) * 4096 + (t & 63) * 8;
#pragma unroll
                    for (int bj = 0; bj < 2; ++bj) {
                        const f32x4 x1 = acc[ai][bj][m][0] * f * *(const PG8_LAS f32x4*)(gp + 32 * bj), x2 = acc[ai][bj][m][1] * f * *(const PG8_LAS f32x4*)(gp + 32 * bj + 16);
                        u32x4 w; w.x = cvt_pk_bf16(x1[0], x1[1]); w.y = cvt_pk_bf16(x1[2], x1[3]); w.z = cvt_pk_bf16(x2[0], x2[1]); w.w = cvt_pk_bf16(x2[2], x2[3]);
                        *(u32x4*)(dt + (isq ? 32 * bj : 2048 * bj)) = w;
                    }
                    asm volatile("" ::: "memory");
                }
        } else {
            bf16_t* V = (bf16_t*)(w2 + WS_VB) + (size_t)((G - 28) >> 1) * MROWS * 128 + (64 * ((G - 28) & 1) + 4 * fq) * 8;
#pragma unroll
            for (int ai = 0; ai < 2; ++ai)
#pragma unroll
                for (int m = 0; m < 4; ++m) {
                    const int rl = ai * HALF + m * 16 + row0; const int t = u.pm * BM + rl; const float rs = rstd[ui * 256 + rl];
                    const int kk = t & 63, ks = kk >> 4, ko = kk & 15, hi = (ko >> 2) & 1, j = ((ko >> 3) << 2) | (ko & 3);
                    bf16_t* vb = V + (size_t)(((t >> 6) * 4 + ks) * 2 + hi) * 1024 + j;
#pragma unroll
                    for (int bj = 0; bj < 2; ++bj)
#pragma unroll
                        for (int n = 0; n < 2; ++n)
#pragma unroll
                            for (int e = 0; e < 4; ++e) vb[(32 * bj + 16 * n + e) * 8] = f2bf1(acc[ai][bj][m][n][e] * rs);
                    asm volatile("" ::: "memory");
                }
        }
    }
};

#ifndef NOTAIL
#define NOTAIL 0
#endif
template <int KD, class Epi, class Sched, bool ALIGN_EPI = false, bool SP2 = false, int LD = KD, bool VARK = false>
__device__ __forceinline__ void gemm_phase(PG8_LAS unsigned char* lds, const Gemm g, const Sched& S, const Epi& E, int wave_id) {
    int tid_ = wave_id * 64 + lane_id_v(); asm volatile("" : "+v"(tid_));
    const int tid = tid_, wid = __builtin_amdgcn_readfirstlane(tid >> 6), lane = tid & 63, wr = wid >> 2, wc = wid & 3, fr = lane & 15, fq = lane >> 4;
    constexpr int K = KD, ntc = K / BK; static_assert(ntc % 2 == 0, "even K-tile count");
    unsigned voffA[2], voffB[2];
#pragma unroll
    for (int i = 0; i < 2; ++i) { int R, C; stage_rc(tid * 16 + i * 8192, R, C); const int Rb = Epi::PERM ? ((R & ~31) + perm32(R & 31)) : R;
        voffA[i] = (unsigned)(R * LD + C) * 2u; voffB[i] = (unsigned)(Rb * LD + C) * 2u; }
    constexpr size_t kstep = (size_t)(BK * 2);
    constexpr size_t hstep = (size_t)HALF * LD * 2;
    constexpr size_t tstep = 2 * hstep;
    const unsigned ldsw = (unsigned)wid * 1024u;
    const int aoff = lds_byte(wr * 64 + fr, fq * 8), boff = lds_byte(wc * 32 + fr, fq * 8);
#define PG8_SA(b, h) (((b) * 2 + (h)) * HTB)
#define PG8_SB(b, h) ((4 + (b) * 2 + (h)) * HTB)
#define PG8_STAGE(bufoff, gbase, voff) do { _Pragma("unroll") for (int _i = 0; _i < 2; ++_i) \
        __builtin_amdgcn_global_load_lds((const unsigned*)((const char*)(gbase) + (voff)[_i]), (PG8_LAS unsigned*)(lds + (bufoff) + ldsw + _i * 8192), 16, 0, 0); } while (0)
#define PG8_LDA(dst, b, h) do { _Pragma("unroll") for (int m = 0; m < 4; ++m) _Pragma("unroll") for (int k = 0; k < 2; ++k) dst[m][k] = *(const PG8_LAS bf16x8*)(lds + PG8_SA(b, h) + aoff + m * 2048 + k * 1024); } while (0)
#define PG8_LDB(dst, b, h) do { _Pragma("unroll") for (int n = 0; n < 2; ++n) _Pragma("unroll") for (int k = 0; k < 2; ++k) dst[n][k] = *(const PG8_LAS bf16x8*)(lds + PG8_SB(b, h) + boff + n * 2048 + k * 1024); } while (0)
#define PG8_MMA(ai, bj, At, Bt) do { __builtin_amdgcn_s_setprio(1); _Pragma("unroll") for (int m = 0; m < 4; ++m) _Pragma("unroll") for (int n = 0; n < 2; ++n) _Pragma("unroll") for (int k = 0; k < 2; ++k) \
        acc[ai][bj][m][n] = __builtin_amdgcn_mfma_f32_16x16x32_bf16(Bt[n][k], At[m][k], acc[ai][bj][m][n], 0, 0, 0); __builtin_amdgcn_s_setprio(0); } while (0)
#define PG8_WAIT_V(n) asm volatile("s_waitcnt vmcnt(" #n ")" ::: "memory")
#define PG8_WAIT_L(n) asm volatile("s_waitcnt lgkmcnt(" #n ")" ::: "memory")
#define PG8_BAR __builtin_amdgcn_s_barrier()
#define PG8_SCHED __builtin_amdgcn_sched_barrier(0)
    Unit cur, nxt; int ui = 0;
    if (!S.next(0, cur)) return;
    f32x4 acc[2][2][4][2];
#pragma unroll
    for (int a = 0; a < 2; ++a)
#pragma unroll
        for (int b = 0; b < 2; ++b)
#pragma unroll
            for (int m = 0; m < 4; ++m)
#pragma unroll
                for (int n = 0; n < 2; ++n) acc[a][b][m][n] = (f32x4){0.f, 0.f, 0.f, 0.f};
    bf16x8 At[4][2], B0[2][2], B1[2][2];
    const char* cA = (const char*)g.A + (size_t)cur.pm * tstep + (VARK ? cur.kofs : 0); const char* cB = (const char*)g.Bt + (size_t)cur.pn * tstep + (VARK ? cur.kofs : 0);
    S.a_ready(cur);
    if constexpr (SP2) {
        PG8_STAGE(PG8_SB(0, 0), cB, voffB); PG8_STAGE(PG8_SB(0, 1), cB + hstep, voffB); PG8_STAGE(PG8_SA(0, 0), cA, voffA); PG8_STAGE(PG8_SA(0, 1), cA + hstep, voffA);
        if (wr == 1) PG8_BAR;
        PG8_WAIT_V(2); PG8_BAR;
        PG8_STAGE(PG8_SB(1, 0), cB + kstep, voffB); PG8_STAGE(PG8_SA(1, 0), cA + kstep, voffA); PG8_STAGE(PG8_SB(1, 1), cB + hstep + kstep, voffB);
        PG8_WAIT_V(6); PG8_BAR;
    } else {
        PG8_STAGE(PG8_SB(0, 0), cB, voffB); PG8_STAGE(PG8_SA(0, 0), cA, voffA); PG8_STAGE(PG8_SB(0, 1), cB + hstep, voffB); PG8_STAGE(PG8_SA(0, 1), cA + hstep, voffA);
        if (wr == 1) PG8_BAR;
        PG8_WAIT_V(4); PG8_BAR;
        PG8_STAGE(PG8_SB(1, 0), cB + kstep, voffB); PG8_STAGE(PG8_SA(1, 0), cA + kstep, voffA); PG8_STAGE(PG8_SB(1, 1), cB + hstep + kstep, voffB);
        PG8_WAIT_V(6); PG8_BAR;
    }
    for (;;) {
        const bool has_next = S.next(ui + 1, nxt);
        const char* nA = has_next ? (const char*)g.A + (size_t)nxt.pm * tstep + (VARK ? nxt.kofs : 0) : cA; const char* nB = has_next ? (const char*)g.Bt + (size_t)nxt.pn * tstep + (VARK ? nxt.kofs : 0) : cB;
        const int nt = VARK ? cur.nt : ntc;
        for (int t = 0; t < nt; t += 2) {
            const bool last = (t == nt - 2); const bool fin = last && !has_next;
            const char* a1 = cA + (size_t)(t + 1) * kstep;
            const char* a2 = last ? nA : cA + (size_t)(t + 2) * kstep; const char* b2 = last ? nB : cB + (size_t)(t + 2) * kstep;
            const char* a3 = a2 + kstep; const char* b3 = b2 + kstep;
            if (last && has_next) S.a_ready(nxt);
            if constexpr (SP2) {
            PG8_LDB(B0, 0, 0); PG8_LDB(B1, 0, 1); PG8_SCHED; PG8_LDA(At, 0, 0); PG8_STAGE(PG8_SA(1, 1), a1 + hstep, voffA);
            PG8_WAIT_V(8); PG8_WAIT_L(0); PG8_BAR; PG8_MMA(0, 0, At, B0); PG8_MMA(0, 1, At, B1); PG8_BAR; PG8_SCHED;
            PG8_LDA(At, 0, 1); if (NOTAIL && fin) { PG8_WAIT_V(2); } else { PG8_STAGE(PG8_SB(0, 0), b2, voffB); PG8_STAGE(PG8_SB(0, 1), b2 + hstep, voffB); PG8_STAGE(PG8_SA(0, 0), a2, voffA); PG8_WAIT_V(8); }
            PG8_WAIT_L(0); PG8_BAR; PG8_MMA(1, 0, At, B0); PG8_MMA(1, 1, At, B1); PG8_BAR; PG8_SCHED;
            PG8_LDB(B0, 1, 0); PG8_LDB(B1, 1, 1); PG8_SCHED; PG8_LDA(At, 1, 0); if (NOTAIL && fin) { PG8_WAIT_V(0); } else { PG8_STAGE(PG8_SA(0, 1), a2 + hstep, voffA); PG8_WAIT_V(8); }
            PG8_WAIT_L(0); PG8_BAR; PG8_MMA(0, 0, At, B0); PG8_MMA(0, 1, At, B1); PG8_BAR; PG8_SCHED;
            PG8_LDA(At, 1, 1); if (!(NOTAIL && fin)) { PG8_STAGE(PG8_SB(1, 0), b3, voffB); PG8_STAGE(PG8_SB(1, 1), b3 + hstep, voffB); PG8_STAGE(PG8_SA(1, 0), a3, voffA); PG8_WAIT_V(8); }
            PG8_WAIT_L(0); PG8_BAR; PG8_MMA(1, 0, At, B0); PG8_MMA(1, 1, At, B1); PG8_BAR; PG8_SCHED;
            } else {
            PG8_LDB(B0, 0, 0); PG8_SCHED; PG8_LDA(At, 0, 0); PG8_STAGE(PG8_SA(1, 1), a1 + hstep, voffA);
            PG8_WAIT_L(8); PG8_BAR; PG8_WAIT_L(0); PG8_MMA(0, 0, At, B0); PG8_BAR; PG8_SCHED;
            PG8_LDB(B1, 0, 1); PG8_STAGE(PG8_SB(0, 0), b2, voffB);
            PG8_BAR; PG8_WAIT_L(0); PG8_MMA(0, 1, At, B1); PG8_BAR;
            PG8_LDA(At, 0, 1); PG8_STAGE(PG8_SA(0, 0), a2, voffA);
            PG8_BAR; PG8_WAIT_L(0); PG8_MMA(1, 0, At, B0); PG8_BAR; PG8_SCHED;
            PG8_STAGE(PG8_SB(0, 1), b2 + hstep, voffB);
            PG8_WAIT_V(6); PG8_BAR; PG8_MMA(1, 1, At, B1); PG8_BAR;
            PG8_LDB(B0, 1, 0); PG8_SCHED; PG8_LDA(At, 1, 0); PG8_STAGE(PG8_SA(0, 1), a2 + hstep, voffA);
            PG8_WAIT_L(8); PG8_BAR; PG8_WAIT_L(0); PG8_MMA(0, 0, At, B0); PG8_BAR; PG8_SCHED;
            PG8_LDB(B1, 1, 1); PG8_STAGE(PG8_SB(1, 0), b3, voffB);
            PG8_BAR; PG8_WAIT_L(0); PG8_MMA(0, 1, At, B1); PG8_BAR;
            PG8_LDA(At, 1, 1); PG8_STAGE(PG8_SA(1, 0), a3, voffA);
            PG8_BAR; PG8_WAIT_L(0); PG8_MMA(1, 0, At, B0); PG8_BAR; PG8_SCHED;
            PG8_STAGE(PG8_SB(1, 1), b3 + hstep, voffB);
            PG8_WAIT_V(6); PG8_BAR; PG8_MMA(1, 1, At, B1); PG8_BAR;
            }
        }
        if constexpr (ALIGN_EPI) { if (wr == 0) PG8_BAR; }
        if constexpr (!Epi::AFTER_DRAIN) { E(acc, cur, ui, wr, wc, fr, fq); S.done(cur); }
        if (!has_next) break;
#pragma unroll
        for (int a = 0; a < 2; ++a)
#pragma unroll
            for (int b = 0; b < 2; ++b)
#pragma unroll
                for (int m = 0; m < 4; ++m)
#pragma unroll
                    for (int n = 0; n < 2; ++n) acc[a][b][m][n] = (f32x4){0.f, 0.f, 0.f, 0.f};
        cur = nxt; cA = nA; cB = nB; ++ui;
        if constexpr (ALIGN_EPI) { if (wr == 1) PG8_BAR; }
    }
    PG8_WAIT_V(0);
    if constexpr (!ALIGN_EPI) { if (wr == 0) PG8_BAR; }
    PG8_BAR;
    if constexpr (Epi::AFTER_DRAIN) { E.fused(acc, cur, wr, wc, fr, fq, lds, wid, lane); S.done(cur); }
#undef PG8_SA
#undef PG8_SB
#undef PG8_STAGE
#undef PG8_LDA
#undef PG8_LDB
#undef PG8_MMA
#undef PG8_WAIT_V
#undef PG8_WAIT_L
#undef PG8_BAR
#undef PG8_SCHED
}
}
namespace att {
typedef unsigned short bf16_t;
typedef short bf16x8 __attribute__((ext_vector_type(8)));
typedef float f32x16 __attribute__((ext_vector_type(16)));
typedef float f32x4 __attribute__((ext_vector_type(4)));
typedef unsigned u32x4 __attribute__((ext_vector_type(4)));
#define ALAS __attribute__((address_space(3)))
constexpr int MROWS = M;
constexpr int WSF_OFF = 114688;
constexpr int LDS_NEED = WSF_OFF + 8 * 256;
__device__ __forceinline__ int crow(int r, int hi) { return (r & 3) + 8 * (r >> 2) + 4 * hi; }
__device__ __forceinline__ void glds16(const void* gsrc, unsigned lds_dst) { unsigned keep;
    asm volatile("s_mov_b32 %0, m0\n\ts_mov_b32 m0, %2\n\ts_nop 0\n\tglobal_load_lds_dwordx4 %1, off\n\ts_mov_b32 m0, %0" : "=&s"(keep) : "v"(gsrc), "s"(lds_dst) : "memory"); }
typedef float f32x2_t __attribute__((ext_vector_type(2))); typedef __bf16 bf16x2_t __attribute__((ext_vector_type(2)));
__device__ __forceinline__ unsigned cvtpk(float lo, float hi) { f32x2_t v = {lo, hi}; bf16x2_t b = __builtin_convertvector(v, bf16x2_t); return __builtin_bit_cast(unsigned, b); }
__device__ __forceinline__ void glds16s(const void* sbase, unsigned voff, unsigned lds_dst) { unsigned keep;
#ifdef GLDS_M0_CLOBBER
    (void)keep; asm volatile("s_mov_b32 m0, %2\n\ts_nop 0\n\tglobal_load_lds_dwordx4 %0, %1" :: "v"(voff), "s"(sbase), "s"(lds_dst) : "memory", "m0"); }
#else
    asm volatile("s_mov_b32 %0, m0\n\ts_mov_b32 m0, %3\n\ts_nop 0\n\tglobal_load_lds_dwordx4 %1, %2\n\ts_mov_b32 m0, %0" : "=&s"(keep) : "v"(voff), "s"(sbase), "s"(lds_dst) : "memory"); }
#endif
#define ATT_WAIT_BAR(N) asm volatile("s_waitcnt vmcnt(" #N ") lgkmcnt(0)\n\ts_barrier" ::: "memory")
#define ATT_MFMA(a, b, c) __builtin_amdgcn_mfma_f32_32x32x16_bf16(a, b, c, 0, 0, 0)

struct Tensors { unsigned char* ws; const ALAS float* subln; };
__device__ __forceinline__ Tensors make_tensors(unsigned char* ws, const ALAS float* prm) { return Tensors{ws, prm + PRM_SUBLN}; }
#define T_QA ((const bf16_t*)(tws_ + WS_QA))
#define T_KA ((const bf16_t*)(tws_ + WS_KA))
#define T_VA ((const bf16_t*)(tws_ + WS_VA))
#define T_QB ((const bf16_t*)(tws_ + WS_QB))
#define T_KB ((const bf16_t*)(tws_ + WS_KB))
#define T_VB ((const bf16_t*)(tws_ + WS_VB))
#define T_MIX ((bf16_t*)(tws_ + WS_MIX))

#define SBAR() __builtin_amdgcn_sched_barrier(0)
#define PIN(x) asm volatile("" : "+v"(x))
#define PKW(P, B) cvtpk(P[B], P[(B) + 1])
#define EX(v) __builtin_amdgcn_exp2f(v)
#define WB_SEL(n) do { switch (n) { case 0: ATT_WAIT_BAR(0); break; case 1: ATT_WAIT_BAR(1); break; case 2: ATT_WAIT_BAR(2); break; case 3: ATT_WAIT_BAR(3); break; case 4: ATT_WAIT_BAR(4); break; case 6: ATT_WAIT_BAR(6); break; default: ATT_WAIT_BAR(8); } } while (0)
template <bool ISB>
__device__ __forceinline__ void attn_unit(const Tensors& T, int head, int qb, float negM2, float lam, float c2, int dskip, char* shm, int wave_id) {
    unsigned char* tws_ = T.ws; LAUNDER_G(tws_);
    constexpr int DV = ISB ? 128 : 64, ND0 = DV / 32, NK = ISB ? 2 : 1, NV = ISB ? 2 : 1;
    constexpr int KSLOT = ISB ? 16384 : 8192, VSLOT = ISB ? 16384 : 8192, LDS_K = 0, LDS_V = 3 * KSLOT;
    int tid_ = wave_id * 64 + lane_id_v(); asm volatile("" : "+v"(tid_));
    const int tid = tid_, lane = tid & 63, r32 = lane & 31, hi = lane >> 5; const int wid = __builtin_amdgcn_readfirstlane(tid >> 6);
    const int mapc = ISB ? (wid >> 2) : 0, wq = ISB ? (wid & 3) : wid;
    const int q0 = ISB ? qb * 128 : qb * 256; const int qrow = q0 + wq * 32 + r32;
    int t0 = 0, t1 = 256;
    if (ISB) { const int lo = q0 - dskip, hi_ = q0 + 127 + dskip; t0 = lo > 0 ? (lo >> 6) : 0; t1 = (hi_ >> 6) + 1; if (t1 > 256) t1 = 256;
        if ((t1 - t0) & 1) { if (t0 > 0) --t0; else ++t1; } }
    const int n = t1 - t0;
    const unsigned lds0 = (unsigned)(uintptr_t)shm;
    const ALAS char* shm3 = (const ALAS char*)shm;
    const char* k1b = ISB ? (const char*)(T_KB + (size_t)(2 * head) * MROWS * 64) + (size_t)t0 * 8192 : (const char*)(T_KA + (size_t)(head >> 2) * MROWS * 64);
    const char* k2b = ISB ? (const char*)(T_KB + (size_t)(2 * head + 1) * MROWS * 64) + (size_t)t0 * 8192 : nullptr;
    const char* vb_ = ISB ? (const char*)(T_VB + (size_t)head * MROWS * 128) + (size_t)t0 * 16384 : (const char*)(T_VA + (size_t)(head >> 2) * MROWS * 64);
    const unsigned dvo = (unsigned)(wid * 1024 + lane * 16);
    const unsigned kdst = lds0 + LDS_K + wid * 1024, vdst = lds0 + LDS_V + wid * 1024;
#define DMA_K(i, so) do { glds16s(k1b + (size_t)(i) * 8192, dvo, (unsigned)__builtin_amdgcn_readfirstlane(kdst + (so))); if (ISB) glds16s(k2b + (size_t)(i) * 8192, dvo, (unsigned)__builtin_amdgcn_readfirstlane(kdst + (so) + 8192)); } while (0)
#define DMA_V(i, so) do { if (ISB) { glds16s(vb_ + (size_t)(i) * 16384, dvo, (unsigned)__builtin_amdgcn_readfirstlane(vdst + (so))); glds16s(vb_ + (size_t)(i) * 16384 + 8192, dvo, (unsigned)__builtin_amdgcn_readfirstlane(vdst + (so) + 8192)); } \
      else glds16s(vb_ + (size_t)(i) * 8192, dvo, (unsigned)__builtin_amdgcn_readfirstlane(vdst + (so))); } while (0)
    DMA_K(0, 0); DMA_V(0, 0); DMA_K(1, KSLOT); DMA_V(1, VSLOT);
    const bf16_t* Qw = (ISB ? T_QB + (size_t)(2 * head + mapc) * MROWS * 64 : T_QA + (size_t)head * MROWS * 64) + (size_t)qrow * 64;
    bf16x8 qr[4];
#pragma unroll
    for (int d0 = 0; d0 < 4; ++d0) qr[d0] = *(const bf16x8*)(Qw + d0 * 16 + hi * 8);
    f32x16 o[ND0];
#pragma unroll
    for (int d = 0; d < ND0; ++d) o[d] = f32x16{};
    f32x16 negm;
#pragma unroll
    for (int r = 0; r < 16; ++r) negm[r] = negM2;
    asm volatile("" : "+v"(negm));
    float l_reg = 0.f;
    f32x16 osum = f32x16{}; bf16x8 ones; { const short o1 = (short)0x3f80; ones = (bf16x8){o1, o1, o1, o1, o1, o1, o1, o1}; } asm volatile("" : "+v"(ones));
    const ALAS char* kp0 = shm3 + LDS_K + (ISB ? mapc * 8192 : 0) + hi * 1024 + r32 * 16;
    const ALAS char* vp0 = shm3 + LDS_V + hi * (DV * 16) + r32 * 16;
    const int qw_lo = q0 + wq * 32, qw_hi = qw_lo + 31;
    const float nc2 = -c2; const float dl0 = (float)(64 * t0 - qrow + 4 * hi);
#define BIAS_GEN4(X, B, DC) do { const float e1_ = (DC) + 1.0f, e2_ = (DC) + 2.0f, e3_ = e1_ + 2.0f; \
        X[B] = __builtin_fmaf(__builtin_fabsf(DC), nc2, negM2); X[(B) + 1] = __builtin_fmaf(__builtin_fabsf(e1_), nc2, negM2); X[(B) + 2] = __builtin_fmaf(__builtin_fabsf(e2_), nc2, negM2); X[(B) + 3] = __builtin_fmaf(__builtin_fabsf(e3_), nc2, negM2); DC += 8.0f; } while (0)
#define BIAS_FAST4(X, B, DC) do { X[B] = __builtin_fmaf(sc1_, (DC), negM2); float t1_ = X[B] + sc1_; asm volatile("" : "+v"(t1_)); float t2_ = X[B] + sc2_; asm volatile("" : "+v"(t2_)); X[(B) + 1] = t1_; X[(B) + 2] = t2_; X[(B) + 3] = X[B] + sc3_; DC += 8.0f; } while (0)
#define BIAS_ALL(X0, X1, DL) do { float dc_ = (DL); BIAS_GEN4(X0, 0, dc_); BIAS_GEN4(X0, 4, dc_); BIAS_GEN4(X0, 8, dc_); BIAS_GEN4(X0, 12, dc_); BIAS_GEN4(X1, 0, dc_); BIAS_GEN4(X1, 4, dc_); BIAS_GEN4(X1, 8, dc_); BIAS_GEN4(X1, 12, dc_); } while (0)
#ifdef BIAS_CONST
    float cst[32];
#pragma unroll
    for (int e = 0; e < 32; ++e) { float cv_ = c2 * (float)(8 * (e >> 2) + (e & 3)); asm volatile("" : "+v"(cv_)); cst[e] = __builtin_bit_cast(float, __builtin_amdgcn_readfirstlane(__builtin_bit_cast(int, cv_))); }
#define BIAS_STEP_SETUP() const float base_ = __builtin_fmaf(sc1_, dcn_, negM2); float sgn_ = above_ ? -1.0f : 1.0f; asm volatile("" : "+v"(sgn_))
#else
#define BIAS_STEP_SETUP() do {} while (0)
#endif
    f32x16 pA0, pA1, pB0, pB1;
    bf16x8 kf[8], vf[4]; u32x4 pw0, pw1, pw2, pw3;
    int ks_prev = 0, ks_cur = 0, ks_next = KSLOT, vs_prev = 0, vs_cur = VSLOT, vs_next = 2 * VSLOT, vs_n2 = 3 * VSLOT;
#define ROTK() do { ks_prev = ks_cur; ks_cur = ks_next; ks_next = (ks_next == 2 * KSLOT) ? 0 : ks_next + KSLOT; } while (0)
#define ROT() do { ROTK(); const int tv_ = vs_prev; vs_prev = vs_cur; vs_cur = vs_next; vs_next = vs_n2; vs_n2 = tv_; } while (0)
    DMA_K(2, 2 * KSLOT);
    WB_SEL(2 * NV + 2 * NK);
    if (ISB) { BIAS_ALL(pA0, pA1, dl0); } else { pA0 = negm; pA1 = negm; }
    {
        const ALAS char* kp = kp0;
#pragma unroll
        for (int d0 = 0; d0 < 4; ++d0) { const bf16x8 b0 = *(const ALAS bf16x8*)(kp + d0 * 2048), b1 = *(const ALAS bf16x8*)(kp + d0 * 2048 + 512);
            pA0 = ATT_MFMA(b0, qr[d0], pA0); pA1 = ATT_MFMA(b1, qr[d0], pA1); }
#pragma unroll
        for (int r = 0; r < 16; ++r) { pA0[r] = EX(pA0[r]); pA1[r] = EX(pA1[r]); }
    }
    WB_SEL(0);
    DMA_K(3, 0); DMA_V(2, 2 * VSLOT);
    ROTK();
#define KLOAD2(base, j) do { kf[2 * (j)] = *(const ALAS bf16x8*)((base) + (j) * 2048); kf[2 * (j) + 1] = *(const ALAS bf16x8*)((base) + (j) * 2048 + 512); } while (0)
    { const ALAS char* kb_ = kp0 + ks_cur; KLOAD2(kb_, 0); KLOAD2(kb_, 1); KLOAD2(kb_, 2); KLOAD2(kb_, 3); }
    if (ISB) { BIAS_ALL(pB0, pB1, dl0 + 64.f); }
    WB_SEL(NK + NV);
#define PAF(k) __builtin_bit_cast(bf16x8, pw##k)
#if (B_ORDER & 1)
#define GAPA(MF, A0, A1, A2, A3, W0, W1, PW) do { if (ISB) { sacc += A0; sacc += A1; sacc += A2; sacc += A3; PIN(sacc); } W0; W1; PIN(PW); SBAR(); MF; SBAR(); } while (0)
#else
#define GAPA(MF, A0, A1, A2, A3, W0, W1, PW) do { MF; if (ISB) { sacc += A0; sacc += A1; sacc += A2; sacc += A3; PIN(sacc); } W0; W1; PIN(PW); SBAR(); } while (0)
#endif
#define GAPB(MF, X, B) do { MF; X[B] = EX(X[B]); X[(B) + 1] = EX(X[(B) + 1]); X[(B) + 2] = EX(X[(B) + 2]); X[(B) + 3] = EX(X[(B) + 3]); PIN(X); SBAR(); } while (0)
#define GAPX(MF, EXS, X) do { MF; EXS; PIN(X); SBAR(); } while (0)
#define EXE(C0, C1, k) do { if ((k) < 16) C0[(k) & 15] = EX(C0[(k) & 15]); else C1[(k) & 15] = EX(C1[(k) & 15]); } while (0)
#define EXN(C0, C1, k, N) do { EXE(C0, C1, k); if ((N) > 1) EXE(C0, C1, (k) + 1); if ((N) > 2) EXE(C0, C1, (k) + 2); } while (0)
#if (B_ORDER & 2)
#define GAPEN(MF, C0, C1, k, N) do { EXN(C0, C1, k, N); PIN(C0); PIN(C1); SBAR(); MF; SBAR(); } while (0)
#else
#define GAPEN(MF, C0, C1, k, N) do { MF; EXN(C0, C1, k, N); PIN(C0); PIN(C1); SBAR(); } while (0)
#endif
#define GAPE3(MF, C0, C1, k) do { MF; EXE(C0, C1, k); EXE(C0, C1, (k) + 1); EXE(C0, C1, (k) + 2); PIN(C0); PIN(C1); SBAR(); } while (0)
#ifdef BIAS_CONST
#define GAPC(MF, G, X, B, E0) do { MF; if (G) { { float a0_ = __builtin_fmaf(sgn_, cst[(E0) + (B)], base_), a1_ = __builtin_fmaf(sgn_, cst[(E0) + (B) + 1], base_), a2_ = __builtin_fmaf(sgn_, cst[(E0) + (B) + 2], base_), a3_ = __builtin_fmaf(sgn_, cst[(E0) + (B) + 3], base_); asm volatile("" : "+v"(a0_), "+v"(a1_), "+v"(a2_), "+v"(a3_)); X[B] = a0_; X[(B) + 1] = a1_; X[(B) + 2] = a2_; X[(B) + 3] = a3_; } \
        if (__builtin_expect(!fastb_, 0)) { float dg_ = dcn_ + (float)(8 * (((E0) + (B)) >> 2)); BIAS_GEN4(X, B, dg_); } PIN(X); } SBAR(); } while (0)
#else
#define GAPC(MF, G, X, B, E0) do { MF; if (G) { BIAS_FAST4(X, B, dcn_); if (__builtin_expect(!fastb_, 0)) { float dg_ = dcn_ - 8.0f; BIAS_GEN4(X, B, dg_); } PIN(X); } SBAR(); } while (0)
#endif
#define VRD(i) do { vf[i] = *(const ALAS bf16x8*)(vp_ + ((i) & 3) * (DV * 32) + ((i) >> 2) * 512); } while (0)
#define VRDN(i, d) do { vf[i] = *(const ALAS bf16x8*)(vp_ + (i) * (DV * 32) + (d) * 512); } while (0)
#define VRDA(i) do { vf[i] = *(const ALAS bf16x8*)(vp_ + (i) * (DV * 32) + 512); } while (0)
#define VRD2(i) do { vf[i] = *(const ALAS bf16x8*)(vp_ + ((i) & 3) * (DV * 32) + (((i) >> 2) + 2) * 512); } while (0)
#define KRD(G, j) do { if (G) { KLOAD2(kn_, j); SBAR(); } } while (0)
#define KRD1(G, j) do { if (G) { kf[j] = *(const ALAS bf16x8*)(kn_ + ((j) >> 1) * 2048 + ((j) & 1) * 512); SBAR(); } } while (0)
#define CIN(C) (ISB ? C : negm)
#define STEP(C0, C1, P0, P1, i, GK, GV, GL) do { SBAR(); \
    const ALAS char* vp_ = vp0 + vs_prev; const ALAS char* kn_ = kp0 + ks_next; float dcn_ = dl0 + 64.f * (float)((i) + 1); const int kt_ = 64 * (t0 + (i) + 1); const bool above_ = kt_ > qw_hi, fastb_ = above_ || (kt_ + 63 < qw_lo); \
    const float sc1_ = above_ ? nc2 : c2, sc2_ = sc1_ + sc1_, sc3_ = sc2_ + sc1_; BIAS_STEP_SETUP(); \
    VRD(0); SBAR(); float sacc = P0[0] + P0[1]; \
    GAPA(C0 = ATT_MFMA(kf[0], qr[0], CIN(C0)), P0[2], P0[3], P0[4], P0[5],     pw0[0] = PKW(P0, 0), pw0[1] = PKW(P0, 2), pw0); \
    SBAR(); GAPA(C1 = ATT_MFMA(kf[1], qr[0], CIN(C1)), P0[6], P0[7], P0[8], P0[9],     pw0[2] = PKW(P0, 4), pw0[3] = PKW(P0, 6), pw0); \
    VRD(1); SBAR(); GAPA(C0 = ATT_MFMA(kf[2], qr[1], C0),   P0[10], P0[11], P0[12], P0[13], pw1[0] = PKW(P0, 8), pw1[1] = PKW(P0, 10), pw1); \
    SBAR(); GAPA(C1 = ATT_MFMA(kf[3], qr[1], C1),   P0[14], P0[15], P1[0], P1[1],   pw1[2] = PKW(P0, 12), pw1[3] = PKW(P0, 14), pw1); \
    VRD(2); SBAR(); GAPA(C0 = ATT_MFMA(kf[4], qr[2], C0),   P1[2], P1[3], P1[4], P1[5],     pw2[0] = PKW(P1, 0), pw2[1] = PKW(P1, 2), pw2); \
    SBAR(); GAPA(C1 = ATT_MFMA(kf[5], qr[2], C1),   P1[6], P1[7], P1[8], P1[9],     pw2[2] = PKW(P1, 4), pw2[3] = PKW(P1, 6), pw2); \
    VRD(3); SBAR(); GAPA(C0 = ATT_MFMA(kf[6], qr[3], C0),   P1[10], P1[11], P1[12], P1[13], pw3[0] = PKW(P1, 8), pw3[1] = PKW(P1, 10), pw3); \
    SBAR(); GAPA(C1 = ATT_MFMA(kf[7], qr[3], C1),   P1[14], P1[15], 0.f, 0.f,       pw3[2] = PKW(P1, 12), pw3[3] = PKW(P1, 14), pw3); \
    l_reg += sacc; \
    if (BDMA_MODE < 4) { if (GK) { DMA_K((i) + 3, ks_cur); } } if (BDMA_MODE == 0 || BDMA_MODE == 4) { if (GV) { DMA_V((i) + 2, vs_n2); } } \
    SBAR(); \
    if (!ISB) { \
        GAPX(o[0] = ATT_MFMA(PAF(0), vf[0], o[0]), C0[0] = EX(C0[0]); C0[1] = EX(C0[1]); C0[2] = EX(C0[2]), C0); \
        VRDA(0); SBAR(); GAPX(o[0] = ATT_MFMA(PAF(1), vf[1], o[0]), C0[3] = EX(C0[3]); C0[4] = EX(C0[4]); C0[5] = EX(C0[5]), C0); \
        VRDA(1); SBAR(); GAPX(osum = ATT_MFMA(PAF(0), ones, osum),  C0[6] = EX(C0[6]); C0[7] = EX(C0[7]); C0[8] = EX(C0[8]), C0); \
        GAPX(o[0] = ATT_MFMA(PAF(2), vf[2], o[0]), C0[9] = EX(C0[9]); C0[10] = EX(C0[10]); C0[11] = EX(C0[11]), C0); \
        VRDA(2); SBAR(); GAPX(o[0] = ATT_MFMA(PAF(3), vf[3], o[0]), C0[12] = EX(C0[12]); C0[13] = EX(C0[13]); C0[14] = EX(C0[14]), C0); \
        VRDA(3); SBAR(); GAPX(osum = ATT_MFMA(PAF(1), ones, osum),  C0[15] = EX(C0[15]); C1[0] = EX(C1[0]); C1[1] = EX(C1[1]), C1); PIN(C0); \
        KRD(GL, 0); GAPX(o[1] = ATT_MFMA(PAF(0), vf[0], o[1]), C1[2] = EX(C1[2]); C1[3] = EX(C1[3]); C1[4] = EX(C1[4]), C1); \
        KRD(GL, 1); GAPX(o[1] = ATT_MFMA(PAF(1), vf[1], o[1]), C1[5] = EX(C1[5]); C1[6] = EX(C1[6]); C1[7] = EX(C1[7]), C1); \
        KRD(GL, 2); GAPX(osum = ATT_MFMA(PAF(2), ones, osum),  C1[8] = EX(C1[8]); C1[9] = EX(C1[9]); C1[10] = EX(C1[10]), C1); \
        KRD(GL, 3); GAPX(o[1] = ATT_MFMA(PAF(2), vf[2], o[1]), C1[11] = EX(C1[11]); C1[12] = EX(C1[12]), C1); \
        GAPX(o[1] = ATT_MFMA(PAF(3), vf[3], o[1]), C1[13] = EX(C1[13]); C1[14] = EX(C1[14]), C1); \
        GAPX(osum = ATT_MFMA(PAF(3), ones, osum),  C1[15] = EX(C1[15]), C1); \
    } else { \
        GAPEN(o[0] = ATT_MFMA(PAF(0), vf[0], o[0]), C0, C1, 0, 3);  VRDN(0, 1); KRD1(GL, 0); SBAR(); \
        GAPEN(o[0] = ATT_MFMA(PAF(1), vf[1], o[0]), C0, C1, 3, 2);  VRDN(1, 1); KRD1(GL, 1); SBAR(); \
        GAPEN(o[0] = ATT_MFMA(PAF(2), vf[2], o[0]), C0, C1, 5, 3);  VRDN(2, 1); KRD1(GL, 2); SBAR(); \
        GAPEN(o[0] = ATT_MFMA(PAF(3), vf[3], o[0]), C0, C1, 8, 2);  VRDN(3, 1); KRD1(GL, 3); SBAR(); \
        if (BDMA_MODE == 2) { if (GV) { DMA_V((i) + 2, vs_n2); } SBAR(); } \
        GAPEN(o[1] = ATT_MFMA(PAF(0), vf[0], o[1]), C0, C1, 10, 3); VRDN(0, 2); KRD1(GL, 4); SBAR(); \
        GAPEN(o[1] = ATT_MFMA(PAF(1), vf[1], o[1]), C0, C1, 13, 2); VRDN(1, 2); KRD1(GL, 5); SBAR(); \
        GAPEN(o[1] = ATT_MFMA(PAF(2), vf[2], o[1]), C0, C1, 15, 3); VRDN(2, 2); KRD1(GL, 6); SBAR(); \
        GAPEN(o[1] = ATT_MFMA(PAF(3), vf[3], o[1]), C0, C1, 18, 2); VRDN(3, 2); KRD1(GL, 7); SBAR(); \
        if (BDMA_MODE == 1 || BDMA_MODE == 5) { if (GV) { DMA_V((i) + 2, vs_n2); } SBAR(); } if (BDMA_MODE == 4 || BDMA_MODE == 5) { if (GK) { DMA_K((i) + 3, ks_cur); } SBAR(); } \
        GAPC(o[ND0 - 2] = ATT_MFMA(PAF(0), vf[0], o[ND0 - 2]); EXN(C0, C1, 20, 2), GL, P0, 0, 0);  VRDN(0, 3); SBAR(); \
        GAPC(o[ND0 - 2] = ATT_MFMA(PAF(1), vf[1], o[ND0 - 2]); EXN(C0, C1, 22, 1), GL, P0, 4, 0);  VRDN(1, 3); SBAR(); \
        GAPC(o[ND0 - 2] = ATT_MFMA(PAF(2), vf[2], o[ND0 - 2]); EXN(C0, C1, 23, 2), GL, P0, 8, 0);  VRDN(2, 3); SBAR(); \
        GAPC(o[ND0 - 2] = ATT_MFMA(PAF(3), vf[3], o[ND0 - 2]); EXN(C0, C1, 25, 1), GL, P0, 12, 0); VRDN(3, 3); SBAR(); \
        GAPC(o[ND0 - 1] = ATT_MFMA(PAF(0), vf[0], o[ND0 - 1]); EXN(C0, C1, 26, 2), GL, P1, 0, 16); \
        GAPC(o[ND0 - 1] = ATT_MFMA(PAF(1), vf[1], o[ND0 - 1]); EXN(C0, C1, 28, 1), GL, P1, 4, 16); \
        GAPC(o[ND0 - 1] = ATT_MFMA(PAF(2), vf[2], o[ND0 - 1]); EXN(C0, C1, 29, 2), GL, P1, 8, 16); \
        GAPC(o[ND0 - 1] = ATT_MFMA(PAF(3), vf[3], o[ND0 - 1]); EXN(C0, C1, 31, 1); PIN(C1), GL, P1, 12, 16); \
        if (BDMA_MODE == 3) { if (GV) { DMA_V((i) + 2, vs_n2); } SBAR(); } \
    } } while (0)
    int i = 1;
    for (; i + 5 < n; i += 2) {
        STEP(pB0, pB1, pA0, pA1, i, true, true, true);     WB_SEL(NK + 2 * NV); ROT();
        STEP(pA0, pA1, pB0, pB1, i + 1, true, true, true); WB_SEL(NK + 2 * NV); ROT();
    }
#define ENDW(ii) do { if ((ii) + 3 < n) { WB_SEL(NK + 2 * NV); } else if ((ii) + 2 < n) { WB_SEL(2 * NV); } else { WB_SEL(0); } } while (0)
    for (; i + 1 < n; i += 2) {
        STEP(pB0, pB1, pA0, pA1, i, (i + 3 < n), (i + 2 < n), (i + 1 < n));         ENDW(i);     ROT();
        STEP(pA0, pA1, pB0, pB1, i + 1, (i + 4 < n), (i + 3 < n), (i + 2 < n));     ENDW(i + 1); ROT();
    }
    STEP(pB0, pB1, pA0, pA1, n - 1, false, false, false);
    { if (ISB) { float sacc = pB0[0] + pB0[1];
#pragma unroll
      for (int r = 2; r < 16; ++r) sacc += pB0[r];
#pragma unroll
      for (int r = 0; r < 16; ++r) sacc += pB1[r];
      l_reg += sacc; }
      pw0 = (u32x4){PKW(pB0, 0), PKW(pB0, 2), PKW(pB0, 4), PKW(pB0, 6)}; pw1 = (u32x4){PKW(pB0, 8), PKW(pB0, 10), PKW(pB0, 12), PKW(pB0, 14)};
      pw2 = (u32x4){PKW(pB1, 0), PKW(pB1, 2), PKW(pB1, 4), PKW(pB1, 6)}; pw3 = (u32x4){PKW(pB1, 8), PKW(pB1, 10), PKW(pB1, 12), PKW(pB1, 14)};
      SBAR();
      const ALAS char* vp_ = vp0 + vs_cur;
#pragma unroll
      for (int d = 0; d < ND0; ++d) {
          const bf16x8 v0 = *(const ALAS bf16x8*)(vp_ + 0 * (DV * 32) + d * 512), v1 = *(const ALAS bf16x8*)(vp_ + 1 * (DV * 32) + d * 512), v2 = *(const ALAS bf16x8*)(vp_ + 2 * (DV * 32) + d * 512), v3 = *(const ALAS bf16x8*)(vp_ + 3 * (DV * 32) + d * 512);
          o[d] = ATT_MFMA(PAF(0), v0, o[d]); o[d] = ATT_MFMA(PAF(1), v1, o[d]); o[d] = ATT_MFMA(PAF(2), v2, o[d]); o[d] = ATT_MFMA(PAF(3), v3, o[d]); }
      if (!ISB) { osum = ATT_MFMA(PAF(0), ones, osum); osum = ATT_MFMA(PAF(1), ones, osum); osum = ATT_MFMA(PAF(2), ones, osum); osum = ATT_MFMA(PAF(3), ones, osum); } }
    const float sacc = l_reg;
    const int lane_e = lane_id_v();
    ATT_WAIT_BAR(0);
    {
    const int lane = lane_e, r32 = lane & 31, hi = lane >> 5; const int q0 = ISB ? qb * 128 : qb * 256;
    float rli[16];
    ALAS float* wsf = (ALAS float*)(shm3 + WSF_OFF) + wid * 64;
    if (ISB) {
        const float l = sum_x32(sacc);
        if (hi == 0) wsf[r32] = l;
        asm volatile("s_waitcnt lgkmcnt(0)" ::: "memory");
#pragma unroll
        for (int r = 0; r < 16; ++r) rli[r] = __builtin_amdgcn_rcpf(wsf[crow(r, hi)]);
    } else {
#pragma unroll
        for (int r = 0; r < 16; ++r) rli[r] = __builtin_amdgcn_rcpf(osum[r]);
    }
    if (!ISB) {
        ALAS bf16_t* stg = (ALAS bf16_t*)shm3 + wid * 2048;
#pragma unroll
        for (int r = 0; r < 16; ++r) { const int orow = crow(r, hi);
#pragma unroll
            for (int d = 0; d < ND0; ++d) stg[orow * 64 + d * 32 + r32] = pg8::f2bf1(o[d][r] * rli[r]); }
        asm volatile("s_waitcnt lgkmcnt(0)" ::: "memory");
#pragma unroll
        for (int i = 0; i < 4; ++i) { const int row = i * 8 + (lane >> 3), ch = lane & 7; const u32x4 v = *(const ALAS u32x4*)(stg + row * 64 + ch * 8);
            *(u32x4*)(T_MIX + (size_t)(q0 + wid * 32 + row) * 1024 + head * 64 + ch * 8) = v; }
    } else {
        ALAS float* X = (ALAS float*)shm3 + wq * 4096;
        const float sc = (mapc == 1) ? lam : 1.0f;
        if (mapc == 1) {
#pragma unroll
            for (int r = 0; r < 16; ++r) { const int orow = crow(r, hi); const float f = rli[r] * sc;
#pragma unroll
                for (int d = 0; d < ND0; ++d) X[orow * 128 + d * 32 + r32] = o[d][r] * f; }
        }
        asm volatile("s_waitcnt lgkmcnt(0)\n\ts_barrier" ::: "memory");
        if (mapc == 0) {
#pragma unroll
            for (int r = 0; r < 16; ++r) { const int orow = crow(r, hi);
#pragma unroll
                for (int d = 0; d < ND0; ++d) { const int idx = orow * 128 + d * 32 + r32; X[idx] = o[d][r] * rli[r] - X[idx]; } }
            asm volatile("s_waitcnt lgkmcnt(0)" ::: "memory");
            const int qq = lane >> 1, hf = lane & 1;
            const ALAS float* rowp = X + qq * 128 + hf * 64;
            f32x4 vv[16]; float ss = 0.f;
#pragma unroll
            for (int i = 0; i < 16; ++i) { vv[i] = *(const ALAS f32x4*)(rowp + 4 * i); ss += (vv[i][0] * vv[i][0] + vv[i][1] * vv[i][1]) + (vv[i][2] * vv[i][2] + vv[i][3] * vv[i][3]); }
            ss += xor_lane<1>(ss);
            const float rs = 0.8f / sqrtf(ss * (1.0f / 128.0f) + 1e-6f);
            bf16_t* dst = T_MIX + (size_t)(q0 + wq * 32 + qq) * 1024 + 512 + head * 128 + hf * 64;
            const ALAS float* sl = T.subln + hf * 64;
#pragma unroll
            for (int i = 0; i < 8; ++i) { const f32x4 g0 = *(const ALAS f32x4*)(sl + 8 * i), g1 = *(const ALAS f32x4*)(sl + 8 * i + 4); const f32x4 a = vv[2 * i] * rs * g0, b = vv[2 * i + 1] * rs * g1;
                u32x4 w; w.x = cvtpk(a[0], a[1]); w.y = cvtpk(a[2], a[3]); w.z = cvtpk(b[0], b[1]); w.w = cvtpk(b[2], b[3]); *(u32x4*)(dst + 8 * i) = w; }
        }
    }
    }
    asm volatile("s_waitcnt lgkmcnt(0)\n\ts_barrier" ::: "memory");
#undef DMA_K
#undef DMA_V
#undef ROT
#undef STEP
#undef ENDW
#undef GAPA
#undef GAPB
#undef GAPC
#undef GAPE3
#undef GAPEN
#undef EXN
#undef EXE
#undef GAPX
#undef VRD
#undef VRD2
#undef VRDA
#undef VRDN
#undef KRD
#undef KRD1
#undef CIN
#undef PAF
#undef KLOAD2
#undef BIAS_GEN4
#undef BIAS_FAST4
#undef BIAS_ALL
#undef BIAS_STEP_SETUP
}

typedef int i32x8 __attribute__((ext_vector_type(8)));
typedef unsigned u32x8 __attribute__((ext_vector_type(8)));
#define MFMA8(a, b, c) __builtin_amdgcn_mfma_scale_f32_32x32x64_f8f6f4(a, b, c, 0, 0, 0, 0, 0, 0)
__device__ __forceinline__ void attn_unit_a8(const Tensors& T, int head, int qb, float negM2s, char* shm, int wave_id) {
    unsigned char* tws_ = T.ws; LAUNDER_G(tws_);
    constexpr int KSLOT = 4096, VSLOT = 4096, LDS_K = 0, LDS_V = 3 * KSLOT, n = 256;
    int tid_ = wave_id * 64 + lane_id_v(); asm volatile("" : "+v"(tid_));
    const int tid = tid_, lane = tid & 63, r32 = lane & 31, hi = lane >> 5; const int wid = __builtin_amdgcn_readfirstlane(tid >> 6);
    const int q0 = qb * 256; const int qrow = q0 + wid * 32 + r32;
    const unsigned lds0 = (unsigned)(uintptr_t)shm;
    const ALAS char* shm3 = (const ALAS char*)shm;
    const bool kw = wid < 4;
    const char* sb = (const char*)(tws_ + (kw ? WS_KA : WS_VA)) + (size_t)(head >> 2) * MROWS * 64 + (wid & 3) * 1024;
    const unsigned dvo = (unsigned)(lane * 16);
    const unsigned ddst = lds0 + (kw ? LDS_K : LDS_V) + (wid & 3) * 1024;
#define DMA8(i, so) glds16s(sb + (size_t)(i) * 4096, dvo, (unsigned)__builtin_amdgcn_readfirstlane(ddst + (so)))
#define WB8(NKW, NVW) do { if (kw) { WB_SEL(NKW); } else { WB_SEL(NVW); } } while (0)
    if (kw) { DMA8(0, 0); DMA8(1, KSLOT); DMA8(2, 2 * KSLOT); } else { DMA8(0, 0); DMA8(1, VSLOT); }
    const unsigned char* Qw = (tws_ + WS_QA) + ((size_t)head * MROWS + qrow) * 64 + hi * 32;
    i32x8 qf; { const u32x4 a_ = *(const u32x4*)Qw, b_ = *(const u32x4*)(Qw + 16); qf = (i32x8){(int)a_[0], (int)a_[1], (int)a_[2], (int)a_[3], (int)b_[0], (int)b_[1], (int)b_[2], (int)b_[3]}; }
    f32x16 o0 = f32x16{}, o1 = f32x16{}, osum = f32x16{};
    f32x16 negm;
#pragma unroll
    for (int r = 0; r < 16; ++r) negm[r] = negM2s;
    asm volatile("" : "+v"(negm));
    i32x8 ones; { const int o4 = 0x38383838; ones = (i32x8){o4, o4, o4, o4, o4, o4, o4, o4}; } asm volatile("" : "+v"(ones));
    const ALAS char* kp0 = shm3 + LDS_K + hi * 1024 + r32 * 16;
    const ALAS char* vp0 = shm3 + LDS_V + hi * 1024 + r32 * 16;
    f32x16 pA0, pA1, pB0, pB1;
    i32x8 kf0, kf1, vf0, vf1, pf = (i32x8){0, 0, 0, 0, 0, 0, 0, 0};
    int ks_prev = 0, ks_cur = 0, ks_next = KSLOT, vs_prev = 0, vs_cur = VSLOT, vs_next = 2 * VSLOT, vs_n2 = 3 * VSLOT;
#define ROTK8() do { ks_prev = ks_cur; ks_cur = ks_next; ks_next = (ks_next == 2 * KSLOT) ? 0 : ks_next + KSLOT; } while (0)
#define ROT8() do { ROTK8(); const int tv_ = vs_prev; vs_prev = vs_cur; vs_cur = vs_next; vs_next = vs_n2; vs_n2 = tv_; } while (0)
#define LD32(dst, p) do { const u32x4 a_ = *(const ALAS u32x4*)(p), b_ = *(const ALAS u32x4*)((p) + 512); dst = (i32x8){(int)a_[0], (int)a_[1], (int)a_[2], (int)a_[3], (int)b_[0], (int)b_[1], (int)b_[2], (int)b_[3]}; } while (0)
#define PK8(P, B, OLD) __builtin_amdgcn_cvt_pk_fp8_f32(P[(B) + 2], P[(B) + 3], __builtin_amdgcn_cvt_pk_fp8_f32(P[B], P[(B) + 1], OLD, false), true)
    WB8(2, 2);
    { LD32(kf0, kp0); LD32(kf1, kp0 + 2048);
      pA0 = MFMA8(kf0, qf, negm); pA1 = MFMA8(kf1, qf, negm);
#pragma unroll
      for (int r = 0; r < 16; ++r) { pA0[r] = EX(pA0[r]); pA1[r] = EX(pA1[r]); } }
    WB_SEL(0);
    if (kw) { DMA8(3, 0); } else { DMA8(2, 2 * VSLOT); }
    ROTK8();
    { const ALAS char* kb_ = kp0 + ks_cur; LD32(kf0, kb_); LD32(kf1, kb_ + 2048); }
    WB_SEL(1);
#define STEP8(C0, C1, P0, P1, i, GK, GV, GL) do { SBAR(); \
    const ALAS char* vp_ = vp0 + vs_prev; const ALAS char* kn_ = kp0 + ks_next; \
    LD32(vf0, vp_); LD32(vf1, vp_ + 2048); SBAR(); \
    C0 = MFMA8(kf0, qf, negm); \
    pf[0] = PK8(P0, 0, pf[0]); pf[1] = PK8(P0, 4, pf[1]); pf[2] = PK8(P0, 8, pf[2]); pf[3] = PK8(P0, 12, pf[3]); PIN(pf); SBAR(); \
    C1 = MFMA8(kf1, qf, negm); \
    pf[4] = PK8(P1, 0, pf[4]); pf[5] = PK8(P1, 4, pf[5]); pf[6] = PK8(P1, 8, pf[6]); pf[7] = PK8(P1, 12, pf[7]); PIN(pf); SBAR(); \
    if (kw) { if (GK) { DMA8((i) + 3, ks_cur); } } else { if (GV) { DMA8((i) + 2, vs_n2); } } \
    SBAR(); \
    o0 = MFMA8(pf, vf0, o0); \
    _Pragma("unroll") for (int r_ = 0; r_ < 16; ++r_) C0[r_] = EX(C0[r_]); PIN(C0); SBAR(); \
    if (GL) { LD32(kf0, kn_); LD32(kf1, kn_ + 2048); SBAR(); } \
    o1 = MFMA8(pf, vf1, o1); \
    _Pragma("unroll") for (int r_ = 0; r_ < 8; ++r_) C1[r_] = EX(C1[r_]); PIN(C1); SBAR(); \
    osum = MFMA8(pf, ones, osum); \
    _Pragma("unroll") for (int r_ = 8; r_ < 16; ++r_) C1[r_] = EX(C1[r_]); PIN(C1); SBAR(); \
    } while (0)
    int i = 1;
    for (; i + 5 < n; i += 2) {
        STEP8(pB0, pB1, pA0, pA1, i, true, true, true);     WB8(1, 2); ROT8();
        STEP8(pA0, pA1, pB0, pB1, i + 1, true, true, true); WB8(1, 2); ROT8();
    }
#define ENDW8(ii) do { if ((ii) + 3 < n) { WB8(1, 2); } else if ((ii) + 2 < n) { WB8(0, 2); } else { WB_SEL(0); } } while (0)
    for (; i + 1 < n; i += 2) {
        STEP8(pB0, pB1, pA0, pA1, i, (i + 3 < n), (i + 2 < n), (i + 1 < n));         ENDW8(i);     ROT8();
        STEP8(pA0, pA1, pB0, pB1, i + 1, (i + 4 < n), (i + 3 < n), (i + 2 < n));     ENDW8(i + 1); ROT8();
    }
    STEP8(pB0, pB1, pA0, pA1, n - 1, false, false, false);
    { pf[0] = PK8(pB0, 0, pf[0]); pf[1] = PK8(pB0, 4, pf[1]); pf[2] = PK8(pB0, 8, pf[2]); pf[3] = PK8(pB0, 12, pf[3]); pf[4] = PK8(pB1, 0, pf[4]); pf[5] = PK8(pB1, 4, pf[5]); pf[6] = PK8(pB1, 8, pf[6]); pf[7] = PK8(pB1, 12, pf[7]);
      const ALAS char* vp_ = vp0 + vs_cur; LD32(vf0, vp_); LD32(vf1, vp_ + 2048);
      o0 = MFMA8(pf, vf0, o0); o1 = MFMA8(pf, vf1, o1); osum = MFMA8(pf, ones, osum); }
    ATT_WAIT_BAR(0);
    {
        const int lane_e = lane_id_v(), l32 = lane_e & 31, hh = lane_e >> 5;
        ALAS bf16_t* stg = (ALAS bf16_t*)shm3 + wid * 2048;
#pragma unroll
        for (int r = 0; r < 16; ++r) { const int orow = crow(r, hh); const float rl = __builtin_amdgcn_rcpf(osum[r]);
            stg[orow * 64 + l32] = pg8::f2bf1(o0[r] * rl); stg[orow * 64 + 32 + l32] = pg8::f2bf1(o1[r] * rl); }
        asm volatile("s_waitcnt lgkmcnt(0)" ::: "memory");
#pragma unroll
        for (int i2 = 0; i2 < 4; ++i2) { const int row = i2 * 8 + (lane_e >> 3), ch = lane_e & 7; const u32x4 v = *(const ALAS u32x4*)(stg + row * 64 + ch * 8);
            *(u32x4*)(T_MIX + (size_t)(qb * 256 + wid * 32 + row) * 1024 + head * 64 + ch * 8) = v; }
    }
    asm volatile("s_waitcnt lgkmcnt(0)\n\ts_barrier" ::: "memory");
#undef DMA8
#undef EXPBLK
#undef PACK8
#undef WB8
#undef ROTK8
#undef ROT8
#undef LD32
#undef PK8
#undef STEP8
#undef ENDW8
}

typedef short v2i16_t __attribute__((ext_vector_type(2)));
template<int U, int PROBE = 0>
__device__ __forceinline__ void attn_unit_a8x2(const Tensors& T, int head, int qb, float negM2s, char* shm, int wave_id) {
    unsigned char* tws_ = T.ws; LAUNDER_G(tws_);
    constexpr int KSLOT = 4096, VSLOT = 4096, RS = 3 * U * 4096, LDS_K = 0, LDS_V = RS, n = 256;
    int tid_ = wave_id * 64 + lane_id_v(); asm volatile("" : "+v"(tid_));
    const int tid = tid_, lane = tid & 63, r32 = lane & 31, hi = lane >> 5; const int wid = __builtin_amdgcn_readfirstlane(tid >> 6);
    const int q0 = qb * 512; const int qrow = q0 + wid * 64 + r32;
    const unsigned lds0 = (unsigned)(uintptr_t)shm;
    const ALAS char* shm3 = (const ALAS char*)shm;
    const bool kw = wid < 4;
    const char* sb = (const char*)(tws_ + (kw ? WS_KA : WS_VA)) + (size_t)(head >> 2) * MROWS * 64 + (wid & 3) * 1024;
    const unsigned dvo = (unsigned)(lane * 16);
    const unsigned ddst = lds0 + (kw ? LDS_K : LDS_V) + (wid & 3) * 1024;
#define DMA8(i, so) glds16s(sb + (size_t)(i) * 4096, dvo, (unsigned)__builtin_amdgcn_readfirstlane(ddst + (so)))
#pragma unroll
    for (int i0 = 0; i0 < 2 * U; ++i0) DMA8(i0, i0 * 4096);
    if (kw) DMA8(2 * U, 2 * U * 4096);
    const unsigned char* Qw = (tws_ + WS_QA) + ((size_t)head * MROWS + qrow) * 64 + hi * 32;
    i32x8 qfa, qfb;
    { const u32x4 a_ = *(const u32x4*)Qw, b_ = *(const u32x4*)(Qw + 16); qfa = (i32x8){(int)a_[0], (int)a_[1], (int)a_[2], (int)a_[3], (int)b_[0], (int)b_[1], (int)b_[2], (int)b_[3]}; }
    { const u32x4 a_ = *(const u32x4*)(Qw + 32 * 64), b_ = *(const u32x4*)(Qw + 32 * 64 + 16); qfb = (i32x8){(int)a_[0], (int)a_[1], (int)a_[2], (int)a_[3], (int)b_[0], (int)b_[1], (int)b_[2], (int)b_[3]}; }
#if A8_SUM16
    f32x16 oa0 = f32x16{}, oa1 = f32x16{}, ob0 = f32x16{}, ob1 = f32x16{};
    f32x4 sa4 = f32x4{}, sb4 = f32x4{};
#if A8_SUM16 == 2
    f32x16 osa = f32x16{};
#endif
#else
    f32x16 oa0 = f32x16{}, oa1 = f32x16{}, osa = f32x16{}, ob0 = f32x16{}, ob1 = f32x16{}, osb = f32x16{};
#endif
#if A8_SUM16 == 2
    const f32x16 negm = f32x16{};
#else
    f32x16 negm;
#pragma unroll
    for (int r = 0; r < 16; ++r) negm[r] = negM2s;
    asm volatile("" : "+v"(negm));
#endif
#if A8_SUM16
    i32x8 ind; { const int o4 = (((lane >> 4) & 1) == ((lane & 15) >> 3)) ? 0x38383838 : 0; ind = (i32x8){o4, o4, o4, o4, o4, o4, o4, o4}; } asm volatile("" : "+v"(ind));
#if A8_SUM16 == 2
    i32x8 ones; { const int o4 = 0x38383838; ones = (i32x8){o4, o4, o4, o4, o4, o4, o4, o4}; } asm volatile("" : "+v"(ones));
#endif
#else
    i32x8 ones; { const int o4 = 0x38383838; ones = (i32x8){o4, o4, o4, o4, o4, o4, o4, o4}; } asm volatile("" : "+v"(ones));
#endif
    const ALAS char* kp0 = shm3 + LDS_K + hi * 1024 + r32 * 16;
    const ALAS char* vp0 = shm3 + LDS_V + hi * 1024 + r32 * 16;
    f32x16 Ca0, Ca1, Cb0, Cb1;
#ifdef A8_EXPH
#define EXPBLK(H, C, b) do { const unsigned h0_ = __builtin_bit_cast(unsigned, __builtin_amdgcn_cvt_pkrtz(C[b], C[(b) + 1])), h1_ = __builtin_bit_cast(unsigned, __builtin_amdgcn_cvt_pkrtz(C[(b) + 2], C[(b) + 3])), \
        h2_ = __builtin_bit_cast(unsigned, __builtin_amdgcn_cvt_pkrtz(C[(b) + 4], C[(b) + 5])), h3_ = __builtin_bit_cast(unsigned, __builtin_amdgcn_cvt_pkrtz(C[(b) + 6], C[(b) + 7])); unsigned d0_, d1_, d2_, d3_; \
        asm volatile("v_exp_f16_e32 %0, %4\n\tv_exp_f16_e32 %1, %5\n\tv_exp_f16_e32 %2, %6\n\tv_exp_f16_e32 %3, %7\n\t" \
                     "v_exp_f16_sdwa %0, %4 dst_sel:WORD_1 dst_unused:UNUSED_PRESERVE src0_sel:WORD_1\n\tv_exp_f16_sdwa %1, %5 dst_sel:WORD_1 dst_unused:UNUSED_PRESERVE src0_sel:WORD_1\n\t" \
                     "v_exp_f16_sdwa %2, %6 dst_sel:WORD_1 dst_unused:UNUSED_PRESERVE src0_sel:WORD_1\n\tv_exp_f16_sdwa %3, %7 dst_sel:WORD_1 dst_unused:UNUSED_PRESERVE src0_sel:WORD_1" \
                     : "=&v"(d0_), "=&v"(d1_), "=&v"(d2_), "=&v"(d3_) : "v"(h0_), "v"(h1_), "v"(h2_), "v"(h3_)); \
        C[(b) / 2] = __builtin_bit_cast(float, d0_); C[(b) / 2 + 1] = __builtin_bit_cast(float, d1_); C[(b) / 2 + 2] = __builtin_bit_cast(float, d2_); C[(b) / 2 + 3] = __builtin_bit_cast(float, d3_); PIN(C); } while (0)
#define PKH(C, j) (int)__builtin_amdgcn_perm(__builtin_bit_cast(unsigned, C[2 * (j) + 1]), __builtin_bit_cast(unsigned, C[2 * (j)]), 0x07050301u)
#define PACK8(H0, H1, C0, C1) do { pf[0] = PKH(C0, 0); pf[1] = PKH(C0, 1); pf[2] = PKH(C0, 2); pf[3] = PKH(C0, 3); pf[4] = PKH(C1, 0); pf[5] = PKH(C1, 1); pf[6] = PKH(C1, 2); pf[7] = PKH(C1, 3); PIN(pf); } while (0)
#else
#define EXPBLK(H, C, b) do { _Pragma("unroll") for (int r_ = (b); r_ < (b) + 8; ++r_) C[r_] = ((PROBE & 1) ? __builtin_fmaxf(C[r_], 1.0f) : EX(C[r_])); PIN(C); } while (0)
#define PACK8(H0, H1, C0, C1) do { pf[0] = PK8(C0, 0, pf[0]); pf[1] = PK8(C0, 4, pf[1]); pf[2] = PK8(C0, 8, pf[2]); pf[3] = PK8(C0, 12, pf[3]); pf[4] = PK8(C1, 0, pf[4]); pf[5] = PK8(C1, 4, pf[5]); pf[6] = PK8(C1, 8, pf[6]); pf[7] = PK8(C1, 12, pf[7]); PIN(pf); } while (0)
#endif
    i32x8 kf0, kf1, vf0, vf1, pf = (i32x8){0, 0, 0, 0, 0, 0, 0, 0};
#define LD32(dst, p) do { const u32x4 a_ = *(const ALAS u32x4*)(p), b_ = *(const ALAS u32x4*)((p) + 512); dst = (i32x8){(int)a_[0], (int)a_[1], (int)a_[2], (int)a_[3], (int)b_[0], (int)b_[1], (int)b_[2], (int)b_[3]}; } while (0)
#ifdef A8_BF8
#define PK8(P, B, OLD) (int)__builtin_amdgcn_perm(__builtin_bit_cast(unsigned, __builtin_amdgcn_cvt_pkrtz(P[(B) + 2], P[(B) + 3])), __builtin_bit_cast(unsigned, __builtin_amdgcn_cvt_pkrtz(P[B], P[(B) + 1])), 0x07050301u)
#define MFMA8P(a, b, c) __builtin_amdgcn_mfma_scale_f32_32x32x64_f8f6f4(a, b, c, 1, 0, 0, 0, 0, 0)
#define MFMA16P(a, b, c) __builtin_amdgcn_mfma_scale_f32_16x16x128_f8f6f4(a, b, c, 1, 0, 0, 0, 0, 0)
#elif defined(A8_SCALECVT)
#define MFMA8P(a, b, c) MFMA8(a, b, c)
#define MFMA16P(a, b, c) __builtin_amdgcn_mfma_scale_f32_16x16x128_f8f6f4(a, b, c, 0, 0, 0, 0, 0, 0)
#define PK8(P, B, OLD) __builtin_bit_cast(int, __builtin_amdgcn_cvt_scalef32_pk_fp8_f32(__builtin_amdgcn_cvt_scalef32_pk_fp8_f32(__builtin_bit_cast(v2i16_t, (int)(OLD)), P[B], P[(B) + 1], 1.0f, false), P[(B) + 2], P[(B) + 3], 1.0f, true))
#else
#define MFMA8P(a, b, c) MFMA8(a, b, c)
#define MFMA16P(a, b, c) __builtin_amdgcn_mfma_scale_f32_16x16x128_f8f6f4(a, b, c, 0, 0, 0, 0, 0, 0)
#define PK8(P, B, OLD) __builtin_amdgcn_cvt_pk_fp8_f32(P[(B) + 2], P[(B) + 3], __builtin_amdgcn_cvt_pk_fp8_f32(P[B], P[(B) + 1], OLD, false), true)
#endif
    if (kw) { WB_SEL(U); } else { WB_SEL(U); }
    { LD32(kf0, kp0); LD32(kf1, kp0 + 2048);
      Ca0 = MFMA8(kf0, qfa, negm); Ca1 = MFMA8(kf1, qfa, negm); Cb0 = MFMA8(kf0, qfb, negm); Cb1 = MFMA8(kf1, qfb, negm);
      EXPBLK(Ha0, Ca0, 0); EXPBLK(Ha0, Ca0, 8); EXPBLK(Ha1, Ca1, 0); EXPBLK(Ha1, Ca1, 8); }
    asm volatile("s_waitcnt lgkmcnt(0)\n\ts_barrier" ::: "memory");
    int ks = 0, vs = 0;
#define ADV(x, k) (((x) + (k) * 4096 >= RS) ? (x) + (k) * 4096 - RS : (x) + (k) * 4096)
    for (int t0 = 0; t0 < n; t0 += U) {
#pragma unroll
      for (int j = 0; j < U; ++j) {
        const int t = t0 + j;
        const bool GK = t + 1 + 2 * U < n, GV = t + 2 * U < n, GL = t + 1 < n;
        const int ksn = ADV(ks, 1);
        SBAR();
        if (!(PROBE & 4)) if (!A8_VPREF || j == 0) { const ALAS char* vp_ = vp0 + vs; LD32(vf0, vp_); LD32(vf1, vp_ + 2048); }
        if (!(PROBE & 4)) if (GL) { const ALAS char* kn_ = kp0 + ksn; LD32(kf0, kn_); LD32(kf1, kn_ + 2048); } SBAR();
        if (!(PROBE & 8)) { PACK8(Ha0, Ha1, Ca0, Ca1); } SBAR();
#ifdef A8_EXPH_DUP
        {
#pragma unroll
          for (int r = 0; r < 16; ++r) { float x_ = Ca0[r], y_ = Ca1[r]; asm volatile("v_exp_f16_e32 %0, %0\n\tv_exp_f16_e32 %1, %1" : "+v"(x_), "+v"(y_)); Ca0[r] = x_; Ca1[r] = y_; }
          SBAR(); }
#endif
#ifdef A8_CVT_DUP
        { int d0_ = 0, d1_ = 0, d2_ = 0, d3_ = 0;
#pragma unroll
          for (int r = 0; r < 16; r += 4) { d0_ = PK8(Ca0, r, d0_); d1_ = PK8(Ca1, r, d1_); d2_ = PK8(Ca0, r, d2_); d3_ = PK8(Ca1, r, d3_); asm volatile("" : "+v"(d0_), "+v"(d1_), "+v"(d2_), "+v"(d3_)); }
          SBAR(); }
#endif
        if (!(PROBE & 32)) oa0 = MFMA8P(pf, vf0, oa0);
        EXPBLK(Hb0, Cb0, 0); SBAR();
        if (!(PROBE & 32)) oa1 = MFMA8P(pf, vf1, oa1);
        EXPBLK(Hb0, Cb0, 8); SBAR();
#if A8_SUM16
        if (!(PROBE & 32)) sa4 = MFMA16P(pf, ind, sa4);
#if A8_SUM16 == 2
        osa = MFMA8P(pf, ones, osa);
#endif
#else
        osa = MFMA8P(pf, ones, osa);
#endif
        EXPBLK(Hb1, Cb1, 0); SBAR();
        if (GL && !(PROBE & 64)) { Ca0 = MFMA8(kf0, qfa, negm); }
        EXPBLK(Hb1, Cb1, 8); SBAR();
        if (GL && !(PROBE & 64)) { Ca1 = MFMA8(kf1, qfa, negm); }
        if (!(PROBE & 2)) { if (kw) { if (GK) { DMA8(t + 1 + 2 * U, ADV(ks, 2 * U + 1)); } } else { if (GV) { DMA8(t + 2 * U, ADV(vs, 2 * U)); } } }
        SBAR();
        if (!(PROBE & 8)) { PACK8(Hb0, Hb1, Cb0, Cb1); } SBAR();
        if (!(PROBE & 32)) ob0 = MFMA8P(pf, vf0, ob0);
        if (GL) {
            EXPBLK(Ha0, Ca0, 0); }
        SBAR();
        if (!(PROBE & 32)) ob1 = MFMA8P(pf, vf1, ob1);
        if (GL) {
            EXPBLK(Ha0, Ca0, 8); }
        SBAR();
        if (A8_VPREF && j < U - 1) { const ALAS char* vn_ = vp0 + ADV(vs, 1); LD32(vf0, vn_); LD32(vf1, vn_ + 2048); SBAR(); }
#if A8_SUM16
        if (!(PROBE & 32)) sb4 = MFMA16P(pf, ind, sb4);
#else
        osb = MFMA8P(pf, ones, osb);
#endif
        if (GL) {
            EXPBLK(Ha1, Ca1, 0); }
        SBAR();
        if (GL) { if (!(PROBE & 64)) Cb0 = MFMA8(kf0, qfb, negm);
            EXPBLK(Ha1, Ca1, 8); }
        SBAR();
        if (GL && !(PROBE & 64)) { Cb1 = MFMA8(kf1, qfb, negm); }
        if (j == U - 1 && !(PROBE & 16)) { if ((PROBE & 2) == 0 && (kw ? GK : GV)) { WB_SEL(U); } else { WB_SEL(0); }
#ifdef A8_LAG
            if (!kw) __builtin_amdgcn_s_sleep(A8_LAG);
#endif
        }
        ks = ksn; vs = ADV(vs, 1);
      }
    }
#undef ADV
    {
        const int lane_e = lane_id_v(), l32 = lane_e & 31, hh = lane_e >> 5;
        ALAS bf16_t* stg = (ALAS bf16_t*)shm3 + wid * 4096;
#if A8_SUM16
        ALAS float* ls = (ALAS float*)(shm3 + 65536) + wid * 64;
        if ((lane_e & 7) == 0) { const int q0_ = 16 * ((lane_e >> 3) & 1) + 4 * (lane_e >> 4);
#pragma unroll
            for (int r = 0; r < 4; ++r) { ls[q0_ + r] = sa4[r]; ls[32 + q0_ + r] = sb4[r]; } }
        asm volatile("s_waitcnt lgkmcnt(0)" ::: "memory");
#endif
#pragma unroll
        for (int r = 0; r < 16; ++r) { const int orow = crow(r, hh);
#if A8_SUM16
            float ra = __builtin_amdgcn_rcpf(ls[orow]); const float rb = __builtin_amdgcn_rcpf(ls[32 + orow]);
#if A8_SUM16 == 2
            { const float rref = __builtin_amdgcn_rcpf(osa[r]); if (!(__builtin_fabsf(ra - rref) <= 1e-3f * rref)) ra = __builtin_nanf(""); }
#endif
#else
            const float ra = __builtin_amdgcn_rcpf(osa[r]), rb = __builtin_amdgcn_rcpf(osb[r]);
#endif
            stg[orow * 64 + l32] = pg8::f2bf1(oa0[r] * ra); stg[orow * 64 + 32 + l32] = pg8::f2bf1(oa1[r] * ra);
            stg[2048 + orow * 64 + l32] = pg8::f2bf1(ob0[r] * rb); stg[2048 + orow * 64 + 32 + l32] = pg8::f2bf1(ob1[r] * rb); }
        asm volatile("s_waitcnt lgkmcnt(0)" ::: "memory");
#pragma unroll
        for (int i2 = 0; i2 < 8; ++i2) { const int row = i2 * 8 + (lane_e >> 3), ch = lane_e & 7; const u32x4 v = *(const ALAS u32x4*)(stg + row * 64 + ch * 8);
            *(u32x4*)(T_MIX + (size_t)(qb * 512 + wid * 64 + row) * 1024 + head * 64 + ch * 8) = v; }
    }
    asm volatile("s_waitcnt lgkmcnt(0)\n\ts_barrier" ::: "memory");
#undef DMA8
#undef LD32
#undef PK8
}
}
static_assert(att::LDS_NEED <= RING_BYTES, "LDS map");

#define GAS __attribute__((address_space(1)))
#define LAS __attribute__((address_space(3)))
typedef unsigned short bf16;
typedef unsigned v4u __attribute__((ext_vector_type(4)));
typedef float f32x4 __attribute__((ext_vector_type(4)));
typedef GAS unsigned gu32;
#define RLX_AGENT __ATOMIC_RELAXED, __HIP_MEMORY_SCOPE_AGENT
#define LDS_WAIT() asm volatile("s_waitcnt lgkmcnt(0)" ::: "memory")
#define VM_WAIT() asm volatile("s_waitcnt vmcnt(0)" ::: "memory")
__device__ __forceinline__ unsigned f2bf(float f) { unsigned u = __builtin_bit_cast(unsigned, f); return (u + 0x7fffu + ((u >> 16) & 1u)) >> 16; }
__device__ __forceinline__ unsigned pk2(float lo, float hi) { return f2bf(lo) | (f2bf(hi) << 16); }
#define XB_TMO      128
#define XB_XCNT(j)  (256  + 64 * (j))
#define XB_XSUB(j)  (1280 + 64 * (j))
#define XB_XGEN(j)  (2304 + 64 * (j))
#define XB_TOP      3328
#define XB_TOPGEN   3392
#define XCD_BAR_WORDS 3456
#define XB_SPIN_CAP (1u << 18)

__device__ __forceinline__ unsigned xb_ld(unsigned* p)              { return __hip_atomic_load(p, __ATOMIC_RELAXED, __HIP_MEMORY_SCOPE_AGENT); }
__device__ __forceinline__ unsigned xb_add(unsigned* p, unsigned v) { return __hip_atomic_fetch_add(p, v, __ATOMIC_RELAXED, __HIP_MEMORY_SCOPE_AGENT); }
__device__ __forceinline__ unsigned xb_xcc_id() { return (unsigned)__builtin_amdgcn_s_getreg((3 << 11) | 20) & 0xFu; }
#define XB_SPIN(cond, bar) do { unsigned _sp = 0; while (cond) { __builtin_amdgcn_s_sleep(1); \
    if ((++_sp & 255u) == 0u) { if (xb_ld(&(bar)[XB_TMO])) break; if (_sp > XB_SPIN_CAP) { atomicAdd(&(bar)[XB_TMO], 1u); break; } } } } while (0)

struct XcdBarrier {
    unsigned* bar; unsigned x;
    volatile LAS unsigned* st;
};

__device__ __forceinline__ XcdBarrier xcd_barrier_post(unsigned* bar, volatile LAS unsigned* st, bool t0) {
    XcdBarrier b; b.bar = bar; b.x = (unsigned)__builtin_amdgcn_readfirstlane((int)xb_xcc_id()); b.st = st;
    if (t0) (void)xb_add(&bar[XB_XCNT(b.x)], 1u);
    return b;
}
__device__ __forceinline__ void xcd_barrier_complete(unsigned* bar, unsigned x, unsigned& nloc, unsigned& nx) {
    const unsigned G = gridDim.x * gridDim.y * gridDim.z;
    unsigned sum, cnt, mine, sp = 0u;
    for (;;) {
        sum = 0u; cnt = 0u; mine = 0u;
#pragma unroll
        for (unsigned j = 0; j < 16; ++j) { const unsigned c = xb_ld(&bar[XB_XCNT(j)]); sum += c; cnt += (c > 0u) ? 1u : 0u; mine = (j == x) ? c : mine; }
        if (sum == G) break;
        __builtin_amdgcn_s_sleep(1);
        if ((++sp & 255u) == 0u) { if (xb_ld(&bar[XB_TMO])) break; if (sp > XB_SPIN_CAP) { atomicAdd(&bar[XB_TMO], 1u); break; } }
    }
    nloc = mine > 0u ? mine : 1u; nx = cnt > 0u ? cnt : 1u;
}

__device__ __forceinline__ void xcd_barrier(const XcdBarrier& b_, int wave_id) {
    XcdBarrier b = b_; asm volatile("" : "+s"(b.bar), "+s"(b.x));
    const bool t0 = (wave_id == 0) && (lane_id_v() == 0);
    asm volatile("s_waitcnt vmcnt(0)" ::: "memory");
    __syncthreads();
    if (t0) {
        unsigned* bar = b.bar;
        __builtin_amdgcn_s_waitcnt(0);
        unsigned nloc = b.st[0], nx = b.st[1];
        if (nloc == 0u) { xcd_barrier_complete(bar, b.x, nloc, nx); b.st[0] = nloc; b.st[1] = nx; }
        const unsigned old = xb_add(&bar[XB_XSUB(b.x)], 1u);
        const unsigned gen = old / nloc;
        if (old + 1u == (gen + 1u) * nloc) {
            __builtin_amdgcn_fence(__ATOMIC_RELEASE, "agent");
            asm volatile("s_waitcnt vmcnt(0)" ::: "memory");
            const unsigned og = xb_add(&bar[XB_TOP], 1u);
            const unsigned tg = og / nx;
            if (og + 1u == (tg + 1u) * nx) xb_add(&bar[XB_TOPGEN], 1u);
            else XB_SPIN(xb_ld(&bar[XB_TOPGEN]) == tg, bar);
            __builtin_amdgcn_fence(__ATOMIC_ACQUIRE, "agent");
            xb_add(&bar[XB_XGEN(b.x)], 1u);
            asm volatile("s_waitcnt vmcnt(0)" ::: "memory");
        } else {
            XB_SPIN(xb_ld(&bar[XB_XGEN(b.x)]) == gen, bar);
            __builtin_amdgcn_fence(__ATOMIC_ACQUIRE, "agent");
            asm volatile("s_waitcnt vmcnt(0)" ::: "memory");
        }
    }
    __syncthreads();
}
#ifndef PHMASK
#define PHMASK 63
#endif
#ifndef ATT_DUP
#define ATT_DUP 1
#endif
#ifndef GU_DUP
#define GU_DUP 1
#endif
#ifndef IN_DUP
#define IN_DUP 1
#endif
#ifndef D1_DUP
#define D1_DUP 1
#endif
#ifndef P0_DUP
#define P0_DUP 1
#endif
#ifndef NODEFER
#define DEFER_OK (G == 256)
#else
#define DEFER_OK false
#endif

__device__ __forceinline__ float wave_sum(float v) { v += xor_lane<1>(v); v += xor_lane<2>(v); v += xor_lane<4>(v); v += xor_lane<8>(v); v += xor_lane<16>(v); return sum_x32(v); }
__device__ __forceinline__ float wave_max(float v) { v = fmaxf(v, xor_lane<1>(v)); v = fmaxf(v, xor_lane<2>(v)); v = fmaxf(v, xor_lane<4>(v)); v = fmaxf(v, xor_lane<8>(v)); v = fmaxf(v, xor_lane<16>(v)); return max_x32(v); }
__device__ __forceinline__ void tr_item(const float* W, int ldw, int srccol0, const float* gain, bf16* WT, int K, int dstrow0, int k0, LAS float* scr, int lane) {
    const int kq = lane >> 3, nq = lane & 7;
    f32x4 w[8]; float g[8];
#pragma unroll
    for (int i = 0; i < 8; ++i) { const int kk = 8 * i + kq; w[i] = *(const GAS f32x4*)(W + (size_t)(k0 + kk) * ldw + srccol0 + 4 * nq); g[i] = gain ? gain[k0 + kk] : 1.0f; }
#pragma unroll
    for (int i = 0; i < 8; ++i) { const int kk = 8 * i + kq; LAS float* s = scr + kk * 33 + 4 * nq; s[0] = w[i][0] * g[i]; s[1] = w[i][1] * g[i]; s[2] = w[i][2] * g[i]; s[3] = w[i][3] * g[i]; }
    LDS_WAIT(); asm volatile("" ::: "memory");
    const int c = lane & 7;
#pragma unroll
    for (int j = 0; j < 4; ++j) { const int n = (lane >> 3) + 8 * j; const LAS float* s = scr + (8 * c) * 33 + n;
        v4u o; o.x = pk2(s[0 * 33], s[1 * 33]); o.y = pk2(s[2 * 33], s[3 * 33]); o.z = pk2(s[4 * 33], s[5 * 33]); o.w = pk2(s[6 * 33], s[7 * 33]);
        *(GAS v4u*)(WT + (size_t)(dstrow0 + n) * K + k0 + 8 * c) = o; }
    LDS_WAIT(); asm volatile("" ::: "memory");
}

#define TR_ONE(it_) do { int r = (it_); \
        if (r < 2 * I_GU) { const int l2 = r >= I_GU; if (l2) r -= I_GU; const int kb = r / (NGU / 32), nb = r % (NGU / 32), n0 = nb * 32, pn = n0 >> 8, j0 = n0 & 255; \
            const float* src = (j0 < 128) ? (l2 ? args.in[18] : args.in[2]) : (l2 ? args.in[19] : args.in[3]); \
            tr_item(src, FF, pn * 128 + (j0 & 127), l2 ? args.in[17] : args.in[1], (bf16*)(ws + (l2 ? WS_WGU2 : WS_WGU1)), D, n0, kb * 64, scr, lane); break; } \
        r -= 2 * I_GU; \
        if (r < 2 * I_D) { const int l2 = r >= I_D; if (l2) r -= I_D; const int kb = r / (D / 32), nb = r % (D / 32); \
            tr_item(l2 ? args.in[20] : args.in[4], D, nb * 32, nullptr, (bf16*)(ws + (l2 ? WS_WD2 : WS_WD1)), FF, nb * 32, kb * 64, scr, lane); break; } \
        r -= 2 * I_D; \
        if (r < I_IN) { const int kb = r / (NIN / 32), nb = r % (NIN / 32), n0 = nb * 32, pn = n0 >> 8, j0 = n0 & 255, bj = j0 >> 7, wc = (j0 >> 5) & 3; \
            tr_item(args.in[6], NIN, pn * 256 + wc * 64 + bj * 32, args.in[5], (bf16*)(ws + WS_WIN), D, n0, kb * 64, scr, lane); break; } \
        r -= I_IN; \
        { const int kb = r / (D / 32), nb = r % (D / 32); tr_item(args.in[16], D, nb * 32, nullptr, (bf16*)(ws + WS_WOUT), D, nb * 32, kb * 64, scr, lane); } } while (0)
constexpr int I_GU = (D / 64) * (NGU / 32), I_D = (FF / 64) * (D / 32), I_IN = (D / 64) * (NIN / 32), I_OUT = (D / 64) * (D / 32);
#define TR_DEFERRED(first_idle, IT0, IT1) do { if (bx >= (first_idle)) { const int lane = lane_id_v(); LAS float* scr = (LAS float*)(L + RING_OFF + wave * 16384); \
        const int nw_ = (G - (first_idle)) * NWAVES; for (int it = (IT0) + (bx - (first_idle)) * NWAVES + wave; it < (IT1); it += nw_) { TR_ONE(it); } } } while (0)
struct Args { const float* in[21]; float* out; unsigned char* ws; };
#define LAUNDER(p) asm volatile("" : "+s"(p))

__global__ void __launch_bounds__(NWAVES * 64, 2) mk_fwd(Args args) {
    extern __shared__ __attribute__((aligned(16))) unsigned char lds[];
    LAS unsigned char* L = (LAS unsigned char*)lds;
    volatile LAS unsigned* MISC = (volatile LAS unsigned*)(L + MISC_OFF);
    const int wave = __builtin_amdgcn_readfirstlane((int)threadIdx.x >> 6);
    const int G = gridDim.x; const int bx = blockIdx.x;
    unsigned char* ws = args.ws; float* out = args.out; LAUNDER_G(ws); LAUNDER_G(out);
    { const int tid = wave * 64 + lane_id_v(); for (int u = tid; u < (LDS_BYTES - LDSCTL_OFF) / 4; u += NWAVES * 64) ((LAS unsigned*)(L + LDSCTL_OFF))[u] = 0u; }
    __syncthreads();
    XcdBarrier bar = xcd_barrier_post((unsigned*)((gu32*)(ws + WS_CTL) + CW_BAR), MISC + 8, (wave == 0) && (lane_id_v() == 0));
    LAS float* rstd_tab = (LAS float*)(L + RSTD_OFF);
    LAS float* PRM = (LAS float*)(L + PRM_OFF);
    float pr0_ = 0.f, pr1_ = 0.f, pr2_ = 0.f, pr3_ = 0.f;
    { const int lane = lane_id_v();
      if (wave == 0) { pr0_ = ((const GAS float*)args.in[7])[lane]; pr1_ = ((const GAS float*)args.in[8])[lane]; }
      else if (wave == 1) { pr0_ = ((const GAS float*)args.in[9])[lane]; pr1_ = ((const GAS float*)args.in[10])[lane]; }
      else if (wave == 2) { pr0_ = ((const GAS float*)args.in[15])[lane]; pr1_ = ((const GAS float*)args.in[15])[64 + lane]; }
      else if (wave < 7) { const int h = wave - 3; pr0_ = ((const GAS float*)args.in[11])[h * 64 + lane]; pr1_ = ((const GAS float*)args.in[12])[h * 64 + lane]; pr2_ = ((const GAS float*)args.in[13])[h * 64 + lane]; pr3_ = ((const GAS float*)args.in[14])[h * 64 + lane]; } }
#define PRM_FINISH() do { const int lane = lane_id_v(); \
      if (wave == 0) { PRM[PRM_GAQ + lane] = pr0_; PRM[PRM_GAK + lane] = pr1_; const float ma_ = wave_max(fabsf(pr0_)), mk_ = wave_max(fabsf(pr1_)); if (lane == 0) PRM[PRM_NEGM2A] = -(8.0f * 1.4426950408889634f * 1.02f) * ma_ * mk_; } \
      else if (wave == 1) { PRM[PRM_GBQ + lane] = pr0_; PRM[PRM_GBK + lane] = pr1_; const float ma_ = wave_max(fabsf(pr0_)), mk_ = wave_max(fabsf(pr1_)); if (lane == 0) PRM[PRM_NEGM2B] = -(8.0f * 1.4426950408889634f * 1.02f) * ma_ * mk_; } \
      else if (wave == 2) { PRM[PRM_SUBLN + lane] = pr0_; PRM[PRM_SUBLN + 64 + lane] = pr1_; } \
      else if (wave < 7) { const float d1_ = wave_sum(pr0_ * pr1_), d2_ = wave_sum(pr2_ * pr3_); if (lane == 0) PRM[PRM_LAM + (wave - 3)] = expf(d1_) - expf(d2_) + 0.2f; } \
      LDS_WAIT(); } while (0)

#define BUILD_RSTD(S) do { pg8::Unit u_; const int tid = wave * 64 + lane_id_v(); const float* SSQ_ = (const float*)(ws + WS_SSQ); for (int i_ = 0; i_ < 6 && (S).next(i_, u_); ++i_) if (tid < 256) { const f32x4* p_ = (const f32x4*)(SSQ_ + (size_t)(u_.pm * 256 + tid) * 16); \
        const f32x4 a_ = p_[0], b_ = p_[1], c_ = p_[2], d_ = p_[3]; const float s_ = ((a_[0] + a_[1]) + (a_[2] + a_[3])) + ((b_[0] + b_[1]) + (b_[2] + b_[3])) + ((c_[0] + c_[1]) + (c_[2] + c_[3])) + ((d_[0] + d_[1]) + (d_[2] + d_[3])); \
        rstd_tab[i_ * 256 + tid] = 1.0f / sqrtf(s_ * (1.0f / 1024.0f) + 1e-6f); } LDS_WAIT(); __syncthreads(); } while (0)

#if (PHMASK & 1)
    for (int dup0 = 0; dup0 < P0_DUP; ++dup0) {
        if (dup0) xcd_barrier(bar, wave);
        const int lane = lane_id_v(), tid = wave * 64 + lane;
        const int vcu = (G % 8 == 0) ? (bx % 8) * (G / 8) + bx / 8 : bx;
        float* ROPE = (float*)(ws + WS_ROPE); float* SSQ = (float*)(ws + WS_SSQ); bf16* XB = (bf16*)(ws + WS_XB); const float* x = args.in[0];
        LAS float* scr = (LAS float*)(L + RING_OFF + wave * 16384);
        const int gw = vcu * NWAVES + wave, NGW = G * NWAVES;
        for (int it = gw; it < ((DEFER_OK) ? I_GU : 2 * I_GU + 2 * I_D + I_IN + I_OUT); it += NGW) { TR_ONE(it); }
        for (int m = gw; m < M; m += NGW) {
            const GAS f32x4* xr = (const GAS f32x4*)(x + (size_t)m * D) + lane; f32x4 v[4]; float s = 0.f;
#pragma unroll
            for (int j = 0; j < 4; ++j) { v[j] = xr[64 * j]; s += (v[j][0] * v[j][0] + v[j][1] * v[j][1]) + (v[j][2] * v[j][2] + v[j][3] * v[j][3]); }
            s = wave_sum(s);
            GAS unsigned long long* o8 = (GAS unsigned long long*)(XB + (size_t)m * D) + lane;
#pragma unroll
            for (int j = 0; j < 4; ++j) o8[64 * j] = (unsigned long long)pk2(v[j][0], v[j][1]) | ((unsigned long long)pk2(v[j][2], v[j][3]) << 32);
            if (lane < 16) SSQ[(size_t)m * 16 + lane] = (lane == 0) ? s : 0.f;
        }
        for (int e = bx * (NWAVES * 64) + tid; e < 5120; e += G * NWAVES * 64) {
            const int isc = e >= 4096, ee = isc ? e - 4096 : e, pos = ee >> 4, i = ee & 15;
            const float invf = powf(10000.0f, -(float)i * (1.0f / 16.0f)); const float ang = (float)pos * invf; float sn, cs; sincosf(ang, &sn, &cs);
            if (isc) { ROPE[8192 + ee] = cs; ROPE[9216 + ee] = sn; } else { ROPE[ee] = cs; ROPE[4096 + ee] = sn; }
        }
    }
#endif
    PRM_FINISH();
    xcd_barrier(bar, wave);

    for (int rep = 0; rep < 2; ++rep) {
#if (PHMASK & 2)
        {
            LAUNDER_G(ws);
            pg8::Gemm g{(const bf16*)(ws + WS_XB), (const bf16*)(ws + (rep ? WS_WGU2 : WS_WGU1)), M, NGU, D}; pg8::StaticOrderT<M, NGU> S; int bxs_ = bx, Gs_ = G; LAUNDER(bxs_); LAUNDER(Gs_); S.init(Gs_, bxs_);
#if defined(SPLITK_GU2)
            { pg8::SplitTailOrderT<pg8::StaticOrderT<M, NGU>, 5, D / 64> SKr{S, (rep == 1) && (G == 256)}; BUILD_RSTD(SKr); }
#else
            BUILD_RSTD(S);
#endif
            pg8::EpiSwiGLU E{ws, rstd_tab};
            for (int dup = 0; dup < GU_DUP; ++dup) { if (dup) xcd_barrier(bar, wave);
#if defined(CLK_PROBE_GU)
            unsigned long long c0_ = __builtin_amdgcn_s_memtime(), r0_ = __builtin_amdgcn_s_memrealtime();
#endif
#if defined(SPLITK_GU2)
            {
                typedef pg8::SplitTailOrderT<pg8::StaticOrderT<M, NGU>, 5, D / 64> SKO; SKO SK{S, (rep == 1) && (G == 256)};
                pg8::EpiSwiGLUSplit E2{ws, rstd_tab};
                pg8::gemm_phase<D, pg8::EpiSwiGLUSplit, SKO, true, true, D, true>(L + RING_OFF, g, SK, E2, wave);
            }
#else
            pg8::gemm_phase<D, pg8::EpiSwiGLU, pg8::StaticOrderT<M, NGU>, true, true>(L + RING_OFF, g, S, E, wave);
#endif
            if (rep == 0 && dup == 0 && DEFER_OK) { TR_DEFERRED(128, 2 * I_GU, 2 * I_GU + I_D); TR_DEFERRED(128, 2 * I_GU + 2 * I_D, 2 * I_GU + 2 * I_D + I_IN); }
#if defined(CLK_PROBE_GU)
            if (rep == 0 && bx == 0) { const unsigned long long c1_ = __builtin_amdgcn_s_memtime(), r1_ = __builtin_amdgcn_s_memrealtime(); const unsigned long long spin_ = 1000ull * (c1_ - c0_) / (r1_ - r0_); while (__builtin_amdgcn_s_memrealtime() - r1_ < spin_) __builtin_amdgcn_s_sleep(8); }
#endif
            }
        }
#endif
        xcd_barrier(bar, wave);
#if (PHMASK & 4)
        {
            LAUNDER_G(ws); LAUNDER_G(out);
            pg8::Gemm g{(const bf16*)(ws + WS_H), (const bf16*)(ws + (rep ? WS_WD2 : WS_WD1)), M, D, FF}; pg8::StaticOrderT<M, D> S; int bxs_ = bx, Gs_ = G; LAUNDER(bxs_); LAUNDER(Gs_); S.init(Gs_, bxs_);
            if (rep == 0) { pg8::EpiResid<true, true, false> E{nullptr, nullptr, ws, 0.5f}; for (int dup = 0; dup < D1_DUP; ++dup) { if (dup) xcd_barrier(bar, wave);
#if defined(D1_NULLEPI)
                if (dup) { pg8::EpiNull EN; pg8::gemm_phase<FF, pg8::EpiNull, pg8::StaticOrderT<M, D>, true, true>(L + RING_OFF, g, S, EN, wave); continue; }
#endif
#if defined(D1_SCRATCH)
                if (dup) { pg8::EpiResidStaged<true, false> ES{nullptr, ws, 0.5f, ws + (140u << 20)}; pg8::gemm_phase<FF, pg8::EpiResidStaged<true, false>, pg8::StaticOrderT<M, D>, false, true>(L + RING_OFF, g, S, ES, wave); continue; }
#endif
                pg8::gemm_phase<FF, pg8::EpiResid<true, true, false>, pg8::StaticOrderT<M, D>, true, true>(L + RING_OFF, g, S, E, wave); } }
            else {
#if defined(D7_DUP) && defined(D7_PROBE1)
                for (int dup = 0; dup < D7_DUP; ++dup) { if (dup) xcd_barrier(bar, wave);
                    if (dup < D7_DUP - 1) { pg8::EpiResid<true, false, true, 1> EP{nullptr, out, ws, 0.5f}; pg8::gemm_phase<FF, pg8::EpiResid<true, false, true, 1>, pg8::StaticOrderT<M, D>, true, true>(L + RING_OFF, g, S, EP, wave); }
                    else { pg8::EpiResid<true, false, true> E{nullptr, out, ws, 0.5f}; pg8::gemm_phase<FF, pg8::EpiResid<true, false, true>, pg8::StaticOrderT<M, D>, true, true>(L + RING_OFF, g, S, E, wave); } }
#elif defined(D7_DUP)
                pg8::EpiResid<true, false, true> E{nullptr, out, ws, 0.5f};
#pragma unroll 1
                for (int dup = 0; dup < D7_DUP; ++dup) { if (dup) xcd_barrier(bar, wave); pg8::gemm_phase<FF, pg8::EpiResid<true, false, true>, pg8::StaticOrderT<M, D>, true, true>(L + RING_OFF, g, S, E, wave); }
#else
                pg8::EpiResid<true, false, true> E{nullptr, out, ws, 0.5f}; pg8::gemm_phase<FF, pg8::EpiResid<true, false, true>, pg8::StaticOrderT<M, D>, true, true>(L + RING_OFF, g, S, E, wave);
#endif
            }
        }
#endif
        if (rep == 1) break;
        xcd_barrier(bar, wave);
#if (PHMASK & 8)
        {
            LAUNDER_G(ws);
            pg8::Gemm g{(const bf16*)(ws + WS_XB), (const bf16*)(ws + WS_WIN), M, NIN, D}; pg8::StaticOrderT<M, NIN> S; int bxs_ = bx, Gs_ = G; LAUNDER(bxs_); LAUNDER(Gs_); S.init(Gs_, bxs_);
            BUILD_RSTD(S);
            pg8::EpiInProj E{rstd_tab, PRM, ws};
            for (int dup = 0; dup < IN_DUP; ++dup) { if (dup) xcd_barrier(bar, wave);
            pg8::gemm_phase<D, pg8::EpiInProj, pg8::StaticOrderT<M, NIN>, true, true>(L + RING_OFF, g, S, E, wave);
            if (dup == 0 && DEFER_OK) { TR_DEFERRED(64, I_GU, 2 * I_GU); TR_DEFERRED(64, 2 * I_GU + I_D, 2 * I_GU + 2 * I_D); TR_DEFERRED(64, 2 * I_GU + 2 * I_D + I_IN, 2 * I_GU + 2 * I_D + I_IN + I_OUT); } }
        }
#endif
        xcd_barrier(bar, wave);
#if (PHMASK & 16)
        for (int dup = 0; dup < ATT_DUP; ++dup) {
            LAUNDER_G(ws);
            if (dup) xcd_barrier(bar, wave);
            gu32* qhead = (gu32*)(ws + WS_CTL) + CW_QUEUE + 64 * dup;
#if defined(CLK_PROBE)
            unsigned long long c0_ = __builtin_amdgcn_s_memtime(), r0_ = __builtin_amdgcn_s_memrealtime();
#endif
            const att::Tensors T = att::make_tensors(ws, PRM);
            const bool st = (G == 256);
            const int xg = bx & 7, cg = bx >> 3;
            for (int step = 0;; ++step) {
                int kind, h, qb;
                if (st && step < 2) {
                    if (step < 1) { kind = 0; h = xg; qb = cg; }
                    else { kind = 1; h = (xg < 4) ? 3 : 2; qb = 32 * (xg & 3) + cg; }
                } else {
                    if ((wave == 0) && (lane_id_v() == 0)) MISC[12] = __hip_atomic_fetch_add(qhead, 1u, RLX_AGENT);
                    LDS_WAIT(); __syncthreads();
                    int idx = __builtin_amdgcn_readfirstlane((int)MISC[12]);
                    if (st) idx += 512;
                    if (idx >= 768) break;
                    if (idx < 256 || idx >= 512) { kind = 1;
                        if (idx < 128) { h = 3; qb = idx; } else if (idx < 256) { const int i = idx - 128; h = 2; qb = (i & 1) ? 63 - (i >> 1) : 64 + (i >> 1); }
                        else if (idx < 640) { h = 1; qb = idx - 512; } else { h = 0; qb = idx - 640; }
                    } else { kind = 0; const int i = idx - 256; h = i >> 5; qb = i & 31; }
                }
#if defined(DUP_ONLY_A)
                if (dup && kind) continue;
#elif defined(DUP_ONLY_B)
                if (dup && !kind) continue;
#endif
                if (kind) {
                    const float slope = (h == 0) ? 0.25f : (h == 1) ? 0.0625f : (h == 2) ? 0.015625f : 0.00390625f;
                    const float c2 = slope * 1.4426950408889634f; const int dskip = (int)(150.0f / c2) + 1;
                    att::attn_unit<true>(T, h, qb, PRM[PRM_NEGM2B], PRM[PRM_LAM + h], c2, dskip, (char*)lds + RING_OFF, wave);
                } else {
#if defined(A8_NOEXP_DUP)
                    if (dup < ATT_DUP - 1) att::attn_unit_a8x2<A8U, A8_NOEXP_DUP>(T, h, qb, PRM[PRM_NEGM2A] + 8.0f, (char*)lds + RING_OFF, wave); else
#endif
                    att::attn_unit_a8x2<A8U>(T, h, qb, PRM[PRM_NEGM2A] + 8.0f, (char*)lds + RING_OFF, wave); }
            }
#if defined(CLK_PROBE)
            if (dup == ATT_DUP - 1 && bx == 0) { const unsigned long long c1_ = __builtin_amdgcn_s_memtime(), r1_ = __builtin_amdgcn_s_memrealtime(); const unsigned long long spin_ = 1000ull * (c1_ - c0_) / (r1_ - r0_); while (__builtin_amdgcn_s_memrealtime() - r1_ < spin_) __builtin_amdgcn_s_sleep(8); }
#endif
        }
#endif
        xcd_barrier(bar, wave);
#if (PHMASK & 32)
        {
            LAUNDER_G(ws); LAUNDER_G(out);
            pg8::Gemm g{(const bf16*)(ws + WS_MIX), (const bf16*)(ws + WS_WOUT), M, D, D}; pg8::StaticOrderT<M, D> S; int bxs_ = bx, Gs_ = G; LAUNDER(bxs_); LAUNDER(Gs_); S.init(Gs_, bxs_);
            pg8::EpiResid<true, true, false> E{nullptr, nullptr, ws, 1.0f}; pg8::gemm_phase<D, pg8::EpiResid<true, true, false>, pg8::StaticOrderT<M, D>, true, true>(L + RING_OFF, g, S, E, wave);
        }
#endif
        xcd_barrier(bar, wave);
    }
}

extern "C" void kernel_launch(void* const* d_in, const int* in_sizes, int n_in, void* d_out, int out_size, void* d_ws, size_t ws_size, hipStream_t stream) {
    static int grid = 0;
    if (grid == 0) {
        if (n_in != 21 || in_sizes[0] != M * D || out_size != M * D || ws_size < WS_END) { fprintf(stderr, "kernel_launch: unexpected shapes (n_in %d, in0 %d, out %d, ws %zu)\n", n_in, n_in > 0 ? in_sizes[0] : -1, out_size, ws_size); grid = -1; return; }
        int dev = 0, cus = 0, per_cu = 0;
        if (hipGetDevice(&dev) != hipSuccess || hipDeviceGetAttribute(&cus, hipDeviceAttributeMultiprocessorCount, dev) != hipSuccess) { grid = -1; return; }
        if (hipFuncSetAttribute((const void*)mk_fwd, hipFuncAttributeMaxDynamicSharedMemorySize, LDS_BYTES) != hipSuccess) { fprintf(stderr, "kernel_launch: hipFuncSetAttribute failed\n"); grid = -1; return; }
        if (hipOccupancyMaxActiveBlocksPerMultiprocessor(&per_cu, (const void*)mk_fwd, NWAVES * 64, LDS_BYTES) != hipSuccess || per_cu < 1) { fprintf(stderr, "kernel_launch: occupancy query says %d blocks per CU\n", per_cu); (void)hipGetLastError(); grid = -1; return; }
        grid = cus;
    }
    if (grid < 0) return;
    if (hipMemsetAsync((char*)d_ws + WS_CTL, 0, CTL_ZERO_BYTES, stream) != hipSuccess) { fprintf(stderr, "kernel_launch: memset failed\n"); return; }
    Args a{};
    for (int i = 0; i < 21; ++i) a.in[i] = (const float*)d_in[i];
    a.out = (float*)d_out; a.ws = (unsigned char*)d_ws;
    hipLaunchKernelGGL(mk_fwd, dim3(grid), dim3(NWAVES * 64), LDS_BYTES, stream, a);
    const hipError_t le = hipPeekAtLastError();
    if (le != hipSuccess) fprintf(stderr, "kernel_launch: launch failed: %s\n", hipGetErrorName(le));
}
```

```cpp
#include <hip/hip_runtime.h>
#include <cstdio>
#include <cstdint>
#define GLDS_M0_CLOBBER 1
#define A8_PIPE2 1
#define A8_SUM16 1
#ifndef A8_PIPE2
#define A8_PIPE2 0
#endif
#ifndef A8_DMASTAG
#define A8_DMASTAG 0
#endif
#ifndef A8_SUM16
#define A8_SUM16 0
#endif
#ifndef B_ORDER
#define B_ORDER 0
#endif
#ifndef A8_VPREF
#define A8_VPREF 0
#endif
#ifndef BDMA_MODE
#define BDMA_MODE 0
#endif
#ifndef A8U
#define A8U 4
#endif
#ifndef A8_NOBF8
#define A8_BF8 1
#endif

constexpr int NWAVES = 8;
constexpr int M = 16384, D = 1024, FF = 2816, NGU = 2 * FF, NIN = 2304;
constexpr size_t MiB = 1u << 20;
constexpr size_t WS_CTL = 0, CTL_ZERO_BYTES = 64 * 1024;
constexpr size_t WS_WGU1 = 2 * MiB, WS_WD1 = 13 * MiB, WS_WIN = 19 * MiB, WS_WOUT = 24 * MiB, WS_WGU2 = 26 * MiB, WS_WD2 = 37 * MiB;
constexpr size_t WS_ROPE = 43 * MiB, WS_SSQ = 44 * MiB;
constexpr size_t WS_XB = 48 * MiB;
constexpr size_t WS_H = 80 * MiB;
constexpr size_t WS_QA = 80 * MiB, WS_KA = 96 * MiB, WS_VA = 100 * MiB, WS_QB = 104 * MiB, WS_KB = 120 * MiB, WS_VB = 136 * MiB, WS_MIX = 152 * MiB;
constexpr size_t WS_END = 184 * MiB;
static_assert(WS_WGU1 + (size_t)NGU * D * 2 <= WS_WD1 && WS_WD1 + (size_t)D * FF * 2 <= WS_WIN && WS_WIN + (size_t)NIN * D * 2 <= WS_WOUT && WS_WOUT + (size_t)D * D * 2 <= WS_WGU2 &&
              WS_WGU2 + (size_t)NGU * D * 2 <= WS_WD2 && WS_WD2 + (size_t)D * FF * 2 <= WS_ROPE && WS_H + (size_t)M * FF * 2 <= WS_END && WS_MIX + (size_t)M * D * 2 <= WS_END, "d_ws map");
constexpr int CW_BAR = 1024;
constexpr int CW_XFLAG = 9216;
constexpr size_t WS_XCH = 184 * MiB;
constexpr int CW_QUEUE = 8192;
constexpr int RING_OFF = 0, RING_BYTES = 131072;
constexpr int LDSCTL_OFF = RING_BYTES, MISC_OFF = LDSCTL_OFF + 320, RSTD_OFF = LDSCTL_OFF + 1024, PRM_OFF = LDSCTL_OFF + 8192;
constexpr int LDS_BYTES = 147456;
constexpr int PRM_GAQ = 0, PRM_GAK = 64, PRM_GBQ = 128, PRM_GBK = 192, PRM_SUBLN = 256, PRM_NEGM2A = 384, PRM_NEGM2B = 385, PRM_LAM = 388, PRM_WORDS = 392;
static_assert(RSTD_OFF + 6 * 256 * 4 <= PRM_OFF && PRM_OFF + PRM_WORDS * 4 <= LDS_BYTES, "LDS map");

__device__ __forceinline__ int lane_id_v() { int l; asm volatile("v_mbcnt_lo_u32_b32 %0, -1, 0\n\tv_mbcnt_hi_u32_b32 %0, -1, %0" : "=v"(l)); return l; }

template <int MASK> __device__ __forceinline__ float xor_lane(float v) {
    if constexpr (MASK == 32) { const auto rr = __builtin_amdgcn_permlane32_swap(__float_as_uint(v), __float_as_uint(v), false, false); return __uint_as_float(lane_id_v() < 32 ? rr[1] : rr[0]); }
    else return __uint_as_float((unsigned)__builtin_amdgcn_ds_swizzle((int)__float_as_uint(v), (MASK << 10) | 0x1f));
}
__device__ __forceinline__ float sum_x32(float v) { const auto rr = __builtin_amdgcn_permlane32_swap(__float_as_uint(v), __float_as_uint(v), false, false); return __uint_as_float(rr[0]) + __uint_as_float(rr[1]); }
__device__ __forceinline__ float max_x32(float v) { const auto rr = __builtin_amdgcn_permlane32_swap(__float_as_uint(v), __float_as_uint(v), false, false); return fmaxf(__uint_as_float(rr[0]), __uint_as_float(rr[1])); }

#define LAUNDER_G(p) do { __attribute__((address_space(1))) void* g_ = (__attribute__((address_space(1))) void*)(p); asm volatile("" : "+s"(g_)); (p) = (decltype(p))g_; } while (0)
namespace pg8 {
#define PG8_LAS __attribute__((address_space(3)))
typedef unsigned short bf16_t;
typedef short bf16x8 __attribute__((ext_vector_type(8)));
typedef float f32x4 __attribute__((ext_vector_type(4)));
typedef unsigned u32x4 __attribute__((ext_vector_type(4)));
constexpr int BM = 256, BK = 64, HALF = 128, HTB = HALF * BK * 2  , STAGE_BYTES = 8 * HTB, NXCD = 8, WGM = 8;

__host__ __device__ __forceinline__ int lds_byte(int r, int c) { const int st = (r >> 4) * 2 + (c >> 5), rr = r & 15, cc = c & 31, ob = rr * 64 + cc * 2; return st * 1024 + (ob ^ (((ob >> 9) & 1) << 5)); }
__host__ __device__ __forceinline__ void stage_rc(int b, int& R, int& C) { const int st = b / 1024, sb = b % 1024, swz = sb ^ (((sb >> 9) & 1) << 5); R = (st >> 1) * 16 + swz / 64; C = (st & 1) * 32 + (swz % 64) / 2; }
__host__ __device__ __forceinline__ int perm32(int rho) { const int n = rho >> 4, i = rho & 15; return 8 * (i >> 2) + 4 * n + (i & 3); }

struct Unit { int pm, pn; int kofs, nt; };
struct Gemm { const bf16_t* A; const bf16_t* Bt; int M, N, K; };

template <int MD, int ND> struct StaticOrderT {
    static constexpr int nM = MD / BM, nN = ND / BM, nwg = nM * nN;
    int G, c;
    __host__ __device__ void init(int G_, int c_) { G = G_; c = c_; }
    __host__ __device__ bool next(int i, Unit& u) const { return at(i * G + c, u); }
    __host__ __device__ bool at(int L, Unit& u) const {
        if (L >= nwg) return false;
        int wgid = L; { constexpr int q = nwg / NXCD, r = nwg % NXCD; const int xcd = wgid % NXCD, off = wgid / NXCD; wgid = (xcd < r ? xcd * (q + 1) : r * (q + 1) + (xcd - r) * q) + off; }
        constexpr int nig = WGM * nN; const int gid = wgid / nig, fm = gid * WGM, gsz = (nM - fm) < WGM ? (nM - fm) : WGM;
        u.pm = fm + ((wgid % nig) % gsz); u.pn = (wgid % nig) / gsz; u.kofs = 0; u.nt = 0; return true;
    }
    __device__ __forceinline__ void a_ready(const Unit&) const {}
    __device__ __forceinline__ void done(const Unit&) const {}
};
template <class S0, int RT, int NTF> struct SplitTailOrderT { S0 s; bool sk;
    __host__ __device__ bool next(int i, Unit& u) const {
        if (!sk || i < RT) { const bool r = s.next(i, u); u.kofs = 0; u.nt = NTF; return r; }
        if (i > RT) return false;
        const int h = s.G >> 1; s.at(RT * s.G + (s.c % h), u); u.kofs = (s.c / h) * (NTF / 2) * BK * 2; u.nt = NTF / 2; return true; }
    __device__ __forceinline__ void a_ready(const Unit&) const {} __device__ __forceinline__ void done(const Unit&) const {} };


__device__ __forceinline__ unsigned cvt_pk_bf16(float lo, float hi) { unsigned r; asm volatile("v_cvt_pk_bf16_f32 %0, %1, %2" : "=v"(r) : "v"(lo), "v"(hi)); return r; }
__device__ __forceinline__ unsigned short f2bf1(float f) { unsigned u = __builtin_bit_cast(unsigned, f); return (unsigned short)((u + 0x7fffu + ((u >> 16) & 1u)) >> 16); }
typedef unsigned u32x2 __attribute__((ext_vector_type(2)));
constexpr int MROWS = M, DMODEL = D, DFF = FF;

typedef float f32x2 __attribute__((ext_vector_type(2)));
#ifdef SWIGLU_FMA
#define SWIGLU_RS2(rs) __builtin_amdgcn_rcpf((rs) * (rs))
#else
#define SWIGLU_RS2(rs) ((rs) * (rs))
#endif
__device__ __forceinline__ f32x2 swiglu2(f32x2 ag, f32x2 au, float k1, float rs2) {
    const f32x2 t = ag * k1; f32x2 ex; ex.x = __builtin_amdgcn_exp2f(t.x); ex.y = __builtin_amdgcn_exp2f(t.y);
#ifdef SWIGLU_FMA
    const f32x2 d = ex * rs2 + rs2; f32x2 r; r.x = __builtin_amdgcn_rcpf(d.x); r.y = __builtin_amdgcn_rcpf(d.y);
    return (ag * au) * r;
#else
    const f32x2 d = ex + 1.0f; f32x2 r; r.x = __builtin_amdgcn_rcpf(d.x); r.y = __builtin_amdgcn_rcpf(d.y);
    return ((ag * au) * rs2) * r;
#endif
}
__device__ __forceinline__ f32x4 swiglu4(f32x4 ag, f32x4 au, float k1, float rs2) {
    const f32x2 a = swiglu2((f32x2){ag[0], ag[1]}, (f32x2){au[0], au[1]}, k1, rs2), b = swiglu2((f32x2){ag[2], ag[3]}, (f32x2){au[2], au[3]}, k1, rs2);
    return (f32x4){a.x, a.y, b.x, b.y};
}
struct EpiSwiGLU {
    static constexpr bool PERM = true, AFTER_DRAIN = false;
    unsigned char* ws; const PG8_LAS float* rstd;
    __device__ __forceinline__ void operator()(const f32x4 (&acc)[2][2][4][2], const Unit& u, int ui, int wr, int wc, int fr, int fq) const {
        asm volatile("" : "+v"(fr), "+v"(fq));
        const int col0 = u.pn * 128 + wc * 32 + 8 * fq; unsigned char* w2 = ws; LAUNDER_G(w2); bf16_t* H = (bf16_t*)(w2 + WS_H);
#pragma unroll
        for (int ai = 0; ai < 2; ++ai)
#pragma unroll
            for (int m = 0; m < 4; ++m) {
                const int rl = ai * HALF + wr * 64 + m * 16 + fr; const float rs = rstd[ui * 256 + rl];
                const float k1 = rs * -1.4426950408889634f, rs2 = SWIGLU_RS2(rs);
                const f32x4 h0 = swiglu4(acc[ai][0][m][0], acc[ai][1][m][0], k1, rs2), h1 = swiglu4(acc[ai][0][m][1], acc[ai][1][m][1], k1, rs2);
                u32x4 w; w.x = cvt_pk_bf16(h0[0], h0[1]); w.y = cvt_pk_bf16(h0[2], h0[3]); w.z = cvt_pk_bf16(h1[0], h1[1]); w.w = cvt_pk_bf16(h1[2], h1[3]);
                *(u32x4*)(H + (size_t)(u.pm * BM + rl) * DFF + col0) = w;
            }
    }
};
struct EpiSwiGLUSplit {
    static constexpr bool PERM = true, AFTER_DRAIN = false;
    unsigned char* ws; const PG8_LAS float* rstd;
    typedef unsigned long long u64;
    __device__ __forceinline__ static void put(u64* p, const f32x4& v) {
        __hip_atomic_store(p, ((u64)__float_as_uint(v[1]) << 32) | __float_as_uint(v[0]), __ATOMIC_RELAXED, __HIP_MEMORY_SCOPE_AGENT);
        __hip_atomic_store(p + 1, ((u64)__float_as_uint(v[3]) << 32) | __float_as_uint(v[2]), __ATOMIC_RELAXED, __HIP_MEMORY_SCOPE_AGENT); }
    __device__ __forceinline__ static f32x4 get(const u64* p) {
        const u64 a = __hip_atomic_load(p, __ATOMIC_RELAXED, __HIP_MEMORY_SCOPE_AGENT), b = __hip_atomic_load(p + 1, __ATOMIC_RELAXED, __HIP_MEMORY_SCOPE_AGENT);
        return (f32x4){__uint_as_float((unsigned)a), __uint_as_float((unsigned)(a >> 32)), __uint_as_float((unsigned)b), __uint_as_float((unsigned)(b >> 32))}; }
    template <int SS> __device__ __forceinline__ void run(const f32x4 (&acc)[2][2][4][2], const Unit& u, int wr, int wc, int fr, int fq) const {
        unsigned char* w2 = ws; LAUNDER_G(w2);
        const int pair = (int)(__builtin_amdgcn_workgroup_id_x() & 127u); constexpr int rslot = 5;
        const unsigned tid = (unsigned)((wr * 4 + wc) * 64 + fq * 16 + fr);
        unsigned char* xb_ = w2 + WS_XCH + (size_t)pair * (2 * 16 * 512 * 16);
        u64* xo = (u64*)(xb_ + (size_t)(1 - SS) * (16 * 512 * 16) + tid * 16u);
        const u64* xi = (const u64*)(xb_ + (size_t)SS * (16 * 512 * 16) + tid * 16u);
        unsigned* flg = (unsigned*)(w2 + WS_CTL) + CW_XFLAG + pair * 2;
#pragma unroll
        for (int bj = 0; bj < 2; ++bj)
#pragma unroll
            for (int m = 0; m < 4; ++m)
#pragma unroll
                for (int n = 0; n < 2; ++n) put(xo + (size_t)((bj * 4 + m) * 2 + n) * 1024, acc[1 - SS][bj][m][n]);
        asm volatile("s_waitcnt vmcnt(0)" ::: "memory");
        __syncthreads();
        if (tid == 0) { __hip_atomic_store(flg + (1 - SS), 1u, __ATOMIC_RELAXED, __HIP_MEMORY_SCOPE_AGENT);
            unsigned sp = 0; while (__hip_atomic_load(flg + SS, __ATOMIC_RELAXED, __HIP_MEMORY_SCOPE_AGENT) == 0u) { __builtin_amdgcn_s_sleep(1); if (++sp > (1u << 20)) break; } }
        __syncthreads();
        bf16_t* H = (bf16_t*)(w2 + WS_H); const int col0 = u.pn * 128 + wc * 32 + 8 * fq;
#pragma unroll
        for (int m = 0; m < 4; ++m) {
            const f32x4 g0 = acc[SS][0][m][0] + get(xi + (size_t)((0 * 4 + m) * 2 + 0) * 1024), g1 = acc[SS][0][m][1] + get(xi + (size_t)((0 * 4 + m) * 2 + 1) * 1024);
            const f32x4 u0 = acc[SS][1][m][0] + get(xi + (size_t)((1 * 4 + m) * 2 + 0) * 1024), u1 = acc[SS][1][m][1] + get(xi + (size_t)((1 * 4 + m) * 2 + 1) * 1024);
            const int rl = SS * HALF + wr * 64 + m * 16 + fr; const float rs = rstd[rslot * 256 + rl];
            const float k1 = rs * -1.4426950408889634f, rs2 = SWIGLU_RS2(rs);
            const f32x4 h0 = swiglu4(g0, u0, k1, rs2), h1 = swiglu4(g1, u1, k1, rs2);
            u32x4 w; w.x = cvt_pk_bf16(h0[0], h0[1]); w.y = cvt_pk_bf16(h0[2], h0[3]); w.z = cvt_pk_bf16(h1[0], h1[1]); w.w = cvt_pk_bf16(h1[2], h1[3]);
            *(u32x4*)(H + (size_t)(u.pm * BM + rl) * DFF + col0) = w;
        }
    }
    __device__ __forceinline__ void operator()(const f32x4 (&acc)[2][2][4][2], const Unit& u, int ui, int wr, int wc, int fr, int fq) const {
        if (u.nt == (D / BK) / 2) { asm volatile("" : "+v"(fr), "+v"(fq));
            if (__builtin_amdgcn_workgroup_id_x() >> 7) run<1>(acc, u, wr, wc, fr, fq); else run<0>(acc, u, wr, wc, fr, fq); }
        else { EpiSwiGLU E0{ws, rstd}; E0(acc, u, ui, wr, wc, fr, fq); }
    }
};
template <bool SRC_B, bool WRITE_B, bool WRITE_F, int PROBE = 0> struct EpiResid {
    static constexpr bool PERM = true, AFTER_DRAIN = false;
    const float* base; float* out; unsigned char* ws; float alpha;
    __device__ __forceinline__ static f32x4 up4(unsigned a, unsigned b) { return (f32x4){__uint_as_float(a << 16), __uint_as_float(a & 0xffff0000u), __uint_as_float(b << 16), __uint_as_float(b & 0xffff0000u)}; }
    __device__ __forceinline__ void operator()(const f32x4 (&acc)[2][2][4][2], const Unit& u, int ui, int wr, int wc, int fr, int fq) const {
        asm volatile("" : "+v"(fr), "+v"(fq));
        const int col0 = u.pn * BM + wc * 32 + 8 * fq;
        unsigned char* w2 = ws; LAUNDER_G(w2); bf16_t* xb = (bf16_t*)(w2 + WS_XB); float* ssqp = (float*)(w2 + WS_SSQ);
#pragma unroll
        for (int ai = 0; ai < 2; ++ai) {
            f32x4 rb[4][2][2];
#pragma unroll
            for (int m = 0; m < 4; ++m) { const size_t off = (size_t)(u.pm * BM + ai * HALF + wr * 64 + m * 16 + fr) * DMODEL + col0;
#pragma unroll
                for (int bj = 0; bj < 2; ++bj) {
                    if (PROBE == 1) { rb[m][bj][0] = (f32x4){0.f, 0.f, 0.f, 0.f}; rb[m][bj][1] = rb[m][bj][0]; }
                    else if (SRC_B) { const u32x4 r = *(const u32x4*)(xb + off + bj * HALF); rb[m][bj][0] = __builtin_bit_cast(f32x4, r); }
                    else { rb[m][bj][0] = *(const f32x4*)(base + off + bj * HALF); rb[m][bj][1] = *(const f32x4*)(base + off + bj * HALF + 4); } } }
#pragma unroll
            for (int m = 0; m < 4; ++m) {
                const int row = u.pm * BM + ai * HALF + wr * 64 + m * 16 + fr; const size_t off = (size_t)row * DMODEL + col0; float ss = 0.f;
#pragma unroll
                for (int bj = 0; bj < 2; ++bj) { const size_t o = off + bj * HALF;
                    f32x4 b0, b1;
                    if (SRC_B) { const u32x4 r = __builtin_bit_cast(u32x4, rb[m][bj][0]); b0 = up4(r[0], r[1]); b1 = up4(r[2], r[3]); } else { b0 = rb[m][bj][0]; b1 = rb[m][bj][1]; }
                    const f32x4 v0 = b0 + acc[ai][bj][m][0] * alpha, v1 = b1 + acc[ai][bj][m][1] * alpha;
                    if (PROBE == 2) { asm volatile("" :: "v"(v0), "v"(v1)); }
#ifdef OUT_NT
                    if (WRITE_F && PROBE != 2) { __builtin_nontemporal_store(v0, (f32x4*)(out + o)); __builtin_nontemporal_store(v1, (f32x4*)(out + o + 4)); }
#else
                    if (WRITE_F && PROBE != 2) { *(f32x4*)(out + o) = v0; *(f32x4*)(out + o + 4) = v1; }
#endif
                    if (WRITE_B && PROBE != 2) { ss += ((v0[0] * v0[0] + v0[1] * v0[1]) + (v0[2] * v0[2] + v0[3] * v0[3])) + ((v1[0] * v1[0] + v1[1] * v1[1]) + (v1[2] * v1[2] + v1[3] * v1[3]));
                        u32x4 w; w.x = cvt_pk_bf16(v0[0], v0[1]); w.y = cvt_pk_bf16(v0[2], v0[3]); w.z = cvt_pk_bf16(v1[0], v1[1]); w.w = cvt_pk_bf16(v1[2], v1[3]); *(u32x4*)(xb + o) = w; } }
                if (WRITE_B && PROBE != 2) { ss += xor_lane<16>(ss); ss = sum_x32(ss); if (fq == 0) ssqp[(size_t)row * 16 + u.pn * 4 + wc] = ss; }
            }
            asm volatile("" ::: "memory");
        }
    }
};
template <bool WRITE_B, bool WRITE_F> struct EpiResidStaged {
    static constexpr bool PERM = true, AFTER_DRAIN = true;
    float* out; unsigned char* ws; float alpha; unsigned char* wsw;
    __device__ __forceinline__ static f32x4 up4(unsigned a, unsigned b) { return (f32x4){__uint_as_float(a << 16), __uint_as_float(a & 0xffff0000u), __uint_as_float(b << 16), __uint_as_float(b & 0xffff0000u)}; }
    __device__ __forceinline__ void fused(f32x4 (&acc)[2][2][4][2], const Unit& u, int wr, int wc, int fr, int fq, PG8_LAS unsigned char* lds, int wid, int lane) const {
        unsigned char* w2 = ws; LAUNDER_G(w2); const bf16_t* xb = (const bf16_t*)(w2 + WS_XB); unsigned char* w3 = wsw; LAUNDER_G(w3); bf16_t* xbw = (bf16_t*)(w3 + WS_XB); float* ssqp = (float*)(w3 + WS_SSQ);
        {
            const int tid = wid * 64 + lane, c = tid & 31, r0 = tid >> 5;
            const bf16_t* src = xb + (size_t)(u.pm * BM + r0) * DMODEL + u.pn * BM + c * 8;
            u32x4 t[16];
#pragma unroll
            for (int p = 0; p < 16; ++p) t[p] = *(const u32x4*)(src + (size_t)(p * 16) * DMODEL);
#pragma unroll
            for (int p = 0; p < 16; ++p) { const int r = p * 16 + r0; *(PG8_LAS u32x4*)(lds + r * 512 + ((c ^ (r & 15)) << 4)) = t[p]; }
        }
        asm volatile("s_waitcnt vmcnt(0) lgkmcnt(0)\n\ts_barrier" ::: "memory");
        asm volatile("" : "+v"(fr), "+v"(fq));
        const int col0 = u.pn * BM + wc * 32 + 8 * fq;
#pragma unroll
        for (int ai = 0; ai < 2; ++ai)
#pragma unroll
            for (int m = 0; m < 4; ++m) {
                const int rl = ai * HALF + wr * 64 + m * 16 + fr; const int row = u.pm * BM + rl; const size_t off = (size_t)row * DMODEL + col0; float ss = 0.f;
#pragma unroll
                for (int bj = 0; bj < 2; ++bj) { const size_t o = off + bj * HALF;
                    const int chunk = 16 * bj + 4 * wc + fq;
                    const u32x4 r = *(const PG8_LAS u32x4*)(lds + rl * 512 + ((chunk ^ (rl & 15)) << 4));
                    const f32x4 b0 = up4(r[0], r[1]), b1 = up4(r[2], r[3]);
                    const f32x4 v0 = b0 + acc[ai][bj][m][0] * alpha, v1 = b1 + acc[ai][bj][m][1] * alpha;
                    if (WRITE_F) { *(f32x4*)(out + o) = v0; *(f32x4*)(out + o + 4) = v1; }
                    if (WRITE_B) { ss += ((v0[0] * v0[0] + v0[1] * v0[1]) + (v0[2] * v0[2] + v0[3] * v0[3])) + ((v1[0] * v1[0] + v1[1] * v1[1]) + (v1[2] * v1[2] + v1[3] * v1[3]));
                        u32x4 w; w.x = cvt_pk_bf16(v0[0], v0[1]); w.y = cvt_pk_bf16(v0[2], v0[3]); w.z = cvt_pk_bf16(v1[0], v1[1]); w.w = cvt_pk_bf16(v1[2], v1[3]); *(u32x4*)(xbw + o) = w; } }
                if (WRITE_B) { ss += xor_lane<16>(ss); ss = sum_x32(ss); if (fq == 0) ssqp[(size_t)row * 16 + u.pn * 4 + wc] = ss; }
            }
    }
};
struct EpiNull {
    static constexpr bool PERM = true, AFTER_DRAIN = false;
    __device__ __forceinline__ void operator()(const f32x4 (&acc)[2][2][4][2], const Unit& u, int ui, int wr, int wc, int fr, int fq) const {
#pragma unroll
        for (int ai = 0; ai < 2; ++ai)
#pragma unroll
            for (int bj = 0; bj < 2; ++bj)
#pragma unroll
                for (int m = 0; m < 4; ++m)
#pragma unroll
                    for (int n = 0; n < 2; ++n) { f32x4 t = acc[ai][bj][m][n]; asm volatile("" :: "v"(t)); }
    }
};
struct EpiInProj {
    static constexpr bool PERM = false, AFTER_DRAIN = false;
    const PG8_LAS float* rstd; const PG8_LAS float* prm; unsigned char* ws;
    __device__ __forceinline__ static float head_f(const f32x4 (&acc)[2][2][4][2], int ai, int m, float rs) {
        float ss = 0.f;
#pragma unroll
        for (int bj = 0; bj < 2; ++bj)
#pragma unroll
            for (int n = 0; n < 2; ++n) { const f32x4 a = acc[ai][bj][m][n]; ss += (a[0] * a[0] + a[1] * a[1]) + (a[2] * a[2] + a[3] * a[3]); }
        ss += xor_lane<16>(ss); ss = sum_x32(ss);
        return rs / sqrtf(ss * rs * rs * (1.0f / 64.0f) + 1e-6f);
    }
    __device__ __forceinline__ void operator()(const f32x4 (&acc)[2][2][4][2], const Unit& u, int ui, int wr, int wc, int fr, int fq) const {
        const int G = __builtin_amdgcn_readfirstlane(u.pn * 4 + wc);
        unsigned char* w2 = ws; LAUNDER_G(w2);
        asm volatile("" : "+v"(fr), "+v"(fq));
        const int row0 = wr * 64 + fr;
        if (G < 10) {
            const bool isq = G < 8;
            const PG8_LAS float* gp = prm + (isq ? PRM_GAQ : PRM_GAK) + 4 * fq;
            const float* rope = (const float*)(w2 + WS_ROPE) + 4 * fq;
            const float qs = isq ? 0.125f * 1.4426950408889634f : 1.0f;
            unsigned char* db = isq ? (w2 + WS_QA) + (size_t)G * MROWS * 64 + 8 * fq : (w2 + WS_KA) + (size_t)(G - 8) * MROWS * 64 + (fq >> 1) * 512 + 8 * (fq & 1);
#pragma unroll
            for (int ai = 0; ai < 2; ++ai)
#pragma unroll
                for (int m = 0; m < 4; ++m) {
                    const int rl = ai * HALF + m * 16 + row0; const int t = u.pm * BM + rl; const float f = head_f(acc, ai, m, rstd[ui * 256 + rl]) * qs;
                    unsigned char* dt = isq ? db + (size_t)t * 64 : db + (size_t)(t >> 6) * 4096 + ((t & 63) >> 5) * 2048 + (t & 31) * 16;
#pragma unroll
                    for (int bj = 0; bj < 2; ++bj) {
                        const f32x4 x1 = acc[ai][bj][m][0] * f * *(const PG8_LAS f32x4*)(gp + 32 * bj), x2 = acc[ai][bj][m][1] * f * *(const PG8_LAS f32x4*)(gp + 32 * bj + 16);
                        const int pos = bj ? (t & 63) : (t >> 6); const float* rp = rope + (bj ? 8192 : 0) + pos * 16;
                        const f32x4 c = *(const f32x4*)rp, s = *(const f32x4*)(rp + (bj ? 1024 : 4096));
                        const f32x4 y1 = x1 * c - x2 * s, y2 = x2 * c + x1 * s;
                        int lo = __builtin_amdgcn_cvt_pk_fp8_f32(y1[0], y1[1], 0, false); lo = __builtin_amdgcn_cvt_pk_fp8_f32(y1[2], y1[3], lo, true);
                        int hi = __builtin_amdgcn_cvt_pk_fp8_f32(y2[0], y2[1], 0, false); hi = __builtin_amdgcn_cvt_pk_fp8_f32(y2[2], y2[3], hi, true);
                        u32x2 w; w.x = (unsigned)lo; w.y = (unsigned)hi;
                        *(u32x2*)(dt + (isq ? 32 * bj : 1024 * bj)) = w;
                    }
                    asm volatile("" ::: "memory");
                }
        } else if (G < 12) {
            unsigned char* V8 = (w2 + WS_VA) + (size_t)(G - 10) * MROWS * 64 + (4 * fq) * 16;
#pragma unroll
            for (int ai = 0; ai < 2; ++ai)
#pragma unroll
                for (int m = 0; m < 4; ++m) {
                    const int rl = ai * HALF + m * 16 + row0; const int t = u.pm * BM + rl; const float rs = rstd[ui * 256 + rl];
                    const int kk = t & 63, c = kk >> 5, r = kk & 31, h = (r >> 2) & 1, jj = (r & 3) + 4 * (r >> 3);
                    unsigned char* vb = V8 + (size_t)(t >> 6) * 4096 + h * 1024 + c * 512 + jj;
#pragma unroll
                    for (int bj = 0; bj < 2; ++bj)
#pragma unroll
                        for (int n = 0; n < 2; ++n) { const f32x4 v = acc[ai][bj][m][n] * rs;
                            const int p01 = __builtin_amdgcn_cvt_pk_fp8_f32(v[0], v[1], 0, false), p23 = __builtin_amdgcn_cvt_pk_fp8_f32(v[2], v[3], 0, false);
                            unsigned char* q = vb + bj * 2048 + (16 * n) * 16;
                            q[0] = (unsigned char)(p01 & 0xff); q[16] = (unsigned char)((p01 >> 8) & 0xff); q[32] = (unsigned char)(p23 & 0xff); q[48] = (unsigned char)((p23 >> 8) & 0xff); }
                    asm volatile("" ::: "memory");
                }
        } else if (G < 28) {
            const bool isq = G < 20;
            const PG8_LAS float* gp = prm + (isq ? PRM_GBQ : PRM_GBK) + 4 * fq;
            const float qs = isq ? 0.125f * 1.4426950408889634f : 1.0f;
            bf16_t* db = isq ? (bf16_t*)(w2 + WS_QB) + (size_t)(G - 12) * MROWS * 64 + 8 * fq : (bf16_t*)(w2 + WS_KB) + (size_t)(G - 20) * MROWS * 64 + (size_t)fq * 512;
#pragma unroll
            for (int ai = 0; ai < 2; ++ai)
#pragma unroll
                for (int m = 0; m < 4; ++m) {
                    const int rl = ai * HALF + m * 16 + row0; const int t = u.pm * BM + rl; const float f = head_f(acc, ai, m, rstd[ui * 256 + rl]) * qs;
                    bf16_t* dt = isq ? db + (size_t)t * 64 : db + (size_t)(t >> 6) * 4096 + (t & 63) * 8;
#pragma unroll
                    for (int bj = 0; bj < 2; ++bj) {
                        const f32x4 x1 = acc[ai][bj][m][0] * f * *(const PG8_LAS f32x4*)(gp + 32 * bj), x2 = acc[ai][bj][m][1] * f * *(const PG8_LAS f32x4*)(gp + 32 * bj + 16);
                        u32x4 w; w.x = cvt_pk_bf16(x1[0], x1[1]); w.y = cvt_pk_bf16(x1[2], x1[3]); w.z = cvt_pk_bf16(x2[0], x2[1]); w.w = cvt_pk_bf16(x2[2], x2[3]);
                        *(u32x4*)(dt + (isq ? 32 * bj : 2048 * bj)) = w;
                    }
                    asm volatile("" ::: "memory");
                }
        } else {
            bf16_t* V = (bf16_t*)(w2 + WS_VB) + (size_t)((G - 28) >> 1) * MROWS * 128 + (64 * ((G - 28) & 1) + 4 * fq) * 8;
#pragma unroll
            for (int ai = 0; ai < 2; ++ai)
#pragma unroll
                for (int m = 0; m < 4; ++m) {
                    const int rl = ai * HALF + m * 16 + row0; const int t = u.pm * BM + rl; const float rs = rstd[ui * 256 + rl];
                    const int kk = t & 63, ks = kk >> 4, ko = kk & 15, hi = (ko >> 2) & 1, j = ((ko >> 3) << 2) | (ko & 3);
                    bf16_t* vb = V + (size_t)(((t >> 6) * 4 + ks) * 2 + hi) * 1024 + j;
#pragma unroll
                    for (int bj = 0; bj < 2; ++bj)
#pragma unroll
                        for (int n = 0; n < 2; ++n)
#pragma unroll
                            for (int e = 0; e < 4; ++e) vb[(32 * bj + 16 * n + e) * 8] = f2bf1(acc[ai][bj][m][n][e] * rs);
                    asm volatile("" ::: "memory");
                }
        }
    }
};

#ifndef NOTAIL
#define NOTAIL 0
#endif
template <int KD, class Epi, class Sched, bool ALIGN_EPI = false, bool SP2 = false, int LD = KD, bool VARK = false>
__device__ __forceinline__ void gemm_phase(PG8_LAS unsigned char* lds, const Gemm g, const Sched& S, const Epi& E, int wave_id) {
    int tid_ = wave_id * 64 + lane_id_v(); asm volatile("" : "+v"(tid_));
    const int tid = tid_, wid = __builtin_amdgcn_readfirstlane(tid >> 6), lane = tid & 63, wr = wid >> 2, wc = wid & 3, fr = lane & 15, fq = lane >> 4;
    constexpr int K = KD, ntc = K / BK; static_assert(ntc % 2 == 0, "even K-tile count");
    unsigned voffA[2], voffB[2];
#pragma unroll
    for (int i = 0; i < 2; ++i) { int R, C; stage_rc(tid * 16 + i * 8192, R, C); const int Rb = Epi::PERM ? ((R & ~31) + perm32(R & 31)) : R;
        voffA[i] = (unsigned)(R * LD + C) * 2u; voffB[i] = (unsigned)(Rb * LD + C) * 2u; }
    constexpr size_t kstep = (size_t)(BK * 2);
    constexpr size_t hstep = (size_t)HALF * LD * 2;
    constexpr size_t tstep = 2 * hstep;
    const unsigned ldsw = (unsigned)wid * 1024u;
    const int aoff = lds_byte(wr * 64 + fr, fq * 8), boff = lds_byte(wc * 32 + fr, fq * 8);
#define PG8_SA(b, h) (((b) * 2 + (h)) * HTB)
#define PG8_SB(b, h) ((4 + (b) * 2 + (h)) * HTB)
#define PG8_STAGE(bufoff, gbase, voff) do { _Pragma("unroll") for (int _i = 0; _i < 2; ++_i) \
        __builtin_amdgcn_global_load_lds((const unsigned*)((const char*)(gbase) + (voff)[_i]), (PG8_LAS unsigned*)(lds + (bufoff) + ldsw + _i * 8192), 16, 0, 0); } while (0)
#define PG8_LDA(dst, b, h) do { _Pragma("unroll") for (int m = 0; m < 4; ++m) _Pragma("unroll") for (int k = 0; k < 2; ++k) dst[m][k] = *(const PG8_LAS bf16x8*)(lds + PG8_SA(b, h) + aoff + m * 2048 + k * 1024); } while (0)
#define PG8_LDB(dst, b, h) do { _Pragma("unroll") for (int n = 0; n < 2; ++n) _Pragma("unroll") for (int k = 0; k < 2; ++k) dst[n][k] = *(const PG8_LAS bf16x8*)(lds + PG8_SB(b, h) + boff + n * 2048 + k * 1024); } while (0)
#define PG8_MMA(ai, bj, At, Bt) do { __builtin_amdgcn_s_setprio(1); _Pragma("unroll") for (int m = 0; m < 4; ++m) _Pragma("unroll") for (int n = 0; n < 2; ++n) _Pragma("unroll") for (int k = 0; k < 2; ++k) \
        acc[ai][bj][m][n] = __builtin_amdgcn_mfma_f32_16x16x32_bf16(Bt[n][k], At[m][k], acc[ai][bj][m][n], 0, 0, 0); __builtin_amdgcn_s_setprio(0); } while (0)
#define PG8_WAIT_V(n) asm volatile("s_waitcnt vmcnt(" #n ")" ::: "memory")
#define PG8_WAIT_L(n) asm volatile("s_waitcnt lgkmcnt(" #n ")" ::: "memory")
#define PG8_BAR __builtin_amdgcn_s_barrier()
#define PG8_SCHED __builtin_amdgcn_sched_barrier(0)
    Unit cur, nxt; int ui = 0;
    if (!S.next(0, cur)) return;
    f32x4 acc[2][2][4][2];
#pragma unroll
    for (int a = 0; a < 2; ++a)
#pragma unroll
        for (int b = 0; b < 2; ++b)
#pragma unroll
            for (int m = 0; m < 4; ++m)
#pragma unroll
                for (int n = 0; n < 2; ++n) acc[a][b][m][n] = (f32x4){0.f, 0.f, 0.f, 0.f};
    bf16x8 At[4][2], B0[2][2], B1[2][2];
    const char* cA = (const char*)g.A + (size_t)cur.pm * tstep + (VARK ? cur.kofs : 0); const char* cB = (const char*)g.Bt + (size_t)cur.pn * tstep + (VARK ? cur.kofs : 0);
    S.a_ready(cur);
    if constexpr (SP2) {
        PG8_STAGE(PG8_SB(0, 0), cB, voffB); PG8_STAGE(PG8_SB(0, 1), cB + hstep, voffB); PG8_STAGE(PG8_SA(0, 0), cA, voffA); PG8_STAGE(PG8_SA(0, 1), cA + hstep, voffA);
        if (wr == 1) PG8_BAR;
        PG8_WAIT_V(2); PG8_BAR;
        PG8_STAGE(PG8_SB(1, 0), cB + kstep, voffB); PG8_STAGE(PG8_SA(1, 0), cA + kstep, voffA); PG8_STAGE(PG8_SB(1, 1), cB + hstep + kstep, voffB);
        PG8_WAIT_V(6); PG8_BAR;
    } else {
        PG8_STAGE(PG8_SB(0, 0), cB, voffB); PG8_STAGE(PG8_SA(0, 0), cA, voffA); PG8_STAGE(PG8_SB(0, 1), cB + hstep, voffB); PG8_STAGE(PG8_SA(0, 1), cA + hstep, voffA);
        if (wr == 1) PG8_BAR;
        PG8_WAIT_V(4); PG8_BAR;
        PG8_STAGE(PG8_SB(1, 0), cB + kstep, voffB); PG8_STAGE(PG8_SA(1, 0), cA + kstep, voffA); PG8_STAGE(PG8_SB(1, 1), cB + hstep + kstep, voffB);
        PG8_WAIT_V(6); PG8_BAR;
    }
    for (;;) {
        const bool has_next = S.next(ui + 1, nxt);
        const char* nA = has_next ? (const char*)g.A + (size_t)nxt.pm * tstep + (VARK ? nxt.kofs : 0) : cA; const char* nB = has_next ? (const char*)g.Bt + (size_t)nxt.pn * tstep + (VARK ? nxt.kofs : 0) : cB;
        const int nt = VARK ? cur.nt : ntc;
        for (int t = 0; t < nt; t += 2) {
            const bool last = (t == nt - 2); const bool fin = last && !has_next;
            const char* a1 = cA + (size_t)(t + 1) * kstep;
            const char* a2 = last ? nA : cA + (size_t)(t + 2) * kstep; const char* b2 = last ? nB : cB + (size_t)(t + 2) * kstep;
            const char* a3 = a2 + kstep; const char* b3 = b2 + kstep;
            if (last && has_next) S.a_ready(nxt);
            if constexpr (SP2) {
            PG8_LDB(B0, 0, 0); PG8_LDB(B1, 0, 1); PG8_SCHED; PG8_LDA(At, 0, 0); PG8_STAGE(PG8_SA(1, 1), a1 + hstep, voffA);
            PG8_WAIT_V(8); PG8_WAIT_L(0); PG8_BAR; PG8_MMA(0, 0, At, B0); PG8_MMA(0, 1, At, B1); PG8_BAR; PG8_SCHED;
            PG8_LDA(At, 0, 1); if (NOTAIL && fin) { PG8_WAIT_V(2); } else { PG8_STAGE(PG8_SB(0, 0), b2, voffB); PG8_STAGE(PG8_SB(0, 1), b2 + hstep, voffB); PG8_STAGE(PG8_SA(0, 0), a2, voffA); PG8_WAIT_V(8); }
            PG8_WAIT_L(0); PG8_BAR; PG8_MMA(1, 0, At, B0); PG8_MMA(1, 1, At, B1); PG8_BAR; PG8_SCHED;
            PG8_LDB(B0, 1, 0); PG8_LDB(B1, 1, 1); PG8_SCHED; PG8_LDA(At, 1, 0); if (NOTAIL && fin) { PG8_WAIT_V(0); } else { PG8_STAGE(PG8_SA(0, 1), a2 + hstep, voffA); PG8_WAIT_V(8); }
            PG8_WAIT_L(0); PG8_BAR; PG8_MMA(0, 0, At, B0); PG8_MMA(0, 1, At, B1); PG8_BAR; PG8_SCHED;
            PG8_LDA(At, 1, 1); if (!(NOTAIL && fin)) { PG8_STAGE(PG8_SB(1, 0), b3, voffB); PG8_STAGE(PG8_SB(1, 1), b3 + hstep, voffB); PG8_STAGE(PG8_SA(1, 0), a3, voffA); PG8_WAIT_V(8); }
            PG8_WAIT_L(0); PG8_BAR; PG8_MMA(1, 0, At, B0); PG8_MMA(1, 1, At, B1); PG8_BAR; PG8_SCHED;
            } else {
            PG8_LDB(B0, 0, 0); PG8_SCHED; PG8_LDA(At, 0, 0); PG8_STAGE(PG8_SA(1, 1), a1 + hstep, voffA);
            PG8_WAIT_L(8); PG8_BAR; PG8_WAIT_L(0); PG8_MMA(0, 0, At, B0); PG8_BAR; PG8_SCHED;
            PG8_LDB(B1, 0, 1); PG8_STAGE(PG8_SB(0, 0), b2, voffB);
            PG8_BAR; PG8_WAIT_L(0); PG8_MMA(0, 1, At, B1); PG8_BAR;
            PG8_LDA(At, 0, 1); PG8_STAGE(PG8_SA(0, 0), a2, voffA);
            PG8_BAR; PG8_WAIT_L(0); PG8_MMA(1, 0, At, B0); PG8_BAR; PG8_SCHED;
            PG8_STAGE(PG8_SB(0, 1), b2 + hstep, voffB);
            PG8_WAIT_V(6); PG8_BAR; PG8_MMA(1, 1, At, B1); PG8_BAR;
            PG8_LDB(B0, 1, 0); PG8_SCHED; PG8_LDA(At, 1, 0); PG8_STAGE(PG8_SA(0, 1), a2 + hstep, voffA);
            PG8_WAIT_L(8); PG8_BAR; PG8_WAIT_L(0); PG8_MMA(0, 0, At, B0); PG8_BAR; PG8_SCHED;
            PG8_LDB(B1, 1, 1); PG8_STAGE(PG8_SB(1, 0), b3, voffB);
            PG8_BAR; PG8_WAIT_L(0); PG8_MMA(0, 1, At, B1); PG8_BAR;
            PG8_LDA(At, 1, 1); PG8_STAGE(PG8_SA(1, 0), a3, voffA);
            PG8_BAR; PG8_WAIT_L(0); PG8_MMA(1, 0, At, B0); PG8_BAR; PG8_SCHED;
            PG8_STAGE(PG8_SB(1, 1), b3 + hstep, voffB);
            PG8_WAIT_V(6); PG8_BAR; PG8_MMA(1, 1, At, B1); PG8_BAR;
            }
        }
        if constexpr (ALIGN_EPI) { if (wr == 0) PG8_BAR; }
        if constexpr (!Epi::AFTER_DRAIN) { E(acc, cur, ui, wr, wc, fr, fq); S.done(cur); }
        if (!has_next) break;
#pragma unroll
        for (int a = 0; a < 2; ++a)
#pragma unroll
            for (int b = 0; b < 2; ++b)
#pragma unroll
                for (int m = 0; m < 4; ++m)
#pragma unroll
                    for (int n = 0; n < 2; ++n) acc[a][b][m][n] = (f32x4){0.f, 0.f, 0.f, 0.f};
        cur = nxt; cA = nA; cB = nB; ++ui;
        if constexpr (ALIGN_EPI) { if (wr == 1) PG8_BAR; }
    }
    PG8_WAIT_V(0);
    if constexpr (!ALIGN_EPI) { if (wr == 0) PG8_BAR; }
    PG8_BAR;
    if constexpr (Epi::AFTER_DRAIN) { E.fused(acc, cur, wr, wc, fr, fq, lds, wid, lane); S.done(cur); }
#undef PG8_SA
#undef PG8_SB
#undef PG8_STAGE
#undef PG8_LDA
#undef PG8_LDB
#undef PG8_MMA
#undef PG8_WAIT_V
#undef PG8_WAIT_L
#undef PG8_BAR
#undef PG8_SCHED
}
}
namespace att {
typedef unsigned short bf16_t;
typedef short bf16x8 __attribute__((ext_vector_type(8)));
typedef float f32x16 __attribute__((ext_vector_type(16)));
typedef float f32x4 __attribute__((ext_vector_type(4)));
typedef unsigned u32x4 __attribute__((ext_vector_type(4)));
#define ALAS __attribute__((address_space(3)))
constexpr int MROWS = M;
constexpr int WSF_OFF = 114688;
constexpr int LDS_NEED = WSF_OFF + 8 * 256;
__device__ __forceinline__ int crow(int r, int hi) { return (r & 3) + 8 * (r >> 2) + 4 * hi; }
__device__ __forceinline__ void glds16(const void* gsrc, unsigned lds_dst) { unsigned keep;
    asm volatile("s_mov_b32 %0, m0\n\ts_mov_b32 m0, %2\n\ts_nop 0\n\tglobal_load_lds_dwordx4 %1, off\n\ts_mov_b32 m0, %0" : "=&s"(keep) : "v"(gsrc), "s"(lds_dst) : "memory"); }
typedef float f32x2_t __attribute__((ext_vector_type(2))); typedef __bf16 bf16x2_t __attribute__((ext_vector_type(2)));
__device__ __forceinline__ unsigned cvtpk(float lo, float hi) { f32x2_t v = {lo, hi}; bf16x2_t b = __builtin_convertvector(v, bf16x2_t); return __builtin_bit_cast(unsigned, b); }
__device__ __forceinline__ void glds16s(const void* sbase, unsigned voff, unsigned lds_dst) { unsigned keep;
#ifdef GLDS_M0_CLOBBER
    (void)keep; asm volatile("s_mov_b32 m0, %2\n\ts_nop 0\n\tglobal_load_lds_dwordx4 %0, %1" :: "v"(voff), "s"(sbase), "s"(lds_dst) : "memory", "m0"); }
#else
    asm volatile("s_mov_b32 %0, m0\n\ts_mov_b32 m0, %3\n\ts_nop 0\n\tglobal_load_lds_dwordx4 %1, %2\n\ts_mov_b32 m0, %0" : "=&s"(keep) : "v"(voff), "s"(sbase), "s"(lds_dst) : "memory"); }
#endif
#define ATT_WAIT_BAR(N) asm volatile("s_waitcnt vmcnt(" #N ") lgkmcnt(0)\n\ts_barrier" ::: "memory")
#define ATT_MFMA(a, b, c) __builtin_amdgcn_mfma_f32_32x32x16_bf16(a, b, c, 0, 0, 0)

struct Tensors { unsigned char* ws; const ALAS float* subln; };
__device__ __forceinline__ Tensors make_tensors(unsigned char* ws, const ALAS float* prm) { return Tensors{ws, prm + PRM_SUBLN}; }
#define T_QA ((const bf16_t*)(tws_ + WS_QA))
#define T_KA ((const bf16_t*)(tws_ + WS_KA))
#define T_VA ((const bf16_t*)(tws_ + WS_VA))
#define T_QB ((const bf16_t*)(tws_ + WS_QB))
#define T_KB ((const bf16_t*)(tws_ + WS_KB))
#define T_VB ((const bf16_t*)(tws_ + WS_VB))
#define T_MIX ((bf16_t*)(tws_ + WS_MIX))

#define SBAR() __builtin_amdgcn_sched_barrier(0)
#define PIN(x) asm volatile("" : "+v"(x))
#define PKW(P, B) cvtpk(P[B], P[(B) + 1])
#define EX(v) __builtin_amdgcn_exp2f(v)
#define WB_SEL(n) do { switch (n) { case 0: ATT_WAIT_BAR(0); break; case 1: ATT_WAIT_BAR(1); break; case 2: ATT_WAIT_BAR(2); break; case 3: ATT_WAIT_BAR(3); break; case 4: ATT_WAIT_BAR(4); break; case 6: ATT_WAIT_BAR(6); break; default: ATT_WAIT_BAR(8); } } while (0)
template <bool ISB>
__device__ __forceinline__ void attn_unit(const Tensors& T, int head, int qb, float negM2, float lam, float c2, int dskip, char* shm, int wave_id) {
    unsigned char* tws_ = T.ws; LAUNDER_G(tws_);
    constexpr int DV = ISB ? 128 : 64, ND0 = DV / 32, NK = ISB ? 2 : 1, NV = ISB ? 2 : 1;
    constexpr int KSLOT = ISB ? 16384 : 8192, VSLOT = ISB ? 16384 : 8192, LDS_K = 0, LDS_V = 3 * KSLOT;
    int tid_ = wave_id * 64 + lane_id_v(); asm volatile("" : "+v"(tid_));
    const int tid = tid_, lane = tid & 63, r32 = lane & 31, hi = lane >> 5; const int wid = __builtin_amdgcn_readfirstlane(tid >> 6);
    const int mapc = ISB ? (wid >> 2) : 0, wq = ISB ? (wid & 3) : wid;
    const int q0 = ISB ? qb * 128 : qb * 256; const int qrow = q0 + wq * 32 + r32;
    int t0 = 0, t1 = 256;
    if (ISB) { const int lo = q0 - dskip, hi_ = q0 + 127 + dskip; t0 = lo > 0 ? (lo >> 6) : 0; t1 = (hi_ >> 6) + 1; if (t1 > 256) t1 = 256;
        if ((t1 - t0) & 1) { if (t0 > 0) --t0; else ++t1; } }
    const int n = t1 - t0;
    const unsigned lds0 = (unsigned)(uintptr_t)shm;
    const ALAS char* shm3 = (const ALAS char*)shm;
    const char* k1b = ISB ? (const char*)(T_KB + (size_t)(2 * head) * MROWS * 64) + (size_t)t0 * 8192 : (const char*)(T_KA + (size_t)(head >> 2) * MROWS * 64);
    const char* k2b = ISB ? (const char*)(T_KB + (size_t)(2 * head + 1) * MROWS * 64) + (size_t)t0 * 8192 : nullptr;
    const char* vb_ = ISB ? (const char*)(T_VB + (size_t)head * MROWS * 128) + (size_t)t0 * 16384 : (const char*)(T_VA + (size_t)(head >> 2) * MROWS * 64);
    const unsigned dvo = (unsigned)(wid * 1024 + lane * 16);
    const unsigned kdst = lds0 + LDS_K + wid * 1024, vdst = lds0 + LDS_V + wid * 1024;
#define DMA_K(i, so) do { glds16s(k1b + (size_t)(i) * 8192, dvo, (unsigned)__builtin_amdgcn_readfirstlane(kdst + (so))); if (ISB) glds16s(k2b + (size_t)(i) * 8192, dvo, (unsigned)__builtin_amdgcn_readfirstlane(kdst + (so) + 8192)); } while (0)
#define DMA_V(i, so) do { if (ISB) { glds16s(vb_ + (size_t)(i) * 16384, dvo, (unsigned)__builtin_amdgcn_readfirstlane(vdst + (so))); glds16s(vb_ + (size_t)(i) * 16384 + 8192, dvo, (unsigned)__builtin_amdgcn_readfirstlane(vdst + (so) + 8192)); } \
      else glds16s(vb_ + (size_t)(i) * 8192, dvo, (unsigned)__builtin_amdgcn_readfirstlane(vdst + (so))); } while (0)
    DMA_K(0, 0); DMA_V(0, 0); DMA_K(1, KSLOT); DMA_V(1, VSLOT);
    const bf16_t* Qw = (ISB ? T_QB + (size_t)(2 * head + mapc) * MROWS * 64 : T_QA + (size_t)head * MROWS * 64) + (size_t)qrow * 64;
    bf16x8 qr[4];
#pragma unroll
    for (int d0 = 0; d0 < 4; ++d0) qr[d0] = *(const bf16x8*)(Qw + d0 * 16 + hi * 8);
    f32x16 o[ND0];
#pragma unroll
    for (int d = 0; d < ND0; ++d) o[d] = f32x16{};
    f32x16 negm;
#pragma unroll
    for (int r = 0; r < 16; ++r) negm[r] = negM2;
    asm volatile("" : "+v"(negm));
    float l_reg = 0.f;
    f32x16 osum = f32x16{}; bf16x8 ones; { const short o1 = (short)0x3f80; ones = (bf16x8){o1, o1, o1, o1, o1, o1, o1, o1}; } asm volatile("" : "+v"(ones));
    const ALAS char* kp0 = shm3 + LDS_K + (ISB ? mapc * 8192 : 0) + hi * 1024 + r32 * 16;
    const ALAS char* vp0 = shm3 + LDS_V + hi * (DV * 16) + r32 * 16;
    const int qw_lo = q0 + wq * 32, qw_hi = qw_lo + 31;
    const float nc2 = -c2; const float dl0 = (float)(64 * t0 - qrow + 4 * hi);
#define BIAS_GEN4(X, B, DC) do { const float e1_ = (DC) + 1.0f, e2_ = (DC) + 2.0f, e3_ = e1_ + 2.0f; \
        X[B] = __builtin_fmaf(__builtin_fabsf(DC), nc2, negM2); X[(B) + 1] = __builtin_fmaf(__builtin_fabsf(e1_), nc2, negM2); X[(B) + 2] = __builtin_fmaf(__builtin_fabsf(e2_), nc2, negM2); X[(B) + 3] = __builtin_fmaf(__builtin_fabsf(e3_), nc2, negM2); DC += 8.0f; } while (0)
#define BIAS_FAST4(X, B, DC) do { X[B] = __builtin_fmaf(sc1_, (DC), negM2); float t1_ = X[B] + sc1_; asm volatile("" : "+v"(t1_)); float t2_ = X[B] + sc2_; asm volatile("" : "+v"(t2_)); X[(B) + 1] = t1_; X[(B) + 2] = t2_; X[(B) + 3] = X[B] + sc3_; DC += 8.0f; } while (0)
#define BIAS_ALL(X0, X1, DL) do { float dc_ = (DL); BIAS_GEN4(X0, 0, dc_); BIAS_GEN4(X0, 4, dc_); BIAS_GEN4(X0, 8, dc_); BIAS_GEN4(X0, 12, dc_); BIAS_GEN4(X1, 0, dc_); BIAS_GEN4(X1, 4, dc_); BIAS_GEN4(X1, 8, dc_); BIAS_GEN4(X1, 12, dc_); } while (0)
#ifdef BIAS_CONST
    float cst[32];
#pragma unroll
    for (int e = 0; e < 32; ++e) { float cv_ = c2 * (float)(8 * (e >> 2) + (e & 3)); asm volatile("" : "+v"(cv_)); cst[e] = __builtin_bit_cast(float, __builtin_amdgcn_readfirstlane(__builtin_bit_cast(int, cv_))); }
#define BIAS_STEP_SETUP() const float base_ = __builtin_fmaf(sc1_, dcn_, negM2); float sgn_ = above_ ? -1.0f : 1.0f; asm volatile("" : "+v"(sgn_))
#else
#define BIAS_STEP_SETUP() do {} while (0)
#endif
    f32x16 pA0, pA1, pB0, pB1;
    bf16x8 kf[8], vf[4]; u32x4 pw0, pw1, pw2, pw3;
    int ks_prev = 0, ks_cur = 0, ks_next = KSLOT, vs_prev = 0, vs_cur = VSLOT, vs_next = 2 * VSLOT, vs_n2 = 3 * VSLOT;
#define ROTK() do { ks_prev = ks_cur; ks_cur = ks_next; ks_next = (ks_next == 2 * KSLOT) ? 0 : ks_next + KSLOT; } while (0)
#define ROT() do { ROTK(); const int tv_ = vs_prev; vs_prev = vs_cur; vs_cur = vs_next; vs_next = vs_n2; vs_n2 = tv_; } while (0)
    DMA_K(2, 2 * KSLOT);
    WB_SEL(2 * NV + 2 * NK);
    if (ISB) { BIAS_ALL(pA0, pA1, dl0); } else { pA0 = negm; pA1 = negm; }
    {
        const ALAS char* kp = kp0;
#pragma unroll
        for (int d0 = 0; d0 < 4; ++d0) { const bf16x8 b0 = *(const ALAS bf16x8*)(kp + d0 * 2048), b1 = *(const ALAS bf16x8*)(kp + d0 * 2048 + 512);
            pA0 = ATT_MFMA(b0, qr[d0], pA0); pA1 = ATT_MFMA(b1, qr[d0], pA1); }
#pragma unroll
        for (int r = 0; r < 16; ++r) { pA0[r] = EX(pA0[r]); pA1[r] = EX(pA1[r]); }
    }
    WB_SEL(0);
    DMA_K(3, 0); DMA_V(2, 2 * VSLOT);
    ROTK();
#define KLOAD2(base, j) do { kf[2 * (j)] = *(const ALAS bf16x8*)((base) + (j) * 2048); kf[2 * (j) + 1] = *(const ALAS bf16x8*)((base) + (j) * 2048 + 512); } while (0)
    { const ALAS char* kb_ = kp0 + ks_cur; KLOAD2(kb_, 0); KLOAD2(kb_, 1); KLOAD2(kb_, 2); KLOAD2(kb_, 3); }
    if (ISB) { BIAS_ALL(pB0, pB1, dl0 + 64.f); }
    WB_SEL(NK + NV);
#define PAF(k) __builtin_bit_cast(bf16x8, pw##k)
#if (B_ORDER & 1)
#define GAPA(MF, A0, A1, A2, A3, W0, W1, PW) do { if (ISB) { sacc += A0; sacc += A1; sacc += A2; sacc += A3; PIN(sacc); } W0; W1; PIN(PW); SBAR(); MF; SBAR(); } while (0)
#else
#define GAPA(MF, A0, A1, A2, A3, W0, W1, PW) do { MF; if (ISB) { sacc += A0; sacc += A1; sacc += A2; sacc += A3; PIN(sacc); } W0; W1; PIN(PW); SBAR(); } while (0)
#endif
#define GAPB(MF, X, B) do { MF; X[B] = EX(X[B]); X[(B) + 1] = EX(X[(B) + 1]); X[(B) + 2] = EX(X[(B) + 2]); X[(B) + 3] = EX(X[(B) + 3]); PIN(X); SBAR(); } while (0)
#define GAPX(MF, EXS, X) do { MF; EXS; PIN(X); SBAR(); } while (0)
#define EXE(C0, C1, k) do { if ((k) < 16) C0[(k) & 15] = EX(C0[(k) & 15]); else C1[(k) & 15] = EX(C1[(k) & 15]); } while (0)
#define EXN(C0, C1, k, N) do { EXE(C0, C1, k); if ((N) > 1) EXE(C0, C1, (k) + 1); if ((N) > 2) EXE(C0, C1, (k) + 2); } while (0)
#if (B_ORDER & 2)
#define GAPEN(MF, C0, C1, k, N) do { EXN(C0, C1, k, N); PIN(C0); PIN(C1); SBAR(); MF; SBAR(); } while (0)
#else
#define GAPEN(MF, C0, C1, k, N) do { MF; EXN(C0, C1, k, N); PIN(C0); PIN(C1); SBAR(); } while (0)
#endif
#define GAPE3(MF, C0, C1, k) do { MF; EXE(C0, C1, k); EXE(C0, C1, (k) + 1); EXE(C0, C1, (k) + 2); PIN(C0); PIN(C1); SBAR(); } while (0)
#ifdef BIAS_CONST
#define GAPC(MF, G, X, B, E0) do { MF; if (G) { { float a0_ = __builtin_fmaf(sgn_, cst[(E0) + (B)], base_), a1_ = __builtin_fmaf(sgn_, cst[(E0) + (B) + 1], base_), a2_ = __builtin_fmaf(sgn_, cst[(E0) + (B) + 2], base_), a3_ = __builtin_fmaf(sgn_, cst[(E0) + (B) + 3], base_); asm volatile("" : "+v"(a0_), "+v"(a1_), "+v"(a2_), "+v"(a3_)); X[B] = a0_; X[(B) + 1] = a1_; X[(B) + 2] = a2_; X[(B) + 3] = a3_; } \
        if (__builtin_expect(!fastb_, 0)) { float dg_ = dcn_ + (float)(8 * (((E0) + (B)) >> 2)); BIAS_GEN4(X, B, dg_); } PIN(X); } SBAR(); } while (0)
#else
#define GAPC(MF, G, X, B, E0) do { MF; if (G) { BIAS_FAST4(X, B, dcn_); if (__builtin_expect(!fastb_, 0)) { float dg_ = dcn_ - 8.0f; BIAS_GEN4(X, B, dg_); } PIN(X); } SBAR(); } while (0)
#endif
#define VRD(i) do { vf[i] = *(const ALAS bf16x8*)(vp_ + ((i) & 3) * (DV * 32) + ((i) >> 2) * 512); } while (0)
#define VRDN(i, d) do { vf[i] = *(const ALAS bf16x8*)(vp_ + (i) * (DV * 32) + (d) * 512); } while (0)
#define VRDA(i) do { vf[i] = *(const ALAS bf16x8*)(vp_ + (i) * (DV * 32) + 512); } while (0)
#define VRD2(i) do { vf[i] = *(const ALAS bf16x8*)(vp_ + ((i) & 3) * (DV * 32) + (((i) >> 2) + 2) * 512); } while (0)
#define KRD(G, j) do { if (G) { KLOAD2(kn_, j); SBAR(); } } while (0)
#define KRD1(G, j) do { if (G) { kf[j] = *(const ALAS bf16x8*)(kn_ + ((j) >> 1) * 2048 + ((j) & 1) * 512); SBAR(); } } while (0)
#define CIN(C) (ISB ? C : negm)
#define STEP(C0, C1, P0, P1, i, GK, GV, GL) do { SBAR(); \
    const ALAS char* vp_ = vp0 + vs_prev; const ALAS char* kn_ = kp0 + ks_next; float dcn_ = dl0 + 64.f * (float)((i) + 1); const int kt_ = 64 * (t0 + (i) + 1); const bool above_ = kt_ > qw_hi, fastb_ = above_ || (kt_ + 63 < qw_lo); \
    const float sc1_ = above_ ? nc2 : c2, sc2_ = sc1_ + sc1_, sc3_ = sc2_ + sc1_; BIAS_STEP_SETUP(); \
    VRD(0); SBAR(); float sacc = P0[0] + P0[1]; \
    GAPA(C0 = ATT_MFMA(kf[0], qr[0], CIN(C0)), P0[2], P0[3], P0[4], P0[5],     pw0[0] = PKW(P0, 0), pw0[1] = PKW(P0, 2), pw0); \
    SBAR(); GAPA(C1 = ATT_MFMA(kf[1], qr[0], CIN(C1)), P0[6], P0[7], P0[8], P0[9],     pw0[2] = PKW(P0, 4), pw0[3] = PKW(P0, 6), pw0); \
    VRD(1); SBAR(); GAPA(C0 = ATT_MFMA(kf[2], qr[1], C0),   P0[10], P0[11], P0[12], P0[13], pw1[0] = PKW(P0, 8), pw1[1] = PKW(P0, 10), pw1); \
    SBAR(); GAPA(C1 = ATT_MFMA(kf[3], qr[1], C1),   P0[14], P0[15], P1[0], P1[1],   pw1[2] = PKW(P0, 12), pw1[3] = PKW(P0, 14), pw1); \
    VRD(2); SBAR(); GAPA(C0 = ATT_MFMA(kf[4], qr[2], C0),   P1[2], P1[3], P1[4], P1[5],     pw2[0] = PKW(P1, 0), pw2[1] = PKW(P1, 2), pw2); \
    SBAR(); GAPA(C1 = ATT_MFMA(kf[5], qr[2], C1),   P1[6], P1[7], P1[8], P1[9],     pw2[2] = PKW(P1, 4), pw2[3] = PKW(P1, 6), pw2); \
    VRD(3); SBAR(); GAPA(C0 = ATT_MFMA(kf[6], qr[3], C0),   P1[10], P1[11], P1[12], P1[13], pw3[0] = PKW(P1, 8), pw3[1] = PKW(P1, 10), pw3); \
    SBAR(); GAPA(C1 = ATT_MFMA(kf[7], qr[3], C1),   P1[14], P1[15], 0.f, 0.f,       pw3[2] = PKW(P1, 12), pw3[3] = PKW(P1, 14), pw3); \
    l_reg += sacc; \
    if (BDMA_MODE < 4) { if (GK) { DMA_K((i) + 3, ks_cur); } } if (BDMA_MODE == 0 || BDMA_MODE == 4) { if (GV) { DMA_V((i) + 2, vs_n2); } } \
    SBAR(); \
    if (!ISB) { \
        GAPX(o[0] = ATT_MFMA(PAF(0), vf[0], o[0]), C0[0] = EX(C0[0]); C0[1] = EX(C0[1]); C0[2] = EX(C0[2]), C0); \
        VRDA(0); SBAR(); GAPX(o[0] = ATT_MFMA(PAF(1), vf[1], o[0]), C0[3] = EX(C0[3]); C0[4] = EX(C0[4]); C0[5] = EX(C0[5]), C0); \
        VRDA(1); SBAR(); GAPX(osum = ATT_MFMA(PAF(0), ones, osum),  C0[6] = EX(C0[6]); C0[7] = EX(C0[7]); C0[8] = EX(C0[8]), C0); \
        GAPX(o[0] = ATT_MFMA(PAF(2), vf[2], o[0]), C0[9] = EX(C0[9]); C0[10] = EX(C0[10]); C0[11] = EX(C0[11]), C0); \
        VRDA(2); SBAR(); GAPX(o[0] = ATT_MFMA(PAF(3), vf[3], o[0]), C0[12] = EX(C0[12]); C0[13] = EX(C0[13]); C0[14] = EX(C0[14]), C0); \
        VRDA(3); SBAR(); GAPX(osum = ATT_MFMA(PAF(1), ones, osum),  C0[15] = EX(C0[15]); C1[0] = EX(C1[0]); C1[1] = EX(C1[1]), C1); PIN(C0); \
        KRD(GL, 0); GAPX(o[1] = ATT_MFMA(PAF(0), vf[0], o[1]), C1[2] = EX(C1[2]); C1[3] = EX(C1[3]); C1[4] = EX(C1[4]), C1); \
        KRD(GL, 1); GAPX(o[1] = ATT_MFMA(PAF(1), vf[1], o[1]), C1[5] = EX(C1[5]); C1[6] = EX(C1[6]); C1[7] = EX(C1[7]), C1); \
        KRD(GL, 2); GAPX(osum = ATT_MFMA(PAF(2), ones, osum),  C1[8] = EX(C1[8]); C1[9] = EX(C1[9]); C1[10] = EX(C1[10]), C1); \
        KRD(GL, 3); GAPX(o[1] = ATT_MFMA(PAF(2), vf[2], o[1]), C1[11] = EX(C1[11]); C1[12] = EX(C1[12]), C1); \
        GAPX(o[1] = ATT_MFMA(PAF(3), vf[3], o[1]), C1[13] = EX(C1[13]); C1[14] = EX(C1[14]), C1); \
        GAPX(osum = ATT_MFMA(PAF(3), ones, osum),  C1[15] = EX(C1[15]), C1); \
    } else { \
        GAPEN(o[0] = ATT_MFMA(PAF(0), vf[0], o[0]), C0, C1, 0, 3);  VRDN(0, 1); KRD1(GL, 0); SBAR(); \
        GAPEN(o[0] = ATT_MFMA(PAF(1), vf[1], o[0]), C0, C1, 3, 2);  VRDN(1, 1); KRD1(GL, 1); SBAR(); \
        GAPEN(o[0] = ATT_MFMA(PAF(2), vf[2], o[0]), C0, C1, 5, 3);  VRDN(2, 1); KRD1(GL, 2); SBAR(); \
        GAPEN(o[0] = ATT_MFMA(PAF(3), vf[3], o[0]), C0, C1, 8, 2);  VRDN(3, 1); KRD1(GL, 3); SBAR(); \
        if (BDMA_MODE == 2) { if (GV) { DMA_V((i) + 2, vs_n2); } SBAR(); } \
        GAPEN(o[1] = ATT_MFMA(PAF(0), vf[0], o[1]), C0, C1, 10, 3); VRDN(0, 2); KRD1(GL, 4); SBAR(); \
        GAPEN(o[1] = ATT_MFMA(PAF(1), vf[1], o[1]), C0, C1, 13, 2); VRDN(1, 2); KRD1(GL, 5); SBAR(); \
        GAPEN(o[1] = ATT_MFMA(PAF(2), vf[2], o[1]), C0, C1, 15, 3); VRDN(2, 2); KRD1(GL, 6); SBAR(); \
        GAPEN(o[1] = ATT_MFMA(PAF(3), vf[3], o[1]), C0, C1, 18, 2); VRDN(3, 2); KRD1(GL, 7); SBAR(); \
        if (BDMA_MODE == 1 || BDMA_MODE == 5) { if (GV) { DMA_V((i) + 2, vs_n2); } SBAR(); } if (BDMA_MODE == 4 || BDMA_MODE == 5) { if (GK) { DMA_K((i) + 3, ks_cur); } SBAR(); } \
        GAPC(o[ND0 - 2] = ATT_MFMA(PAF(0), vf[0], o[ND0 - 2]); EXN(C0, C1, 20, 2), GL, P0, 0, 0);  VRDN(0, 3); SBAR(); \
        GAPC(o[ND0 - 2] = ATT_MFMA(PAF(1), vf[1], o[ND0 - 2]); EXN(C0, C1, 22, 1), GL, P0, 4, 0);  VRDN(1, 3); SBAR(); \
        GAPC(o[ND0 - 2] = ATT_MFMA(PAF(2), vf[2], o[ND0 - 2]); EXN(C0, C1, 23, 2), GL, P0, 8, 0);  VRDN(2, 3); SBAR(); \
        GAPC(o[ND0 - 2] = ATT_MFMA(PAF(3), vf[3], o[ND0 - 2]); EXN(C0, C1, 25, 1), GL, P0, 12, 0); VRDN(3, 3); SBAR(); \
        GAPC(o[ND0 - 1] = ATT_MFMA(PAF(0), vf[0], o[ND0 - 1]); EXN(C0, C1, 26, 2), GL, P1, 0, 16); \
        GAPC(o[ND0 - 1] = ATT_MFMA(PAF(1), vf[1], o[ND0 - 1]); EXN(C0, C1, 28, 1), GL, P1, 4, 16); \
        GAPC(o[ND0 - 1] = ATT_MFMA(PAF(2), vf[2], o[ND0 - 1]); EXN(C0, C1, 29, 2), GL, P1, 8, 16); \
        GAPC(o[ND0 - 1] = ATT_MFMA(PAF(3), vf[3], o[ND0 - 1]); EXN(C0, C1, 31, 1); PIN(C1), GL, P1, 12, 16); \
        if (BDMA_MODE == 3) { if (GV) { DMA_V((i) + 2, vs_n2); } SBAR(); } \
    } } while (0)
    int i = 1;
    for (; i + 5 < n; i += 2) {
        STEP(pB0, pB1, pA0, pA1, i, true, true, true);     WB_SEL(NK + 2 * NV); ROT();
        STEP(pA0, pA1, pB0, pB1, i + 1, true, true, true); WB_SEL(NK + 2 * NV); ROT();
    }
#define ENDW(ii) do { if ((ii) + 3 < n) { WB_SEL(NK + 2 * NV); } else if ((ii) + 2 < n) { WB_SEL(2 * NV); } else { WB_SEL(0); } } while (0)
    for (; i + 1 < n; i += 2) {
        STEP(pB0, pB1, pA0, pA1, i, (i + 3 < n), (i + 2 < n), (i + 1 < n));         ENDW(i);     ROT();
        STEP(pA0, pA1, pB0, pB1, i + 1, (i + 4 < n), (i + 3 < n), (i + 2 < n));     ENDW(i + 1); ROT();
    }
    STEP(pB0, pB1, pA0, pA1, n - 1, false, false, false);
    { if (ISB) { float sacc = pB0[0] + pB0[1];
#pragma unroll
      for (int r = 2; r < 16; ++r) sacc += pB0[r];
#pragma unroll
      for (int r = 0; r < 16; ++r) sacc += pB1[r];
      l_reg += sacc; }
      pw0 = (u32x4){PKW(pB0, 0), PKW(pB0, 2), PKW(pB0, 4), PKW(pB0, 6)}; pw1 = (u32x4){PKW(pB0, 8), PKW(pB0, 10), PKW(pB0, 12), PKW(pB0, 14)};
      pw2 = (u32x4){PKW(pB1, 0), PKW(pB1, 2), PKW(pB1, 4), PKW(pB1, 6)}; pw3 = (u32x4){PKW(pB1, 8), PKW(pB1, 10), PKW(pB1, 12), PKW(pB1, 14)};
      SBAR();
      const ALAS char* vp_ = vp0 + vs_cur;
#pragma unroll
      for (int d = 0; d < ND0; ++d) {
          const bf16x8 v0 = *(const ALAS bf16x8*)(vp_ + 0 * (DV * 32) + d * 512), v1 = *(const ALAS bf16x8*)(vp_ + 1 * (DV * 32) + d * 512), v2 = *(const ALAS bf16x8*)(vp_ + 2 * (DV * 32) + d * 512), v3 = *(const ALAS bf16x8*)(vp_ + 3 * (DV * 32) + d * 512);
          o[d] = ATT_MFMA(PAF(0), v0, o[d]); o[d] = ATT_MFMA(PAF(1), v1, o[d]); o[d] = ATT_MFMA(PAF(2), v2, o[d]); o[d] = ATT_MFMA(PAF(3), v3, o[d]); }
      if (!ISB) { osum = ATT_MFMA(PAF(0), ones, osum); osum = ATT_MFMA(PAF(1), ones, osum); osum = ATT_MFMA(PAF(2), ones, osum); osum = ATT_MFMA(PAF(3), ones, osum); } }
    const float sacc = l_reg;
    const int lane_e = lane_id_v();
    ATT_WAIT_BAR(0);
    {
    const int lane = lane_e, r32 = lane & 31, hi = lane >> 5; const int q0 = ISB ? qb * 128 : qb * 256;
    float rli[16];
    ALAS float* wsf = (ALAS float*)(shm3 + WSF_OFF) + wid * 64;
    if (ISB) {
        const float l = sum_x32(sacc);
        if (hi == 0) wsf[r32] = l;
        asm volatile("s_waitcnt lgkmcnt(0)" ::: "memory");
#pragma unroll
        for (int r = 0; r < 16; ++r) rli[r] = __builtin_amdgcn_rcpf(wsf[crow(r, hi)]);
    } else {
#pragma unroll
        for (int r = 0; r < 16; ++r) rli[r] = __builtin_amdgcn_rcpf(osum[r]);
    }
    if (!ISB) {
        ALAS bf16_t* stg = (ALAS bf16_t*)shm3 + wid * 2048;
#pragma unroll
        for (int r = 0; r < 16; ++r) { const int orow = crow(r, hi);
#pragma unroll
            for (int d = 0; d < ND0; ++d) stg[orow * 64 + d * 32 + r32] = pg8::f2bf1(o[d][r] * rli[r]); }
        asm volatile("s_waitcnt lgkmcnt(0)" ::: "memory");
#pragma unroll
        for (int i = 0; i < 4; ++i) { const int row = i * 8 + (lane >> 3), ch = lane & 7; const u32x4 v = *(const ALAS u32x4*)(stg + row * 64 + ch * 8);
            *(u32x4*)(T_MIX + (size_t)(q0 + wid * 32 + row) * 1024 + head * 64 + ch * 8) = v; }
    } else {
        ALAS float* X = (ALAS float*)shm3 + wq * 4096;
        const float sc = (mapc == 1) ? lam : 1.0f;
        if (mapc == 1) {
#pragma unroll
            for (int r = 0; r < 16; ++r) { const int orow = crow(r, hi); const float f = rli[r] * sc;
#pragma unroll
                for (int d = 0; d < ND0; ++d) X[orow * 128 + d * 32 + r32] = o[d][r] * f; }
        }
        asm volatile("s_waitcnt lgkmcnt(0)\n\ts_barrier" ::: "memory");
        if (mapc == 0) {
#pragma unroll
            for (int r = 0; r < 16; ++r) { const int orow = crow(r, hi);
#pragma unroll
                for (int d = 0; d < ND0; ++d) { const int idx = orow * 128 + d * 32 + r32; X[idx] = o[d][r] * rli[r] - X[idx]; } }
            asm volatile("s_waitcnt lgkmcnt(0)" ::: "memory");
            const int qq = lane >> 1, hf = lane & 1;
            const ALAS float* rowp = X + qq * 128 + hf * 64;
            f32x4 vv[16]; float ss = 0.f;
#pragma unroll
            for (int i = 0; i < 16; ++i) { vv[i] = *(const ALAS f32x4*)(rowp + 4 * i); ss += (vv[i][0] * vv[i][0] + vv[i][1] * vv[i][1]) + (vv[i][2] * vv[i][2] + vv[i][3] * vv[i][3]); }
            ss += xor_lane<1>(ss);
            const float rs = 0.8f / sqrtf(ss * (1.0f / 128.0f) + 1e-6f);
            bf16_t* dst = T_MIX + (size_t)(q0 + wq * 32 + qq) * 1024 + 512 + head * 128 + hf * 64;
            const ALAS float* sl = T.subln + hf * 64;
#pragma unroll
            for (int i = 0; i < 8; ++i) { const f32x4 g0 = *(const ALAS f32x4*)(sl + 8 * i), g1 = *(const ALAS f32x4*)(sl + 8 * i + 4); const f32x4 a = vv[2 * i] * rs * g0, b = vv[2 * i + 1] * rs * g1;
                u32x4 w; w.x = cvtpk(a[0], a[1]); w.y = cvtpk(a[2], a[3]); w.z = cvtpk(b[0], b[1]); w.w = cvtpk(b[2], b[3]); *(u32x4*)(dst + 8 * i) = w; }
        }
    }
    }
    asm volatile("s_waitcnt lgkmcnt(0)\n\ts_barrier" ::: "memory");
#undef DMA_K
#undef DMA_V
#undef ROT
#undef STEP
#undef ENDW
#undef GAPA
#undef GAPB
#undef GAPC
#undef GAPE3
#undef GAPEN
#undef EXN
#undef EXE
#undef GAPX
#undef VRD
#undef VRD2
#undef VRDA
#undef VRDN
#undef KRD
#undef KRD1
#undef CIN
#undef PAF
#undef KLOAD2
#undef BIAS_GEN4
#undef BIAS_FAST4
#undef BIAS_ALL
#undef BIAS_STEP_SETUP
}

typedef int i32x8 __attribute__((ext_vector_type(8)));
typedef unsigned u32x8 __attribute__((ext_vector_type(8)));
#define MFMA8(a, b, c) __builtin_amdgcn_mfma_scale_f32_32x32x64_f8f6f4(a, b, c, 0, 0, 0, 0, 0, 0)
__device__ __forceinline__ void attn_unit_a8(const Tensors& T, int head, int qb, float negM2s, char* shm, int wave_id) {
    unsigned char* tws_ = T.ws; LAUNDER_G(tws_);
    constexpr int KSLOT = 4096, VSLOT = 4096, LDS_K = 0, LDS_V = 3 * KSLOT, n = 256;
    int tid_ = wave_id * 64 + lane_id_v(); asm volatile("" : "+v"(tid_));
    const int tid = tid_, lane = tid & 63, r32 = lane & 31, hi = lane >> 5; const int wid = __builtin_amdgcn_readfirstlane(tid >> 6);
    const int q0 = qb * 256; const int qrow = q0 + wid * 32 + r32;
    const unsigned lds0 = (unsigned)(uintptr_t)shm;
    const ALAS char* shm3 = (const ALAS char*)shm;
    const bool kw = wid < 4;
    const char* sb = (const char*)(tws_ + (kw ? WS_KA : WS_VA)) + (size_t)(head >> 2) * MROWS * 64 + (wid & 3) * 1024;
    const unsigned dvo = (unsigned)(lane * 16);
    const unsigned ddst = lds0 + (kw ? LDS_K : LDS_V) + (wid & 3) * 1024;
#define DMA8(i, so) glds16s(sb + (size_t)(i) * 4096, dvo, (unsigned)__builtin_amdgcn_readfirstlane(ddst + (so)))
#define WB8(NKW, NVW) do { if (kw) { WB_SEL(NKW); } else { WB_SEL(NVW); } } while (0)
    if (kw) { DMA8(0, 0); DMA8(1, KSLOT); DMA8(2, 2 * KSLOT); } else { DMA8(0, 0); DMA8(1, VSLOT); }
    const unsigned char* Qw = (tws_ + WS_QA) + ((size_t)head * MROWS + qrow) * 64 + hi * 32;
    i32x8 qf; { const u32x4 a_ = *(const u32x4*)Qw, b_ = *(const u32x4*)(Qw + 16); qf = (i32x8){(int)a_[0], (int)a_[1], (int)a_[2], (int)a_[3], (int)b_[0], (int)b_[1], (int)b_[2], (int)b_[3]}; }
    f32x16 o0 = f32x16{}, o1 = f32x16{}, osum = f32x16{};
    f32x16 negm;
#pragma unroll
    for (int r = 0; r < 16; ++r) negm[r] = negM2s;
    asm volatile("" : "+v"(negm));
    i32x8 ones; { const int o4 = 0x38383838; ones = (i32x8){o4, o4, o4, o4, o4, o4, o4, o4}; } asm volatile("" : "+v"(ones));
    const ALAS char* kp0 = shm3 + LDS_K + hi * 1024 + r32 * 16;
    const ALAS char* vp0 = shm3 + LDS_V + hi * 1024 + r32 * 16;
    f32x16 pA0, pA1, pB0, pB1;
    i32x8 kf0, kf1, vf0, vf1, pf = (i32x8){0, 0, 0, 0, 0, 0, 0, 0};
    int ks_prev = 0, ks_cur = 0, ks_next = KSLOT, vs_prev = 0, vs_cur = VSLOT, vs_next = 2 * VSLOT, vs_n2 = 3 * VSLOT;
#define ROTK8() do { ks_prev = ks_cur; ks_cur = ks_next; ks_next = (ks_next == 2 * KSLOT) ? 0 : ks_next + KSLOT; } while (0)
#define ROT8() do { ROTK8(); const int tv_ = vs_prev; vs_prev = vs_cur; vs_cur = vs_next; vs_next = vs_n2; vs_n2 = tv_; } while (0)
#define LD32(dst, p) do { const u32x4 a_ = *(const ALAS u32x4*)(p), b_ = *(const ALAS u32x4*)((p) + 512); dst = (i32x8){(int)a_[0], (int)a_[1], (int)a_[2], (int)a_[3], (int)b_[0], (int)b_[1], (int)b_[2], (int)b_[3]}; } while (0)
#define PK8(P, B, OLD) __builtin_amdgcn_cvt_pk_fp8_f32(P[(B) + 2], P[(B) + 3], __builtin_amdgcn_cvt_pk_fp8_f32(P[B], P[(B) + 1], OLD, false), true)
    WB8(2, 2);
    { LD32(kf0, kp0); LD32(kf1, kp0 + 2048);
      pA0 = MFMA8(kf0, qf, negm); pA1 = MFMA8(kf1, qf, negm);
#pragma unroll
      for (int r = 0; r < 16; ++r) { pA0[r] = EX(pA0[r]); pA1[r] = EX(pA1[r]); } }
    WB_SEL(0);
    if (kw) { DMA8(3, 0); } else { DMA8(2, 2 * VSLOT); }
    ROTK8();
    { const ALAS char* kb_ = kp0 + ks_cur; LD32(kf0, kb_); LD32(kf1, kb_ + 2048); }
    WB_SEL(1);
#define STEP8(C0, C1, P0, P1, i, GK, GV, GL) do { SBAR(); \
    const ALAS char* vp_ = vp0 + vs_prev; const ALAS char* kn_ = kp0 + ks_next; \
    LD32(vf0, vp_); LD32(vf1, vp_ + 2048); SBAR(); \
    C0 = MFMA8(kf0, qf, negm); \
    pf[0] = PK8(P0, 0, pf[0]); pf[1] = PK8(P0, 4, pf[1]); pf[2] = PK8(P0, 8, pf[2]); pf[3] = PK8(P0, 12, pf[3]); PIN(pf); SBAR(); \
    C1 = MFMA8(kf1, qf, negm); \
    pf[4] = PK8(P1, 0, pf[4]); pf[5] = PK8(P1, 4, pf[5]); pf[6] = PK8(P1, 8, pf[6]); pf[7] = PK8(P1, 12, pf[7]); PIN(pf); SBAR(); \
    if (kw) { if (GK) { DMA8((i) + 3, ks_cur); } } else { if (GV) { DMA8((i) + 2, vs_n2); } } \
    SBAR(); \
    o0 = MFMA8(pf, vf0, o0); \
    _Pragma("unroll") for (int r_ = 0; r_ < 16; ++r_) C0[r_] = EX(C0[r_]); PIN(C0); SBAR(); \
    if (GL) { LD32(kf0, kn_); LD32(kf1, kn_ + 2048); SBAR(); } \
    o1 = MFMA8(pf, vf1, o1); \
    _Pragma("unroll") for (int r_ = 0; r_ < 8; ++r_) C1[r_] = EX(C1[r_]); PIN(C1); SBAR(); \
    osum = MFMA8(pf, ones, osum); \
    _Pragma("unroll") for (int r_ = 8; r_ < 16; ++r_) C1[r_] = EX(C1[r_]); PIN(C1); SBAR(); \
    } while (0)
    int i = 1;
    for (; i + 5 < n; i += 2) {
        STEP8(pB0, pB1, pA0, pA1, i, true, true, true);     WB8(1, 2); ROT8();
        STEP8(pA0, pA1, pB0, pB1, i + 1, true, true, true); WB8(1, 2); ROT8();
    }
#define ENDW8(ii) do { if ((ii) + 3 < n) { WB8(1, 2); } else if ((ii) + 2 < n) { WB8(0, 2); } else { WB_SEL(0); } } while (0)
    for (; i + 1 < n; i += 2) {
        STEP8(pB0, pB1, pA0, pA1, i, (i + 3 < n), (i + 2 < n), (i + 1 < n));         ENDW8(i);     ROT8();
        STEP8(pA0, pA1, pB0, pB1, i + 1, (i + 4 < n), (i + 3 < n), (i + 2 < n));     ENDW8(i + 1); ROT8();
    }
    STEP8(pB0, pB1, pA0, pA1, n - 1, false, false, false);
    { pf[0] = PK8(pB0, 0, pf[0]); pf[1] = PK8(pB0, 4, pf[1]); pf[2] = PK8(pB0, 8, pf[2]); pf[3] = PK8(pB0, 12, pf[3]); pf[4] = PK8(pB1, 0, pf[4]); pf[5] = PK8(pB1, 4, pf[5]); pf[6] = PK8(pB1, 8, pf[6]); pf[7] = PK8(pB1, 12, pf[7]);
      const ALAS char* vp_ = vp0 + vs_cur; LD32(vf0, vp_); LD32(vf1, vp_ + 2048);
      o0 = MFMA8(pf, vf0, o0); o1 = MFMA8(pf, vf1, o1); osum = MFMA8(pf, ones, osum); }
    ATT_WAIT_BAR(0);
    {
        const int lane_e = lane_id_v(), l32 = lane_e & 31, hh = lane_e >> 5;
        ALAS bf16_t* stg = (ALAS bf16_t*)shm3 + wid * 2048;
#pragma unroll
        for (int r = 0; r < 16; ++r) { const int orow = crow(r, hh); const float rl = __builtin_amdgcn_rcpf(osum[r]);
            stg[orow * 64 + l32] = pg8::f2bf1(o0[r] * rl); stg[orow * 64 + 32 + l32] = pg8::f2bf1(o1[r] * rl); }
        asm volatile("s_waitcnt lgkmcnt(0)" ::: "memory");
#pragma unroll
        for (int i2 = 0; i2 < 4; ++i2) { const int row = i2 * 8 + (lane_e >> 3), ch = lane_e & 7; const u32x4 v = *(const ALAS u32x4*)(stg + row * 64 + ch * 8);
            *(u32x4*)(T_MIX + (size_t)(qb * 256 + wid * 32 + row) * 1024 + head * 64 + ch * 8) = v; }
    }
    asm volatile("s_waitcnt lgkmcnt(0)\n\ts_barrier" ::: "memory");
#undef DMA8
#undef EXPR
#undef PACKH0
#undef PACKH1
#undef ROWSUM_A
#undef ROWSUM_B
#undef EXPBLK
#undef PACK8
#undef WB8
#undef ROTK8
#undef ROT8
#undef LD32
#undef PK8
#undef STEP8
#undef ENDW8
}

typedef short v2i16_t __attribute__((ext_vector_type(2)));
template<int U, int PROBE = 0>
__device__ __forceinline__ void attn_unit_a8x2(const Tensors& T, int head, int qb, float negM2s, char* shm, int wave_id) {
    unsigned char* tws_ = T.ws; LAUNDER_G(tws_);
    constexpr int KSLOT = 4096, VSLOT = 4096, RS = 3 * U * 4096, LDS_K = 0, LDS_V = RS, n = 256;
    int tid_ = wave_id * 64 + lane_id_v(); asm volatile("" : "+v"(tid_));
    const int tid = tid_, lane = tid & 63, r32 = lane & 31, hi = lane >> 5; const int wid = __builtin_amdgcn_readfirstlane(tid >> 6);
    const int q0 = qb * 512; const int qrow = q0 + wid * 64 + r32;
    const unsigned lds0 = (unsigned)(uintptr_t)shm;
    const ALAS char* shm3 = (const ALAS char*)shm;
    const bool kw = wid < 4;
    const char* sb = (const char*)(tws_ + (kw ? WS_KA : WS_VA)) + (size_t)(head >> 2) * MROWS * 64 + (wid & 3) * 1024;
    const unsigned dvo = (unsigned)(lane * 16);
    const unsigned ddst = lds0 + (kw ? LDS_K : LDS_V) + (wid & 3) * 1024;
#define DMA8(i, so) glds16s(sb + (size_t)(i) * 4096, dvo, (unsigned)__builtin_amdgcn_readfirstlane(ddst + (so)))
#pragma unroll
    for (int i0 = 0; i0 < 2 * U; ++i0) DMA8(i0, i0 * 4096);
    if (kw) DMA8(2 * U, 2 * U * 4096);
    const unsigned char* Qw = (tws_ + WS_QA) + ((size_t)head * MROWS + qrow) * 64 + hi * 32;
    i32x8 qfa, qfb;
    { const u32x4 a_ = *(const u32x4*)Qw, b_ = *(const u32x4*)(Qw + 16); qfa = (i32x8){(int)a_[0], (int)a_[1], (int)a_[2], (int)a_[3], (int)b_[0], (int)b_[1], (int)b_[2], (int)b_[3]}; }
    { const u32x4 a_ = *(const u32x4*)(Qw + 32 * 64), b_ = *(const u32x4*)(Qw + 32 * 64 + 16); qfb = (i32x8){(int)a_[0], (int)a_[1], (int)a_[2], (int)a_[3], (int)b_[0], (int)b_[1], (int)b_[2], (int)b_[3]}; }
#if A8_SUM16
    f32x16 oa0 = f32x16{}, oa1 = f32x16{}, ob0 = f32x16{}, ob1 = f32x16{};
    f32x4 sa4 = f32x4{}, sb4 = f32x4{};
#if A8_SUM16 == 2
    f32x16 osa = f32x16{};
#endif
#else
    f32x16 oa0 = f32x16{}, oa1 = f32x16{}, osa = f32x16{}, ob0 = f32x16{}, ob1 = f32x16{}, osb = f32x16{};
#endif
#if A8_SUM16 == 2
    const f32x16 negm = f32x16{};
#else
    f32x16 negm;
#pragma unroll
    for (int r = 0; r < 16; ++r) negm[r] = negM2s;
    asm volatile("" : "+v"(negm));
#endif
#if A8_SUM16
    i32x8 ind; { const int o4 = (((lane >> 4) & 1) == ((lane & 15) >> 3)) ? 0x38383838 : 0; ind = (i32x8){o4, o4, o4, o4, o4, o4, o4, o4}; } asm volatile("" : "+v"(ind));
#if A8_SUM16 == 2
    i32x8 ones; { const int o4 = 0x38383838; ones = (i32x8){o4, o4, o4, o4, o4, o4, o4, o4}; } asm volatile("" : "+v"(ones));
#endif
#else
    i32x8 ones; { const int o4 = 0x38383838; ones = (i32x8){o4, o4, o4, o4, o4, o4, o4, o4}; } asm volatile("" : "+v"(ones));
#endif
    const ALAS char* kp0 = shm3 + LDS_K + hi * 1024 + r32 * 16;
    const ALAS char* vp0 = shm3 + LDS_V + hi * 1024 + r32 * 16;
    f32x16 Ca0, Ca1, Cb0, Cb1;
#ifdef A8_EXPH
#define EXPBLK(H, C, b) do { const unsigned h0_ = __builtin_bit_cast(unsigned, __builtin_amdgcn_cvt_pkrtz(C[b], C[(b) + 1])), h1_ = __builtin_bit_cast(unsigned, __builtin_amdgcn_cvt_pkrtz(C[(b) + 2], C[(b) + 3])), \
        h2_ = __builtin_bit_cast(unsigned, __builtin_amdgcn_cvt_pkrtz(C[(b) + 4], C[(b) + 5])), h3_ = __builtin_bit_cast(unsigned, __builtin_amdgcn_cvt_pkrtz(C[(b) + 6], C[(b) + 7])); unsigned d0_, d1_, d2_, d3_; \
        asm volatile("v_exp_f16_e32 %0, %4\n\tv_exp_f16_e32 %1, %5\n\tv_exp_f16_e32 %2, %6\n\tv_exp_f16_e32 %3, %7\n\t" \
                     "v_exp_f16_sdwa %0, %4 dst_sel:WORD_1 dst_unused:UNUSED_PRESERVE src0_sel:WORD_1\n\tv_exp_f16_sdwa %1, %5 dst_sel:WORD_1 dst_unused:UNUSED_PRESERVE src0_sel:WORD_1\n\t" \
                     "v_exp_f16_sdwa %2, %6 dst_sel:WORD_1 dst_unused:UNUSED_PRESERVE src0_sel:WORD_1\n\tv_exp_f16_sdwa %3, %7 dst_sel:WORD_1 dst_unused:UNUSED_PRESERVE src0_sel:WORD_1" \
                     : "=&v"(d0_), "=&v"(d1_), "=&v"(d2_), "=&v"(d3_) : "v"(h0_), "v"(h1_), "v"(h2_), "v"(h3_)); \
        C[(b) / 2] = __builtin_bit_cast(float, d0_); C[(b) / 2 + 1] = __builtin_bit_cast(float, d1_); C[(b) / 2 + 2] = __builtin_bit_cast(float, d2_); C[(b) / 2 + 3] = __builtin_bit_cast(float, d3_); PIN(C); } while (0)
#define PKH(C, j) (int)__builtin_amdgcn_perm(__builtin_bit_cast(unsigned, C[2 * (j) + 1]), __builtin_bit_cast(unsigned, C[2 * (j)]), 0x07050301u)
#define PACK8(H0, H1, C0, C1) do { pf[0] = PKH(C0, 0); pf[1] = PKH(C0, 1); pf[2] = PKH(C0, 2); pf[3] = PKH(C0, 3); pf[4] = PKH(C1, 0); pf[5] = PKH(C1, 1); pf[6] = PKH(C1, 2); pf[7] = PKH(C1, 3); PIN(pf); } while (0)
#else
#define EXPBLK(H, C, b) do { _Pragma("unroll") for (int r_ = (b); r_ < (b) + 8; ++r_) C[r_] = ((PROBE & 1) ? __builtin_fmaxf(C[r_], 1.0f) : EX(C[r_])); PIN(C); } while (0)
#define PACK8(H0, H1, C0, C1) do { pf[0] = PK8(C0, 0, pf[0]); pf[1] = PK8(C0, 4, pf[1]); pf[2] = PK8(C0, 8, pf[2]); pf[3] = PK8(C0, 12, pf[3]); pf[4] = PK8(C1, 0, pf[4]); pf[5] = PK8(C1, 4, pf[5]); pf[6] = PK8(C1, 8, pf[6]); pf[7] = PK8(C1, 12, pf[7]); PIN(pf); } while (0)
#endif
    i32x8 kf0, kf1, vf0, vf1, pf = (i32x8){0, 0, 0, 0, 0, 0, 0, 0};
#define LD32(dst, p) do { const u32x4 a_ = *(const ALAS u32x4*)(p), b_ = *(const ALAS u32x4*)((p) + 512); dst = (i32x8){(int)a_[0], (int)a_[1], (int)a_[2], (int)a_[3], (int)b_[0], (int)b_[1], (int)b_[2], (int)b_[3]}; } while (0)
#ifdef A8_BF8
#define PK8(P, B, OLD) (int)__builtin_amdgcn_perm(__builtin_bit_cast(unsigned, __builtin_amdgcn_cvt_pkrtz(P[(B) + 2], P[(B) + 3])), __builtin_bit_cast(unsigned, __builtin_amdgcn_cvt_pkrtz(P[B], P[(B) + 1])), 0x07050301u)
#define MFMA8P(a, b, c) __builtin_amdgcn_mfma_scale_f32_32x32x64_f8f6f4(a, b, c, 1, 0, 0, 0, 0, 0)
#define MFMA16P(a, b, c) __builtin_amdgcn_mfma_scale_f32_16x16x128_f8f6f4(a, b, c, 1, 0, 0, 0, 0, 0)
#elif defined(A8_SCALECVT)
#define MFMA8P(a, b, c) MFMA8(a, b, c)
#define MFMA16P(a, b, c) __builtin_amdgcn_mfma_scale_f32_16x16x128_f8f6f4(a, b, c, 0, 0, 0, 0, 0, 0)
#define PK8(P, B, OLD) __builtin_bit_cast(int, __builtin_amdgcn_cvt_scalef32_pk_fp8_f32(__builtin_amdgcn_cvt_scalef32_pk_fp8_f32(__builtin_bit_cast(v2i16_t, (int)(OLD)), P[B], P[(B) + 1], 1.0f, false), P[(B) + 2], P[(B) + 3], 1.0f, true))
#else
#define MFMA8P(a, b, c) MFMA8(a, b, c)
#define MFMA16P(a, b, c) __builtin_amdgcn_mfma_scale_f32_16x16x128_f8f6f4(a, b, c, 0, 0, 0, 0, 0, 0)
#define PK8(P, B, OLD) __builtin_amdgcn_cvt_pk_fp8_f32(P[(B) + 2], P[(B) + 3], __builtin_amdgcn_cvt_pk_fp8_f32(P[B], P[(B) + 1], OLD, false), true)
#endif
    if (kw) { WB_SEL(U); } else { WB_SEL(U); }
    { LD32(kf0, kp0); LD32(kf1, kp0 + 2048);
      Ca0 = MFMA8(kf0, qfa, negm); Ca1 = MFMA8(kf1, qfa, negm); Cb0 = MFMA8(kf0, qfb, negm); Cb1 = MFMA8(kf1, qfb, negm);
      EXPBLK(Ha0, Ca0, 0); EXPBLK(Ha0, Ca0, 8); EXPBLK(Ha1, Ca1, 0); EXPBLK(Ha1, Ca1, 8); }
#define EXPR(C, lo, hi) do { _Pragma("unroll") for (int r_ = (lo); r_ < (hi); ++r_) C[r_] = EX(C[r_]); PIN(C); } while (0)
#define PACKH0(C0) do { pf[0] = PK8(C0, 0, pf[0]); pf[1] = PK8(C0, 4, pf[1]); pf[2] = PK8(C0, 8, pf[2]); pf[3] = PK8(C0, 12, pf[3]); PIN(pf); } while (0)
#define PACKH1(C1) do { pf[4] = PK8(C1, 0, pf[4]); pf[5] = PK8(C1, 4, pf[5]); pf[6] = PK8(C1, 8, pf[6]); pf[7] = PK8(C1, 12, pf[7]); PIN(pf); } while (0)
#if A8_SUM16
#define ROWSUM_A() sa4 = MFMA16P(pf, ind, sa4)
#define ROWSUM_B() sb4 = MFMA16P(pf, ind, sb4)
#else
#define ROWSUM_A() osa = MFMA8P(pf, ones, osa)
#define ROWSUM_B() osb = MFMA8P(pf, ones, osb)
#endif
#if A8_PIPE2
    PACKH0(Ca0); PACKH1(Ca1);
#endif
    asm volatile("s_waitcnt lgkmcnt(0)\n\ts_barrier" ::: "memory");
    int ks = 0, vs = 0;
    const int dslot = A8_DMASTAG ? ((wid + (kw ? 0 : 2)) & 3) : 3;
#define ADV(x, k) (((x) + (k) * 4096 >= RS) ? (x) + (k) * 4096 - RS : (x) + (k) * 4096)
    for (int t0 = 0; t0 < n; t0 += U) {
#pragma unroll
      for (int j = 0; j < U; ++j) {
        const int t = t0 + j;
        const bool GK = t + 1 + 2 * U < n, GV = t + 2 * U < n, GL = t + 1 < n;
        const int ksn = ADV(ks, 1);
        SBAR();
#if A8_PIPE2
        { const ALAS char* vp_ = vp0 + vs; LD32(vf0, vp_); LD32(vf1, vp_ + 2048); }
        if (GL) { const ALAS char* kn_ = kp0 + ksn; LD32(kf0, kn_); LD32(kf1, kn_ + 2048); } SBAR();
        oa0 = MFMA8P(pf, vf0, oa0); EXPR(Cb0, 0, 11); SBAR();
        oa1 = MFMA8P(pf, vf1, oa1); EXPR(Cb0, 11, 16); EXPR(Cb1, 0, 6); SBAR();
        ROWSUM_A(); EXPR(Cb1, 6, 16); SBAR();
        if (GL) { Ca0 = MFMA8(kf0, qfa, negm); } PACKH0(Cb0); SBAR();
        if (GL) { Ca1 = MFMA8(kf1, qfa, negm); } PACKH1(Cb1);
        if (kw) { if (GK) { DMA8(t + 1 + 2 * U, ADV(ks, 2 * U + 1)); } } else { if (GV) { DMA8(t + 2 * U, ADV(vs, 2 * U)); } }
        SBAR();
        ob0 = MFMA8P(pf, vf0, ob0); if (GL) { EXPR(Ca0, 0, 11); } SBAR();
        ob1 = MFMA8P(pf, vf1, ob1); if (GL) { EXPR(Ca0, 11, 16); EXPR(Ca1, 0, 6); } SBAR();
        ROWSUM_B(); if (GL) { EXPR(Ca1, 6, 16); } SBAR();
        if (GL) { Cb0 = MFMA8(kf0, qfb, negm); PACKH0(Ca0); } SBAR();
        if (GL) { Cb1 = MFMA8(kf1, qfb, negm); PACKH1(Ca1); } SBAR();
#else
        if (!(PROBE & 4)) if (!A8_VPREF || j == 0) { const ALAS char* vp_ = vp0 + vs; LD32(vf0, vp_); LD32(vf1, vp_ + 2048); }
        if (!(PROBE & 4)) if (GL) { const ALAS char* kn_ = kp0 + ksn; LD32(kf0, kn_); LD32(kf1, kn_ + 2048); } SBAR();
        if (!(PROBE & 8)) { PACK8(Ha0, Ha1, Ca0, Ca1); } SBAR();
#ifdef A8_EXPH_DUP
        {
#pragma unroll
          for (int r = 0; r < 16; ++r) { float x_ = Ca0[r], y_ = Ca1[r]; asm volatile("v_exp_f16_e32 %0, %0\n\tv_exp_f16_e32 %1, %1" : "+v"(x_), "+v"(y_)); Ca0[r] = x_; Ca1[r] = y_; }
          SBAR(); }
#endif
#ifdef A8_CVT_DUP
        { int d0_ = 0, d1_ = 0, d2_ = 0, d3_ = 0;
#pragma unroll
          for (int r = 0; r < 16; r += 4) { d0_ = PK8(Ca0, r, d0_); d1_ = PK8(Ca1, r, d1_); d2_ = PK8(Ca0, r, d2_); d3_ = PK8(Ca1, r, d3_); asm volatile("" : "+v"(d0_), "+v"(d1_), "+v"(d2_), "+v"(d3_)); }
          SBAR(); }
#endif
        if (!(PROBE & 32)) oa0 = MFMA8P(pf, vf0, oa0);
        EXPBLK(Hb0, Cb0, 0); SBAR();
        if (A8_DMASTAG && !(PROBE & 2) && dslot == 0) { { if (kw) { if (GK) { DMA8(t + 1 + 2 * U, ADV(ks, 2 * U + 1)); } } else { if (GV) { DMA8(t + 2 * U, ADV(vs, 2 * U)); } } } SBAR(); }
        if (!(PROBE & 32)) oa1 = MFMA8P(pf, vf1, oa1);
        EXPBLK(Hb0, Cb0, 8); SBAR();
        if (A8_DMASTAG && !(PROBE & 2) && dslot == 1) { { if (kw) { if (GK) { DMA8(t + 1 + 2 * U, ADV(ks, 2 * U + 1)); } } else { if (GV) { DMA8(t + 2 * U, ADV(vs, 2 * U)); } } } SBAR(); }
#if A8_SUM16
        if (!(PROBE & 32)) sa4 = MFMA16P(pf, ind, sa4);
#if A8_SUM16 == 2
        osa = MFMA8P(pf, ones, osa);
#endif
#else
        osa = MFMA8P(pf, ones, osa);
#endif
        EXPBLK(Hb1, Cb1, 0); SBAR();
        if (A8_DMASTAG && !(PROBE & 2) && dslot == 2) { { if (kw) { if (GK) { DMA8(t + 1 + 2 * U, ADV(ks, 2 * U + 1)); } } else { if (GV) { DMA8(t + 2 * U, ADV(vs, 2 * U)); } } } SBAR(); }
        if (GL && !(PROBE & 64)) { Ca0 = MFMA8(kf0, qfa, negm); }
        EXPBLK(Hb1, Cb1, 8); SBAR();
        if (GL && !(PROBE & 64)) { Ca1 = MFMA8(kf1, qfa, negm); }
        if (!(PROBE & 2) && (!A8_DMASTAG || dslot == 3)) { if (kw) { if (GK) { DMA8(t + 1 + 2 * U, ADV(ks, 2 * U + 1)); } } else { if (GV) { DMA8(t + 2 * U, ADV(vs, 2 * U)); } } }
        SBAR();
        if (!(PROBE & 8)) { PACK8(Hb0, Hb1, Cb0, Cb1); } SBAR();
        if (!(PROBE & 32)) ob0 = MFMA8P(pf, vf0, ob0);
        if (GL) {
            EXPBLK(Ha0, Ca0, 0); }
        SBAR();
        if (!(PROBE & 32)) ob1 = MFMA8P(pf, vf1, ob1);
        if (GL) {
            EXPBLK(Ha0, Ca0, 8); }
        SBAR();
        if (A8_VPREF && j < U - 1) { const ALAS char* vn_ = vp0 + ADV(vs, 1); LD32(vf0, vn_); LD32(vf1, vn_ + 2048); SBAR(); }
#if A8_SUM16
        if (!(PROBE & 32)) sb4 = MFMA16P(pf, ind, sb4);
#else
        osb = MFMA8P(pf, ones, osb);
#endif
        if (GL) {
            EXPBLK(Ha1, Ca1, 0); }
        SBAR();
        if (GL) { if (!(PROBE & 64)) Cb0 = MFMA8(kf0, qfb, negm);
            EXPBLK(Ha1, Ca1, 8); }
        SBAR();
        if (GL && !(PROBE & 64)) { Cb1 = MFMA8(kf1, qfb, negm); }
#endif
        if (j == U - 1 && !(PROBE & 16)) { if ((PROBE & 2) == 0 && (kw ? GK : GV)) { WB_SEL(U); } else { WB_SEL(0); }
#ifdef A8_LAG
            if (!kw) __builtin_amdgcn_s_sleep(A8_LAG);
#endif
        }
        ks = ksn; vs = ADV(vs, 1);
      }
    }
#undef ADV
    {
        const int lane_e = lane_id_v(), l32 = lane_e & 31, hh = lane_e >> 5;
        ALAS bf16_t* stg = (ALAS bf16_t*)shm3 + wid * 4096;
#if A8_SUM16
        ALAS float* ls = (ALAS float*)(shm3 + 65536) + wid * 64;
        if ((lane_e & 7) == 0) { const int q0_ = 16 * ((lane_e >> 3) & 1) + 4 * (lane_e >> 4);
#pragma unroll
            for (int r = 0; r < 4; ++r) { ls[q0_ + r] = sa4[r]; ls[32 + q0_ + r] = sb4[r]; } }
        asm volatile("s_waitcnt lgkmcnt(0)" ::: "memory");
#endif
#pragma unroll
        for (int r = 0; r < 16; ++r) { const int orow = crow(r, hh);
#if A8_SUM16
            float ra = __builtin_amdgcn_rcpf(ls[orow]); const float rb = __builtin_amdgcn_rcpf(ls[32 + orow]);
#if A8_SUM16 == 2
            { const float rref = __builtin_amdgcn_rcpf(osa[r]); if (!(__builtin_fabsf(ra - rref) <= 1e-3f * rref)) ra = __builtin_nanf(""); }
#endif
#else
            const float ra = __builtin_amdgcn_rcpf(osa[r]), rb = __builtin_amdgcn_rcpf(osb[r]);
#endif
            stg[orow * 64 + l32] = pg8::f2bf1(oa0[r] * ra); stg[orow * 64 + 32 + l32] = pg8::f2bf1(oa1[r] * ra);
            stg[2048 + orow * 64 + l32] = pg8::f2bf1(ob0[r] * rb); stg[2048 + orow * 64 + 32 + l32] = pg8::f2bf1(ob1[r] * rb); }
        asm volatile("s_waitcnt lgkmcnt(0)" ::: "memory");
#pragma unroll
        for (int i2 = 0; i2 < 8; ++i2) { const int row = i2 * 8 + (lane_e >> 3), ch = lane_e & 7; const u32x4 v = *(const ALAS u32x4*)(stg + row * 64 + ch * 8);
            *(u32x4*)(T_MIX + (size_t)(qb * 512 + wid * 64 + row) * 1024 + head * 64 + ch * 8) = v; }
    }
    asm volatile("s_waitcnt lgkmcnt(0)\n\ts_barrier" ::: "memory");
#undef DMA8
#undef LD32
#undef PK8
}
}
static_assert(att::LDS_NEED <= RING_BYTES, "LDS map");

#define GAS __attribute__((address_space(1)))
#define LAS __attribute__((address_space(3)))
typedef unsigned short bf16;
typedef unsigned v4u __attribute__((ext_vector_type(4)));
typedef float f32x4 __attribute__((ext_vector_type(4)));
typedef GAS unsigned gu32;
#define RLX_AGENT __ATOMIC_RELAXED, __HIP_MEMORY_SCOPE_AGENT
#define LDS_WAIT() asm volatile("s_waitcnt lgkmcnt(0)" ::: "memory")
#define VM_WAIT() asm volatile("s_waitcnt vmcnt(0)" ::: "memory")
__device__ __forceinline__ unsigned f2bf(float f) { unsigned u = __builtin_bit_cast(unsigned, f); return (u + 0x7fffu + ((u >> 16) & 1u)) >> 16; }
__device__ __forceinline__ unsigned pk2(float lo, float hi) { return f2bf(lo) | (f2bf(hi) << 16); }
#define XB_TMO      128
#define XB_XCNT(j)  (256  + 64 * (j))
#define XB_XSUB(j)  (1280 + 64 * (j))
#define XB_XGEN(j)  (2304 + 64 * (j))
#define XB_TOP      3328
#define XB_TOPGEN   3392
#define XCD_BAR_WORDS 3456
#define XB_SPIN_CAP (1u << 18)

__device__ __forceinline__ unsigned xb_ld(unsigned* p)              { return __hip_atomic_load(p, __ATOMIC_RELAXED, __HIP_MEMORY_SCOPE_AGENT); }
__device__ __forceinline__ unsigned xb_add(unsigned* p, unsigned v) { return __hip_atomic_fetch_add(p, v, __ATOMIC_RELAXED, __HIP_MEMORY_SCOPE_AGENT); }
__device__ __forceinline__ unsigned xb_xcc_id() { return (unsigned)__builtin_amdgcn_s_getreg((3 << 11) | 20) & 0xFu; }
#define XB_SPIN(cond, bar) do { unsigned _sp = 0; while (cond) { __builtin_amdgcn_s_sleep(1); \
    if ((++_sp & 255u) == 0u) { if (xb_ld(&(bar)[XB_TMO])) break; if (_sp > XB_SPIN_CAP) { atomicAdd(&(bar)[XB_TMO], 1u); break; } } } } while (0)

struct XcdBarrier {
    unsigned* bar; unsigned x;
    volatile LAS unsigned* st;
};

__device__ __forceinline__ XcdBarrier xcd_barrier_post(unsigned* bar, volatile LAS unsigned* st, bool t0) {
    XcdBarrier b; b.bar = bar; b.x = (unsigned)__builtin_amdgcn_readfirstlane((int)xb_xcc_id()); b.st = st;
    if (t0) (void)xb_add(&bar[XB_XCNT(b.x)], 1u);
    return b;
}
__device__ __forceinline__ void xcd_barrier_complete(unsigned* bar, unsigned x, unsigned& nloc, unsigned& nx) {
    const unsigned G = gridDim.x * gridDim.y * gridDim.z;
    unsigned sum, cnt, mine, sp = 0u;
    for (;;) {
        sum = 0u; cnt = 0u; mine = 0u;
#pragma unroll
        for (unsigned j = 0; j < 16; ++j) { const unsigned c = xb_ld(&bar[XB_XCNT(j)]); sum += c; cnt += (c > 0u) ? 1u : 0u; mine = (j == x) ? c : mine; }
        if (sum == G) break;
        __builtin_amdgcn_s_sleep(1);
        if ((++sp & 255u) == 0u) { if (xb_ld(&bar[XB_TMO])) break; if (sp > XB_SPIN_CAP) { atomicAdd(&bar[XB_TMO], 1u); break; } }
    }
    nloc = mine > 0u ? mine : 1u; nx = cnt > 0u ? cnt : 1u;
}

__device__ __forceinline__ void xcd_barrier(const XcdBarrier& b_, int wave_id) {
    XcdBarrier b = b_; asm volatile("" : "+s"(b.bar), "+s"(b.x));
    const bool t0 = (wave_id == 0) && (lane_id_v() == 0);
    asm volatile("s_waitcnt vmcnt(0)" ::: "memory");
    __syncthreads();
    if (t0) {
        unsigned* bar = b.bar;
        __builtin_amdgcn_s_waitcnt(0);
        unsigned nloc = b.st[0], nx = b.st[1];
        if (nloc == 0u) { xcd_barrier_complete(bar, b.x, nloc, nx); b.st[0] = nloc; b.st[1] = nx; }
        const unsigned old = xb_add(&bar[XB_XSUB(b.x)], 1u);
        const unsigned gen = old / nloc;
        if (old + 1u == (gen + 1u) * nloc) {
            __builtin_amdgcn_fence(__ATOMIC_RELEASE, "agent");
            asm volatile("s_waitcnt vmcnt(0)" ::: "memory");
            const unsigned og = xb_add(&bar[XB_TOP], 1u);
            const unsigned tg = og / nx;
            if (og + 1u == (tg + 1u) * nx) xb_add(&bar[XB_TOPGEN], 1u);
            else XB_SPIN(xb_ld(&bar[XB_TOPGEN]) == tg, bar);
            __builtin_amdgcn_fence(__ATOMIC_ACQUIRE, "agent");
            xb_add(&bar[XB_XGEN(b.x)], 1u);
            asm volatile("s_waitcnt vmcnt(0)" ::: "memory");
        } else {
            XB_SPIN(xb_ld(&bar[XB_XGEN(b.x)]) == gen, bar);
            __builtin_amdgcn_fence(__ATOMIC_ACQUIRE, "agent");
            asm volatile("s_waitcnt vmcnt(0)" ::: "memory");
        }
    }
    __syncthreads();
}
#ifndef PHMASK
#define PHMASK 63
#endif
#ifndef ATT_DUP
#define ATT_DUP 1
#endif
#ifndef GU_DUP
#define GU_DUP 1
#endif
#ifndef IN_DUP
#define IN_DUP 1
#endif
#ifndef D1_DUP
#define D1_DUP 1
#endif
#ifndef P0_DUP
#define P0_DUP 1
#endif
#ifndef NODEFER
#define DEFER_OK (G == 256)
#else
#define DEFER_OK false
#endif

__device__ __forceinline__ float wave_sum(float v) { v += xor_lane<1>(v); v += xor_lane<2>(v); v += xor_lane<4>(v); v += xor_lane<8>(v); v += xor_lane<16>(v); return sum_x32(v); }
__device__ __forceinline__ float wave_max(float v) { v = fmaxf(v, xor_lane<1>(v)); v = fmaxf(v, xor_lane<2>(v)); v = fmaxf(v, xor_lane<4>(v)); v = fmaxf(v, xor_lane<8>(v)); v = fmaxf(v, xor_lane<16>(v)); return max_x32(v); }
__device__ __forceinline__ void tr_item(const float* W, int ldw, int srccol0, const float* gain, bf16* WT, int K, int dstrow0, int k0, LAS float* scr, int lane) {
    const int kq = lane >> 3, nq = lane & 7;
    f32x4 w[8]; float g[8];
#pragma unroll
    for (int i = 0; i < 8; ++i) { const int kk = 8 * i + kq; w[i] = *(const GAS f32x4*)(W + (size_t)(k0 + kk) * ldw + srccol0 + 4 * nq); g[i] = gain ? gain[k0 + kk] : 1.0f; }
#pragma unroll
    for (int i = 0; i < 8; ++i) { const int kk = 8 * i + kq; LAS float* s = scr + kk * 33 + 4 * nq; s[0] = w[i][0] * g[i]; s[1] = w[i][1] * g[i]; s[2] = w[i][2] * g[i]; s[3] = w[i][3] * g[i]; }
    LDS_WAIT(); asm volatile("" ::: "memory");
    const int c = lane & 7;
#pragma unroll
    for (int j = 0; j < 4; ++j) { const int n = (lane >> 3) + 8 * j; const LAS float* s = scr + (8 * c) * 33 + n;
        v4u o; o.x = pk2(s[0 * 33], s[1 * 33]); o.y = pk2(s[2 * 33], s[3 * 33]); o.z = pk2(s[4 * 33], s[5 * 33]); o.w = pk2(s[6 * 33], s[7 * 33]);
        *(GAS v4u*)(WT + (size_t)(dstrow0 + n) * K + k0 + 8 * c) = o; }
    LDS_WAIT(); asm volatile("" ::: "memory");
}

#define TR_ONE(it_) do { int r = (it_); \
        if (r < 2 * I_GU) { const int l2 = r >= I_GU; if (l2) r -= I_GU; const int kb = r / (NGU / 32), nb = r % (NGU / 32), n0 = nb * 32, pn = n0 >> 8, j0 = n0 & 255; \
            const float* src = (j0 < 128) ? (l2 ? args.in[18] : args.in[2]) : (l2 ? args.in[19] : args.in[3]); \
            tr_item(src, FF, pn * 128 + (j0 & 127), l2 ? args.in[17] : args.in[1], (bf16*)(ws + (l2 ? WS_WGU2 : WS_WGU1)), D, n0, kb * 64, scr, lane); break; } \
        r -= 2 * I_GU; \
        if (r < 2 * I_D) { const int l2 = r >= I_D; if (l2) r -= I_D; const int kb = r / (D / 32), nb = r % (D / 32); \
            tr_item(l2 ? args.in[20] : args.in[4], D, nb * 32, nullptr, (bf16*)(ws + (l2 ? WS_WD2 : WS_WD1)), FF, nb * 32, kb * 64, scr, lane); break; } \
        r -= 2 * I_D; \
        if (r < I_IN) { const int kb = r / (NIN / 32), nb = r % (NIN / 32), n0 = nb * 32, pn = n0 >> 8, j0 = n0 & 255, bj = j0 >> 7, wc = (j0 >> 5) & 3; \
            tr_item(args.in[6], NIN, pn * 256 + wc * 64 + bj * 32, args.in[5], (bf16*)(ws + WS_WIN), D, n0, kb * 64, scr, lane); break; } \
        r -= I_IN; \
        { const int kb = r / (D / 32), nb = r % (D / 32); tr_item(args.in[16], D, nb * 32, nullptr, (bf16*)(ws + WS_WOUT), D, nb * 32, kb * 64, scr, lane); } } while (0)
constexpr int I_GU = (D / 64) * (NGU / 32), I_D = (FF / 64) * (D / 32), I_IN = (D / 64) * (NIN / 32), I_OUT = (D / 64) * (D / 32);
#define TR_DEFERRED(first_idle, IT0, IT1) do { if (bx >= (first_idle)) { const int lane = lane_id_v(); LAS float* scr = (LAS float*)(L + RING_OFF + wave * 16384); \
        const int nw_ = (G - (first_idle)) * NWAVES; for (int it = (IT0) + (bx - (first_idle)) * NWAVES + wave; it < (IT1); it += nw_) { TR_ONE(it); } } } while (0)
struct Args { const float* in[21]; float* out; unsigned char* ws; };
#define LAUNDER(p) asm volatile("" : "+s"(p))

__global__ void __launch_bounds__(NWAVES * 64, 2) mk_fwd(Args args) {
    extern __shared__ __attribute__((aligned(16))) unsigned char lds[];
    LAS unsigned char* L = (LAS unsigned char*)lds;
    volatile LAS unsigned* MISC = (volatile LAS unsigned*)(L + MISC_OFF);
    const int wave = __builtin_amdgcn_readfirstlane((int)threadIdx.x >> 6);
    const int G = gridDim.x; const int bx = blockIdx.x;
    unsigned char* ws = args.ws; float* out = args.out; LAUNDER_G(ws); LAUNDER_G(out);
    { const int tid = wave * 64 + lane_id_v(); for (int u = tid; u < (LDS_BYTES - LDSCTL_OFF) / 4; u += NWAVES * 64) ((LAS unsigned*)(L + LDSCTL_OFF))[u] = 0u; }
    __syncthreads();
    XcdBarrier bar = xcd_barrier_post((unsigned*)((gu32*)(ws + WS_CTL) + CW_BAR), MISC + 8, (wave == 0) && (lane_id_v() == 0));
    LAS float* rstd_tab = (LAS float*)(L + RSTD_OFF);
    LAS float* PRM = (LAS float*)(L + PRM_OFF);
    float pr0_ = 0.f, pr1_ = 0.f, pr2_ = 0.f, pr3_ = 0.f;
    { const int lane = lane_id_v();
      if (wave == 0) { pr0_ = ((const GAS float*)args.in[7])[lane]; pr1_ = ((const GAS float*)args.in[8])[lane]; }
      else if (wave == 1) { pr0_ = ((const GAS float*)args.in[9])[lane]; pr1_ = ((const GAS float*)args.in[10])[lane]; }
      else if (wave == 2) { pr0_ = ((const GAS float*)args.in[15])[lane]; pr1_ = ((const GAS float*)args.in[15])[64 + lane]; }
      else if (wave < 7) { const int h = wave - 3; pr0_ = ((const GAS float*)args.in[11])[h * 64 + lane]; pr1_ = ((const GAS float*)args.in[12])[h * 64 + lane]; pr2_ = ((const GAS float*)args.in[13])[h * 64 + lane]; pr3_ = ((const GAS float*)args.in[14])[h * 64 + lane]; } }
#define PRM_FINISH() do { const int lane = lane_id_v(); \
      if (wave == 0) { PRM[PRM_GAQ + lane] = pr0_; PRM[PRM_GAK + lane] = pr1_; const float ma_ = wave_max(fabsf(pr0_)), mk_ = wave_max(fabsf(pr1_)); if (lane == 0) PRM[PRM_NEGM2A] = -(8.0f * 1.4426950408889634f * 1.02f) * ma_ * mk_; } \
      else if (wave == 1) { PRM[PRM_GBQ + lane] = pr0_; PRM[PRM_GBK + lane] = pr1_; const float ma_ = wave_max(fabsf(pr0_)), mk_ = wave_max(fabsf(pr1_)); if (lane == 0) PRM[PRM_NEGM2B] = -(8.0f * 1.4426950408889634f * 1.02f) * ma_ * mk_; } \
      else if (wave == 2) { PRM[PRM_SUBLN + lane] = pr0_; PRM[PRM_SUBLN + 64 + lane] = pr1_; } \
      else if (wave < 7) { const float d1_ = wave_sum(pr0_ * pr1_), d2_ = wave_sum(pr2_ * pr3_); if (lane == 0) PRM[PRM_LAM + (wave - 3)] = expf(d1_) - expf(d2_) + 0.2f; } \
      LDS_WAIT(); } while (0)

#define BUILD_RSTD(S) do { pg8::Unit u_; const int tid = wave * 64 + lane_id_v(); const float* SSQ_ = (const float*)(ws + WS_SSQ); for (int i_ = 0; i_ < 6 && (S).next(i_, u_); ++i_) if (tid < 256) { const f32x4* p_ = (const f32x4*)(SSQ_ + (size_t)(u_.pm * 256 + tid) * 16); \
        const f32x4 a_ = p_[0], b_ = p_[1], c_ = p_[2], d_ = p_[3]; const float s_ = ((a_[0] + a_[1]) + (a_[2] + a_[3])) + ((b_[0] + b_[1]) + (b_[2] + b_[3])) + ((c_[0] + c_[1]) + (c_[2] + c_[3])) + ((d_[0] + d_[1]) + (d_[2] + d_[3])); \
        rstd_tab[i_ * 256 + tid] = 1.0f / sqrtf(s_ * (1.0f / 1024.0f) + 1e-6f); } LDS_WAIT(); __syncthreads(); } while (0)

#if (PHMASK & 1)
    for (int dup0 = 0; dup0 < P0_DUP; ++dup0) {
        if (dup0) xcd_barrier(bar, wave);
        const int lane = lane_id_v(), tid = wave * 64 + lane;
        const int vcu = (G % 8 == 0) ? (bx % 8) * (G / 8) + bx / 8 : bx;
        float* ROPE = (float*)(ws + WS_ROPE); float* SSQ = (float*)(ws + WS_SSQ); bf16* XB = (bf16*)(ws + WS_XB); const float* x = args.in[0];
        LAS float* scr = (LAS float*)(L + RING_OFF + wave * 16384);
        const int gw = vcu * NWAVES + wave, NGW = G * NWAVES;
        for (int it = gw; it < ((DEFER_OK) ? I_GU : 2 * I_GU + 2 * I_D + I_IN + I_OUT); it += NGW) { TR_ONE(it); }
        for (int m = gw; m < M; m += NGW) {
            const GAS f32x4* xr = (const GAS f32x4*)(x + (size_t)m * D) + lane; f32x4 v[4]; float s = 0.f;
#pragma unroll
            for (int j = 0; j < 4; ++j) { v[j] = xr[64 * j]; s += (v[j][0] * v[j][0] + v[j][1] * v[j][1]) + (v[j][2] * v[j][2] + v[j][3] * v[j][3]); }
            s = wave_sum(s);
            GAS unsigned long long* o8 = (GAS unsigned long long*)(XB + (size_t)m * D) + lane;
#pragma unroll
            for (int j = 0; j < 4; ++j) o8[64 * j] = (unsigned long long)pk2(v[j][0], v[j][1]) | ((unsigned long long)pk2(v[j][2], v[j][3]) << 32);
            if (lane < 16) SSQ[(size_t)m * 16 + lane] = (lane == 0) ? s : 0.f;
        }
        for (int e = bx * (NWAVES * 64) + tid; e < 5120; e += G * NWAVES * 64) {
            const int isc = e >= 4096, ee = isc ? e - 4096 : e, pos = ee >> 4, i = ee & 15;
            const float invf = powf(10000.0f, -(float)i * (1.0f / 16.0f)); const float ang = (float)pos * invf; float sn, cs; sincosf(ang, &sn, &cs);
            if (isc) { ROPE[8192 + ee] = cs; ROPE[9216 + ee] = sn; } else { ROPE[ee] = cs; ROPE[4096 + ee] = sn; }
        }
    }
#endif
    PRM_FINISH();
    xcd_barrier(bar, wave);

    for (int rep = 0; rep < 2; ++rep) {
#if (PHMASK & 2)
        {
            LAUNDER_G(ws);
            pg8::Gemm g{(const bf16*)(ws + WS_XB), (const bf16*)(ws + (rep ? WS_WGU2 : WS_WGU1)), M, NGU, D}; pg8::StaticOrderT<M, NGU> S; int bxs_ = bx, Gs_ = G; LAUNDER(bxs_); LAUNDER(Gs_); S.init(Gs_, bxs_);
#if defined(SPLITK_GU2)
            { pg8::SplitTailOrderT<pg8::StaticOrderT<M, NGU>, 5, D / 64> SKr{S, (rep == 1) && (G == 256)}; BUILD_RSTD(SKr); }
#else
            BUILD_RSTD(S);
#endif
            pg8::EpiSwiGLU E{ws, rstd_tab};
            for (int dup = 0; dup < GU_DUP; ++dup) { if (dup) xcd_barrier(bar, wave);
#if defined(CLK_PROBE_GU)
            unsigned long long c0_ = __builtin_amdgcn_s_memtime(), r0_ = __builtin_amdgcn_s_memrealtime();
#endif
#if defined(SPLITK_GU2)
            {
                typedef pg8::SplitTailOrderT<pg8::StaticOrderT<M, NGU>, 5, D / 64> SKO; SKO SK{S, (rep == 1) && (G == 256)};
                pg8::EpiSwiGLUSplit E2{ws, rstd_tab};
                pg8::gemm_phase<D, pg8::EpiSwiGLUSplit, SKO, true, true, D, true>(L + RING_OFF, g, SK, E2, wave);
            }
#else
            pg8::gemm_phase<D, pg8::EpiSwiGLU, pg8::StaticOrderT<M, NGU>, true, true>(L + RING_OFF, g, S, E, wave);
#endif
            if (rep == 0 && dup == 0 && DEFER_OK) { TR_DEFERRED(128, 2 * I_GU, 2 * I_GU + I_D); TR_DEFERRED(128, 2 * I_GU + 2 * I_D, 2 * I_GU + 2 * I_D + I_IN); }
#if defined(CLK_PROBE_GU)
            if (rep == 0 && bx == 0) { const unsigned long long c1_ = __builtin_amdgcn_s_memtime(), r1_ = __builtin_amdgcn_s_memrealtime(); const unsigned long long spin_ = 1000ull * (c1_ - c0_) / (r1_ - r0_); while (__builtin_amdgcn_s_memrealtime() - r1_ < spin_) __builtin_amdgcn_s_sleep(8); }
#endif
            }
        }
#endif
        xcd_barrier(bar, wave);
#if (PHMASK & 4)
        {
            LAUNDER_G(ws); LAUNDER_G(out);
            pg8::Gemm g{(const bf16*)(ws + WS_H), (const bf16*)(ws + (rep ? WS_WD2 : WS_WD1)), M, D, FF}; pg8::StaticOrderT<M, D> S; int bxs_ = bx, Gs_ = G; LAUNDER(bxs_); LAUNDER(Gs_); S.init(Gs_, bxs_);
            if (rep == 0) { pg8::EpiResid<true, true, false> E{nullptr, nullptr, ws, 0.5f}; for (int dup = 0; dup < D1_DUP; ++dup) { if (dup) xcd_barrier(bar, wave);
#if defined(D1_NULLEPI)
                if (dup) { pg8::EpiNull EN; pg8::gemm_phase<FF, pg8::EpiNull, pg8::StaticOrderT<M, D>, true, true>(L + RING_OFF, g, S, EN, wave); continue; }
#endif
#if defined(D1_SCRATCH)
                if (dup) { pg8::EpiResidStaged<true, false> ES{nullptr, ws, 0.5f, ws + (140u << 20)}; pg8::gemm_phase<FF, pg8::EpiResidStaged<true, false>, pg8::StaticOrderT<M, D>, false, true>(L + RING_OFF, g, S, ES, wave); continue; }
#endif
                pg8::gemm_phase<FF, pg8::EpiResid<true, true, false>, pg8::StaticOrderT<M, D>, true, true>(L + RING_OFF, g, S, E, wave); } }
            else {
#if defined(D7_DUP) && defined(D7_PROBE1)
                for (int dup = 0; dup < D7_DUP; ++dup) { if (dup) xcd_barrier(bar, wave);
                    if (dup < D7_DUP - 1) { pg8::EpiResid<true, false, true, 1> EP{nullptr, out, ws, 0.5f}; pg8::gemm_phase<FF, pg8::EpiResid<true, false, true, 1>, pg8::StaticOrderT<M, D>, true, true>(L + RING_OFF, g, S, EP, wave); }
                    else { pg8::EpiResid<true, false, true> E{nullptr, out, ws, 0.5f}; pg8::gemm_phase<FF, pg8::EpiResid<true, false, true>, pg8::StaticOrderT<M, D>, true, true>(L + RING_OFF, g, S, E, wave); } }
#elif defined(D7_DUP)
                pg8::EpiResid<true, false, true> E{nullptr, out, ws, 0.5f};
#pragma unroll 1
                for (int dup = 0; dup < D7_DUP; ++dup) { if (dup) xcd_barrier(bar, wave); pg8::gemm_phase<FF, pg8::EpiResid<true, false, true>, pg8::StaticOrderT<M, D>, true, true>(L + RING_OFF, g, S, E, wave); }
#else
                pg8::EpiResid<true, false, true> E{nullptr, out, ws, 0.5f}; pg8::gemm_phase<FF, pg8::EpiResid<true, false, true>, pg8::StaticOrderT<M, D>, true, true>(L + RING_OFF, g, S, E, wave);
#endif
            }
        }
#endif
        if (rep == 1) break;
        xcd_barrier(bar, wave);
#if (PHMASK & 8)
        {
            LAUNDER_G(ws);
            pg8::Gemm g{(const bf16*)(ws + WS_XB), (const bf16*)(ws + WS_WIN), M, NIN, D}; pg8::StaticOrderT<M, NIN> S; int bxs_ = bx, Gs_ = G; LAUNDER(bxs_); LAUNDER(Gs_); S.init(Gs_, bxs_);
            BUILD_RSTD(S);
            pg8::EpiInProj E{rstd_tab, PRM, ws};
            for (int dup = 0; dup < IN_DUP; ++dup) { if (dup) xcd_barrier(bar, wave);
            pg8::gemm_phase<D, pg8::EpiInProj, pg8::StaticOrderT<M, NIN>, true, true>(L + RING_OFF, g, S, E, wave);
            if (dup == 0 && DEFER_OK) { TR_DEFERRED(64, I_GU, 2 * I_GU); TR_DEFERRED(64, 2 * I_GU + I_D, 2 * I_GU + 2 * I_D); TR_DEFERRED(64, 2 * I_GU + 2 * I_D + I_IN, 2 * I_GU + 2 * I_D + I_IN + I_OUT); } }
        }
#endif
        xcd_barrier(bar, wave);
#if (PHMASK & 16)
        for (int dup = 0; dup < ATT_DUP; ++dup) {
            LAUNDER_G(ws);
            if (dup) xcd_barrier(bar, wave);
            gu32* qhead = (gu32*)(ws + WS_CTL) + CW_QUEUE + 64 * dup;
#if defined(CLK_PROBE)
            unsigned long long c0_ = __builtin_amdgcn_s_memtime(), r0_ = __builtin_amdgcn_s_memrealtime();
#endif
            const att::Tensors T = att::make_tensors(ws, PRM);
            const bool st = (G == 256);
            const int xg = bx & 7, cg = bx >> 3;
            for (int step = 0;; ++step) {
                int kind, h, qb;
                if (st && step < 2) {
                    if (step < 1) { kind = 0; h = xg; qb = cg; }
                    else { kind = 1; h = (xg < 4) ? 3 : 2; qb = 32 * (xg & 3) + cg; }
                } else {
                    if ((wave == 0) && (lane_id_v() == 0)) MISC[12] = __hip_atomic_fetch_add(qhead, 1u, RLX_AGENT);
                    LDS_WAIT(); __syncthreads();
                    int idx = __builtin_amdgcn_readfirstlane((int)MISC[12]);
                    if (st) idx += 512;
                    if (idx >= 768) break;
                    if (idx < 256 || idx >= 512) { kind = 1;
                        if (idx < 128) { h = 3; qb = idx; } else if (idx < 256) { const int i = idx - 128; h = 2; qb = (i & 1) ? 63 - (i >> 1) : 64 + (i >> 1); }
                        else if (idx < 640) { h = 1; qb = idx - 512; } else { h = 0; qb = idx - 640; }
                    } else { kind = 0; const int i = idx - 256; h = i >> 5; qb = i & 31; }
                }
#if defined(DUP_ONLY_A)
                if (dup && kind) continue;
#elif defined(DUP_ONLY_B)
                if (dup && !kind) continue;
#endif
                if (kind) {
                    const float slope = (h == 0) ? 0.25f : (h == 1) ? 0.0625f : (h == 2) ? 0.015625f : 0.00390625f;
                    const float c2 = slope * 1.4426950408889634f; const int dskip = (int)(150.0f / c2) + 1;
                    att::attn_unit<true>(T, h, qb, PRM[PRM_NEGM2B], PRM[PRM_LAM + h], c2, dskip, (char*)lds + RING_OFF, wave);
                } else {
#if defined(A8_NOEXP_DUP)
                    if (dup < ATT_DUP - 1) att::attn_unit_a8x2<A8U, A8_NOEXP_DUP>(T, h, qb, PRM[PRM_NEGM2A] + 8.0f, (char*)lds + RING_OFF, wave); else
#endif
                    att::attn_unit_a8x2<A8U>(T, h, qb, PRM[PRM_NEGM2A] + 8.0f, (char*)lds + RING_OFF, wave); }
            }
#if defined(CLK_PROBE)
            if (dup == ATT_DUP - 1 && bx == 0) { const unsigned long long c1_ = __builtin_amdgcn_s_memtime(), r1_ = __builtin_amdgcn_s_memrealtime(); const unsigned long long spin_ = 1000ull * (c1_ - c0_) / (r1_ - r0_); while (__builtin_amdgcn_s_memrealtime() - r1_ < spin_) __builtin_amdgcn_s_sleep(8); }
#endif
        }
#endif
        xcd_barrier(bar, wave);
#if (PHMASK & 32)
        {
            LAUNDER_G(ws); LAUNDER_G(out);
            pg8::Gemm g{(const bf16*)(ws + WS_MIX), (const bf16*)(ws + WS_WOUT), M, D, D}; pg8::StaticOrderT<M, D> S; int bxs_ = bx, Gs_ = G; LAUNDER(bxs_); LAUNDER(Gs_); S.init(Gs_, bxs_);
            pg8::EpiResid<true, true, false> E{nullptr, nullptr, ws, 1.0f}; pg8::gemm_phase<D, pg8::EpiResid<true, true, false>, pg8::StaticOrderT<M, D>, true, true>(L + RING_OFF, g, S, E, wave);
        }
#endif
        xcd_barrier(bar, wave);
    }
}

extern "C" void kernel_launch(void* const* d_in, const int* in_sizes, int n_in, void* d_out, int out_size, void* d_ws, size_t ws_size, hipStream_t stream) {
    static int grid = 0;
    if (grid == 0) {
        if (n_in != 21 || in_sizes[0] != M * D || out_size != M * D || ws_size < WS_END) { fprintf(stderr, "kernel_launch: unexpected shapes (n_in %d, in0 %d, out %d, ws %zu)\n", n_in, n_in > 0 ? in_sizes[0] : -1, out_size, ws_size); grid = -1; return; }
        int dev = 0, cus = 0, per_cu = 0;
        if (hipGetDevice(&dev) != hipSuccess || hipDeviceGetAttribute(&cus, hipDeviceAttributeMultiprocessorCount, dev) != hipSuccess) { grid = -1; return; }
        if (hipFuncSetAttribute((const void*)mk_fwd, hipFuncAttributeMaxDynamicSharedMemorySize, LDS_BYTES) != hipSuccess) { fprintf(stderr, "kernel_launch: hipFuncSetAttribute failed\n"); grid = -1; return; }
        if (hipOccupancyMaxActiveBlocksPerMultiprocessor(&per_cu, (const void*)mk_fwd, NWAVES * 64, LDS_BYTES) != hipSuccess || per_cu < 1) { fprintf(stderr, "kernel_launch: occupancy query says %d blocks per CU\n", per_cu); (void)hipGetLastError(); grid = -1; return; }
        grid = cus;
    }
    if (grid < 0) return;
    if (hipMemsetAsync((char*)d_ws + WS_CTL, 0, CTL_ZERO_BYTES, stream) != hipSuccess) { fprintf(stderr, "kernel_launch: memset failed\n"); return; }
    Args a{};
    for (int i = 0; i < 21; ++i) a.in[i] = (const float*)d_in[i];
    a.out = (float*)d_out; a.ws = (unsigned char*)d_ws;
    hipLaunchKernelGGL(mk_fwd, dim3(grid), dim3(NWAVES * 64), LDS_BYTES, stream, a);
    const hipError_t le = hipPeekAtLastError();
    if (le != hipSuccess) fprintf(stderr, "kernel_launch: launch failed: %s\n", hipGetErrorName(le));
}
```

```cpp
#include <hip/hip_runtime.h>
#include <cstdio>
#include <cstdint>
#define GLDS_M0_CLOBBER 1
#define A8_PIPE2 1
#define A8_SUM16 1
#define B_VF8 1
#ifndef A8_DMAPOS
#define A8_DMAPOS 0
#endif
#ifndef B_VF8
#define B_VF8 0
#endif
#ifndef A8_PIPE2
#define A8_PIPE2 0
#endif
#ifndef A8_DMASTAG
#define A8_DMASTAG 0
#endif
#ifndef A8_SUM16
#define A8_SUM16 0
#endif
#ifndef B_ORDER
#define B_ORDER 0
#endif
#ifndef A8_VPREF
#define A8_VPREF 0
#endif
#ifndef BDMA_MODE
#define BDMA_MODE 0
#endif
#ifndef A8U
#define A8U 4
#endif
#ifndef A8_NOBF8
#define A8_BF8 1
#endif

constexpr int NWAVES = 8;
constexpr int M = 16384, D = 1024, FF = 2816, NGU = 2 * FF, NIN = 2304;
constexpr size_t MiB = 1u << 20;
constexpr size_t WS_CTL = 0, CTL_ZERO_BYTES = 64 * 1024;
constexpr size_t WS_WGU1 = 2 * MiB, WS_WD1 = 13 * MiB, WS_WIN = 19 * MiB, WS_WOUT = 24 * MiB, WS_WGU2 = 26 * MiB, WS_WD2 = 37 * MiB;
constexpr size_t WS_ROPE = 43 * MiB, WS_SSQ = 44 * MiB;
constexpr size_t WS_XB = 48 * MiB;
constexpr size_t WS_H = 80 * MiB;
constexpr size_t WS_QA = 80 * MiB, WS_KA = 96 * MiB, WS_VA = 100 * MiB, WS_QB = 104 * MiB, WS_KB = 120 * MiB, WS_VB = 136 * MiB, WS_MIX = 152 * MiB;
constexpr size_t WS_END = 184 * MiB;
static_assert(WS_WGU1 + (size_t)NGU * D * 2 <= WS_WD1 && WS_WD1 + (size_t)D * FF * 2 <= WS_WIN && WS_WIN + (size_t)NIN * D * 2 <= WS_WOUT && WS_WOUT + (size_t)D * D * 2 <= WS_WGU2 &&
              WS_WGU2 + (size_t)NGU * D * 2 <= WS_WD2 && WS_WD2 + (size_t)D * FF * 2 <= WS_ROPE && WS_H + (size_t)M * FF * 2 <= WS_END && WS_MIX + (size_t)M * D * 2 <= WS_END, "d_ws map");
constexpr int CW_BAR = 1024;
constexpr int CW_XFLAG = 9216;
constexpr size_t WS_XCH = 184 * MiB;
constexpr int CW_QUEUE = 8192;
constexpr int RING_OFF = 0, RING_BYTES = 131072;
constexpr int LDSCTL_OFF = RING_BYTES, MISC_OFF = LDSCTL_OFF + 320, RSTD_OFF = LDSCTL_OFF + 1024, PRM_OFF = LDSCTL_OFF + 8192;
constexpr int LDS_BYTES = 147456;
constexpr int PRM_GAQ = 0, PRM_GAK = 64, PRM_GBQ = 128, PRM_GBK = 192, PRM_SUBLN = 256, PRM_NEGM2A = 384, PRM_NEGM2B = 385, PRM_LAM = 388, PRM_WORDS = 392;
static_assert(RSTD_OFF + 6 * 256 * 4 <= PRM_OFF && PRM_OFF + PRM_WORDS * 4 <= LDS_BYTES, "LDS map");

__device__ __forceinline__ int lane_id_v() { int l; asm volatile("v_mbcnt_lo_u32_b32 %0, -1, 0\n\tv_mbcnt_hi_u32_b32 %0, -1, %0" : "=v"(l)); return l; }

template <int MASK> __device__ __forceinline__ float xor_lane(float v) {
    if constexpr (MASK == 32) { const auto rr = __builtin_amdgcn_permlane32_swap(__float_as_uint(v), __float_as_uint(v), false, false); return __uint_as_float(lane_id_v() < 32 ? rr[1] : rr[0]); }
    else return __uint_as_float((unsigned)__builtin_amdgcn_ds_swizzle((int)__float_as_uint(v), (MASK << 10) | 0x1f));
}
__device__ __forceinline__ float sum_x32(float v) { const auto rr = __builtin_amdgcn_permlane32_swap(__float_as_uint(v), __float_as_uint(v), false, false); return __uint_as_float(rr[0]) + __uint_as_float(rr[1]); }
__device__ __forceinline__ float max_x32(float v) { const auto rr = __builtin_amdgcn_permlane32_swap(__float_as_uint(v), __float_as_uint(v), false, false); return fmaxf(__uint_as_float(rr[0]), __uint_as_float(rr[1])); }

#define LAUNDER_G(p) do { __attribute__((address_space(1))) void* g_ = (__attribute__((address_space(1))) void*)(p); asm volatile("" : "+s"(g_)); (p) = (decltype(p))g_; } while (0)
namespace pg8 {
#define PG8_LAS __attribute__((address_space(3)))
typedef unsigned short bf16_t;
typedef short bf16x8 __attribute__((ext_vector_type(8)));
typedef float f32x4 __attribute__((ext_vector_type(4)));
typedef unsigned u32x4 __attribute__((ext_vector_type(4)));
constexpr int BM = 256, BK = 64, HALF = 128, HTB = HALF * BK * 2  , STAGE_BYTES = 8 * HTB, NXCD = 8, WGM = 8;

__host__ __device__ __forceinline__ int lds_byte(int r, int c) { const int st = (r >> 4) * 2 + (c >> 5), rr = r & 15, cc = c & 31, ob = rr * 64 + cc * 2; return st * 1024 + (ob ^ (((ob >> 9) & 1) << 5)); }
__host__ __device__ __forceinline__ void stage_rc(int b, int& R, int& C) { const int st = b / 1024, sb = b % 1024, swz = sb ^ (((sb >> 9) & 1) << 5); R = (st >> 1) * 16 + swz / 64; C = (st & 1) * 32 + (swz % 64) / 2; }
__host__ __device__ __forceinline__ int perm32(int rho) { const int n = rho >> 4, i = rho & 15; return 8 * (i >> 2) + 4 * n + (i & 3); }

struct Unit { int pm, pn; int kofs, nt; };
struct Gemm { const bf16_t* A; const bf16_t* Bt; int M, N, K; };

template <int MD, int ND> struct StaticOrderT {
    static constexpr int nM = MD / BM, nN = ND / BM, nwg = nM * nN;
    int G, c;
    __host__ __device__ void init(int G_, int c_) { G = G_; c = c_; }
    __host__ __device__ bool next(int i, Unit& u) const { return at(i * G + c, u); }
    __host__ __device__ bool at(int L, Unit& u) const {
        if (L >= nwg) return false;
        int wgid = L; { constexpr int q = nwg / NXCD, r = nwg % NXCD; const int xcd = wgid % NXCD, off = wgid / NXCD; wgid = (xcd < r ? xcd * (q + 1) : r * (q + 1) + (xcd - r) * q) + off; }
        constexpr int nig = WGM * nN; const int gid = wgid / nig, fm = gid * WGM, gsz = (nM - fm) < WGM ? (nM - fm) : WGM;
        u.pm = fm + ((wgid % nig) % gsz); u.pn = (wgid % nig) / gsz; u.kofs = 0; u.nt = 0; return true;
    }
    __device__ __forceinline__ void a_ready(const Unit&) const {}
    __device__ __forceinline__ void done(const Unit&) const {}
};
template <class S0, int RT, int NTF> struct SplitTailOrderT { S0 s; bool sk;
    __host__ __device__ bool next(int i, Unit& u) const {
        if (!sk || i < RT) { const bool r = s.next(i, u); u.kofs = 0; u.nt = NTF; return r; }
        if (i > RT) return false;
        const int h = s.G >> 1; s.at(RT * s.G + (s.c % h), u); u.kofs = (s.c / h) * (NTF / 2) * BK * 2; u.nt = NTF / 2; return true; }
    __device__ __forceinline__ void a_ready(const Unit&) const {} __device__ __forceinline__ void done(const Unit&) const {} };


__device__ __forceinline__ unsigned cvt_pk_bf16(float lo, float hi) { unsigned r; asm volatile("v_cvt_pk_bf16_f32 %0, %1, %2" : "=v"(r) : "v"(lo), "v"(hi)); return r; }
__device__ __forceinline__ unsigned short f2bf1(float f) { unsigned u = __builtin_bit_cast(unsigned, f); return (unsigned short)((u + 0x7fffu + ((u >> 16) & 1u)) >> 16); }
typedef unsigned u32x2 __attribute__((ext_vector_type(2)));
constexpr int MROWS = M, DMODEL = D, DFF = FF;

typedef float f32x2 __attribute__((ext_vector_type(2)));
#ifdef SWIGLU_FMA
#define SWIGLU_RS2(rs) __builtin_amdgcn_rcpf((rs) * (rs))
#else
#define SWIGLU_RS2(rs) ((rs) * (rs))
#endif
__device__ __forceinline__ f32x2 swiglu2(f32x2 ag, f32x2 au, float k1, float rs2) {
    const f32x2 t = ag * k1; f32x2 ex; ex.x = __builtin_amdgcn_exp2f(t.x); ex.y = __builtin_amdgcn_exp2f(t.y);
#ifdef SWIGLU_FMA
    const f32x2 d = ex * rs2 + rs2; f32x2 r; r.x = __builtin_amdgcn_rcpf(d.x); r.y = __builtin_amdgcn_rcpf(d.y);
    return (ag * au) * r;
#else
    const f32x2 d = ex + 1.0f; f32x2 r; r.x = __builtin_amdgcn_rcpf(d.x); r.y = __builtin_amdgcn_rcpf(d.y);
    return ((ag * au) * rs2) * r;
#endif
}
__device__ __forceinline__ f32x4 swiglu4(f32x4 ag, f32x4 au, float k1, float rs2) {
    const f32x2 a = swiglu2((f32x2){ag[0], ag[1]}, (f32x2){au[0], au[1]}, k1, rs2), b = swiglu2((f32x2){ag[2], ag[3]}, (f32x2){au[2], au[3]}, k1, rs2);
    return (f32x4){a.x, a.y, b.x, b.y};
}
struct EpiSwiGLU {
    static constexpr bool PERM = true, AFTER_DRAIN = false;
    unsigned char* ws; const PG8_LAS float* rstd;
    __device__ __forceinline__ void operator()(const f32x4 (&acc)[2][2][4][2], const Unit& u, int ui, int wr, int wc, int fr, int fq) const {
        asm volatile("" : "+v"(fr), "+v"(fq));
        const int col0 = u.pn * 128 + wc * 32 + 8 * fq; unsigned char* w2 = ws; LAUNDER_G(w2); bf16_t* H = (bf16_t*)(w2 + WS_H);
#pragma unroll
        for (int ai = 0; ai < 2; ++ai)
#pragma unroll
            for (int m = 0; m < 4; ++m) {
                const int rl = ai * HALF + wr * 64 + m * 16 + fr; const float rs = rstd[ui * 256 + rl];
                const float k1 = rs * -1.4426950408889634f, rs2 = SWIGLU_RS2(rs);
                const f32x4 h0 = swiglu4(acc[ai][0][m][0], acc[ai][1][m][0], k1, rs2), h1 = swiglu4(acc[ai][0][m][1], acc[ai][1][m][1], k1, rs2);
                u32x4 w; w.x = cvt_pk_bf16(h0[0], h0[1]); w.y = cvt_pk_bf16(h0[2], h0[3]); w.z = cvt_pk_bf16(h1[0], h1[1]); w.w = cvt_pk_bf16(h1[2], h1[3]);
                *(u32x4*)(H + (size_t)(u.pm * BM + rl) * DFF + col0) = w;
            }
    }
};
struct EpiSwiGLUSplit {
    static constexpr bool PERM = true, AFTER_DRAIN = false;
    unsigned char* ws; const PG8_LAS float* rstd;
    typedef unsigned long long u64;
    __device__ __forceinline__ static void put(u64* p, const f32x4& v) {
        __hip_atomic_store(p, ((u64)__float_as_uint(v[1]) << 32) | __float_as_uint(v[0]), __ATOMIC_RELAXED, __HIP_MEMORY_SCOPE_AGENT);
        __hip_atomic_store(p + 1, ((u64)__float_as_uint(v[3]) << 32) | __float_as_uint(v[2]), __ATOMIC_RELAXED, __HIP_MEMORY_SCOPE_AGENT); }
    __device__ __forceinline__ static f32x4 get(const u64* p) {
        const u64 a = __hip_atomic_load(p, __ATOMIC_RELAXED, __HIP_MEMORY_SCOPE_AGENT), b = __hip_atomic_load(p + 1, __ATOMIC_RELAXED, __HIP_MEMORY_SCOPE_AGENT);
        return (f32x4){__uint_as_float((unsigned)a), __uint_as_float((unsigned)(a >> 32)), __uint_as_float((unsigned)b), __uint_as_float((unsigned)(b >> 32))}; }
    template <int SS> __device__ __forceinline__ void run(const f32x4 (&acc)[2][2][4][2], const Unit& u, int wr, int wc, int fr, int fq) const {
        unsigned char* w2 = ws; LAUNDER_G(w2);
        const int pair = (int)(__builtin_amdgcn_workgroup_id_x() & 127u); constexpr int rslot = 5;
        const unsigned tid = (unsigned)((wr * 4 + wc) * 64 + fq * 16 + fr);
        unsigned char* xb_ = w2 + WS_XCH + (size_t)pair * (2 * 16 * 512 * 16);
        u64* xo = (u64*)(xb_ + (size_t)(1 - SS) * (16 * 512 * 16) + tid * 16u);
        const u64* xi = (const u64*)(xb_ + (size_t)SS * (16 * 512 * 16) + tid * 16u);
        unsigned* flg = (unsigned*)(w2 + WS_CTL) + CW_XFLAG + pair * 2;
#pragma unroll
        for (int bj = 0; bj < 2; ++bj)
#pragma unroll
            for (int m = 0; m < 4; ++m)
#pragma unroll
                for (int n = 0; n < 2; ++n) put(xo + (size_t)((bj * 4 + m) * 2 + n) * 1024, acc[1 - SS][bj][m][n]);
        asm volatile("s_waitcnt vmcnt(0)" ::: "memory");
        __syncthreads();
        if (tid == 0) { __hip_atomic_store(flg + (1 - SS), 1u, __ATOMIC_RELAXED, __HIP_MEMORY_SCOPE_AGENT);
            unsigned sp = 0; while (__hip_atomic_load(flg + SS, __ATOMIC_RELAXED, __HIP_MEMORY_SCOPE_AGENT) == 0u) { __builtin_amdgcn_s_sleep(1); if (++sp > (1u << 20)) break; } }
        __syncthreads();
        bf16_t* H = (bf16_t*)(w2 + WS_H); const int col0 = u.pn * 128 + wc * 32 + 8 * fq;
#pragma unroll
        for (int m = 0; m < 4; ++m) {
            const f32x4 g0 = acc[SS][0][m][0] + get(xi + (size_t)((0 * 4 + m) * 2 + 0) * 1024), g1 = acc[SS][0][m][1] + get(xi + (size_t)((0 * 4 + m) * 2 + 1) * 1024);
            const f32x4 u0 = acc[SS][1][m][0] + get(xi + (size_t)((1 * 4 + m) * 2 + 0) * 1024), u1 = acc[SS][1][m][1] + get(xi + (size_t)((1 * 4 + m) * 2 + 1) * 1024);
            const int rl = SS * HALF + wr * 64 + m * 16 + fr; const float rs = rstd[rslot * 256 + rl];
            const float k1 = rs * -1.4426950408889634f, rs2 = SWIGLU_RS2(rs);
            const f32x4 h0 = swiglu4(g0, u0, k1, rs2), h1 = swiglu4(g1, u1, k1, rs2);
            u32x4 w; w.x = cvt_pk_bf16(h0[0], h0[1]); w.y = cvt_pk_bf16(h0[2], h0[3]); w.z = cvt_pk_bf16(h1[0], h1[1]); w.w = cvt_pk_bf16(h1[2], h1[3]);
            *(u32x4*)(H + (size_t)(u.pm * BM + rl) * DFF + col0) = w;
        }
    }
    __device__ __forceinline__ void operator()(const f32x4 (&acc)[2][2][4][2], const Unit& u, int ui, int wr, int wc, int fr, int fq) const {
        if (u.nt == (D / BK) / 2) { asm volatile("" : "+v"(fr), "+v"(fq));
            if (__builtin_amdgcn_workgroup_id_x() >> 7) run<1>(acc, u, wr, wc, fr, fq); else run<0>(acc, u, wr, wc, fr, fq); }
        else { EpiSwiGLU E0{ws, rstd}; E0(acc, u, ui, wr, wc, fr, fq); }
    }
};
template <bool SRC_B, bool WRITE_B, bool WRITE_F, int PROBE = 0> struct EpiResid {
    static constexpr bool PERM = true, AFTER_DRAIN = false;
    const float* base; float* out; unsigned char* ws; float alpha;
    __device__ __forceinline__ static f32x4 up4(unsigned a, unsigned b) { return (f32x4){__uint_as_float(a << 16), __uint_as_float(a & 0xffff0000u), __uint_as_float(b << 16), __uint_as_float(b & 0xffff0000u)}; }
    __device__ __forceinline__ void operator()(const f32x4 (&acc)[2][2][4][2], const Unit& u, int ui, int wr, int wc, int fr, int fq) const {
        asm volatile("" : "+v"(fr), "+v"(fq));
        const int col0 = u.pn * BM + wc * 32 + 8 * fq;
        unsigned char* w2 = ws; LAUNDER_G(w2); bf16_t* xb = (bf16_t*)(w2 + WS_XB); float* ssqp = (float*)(w2 + WS_SSQ);
#pragma unroll
        for (int ai = 0; ai < 2; ++ai) {
            f32x4 rb[4][2][2];
#pragma unroll
            for (int m = 0; m < 4; ++m) { const size_t off = (size_t)(u.pm * BM + ai * HALF + wr * 64 + m * 16 + fr) * DMODEL + col0;
#pragma unroll
                for (int bj = 0; bj < 2; ++bj) {
                    if (PROBE == 1) { rb[m][bj][0] = (f32x4){0.f, 0.f, 0.f, 0.f}; rb[m][bj][1] = rb[m][bj][0]; }
                    else if (SRC_B) { const u32x4 r = *(const u32x4*)(xb + off + bj * HALF); rb[m][bj][0] = __builtin_bit_cast(f32x4, r); }
                    else { rb[m][bj][0] = *(const f32x4*)(base + off + bj * HALF); rb[m][bj][1] = *(const f32x4*)(base + off + bj * HALF + 4); } } }
#pragma unroll
            for (int m = 0; m < 4; ++m) {
                const int row = u.pm * BM + ai * HALF + wr * 64 + m * 16 + fr; const size_t off = (size_t)row * DMODEL + col0; float ss = 0.f;
#pragma unroll
                for (int bj = 0; bj < 2; ++bj) { const size_t o = off + bj * HALF;
                    f32x4 b0, b1;
                    if (SRC_B) { const u32x4 r = __builtin_bit_cast(u32x4, rb[m][bj][0]); b0 = up4(r[0], r[1]); b1 = up4(r[2], r[3]); } else { b0 = rb[m][bj][0]; b1 = rb[m][bj][1]; }
                    const f32x4 v0 = b0 + acc[ai][bj][m][0] * alpha, v1 = b1 + acc[ai][bj][m][1] * alpha;
                    if (PROBE == 2) { asm volatile("" :: "v"(v0), "v"(v1)); }
#ifdef OUT_NT
                    if (WRITE_F && PROBE != 2) { __builtin_nontemporal_store(v0, (f32x4*)(out + o)); __builtin_nontemporal_store(v1, (f32x4*)(out + o + 4)); }
#else
                    if (WRITE_F && PROBE != 2) { *(f32x4*)(out + o) = v0; *(f32x4*)(out + o + 4) = v1; }
#endif
                    if (WRITE_B && PROBE != 2) { ss += ((v0[0] * v0[0] + v0[1] * v0[1]) + (v0[2] * v0[2] + v0[3] * v0[3])) + ((v1[0] * v1[0] + v1[1] * v1[1]) + (v1[2] * v1[2] + v1[3] * v1[3]));
                        u32x4 w; w.x = cvt_pk_bf16(v0[0], v0[1]); w.y = cvt_pk_bf16(v0[2], v0[3]); w.z = cvt_pk_bf16(v1[0], v1[1]); w.w = cvt_pk_bf16(v1[2], v1[3]); *(u32x4*)(xb + o) = w; } }
                if (WRITE_B && PROBE != 2) { ss += xor_lane<16>(ss); ss = sum_x32(ss); if (fq == 0) ssqp[(size_t)row * 16 + u.pn * 4 + wc] = ss; }
            }
            asm volatile("" ::: "memory");
        }
    }
};
template <bool WRITE_B, bool WRITE_F> struct EpiResidStaged {
    static constexpr bool PERM = true, AFTER_DRAIN = true;
    float* out; unsigned char* ws; float alpha; unsigned char* wsw;
    __device__ __forceinline__ static f32x4 up4(unsigned a, unsigned b) { return (f32x4){__uint_as_float(a << 16), __uint_as_float(a & 0xffff0000u), __uint_as_float(b << 16), __uint_as_float(b & 0xffff0000u)}; }
    __device__ __forceinline__ void fused(f32x4 (&acc)[2][2][4][2], const Unit& u, int wr, int wc, int fr, int fq, PG8_LAS unsigned char* lds, int wid, int lane) const {
        unsigned char* w2 = ws; LAUNDER_G(w2); const bf16_t* xb = (const bf16_t*)(w2 + WS_XB); unsigned char* w3 = wsw; LAUNDER_G(w3); bf16_t* xbw = (bf16_t*)(w3 + WS_XB); float* ssqp = (float*)(w3 + WS_SSQ);
        {
            const int tid = wid * 64 + lane, c = tid & 31, r0 = tid >> 5;
            const bf16_t* src = xb + (size_t)(u.pm * BM + r0) * DMODEL + u.pn * BM + c * 8;
            u32x4 t[16];
#pragma unroll
            for (int p = 0; p < 16; ++p) t[p] = *(const u32x4*)(src + (size_t)(p * 16) * DMODEL);
#pragma unroll
            for (int p = 0; p < 16; ++p) { const int r = p * 16 + r0; *(PG8_LAS u32x4*)(lds + r * 512 + ((c ^ (r & 15)) << 4)) = t[p]; }
        }
        asm volatile("s_waitcnt vmcnt(0) lgkmcnt(0)\n\ts_barrier" ::: "memory");
        asm volatile("" : "+v"(fr), "+v"(fq));
        const int col0 = u.pn * BM + wc * 32 + 8 * fq;
#pragma unroll
        for (int ai = 0; ai < 2; ++ai)
#pragma unroll
            for (int m = 0; m < 4; ++m) {
                const int rl = ai * HALF + wr * 64 + m * 16 + fr; const int row = u.pm * BM + rl; const size_t off = (size_t)row * DMODEL + col0; float ss = 0.f;
#pragma unroll
                for (int bj = 0; bj < 2; ++bj) { const size_t o = off + bj * HALF;
                    const int chunk = 16 * bj + 4 * wc + fq;
                    const u32x4 r = *(const PG8_LAS u32x4*)(lds + rl * 512 + ((chunk ^ (rl & 15)) << 4));
                    const f32x4 b0 = up4(r[0], r[1]), b1 = up4(r[2], r[3]);
                    const f32x4 v0 = b0 + acc[ai][bj][m][0] * alpha, v1 = b1 + acc[ai][bj][m][1] * alpha;
                    if (WRITE_F) { *(f32x4*)(out + o) = v0; *(f32x4*)(out + o + 4) = v1; }
                    if (WRITE_B) { ss += ((v0[0] * v0[0] + v0[1] * v0[1]) + (v0[2] * v0[2] + v0[3] * v0[3])) + ((v1[0] * v1[0] + v1[1] * v1[1]) + (v1[2] * v1[2] + v1[3] * v1[3]));
                        u32x4 w; w.x = cvt_pk_bf16(v0[0], v0[1]); w.y = cvt_pk_bf16(v0[2], v0[3]); w.z = cvt_pk_bf16(v1[0], v1[1]); w.w = cvt_pk_bf16(v1[2], v1[3]); *(u32x4*)(xbw + o) = w; } }
                if (WRITE_B) { ss += xor_lane<16>(ss); ss = sum_x32(ss); if (fq == 0) ssqp[(size_t)row * 16 + u.pn * 4 + wc] = ss; }
            }
    }
};
struct EpiNull {
    static constexpr bool PERM = true, AFTER_DRAIN = false;
    __device__ __forceinline__ void operator()(const f32x4 (&acc)[2][2][4][2], const Unit& u, int ui, int wr, int wc, int fr, int fq) const {
#pragma unroll
        for (int ai = 0; ai < 2; ++ai)
#pragma unroll
            for (int bj = 0; bj < 2; ++bj)
#pragma unroll
                for (int m = 0; m < 4; ++m)
#pragma unroll
                    for (int n = 0; n < 2; ++n) { f32x4 t = acc[ai][bj][m][n]; asm volatile("" :: "v"(t)); }
    }
};
struct EpiInProj {
    static constexpr bool PERM = false, AFTER_DRAIN = false;
    const PG8_LAS float* rstd; const PG8_LAS float* prm; unsigned char* ws;
    __device__ __forceinline__ static float head_f(const f32x4 (&acc)[2][2][4][2], int ai, int m, float rs) {
        float ss = 0.f;
#pragma unroll
        for (int bj = 0; bj < 2; ++bj)
#pragma unroll
            for (int n = 0; n < 2; ++n) { const f32x4 a = acc[ai][bj][m][n]; ss += (a[0] * a[0] + a[1] * a[1]) + (a[2] * a[2] + a[3] * a[3]); }
        ss += xor_lane<16>(ss); ss = sum_x32(ss);
        return rs / sqrtf(ss * rs * rs * (1.0f / 64.0f) + 1e-6f);
    }
    __device__ __forceinline__ void operator()(const f32x4 (&acc)[2][2][4][2], const Unit& u, int ui, int wr, int wc, int fr, int fq) const {
        const int G = __builtin_amdgcn_readfirstlane(u.pn * 4 + wc);
        unsigned char* w2 = ws; LAUNDER_G(w2);
        asm volatile("" : "+v"(fr), "+v"(fq));
        const int row0 = wr * 64 + fr;
        if (G < 10) {
            const bool isq = G < 8;
            const PG8_LAS float* gp = prm + (isq ? PRM_GAQ : PRM_GAK) + 4 * fq;
            const float* rope = (const float*)(w2 + WS_ROPE) + 4 * fq;
            const float qs = isq ? 0.125f * 1.4426950408889634f : 1.0f;
            unsigned char* db = isq ? (w2 + WS_QA) + (size_t)G * MROWS * 64 + 8 * fq : (w2 + WS_KA) + (size_t)(G - 8) * MROWS * 64 + (fq >> 1) * 512 + 8 * (fq & 1);
#pragma unroll
            for (int ai = 0; ai < 2; ++ai)
#pragma unroll
                for (int m = 0; m < 4; ++m) {
                    const int rl = ai * HALF + m * 16 + row0; const int t = u.pm * BM + rl; const float f = head_f(acc, ai, m, rstd[ui * 256 + rl]) * qs;
                    unsigned char* dt = isq ? db + (size_t)t * 64 : db + (size_t)(t >> 6) * 4096 + ((t & 63) >> 5) * 2048 + (t & 31) * 16;
#pragma unroll
                    for (int bj = 0; bj < 2; ++bj) {
                        const f32x4 x1 = acc[ai][bj][m][0] * f * *(const PG8_LAS f32x4*)(gp + 32 * bj), x2 = acc[ai][bj][m][1] * f * *(const PG8_LAS f32x4*)(gp + 32 * bj + 16);
                        const int pos = bj ? (t & 63) : (t >> 6); const float* rp = rope + (bj ? 8192 : 0) + pos * 16;
                        const f32x4 c = *(const f32x4*)rp, s = *(const f32x4*)(rp + (bj ? 1024 : 4096));
                        const f32x4 y1 = x1 * c - x2 * s, y2 = x2 * c + x1 * s;
                        int lo = __builtin_amdgcn_cvt_pk_fp8_f32(y1[0], y1[1], 0, false); lo = __builtin_amdgcn_cvt_pk_fp8_f32(y1[2], y1[3], lo, true);
                        int hi = __builtin_amdgcn_cvt_pk_fp8_f32(y2[0], y2[1], 0, false); hi = __builtin_amdgcn_cvt_pk_fp8_f32(y2[2], y2[3], hi, true);
                        u32x2 w; w.x = (unsigned)lo; w.y = (unsigned)hi;
                        *(u32x2*)(dt + (isq ? 32 * bj : 1024 * bj)) = w;
                    }
                    asm volatile("" ::: "memory");
                }
        } else if (G < 12) {
            unsigned char* V8 = (w2 + WS_VA) + (size_t)(G - 10) * MROWS * 64 + (4 * fq) * 16;
#pragma unroll
            for (int ai = 0; ai < 2; ++ai)
#pragma unroll
                for (int m = 0; m < 4; ++m) {
                    const int rl = ai * HALF + m * 16 + row0; const int t = u.pm * BM + rl; const float rs = rstd[ui * 256 + rl];
                    const int kk = t & 63, c = kk >> 5, r = kk & 31, h = (r >> 2) & 1, jj = (r & 3) + 4 * (r >> 3);
                    unsigned char* vb = V8 + (size_t)(t >> 6) * 4096 + h * 1024 + c * 512 + jj;
#pragma unroll
                    for (int bj = 0; bj < 2; ++bj)
#pragma unroll
                        for (int n = 0; n < 2; ++n) { const f32x4 v = acc[ai][bj][m][n] * rs;
                            const int p01 = __builtin_amdgcn_cvt_pk_fp8_f32(v[0], v[1], 0, false), p23 = __builtin_amdgcn_cvt_pk_fp8_f32(v[2], v[3], 0, false);
                            unsigned char* q = vb + bj * 2048 + (16 * n) * 16;
                            q[0] = (unsigned char)(p01 & 0xff); q[16] = (unsigned char)((p01 >> 8) & 0xff); q[32] = (unsigned char)(p23 & 0xff); q[48] = (unsigned char)((p23 >> 8) & 0xff); }
                    asm volatile("" ::: "memory");
                }
        } else if (G < 28) {
            const bool isq = G < 20;
            const PG8_LAS float* gp = prm + (isq ? PRM_GBQ : PRM_GBK) + 4 * fq;
            const float qs = isq ? 0.125f * 1.4426950408889634f : 1.0f;
            bf16_t* db = isq ? (bf16_t*)(w2 + WS_QB) + (size_t)(G - 12) * MROWS * 64 + 8 * fq : (bf16_t*)(w2 + WS_KB) + (size_t)(G - 20) * MROWS * 64 + (size_t)fq * 512;
#pragma unroll
            for (int ai = 0; ai < 2; ++ai)
#pragma unroll
                for (int m = 0; m < 4; ++m) {
                    const int rl = ai * HALF + m * 16 + row0; const int t = u.pm * BM + rl; const float f = head_f(acc, ai, m, rstd[ui * 256 + rl]) * qs;
                    bf16_t* dt = isq ? db + (size_t)t * 64 : db + (size_t)(t >> 6) * 4096 + (t & 63) * 8;
#pragma unroll
                    for (int bj = 0; bj < 2; ++bj) {
                        const f32x4 x1 = acc[ai][bj][m][0] * f * *(const PG8_LAS f32x4*)(gp + 32 * bj), x2 = acc[ai][bj][m][1] * f * *(const PG8_LAS f32x4*)(gp + 32 * bj + 16);
                        u32x4 w; w.x = cvt_pk_bf16(x1[0], x1[1]); w.y = cvt_pk_bf16(x1[2], x1[3]); w.z = cvt_pk_bf16(x2[0], x2[1]); w.w = cvt_pk_bf16(x2[2], x2[3]);
                        *(u32x4*)(dt + (isq ? 32 * bj : 2048 * bj)) = w;
                    }
                    asm volatile("" ::: "memory");
                }
        } else {
            bf16_t* V = (bf16_t*)(w2 + WS_VB) + (size_t)((G - 28) >> 1) * MROWS * 128 + (64 * ((G - 28) & 1) + 4 * fq) * 8;
#pragma unroll
            for (int ai = 0; ai < 2; ++ai)
#pragma unroll
                for (int m = 0; m < 4; ++m) {
                    const int rl = ai * HALF + m * 16 + row0; const int t = u.pm * BM + rl; const float rs = rstd[ui * 256 + rl];
                    const int kk = t & 63, ks = kk >> 4, ko = kk & 15, hi = (ko >> 2) & 1, j = ((ko >> 3) << 2) | (ko & 3);
                    bf16_t* vb = V + (size_t)(((t >> 6) * 4 + ks) * 2 + hi) * 1024 + j;
#pragma unroll
                    for (int bj = 0; bj < 2; ++bj)
#pragma unroll
                        for (int n = 0; n < 2; ++n)
#pragma unroll
                            for (int e = 0; e < 4; ++e) vb[(32 * bj + 16 * n + e) * 8] = f2bf1(acc[ai][bj][m][n][e] * rs);
                    asm volatile("" ::: "memory");
                }
        }
    }
};

#ifndef NOTAIL
#define NOTAIL 0
#endif
template <int KD, class Epi, class Sched, bool ALIGN_EPI = false, bool SP2 = false, int LD = KD, bool VARK = false>
__device__ __forceinline__ void gemm_phase(PG8_LAS unsigned char* lds, const Gemm g, const Sched& S, const Epi& E, int wave_id) {
    int tid_ = wave_id * 64 + lane_id_v(); asm volatile("" : "+v"(tid_));
    const int tid = tid_, wid = __builtin_amdgcn_readfirstlane(tid >> 6), lane = tid & 63, wr = wid >> 2, wc = wid & 3, fr = lane & 15, fq = lane >> 4;
    constexpr int K = KD, ntc = K / BK; static_assert(ntc % 2 == 0, "even K-tile count");
    unsigned voffA[2], voffB[2];
#pragma unroll
    for (int i = 0; i < 2; ++i) { int R, C; stage_rc(tid * 16 + i * 8192, R, C); const int Rb = Epi::PERM ? ((R & ~31) + perm32(R & 31)) : R;
        voffA[i] = (unsigned)(R * LD + C) * 2u; voffB[i] = (unsigned)(Rb * LD + C) * 2u; }
    constexpr size_t kstep = (size_t)(BK * 2);
    constexpr size_t hstep = (size_t)HALF * LD * 2;
    constexpr size_t tstep = 2 * hstep;
    const unsigned ldsw = (unsigned)wid * 1024u;
    const int aoff = lds_byte(wr * 64 + fr, fq * 8), boff = lds_byte(wc * 32 + fr, fq * 8);
#define PG8_SA(b, h) (((b) * 2 + (h)) * HTB)
#define PG8_SB(b, h) ((4 + (b) * 2 + (h)) * HTB)
#define PG8_STAGE(bufoff, gbase, voff) do { _Pragma("unroll") for (int _i = 0; _i < 2; ++_i) \
        __builtin_amdgcn_global_load_lds((const unsigned*)((const char*)(gbase) + (voff)[_i]), (PG8_LAS unsigned*)(lds + (bufoff) + ldsw + _i * 8192), 16, 0, 0); } while (0)
#define PG8_LDA(dst, b, h) do { _Pragma("unroll") for (int m = 0; m < 4; ++m) _Pragma("unroll") for (int k = 0; k < 2; ++k) dst[m][k] = *(const PG8_LAS bf16x8*)(lds + PG8_SA(b, h) + aoff + m * 2048 + k * 1024); } while (0)
#define PG8_LDB(dst, b, h) do { _Pragma("unroll") for (int n = 0; n < 2; ++n) _Pragma("unroll") for (int k = 0; k < 2; ++k) dst[n][k] = *(const PG8_LAS bf16x8*)(lds + PG8_SB(b, h) + boff + n * 2048 + k * 1024); } while (0)
#define PG8_MMA(ai, bj, At, Bt) do { __builtin_amdgcn_s_setprio(1); _Pragma("unroll") for (int m = 0; m < 4; ++m) _Pragma("unroll") for (int n = 0; n < 2; ++n) _Pragma("unroll") for (int k = 0; k < 2; ++k) \
        acc[ai][bj][m][n] = __builtin_amdgcn_mfma_f32_16x16x32_bf16(Bt[n][k], At[m][k], acc[ai][bj][m][n], 0, 0, 0); __builtin_amdgcn_s_setprio(0); } while (0)
#define PG8_WAIT_V(n) asm volatile("s_waitcnt vmcnt(" #n ")" ::: "memory")
#define PG8_WAIT_L(n) asm volatile("s_waitcnt lgkmcnt(" #n ")" ::: "memory")
#define PG8_BAR __builtin_amdgcn_s_barrier()
#define PG8_SCHED __builtin_amdgcn_sched_barrier(0)
    Unit cur, nxt; int ui = 0;
    if (!S.next(0, cur)) return;
    f32x4 acc[2][2][4][2];
#pragma unroll
    for (int a = 0; a < 2; ++a)
#pragma unroll
        for (int b = 0; b < 2; ++b)
#pragma unroll
            for (int m = 0; m < 4; ++m)
#pragma unroll
                for (int n = 0; n < 2; ++n) acc[a][b][m][n] = (f32x4){0.f, 0.f, 0.f, 0.f};
    bf16x8 At[4][2], B0[2][2], B1[2][2];
    const char* cA = (const char*)g.A + (size_t)cur.pm * tstep + (VARK ? cur.kofs : 0); const char* cB = (const char*)g.Bt + (size_t)cur.pn * tstep + (VARK ? cur.kofs : 0);
    S.a_ready(cur);
    if constexpr (SP2) {
        PG8_STAGE(PG8_SB(0, 0), cB, voffB); PG8_STAGE(PG8_SB(0, 1), cB + hstep, voffB); PG8_STAGE(PG8_SA(0, 0), cA, voffA); PG8_STAGE(PG8_SA(0, 1), cA + hstep, voffA);
        if (wr == 1) PG8_BAR;
        PG8_WAIT_V(2); PG8_BAR;
        PG8_STAGE(PG8_SB(1, 0), cB + kstep, voffB); PG8_STAGE(PG8_SA(1, 0), cA + kstep, voffA); PG8_STAGE(PG8_SB(1, 1), cB + hstep + kstep, voffB);
        PG8_WAIT_V(6); PG8_BAR;
    } else {
        PG8_STAGE(PG8_SB(0, 0), cB, voffB); PG8_STAGE(PG8_SA(0, 0), cA, voffA); PG8_STAGE(PG8_SB(0, 1), cB + hstep, voffB); PG8_STAGE(PG8_SA(0, 1), cA + hstep, voffA);
        if (wr == 1) PG8_BAR;
        PG8_WAIT_V(4); PG8_BAR;
        PG8_STAGE(PG8_SB(1, 0), cB + kstep, voffB); PG8_STAGE(PG8_SA(1, 0), cA + kstep, voffA); PG8_STAGE(PG8_SB(1, 1), cB + hstep + kstep, voffB);
        PG8_WAIT_V(6); PG8_BAR;
    }
    for (;;) {
        const bool has_next = S.next(ui + 1, nxt);
        const char* nA = has_next ? (const char*)g.A + (size_t)nxt.pm * tstep + (VARK ? nxt.kofs : 0) : cA; const char* nB = has_next ? (const char*)g.Bt + (size_t)nxt.pn * tstep + (VARK ? nxt.kofs : 0) : cB;
        const int nt = VARK ? cur.nt : ntc;
        for (int t = 0; t < nt; t += 2) {
            const bool last = (t == nt - 2); const bool fin = last && !has_next;
            const char* a1 = cA + (size_t)(t + 1) * kstep;
            const char* a2 = last ? nA : cA + (size_t)(t + 2) * kstep; const char* b2 = last ? nB : cB + (size_t)(t + 2) * kstep;
            const char* a3 = a2 + kstep; const char* b3 = b2 + kstep;
            if (last && has_next) S.a_ready(nxt);
            if constexpr (SP2) {
            PG8_LDB(B0, 0, 0); PG8_LDB(B1, 0, 1); PG8_SCHED; PG8_LDA(At, 0, 0); PG8_STAGE(PG8_SA(1, 1), a1 + hstep, voffA);
            PG8_WAIT_V(8); PG8_WAIT_L(0); PG8_BAR; PG8_MMA(0, 0, At, B0); PG8_MMA(0, 1, At, B1); PG8_BAR; PG8_SCHED;
            PG8_LDA(At, 0, 1); if (NOTAIL && fin) { PG8_WAIT_V(2); } else { PG8_STAGE(PG8_SB(0, 0), b2, voffB); PG8_STAGE(PG8_SB(0, 1), b2 + hstep, voffB); PG8_STAGE(PG8_SA(0, 0), a2, voffA); PG8_WAIT_V(8); }
            PG8_WAIT_L(0); PG8_BAR; PG8_MMA(1, 0, At, B0); PG8_MMA(1, 1, At, B1); PG8_BAR; PG8_SCHED;
            PG8_LDB(B0, 1, 0); PG8_LDB(B1, 1, 1); PG8_SCHED; PG8_LDA(At, 1, 0); if (NOTAIL && fin) { PG8_WAIT_V(0); } else { PG8_STAGE(PG8_SA(0, 1), a2 + hstep, voffA); PG8_WAIT_V(8); }
            PG8_WAIT_L(0); PG8_BAR; PG8_MMA(0, 0, At, B0); PG8_MMA(0, 1, At, B1); PG8_BAR; PG8_SCHED;
            PG8_LDA(At, 1, 1); if (!(NOTAIL && fin)) { PG8_STAGE(PG8_SB(1, 0), b3, voffB); PG8_STAGE(PG8_SB(1, 1), b3 + hstep, voffB); PG8_STAGE(PG8_SA(1, 0), a3, voffA); PG8_WAIT_V(8); }
            PG8_WAIT_L(0); PG8_BAR; PG8_MMA(1, 0, At, B0); PG8_MMA(1, 1, At, B1); PG8_BAR; PG8_SCHED;
            } else {
            PG8_LDB(B0, 0, 0); PG8_SCHED; PG8_LDA(At, 0, 0); PG8_STAGE(PG8_SA(1, 1), a1 + hstep, voffA);
            PG8_WAIT_L(8); PG8_BAR; PG8_WAIT_L(0); PG8_MMA(0, 0, At, B0); PG8_BAR; PG8_SCHED;
            PG8_LDB(B1, 0, 1); PG8_STAGE(PG8_SB(0, 0), b2, voffB);
            PG8_BAR; PG8_WAIT_L(0); PG8_MMA(0, 1, At, B1); PG8_BAR;
            PG8_LDA(At, 0, 1); PG8_STAGE(PG8_SA(0, 0), a2, voffA);
            PG8_BAR; PG8_WAIT_L(0); PG8_MMA(1, 0, At, B0); PG8_BAR; PG8_SCHED;
            PG8_STAGE(PG8_SB(0, 1), b2 + hstep, voffB);
            PG8_WAIT_V(6); PG8_BAR; PG8_MMA(1, 1, At, B1); PG8_BAR;
            PG8_LDB(B0, 1, 0); PG8_SCHED; PG8_LDA(At, 1, 0); PG8_STAGE(PG8_SA(0, 1), a2 + hstep, voffA);
            PG8_WAIT_L(8); PG8_BAR; PG8_WAIT_L(0); PG8_MMA(0, 0, At, B0); PG8_BAR; PG8_SCHED;
            PG8_LDB(B1, 1, 1); PG8_STAGE(PG8_SB(1, 0), b3, voffB);
            PG8_BAR; PG8_WAIT_L(0); PG8_MMA(0, 1, At, B1); PG8_BAR;
            PG8_LDA(At, 1, 1); PG8_STAGE(PG8_SA(1, 0), a3, voffA);
            PG8_BAR; PG8_WAIT_L(0); PG8_MMA(1, 0, At, B0); PG8_BAR; PG8_SCHED;
            PG8_STAGE(PG8_SB(1, 1), b3 + hstep, voffB);
            PG8_WAIT_V(6); PG8_BAR; PG8_MMA(1, 1, At, B1); PG8_BAR;
            }
        }
        if constexpr (ALIGN_EPI) { if (wr == 0) PG8_BAR; }
        if constexpr (!Epi::AFTER_DRAIN) { E(acc, cur, ui, wr, wc, fr, fq); S.done(cur); }
        if (!has_next) break;
#pragma unroll
        for (int a = 0; a < 2; ++a)
#pragma unroll
            for (int b = 0; b < 2; ++b)
#pragma unroll
                for (int m = 0; m < 4; ++m)
#pragma unroll
                    for (int n = 0; n < 2; ++n) acc[a][b][m][n] = (f32x4){0.f, 0.f, 0.f, 0.f};
        cur = nxt; cA = nA; cB = nB; ++ui;
        if constexpr (ALIGN_EPI) { if (wr == 1) PG8_BAR; }
    }
    PG8_WAIT_V(0);
    if constexpr (!ALIGN_EPI) { if (wr == 0) PG8_BAR; }
    PG8_BAR;
    if constexpr (Epi::AFTER_DRAIN) { E.fused(acc, cur, wr, wc, fr, fq, lds, wid, lane); S.done(cur); }
#undef PG8_SA
#undef PG8_SB
#undef PG8_STAGE
#undef PG8_LDA
#undef PG8_LDB
#undef PG8_MMA
#undef PG8_WAIT_V
#undef PG8_WAIT_L
#undef PG8_BAR
#undef PG8_SCHED
}
}
namespace att {
typedef unsigned short bf16_t;
typedef short bf16x8 __attribute__((ext_vector_type(8)));
typedef float f32x16 __attribute__((ext_vector_type(16)));
typedef float f32x4 __attribute__((ext_vector_type(4)));
typedef unsigned u32x4 __attribute__((ext_vector_type(4)));
#define ALAS __attribute__((address_space(3)))
constexpr int MROWS = M;
constexpr int WSF_OFF = 114688;
constexpr int LDS_NEED = WSF_OFF + 8 * 256;
__device__ __forceinline__ int crow(int r, int hi) { return (r & 3) + 8 * (r >> 2) + 4 * hi; }
__device__ __forceinline__ void glds16(const void* gsrc, unsigned lds_dst) { unsigned keep;
    asm volatile("s_mov_b32 %0, m0\n\ts_mov_b32 m0, %2\n\ts_nop 0\n\tglobal_load_lds_dwordx4 %1, off\n\ts_mov_b32 m0, %0" : "=&s"(keep) : "v"(gsrc), "s"(lds_dst) : "memory"); }
typedef float f32x2_t __attribute__((ext_vector_type(2))); typedef __bf16 bf16x2_t __attribute__((ext_vector_type(2)));
__device__ __forceinline__ unsigned cvtpk(float lo, float hi) { f32x2_t v = {lo, hi}; bf16x2_t b = __builtin_convertvector(v, bf16x2_t); return __builtin_bit_cast(unsigned, b); }
__device__ __forceinline__ void glds16s(const void* sbase, unsigned voff, unsigned lds_dst) { unsigned keep;
#ifdef GLDS_M0_CLOBBER
    (void)keep; asm volatile("s_mov_b32 m0, %2\n\ts_nop 0\n\tglobal_load_lds_dwordx4 %0, %1" :: "v"(voff), "s"(sbase), "s"(lds_dst) : "memory", "m0"); }
#else
    asm volatile("s_mov_b32 %0, m0\n\ts_mov_b32 m0, %3\n\ts_nop 0\n\tglobal_load_lds_dwordx4 %1, %2\n\ts_mov_b32 m0, %0" : "=&s"(keep) : "v"(voff), "s"(sbase), "s"(lds_dst) : "memory"); }
#endif
#define ATT_WAIT_BAR(N) asm volatile("s_waitcnt vmcnt(" #N ") lgkmcnt(0)\n\ts_barrier" ::: "memory")
#define ATT_MFMA(a, b, c) __builtin_amdgcn_mfma_f32_32x32x16_bf16(a, b, c, 0, 0, 0)

struct Tensors { unsigned char* ws; const ALAS float* subln; };
__device__ __forceinline__ Tensors make_tensors(unsigned char* ws, const ALAS float* prm) { return Tensors{ws, prm + PRM_SUBLN}; }
#define T_QA ((const bf16_t*)(tws_ + WS_QA))
#define T_KA ((const bf16_t*)(tws_ + WS_KA))
#define T_VA ((const bf16_t*)(tws_ + WS_VA))
#define T_QB ((const bf16_t*)(tws_ + WS_QB))
#define T_KB ((const bf16_t*)(tws_ + WS_KB))
#define T_VB ((const bf16_t*)(tws_ + WS_VB))
#define T_MIX ((bf16_t*)(tws_ + WS_MIX))

#define SBAR() __builtin_amdgcn_sched_barrier(0)
#define PIN(x) asm volatile("" : "+v"(x))
#define PKW(P, B) cvtpk(P[B], P[(B) + 1])
#define EX(v) __builtin_amdgcn_exp2f(v)
#define WB_SEL(n) do { switch (n) { case 0: ATT_WAIT_BAR(0); break; case 1: ATT_WAIT_BAR(1); break; case 2: ATT_WAIT_BAR(2); break; case 3: ATT_WAIT_BAR(3); break; case 4: ATT_WAIT_BAR(4); break; case 6: ATT_WAIT_BAR(6); break; default: ATT_WAIT_BAR(8); } } while (0)
template <bool ISB, int BPROBE = 0>
__device__ __forceinline__ void attn_unit(const Tensors& T, int head, int qb, float negM2, float lam, float c2, int dskip, char* shm, int wave_id) {
    unsigned char* tws_ = T.ws; LAUNDER_G(tws_);
    constexpr int DV = ISB ? 128 : 64, ND0 = DV / 32, NK = ISB ? 2 : 1, NV = ISB ? 2 : 1;
    constexpr int KSLOT = ISB ? 16384 : 8192, VSLOT = ISB ? 16384 : 8192, LDS_K = 0, LDS_V = 3 * KSLOT;
    int tid_ = wave_id * 64 + lane_id_v(); asm volatile("" : "+v"(tid_));
    const int tid = tid_, lane = tid & 63, r32 = lane & 31, hi = lane >> 5; const int wid = __builtin_amdgcn_readfirstlane(tid >> 6);
    const int mapc = ISB ? (wid >> 2) : 0, wq = ISB ? (wid & 3) : wid;
    const int q0 = ISB ? qb * 128 : qb * 256; const int qrow = q0 + wq * 32 + r32;
    int t0 = 0, t1 = 256;
    if (ISB) { const int lo = q0 - dskip, hi_ = q0 + 127 + dskip; t0 = lo > 0 ? (lo >> 6) : 0; t1 = (hi_ >> 6) + 1; if (t1 > 256) t1 = 256;
        if ((t1 - t0) & 1) { if (t0 > 0) --t0; else ++t1; } }
    const int n = t1 - t0;
    const unsigned lds0 = (unsigned)(uintptr_t)shm;
    const ALAS char* shm3 = (const ALAS char*)shm;
    const char* k1b = ISB ? (const char*)(T_KB + (size_t)(2 * head) * MROWS * 64) + (size_t)t0 * 8192 : (const char*)(T_KA + (size_t)(head >> 2) * MROWS * 64);
    const char* k2b = ISB ? (const char*)(T_KB + (size_t)(2 * head + 1) * MROWS * 64) + (size_t)t0 * 8192 : nullptr;
    const char* vb_ = ISB ? (const char*)(T_VB + (size_t)head * MROWS * 128) + (size_t)t0 * 16384 : (const char*)(T_VA + (size_t)(head >> 2) * MROWS * 64);
    const unsigned dvo = (unsigned)(wid * 1024 + lane * 16);
    const unsigned kdst = lds0 + LDS_K + wid * 1024, vdst = lds0 + LDS_V + wid * 1024;
#define DMA_K(i, so) do { glds16s(k1b + (size_t)(i) * 8192, dvo, (unsigned)__builtin_amdgcn_readfirstlane(kdst + (so))); if (ISB) glds16s(k2b + (size_t)(i) * 8192, dvo, (unsigned)__builtin_amdgcn_readfirstlane(kdst + (so) + 8192)); } while (0)
#define DMA_V(i, so) do { if (ISB) { glds16s(vb_ + (size_t)(i) * 16384, dvo, (unsigned)__builtin_amdgcn_readfirstlane(vdst + (so))); glds16s(vb_ + (size_t)(i) * 16384 + 8192, dvo, (unsigned)__builtin_amdgcn_readfirstlane(vdst + (so) + 8192)); } \
      else glds16s(vb_ + (size_t)(i) * 8192, dvo, (unsigned)__builtin_amdgcn_readfirstlane(vdst + (so))); } while (0)
    DMA_K(0, 0); DMA_V(0, 0); DMA_K(1, KSLOT); DMA_V(1, VSLOT);
    const bf16_t* Qw = (ISB ? T_QB + (size_t)(2 * head + mapc) * MROWS * 64 : T_QA + (size_t)head * MROWS * 64) + (size_t)qrow * 64;
    bf16x8 qr[4];
#pragma unroll
    for (int d0 = 0; d0 < 4; ++d0) qr[d0] = *(const bf16x8*)(Qw + d0 * 16 + hi * 8);
    f32x16 o[ND0];
#pragma unroll
    for (int d = 0; d < ND0; ++d) o[d] = f32x16{};
    f32x16 negm;
#pragma unroll
    for (int r = 0; r < 16; ++r) negm[r] = negM2;
    asm volatile("" : "+v"(negm));
    float l_reg = 0.f;
    f32x16 osum = f32x16{}; bf16x8 ones; { const short o1 = (short)0x3f80; ones = (bf16x8){o1, o1, o1, o1, o1, o1, o1, o1}; } asm volatile("" : "+v"(ones));
    const ALAS char* kp0 = shm3 + LDS_K + (ISB ? mapc * 8192 : 0) + hi * 1024 + r32 * 16;
    const ALAS char* vp0 = shm3 + LDS_V + hi * (DV * 16) + r32 * 16;
    const int qw_lo = q0 + wq * 32, qw_hi = qw_lo + 31;
    const float nc2 = -c2; const float dl0 = (float)(64 * t0 - qrow + 4 * hi);
#define BIAS_GEN4(X, B, DC) do { const float e1_ = (DC) + 1.0f, e2_ = (DC) + 2.0f, e3_ = e1_ + 2.0f; \
        X[B] = __builtin_fmaf(__builtin_fabsf(DC), nc2, negM2); X[(B) + 1] = __builtin_fmaf(__builtin_fabsf(e1_), nc2, negM2); X[(B) + 2] = __builtin_fmaf(__builtin_fabsf(e2_), nc2, negM2); X[(B) + 3] = __builtin_fmaf(__builtin_fabsf(e3_), nc2, negM2); DC += 8.0f; } while (0)
#define BIAS_FAST4(X, B, DC) do { X[B] = __builtin_fmaf(sc1_, (DC), negM2); float t1_ = X[B] + sc1_; asm volatile("" : "+v"(t1_)); float t2_ = X[B] + sc2_; asm volatile("" : "+v"(t2_)); X[(B) + 1] = t1_; X[(B) + 2] = t2_; X[(B) + 3] = X[B] + sc3_; DC += 8.0f; } while (0)
#define BIAS_ALL(X0, X1, DL) do { float dc_ = (DL); BIAS_GEN4(X0, 0, dc_); BIAS_GEN4(X0, 4, dc_); BIAS_GEN4(X0, 8, dc_); BIAS_GEN4(X0, 12, dc_); BIAS_GEN4(X1, 0, dc_); BIAS_GEN4(X1, 4, dc_); BIAS_GEN4(X1, 8, dc_); BIAS_GEN4(X1, 12, dc_); } while (0)
#ifdef BIAS_CONST
    float cst[32];
#pragma unroll
    for (int e = 0; e < 32; ++e) { float cv_ = c2 * (float)(8 * (e >> 2) + (e & 3)); asm volatile("" : "+v"(cv_)); cst[e] = __builtin_bit_cast(float, __builtin_amdgcn_readfirstlane(__builtin_bit_cast(int, cv_))); }
#define BIAS_STEP_SETUP() const float base_ = __builtin_fmaf(sc1_, dcn_, negM2); float sgn_ = above_ ? -1.0f : 1.0f; asm volatile("" : "+v"(sgn_))
#else
#define BIAS_STEP_SETUP() do {} while (0)
#endif
    f32x16 pA0, pA1, pB0, pB1;
    bf16x8 kf[8], vf[B_VF8 ? 8 : 4]; u32x4 pw0, pw1, pw2, pw3;
    int ks_prev = 0, ks_cur = 0, ks_next = KSLOT, vs_prev = 0, vs_cur = VSLOT, vs_next = 2 * VSLOT, vs_n2 = 3 * VSLOT;
#define ROTK() do { ks_prev = ks_cur; ks_cur = ks_next; ks_next = (ks_next == 2 * KSLOT) ? 0 : ks_next + KSLOT; } while (0)
#define ROT() do { ROTK(); const int tv_ = vs_prev; vs_prev = vs_cur; vs_cur = vs_next; vs_next = vs_n2; vs_n2 = tv_; } while (0)
    DMA_K(2, 2 * KSLOT);
    WB_SEL(2 * NV + 2 * NK);
    if (ISB) { BIAS_ALL(pA0, pA1, dl0); } else { pA0 = negm; pA1 = negm; }
    {
        const ALAS char* kp = kp0;
#pragma unroll
        for (int d0 = 0; d0 < 4; ++d0) { const bf16x8 b0 = *(const ALAS bf16x8*)(kp + d0 * 2048), b1 = *(const ALAS bf16x8*)(kp + d0 * 2048 + 512);
            pA0 = ATT_MFMA(b0, qr[d0], pA0); pA1 = ATT_MFMA(b1, qr[d0], pA1); }
#pragma unroll
        for (int r = 0; r < 16; ++r) { pA0[r] = EX(pA0[r]); pA1[r] = EX(pA1[r]); }
    }
    WB_SEL(0);
    DMA_K(3, 0); DMA_V(2, 2 * VSLOT);
    ROTK();
#define KLOAD2(base, j) do { kf[2 * (j)] = *(const ALAS bf16x8*)((base) + (j) * 2048); kf[2 * (j) + 1] = *(const ALAS bf16x8*)((base) + (j) * 2048 + 512); } while (0)
    { const ALAS char* kb_ = kp0 + ks_cur; KLOAD2(kb_, 0); KLOAD2(kb_, 1); KLOAD2(kb_, 2); KLOAD2(kb_, 3); }
    if (ISB) { BIAS_ALL(pB0, pB1, dl0 + 64.f); }
    WB_SEL(NK + NV);
#define PAF(k) __builtin_bit_cast(bf16x8, pw##k)
#if (B_ORDER & 1)
#define GAPA(MF, A0, A1, A2, A3, W0, W1, PW) do { if (ISB) { sacc += A0; sacc += A1; sacc += A2; sacc += A3; PIN(sacc); } W0; W1; PIN(PW); SBAR(); MF; SBAR(); } while (0)
#else
#define GAPA(MF, A0, A1, A2, A3, W0, W1, PW) do { MF; if (ISB) { sacc += A0; sacc += A1; sacc += A2; sacc += A3; PIN(sacc); } W0; W1; PIN(PW); SBAR(); } while (0)
#endif
#define GAPB(MF, X, B) do { MF; X[B] = EX(X[B]); X[(B) + 1] = EX(X[(B) + 1]); X[(B) + 2] = EX(X[(B) + 2]); X[(B) + 3] = EX(X[(B) + 3]); PIN(X); SBAR(); } while (0)
#define GAPX(MF, EXS, X) do { MF; EXS; PIN(X); SBAR(); } while (0)
#define EXB(v) ((BPROBE & 1) ? __builtin_fmaxf((v), 1.0f) : EX(v))
#define EXE(C0, C1, k) do { if ((k) < 16) C0[(k) & 15] = EXB(C0[(k) & 15]); else C1[(k) & 15] = EXB(C1[(k) & 15]); } while (0)
#define EXN(C0, C1, k, N) do { EXE(C0, C1, k); if ((N) > 1) EXE(C0, C1, (k) + 1); if ((N) > 2) EXE(C0, C1, (k) + 2); } while (0)
#if (B_ORDER & 2)
#define GAPEN(MF, C0, C1, k, N) do { EXN(C0, C1, k, N); PIN(C0); PIN(C1); SBAR(); MF; SBAR(); } while (0)
#else
#define GAPEN(MF, C0, C1, k, N) do { MF; EXN(C0, C1, k, N); PIN(C0); PIN(C1); SBAR(); } while (0)
#endif
#define GAPE3(MF, C0, C1, k) do { MF; EXE(C0, C1, k); EXE(C0, C1, (k) + 1); EXE(C0, C1, (k) + 2); PIN(C0); PIN(C1); SBAR(); } while (0)
#ifdef BIAS_CONST
#define GAPC(MF, G, X, B, E0) do { MF; if (G) { { float a0_ = __builtin_fmaf(sgn_, cst[(E0) + (B)], base_), a1_ = __builtin_fmaf(sgn_, cst[(E0) + (B) + 1], base_), a2_ = __builtin_fmaf(sgn_, cst[(E0) + (B) + 2], base_), a3_ = __builtin_fmaf(sgn_, cst[(E0) + (B) + 3], base_); asm volatile("" : "+v"(a0_), "+v"(a1_), "+v"(a2_), "+v"(a3_)); X[B] = a0_; X[(B) + 1] = a1_; X[(B) + 2] = a2_; X[(B) + 3] = a3_; } \
        if (__builtin_expect(!fastb_, 0)) { float dg_ = dcn_ + (float)(8 * (((E0) + (B)) >> 2)); BIAS_GEN4(X, B, dg_); } PIN(X); } SBAR(); } while (0)
#else
#define GAPC(MF, G, X, B, E0) do { MF; if (G) { BIAS_FAST4(X, B, dcn_); if (__builtin_expect(!fastb_, 0)) { float dg_ = dcn_ - 8.0f; BIAS_GEN4(X, B, dg_); } PIN(X); } SBAR(); } while (0)
#endif
#define VRD(i) do { if (!(BPROBE & 4)) vf[i] = *(const ALAS bf16x8*)(vp_ + ((i) & 3) * (DV * 32) + ((i) >> 2) * 512); } while (0)
#define VRDN(i, d) do { if (!(BPROBE & 4)) vf[i] = *(const ALAS bf16x8*)(vp_ + (i) * (DV * 32) + (d) * 512); } while (0)
#define VRDX(slot, ks, d) do { if (!(BPROBE & 4)) vf[slot] = *(const ALAS bf16x8*)(vp_ + (ks) * (DV * 32) + (d) * 512); } while (0)
#define VRDA(i) do { vf[i] = *(const ALAS bf16x8*)(vp_ + (i) * (DV * 32) + 512); } while (0)
#define VRD2(i) do { vf[i] = *(const ALAS bf16x8*)(vp_ + ((i) & 3) * (DV * 32) + (((i) >> 2) + 2) * 512); } while (0)
#define KRD(G, j) do { if (G) { KLOAD2(kn_, j); SBAR(); } } while (0)
#define KRD1(G, j) do { if ((G) && !(BPROBE & 4)) { kf[j] = *(const ALAS bf16x8*)(kn_ + ((j) >> 1) * 2048 + ((j) & 1) * 512); SBAR(); } } while (0)
#define CIN(C) (ISB ? C : negm)
#define STEP(C0, C1, P0, P1, i, GK, GV, GL) do { SBAR(); \
    const ALAS char* vp_ = vp0 + vs_prev; const ALAS char* kn_ = kp0 + ks_next; float dcn_ = dl0 + 64.f * (float)((i) + 1); const int kt_ = 64 * (t0 + (i) + 1); const bool above_ = kt_ > qw_hi, fastb_ = above_ || (kt_ + 63 < qw_lo); \
    const float sc1_ = above_ ? nc2 : c2, sc2_ = sc1_ + sc1_, sc3_ = sc2_ + sc1_; BIAS_STEP_SETUP(); \
    VRD(0); SBAR(); float sacc = P0[0] + P0[1]; \
    GAPA(C0 = ATT_MFMA(kf[0], qr[0], CIN(C0)), P0[2], P0[3], P0[4], P0[5],     pw0[0] = PKW(P0, 0), pw0[1] = PKW(P0, 2), pw0); \
    if (B_VF8) { VRDX(4, 0, 1); } SBAR(); GAPA(C1 = ATT_MFMA(kf[1], qr[0], CIN(C1)), P0[6], P0[7], P0[8], P0[9],     pw0[2] = PKW(P0, 4), pw0[3] = PKW(P0, 6), pw0); \
    VRD(1); SBAR(); GAPA(C0 = ATT_MFMA(kf[2], qr[1], C0),   P0[10], P0[11], P0[12], P0[13], pw1[0] = PKW(P0, 8), pw1[1] = PKW(P0, 10), pw1); \
    if (B_VF8) { VRDX(5, 1, 1); } SBAR(); GAPA(C1 = ATT_MFMA(kf[3], qr[1], C1),   P0[14], P0[15], P1[0], P1[1],   pw1[2] = PKW(P0, 12), pw1[3] = PKW(P0, 14), pw1); \
    VRD(2); SBAR(); GAPA(C0 = ATT_MFMA(kf[4], qr[2], C0),   P1[2], P1[3], P1[4], P1[5],     pw2[0] = PKW(P1, 0), pw2[1] = PKW(P1, 2), pw2); \
    if (B_VF8) { VRDX(6, 2, 1); } SBAR(); GAPA(C1 = ATT_MFMA(kf[5], qr[2], C1),   P1[6], P1[7], P1[8], P1[9],     pw2[2] = PKW(P1, 4), pw2[3] = PKW(P1, 6), pw2); \
    VRD(3); SBAR(); GAPA(C0 = ATT_MFMA(kf[6], qr[3], C0),   P1[10], P1[11], P1[12], P1[13], pw3[0] = PKW(P1, 8), pw3[1] = PKW(P1, 10), pw3); \
    if (B_VF8) { VRDX(7, 3, 1); } SBAR(); GAPA(C1 = ATT_MFMA(kf[7], qr[3], C1),   P1[14], P1[15], 0.f, 0.f,       pw3[2] = PKW(P1, 12), pw3[3] = PKW(P1, 14), pw3); \
    l_reg += sacc; \
    if (!(BPROBE & 2)) { if (BDMA_MODE < 4) { if (GK) { DMA_K((i) + 3, ks_cur); } } if (BDMA_MODE == 0 || BDMA_MODE == 4) { if (GV) { DMA_V((i) + 2, vs_n2); } } } \
    SBAR(); \
    if (!ISB) { \
        GAPX(o[0] = ATT_MFMA(PAF(0), vf[0], o[0]), C0[0] = EX(C0[0]); C0[1] = EX(C0[1]); C0[2] = EX(C0[2]), C0); \
        VRDA(0); SBAR(); GAPX(o[0] = ATT_MFMA(PAF(1), vf[1], o[0]), C0[3] = EX(C0[3]); C0[4] = EX(C0[4]); C0[5] = EX(C0[5]), C0); \
        VRDA(1); SBAR(); GAPX(osum = ATT_MFMA(PAF(0), ones, osum),  C0[6] = EX(C0[6]); C0[7] = EX(C0[7]); C0[8] = EX(C0[8]), C0); \
        GAPX(o[0] = ATT_MFMA(PAF(2), vf[2], o[0]), C0[9] = EX(C0[9]); C0[10] = EX(C0[10]); C0[11] = EX(C0[11]), C0); \
        VRDA(2); SBAR(); GAPX(o[0] = ATT_MFMA(PAF(3), vf[3], o[0]), C0[12] = EX(C0[12]); C0[13] = EX(C0[13]); C0[14] = EX(C0[14]), C0); \
        VRDA(3); SBAR(); GAPX(osum = ATT_MFMA(PAF(1), ones, osum),  C0[15] = EX(C0[15]); C1[0] = EX(C1[0]); C1[1] = EX(C1[1]), C1); PIN(C0); \
        KRD(GL, 0); GAPX(o[1] = ATT_MFMA(PAF(0), vf[0], o[1]), C1[2] = EX(C1[2]); C1[3] = EX(C1[3]); C1[4] = EX(C1[4]), C1); \
        KRD(GL, 1); GAPX(o[1] = ATT_MFMA(PAF(1), vf[1], o[1]), C1[5] = EX(C1[5]); C1[6] = EX(C1[6]); C1[7] = EX(C1[7]), C1); \
        KRD(GL, 2); GAPX(osum = ATT_MFMA(PAF(2), ones, osum),  C1[8] = EX(C1[8]); C1[9] = EX(C1[9]); C1[10] = EX(C1[10]), C1); \
        KRD(GL, 3); GAPX(o[1] = ATT_MFMA(PAF(2), vf[2], o[1]), C1[11] = EX(C1[11]); C1[12] = EX(C1[12]), C1); \
        GAPX(o[1] = ATT_MFMA(PAF(3), vf[3], o[1]), C1[13] = EX(C1[13]); C1[14] = EX(C1[14]), C1); \
        GAPX(osum = ATT_MFMA(PAF(3), ones, osum),  C1[15] = EX(C1[15]), C1); \
    } else { \
        GAPEN(o[0] = ATT_MFMA(PAF(0), vf[0], o[0]), C0, C1, 0, 3);  VRDN(0, B_VF8 ? 2 : 1); KRD1(GL, 0); SBAR(); \
        GAPEN(o[0] = ATT_MFMA(PAF(1), vf[1], o[0]), C0, C1, 3, 2);  VRDN(1, B_VF8 ? 2 : 1); KRD1(GL, 1); SBAR(); \
        GAPEN(o[0] = ATT_MFMA(PAF(2), vf[2], o[0]), C0, C1, 5, 3);  VRDN(2, B_VF8 ? 2 : 1); KRD1(GL, 2); SBAR(); \
        GAPEN(o[0] = ATT_MFMA(PAF(3), vf[3], o[0]), C0, C1, 8, 2);  VRDN(3, B_VF8 ? 2 : 1); KRD1(GL, 3); SBAR(); \
        if (BDMA_MODE == 2) { if (GV) { DMA_V((i) + 2, vs_n2); } SBAR(); } \
        GAPEN(o[1] = ATT_MFMA(PAF(0), vf[B_VF8 ? 4 : 0], o[1]), C0, C1, 10, 3); if (B_VF8) { VRDX(4, 0, 3); } else { VRDN(0, 2); } KRD1(GL, 4); SBAR(); \
        GAPEN(o[1] = ATT_MFMA(PAF(1), vf[B_VF8 ? 5 : 1], o[1]), C0, C1, 13, 2); if (B_VF8) { VRDX(5, 1, 3); } else { VRDN(1, 2); } KRD1(GL, 5); SBAR(); \
        GAPEN(o[1] = ATT_MFMA(PAF(2), vf[B_VF8 ? 6 : 2], o[1]), C0, C1, 15, 3); if (B_VF8) { VRDX(6, 2, 3); } else { VRDN(2, 2); } KRD1(GL, 6); SBAR(); \
        GAPEN(o[1] = ATT_MFMA(PAF(3), vf[B_VF8 ? 7 : 3], o[1]), C0, C1, 18, 2); if (B_VF8) { VRDX(7, 3, 3); } else { VRDN(3, 2); } KRD1(GL, 7); SBAR(); \
        if (BDMA_MODE == 1 || BDMA_MODE == 5) { if (GV) { DMA_V((i) + 2, vs_n2); } SBAR(); } if (BDMA_MODE == 4 || BDMA_MODE == 5) { if (GK) { DMA_K((i) + 3, ks_cur); } SBAR(); } \
        GAPC(o[ND0 - 2] = ATT_MFMA(PAF(0), vf[0], o[ND0 - 2]); EXN(C0, C1, 20, 2), GL, P0, 0, 0);  if (!B_VF8) { VRDN(0, 3); } SBAR(); \
        GAPC(o[ND0 - 2] = ATT_MFMA(PAF(1), vf[1], o[ND0 - 2]); EXN(C0, C1, 22, 1), GL, P0, 4, 0);  if (!B_VF8) { VRDN(1, 3); } SBAR(); \
        GAPC(o[ND0 - 2] = ATT_MFMA(PAF(2), vf[2], o[ND0 - 2]); EXN(C0, C1, 23, 2), GL, P0, 8, 0);  if (!B_VF8) { VRDN(2, 3); } SBAR(); \
        GAPC(o[ND0 - 2] = ATT_MFMA(PAF(3), vf[3], o[ND0 - 2]); EXN(C0, C1, 25, 1), GL, P0, 12, 0); if (!B_VF8) { VRDN(3, 3); } SBAR(); \
        GAPC(o[ND0 - 1] = ATT_MFMA(PAF(0), vf[B_VF8 ? 4 : 0], o[ND0 - 1]); EXN(C0, C1, 26, 2), GL, P1, 0, 16); \
        GAPC(o[ND0 - 1] = ATT_MFMA(PAF(1), vf[B_VF8 ? 5 : 1], o[ND0 - 1]); EXN(C0, C1, 28, 1), GL, P1, 4, 16); \
        GAPC(o[ND0 - 1] = ATT_MFMA(PAF(2), vf[B_VF8 ? 6 : 2], o[ND0 - 1]); EXN(C0, C1, 29, 2), GL, P1, 8, 16); \
        GAPC(o[ND0 - 1] = ATT_MFMA(PAF(3), vf[B_VF8 ? 7 : 3], o[ND0 - 1]); EXN(C0, C1, 31, 1); PIN(C1), GL, P1, 12, 16); \
        if (BDMA_MODE == 3) { if (GV) { DMA_V((i) + 2, vs_n2); } SBAR(); } \
    } } while (0)
    int i = 1;
    for (; i + 5 < n; i += 2) {
        STEP(pB0, pB1, pA0, pA1, i, true, true, true);     if (!(BPROBE & 16)) { if (BPROBE & 2) { WB_SEL(0); } else { WB_SEL(NK + 2 * NV); } } ROT();
        STEP(pA0, pA1, pB0, pB1, i + 1, true, true, true); if (!(BPROBE & 16)) { if (BPROBE & 2) { WB_SEL(0); } else { WB_SEL(NK + 2 * NV); } } ROT();
    }
#define ENDW(ii) do { if ((ii) + 3 < n) { WB_SEL(NK + 2 * NV); } else if ((ii) + 2 < n) { WB_SEL(2 * NV); } else { WB_SEL(0); } } while (0)
    for (; i + 1 < n; i += 2) {
        STEP(pB0, pB1, pA0, pA1, i, (i + 3 < n), (i + 2 < n), (i + 1 < n));         ENDW(i);     ROT();
        STEP(pA0, pA1, pB0, pB1, i + 1, (i + 4 < n), (i + 3 < n), (i + 2 < n));     ENDW(i + 1); ROT();
    }
    STEP(pB0, pB1, pA0, pA1, n - 1, false, false, false);
    { if (ISB) { float sacc = pB0[0] + pB0[1];
#pragma unroll
      for (int r = 2; r < 16; ++r) sacc += pB0[r];
#pragma unroll
      for (int r = 0; r < 16; ++r) sacc += pB1[r];
      l_reg += sacc; }
      pw0 = (u32x4){PKW(pB0, 0), PKW(pB0, 2), PKW(pB0, 4), PKW(pB0, 6)}; pw1 = (u32x4){PKW(pB0, 8), PKW(pB0, 10), PKW(pB0, 12), PKW(pB0, 14)};
      pw2 = (u32x4){PKW(pB1, 0), PKW(pB1, 2), PKW(pB1, 4), PKW(pB1, 6)}; pw3 = (u32x4){PKW(pB1, 8), PKW(pB1, 10), PKW(pB1, 12), PKW(pB1, 14)};
      SBAR();
      const ALAS char* vp_ = vp0 + vs_cur;
#pragma unroll
      for (int d = 0; d < ND0; ++d) {
          const bf16x8 v0 = *(const ALAS bf16x8*)(vp_ + 0 * (DV * 32) + d * 512), v1 = *(const ALAS bf16x8*)(vp_ + 1 * (DV * 32) + d * 512), v2 = *(const ALAS bf16x8*)(vp_ + 2 * (DV * 32) + d * 512), v3 = *(const ALAS bf16x8*)(vp_ + 3 * (DV * 32) + d * 512);
          o[d] = ATT_MFMA(PAF(0), v0, o[d]); o[d] = ATT_MFMA(PAF(1), v1, o[d]); o[d] = ATT_MFMA(PAF(2), v2, o[d]); o[d] = ATT_MFMA(PAF(3), v3, o[d]); }
      if (!ISB) { osum = ATT_MFMA(PAF(0), ones, osum); osum = ATT_MFMA(PAF(1), ones, osum); osum = ATT_MFMA(PAF(2), ones, osum); osum = ATT_MFMA(PAF(3), ones, osum); } }
    const float sacc = l_reg;
    const int lane_e = lane_id_v();
    ATT_WAIT_BAR(0);
    {
    const int lane = lane_e, r32 = lane & 31, hi = lane >> 5; const int q0 = ISB ? qb * 128 : qb * 256;
    float rli[16];
    ALAS float* wsf = (ALAS float*)(shm3 + WSF_OFF) + wid * 64;
    if (ISB) {
        const float l = sum_x32(sacc);
        if (hi == 0) wsf[r32] = l;
        asm volatile("s_waitcnt lgkmcnt(0)" ::: "memory");
#pragma unroll
        for (int r = 0; r < 16; ++r) rli[r] = __builtin_amdgcn_rcpf(wsf[crow(r, hi)]);
    } else {
#pragma unroll
        for (int r = 0; r < 16; ++r) rli[r] = __builtin_amdgcn_rcpf(osum[r]);
    }
    if (!ISB) {
        ALAS bf16_t* stg = (ALAS bf16_t*)shm3 + wid * 2048;
#pragma unroll
        for (int r = 0; r < 16; ++r) { const int orow = crow(r, hi);
#pragma unroll
            for (int d = 0; d < ND0; ++d) stg[orow * 64 + d * 32 + r32] = pg8::f2bf1(o[d][r] * rli[r]); }
        asm volatile("s_waitcnt lgkmcnt(0)" ::: "memory");
#pragma unroll
        for (int i = 0; i < 4; ++i) { const int row = i * 8 + (lane >> 3), ch = lane & 7; const u32x4 v = *(const ALAS u32x4*)(stg + row * 64 + ch * 8);
            *(u32x4*)(T_MIX + (size_t)(q0 + wid * 32 + row) * 1024 + head * 64 + ch * 8) = v; }
    } else {
        ALAS float* X = (ALAS float*)shm3 + wq * 4096;
        const float sc = (mapc == 1) ? lam : 1.0f;
        if (mapc == 1) {
#pragma unroll
            for (int r = 0; r < 16; ++r) { const int orow = crow(r, hi); const float f = rli[r] * sc;
#pragma unroll
                for (int d = 0; d < ND0; ++d) X[orow * 128 + d * 32 + r32] = o[d][r] * f; }
        }
        asm volatile("s_waitcnt lgkmcnt(0)\n\ts_barrier" ::: "memory");
        if (mapc == 0) {
#pragma unroll
            for (int r = 0; r < 16; ++r) { const int orow = crow(r, hi);
#pragma unroll
                for (int d = 0; d < ND0; ++d) { const int idx = orow * 128 + d * 32 + r32; X[idx] = o[d][r] * rli[r] - X[idx]; } }
            asm volatile("s_waitcnt lgkmcnt(0)" ::: "memory");
            const int qq = lane >> 1, hf = lane & 1;
            const ALAS float* rowp = X + qq * 128 + hf * 64;
            f32x4 vv[16]; float ss = 0.f;
#pragma unroll
            for (int i = 0; i < 16; ++i) { vv[i] = *(const ALAS f32x4*)(rowp + 4 * i); ss += (vv[i][0] * vv[i][0] + vv[i][1] * vv[i][1]) + (vv[i][2] * vv[i][2] + vv[i][3] * vv[i][3]); }
            ss += xor_lane<1>(ss);
            const float rs = 0.8f / sqrtf(ss * (1.0f / 128.0f) + 1e-6f);
            bf16_t* dst = T_MIX + (size_t)(q0 + wq * 32 + qq) * 1024 + 512 + head * 128 + hf * 64;
            const ALAS float* sl = T.subln + hf * 64;
#pragma unroll
            for (int i = 0; i < 8; ++i) { const f32x4 g0 = *(const ALAS f32x4*)(sl + 8 * i), g1 = *(const ALAS f32x4*)(sl + 8 * i + 4); const f32x4 a = vv[2 * i] * rs * g0, b = vv[2 * i + 1] * rs * g1;
                u32x4 w; w.x = cvtpk(a[0], a[1]); w.y = cvtpk(a[2], a[3]); w.z = cvtpk(b[0], b[1]); w.w = cvtpk(b[2], b[3]); *(u32x4*)(dst + 8 * i) = w; }
        }
    }
    }
    asm volatile("s_waitcnt lgkmcnt(0)\n\ts_barrier" ::: "memory");
#undef DMA_K
#undef DMA_V
#undef ROT
#undef STEP
#undef ENDW
#undef GAPA
#undef GAPB
#undef GAPC
#undef GAPE3
#undef GAPEN
#undef EXN
#undef EXE
#undef GAPX
#undef VRD
#undef VRD2
#undef VRDA
#undef VRDN
#undef KRD
#undef KRD1
#undef CIN
#undef PAF
#undef KLOAD2
#undef BIAS_GEN4
#undef BIAS_FAST4
#undef BIAS_ALL
#undef BIAS_STEP_SETUP
}

typedef int i32x8 __attribute__((ext_vector_type(8)));
typedef unsigned u32x8 __attribute__((ext_vector_type(8)));
#define MFMA8(a, b, c) __builtin_amdgcn_mfma_scale_f32_32x32x64_f8f6f4(a, b, c, 0, 0, 0, 0, 0, 0)
__device__ __forceinline__ void attn_unit_a8(const Tensors& T, int head, int qb, float negM2s, char* shm, int wave_id) {
    unsigned char* tws_ = T.ws; LAUNDER_G(tws_);
    constexpr int KSLOT = 4096, VSLOT = 4096, LDS_K = 0, LDS_V = 3 * KSLOT, n = 256;
    int tid_ = wave_id * 64 + lane_id_v(); asm volatile("" : "+v"(tid_));
    const int tid = tid_, lane = tid & 63, r32 = lane & 31, hi = lane >> 5; const int wid = __builtin_amdgcn_readfirstlane(tid >> 6);
    const int q0 = qb * 256; const int qrow = q0 + wid * 32 + r32;
    const unsigned lds0 = (unsigned)(uintptr_t)shm;
    const ALAS char* shm3 = (const ALAS char*)shm;
    const bool kw = wid < 4;
    const char* sb = (const char*)(tws_ + (kw ? WS_KA : WS_VA)) + (size_t)(head >> 2) * MROWS * 64 + (wid & 3) * 1024;
    const unsigned dvo = (unsigned)(lane * 16);
    const unsigned ddst = lds0 + (kw ? LDS_K : LDS_V) + (wid & 3) * 1024;
#define DMA8(i, so) glds16s(sb + (size_t)(i) * 4096, dvo, (unsigned)__builtin_amdgcn_readfirstlane(ddst + (so)))
#define WB8(NKW, NVW) do { if (kw) { WB_SEL(NKW); } else { WB_SEL(NVW); } } while (0)
    if (kw) { DMA8(0, 0); DMA8(1, KSLOT); DMA8(2, 2 * KSLOT); } else { DMA8(0, 0); DMA8(1, VSLOT); }
    const unsigned char* Qw = (tws_ + WS_QA) + ((size_t)head * MROWS + qrow) * 64 + hi * 32;
    i32x8 qf; { const u32x4 a_ = *(const u32x4*)Qw, b_ = *(const u32x4*)(Qw + 16); qf = (i32x8){(int)a_[0], (int)a_[1], (int)a_[2], (int)a_[3], (int)b_[0], (int)b_[1], (int)b_[2], (int)b_[3]}; }
    f32x16 o0 = f32x16{}, o1 = f32x16{}, osum = f32x16{};
    f32x16 negm;
#pragma unroll
    for (int r = 0; r < 16; ++r) negm[r] = negM2s;
    asm volatile("" : "+v"(negm));
    i32x8 ones; { const int o4 = 0x38383838; ones = (i32x8){o4, o4, o4, o4, o4, o4, o4, o4}; } asm volatile("" : "+v"(ones));
    const ALAS char* kp0 = shm3 + LDS_K + hi * 1024 + r32 * 16;
    const ALAS char* vp0 = shm3 + LDS_V + hi * 1024 + r32 * 16;
    f32x16 pA0, pA1, pB0, pB1;
    i32x8 kf0, kf1, vf0, vf1, pf = (i32x8){0, 0, 0, 0, 0, 0, 0, 0};
    int ks_prev = 0, ks_cur = 0, ks_next = KSLOT, vs_prev = 0, vs_cur = VSLOT, vs_next = 2 * VSLOT, vs_n2 = 3 * VSLOT;
#define ROTK8() do { ks_prev = ks_cur; ks_cur = ks_next; ks_next = (ks_next == 2 * KSLOT) ? 0 : ks_next + KSLOT; } while (0)
#define ROT8() do { ROTK8(); const int tv_ = vs_prev; vs_prev = vs_cur; vs_cur = vs_next; vs_next = vs_n2; vs_n2 = tv_; } while (0)
#define LD32(dst, p) do { const u32x4 a_ = *(const ALAS u32x4*)(p), b_ = *(const ALAS u32x4*)((p) + 512); dst = (i32x8){(int)a_[0], (int)a_[1], (int)a_[2], (int)a_[3], (int)b_[0], (int)b_[1], (int)b_[2], (int)b_[3]}; } while (0)
#define PK8(P, B, OLD) __builtin_amdgcn_cvt_pk_fp8_f32(P[(B) + 2], P[(B) + 3], __builtin_amdgcn_cvt_pk_fp8_f32(P[B], P[(B) + 1], OLD, false), true)
    WB8(2, 2);
    { LD32(kf0, kp0); LD32(kf1, kp0 + 2048);
      pA0 = MFMA8(kf0, qf, negm); pA1 = MFMA8(kf1, qf, negm);
#pragma unroll
      for (int r = 0; r < 16; ++r) { pA0[r] = EX(pA0[r]); pA1[r] = EX(pA1[r]); } }
    WB_SEL(0);
    if (kw) { DMA8(3, 0); } else { DMA8(2, 2 * VSLOT); }
    ROTK8();
    { const ALAS char* kb_ = kp0 + ks_cur; LD32(kf0, kb_); LD32(kf1, kb_ + 2048); }
    WB_SEL(1);
#define STEP8(C0, C1, P0, P1, i, GK, GV, GL) do { SBAR(); \
    const ALAS char* vp_ = vp0 + vs_prev; const ALAS char* kn_ = kp0 + ks_next; \
    LD32(vf0, vp_); LD32(vf1, vp_ + 2048); SBAR(); \
    C0 = MFMA8(kf0, qf, negm); \
    pf[0] = PK8(P0, 0, pf[0]); pf[1] = PK8(P0, 4, pf[1]); pf[2] = PK8(P0, 8, pf[2]); pf[3] = PK8(P0, 12, pf[3]); PIN(pf); SBAR(); \
    C1 = MFMA8(kf1, qf, negm); \
    pf[4] = PK8(P1, 0, pf[4]); pf[5] = PK8(P1, 4, pf[5]); pf[6] = PK8(P1, 8, pf[6]); pf[7] = PK8(P1, 12, pf[7]); PIN(pf); SBAR(); \
    if (kw) { if (GK) { DMA8((i) + 3, ks_cur); } } else { if (GV) { DMA8((i) + 2, vs_n2); } } \
    SBAR(); \
    o0 = MFMA8(pf, vf0, o0); \
    _Pragma("unroll") for (int r_ = 0; r_ < 16; ++r_) C0[r_] = EX(C0[r_]); PIN(C0); SBAR(); \
    if (GL) { LD32(kf0, kn_); LD32(kf1, kn_ + 2048); SBAR(); } \
    o1 = MFMA8(pf, vf1, o1); \
    _Pragma("unroll") for (int r_ = 0; r_ < 8; ++r_) C1[r_] = EX(C1[r_]); PIN(C1); SBAR(); \
    osum = MFMA8(pf, ones, osum); \
    _Pragma("unroll") for (int r_ = 8; r_ < 16; ++r_) C1[r_] = EX(C1[r_]); PIN(C1); SBAR(); \
    } while (0)
    int i = 1;
    for (; i + 5 < n; i += 2) {
        STEP8(pB0, pB1, pA0, pA1, i, true, true, true);     WB8(1, 2); ROT8();
        STEP8(pA0, pA1, pB0, pB1, i + 1, true, true, true); WB8(1, 2); ROT8();
    }
#define ENDW8(ii) do { if ((ii) + 3 < n) { WB8(1, 2); } else if ((ii) + 2 < n) { WB8(0, 2); } else { WB_SEL(0); } } while (0)
    for (; i + 1 < n; i += 2) {
        STEP8(pB0, pB1, pA0, pA1, i, (i + 3 < n), (i + 2 < n), (i + 1 < n));         ENDW8(i);     ROT8();
        STEP8(pA0, pA1, pB0, pB1, i + 1, (i + 4 < n), (i + 3 < n), (i + 2 < n));     ENDW8(i + 1); ROT8();
    }
    STEP8(pB0, pB1, pA0, pA1, n - 1, false, false, false);
    { pf[0] = PK8(pB0, 0, pf[0]); pf[1] = PK8(pB0, 4, pf[1]); pf[2] = PK8(pB0, 8, pf[2]); pf[3] = PK8(pB0, 12, pf[3]); pf[4] = PK8(pB1, 0, pf[4]); pf[5] = PK8(pB1, 4, pf[5]); pf[6] = PK8(pB1, 8, pf[6]); pf[7] = PK8(pB1, 12, pf[7]);
      const ALAS char* vp_ = vp0 + vs_cur; LD32(vf0, vp_); LD32(vf1, vp_ + 2048);
      o0 = MFMA8(pf, vf0, o0); o1 = MFMA8(pf, vf1, o1); osum = MFMA8(pf, ones, osum); }
    ATT_WAIT_BAR(0);
    {
        const int lane_e = lane_id_v(), l32 = lane_e & 31, hh = lane_e >> 5;
        ALAS bf16_t* stg = (ALAS bf16_t*)shm3 + wid * 2048;
#pragma unroll
        for (int r = 0; r < 16; ++r) { const int orow = crow(r, hh); const float rl = __builtin_amdgcn_rcpf(osum[r]);
            stg[orow * 64 + l32] = pg8::f2bf1(o0[r] * rl); stg[orow * 64 + 32 + l32] = pg8::f2bf1(o1[r] * rl); }
        asm volatile("s_waitcnt lgkmcnt(0)" ::: "memory");
#pragma unroll
        for (int i2 = 0; i2 < 4; ++i2) { const int row = i2 * 8 + (lane_e >> 3), ch = lane_e & 7; const u32x4 v = *(const ALAS u32x4*)(stg + row * 64 + ch * 8);
            *(u32x4*)(T_MIX + (size_t)(qb * 256 + wid * 32 + row) * 1024 + head * 64 + ch * 8) = v; }
    }
    asm volatile("s_waitcnt lgkmcnt(0)\n\ts_barrier" ::: "memory");
#undef DMA8
#undef EXPR
#undef PACKH0
#undef PACKH1
#undef ROWSUM_A
#undef ROWSUM_B
#undef EXPBLK
#undef PACK8
#undef WB8
#undef ROTK8
#undef ROT8
#undef LD32
#undef PK8
#undef STEP8
#undef ENDW8
}

typedef short v2i16_t __attribute__((ext_vector_type(2)));
template<int U, int PROBE = 0>
__device__ __forceinline__ void attn_unit_a8x2(const Tensors& T, int head, int qb, float negM2s, char* shm, int wave_id) {
    unsigned char* tws_ = T.ws; LAUNDER_G(tws_);
    constexpr int KSLOT = 4096, VSLOT = 4096, RS = 3 * U * 4096, LDS_K = 0, LDS_V = RS, n = 256;
    int tid_ = wave_id * 64 + lane_id_v(); asm volatile("" : "+v"(tid_));
    const int tid = tid_, lane = tid & 63, r32 = lane & 31, hi = lane >> 5; const int wid = __builtin_amdgcn_readfirstlane(tid >> 6);
    const int q0 = qb * 512; const int qrow = q0 + wid * 64 + r32;
    const unsigned lds0 = (unsigned)(uintptr_t)shm;
    const ALAS char* shm3 = (const ALAS char*)shm;
    const bool kw = wid < 4;
    const char* sb = (const char*)(tws_ + (kw ? WS_KA : WS_VA)) + (size_t)(head >> 2) * MROWS * 64 + (wid & 3) * 1024;
    const unsigned dvo = (unsigned)(lane * 16);
    const unsigned ddst = lds0 + (kw ? LDS_K : LDS_V) + (wid & 3) * 1024;
#define DMA8(i, so) glds16s(sb + (size_t)(i) * 4096, dvo, (unsigned)__builtin_amdgcn_readfirstlane(ddst + (so)))
#pragma unroll
    for (int i0 = 0; i0 < 2 * U; ++i0) DMA8(i0, i0 * 4096);
    if (kw) DMA8(2 * U, 2 * U * 4096);
    const unsigned char* Qw = (tws_ + WS_QA) + ((size_t)head * MROWS + qrow) * 64 + hi * 32;
    i32x8 qfa, qfb;
    { const u32x4 a_ = *(const u32x4*)Qw, b_ = *(const u32x4*)(Qw + 16); qfa = (i32x8){(int)a_[0], (int)a_[1], (int)a_[2], (int)a_[3], (int)b_[0], (int)b_[1], (int)b_[2], (int)b_[3]}; }
    { const u32x4 a_ = *(const u32x4*)(Qw + 32 * 64), b_ = *(const u32x4*)(Qw + 32 * 64 + 16); qfb = (i32x8){(int)a_[0], (int)a_[1], (int)a_[2], (int)a_[3], (int)b_[0], (int)b_[1], (int)b_[2], (int)b_[3]}; }
#if A8_SUM16
    f32x16 oa0 = f32x16{}, oa1 = f32x16{}, ob0 = f32x16{}, ob1 = f32x16{};
    f32x4 sa4 = f32x4{}, sb4 = f32x4{};
#if A8_SUM16 == 2
    f32x16 osa = f32x16{};
#endif
#else
    f32x16 oa0 = f32x16{}, oa1 = f32x16{}, osa = f32x16{}, ob0 = f32x16{}, ob1 = f32x16{}, osb = f32x16{};
#endif
#if A8_SUM16 == 2
    const f32x16 negm = f32x16{};
#else
    f32x16 negm;
#pragma unroll
    for (int r = 0; r < 16; ++r) negm[r] = negM2s;
    asm volatile("" : "+v"(negm));
#endif
#if A8_SUM16
    i32x8 ind; { const int o4 = (((lane >> 4) & 1) == ((lane & 15) >> 3)) ? 0x38383838 : 0; ind = (i32x8){o4, o4, o4, o4, o4, o4, o4, o4}; } asm volatile("" : "+v"(ind));
#if A8_SUM16 == 2
    i32x8 ones; { const int o4 = 0x38383838; ones = (i32x8){o4, o4, o4, o4, o4, o4, o4, o4}; } asm volatile("" : "+v"(ones));
#endif
#else
    i32x8 ones; { const int o4 = 0x38383838; ones = (i32x8){o4, o4, o4, o4, o4, o4, o4, o4}; } asm volatile("" : "+v"(ones));
#endif
    const ALAS char* kp0 = shm3 + LDS_K + hi * 1024 + r32 * 16;
    const ALAS char* vp0 = shm3 + LDS_V + hi * 1024 + r32 * 16;
    f32x16 Ca0, Ca1, Cb0, Cb1;
#ifdef A8_EXPH
#define EXPBLK(H, C, b) do { const unsigned h0_ = __builtin_bit_cast(unsigned, __builtin_amdgcn_cvt_pkrtz(C[b], C[(b) + 1])), h1_ = __builtin_bit_cast(unsigned, __builtin_amdgcn_cvt_pkrtz(C[(b) + 2], C[(b) + 3])), \
        h2_ = __builtin_bit_cast(unsigned, __builtin_amdgcn_cvt_pkrtz(C[(b) + 4], C[(b) + 5])), h3_ = __builtin_bit_cast(unsigned, __builtin_amdgcn_cvt_pkrtz(C[(b) + 6], C[(b) + 7])); unsigned d0_, d1_, d2_, d3_; \
        asm volatile("v_exp_f16_e32 %0, %4\n\tv_exp_f16_e32 %1, %5\n\tv_exp_f16_e32 %2, %6\n\tv_exp_f16_e32 %3, %7\n\t" \
                     "v_exp_f16_sdwa %0, %4 dst_sel:WORD_1 dst_unused:UNUSED_PRESERVE src0_sel:WORD_1\n\tv_exp_f16_sdwa %1, %5 dst_sel:WORD_1 dst_unused:UNUSED_PRESERVE src0_sel:WORD_1\n\t" \
                     "v_exp_f16_sdwa %2, %6 dst_sel:WORD_1 dst_unused:UNUSED_PRESERVE src0_sel:WORD_1\n\tv_exp_f16_sdwa %3, %7 dst_sel:WORD_1 dst_unused:UNUSED_PRESERVE src0_sel:WORD_1" \
                     : "=&v"(d0_), "=&v"(d1_), "=&v"(d2_), "=&v"(d3_) : "v"(h0_), "v"(h1_), "v"(h2_), "v"(h3_)); \
        C[(b) / 2] = __builtin_bit_cast(float, d0_); C[(b) / 2 + 1] = __builtin_bit_cast(float, d1_); C[(b) / 2 + 2] = __builtin_bit_cast(float, d2_); C[(b) / 2 + 3] = __builtin_bit_cast(float, d3_); PIN(C); } while (0)
#define PKH(C, j) (int)__builtin_amdgcn_perm(__builtin_bit_cast(unsigned, C[2 * (j) + 1]), __builtin_bit_cast(unsigned, C[2 * (j)]), 0x07050301u)
#define PACK8(H0, H1, C0, C1) do { pf[0] = PKH(C0, 0); pf[1] = PKH(C0, 1); pf[2] = PKH(C0, 2); pf[3] = PKH(C0, 3); pf[4] = PKH(C1, 0); pf[5] = PKH(C1, 1); pf[6] = PKH(C1, 2); pf[7] = PKH(C1, 3); PIN(pf); } while (0)
#else
#define EXPBLK(H, C, b) do { _Pragma("unroll") for (int r_ = (b); r_ < (b) + 8; ++r_) C[r_] = ((PROBE & 1) ? __builtin_fmaxf(C[r_], 1.0f) : EX(C[r_])); PIN(C); } while (0)
#define PACK8(H0, H1, C0, C1) do { pf[0] = PK8(C0, 0, pf[0]); pf[1] = PK8(C0, 4, pf[1]); pf[2] = PK8(C0, 8, pf[2]); pf[3] = PK8(C0, 12, pf[3]); pf[4] = PK8(C1, 0, pf[4]); pf[5] = PK8(C1, 4, pf[5]); pf[6] = PK8(C1, 8, pf[6]); pf[7] = PK8(C1, 12, pf[7]); PIN(pf); } while (0)
#endif
    i32x8 kf0, kf1, vf0, vf1, pf = (i32x8){0, 0, 0, 0, 0, 0, 0, 0};
#define LD32(dst, p) do { const u32x4 a_ = *(const ALAS u32x4*)(p), b_ = *(const ALAS u32x4*)((p) + 512); dst = (i32x8){(int)a_[0], (int)a_[1], (int)a_[2], (int)a_[3], (int)b_[0], (int)b_[1], (int)b_[2], (int)b_[3]}; } while (0)
#ifdef A8_BF8
#define PK8(P, B, OLD) (int)__builtin_amdgcn_perm(__builtin_bit_cast(unsigned, __builtin_amdgcn_cvt_pkrtz(P[(B) + 2], P[(B) + 3])), __builtin_bit_cast(unsigned, __builtin_amdgcn_cvt_pkrtz(P[B], P[(B) + 1])), 0x07050301u)
#define MFMA8P(a, b, c) __builtin_amdgcn_mfma_scale_f32_32x32x64_f8f6f4(a, b, c, 1, 0, 0, 0, 0, 0)
#define MFMA16P(a, b, c) __builtin_amdgcn_mfma_scale_f32_16x16x128_f8f6f4(a, b, c, 1, 0, 0, 0, 0, 0)
#elif defined(A8_SCALECVT)
#define MFMA8P(a, b, c) MFMA8(a, b, c)
#define MFMA16P(a, b, c) __builtin_amdgcn_mfma_scale_f32_16x16x128_f8f6f4(a, b, c, 0, 0, 0, 0, 0, 0)
#define PK8(P, B, OLD) __builtin_bit_cast(int, __builtin_amdgcn_cvt_scalef32_pk_fp8_f32(__builtin_amdgcn_cvt_scalef32_pk_fp8_f32(__builtin_bit_cast(v2i16_t, (int)(OLD)), P[B], P[(B) + 1], 1.0f, false), P[(B) + 2], P[(B) + 3], 1.0f, true))
#else
#define MFMA8P(a, b, c) MFMA8(a, b, c)
#define MFMA16P(a, b, c) __builtin_amdgcn_mfma_scale_f32_16x16x128_f8f6f4(a, b, c, 0, 0, 0, 0, 0, 0)
#define PK8(P, B, OLD) __builtin_amdgcn_cvt_pk_fp8_f32(P[(B) + 2], P[(B) + 3], __builtin_amdgcn_cvt_pk_fp8_f32(P[B], P[(B) + 1], OLD, false), true)
#endif
    if (kw) { WB_SEL(U); } else { WB_SEL(U); }
    { LD32(kf0, kp0); LD32(kf1, kp0 + 2048);
      Ca0 = MFMA8(kf0, qfa, negm); Ca1 = MFMA8(kf1, qfa, negm); Cb0 = MFMA8(kf0, qfb, negm); Cb1 = MFMA8(kf1, qfb, negm);
      EXPBLK(Ha0, Ca0, 0); EXPBLK(Ha0, Ca0, 8); EXPBLK(Ha1, Ca1, 0); EXPBLK(Ha1, Ca1, 8); }
#define EXPR(C, lo, hi) do { _Pragma("unroll") for (int r_ = (lo); r_ < (hi); ++r_) C[r_] = EX(C[r_]); PIN(C); } while (0)
#define P2E1 (A8_PIPE2 / 100)
#define P2E2 (A8_PIPE2 % 100)
#define EXPR2(C0, C1, lo, hi) do { _Pragma("unroll") for (int r_ = (lo); r_ < (hi); ++r_) { if (r_ < 16) C0[r_ & 15] = EX(C0[r_ & 15]); else C1[r_ & 15] = EX(C1[r_ & 15]); } PIN(C0); PIN(C1); } while (0)
#define PACKH0(C0) do { pf[0] = PK8(C0, 0, pf[0]); pf[1] = PK8(C0, 4, pf[1]); pf[2] = PK8(C0, 8, pf[2]); pf[3] = PK8(C0, 12, pf[3]); PIN(pf); } while (0)
#define PACKH1(C1) do { pf[4] = PK8(C1, 0, pf[4]); pf[5] = PK8(C1, 4, pf[5]); pf[6] = PK8(C1, 8, pf[6]); pf[7] = PK8(C1, 12, pf[7]); PIN(pf); } while (0)
#if A8_SUM16
#define ROWSUM_A() sa4 = MFMA16P(pf, ind, sa4)
#define ROWSUM_B() sb4 = MFMA16P(pf, ind, sb4)
#else
#define ROWSUM_A() osa = MFMA8P(pf, ones, osa)
#define ROWSUM_B() osb = MFMA8P(pf, ones, osb)
#endif
#if A8_PIPE2
    PACKH0(Ca0); PACKH1(Ca1);
#endif
    asm volatile("s_waitcnt lgkmcnt(0)\n\ts_barrier" ::: "memory");
    int ks = 0, vs = 0;
    const int dslot = A8_DMASTAG ? ((wid + (kw ? 0 : 2)) & 3) : 3;
#define ADV(x, k) (((x) + (k) * 4096 >= RS) ? (x) + (k) * 4096 - RS : (x) + (k) * 4096)
    for (int t0 = 0; t0 < n; t0 += U) {
#pragma unroll
      for (int j = 0; j < U; ++j) {
        const int t = t0 + j;
        const bool GK = t + 1 + 2 * U < n, GV = t + 2 * U < n, GL = t + 1 < n;
        const int ksn = ADV(ks, 1);
        SBAR();
#if A8_PIPE2
        { const ALAS char* vp_ = vp0 + vs; LD32(vf0, vp_); LD32(vf1, vp_ + 2048); }
        if (GL) { const ALAS char* kn_ = kp0 + ksn; LD32(kf0, kn_); LD32(kf1, kn_ + 2048); } SBAR();
#if A8_PIPE2 >= 2
        oa0 = MFMA8P(pf, vf0, oa0); EXPR2(Cb0, Cb1, 0, P2E1); SBAR();
        oa1 = MFMA8P(pf, vf1, oa1); EXPR2(Cb0, Cb1, P2E1, P2E1 + P2E2); SBAR();
        ROWSUM_A(); EXPR2(Cb0, Cb1, P2E1 + P2E2, 32); SBAR();
        if (GL) { Ca0 = MFMA8(kf0, qfa, negm); } PACKH0(Cb0); SBAR();
        if (GL) { Ca1 = MFMA8(kf1, qfa, negm); } PACKH1(Cb1);
        if (kw) { if (GK) { DMA8(t + 1 + 2 * U, ADV(ks, 2 * U + 1)); } } else { if (GV) { DMA8(t + 2 * U, ADV(vs, 2 * U)); } }
        SBAR();
        ob0 = MFMA8P(pf, vf0, ob0); if (GL) { EXPR2(Ca0, Ca1, 0, P2E1); } SBAR();
        ob1 = MFMA8P(pf, vf1, ob1); if (GL) { EXPR2(Ca0, Ca1, P2E1, P2E1 + P2E2); } SBAR();
        ROWSUM_B(); if (GL) { EXPR2(Ca0, Ca1, P2E1 + P2E2, 32); } SBAR();
        if (GL) { Cb0 = MFMA8(kf0, qfb, negm); PACKH0(Ca0); } SBAR();
        if (GL) { Cb1 = MFMA8(kf1, qfb, negm); PACKH1(Ca1); } SBAR();
#else
        oa0 = MFMA8P(pf, vf0, oa0); EXPR(Cb0, 0, 11); SBAR();
        if (A8_DMAPOS == 1) { { if (kw) { if (GK) { DMA8(t + 1 + 2 * U, ADV(ks, 2 * U + 1)); } } else { if (GV) { DMA8(t + 2 * U, ADV(vs, 2 * U)); } } } SBAR(); }
        oa1 = MFMA8P(pf, vf1, oa1); EXPR(Cb0, 11, 16); EXPR(Cb1, 0, 6); SBAR();
        ROWSUM_A(); EXPR(Cb1, 6, 16); SBAR();
        if (A8_DMAPOS == 2) { { if (kw) { if (GK) { DMA8(t + 1 + 2 * U, ADV(ks, 2 * U + 1)); } } else { if (GV) { DMA8(t + 2 * U, ADV(vs, 2 * U)); } } } SBAR(); }
        if (GL) { Ca0 = MFMA8(kf0, qfa, negm); } PACKH0(Cb0); SBAR();
        if (GL) { Ca1 = MFMA8(kf1, qfa, negm); } PACKH1(Cb1);
        if (A8_DMAPOS == 0) { { if (kw) { if (GK) { DMA8(t + 1 + 2 * U, ADV(ks, 2 * U + 1)); } } else { if (GV) { DMA8(t + 2 * U, ADV(vs, 2 * U)); } } } SBAR(); }
        SBAR();
        ob0 = MFMA8P(pf, vf0, ob0); if (GL) { EXPR(Ca0, 0, 11); } SBAR();
        ob1 = MFMA8P(pf, vf1, ob1); if (GL) { EXPR(Ca0, 11, 16); EXPR(Ca1, 0, 6); } SBAR();
        ROWSUM_B(); if (GL) { EXPR(Ca1, 6, 16); } SBAR();
        if (A8_DMAPOS == 4) { { if (kw) { if (GK) { DMA8(t + 1 + 2 * U, ADV(ks, 2 * U + 1)); } } else { if (GV) { DMA8(t + 2 * U, ADV(vs, 2 * U)); } } } SBAR(); }
        if (GL) { Cb0 = MFMA8(kf0, qfb, negm); PACKH0(Ca0); } SBAR();
        if (GL) { Cb1 = MFMA8(kf1, qfb, negm); PACKH1(Ca1); } SBAR();
        if (A8_DMAPOS == 3) { { if (kw) { if (GK) { DMA8(t + 1 + 2 * U, ADV(ks, 2 * U + 1)); } } else { if (GV) { DMA8(t + 2 * U, ADV(vs, 2 * U)); } } } SBAR(); }
#endif
#else
        if (!(PROBE & 4)) if (!A8_VPREF || j == 0) { const ALAS char* vp_ = vp0 + vs; LD32(vf0, vp_); LD32(vf1, vp_ + 2048); }
        if (!(PROBE & 4)) if (GL) { const ALAS char* kn_ = kp0 + ksn; LD32(kf0, kn_); LD32(kf1, kn_ + 2048); } SBAR();
        if (!(PROBE & 8)) { PACK8(Ha0, Ha1, Ca0, Ca1); } SBAR();
#ifdef A8_EXPH_DUP
        {
#pragma unroll
          for (int r = 0; r < 16; ++r) { float x_ = Ca0[r], y_ = Ca1[r]; asm volatile("v_exp_f16_e32 %0, %0\n\tv_exp_f16_e32 %1, %1" : "+v"(x_), "+v"(y_)); Ca0[r] = x_; Ca1[r] = y_; }
          SBAR(); }
#endif
#ifdef A8_CVT_DUP
        { int d0_ = 0, d1_ = 0, d2_ = 0, d3_ = 0;
#pragma unroll
          for (int r = 0; r < 16; r += 4) { d0_ = PK8(Ca0, r, d0_); d1_ = PK8(Ca1, r, d1_); d2_ = PK8(Ca0, r, d2_); d3_ = PK8(Ca1, r, d3_); asm volatile("" : "+v"(d0_), "+v"(d1_), "+v"(d2_), "+v"(d3_)); }
          SBAR(); }
#endif
        if (!(PROBE & 32)) oa0 = MFMA8P(pf, vf0, oa0);
        EXPBLK(Hb0, Cb0, 0); SBAR();
        if (A8_DMASTAG && !(PROBE & 2) && dslot == 0) { { if (kw) { if (GK) { DMA8(t + 1 + 2 * U, ADV(ks, 2 * U + 1)); } } else { if (GV) { DMA8(t + 2 * U, ADV(vs, 2 * U)); } } } SBAR(); }
        if (!(PROBE & 32)) oa1 = MFMA8P(pf, vf1, oa1);
        EXPBLK(Hb0, Cb0, 8); SBAR();
        if (A8_DMASTAG && !(PROBE & 2) && dslot == 1) { { if (kw) { if (GK) { DMA8(t + 1 + 2 * U, ADV(ks, 2 * U + 1)); } } else { if (GV) { DMA8(t + 2 * U, ADV(vs, 2 * U)); } } } SBAR(); }
#if A8_SUM16
        if (!(PROBE & 32)) sa4 = MFMA16P(pf, ind, sa4);
#if A8_SUM16 == 2
        osa = MFMA8P(pf, ones, osa);
#endif
#else
        osa = MFMA8P(pf, ones, osa);
#endif
        EXPBLK(Hb1, Cb1, 0); SBAR();
        if (A8_DMASTAG && !(PROBE & 2) && dslot == 2) { { if (kw) { if (GK) { DMA8(t + 1 + 2 * U, ADV(ks, 2 * U + 1)); } } else { if (GV) { DMA8(t + 2 * U, ADV(vs, 2 * U)); } } } SBAR(); }
        if (GL && !(PROBE & 64)) { Ca0 = MFMA8(kf0, qfa, negm); }
        EXPBLK(Hb1, Cb1, 8); SBAR();
        if (GL && !(PROBE & 64)) { Ca1 = MFMA8(kf1, qfa, negm); }
        if (!(PROBE & 2) && (!A8_DMASTAG || dslot == 3)) { if (kw) { if (GK) { DMA8(t + 1 + 2 * U, ADV(ks, 2 * U + 1)); } } else { if (GV) { DMA8(t + 2 * U, ADV(vs, 2 * U)); } } }
        SBAR();
        if (!(PROBE & 8)) { PACK8(Hb0, Hb1, Cb0, Cb1); } SBAR();
        if (!(PROBE & 32)) ob0 = MFMA8P(pf, vf0, ob0);
        if (GL) {
            EXPBLK(Ha0, Ca0, 0); }
        SBAR();
        if (!(PROBE & 32)) ob1 = MFMA8P(pf, vf1, ob1);
        if (GL) {
            EXPBLK(Ha0, Ca0, 8); }
        SBAR();
        if (A8_VPREF && j < U - 1) { const ALAS char* vn_ = vp0 + ADV(vs, 1); LD32(vf0, vn_); LD32(vf1, vn_ + 2048); SBAR(); }
#if A8_SUM16
        if (!(PROBE & 32)) sb4 = MFMA16P(pf, ind, sb4);
#else
        osb = MFMA8P(pf, ones, osb);
#endif
        if (GL) {
            EXPBLK(Ha1, Ca1, 0); }
        SBAR();
        if (GL) { if (!(PROBE & 64)) Cb0 = MFMA8(kf0, qfb, negm);
            EXPBLK(Ha1, Ca1, 8); }
        SBAR();
        if (GL && !(PROBE & 64)) { Cb1 = MFMA8(kf1, qfb, negm); }
#endif
        if (j == U - 1 && !(PROBE & 16)) { if ((PROBE & 2) == 0 && (kw ? GK : GV)) { WB_SEL(U); } else { WB_SEL(0); }
#ifdef A8_LAG
            if (!kw) __builtin_amdgcn_s_sleep(A8_LAG);
#endif
        }
        ks = ksn; vs = ADV(vs, 1);
      }
    }
#undef ADV
    {
        const int lane_e = lane_id_v(), l32 = lane_e & 31, hh = lane_e >> 5;
        ALAS bf16_t* stg = (ALAS bf16_t*)shm3 + wid * 4096;
#if A8_SUM16
        ALAS float* ls = (ALAS float*)(shm3 + 65536) + wid * 64;
        if ((lane_e & 7) == 0) { const int q0_ = 16 * ((lane_e >> 3) & 1) + 4 * (lane_e >> 4);
#pragma unroll
            for (int r = 0; r < 4; ++r) { ls[q0_ + r] = sa4[r]; ls[32 + q0_ + r] = sb4[r]; } }
        asm volatile("s_waitcnt lgkmcnt(0)" ::: "memory");
#endif
#pragma unroll
        for (int r = 0; r < 16; ++r) { const int orow = crow(r, hh);
#if A8_SUM16
            float ra = __builtin_amdgcn_rcpf(ls[orow]); const float rb = __builtin_amdgcn_rcpf(ls[32 + orow]);
#if A8_SUM16 == 2
            { const float rref = __builtin_amdgcn_rcpf(osa[r]); if (!(__builtin_fabsf(ra - rref) <= 1e-3f * rref)) ra = __builtin_nanf(""); }
#endif
#else
            const float ra = __builtin_amdgcn_rcpf(osa[r]), rb = __builtin_amdgcn_rcpf(osb[r]);
#endif
            stg[orow * 64 + l32] = pg8::f2bf1(oa0[r] * ra); stg[orow * 64 + 32 + l32] = pg8::f2bf1(oa1[r] * ra);
            stg[2048 + orow * 64 + l32] = pg8::f2bf1(ob0[r] * rb); stg[2048 + orow * 64 + 32 + l32] = pg8::f2bf1(ob1[r] * rb); }
        asm volatile("s_waitcnt lgkmcnt(0)" ::: "memory");
#pragma unroll
        for (int i2 = 0; i2 < 8; ++i2) { const int row = i2 * 8 + (lane_e >> 3), ch = lane_e & 7; const u32x4 v = *(const ALAS u32x4*)(stg + row * 64 + ch * 8);
            *(u32x4*)(T_MIX + (size_t)(qb * 512 + wid * 64 + row) * 1024 + head * 64 + ch * 8) = v; }
    }
    asm volatile("s_waitcnt lgkmcnt(0)\n\ts_barrier" ::: "memory");
#undef DMA8
#undef LD32
#undef PK8
}
}
static_assert(att::LDS_NEED <= RING_BYTES, "LDS map");

#define GAS __attribute__((address_space(1)))
#define LAS __attribute__((address_space(3)))
typedef unsigned short bf16;
typedef unsigned v4u __attribute__((ext_vector_type(4)));
typedef float f32x4 __attribute__((ext_vector_type(4)));
typedef GAS unsigned gu32;
#define RLX_AGENT __ATOMIC_RELAXED, __HIP_MEMORY_SCOPE_AGENT
#define LDS_WAIT() asm volatile("s_waitcnt lgkmcnt(0)" ::: "memory")
#define VM_WAIT() asm volatile("s_waitcnt vmcnt(0)" ::: "memory")
__device__ __forceinline__ unsigned f2bf(float f) { unsigned u = __builtin_bit_cast(unsigned, f); return (u + 0x7fffu + ((u >> 16) & 1u)) >> 16; }
__device__ __forceinline__ unsigned pk2(float lo, float hi) { return f2bf(lo) | (f2bf(hi) << 16); }
#define XB_TMO      128
#define XB_XCNT(j)  (256  + 64 * (j))
#define XB_XSUB(j)  (1280 + 64 * (j))
#define XB_XGEN(j)  (2304 + 64 * (j))
#define XB_TOP      3328
#define XB_TOPGEN   3392
#define XCD_BAR_WORDS 3456
#define XB_SPIN_CAP (1u << 18)

__device__ __forceinline__ unsigned xb_ld(unsigned* p)              { return __hip_atomic_load(p, __ATOMIC_RELAXED, __HIP_MEMORY_SCOPE_AGENT); }
__device__ __forceinline__ unsigned xb_add(unsigned* p, unsigned v) { return __hip_atomic_fetch_add(p, v, __ATOMIC_RELAXED, __HIP_MEMORY_SCOPE_AGENT); }
__device__ __forceinline__ unsigned xb_xcc_id() { return (unsigned)__builtin_amdgcn_s_getreg((3 << 11) | 20) & 0xFu; }
#define XB_SPIN(cond, bar) do { unsigned _sp = 0; while (cond) { __builtin_amdgcn_s_sleep(1); \
    if ((++_sp & 255u) == 0u) { if (xb_ld(&(bar)[XB_TMO])) break; if (_sp > XB_SPIN_CAP) { atomicAdd(&(bar)[XB_TMO], 1u); break; } } } } while (0)

struct XcdBarrier {
    unsigned* bar; unsigned x;
    volatile LAS unsigned* st;
};

__device__ __forceinline__ XcdBarrier xcd_barrier_post(unsigned* bar, volatile LAS unsigned* st, bool t0) {
    XcdBarrier b; b.bar = bar; b.x = (unsigned)__builtin_amdgcn_readfirstlane((int)xb_xcc_id()); b.st = st;
    if (t0) (void)xb_add(&bar[XB_XCNT(b.x)], 1u);
    return b;
}
__device__ __forceinline__ void xcd_barrier_complete(unsigned* bar, unsigned x, unsigned& nloc, unsigned& nx) {
    const unsigned G = gridDim.x * gridDim.y * gridDim.z;
    unsigned sum, cnt, mine, sp = 0u;
    for (;;) {
        sum = 0u; cnt = 0u; mine = 0u;
#pragma unroll
        for (unsigned j = 0; j < 16; ++j) { const unsigned c = xb_ld(&bar[XB_XCNT(j)]); sum += c; cnt += (c > 0u) ? 1u : 0u; mine = (j == x) ? c : mine; }
        if (sum == G) break;
        __builtin_amdgcn_s_sleep(1);
        if ((++sp & 255u) == 0u) { if (xb_ld(&bar[XB_TMO])) break; if (sp > XB_SPIN_CAP) { atomicAdd(&bar[XB_TMO], 1u); break; } }
    }
    nloc = mine > 0u ? mine : 1u; nx = cnt > 0u ? cnt : 1u;
}

__device__ __forceinline__ void xcd_barrier(const XcdBarrier& b_, int wave_id) {
    XcdBarrier b = b_; asm volatile("" : "+s"(b.bar), "+s"(b.x));
    const bool t0 = (wave_id == 0) && (lane_id_v() == 0);
    asm volatile("s_waitcnt vmcnt(0)" ::: "memory");
    __syncthreads();
    if (t0) {
        unsigned* bar = b.bar;
        __builtin_amdgcn_s_waitcnt(0);
        unsigned nloc = b.st[0], nx = b.st[1];
        if (nloc == 0u) { xcd_barrier_complete(bar, b.x, nloc, nx); b.st[0] = nloc; b.st[1] = nx; }
        const unsigned old = xb_add(&bar[XB_XSUB(b.x)], 1u);
        const unsigned gen = old / nloc;
        if (old + 1u == (gen + 1u) * nloc) {
            __builtin_amdgcn_fence(__ATOMIC_RELEASE, "agent");
            asm volatile("s_waitcnt vmcnt(0)" ::: "memory");
            const unsigned og = xb_add(&bar[XB_TOP], 1u);
            const unsigned tg = og / nx;
            if (og + 1u == (tg + 1u) * nx) xb_add(&bar[XB_TOPGEN], 1u);
            else XB_SPIN(xb_ld(&bar[XB_TOPGEN]) == tg, bar);
            __builtin_amdgcn_fence(__ATOMIC_ACQUIRE, "agent");
            xb_add(&bar[XB_XGEN(b.x)], 1u);
            asm volatile("s_waitcnt vmcnt(0)" ::: "memory");
        } else {
            XB_SPIN(xb_ld(&bar[XB_XGEN(b.x)]) == gen, bar);
            __builtin_amdgcn_fence(__ATOMIC_ACQUIRE, "agent");
            asm volatile("s_waitcnt vmcnt(0)" ::: "memory");
        }
    }
    __syncthreads();
}
#ifndef PHMASK
#define PHMASK 63
#endif
#ifndef ATT_DUP
#define ATT_DUP 1
#endif
#ifndef GU_DUP
#define GU_DUP 1
#endif
#ifndef IN_DUP
#define IN_DUP 1
#endif
#ifndef D1_DUP
#define D1_DUP 1
#endif
#ifndef P0_DUP
#define P0_DUP 1
#endif
#ifndef NODEFER
#define DEFER_OK (G == 256)
#else
#define DEFER_OK false
#endif

__device__ __forceinline__ float wave_sum(float v) { v += xor_lane<1>(v); v += xor_lane<2>(v); v += xor_lane<4>(v); v += xor_lane<8>(v); v += xor_lane<16>(v); return sum_x32(v); }
__device__ __forceinline__ float wave_max(float v) { v = fmaxf(v, xor_lane<1>(v)); v = fmaxf(v, xor_lane<2>(v)); v = fmaxf(v, xor_lane<4>(v)); v = fmaxf(v, xor_lane<8>(v)); v = fmaxf(v, xor_lane<16>(v)); return max_x32(v); }
__device__ __forceinline__ void tr_item(const float* W, int ldw, int srccol0, const float* gain, bf16* WT, int K, int dstrow0, int k0, LAS float* scr, int lane) {
    const int kq = lane >> 3, nq = lane & 7;
    f32x4 w[8]; float g[8];
#pragma unroll
    for (int i = 0; i < 8; ++i) { const int kk = 8 * i + kq; w[i] = *(const GAS f32x4*)(W + (size_t)(k0 + kk) * ldw + srccol0 + 4 * nq); g[i] = gain ? gain[k0 + kk] : 1.0f; }
#pragma unroll
    for (int i = 0; i < 8; ++i) { const int kk = 8 * i + kq; LAS float* s = scr + kk * 33 + 4 * nq; s[0] = w[i][0] * g[i]; s[1] = w[i][1] * g[i]; s[2] = w[i][2] * g[i]; s[3] = w[i][3] * g[i]; }
    LDS_WAIT(); asm volatile("" ::: "memory");
    const int c = lane & 7;
#pragma unroll
    for (int j = 0; j < 4; ++j) { const int n = (lane >> 3) + 8 * j; const LAS float* s = scr + (8 * c) * 33 + n;
        v4u o; o.x = pk2(s[0 * 33], s[1 * 33]); o.y = pk2(s[2 * 33], s[3 * 33]); o.z = pk2(s[4 * 33], s[5 * 33]); o.w = pk2(s[6 * 33], s[7 * 33]);
        *(GAS v4u*)(WT + (size_t)(dstrow0 + n) * K + k0 + 8 * c) = o; }
    LDS_WAIT(); asm volatile("" ::: "memory");
}

#define TR_ONE(it_) do { int r = (it_); \
        if (r < 2 * I_GU) { const int l2 = r >= I_GU; if (l2) r -= I_GU; const int kb = r / (NGU / 32), nb = r % (NGU / 32), n0 = nb * 32, pn = n0 >> 8, j0 = n0 & 255; \
            const float* src = (j0 < 128) ? (l2 ? args.in[18] : args.in[2]) : (l2 ? args.in[19] : args.in[3]); \
            tr_item(src, FF, pn * 128 + (j0 & 127), l2 ? args.in[17] : args.in[1], (bf16*)(ws + (l2 ? WS_WGU2 : WS_WGU1)), D, n0, kb * 64, scr, lane); break; } \
        r -= 2 * I_GU; \
        if (r < 2 * I_D) { const int l2 = r >= I_D; if (l2) r -= I_D; const int kb = r / (D / 32), nb = r % (D / 32); \
            tr_item(l2 ? args.in[20] : args.in[4], D, nb * 32, nullptr, (bf16*)(ws + (l2 ? WS_WD2 : WS_WD1)), FF, nb * 32, kb * 64, scr, lane); break; } \
        r -= 2 * I_D; \
        if (r < I_IN) { const int kb = r / (NIN / 32), nb = r % (NIN / 32), n0 = nb * 32, pn = n0 >> 8, j0 = n0 & 255, bj = j0 >> 7, wc = (j0 >> 5) & 3; \
            tr_item(args.in[6], NIN, pn * 256 + wc * 64 + bj * 32, args.in[5], (bf16*)(ws + WS_WIN), D, n0, kb * 64, scr, lane); break; } \
        r -= I_IN; \
        { const int kb = r / (D / 32), nb = r % (D / 32); tr_item(args.in[16], D, nb * 32, nullptr, (bf16*)(ws + WS_WOUT), D, nb * 32, kb * 64, scr, lane); } } while (0)
constexpr int I_GU = (D / 64) * (NGU / 32), I_D = (FF / 64) * (D / 32), I_IN = (D / 64) * (NIN / 32), I_OUT = (D / 64) * (D / 32);
#define TR_DEFERRED(first_idle, IT0, IT1) do { if (bx >= (first_idle)) { const int lane = lane_id_v(); LAS float* scr = (LAS float*)(L + RING_OFF + wave * 16384); \
        const int nw_ = (G - (first_idle)) * NWAVES; for (int it = (IT0) + (bx - (first_idle)) * NWAVES + wave; it < (IT1); it += nw_) { TR_ONE(it); } } } while (0)
struct Args { const float* in[21]; float* out; unsigned char* ws; };
#define LAUNDER(p) asm volatile("" : "+s"(p))

__global__ void __launch_bounds__(NWAVES * 64, 2) mk_fwd(Args args) {
    extern __shared__ __attribute__((aligned(16))) unsigned char lds[];
    LAS unsigned char* L = (LAS unsigned char*)lds;
    volatile LAS unsigned* MISC = (volatile LAS unsigned*)(L + MISC_OFF);
    const int wave = __builtin_amdgcn_readfirstlane((int)threadIdx.x >> 6);
    const int G = gridDim.x; const int bx = blockIdx.x;
    unsigned char* ws = args.ws; float* out = args.out; LAUNDER_G(ws); LAUNDER_G(out);
    { const int tid = wave * 64 + lane_id_v(); for (int u = tid; u < (LDS_BYTES - LDSCTL_OFF) / 4; u += NWAVES * 64) ((LAS unsigned*)(L + LDSCTL_OFF))[u] = 0u; }
    __syncthreads();
    XcdBarrier bar = xcd_barrier_post((unsigned*)((gu32*)(ws + WS_CTL) + CW_BAR), MISC + 8, (wave == 0) && (lane_id_v() == 0));
    LAS float* rstd_tab = (LAS float*)(L + RSTD_OFF);
    LAS float* PRM = (LAS float*)(L + PRM_OFF);
    float pr0_ = 0.f, pr1_ = 0.f, pr2_ = 0.f, pr3_ = 0.f;
    { const int lane = lane_id_v();
      if (wave == 0) { pr0_ = ((const GAS float*)args.in[7])[lane]; pr1_ = ((const GAS float*)args.in[8])[lane]; }
      else if (wave == 1) { pr0_ = ((const GAS float*)args.in[9])[lane]; pr1_ = ((const GAS float*)args.in[10])[lane]; }
      else if (wave == 2) { pr0_ = ((const GAS float*)args.in[15])[lane]; pr1_ = ((const GAS float*)args.in[15])[64 + lane]; }
      else if (wave < 7) { const int h = wave - 3; pr0_ = ((const GAS float*)args.in[11])[h * 64 + lane]; pr1_ = ((const GAS float*)args.in[12])[h * 64 + lane]; pr2_ = ((const GAS float*)args.in[13])[h * 64 + lane]; pr3_ = ((const GAS float*)args.in[14])[h * 64 + lane]; } }
#define PRM_FINISH() do { const int lane = lane_id_v(); \
      if (wave == 0) { PRM[PRM_GAQ + lane] = pr0_; PRM[PRM_GAK + lane] = pr1_; const float ma_ = wave_max(fabsf(pr0_)), mk_ = wave_max(fabsf(pr1_)); if (lane == 0) PRM[PRM_NEGM2A] = -(8.0f * 1.4426950408889634f * 1.02f) * ma_ * mk_; } \
      else if (wave == 1) { PRM[PRM_GBQ + lane] = pr0_; PRM[PRM_GBK + lane] = pr1_; const float ma_ = wave_max(fabsf(pr0_)), mk_ = wave_max(fabsf(pr1_)); if (lane == 0) PRM[PRM_NEGM2B] = -(8.0f * 1.4426950408889634f * 1.02f) * ma_ * mk_; } \
      else if (wave == 2) { PRM[PRM_SUBLN + lane] = pr0_; PRM[PRM_SUBLN + 64 + lane] = pr1_; } \
      else if (wave < 7) { const float d1_ = wave_sum(pr0_ * pr1_), d2_ = wave_sum(pr2_ * pr3_); if (lane == 0) PRM[PRM_LAM + (wave - 3)] = expf(d1_) - expf(d2_) + 0.2f; } \
      LDS_WAIT(); } while (0)

#define BUILD_RSTD(S) do { pg8::Unit u_; const int tid = wave * 64 + lane_id_v(); const float* SSQ_ = (const float*)(ws + WS_SSQ); for (int i_ = 0; i_ < 6 && (S).next(i_, u_); ++i_) if (tid < 256) { const f32x4* p_ = (const f32x4*)(SSQ_ + (size_t)(u_.pm * 256 + tid) * 16); \
        const f32x4 a_ = p_[0], b_ = p_[1], c_ = p_[2], d_ = p_[3]; const float s_ = ((a_[0] + a_[1]) + (a_[2] + a_[3])) + ((b_[0] + b_[1]) + (b_[2] + b_[3])) + ((c_[0] + c_[1]) + (c_[2] + c_[3])) + ((d_[0] + d_[1]) + (d_[2] + d_[3])); \
        rstd_tab[i_ * 256 + tid] = 1.0f / sqrtf(s_ * (1.0f / 1024.0f) + 1e-6f); } LDS_WAIT(); __syncthreads(); } while (0)

#if (PHMASK & 1)
    for (int dup0 = 0; dup0 < P0_DUP; ++dup0) {
        if (dup0) xcd_barrier(bar, wave);
        const int lane = lane_id_v(), tid = wave * 64 + lane;
        const int vcu = (G % 8 == 0) ? (bx % 8) * (G / 8) + bx / 8 : bx;
        float* ROPE = (float*)(ws + WS_ROPE); float* SSQ = (float*)(ws + WS_SSQ); bf16* XB = (bf16*)(ws + WS_XB); const float* x = args.in[0];
        LAS float* scr = (LAS float*)(L + RING_OFF + wave * 16384);
        const int gw = vcu * NWAVES + wave, NGW = G * NWAVES;
        for (int it = gw; it < ((DEFER_OK) ? I_GU : 2 * I_GU + 2 * I_D + I_IN + I_OUT); it += NGW) { TR_ONE(it); }
        for (int m = gw; m < M; m += NGW) {
            const GAS f32x4* xr = (const GAS f32x4*)(x + (size_t)m * D) + lane; f32x4 v[4]; float s = 0.f;
#pragma unroll
            for (int j = 0; j < 4; ++j) { v[j] = xr[64 * j]; s += (v[j][0] * v[j][0] + v[j][1] * v[j][1]) + (v[j][2] * v[j][2] + v[j][3] * v[j][3]); }
            s = wave_sum(s);
            GAS unsigned long long* o8 = (GAS unsigned long long*)(XB + (size_t)m * D) + lane;
#pragma unroll
            for (int j = 0; j < 4; ++j) o8[64 * j] = (unsigned long long)pk2(v[j][0], v[j][1]) | ((unsigned long long)pk2(v[j][2], v[j][3]) << 32);
            if (lane < 16) SSQ[(size_t)m * 16 + lane] = (lane == 0) ? s : 0.f;
        }
        for (int e = bx * (NWAVES * 64) + tid; e < 5120; e += G * NWAVES * 64) {
            const int isc = e >= 4096, ee = isc ? e - 4096 : e, pos = ee >> 4, i = ee & 15;
            const float invf = powf(10000.0f, -(float)i * (1.0f / 16.0f)); const float ang = (float)pos * invf; float sn, cs; sincosf(ang, &sn, &cs);
            if (isc) { ROPE[8192 + ee] = cs; ROPE[9216 + ee] = sn; } else { ROPE[ee] = cs; ROPE[4096 + ee] = sn; }
        }
    }
#endif
    PRM_FINISH();
    xcd_barrier(bar, wave);

    for (int rep = 0; rep < 2; ++rep) {
#if (PHMASK & 2)
        {
            LAUNDER_G(ws);
            pg8::Gemm g{(const bf16*)(ws + WS_XB), (const bf16*)(ws + (rep ? WS_WGU2 : WS_WGU1)), M, NGU, D}; pg8::StaticOrderT<M, NGU> S; int bxs_ = bx, Gs_ = G; LAUNDER(bxs_); LAUNDER(Gs_); S.init(Gs_, bxs_);
#if defined(SPLITK_GU2)
            { pg8::SplitTailOrderT<pg8::StaticOrderT<M, NGU>, 5, D / 64> SKr{S, (rep == 1) && (G == 256)}; BUILD_RSTD(SKr); }
#else
            BUILD_RSTD(S);
#endif
            pg8::EpiSwiGLU E{ws, rstd_tab};
            for (int dup = 0; dup < GU_DUP; ++dup) { if (dup) xcd_barrier(bar, wave);
#if defined(CLK_PROBE_GU)
            unsigned long long c0_ = __builtin_amdgcn_s_memtime(), r0_ = __builtin_amdgcn_s_memrealtime();
#endif
#if defined(SPLITK_GU2)
            {
                typedef pg8::SplitTailOrderT<pg8::StaticOrderT<M, NGU>, 5, D / 64> SKO; SKO SK{S, (rep == 1) && (G == 256)};
                pg8::EpiSwiGLUSplit E2{ws, rstd_tab};
                pg8::gemm_phase<D, pg8::EpiSwiGLUSplit, SKO, true, true, D, true>(L + RING_OFF, g, SK, E2, wave);
            }
#else
            pg8::gemm_phase<D, pg8::EpiSwiGLU, pg8::StaticOrderT<M, NGU>, true, true>(L + RING_OFF, g, S, E, wave);
#endif
            if (rep == 0 && dup == 0 && DEFER_OK) { TR_DEFERRED(128, 2 * I_GU, 2 * I_GU + I_D); TR_DEFERRED(128, 2 * I_GU + 2 * I_D, 2 * I_GU + 2 * I_D + I_IN); }
#if defined(CLK_PROBE_GU)
            if (rep == 0 && bx == 0) { const unsigned long long c1_ = __builtin_amdgcn_s_memtime(), r1_ = __builtin_amdgcn_s_memrealtime(); const unsigned long long spin_ = 1000ull * (c1_ - c0_) / (r1_ - r0_); while (__builtin_amdgcn_s_memrealtime() - r1_ < spin_) __builtin_amdgcn_s_sleep(8); }
#endif
            }
        }
#endif
        xcd_barrier(bar, wave);
#if (PHMASK & 4)
        {
            LAUNDER_G(ws); LAUNDER_G(out);
            pg8::Gemm g{(const bf16*)(ws + WS_H), (const bf16*)(ws + (rep ? WS_WD2 : WS_WD1)), M, D, FF}; pg8::StaticOrderT<M, D> S; int bxs_ = bx, Gs_ = G; LAUNDER(bxs_); LAUNDER(Gs_); S.init(Gs_, bxs_);
            if (rep == 0) { pg8::EpiResid<true, true, false> E{nullptr, nullptr, ws, 0.5f}; for (int dup = 0; dup < D1_DUP; ++dup) { if (dup) xcd_barrier(bar, wave);
#if defined(D1_NULLEPI)
                if (dup) { pg8::EpiNull EN; pg8::gemm_phase<FF, pg8::EpiNull, pg8::StaticOrderT<M, D>, true, true>(L + RING_OFF, g, S, EN, wave); continue; }
#endif
#if defined(D1_SCRATCH)
                if (dup) { pg8::EpiResidStaged<true, false> ES{nullptr, ws, 0.5f, ws + (140u << 20)}; pg8::gemm_phase<FF, pg8::EpiResidStaged<true, false>, pg8::StaticOrderT<M, D>, false, true>(L + RING_OFF, g, S, ES, wave); continue; }
#endif
                pg8::gemm_phase<FF, pg8::EpiResid<true, true, false>, pg8::StaticOrderT<M, D>, true, true>(L + RING_OFF, g, S, E, wave); } }
            else {
#if defined(D7_DUP) && defined(D7_PROBE1)
                for (int dup = 0; dup < D7_DUP; ++dup) { if (dup) xcd_barrier(bar, wave);
                    if (dup < D7_DUP - 1) { pg8::EpiResid<true, false, true, 1> EP{nullptr, out, ws, 0.5f}; pg8::gemm_phase<FF, pg8::EpiResid<true, false, true, 1>, pg8::StaticOrderT<M, D>, true, true>(L + RING_OFF, g, S, EP, wave); }
                    else { pg8::EpiResid<true, false, true> E{nullptr, out, ws, 0.5f}; pg8::gemm_phase<FF, pg8::EpiResid<true, false, true>, pg8::StaticOrderT<M, D>, true, true>(L + RING_OFF, g, S, E, wave); } }
#elif defined(D7_DUP)
                pg8::EpiResid<true, false, true> E{nullptr, out, ws, 0.5f};
#pragma unroll 1
                for (int dup = 0; dup < D7_DUP; ++dup) { if (dup) xcd_barrier(bar, wave); pg8::gemm_phase<FF, pg8::EpiResid<true, false, true>, pg8::StaticOrderT<M, D>, true, true>(L + RING_OFF, g, S, E, wave); }
#else
                pg8::EpiResid<true, false, true> E{nullptr, out, ws, 0.5f}; pg8::gemm_phase<FF, pg8::EpiResid<true, false, true>, pg8::StaticOrderT<M, D>, true, true>(L + RING_OFF, g, S, E, wave);
#endif
            }
        }
#endif
        if (rep == 1) break;
        xcd_barrier(bar, wave);
#if (PHMASK & 8)
        {
            LAUNDER_G(ws);
            pg8::Gemm g{(const bf16*)(ws + WS_XB), (const bf16*)(ws + WS_WIN), M, NIN, D}; pg8::StaticOrderT<M, NIN> S; int bxs_ = bx, Gs_ = G; LAUNDER(bxs_); LAUNDER(Gs_); S.init(Gs_, bxs_);
            BUILD_RSTD(S);
            pg8::EpiInProj E{rstd_tab, PRM, ws};
            for (int dup = 0; dup < IN_DUP; ++dup) { if (dup) xcd_barrier(bar, wave);
            pg8::gemm_phase<D, pg8::EpiInProj, pg8::StaticOrderT<M, NIN>, true, true>(L + RING_OFF, g, S, E, wave);
            if (dup == 0 && DEFER_OK) { TR_DEFERRED(64, I_GU, 2 * I_GU); TR_DEFERRED(64, 2 * I_GU + I_D, 2 * I_GU + 2 * I_D); TR_DEFERRED(64, 2 * I_GU + 2 * I_D + I_IN, 2 * I_GU + 2 * I_D + I_IN + I_OUT); } }
        }
#endif
        xcd_barrier(bar, wave);
#if (PHMASK & 16)
        for (int dup = 0; dup < ATT_DUP; ++dup) {
            LAUNDER_G(ws);
            if (dup) xcd_barrier(bar, wave);
            gu32* qhead = (gu32*)(ws + WS_CTL) + CW_QUEUE + 64 * dup;
#if defined(CLK_PROBE)
            unsigned long long c0_ = __builtin_amdgcn_s_memtime(), r0_ = __builtin_amdgcn_s_memrealtime();
#endif
            const att::Tensors T = att::make_tensors(ws, PRM);
            const bool st = (G == 256);
            const int xg = bx & 7, cg = bx >> 3;
            for (int step = 0;; ++step) {
                int kind, h, qb;
                if (st && step < 2) {
                    if (step < 1) { kind = 0; h = xg; qb = cg; }
                    else { kind = 1; h = (xg < 4) ? 3 : 2; qb = 32 * (xg & 3) + cg; }
                } else {
                    if ((wave == 0) && (lane_id_v() == 0)) MISC[12] = __hip_atomic_fetch_add(qhead, 1u, RLX_AGENT);
                    LDS_WAIT(); __syncthreads();
                    int idx = __builtin_amdgcn_readfirstlane((int)MISC[12]);
                    if (st) idx += 512;
                    if (idx >= 768) break;
                    if (idx < 256 || idx >= 512) { kind = 1;
                        if (idx < 128) { h = 3; qb = idx; } else if (idx < 256) { const int i = idx - 128; h = 2; qb = (i & 1) ? 63 - (i >> 1) : 64 + (i >> 1); }
                        else if (idx < 640) { h = 1; qb = idx - 512; } else { h = 0; qb = idx - 640; }
                    } else { kind = 0; const int i = idx - 256; h = i >> 5; qb = i & 31; }
                }
#if defined(DUP_ONLY_A)
                if (dup && kind) continue;
#elif defined(DUP_ONLY_B)
                if (dup && !kind) continue;
#endif
                if (kind) {
                    const float slope = (h == 0) ? 0.25f : (h == 1) ? 0.0625f : (h == 2) ? 0.015625f : 0.00390625f;
                    const float c2 = slope * 1.4426950408889634f; const int dskip = (int)(150.0f / c2) + 1;
#if defined(B_PROBE_DUP)
                    if (dup < ATT_DUP - 1) att::attn_unit<true, B_PROBE_DUP>(T, h, qb, PRM[PRM_NEGM2B], PRM[PRM_LAM + h], c2, dskip, (char*)lds + RING_OFF, wave); else
#endif
                    att::attn_unit<true>(T, h, qb, PRM[PRM_NEGM2B], PRM[PRM_LAM + h], c2, dskip, (char*)lds + RING_OFF, wave);
                } else {
#if defined(A8_NOEXP_DUP)
                    if (dup < ATT_DUP - 1) att::attn_unit_a8x2<A8U, A8_NOEXP_DUP>(T, h, qb, PRM[PRM_NEGM2A] + 8.0f, (char*)lds + RING_OFF, wave); else
#endif
                    att::attn_unit_a8x2<A8U>(T, h, qb, PRM[PRM_NEGM2A] + 8.0f, (char*)lds + RING_OFF, wave); }
            }
#if defined(CLK_PROBE)
            if (dup == ATT_DUP - 1 && bx == 0) { const unsigned long long c1_ = __builtin_amdgcn_s_memtime(), r1_ = __builtin_amdgcn_s_memrealtime(); const unsigned long long spin_ = 1000ull * (c1_ - c0_) / (r1_ - r0_); while (__builtin_amdgcn_s_memrealtime() - r1_ < spin_) __builtin_amdgcn_s_sleep(8); }
#endif
        }
#endif
        xcd_barrier(bar, wave);
#if (PHMASK & 32)
        {
            LAUNDER_G(ws); LAUNDER_G(out);
            pg8::Gemm g{(const bf16*)(ws + WS_MIX), (const bf16*)(ws + WS_WOUT), M, D, D}; pg8::StaticOrderT<M, D> S; int bxs_ = bx, Gs_ = G; LAUNDER(bxs_); LAUNDER(Gs_); S.init(Gs_, bxs_);
            pg8::EpiResid<true, true, false> E{nullptr, nullptr, ws, 1.0f}; pg8::gemm_phase<D, pg8::EpiResid<true, true, false>, pg8::StaticOrderT<M, D>, true, true>(L + RING_OFF, g, S, E, wave);
        }
#endif
        xcd_barrier(bar, wave);
    }
}

extern "C" void kernel_launch(void* const* d_in, const int* in_sizes, int n_in, void* d_out, int out_size, void* d_ws, size_t ws_size, hipStream_t stream) {
    static int grid = 0;
    if (grid == 0) {
        if (n_in != 21 || in_sizes[0] != M * D || out_size != M * D || ws_size < WS_END) { fprintf(stderr, "kernel_launch: unexpected shapes (n_in %d, in0 %d, out %d, ws %zu)\n", n_in, n_in > 0 ? in_sizes[0] : -1, out_size, ws_size); grid = -1; return; }
        int dev = 0, cus = 0, per_cu = 0;
        if (hipGetDevice(&dev) != hipSuccess || hipDeviceGetAttribute(&cus, hipDeviceAttributeMultiprocessorCount, dev) != hipSuccess) { grid = -1; return; }
        if (hipFuncSetAttribute((const void*)mk_fwd, hipFuncAttributeMaxDynamicSharedMemorySize, LDS_BYTES) != hipSuccess) { fprintf(stderr, "kernel_launch: hipFuncSetAttribute failed\n"); grid = -1; return; }
        if (hipOccupancyMaxActiveBlocksPerMultiprocessor(&per_cu, (const void*)mk_fwd, NWAVES * 64, LDS_BYTES) != hipSuccess || per_cu < 1) { fprintf(stderr, "kernel_launch: occupancy query says %d blocks per CU\n", per_cu); (void)hipGetLastError(); grid = -1; return; }
        grid = cus;
    }
    if (grid < 0) return;
    if (hipMemsetAsync((char*)d_ws + WS_CTL, 0, CTL_ZERO_BYTES, stream) != hipSuccess) { fprintf(stderr, "kernel_launch: memset failed\n"); return; }
    Args a{};
    for (int i = 0; i < 21; ++i) a.in[i] = (const float*)d_in[i];
    a.out = (float*)d_out; a.ws = (unsigned char*)d_ws;
    hipLaunchKernelGGL(mk_fwd, dim3(grid), dim3(NWAVES * 64), LDS_BYTES, stream, a);
    const hipError_t le = hipPeekAtLastError();
    if (le != hipSuccess) fprintf(stderr, "kernel_launch: launch failed: %s\n", hipGetErrorName(le));
}
```

```cpp
#include <hip/hip_runtime.h>
#include <cstdio>
#include <cstdint>
#define GLDS_M0_CLOBBER 1
#define A8_PIPE2 1
#define A8_SUM16 1
#define B_VF8 1
#define A8_VPREF 1
#define A8U 8
#ifndef A8_DMAPOS
#define A8_DMAPOS 0
#endif
#ifndef B_VF8
#define B_VF8 0
#endif
#ifndef A8_PIPE2
#define A8_PIPE2 0
#endif
#ifndef A8_DMASTAG
#define A8_DMASTAG 0
#endif
#ifndef A8_SUM16
#define A8_SUM16 0
#endif
#ifndef B_ORDER
#define B_ORDER 0
#endif
#ifndef A8_VPREF
#define A8_VPREF 0
#endif
#ifndef BDMA_MODE
#define BDMA_MODE 0
#endif
#ifndef A8U
#define A8U 4
#endif
#ifndef A8_NOBF8
#define A8_BF8 1
#endif

constexpr int NWAVES = 8;
constexpr int M = 16384, D = 1024, FF = 2816, NGU = 2 * FF, NIN = 2304;
constexpr size_t MiB = 1u << 20;
constexpr size_t WS_CTL = 0, CTL_ZERO_BYTES = 64 * 1024;
constexpr size_t WS_WGU1 = 2 * MiB, WS_WD1 = 13 * MiB, WS_WIN = 19 * MiB, WS_WOUT = 24 * MiB, WS_WGU2 = 26 * MiB, WS_WD2 = 37 * MiB;
constexpr size_t WS_ROPE = 43 * MiB, WS_SSQ = 44 * MiB;
constexpr size_t WS_XB = 48 * MiB;
constexpr size_t WS_H = 80 * MiB;
constexpr size_t WS_QA = 80 * MiB, WS_KA = 96 * MiB, WS_VA = 100 * MiB, WS_QB = 104 * MiB, WS_KB = 120 * MiB, WS_VB = 136 * MiB, WS_MIX = 152 * MiB;
constexpr size_t WS_END = 184 * MiB;
static_assert(WS_WGU1 + (size_t)NGU * D * 2 <= WS_WD1 && WS_WD1 + (size_t)D * FF * 2 <= WS_WIN && WS_WIN + (size_t)NIN * D * 2 <= WS_WOUT && WS_WOUT + (size_t)D * D * 2 <= WS_WGU2 &&
              WS_WGU2 + (size_t)NGU * D * 2 <= WS_WD2 && WS_WD2 + (size_t)D * FF * 2 <= WS_ROPE && WS_H + (size_t)M * FF * 2 <= WS_END && WS_MIX + (size_t)M * D * 2 <= WS_END, "d_ws map");
constexpr int CW_BAR = 1024;
constexpr int CW_XFLAG = 9216;
constexpr size_t WS_XCH = 184 * MiB;
constexpr int CW_QUEUE = 8192;
constexpr int RING_OFF = 0, RING_BYTES = 131072;
constexpr int LDSCTL_OFF = 147456  , MISC_OFF = LDSCTL_OFF + 320, RSTD_OFF = LDSCTL_OFF + 1024, PRM_OFF = LDSCTL_OFF + 8192;
constexpr int LDS_BYTES = 163840;
constexpr int PRM_GAQ = 0, PRM_GAK = 64, PRM_GBQ = 128, PRM_GBK = 192, PRM_SUBLN = 256, PRM_NEGM2A = 384, PRM_NEGM2B = 385, PRM_LAM = 388, PRM_WORDS = 392;
static_assert(RSTD_OFF + 6 * 256 * 4 <= PRM_OFF && PRM_OFF + PRM_WORDS * 4 <= LDS_BYTES, "LDS map");

__device__ __forceinline__ int lane_id_v() { int l; asm volatile("v_mbcnt_lo_u32_b32 %0, -1, 0\n\tv_mbcnt_hi_u32_b32 %0, -1, %0" : "=v"(l)); return l; }

template <int MASK> __device__ __forceinline__ float xor_lane(float v) {
    if constexpr (MASK == 32) { const auto rr = __builtin_amdgcn_permlane32_swap(__float_as_uint(v), __float_as_uint(v), false, false); return __uint_as_float(lane_id_v() < 32 ? rr[1] : rr[0]); }
    else return __uint_as_float((unsigned)__builtin_amdgcn_ds_swizzle((int)__float_as_uint(v), (MASK << 10) | 0x1f));
}
__device__ __forceinline__ float sum_x32(float v) { const auto rr = __builtin_amdgcn_permlane32_swap(__float_as_uint(v), __float_as_uint(v), false, false); return __uint_as_float(rr[0]) + __uint_as_float(rr[1]); }
__device__ __forceinline__ float max_x32(float v) { const auto rr = __builtin_amdgcn_permlane32_swap(__float_as_uint(v), __float_as_uint(v), false, false); return fmaxf(__uint_as_float(rr[0]), __uint_as_float(rr[1])); }

#define LAUNDER_G(p) do { __attribute__((address_space(1))) void* g_ = (__attribute__((address_space(1))) void*)(p); asm volatile("" : "+s"(g_)); (p) = (decltype(p))g_; } while (0)
namespace pg8 {
#define PG8_LAS __attribute__((address_space(3)))
typedef unsigned short bf16_t;
typedef short bf16x8 __attribute__((ext_vector_type(8)));
typedef float f32x4 __attribute__((ext_vector_type(4)));
typedef unsigned u32x4 __attribute__((ext_vector_type(4)));
constexpr int BM = 256, BK = 64, HALF = 128, HTB = HALF * BK * 2  , STAGE_BYTES = 8 * HTB, NXCD = 8, WGM = 8;

__host__ __device__ __forceinline__ int lds_byte(int r, int c) { const int st = (r >> 4) * 2 + (c >> 5), rr = r & 15, cc = c & 31, ob = rr * 64 + cc * 2; return st * 1024 + (ob ^ (((ob >> 9) & 1) << 5)); }
__host__ __device__ __forceinline__ void stage_rc(int b, int& R, int& C) { const int st = b / 1024, sb = b % 1024, swz = sb ^ (((sb >> 9) & 1) << 5); R = (st >> 1) * 16 + swz / 64; C = (st & 1) * 32 + (swz % 64) / 2; }
__host__ __device__ __forceinline__ int perm32(int rho) { const int n = rho >> 4, i = rho & 15; return 8 * (i >> 2) + 4 * n + (i & 3); }

struct Unit { int pm, pn; int kofs, nt; };
struct Gemm { const bf16_t* A; const bf16_t* Bt; int M, N, K; };

template <int MD, int ND> struct StaticOrderT {
    static constexpr int nM = MD / BM, nN = ND / BM, nwg = nM * nN;
    int G, c;
    __host__ __device__ void init(int G_, int c_) { G = G_; c = c_; }
    __host__ __device__ bool next(int i, Unit& u) const { return at(i * G + c, u); }
    __host__ __device__ bool at(int L, Unit& u) const {
        if (L >= nwg) return false;
        int wgid = L; { constexpr int q = nwg / NXCD, r = nwg % NXCD; const int xcd = wgid % NXCD, off = wgid / NXCD; wgid = (xcd < r ? xcd * (q + 1) : r * (q + 1) + (xcd - r) * q) + off; }
        constexpr int nig = WGM * nN; const int gid = wgid / nig, fm = gid * WGM, gsz = (nM - fm) < WGM ? (nM - fm) : WGM;
        u.pm = fm + ((wgid % nig) % gsz); u.pn = (wgid % nig) / gsz; u.kofs = 0; u.nt = 0; return true;
    }
    __device__ __forceinline__ void a_ready(const Unit&) const {}
    __device__ __forceinline__ void done(const Unit&) const {}
};
template <class S0, int RT, int NTF> struct SplitTailOrderT { S0 s; bool sk;
    __host__ __device__ bool next(int i, Unit& u) const {
        if (!sk || i < RT) { const bool r = s.next(i, u); u.kofs = 0; u.nt = NTF; return r; }
        if (i > RT) return false;
        const int h = s.G >> 1; s.at(RT * s.G + (s.c % h), u); u.kofs = (s.c / h) * (NTF / 2) * BK * 2; u.nt = NTF / 2; return true; }
    __device__ __forceinline__ void a_ready(const Unit&) const {} __device__ __forceinline__ void done(const Unit&) const {} };


__device__ __forceinline__ unsigned cvt_pk_bf16(float lo, float hi) { unsigned r; asm volatile("v_cvt_pk_bf16_f32 %0, %1, %2" : "=v"(r) : "v"(lo), "v"(hi)); return r; }
__device__ __forceinline__ unsigned short f2bf1(float f) { unsigned u = __builtin_bit_cast(unsigned, f); return (unsigned short)((u + 0x7fffu + ((u >> 16) & 1u)) >> 16); }
typedef unsigned u32x2 __attribute__((ext_vector_type(2)));
constexpr int MROWS = M, DMODEL = D, DFF = FF;

typedef float f32x2 __attribute__((ext_vector_type(2)));
#ifdef SWIGLU_FMA
#define SWIGLU_RS2(rs) __builtin_amdgcn_rcpf((rs) * (rs))
#else
#define SWIGLU_RS2(rs) ((rs) * (rs))
#endif
__device__ __forceinline__ f32x2 swiglu2(f32x2 ag, f32x2 au, float k1, float rs2) {
    const f32x2 t = ag * k1; f32x2 ex; ex.x = __builtin_amdgcn_exp2f(t.x); ex.y = __builtin_amdgcn_exp2f(t.y);
#ifdef SWIGLU_FMA
    const f32x2 d = ex * rs2 + rs2; f32x2 r; r.x = __builtin_amdgcn_rcpf(d.x); r.y = __builtin_amdgcn_rcpf(d.y);
    return (ag * au) * r;
#else
    const f32x2 d = ex + 1.0f; f32x2 r; r.x = __builtin_amdgcn_rcpf(d.x); r.y = __builtin_amdgcn_rcpf(d.y);
    return ((ag * au) * rs2) * r;
#endif
}
__device__ __forceinline__ f32x4 swiglu4(f32x4 ag, f32x4 au, float k1, float rs2) {
    const f32x2 a = swiglu2((f32x2){ag[0], ag[1]}, (f32x2){au[0], au[1]}, k1, rs2), b = swiglu2((f32x2){ag[2], ag[3]}, (f32x2){au[2], au[3]}, k1, rs2);
    return (f32x4){a.x, a.y, b.x, b.y};
}
struct EpiSwiGLU {
    static constexpr bool PERM = true, AFTER_DRAIN = false;
    unsigned char* ws; const PG8_LAS float* rstd;
    __device__ __forceinline__ void operator()(const f32x4 (&acc)[2][2][4][2], const Unit& u, int ui, int wr, int wc, int fr, int fq) const {
        asm volatile("" : "+v"(fr), "+v"(fq));
        const int col0 = u.pn * 128 + wc * 32 + 8 * fq; unsigned char* w2 = ws; LAUNDER_G(w2); bf16_t* H = (bf16_t*)(w2 + WS_H);
#pragma unroll
        for (int ai = 0; ai < 2; ++ai)
#pragma unroll
            for (int m = 0; m < 4; ++m) {
                const int rl = ai * HALF + wr * 64 + m * 16 + fr; const float rs = rstd[ui * 256 + rl];
                const float k1 = rs * -1.4426950408889634f, rs2 = SWIGLU_RS2(rs);
                const f32x4 h0 = swiglu4(acc[ai][0][m][0], acc[ai][1][m][0], k1, rs2), h1 = swiglu4(acc[ai][0][m][1], acc[ai][1][m][1], k1, rs2);
                u32x4 w; w.x = cvt_pk_bf16(h0[0], h0[1]); w.y = cvt_pk_bf16(h0[2], h0[3]); w.z = cvt_pk_bf16(h1[0], h1[1]); w.w = cvt_pk_bf16(h1[2], h1[3]);
                *(u32x4*)(H + (size_t)(u.pm * BM + rl) * DFF + col0) = w;
            }
    }
};
struct EpiSwiGLUSplit {
    static constexpr bool PERM = true, AFTER_DRAIN = false;
    unsigned char* ws; const PG8_LAS float* rstd;
    typedef unsigned long long u64;
    __device__ __forceinline__ static void put(u64* p, const f32x4& v) {
        __hip_atomic_store(p, ((u64)__float_as_uint(v[1]) << 32) | __float_as_uint(v[0]), __ATOMIC_RELAXED, __HIP_MEMORY_SCOPE_AGENT);
        __hip_atomic_store(p + 1, ((u64)__float_as_uint(v[3]) << 32) | __float_as_uint(v[2]), __ATOMIC_RELAXED, __HIP_MEMORY_SCOPE_AGENT); }
    __device__ __forceinline__ static f32x4 get(const u64* p) {
        const u64 a = __hip_atomic_load(p, __ATOMIC_RELAXED, __HIP_MEMORY_SCOPE_AGENT), b = __hip_atomic_load(p + 1, __ATOMIC_RELAXED, __HIP_MEMORY_SCOPE_AGENT);
        return (f32x4){__uint_as_float((unsigned)a), __uint_as_float((unsigned)(a >> 32)), __uint_as_float((unsigned)b), __uint_as_float((unsigned)(b >> 32))}; }
    template <int SS> __device__ __forceinline__ void run(const f32x4 (&acc)[2][2][4][2], const Unit& u, int wr, int wc, int fr, int fq) const {
        unsigned char* w2 = ws; LAUNDER_G(w2);
        const int pair = (int)(__builtin_amdgcn_workgroup_id_x() & 127u); constexpr int rslot = 5;
        const unsigned tid = (unsigned)((wr * 4 + wc) * 64 + fq * 16 + fr);
        unsigned char* xb_ = w2 + WS_XCH + (size_t)pair * (2 * 16 * 512 * 16);
        u64* xo = (u64*)(xb_ + (size_t)(1 - SS) * (16 * 512 * 16) + tid * 16u);
        const u64* xi = (const u64*)(xb_ + (size_t)SS * (16 * 512 * 16) + tid * 16u);
        unsigned* flg = (unsigned*)(w2 + WS_CTL) + CW_XFLAG + pair * 2;
#pragma unroll
        for (int bj = 0; bj < 2; ++bj)
#pragma unroll
            for (int m = 0; m < 4; ++m)
#pragma unroll
                for (int n = 0; n < 2; ++n) put(xo + (size_t)((bj * 4 + m) * 2 + n) * 1024, acc[1 - SS][bj][m][n]);
        asm volatile("s_waitcnt vmcnt(0)" ::: "memory");
        __syncthreads();
        if (tid == 0) { __hip_atomic_store(flg + (1 - SS), 1u, __ATOMIC_RELAXED, __HIP_MEMORY_SCOPE_AGENT);
            unsigned sp = 0; while (__hip_atomic_load(flg + SS, __ATOMIC_RELAXED, __HIP_MEMORY_SCOPE_AGENT) == 0u) { __builtin_amdgcn_s_sleep(1); if (++sp > (1u << 20)) break; } }
        __syncthreads();
        bf16_t* H = (bf16_t*)(w2 + WS_H); const int col0 = u.pn * 128 + wc * 32 + 8 * fq;
#pragma unroll
        for (int m = 0; m < 4; ++m) {
            const f32x4 g0 = acc[SS][0][m][0] + get(xi + (size_t)((0 * 4 + m) * 2 + 0) * 1024), g1 = acc[SS][0][m][1] + get(xi + (size_t)((0 * 4 + m) * 2 + 1) * 1024);
            const f32x4 u0 = acc[SS][1][m][0] + get(xi + (size_t)((1 * 4 + m) * 2 + 0) * 1024), u1 = acc[SS][1][m][1] + get(xi + (size_t)((1 * 4 + m) * 2 + 1) * 1024);
            const int rl = SS * HALF + wr * 64 + m * 16 + fr; const float rs = rstd[rslot * 256 + rl];
            const float k1 = rs * -1.4426950408889634f, rs2 = SWIGLU_RS2(rs);
            const f32x4 h0 = swiglu4(g0, u0, k1, rs2), h1 = swiglu4(g1, u1, k1, rs2);
            u32x4 w; w.x = cvt_pk_bf16(h0[0], h0[1]); w.y = cvt_pk_bf16(h0[2], h0[3]); w.z = cvt_pk_bf16(h1[0], h1[1]); w.w = cvt_pk_bf16(h1[2], h1[3]);
            *(u32x4*)(H + (size_t)(u.pm * BM + rl) * DFF + col0) = w;
        }
    }
    __device__ __forceinline__ void operator()(const f32x4 (&acc)[2][2][4][2], const Unit& u, int ui, int wr, int wc, int fr, int fq) const {
        if (u.nt == (D / BK) / 2) { asm volatile("" : "+v"(fr), "+v"(fq));
            if (__builtin_amdgcn_workgroup_id_x() >> 7) run<1>(acc, u, wr, wc, fr, fq); else run<0>(acc, u, wr, wc, fr, fq); }
        else { EpiSwiGLU E0{ws, rstd}; E0(acc, u, ui, wr, wc, fr, fq); }
    }
};
template <bool SRC_B, bool WRITE_B, bool WRITE_F, int PROBE = 0> struct EpiResid {
    static constexpr bool PERM = true, AFTER_DRAIN = false;
    const float* base; float* out; unsigned char* ws; float alpha;
    __device__ __forceinline__ static f32x4 up4(unsigned a, unsigned b) { return (f32x4){__uint_as_float(a << 16), __uint_as_float(a & 0xffff0000u), __uint_as_float(b << 16), __uint_as_float(b & 0xffff0000u)}; }
    __device__ __forceinline__ void operator()(const f32x4 (&acc)[2][2][4][2], const Unit& u, int ui, int wr, int wc, int fr, int fq) const {
        asm volatile("" : "+v"(fr), "+v"(fq));
        const int col0 = u.pn * BM + wc * 32 + 8 * fq;
        unsigned char* w2 = ws; LAUNDER_G(w2); bf16_t* xb = (bf16_t*)(w2 + WS_XB); float* ssqp = (float*)(w2 + WS_SSQ);
#pragma unroll
        for (int ai = 0; ai < 2; ++ai) {
            f32x4 rb[4][2][2];
#pragma unroll
            for (int m = 0; m < 4; ++m) { const size_t off = (size_t)(u.pm * BM + ai * HALF + wr * 64 + m * 16 + fr) * DMODEL + col0;
#pragma unroll
                for (int bj = 0; bj < 2; ++bj) {
                    if (PROBE == 1) { rb[m][bj][0] = (f32x4){0.f, 0.f, 0.f, 0.f}; rb[m][bj][1] = rb[m][bj][0]; }
                    else if (SRC_B) { const u32x4 r = *(const u32x4*)(xb + off + bj * HALF); rb[m][bj][0] = __builtin_bit_cast(f32x4, r); }
                    else { rb[m][bj][0] = *(const f32x4*)(base + off + bj * HALF); rb[m][bj][1] = *(const f32x4*)(base + off + bj * HALF + 4); } } }
#pragma unroll
            for (int m = 0; m < 4; ++m) {
                const int row = u.pm * BM + ai * HALF + wr * 64 + m * 16 + fr; const size_t off = (size_t)row * DMODEL + col0; float ss = 0.f;
#pragma unroll
                for (int bj = 0; bj < 2; ++bj) { const size_t o = off + bj * HALF;
                    f32x4 b0, b1;
                    if (SRC_B) { const u32x4 r = __builtin_bit_cast(u32x4, rb[m][bj][0]); b0 = up4(r[0], r[1]); b1 = up4(r[2], r[3]); } else { b0 = rb[m][bj][0]; b1 = rb[m][bj][1]; }
                    const f32x4 v0 = b0 + acc[ai][bj][m][0] * alpha, v1 = b1 + acc[ai][bj][m][1] * alpha;
                    if (PROBE == 2) { asm volatile("" :: "v"(v0), "v"(v1)); }
#ifdef OUT_NT
                    if (WRITE_F && PROBE != 2) { __builtin_nontemporal_store(v0, (f32x4*)(out + o)); __builtin_nontemporal_store(v1, (f32x4*)(out + o + 4)); }
#else
                    if (WRITE_F && PROBE != 2) { *(f32x4*)(out + o) = v0; *(f32x4*)(out + o + 4) = v1; }
#endif
                    if (WRITE_B && PROBE != 2) { ss += ((v0[0] * v0[0] + v0[1] * v0[1]) + (v0[2] * v0[2] + v0[3] * v0[3])) + ((v1[0] * v1[0] + v1[1] * v1[1]) + (v1[2] * v1[2] + v1[3] * v1[3]));
                        u32x4 w; w.x = cvt_pk_bf16(v0[0], v0[1]); w.y = cvt_pk_bf16(v0[2], v0[3]); w.z = cvt_pk_bf16(v1[0], v1[1]); w.w = cvt_pk_bf16(v1[2], v1[3]); *(u32x4*)(xb + o) = w; } }
                if (WRITE_B && PROBE != 2) { ss += xor_lane<16>(ss); ss = sum_x32(ss); if (fq == 0) ssqp[(size_t)row * 16 + u.pn * 4 + wc] = ss; }
            }
            asm volatile("" ::: "memory");
        }
    }
};
template <bool WRITE_B, bool WRITE_F> struct EpiResidStaged {
    static constexpr bool PERM = true, AFTER_DRAIN = true;
    float* out; unsigned char* ws; float alpha; unsigned char* wsw;
    __device__ __forceinline__ static f32x4 up4(unsigned a, unsigned b) { return (f32x4){__uint_as_float(a << 16), __uint_as_float(a & 0xffff0000u), __uint_as_float(b << 16), __uint_as_float(b & 0xffff0000u)}; }
    __device__ __forceinline__ void fused(f32x4 (&acc)[2][2][4][2], const Unit& u, int wr, int wc, int fr, int fq, PG8_LAS unsigned char* lds, int wid, int lane) const {
        unsigned char* w2 = ws; LAUNDER_G(w2); const bf16_t* xb = (const bf16_t*)(w2 + WS_XB); unsigned char* w3 = wsw; LAUNDER_G(w3); bf16_t* xbw = (bf16_t*)(w3 + WS_XB); float* ssqp = (float*)(w3 + WS_SSQ);
        {
            const int tid = wid * 64 + lane, c = tid & 31, r0 = tid >> 5;
            const bf16_t* src = xb + (size_t)(u.pm * BM + r0) * DMODEL + u.pn * BM + c * 8;
            u32x4 t[16];
#pragma unroll
            for (int p = 0; p < 16; ++p) t[p] = *(const u32x4*)(src + (size_t)(p * 16) * DMODEL);
#pragma unroll
            for (int p = 0; p < 16; ++p) { const int r = p * 16 + r0; *(PG8_LAS u32x4*)(lds + r * 512 + ((c ^ (r & 15)) << 4)) = t[p]; }
        }
        asm volatile("s_waitcnt vmcnt(0) lgkmcnt(0)\n\ts_barrier" ::: "memory");
        asm volatile("" : "+v"(fr), "+v"(fq));
        const int col0 = u.pn * BM + wc * 32 + 8 * fq;
#pragma unroll
        for (int ai = 0; ai < 2; ++ai)
#pragma unroll
            for (int m = 0; m < 4; ++m) {
                const int rl = ai * HALF + wr * 64 + m * 16 + fr; const int row = u.pm * BM + rl; const size_t off = (size_t)row * DMODEL + col0; float ss = 0.f;
#pragma unroll
                for (int bj = 0; bj < 2; ++bj) { const size_t o = off + bj * HALF;
                    const int chunk = 16 * bj + 4 * wc + fq;
                    const u32x4 r = *(const PG8_LAS u32x4*)(lds + rl * 512 + ((chunk ^ (rl & 15)) << 4));
                    const f32x4 b0 = up4(r[0], r[1]), b1 = up4(r[2], r[3]);
                    const f32x4 v0 = b0 + acc[ai][bj][m][0] * alpha, v1 = b1 + acc[ai][bj][m][1] * alpha;
                    if (WRITE_F) { *(f32x4*)(out + o) = v0; *(f32x4*)(out + o + 4) = v1; }
                    if (WRITE_B) { ss += ((v0[0] * v0[0] + v0[1] * v0[1]) + (v0[2] * v0[2] + v0[3] * v0[3])) + ((v1[0] * v1[0] + v1[1] * v1[1]) + (v1[2] * v1[2] + v1[3] * v1[3]));
                        u32x4 w; w.x = cvt_pk_bf16(v0[0], v0[1]); w.y = cvt_pk_bf16(v0[2], v0[3]); w.z = cvt_pk_bf16(v1[0], v1[1]); w.w = cvt_pk_bf16(v1[2], v1[3]); *(u32x4*)(xbw + o) = w; } }
                if (WRITE_B) { ss += xor_lane<16>(ss); ss = sum_x32(ss); if (fq == 0) ssqp[(size_t)row * 16 + u.pn * 4 + wc] = ss; }
            }
    }
};
struct EpiNull {
    static constexpr bool PERM = true, AFTER_DRAIN = false;
    __device__ __forceinline__ void operator()(const f32x4 (&acc)[2][2][4][2], const Unit& u, int ui, int wr, int wc, int fr, int fq) const {
#pragma unroll
        for (int ai = 0; ai < 2; ++ai)
#pragma unroll
            for (int bj = 0; bj < 2; ++bj)
#pragma unroll
                for (int m = 0; m < 4; ++m)
#pragma unroll
                    for (int n = 0; n < 2; ++n) { f32x4 t = acc[ai][bj][m][n]; asm volatile("" :: "v"(t)); }
    }
};
struct EpiInProj {
    static constexpr bool PERM = false, AFTER_DRAIN = false;
    const PG8_LAS float* rstd; const PG8_LAS float* prm; unsigned char* ws;
    __device__ __forceinline__ static float head_f(const f32x4 (&acc)[2][2][4][2], int ai, int m, float rs) {
        float ss = 0.f;
#pragma unroll
        for (int bj = 0; bj < 2; ++bj)
#pragma unroll
            for (int n = 0; n < 2; ++n) { const f32x4 a = acc[ai][bj][m][n]; ss += (a[0] * a[0] + a[1] * a[1]) + (a[2] * a[2] + a[3] * a[3]); }
        ss += xor_lane<16>(ss); ss = sum_x32(ss);
        return rs / sqrtf(ss * rs * rs * (1.0f / 64.0f) + 1e-6f);
    }
    __device__ __forceinline__ void operator()(const f32x4 (&acc)[2][2][4][2], const Unit& u, int ui, int wr, int wc, int fr, int fq) const {
        const int G = __builtin_amdgcn_readfirstlane(u.pn * 4 + wc);
        unsigned char* w2 = ws; LAUNDER_G(w2);
        asm volatile("" : "+v"(fr), "+v"(fq));
        const int row0 = wr * 64 + fr;
        if (G < 10) {
            const bool isq = G < 8;
            const PG8_LAS float* gp = prm + (isq ? PRM_GAQ : PRM_GAK) + 4 * fq;
            const float* rope = (const float*)(w2 + WS_ROPE) + 4 * fq;
            const float qs = isq ? 0.125f * 1.4426950408889634f : 1.0f;
            unsigned char* db = isq ? (w2 + WS_QA) + (size_t)G * MROWS * 64 + 8 * fq : (w2 + WS_KA) + (size_t)(G - 8) * MROWS * 64 + (fq >> 1) * 512 + 8 * (fq & 1);
#pragma unroll
            for (int ai = 0; ai < 2; ++ai)
#pragma unroll
                for (int m = 0; m < 4; ++m) {
                    const int rl = ai * HALF + m * 16 + row0; const int t = u.pm * BM + rl; const float f = head_f(acc, ai, m, rstd[ui * 256 + rl]) * qs;
                    unsigned char* dt = isq ? db + (size_t)t * 64 : db + (size_t)(t >> 6) * 4096 + ((t & 63) >> 5) * 2048 + (t & 31) * 16;
#pragma unroll
                    for (int bj = 0; bj < 2; ++bj) {
                        const f32x4 x1 = acc[ai][bj][m][0] * f * *(const PG8_LAS f32x4*)(gp + 32 * bj), x2 = acc[ai][bj][m][1] * f * *(const PG8_LAS f32x4*)(gp + 32 * bj + 16);
                        const int pos = bj ? (t & 63) : (t >> 6); const float* rp = rope + (bj ? 8192 : 0) + pos * 16;
                        const f32x4 c = *(const f32x4*)rp, s = *(const f32x4*)(rp + (bj ? 1024 : 4096));
                        const f32x4 y1 = x1 * c - x2 * s, y2 = x2 * c + x1 * s;
                        int lo = __builtin_amdgcn_cvt_pk_fp8_f32(y1[0], y1[1], 0, false); lo = __builtin_amdgcn_cvt_pk_fp8_f32(y1[2], y1[3], lo, true);
                        int hi = __builtin_amdgcn_cvt_pk_fp8_f32(y2[0], y2[1], 0, false); hi = __builtin_amdgcn_cvt_pk_fp8_f32(y2[2], y2[3], hi, true);
                        u32x2 w; w.x = (unsigned)lo; w.y = (unsigned)hi;
                        *(u32x2*)(dt + (isq ? 32 * bj : 1024 * bj)) = w;
                    }
                    asm volatile("" ::: "memory");
                }
        } else if (G < 12) {
            unsigned char* V8 = (w2 + WS_VA) + (size_t)(G - 10) * MROWS * 64 + (4 * fq) * 16;
#pragma unroll
            for (int ai = 0; ai < 2; ++ai)
#pragma unroll
                for (int m = 0; m < 4; ++m) {
                    const int rl = ai * HALF + m * 16 + row0; const int t = u.pm * BM + rl; const float rs = rstd[ui * 256 + rl];
                    const int kk = t & 63, c = kk >> 5, r = kk & 31, h = (r >> 2) & 1, jj = (r & 3) + 4 * (r >> 3);
                    unsigned char* vb = V8 + (size_t)(t >> 6) * 4096 + h * 1024 + c * 512 + jj;
#pragma unroll
                    for (int bj = 0; bj < 2; ++bj)
#pragma unroll
                        for (int n = 0; n < 2; ++n) { const f32x4 v = acc[ai][bj][m][n] * rs;
                            const int p01 = __builtin_amdgcn_cvt_pk_fp8_f32(v[0], v[1], 0, false), p23 = __builtin_amdgcn_cvt_pk_fp8_f32(v[2], v[3], 0, false);
                            unsigned char* q = vb + bj * 2048 + (16 * n) * 16;
                            q[0] = (unsigned char)(p01 & 0xff); q[16] = (unsigned char)((p01 >> 8) & 0xff); q[32] = (unsigned char)(p23 & 0xff); q[48] = (unsigned char)((p23 >> 8) & 0xff); }
                    asm volatile("" ::: "memory");
                }
        } else if (G < 28) {
            const bool isq = G < 20;
            const PG8_LAS float* gp = prm + (isq ? PRM_GBQ : PRM_GBK) + 4 * fq;
            const float qs = isq ? 0.125f * 1.4426950408889634f : 1.0f;
            bf16_t* db = isq ? (bf16_t*)(w2 + WS_QB) + (size_t)(G - 12) * MROWS * 64 + 8 * fq : (bf16_t*)(w2 + WS_KB) + (size_t)(G - 20) * MROWS * 64 + (size_t)fq * 512;
#pragma unroll
            for (int ai = 0; ai < 2; ++ai)
#pragma unroll
                for (int m = 0; m < 4; ++m) {
                    const int rl = ai * HALF + m * 16 + row0; const int t = u.pm * BM + rl; const float f = head_f(acc, ai, m, rstd[ui * 256 + rl]) * qs;
                    bf16_t* dt = isq ? db + (size_t)t * 64 : db + (size_t)(t >> 6) * 4096 + (t & 63) * 8;
#pragma unroll
                    for (int bj = 0; bj < 2; ++bj) {
                        const f32x4 x1 = acc[ai][bj][m][0] * f * *(const PG8_LAS f32x4*)(gp + 32 * bj), x2 = acc[ai][bj][m][1] * f * *(const PG8_LAS f32x4*)(gp + 32 * bj + 16);
                        u32x4 w; w.x = cvt_pk_bf16(x1[0], x1[1]); w.y = cvt_pk_bf16(x1[2], x1[3]); w.z = cvt_pk_bf16(x2[0], x2[1]); w.w = cvt_pk_bf16(x2[2], x2[3]);
                        *(u32x4*)(dt + (isq ? 32 * bj : 2048 * bj)) = w;
                    }
                    asm volatile("" ::: "memory");
                }
        } else {
            bf16_t* V = (bf16_t*)(w2 + WS_VB) + (size_t)((G - 28) >> 1) * MROWS * 128 + (64 * ((G - 28) & 1) + 4 * fq) * 8;
#pragma unroll
            for (int ai = 0; ai < 2; ++ai)
#pragma unroll
                for (int m = 0; m < 4; ++m) {
                    const int rl = ai * HALF + m * 16 + row0; const int t = u.pm * BM + rl; const float rs = rstd[ui * 256 + rl];
                    const int kk = t & 63, ks = kk >> 4, ko = kk & 15, hi = (ko >> 2) & 1, j = ((ko >> 3) << 2) | (ko & 3);
                    bf16_t* vb = V + (size_t)(((t >> 6) * 4 + ks) * 2 + hi) * 1024 + j;
#pragma unroll
                    for (int bj = 0; bj < 2; ++bj)
#pragma unroll
                        for (int n = 0; n < 2; ++n)
#pragma unroll
                            for (int e = 0; e < 4; ++e) vb[(32 * bj + 16 * n + e) * 8] = f2bf1(acc[ai][bj][m][n][e] * rs);
                    asm volatile("" ::: "memory");
                }
        }
    }
};

#ifndef NOTAIL
#define NOTAIL 0
#endif
template <int KD, class Epi, class Sched, bool ALIGN_EPI = false, bool SP2 = false, int LD = KD, bool VARK = false>
__device__ __forceinline__ void gemm_phase(PG8_LAS unsigned char* lds, const Gemm g, const Sched& S, const Epi& E, int wave_id) {
    int tid_ = wave_id * 64 + lane_id_v(); asm volatile("" : "+v"(tid_));
    const int tid = tid_, wid = __builtin_amdgcn_readfirstlane(tid >> 6), lane = tid & 63, wr = wid >> 2, wc = wid & 3, fr = lane & 15, fq = lane >> 4;
    constexpr int K = KD, ntc = K / BK; static_assert(ntc % 2 == 0, "even K-tile count");
    unsigned voffA[2], voffB[2];
#pragma unroll
    for (int i = 0; i < 2; ++i) { int R, C; stage_rc(tid * 16 + i * 8192, R, C); const int Rb = Epi::PERM ? ((R & ~31) + perm32(R & 31)) : R;
        voffA[i] = (unsigned)(R * LD + C) * 2u; voffB[i] = (unsigned)(Rb * LD + C) * 2u; }
    constexpr size_t kstep = (size_t)(BK * 2);
    constexpr size_t hstep = (size_t)HALF * LD * 2;
    constexpr size_t tstep = 2 * hstep;
    const unsigned ldsw = (unsigned)wid * 1024u;
    const int aoff = lds_byte(wr * 64 + fr, fq * 8), boff = lds_byte(wc * 32 + fr, fq * 8);
#define PG8_SA(b, h) (((b) * 2 + (h)) * HTB)
#define PG8_SB(b, h) ((4 + (b) * 2 + (h)) * HTB)
#define PG8_STAGE(bufoff, gbase, voff) do { _Pragma("unroll") for (int _i = 0; _i < 2; ++_i) \
        __builtin_amdgcn_global_load_lds((const unsigned*)((const char*)(gbase) + (voff)[_i]), (PG8_LAS unsigned*)(lds + (bufoff) + ldsw + _i * 8192), 16, 0, 0); } while (0)
#define PG8_LDA(dst, b, h) do { _Pragma("unroll") for (int m = 0; m < 4; ++m) _Pragma("unroll") for (int k = 0; k < 2; ++k) dst[m][k] = *(const PG8_LAS bf16x8*)(lds + PG8_SA(b, h) + aoff + m * 2048 + k * 1024); } while (0)
#define PG8_LDB(dst, b, h) do { _Pragma("unroll") for (int n = 0; n < 2; ++n) _Pragma("unroll") for (int k = 0; k < 2; ++k) dst[n][k] = *(const PG8_LAS bf16x8*)(lds + PG8_SB(b, h) + boff + n * 2048 + k * 1024); } while (0)
#define PG8_MMA(ai, bj, At, Bt) do { __builtin_amdgcn_s_setprio(1); _Pragma("unroll") for (int m = 0; m < 4; ++m) _Pragma("unroll") for (int n = 0; n < 2; ++n) _Pragma("unroll") for (int k = 0; k < 2; ++k) \
        acc[ai][bj][m][n] = __builtin_amdgcn_mfma_f32_16x16x32_bf16(Bt[n][k], At[m][k], acc[ai][bj][m][n], 0, 0, 0); __builtin_amdgcn_s_setprio(0); } while (0)
#define PG8_WAIT_V(n) asm volatile("s_waitcnt vmcnt(" #n ")" ::: "memory")
#define PG8_WAIT_L(n) asm volatile("s_waitcnt lgkmcnt(" #n ")" ::: "memory")
#define PG8_BAR __builtin_amdgcn_s_barrier()
#define PG8_SCHED __builtin_amdgcn_sched_barrier(0)
    Unit cur, nxt; int ui = 0;
    if (!S.next(0, cur)) return;
    f32x4 acc[2][2][4][2];
#pragma unroll
    for (int a = 0; a < 2; ++a)
#pragma unroll
        for (int b = 0; b < 2; ++b)
#pragma unroll
            for (int m = 0; m < 4; ++m)
#pragma unroll
                for (int n = 0; n < 2; ++n) acc[a][b][m][n] = (f32x4){0.f, 0.f, 0.f, 0.f};
    bf16x8 At[4][2], B0[2][2], B1[2][2];
    const char* cA = (const char*)g.A + (size_t)cur.pm * tstep + (VARK ? cur.kofs : 0); const char* cB = (const char*)g.Bt + (size_t)cur.pn * tstep + (VARK ? cur.kofs : 0);
    S.a_ready(cur);
    if constexpr (SP2) {
        PG8_STAGE(PG8_SB(0, 0), cB, voffB); PG8_STAGE(PG8_SB(0, 1), cB + hstep, voffB); PG8_STAGE(PG8_SA(0, 0), cA, voffA); PG8_STAGE(PG8_SA(0, 1), cA + hstep, voffA);
        if (wr == 1) PG8_BAR;
        PG8_WAIT_V(2); PG8_BAR;
        PG8_STAGE(PG8_SB(1, 0), cB + kstep, voffB); PG8_STAGE(PG8_SA(1, 0), cA + kstep, voffA); PG8_STAGE(PG8_SB(1, 1), cB + hstep + kstep, voffB);
        PG8_WAIT_V(6); PG8_BAR;
    } else {
        PG8_STAGE(PG8_SB(0, 0), cB, voffB); PG8_STAGE(PG8_SA(0, 0), cA, voffA); PG8_STAGE(PG8_SB(0, 1), cB + hstep, voffB); PG8_STAGE(PG8_SA(0, 1), cA + hstep, voffA);
        if (wr == 1) PG8_BAR;
        PG8_WAIT_V(4); PG8_BAR;
        PG8_STAGE(PG8_SB(1, 0), cB + kstep, voffB); PG8_STAGE(PG8_SA(1, 0), cA + kstep, voffA); PG8_STAGE(PG8_SB(1, 1), cB + hstep + kstep, voffB);
        PG8_WAIT_V(6); PG8_BAR;
    }
    for (;;) {
        const bool has_next = S.next(ui + 1, nxt);
        const char* nA = has_next ? (const char*)g.A + (size_t)nxt.pm * tstep + (VARK ? nxt.kofs : 0) : cA; const char* nB = has_next ? (const char*)g.Bt + (size_t)nxt.pn * tstep + (VARK ? nxt.kofs : 0) : cB;
        const int nt = VARK ? cur.nt : ntc;
        for (int t = 0; t < nt; t += 2) {
            const bool last = (t == nt - 2); const bool fin = last && !has_next;
            const char* a1 = cA + (size_t)(t + 1) * kstep;
            const char* a2 = last ? nA : cA + (size_t)(t + 2) * kstep; const char* b2 = last ? nB : cB + (size_t)(t + 2) * kstep;
            const char* a3 = a2 + kstep; const char* b3 = b2 + kstep;
            if (last && has_next) S.a_ready(nxt);
            if constexpr (SP2) {
            PG8_LDB(B0, 0, 0); PG8_LDB(B1, 0, 1); PG8_SCHED; PG8_LDA(At, 0, 0); PG8_STAGE(PG8_SA(1, 1), a1 + hstep, voffA);
            PG8_WAIT_V(8); PG8_WAIT_L(0); PG8_BAR; PG8_MMA(0, 0, At, B0); PG8_MMA(0, 1, At, B1); PG8_BAR; PG8_SCHED;
            PG8_LDA(At, 0, 1); if (NOTAIL && fin) { PG8_WAIT_V(2); } else { PG8_STAGE(PG8_SB(0, 0), b2, voffB); PG8_STAGE(PG8_SB(0, 1), b2 + hstep, voffB); PG8_STAGE(PG8_SA(0, 0), a2, voffA); PG8_WAIT_V(8); }
            PG8_WAIT_L(0); PG8_BAR; PG8_MMA(1, 0, At, B0); PG8_MMA(1, 1, At, B1); PG8_BAR; PG8_SCHED;
            PG8_LDB(B0, 1, 0); PG8_LDB(B1, 1, 1); PG8_SCHED; PG8_LDA(At, 1, 0); if (NOTAIL && fin) { PG8_WAIT_V(0); } else { PG8_STAGE(PG8_SA(0, 1), a2 + hstep, voffA); PG8_WAIT_V(8); }
            PG8_WAIT_L(0); PG8_BAR; PG8_MMA(0, 0, At, B0); PG8_MMA(0, 1, At, B1); PG8_BAR; PG8_SCHED;
            PG8_LDA(At, 1, 1); if (!(NOTAIL && fin)) { PG8_STAGE(PG8_SB(1, 0), b3, voffB); PG8_STAGE(PG8_SB(1, 1), b3 + hstep, voffB); PG8_STAGE(PG8_SA(1, 0), a3, voffA); PG8_WAIT_V(8); }
            PG8_WAIT_L(0); PG8_BAR; PG8_MMA(1, 0, At, B0); PG8_MMA(1, 1, At, B1); PG8_BAR; PG8_SCHED;
            } else {
            PG8_LDB(B0, 0, 0); PG8_SCHED; PG8_LDA(At, 0, 0); PG8_STAGE(PG8_SA(1, 1), a1 + hstep, voffA);
            PG8_WAIT_L(8); PG8_BAR; PG8_WAIT_L(0); PG8_MMA(0, 0, At, B0); PG8_BAR; PG8_SCHED;
            PG8_LDB(B1, 0, 1); PG8_STAGE(PG8_SB(0, 0), b2, voffB);
            PG8_BAR; PG8_WAIT_L(0); PG8_MMA(0, 1, At, B1); PG8_BAR;
            PG8_LDA(At, 0, 1); PG8_STAGE(PG8_SA(0, 0), a2, voffA);
            PG8_BAR; PG8_WAIT_L(0); PG8_MMA(1, 0, At, B0); PG8_BAR; PG8_SCHED;
            PG8_STAGE(PG8_SB(0, 1), b2 + hstep, voffB);
            PG8_WAIT_V(6); PG8_BAR; PG8_MMA(1, 1, At, B1); PG8_BAR;
            PG8_LDB(B0, 1, 0); PG8_SCHED; PG8_LDA(At, 1, 0); PG8_STAGE(PG8_SA(0, 1), a2 + hstep, voffA);
            PG8_WAIT_L(8); PG8_BAR; PG8_WAIT_L(0); PG8_MMA(0, 0, At, B0); PG8_BAR; PG8_SCHED;
            PG8_LDB(B1, 1, 1); PG8_STAGE(PG8_SB(1, 0), b3, voffB);
            PG8_BAR; PG8_WAIT_L(0); PG8_MMA(0, 1, At, B1); PG8_BAR;
            PG8_LDA(At, 1, 1); PG8_STAGE(PG8_SA(1, 0), a3, voffA);
            PG8_BAR; PG8_WAIT_L(0); PG8_MMA(1, 0, At, B0); PG8_BAR; PG8_SCHED;
            PG8_STAGE(PG8_SB(1, 1), b3 + hstep, voffB);
            PG8_WAIT_V(6); PG8_BAR; PG8_MMA(1, 1, At, B1); PG8_BAR;
            }
        }
        if constexpr (ALIGN_EPI) { if (wr == 0) PG8_BAR; }
        if constexpr (!Epi::AFTER_DRAIN) { E(acc, cur, ui, wr, wc, fr, fq); S.done(cur); }
        if (!has_next) break;
#pragma unroll
        for (int a = 0; a < 2; ++a)
#pragma unroll
            for (int b = 0; b < 2; ++b)
#pragma unroll
                for (int m = 0; m < 4; ++m)
#pragma unroll
                    for (int n = 0; n < 2; ++n) acc[a][b][m][n] = (f32x4){0.f, 0.f, 0.f, 0.f};
        cur = nxt; cA = nA; cB = nB; ++ui;
        if constexpr (ALIGN_EPI) { if (wr == 1) PG8_BAR; }
    }
    PG8_WAIT_V(0);
    if constexpr (!ALIGN_EPI) { if (wr == 0) PG8_BAR; }
    PG8_BAR;
    if constexpr (Epi::AFTER_DRAIN) { E.fused(acc, cur, wr, wc, fr, fq, lds, wid, lane); S.done(cur); }
#undef PG8_SA
#undef PG8_SB
#undef PG8_STAGE
#undef PG8_LDA
#undef PG8_LDB
#undef PG8_MMA
#undef PG8_WAIT_V
#undef PG8_WAIT_L
#undef PG8_BAR
#undef PG8_SCHED
}
}
namespace att {
typedef unsigned short bf16_t;
typedef short bf16x8 __attribute__((ext_vector_type(8)));
typedef float f32x16 __attribute__((ext_vector_type(16)));
typedef float f32x4 __attribute__((ext_vector_type(4)));
typedef unsigned u32x4 __attribute__((ext_vector_type(4)));
#define ALAS __attribute__((address_space(3)))
constexpr int MROWS = M;
constexpr int WSF_OFF = 114688;
constexpr int LDS_NEED = WSF_OFF + 8 * 256;
__device__ __forceinline__ int crow(int r, int hi) { return (r & 3) + 8 * (r >> 2) + 4 * hi; }
__device__ __forceinline__ void glds16(const void* gsrc, unsigned lds_dst) { unsigned keep;
    asm volatile("s_mov_b32 %0, m0\n\ts_mov_b32 m0, %2\n\ts_nop 0\n\tglobal_load_lds_dwordx4 %1, off\n\ts_mov_b32 m0, %0" : "=&s"(keep) : "v"(gsrc), "s"(lds_dst) : "memory"); }
typedef float f32x2_t __attribute__((ext_vector_type(2))); typedef __bf16 bf16x2_t __attribute__((ext_vector_type(2)));
__device__ __forceinline__ unsigned cvtpk(float lo, float hi) { f32x2_t v = {lo, hi}; bf16x2_t b = __builtin_convertvector(v, bf16x2_t); return __builtin_bit_cast(unsigned, b); }
__device__ __forceinline__ void glds16s(const void* sbase, unsigned voff, unsigned lds_dst) { unsigned keep;
#ifdef GLDS_M0_CLOBBER
    (void)keep; asm volatile("s_mov_b32 m0, %2\n\ts_nop 0\n\tglobal_load_lds_dwordx4 %0, %1" :: "v"(voff), "s"(sbase), "s"(lds_dst) : "memory", "m0"); }
#else
    asm volatile("s_mov_b32 %0, m0\n\ts_mov_b32 m0, %3\n\ts_nop 0\n\tglobal_load_lds_dwordx4 %1, %2\n\ts_mov_b32 m0, %0" : "=&s"(keep) : "v"(voff), "s"(sbase), "s"(lds_dst) : "memory"); }
#endif
#define ATT_WAIT_BAR(N) asm volatile("s_waitcnt vmcnt(" #N ") lgkmcnt(0)\n\ts_barrier" ::: "memory")
#define ATT_MFMA(a, b, c) __builtin_amdgcn_mfma_f32_32x32x16_bf16(a, b, c, 0, 0, 0)

struct Tensors { unsigned char* ws; const ALAS float* subln; };
__device__ __forceinline__ Tensors make_tensors(unsigned char* ws, const ALAS float* prm) { return Tensors{ws, prm + PRM_SUBLN}; }
#define T_QA ((const bf16_t*)(tws_ + WS_QA))
#define T_KA ((const bf16_t*)(tws_ + WS_KA))
#define T_VA ((const bf16_t*)(tws_ + WS_VA))
#define T_QB ((const bf16_t*)(tws_ + WS_QB))
#define T_KB ((const bf16_t*)(tws_ + WS_KB))
#define T_VB ((const bf16_t*)(tws_ + WS_VB))
#define T_MIX ((bf16_t*)(tws_ + WS_MIX))

#define SBAR() __builtin_amdgcn_sched_barrier(0)
#define PIN(x) asm volatile("" : "+v"(x))
#define PKW(P, B) cvtpk(P[B], P[(B) + 1])
#define EX(v) __builtin_amdgcn_exp2f(v)
#define WB_SEL(n) do { switch (n) { case 0: ATT_WAIT_BAR(0); break; case 1: ATT_WAIT_BAR(1); break; case 2: ATT_WAIT_BAR(2); break; case 3: ATT_WAIT_BAR(3); break; case 4: ATT_WAIT_BAR(4); break; case 6: ATT_WAIT_BAR(6); break; default: ATT_WAIT_BAR(8); } } while (0)
template <bool ISB, int BPROBE = 0>
__device__ __forceinline__ void attn_unit(const Tensors& T, int head, int qb, float negM2, float lam, float c2, int dskip, char* shm, int wave_id) {
    unsigned char* tws_ = T.ws; LAUNDER_G(tws_);
    constexpr int DV = ISB ? 128 : 64, ND0 = DV / 32, NK = ISB ? 2 : 1, NV = ISB ? 2 : 1;
    constexpr int KSLOT = ISB ? 16384 : 8192, VSLOT = ISB ? 16384 : 8192, LDS_K = 0, LDS_V = 3 * KSLOT;
    int tid_ = wave_id * 64 + lane_id_v(); asm volatile("" : "+v"(tid_));
    const int tid = tid_, lane = tid & 63, r32 = lane & 31, hi = lane >> 5; const int wid = __builtin_amdgcn_readfirstlane(tid >> 6);
    const int mapc = ISB ? (wid >> 2) : 0, wq = ISB ? (wid & 3) : wid;
    const int q0 = ISB ? qb * 128 : qb * 256; const int qrow = q0 + wq * 32 + r32;
    int t0 = 0, t1 = 256;
    if (ISB) { const int lo = q0 - dskip, hi_ = q0 + 127 + dskip; t0 = lo > 0 ? (lo >> 6) : 0; t1 = (hi_ >> 6) + 1; if (t1 > 256) t1 = 256;
        if ((t1 - t0) & 1) { if (t0 > 0) --t0; else ++t1; } }
    const int n = t1 - t0;
    const unsigned lds0 = (unsigned)(uintptr_t)shm;
    const ALAS char* shm3 = (const ALAS char*)shm;
    const char* k1b = ISB ? (const char*)(T_KB + (size_t)(2 * head) * MROWS * 64) + (size_t)t0 * 8192 : (const char*)(T_KA + (size_t)(head >> 2) * MROWS * 64);
    const char* k2b = ISB ? (const char*)(T_KB + (size_t)(2 * head + 1) * MROWS * 64) + (size_t)t0 * 8192 : nullptr;
    const char* vb_ = ISB ? (const char*)(T_VB + (size_t)head * MROWS * 128) + (size_t)t0 * 16384 : (const char*)(T_VA + (size_t)(head >> 2) * MROWS * 64);
    const unsigned dvo = (unsigned)(wid * 1024 + lane * 16);
    const unsigned kdst = lds0 + LDS_K + wid * 1024, vdst = lds0 + LDS_V + wid * 1024;
#define DMA_K(i, so) do { glds16s(k1b + (size_t)(i) * 8192, dvo, (unsigned)__builtin_amdgcn_readfirstlane(kdst + (so))); if (ISB) glds16s(k2b + (size_t)(i) * 8192, dvo, (unsigned)__builtin_amdgcn_readfirstlane(kdst + (so) + 8192)); } while (0)
#define DMA_V(i, so) do { if (ISB) { glds16s(vb_ + (size_t)(i) * 16384, dvo, (unsigned)__builtin_amdgcn_readfirstlane(vdst + (so))); glds16s(vb_ + (size_t)(i) * 16384 + 8192, dvo, (unsigned)__builtin_amdgcn_readfirstlane(vdst + (so) + 8192)); } \
      else glds16s(vb_ + (size_t)(i) * 8192, dvo, (unsigned)__builtin_amdgcn_readfirstlane(vdst + (so))); } while (0)
    DMA_K(0, 0); DMA_V(0, 0); DMA_K(1, KSLOT); DMA_V(1, VSLOT);
    const bf16_t* Qw = (ISB ? T_QB + (size_t)(2 * head + mapc) * MROWS * 64 : T_QA + (size_t)head * MROWS * 64) + (size_t)qrow * 64;
    bf16x8 qr[4];
#pragma unroll
    for (int d0 = 0; d0 < 4; ++d0) qr[d0] = *(const bf16x8*)(Qw + d0 * 16 + hi * 8);
    f32x16 o[ND0];
#pragma unroll
    for (int d = 0; d < ND0; ++d) o[d] = f32x16{};
    f32x16 negm;
#pragma unroll
    for (int r = 0; r < 16; ++r) negm[r] = negM2;
    asm volatile("" : "+v"(negm));
    float l_reg = 0.f;
    f32x16 osum = f32x16{}; bf16x8 ones; { const short o1 = (short)0x3f80; ones = (bf16x8){o1, o1, o1, o1, o1, o1, o1, o1}; } asm volatile("" : "+v"(ones));
    const ALAS char* kp0 = shm3 + LDS_K + (ISB ? mapc * 8192 : 0) + hi * 1024 + r32 * 16;
    const ALAS char* vp0 = shm3 + LDS_V + hi * (DV * 16) + r32 * 16;
    const int qw_lo = q0 + wq * 32, qw_hi = qw_lo + 31;
    const float nc2 = -c2; const float dl0 = (float)(64 * t0 - qrow + 4 * hi);
#define BIAS_GEN4(X, B, DC) do { const float e1_ = (DC) + 1.0f, e2_ = (DC) + 2.0f, e3_ = e1_ + 2.0f; \
        X[B] = __builtin_fmaf(__builtin_fabsf(DC), nc2, negM2); X[(B) + 1] = __builtin_fmaf(__builtin_fabsf(e1_), nc2, negM2); X[(B) + 2] = __builtin_fmaf(__builtin_fabsf(e2_), nc2, negM2); X[(B) + 3] = __builtin_fmaf(__builtin_fabsf(e3_), nc2, negM2); DC += 8.0f; } while (0)
#define BIAS_FAST4(X, B, DC) do { X[B] = __builtin_fmaf(sc1_, (DC), negM2); float t1_ = X[B] + sc1_; asm volatile("" : "+v"(t1_)); float t2_ = X[B] + sc2_; asm volatile("" : "+v"(t2_)); X[(B) + 1] = t1_; X[(B) + 2] = t2_; X[(B) + 3] = X[B] + sc3_; DC += 8.0f; } while (0)
#define BIAS_ALL(X0, X1, DL) do { float dc_ = (DL); BIAS_GEN4(X0, 0, dc_); BIAS_GEN4(X0, 4, dc_); BIAS_GEN4(X0, 8, dc_); BIAS_GEN4(X0, 12, dc_); BIAS_GEN4(X1, 0, dc_); BIAS_GEN4(X1, 4, dc_); BIAS_GEN4(X1, 8, dc_); BIAS_GEN4(X1, 12, dc_); } while (0)
#ifdef BIAS_CONST
    float cst[32];
#pragma unroll
    for (int e = 0; e < 32; ++e) { float cv_ = c2 * (float)(8 * (e >> 2) + (e & 3)); asm volatile("" : "+v"(cv_)); cst[e] = __builtin_bit_cast(float, __builtin_amdgcn_readfirstlane(__builtin_bit_cast(int, cv_))); }
#define BIAS_STEP_SETUP() const float base_ = __builtin_fmaf(sc1_, dcn_, negM2); float sgn_ = above_ ? -1.0f : 1.0f; asm volatile("" : "+v"(sgn_))
#else
#define BIAS_STEP_SETUP() do {} while (0)
#endif
    f32x16 pA0, pA1, pB0, pB1;
    bf16x8 kf[8], vf[B_VF8 ? 8 : 4]; u32x4 pw0, pw1, pw2, pw3;
    int ks_prev = 0, ks_cur = 0, ks_next = KSLOT, vs_prev = 0, vs_cur = VSLOT, vs_next = 2 * VSLOT, vs_n2 = 3 * VSLOT;
#define ROTK() do { ks_prev = ks_cur; ks_cur = ks_next; ks_next = (ks_next == 2 * KSLOT) ? 0 : ks_next + KSLOT; } while (0)
#define ROT() do { ROTK(); const int tv_ = vs_prev; vs_prev = vs_cur; vs_cur = vs_next; vs_next = vs_n2; vs_n2 = tv_; } while (0)
    DMA_K(2, 2 * KSLOT);
    WB_SEL(2 * NV + 2 * NK);
    if (ISB) { BIAS_ALL(pA0, pA1, dl0); } else { pA0 = negm; pA1 = negm; }
    {
        const ALAS char* kp = kp0;
#pragma unroll
        for (int d0 = 0; d0 < 4; ++d0) { const bf16x8 b0 = *(const ALAS bf16x8*)(kp + d0 * 2048), b1 = *(const ALAS bf16x8*)(kp + d0 * 2048 + 512);
            pA0 = ATT_MFMA(b0, qr[d0], pA0); pA1 = ATT_MFMA(b1, qr[d0], pA1); }
#pragma unroll
        for (int r = 0; r < 16; ++r) { pA0[r] = EX(pA0[r]); pA1[r] = EX(pA1[r]); }
    }
    WB_SEL(0);
    DMA_K(3, 0); DMA_V(2, 2 * VSLOT);
    ROTK();
#define KLOAD2(base, j) do { kf[2 * (j)] = *(const ALAS bf16x8*)((base) + (j) * 2048); kf[2 * (j) + 1] = *(const ALAS bf16x8*)((base) + (j) * 2048 + 512); } while (0)
    { const ALAS char* kb_ = kp0 + ks_cur; KLOAD2(kb_, 0); KLOAD2(kb_, 1); KLOAD2(kb_, 2); KLOAD2(kb_, 3); }
    if (ISB) { BIAS_ALL(pB0, pB1, dl0 + 64.f); }
    WB_SEL(NK + NV);
#define PAF(k) __builtin_bit_cast(bf16x8, pw##k)
#if (B_ORDER & 1)
#define GAPA(MF, A0, A1, A2, A3, W0, W1, PW) do { if (ISB) { sacc += A0; sacc += A1; sacc += A2; sacc += A3; PIN(sacc); } W0; W1; PIN(PW); SBAR(); MF; SBAR(); } while (0)
#else
#define GAPA(MF, A0, A1, A2, A3, W0, W1, PW) do { MF; if (ISB) { sacc += A0; sacc += A1; sacc += A2; sacc += A3; PIN(sacc); } W0; W1; PIN(PW); SBAR(); } while (0)
#endif
#define GAPB(MF, X, B) do { MF; X[B] = EX(X[B]); X[(B) + 1] = EX(X[(B) + 1]); X[(B) + 2] = EX(X[(B) + 2]); X[(B) + 3] = EX(X[(B) + 3]); PIN(X); SBAR(); } while (0)
#define GAPX(MF, EXS, X) do { MF; EXS; PIN(X); SBAR(); } while (0)
#define EXB(v) ((BPROBE & 1) ? __builtin_fmaxf((v), 1.0f) : EX(v))
#define EXE(C0, C1, k) do { if ((k) < 16) C0[(k) & 15] = EXB(C0[(k) & 15]); else C1[(k) & 15] = EXB(C1[(k) & 15]); } while (0)
#define EXN(C0, C1, k, N) do { EXE(C0, C1, k); if ((N) > 1) EXE(C0, C1, (k) + 1); if ((N) > 2) EXE(C0, C1, (k) + 2); } while (0)
#if (B_ORDER & 2)
#define GAPEN(MF, C0, C1, k, N) do { EXN(C0, C1, k, N); PIN(C0); PIN(C1); SBAR(); MF; SBAR(); } while (0)
#else
#define GAPEN(MF, C0, C1, k, N) do { MF; EXN(C0, C1, k, N); PIN(C0); PIN(C1); SBAR(); } while (0)
#endif
#define GAPE3(MF, C0, C1, k) do { MF; EXE(C0, C1, k); EXE(C0, C1, (k) + 1); EXE(C0, C1, (k) + 2); PIN(C0); PIN(C1); SBAR(); } while (0)
#ifdef BIAS_CONST
#define GAPC(MF, G, X, B, E0) do { MF; if (G) { { float a0_ = __builtin_fmaf(sgn_, cst[(E0) + (B)], base_), a1_ = __builtin_fmaf(sgn_, cst[(E0) + (B) + 1], base_), a2_ = __builtin_fmaf(sgn_, cst[(E0) + (B) + 2], base_), a3_ = __builtin_fmaf(sgn_, cst[(E0) + (B) + 3], base_); asm volatile("" : "+v"(a0_), "+v"(a1_), "+v"(a2_), "+v"(a3_)); X[B] = a0_; X[(B) + 1] = a1_; X[(B) + 2] = a2_; X[(B) + 3] = a3_; } \
        if (__builtin_expect(!fastb_, 0)) { float dg_ = dcn_ + (float)(8 * (((E0) + (B)) >> 2)); BIAS_GEN4(X, B, dg_); } PIN(X); } SBAR(); } while (0)
#else
#define GAPC(MF, G, X, B, E0) do { MF; if (G) { BIAS_FAST4(X, B, dcn_); if (__builtin_expect(!fastb_, 0)) { float dg_ = dcn_ - 8.0f; BIAS_GEN4(X, B, dg_); } PIN(X); } SBAR(); } while (0)
#endif
#define VRD(i) do { if (!(BPROBE & 4)) vf[i] = *(const ALAS bf16x8*)(vp_ + ((i) & 3) * (DV * 32) + ((i) >> 2) * 512); } while (0)
#define VRDN(i, d) do { if (!(BPROBE & 4)) vf[i] = *(const ALAS bf16x8*)(vp_ + (i) * (DV * 32) + (d) * 512); } while (0)
#define VRDX(slot, ks, d) do { if (!(BPROBE & 4)) vf[slot] = *(const ALAS bf16x8*)(vp_ + (ks) * (DV * 32) + (d) * 512); } while (0)
#define VRDA(i) do { vf[i] = *(const ALAS bf16x8*)(vp_ + (i) * (DV * 32) + 512); } while (0)
#define VRD2(i) do { vf[i] = *(const ALAS bf16x8*)(vp_ + ((i) & 3) * (DV * 32) + (((i) >> 2) + 2) * 512); } while (0)
#define KRD(G, j) do { if (G) { KLOAD2(kn_, j); SBAR(); } } while (0)
#define KRD1(G, j) do { if ((G) && !(BPROBE & 4)) { kf[j] = *(const ALAS bf16x8*)(kn_ + ((j) >> 1) * 2048 + ((j) & 1) * 512); SBAR(); } } while (0)
#define CIN(C) (ISB ? C : negm)
#define STEP(C0, C1, P0, P1, i, GK, GV, GL) do { SBAR(); \
    const ALAS char* vp_ = vp0 + vs_prev; const ALAS char* kn_ = kp0 + ks_next; float dcn_ = dl0 + 64.f * (float)((i) + 1); const int kt_ = 64 * (t0 + (i) + 1); const bool above_ = kt_ > qw_hi, fastb_ = above_ || (kt_ + 63 < qw_lo); \
    const float sc1_ = above_ ? nc2 : c2, sc2_ = sc1_ + sc1_, sc3_ = sc2_ + sc1_; BIAS_STEP_SETUP(); \
    VRD(0); SBAR(); float sacc = P0[0] + P0[1]; \
    GAPA(C0 = ATT_MFMA(kf[0], qr[0], CIN(C0)), P0[2], P0[3], P0[4], P0[5],     pw0[0] = PKW(P0, 0), pw0[1] = PKW(P0, 2), pw0); \
    if (B_VF8) { VRDX(4, 0, 1); } SBAR(); GAPA(C1 = ATT_MFMA(kf[1], qr[0], CIN(C1)), P0[6], P0[7], P0[8], P0[9],     pw0[2] = PKW(P0, 4), pw0[3] = PKW(P0, 6), pw0); \
    VRD(1); SBAR(); GAPA(C0 = ATT_MFMA(kf[2], qr[1], C0),   P0[10], P0[11], P0[12], P0[13], pw1[0] = PKW(P0, 8), pw1[1] = PKW(P0, 10), pw1); \
    if (B_VF8) { VRDX(5, 1, 1); } SBAR(); GAPA(C1 = ATT_MFMA(kf[3], qr[1], C1),   P0[14], P0[15], P1[0], P1[1],   pw1[2] = PKW(P0, 12), pw1[3] = PKW(P0, 14), pw1); \
    VRD(2); SBAR(); GAPA(C0 = ATT_MFMA(kf[4], qr[2], C0),   P1[2], P1[3], P1[4], P1[5],     pw2[0] = PKW(P1, 0), pw2[1] = PKW(P1, 2), pw2); \
    if (B_VF8) { VRDX(6, 2, 1); } SBAR(); GAPA(C1 = ATT_MFMA(kf[5], qr[2], C1),   P1[6], P1[7], P1[8], P1[9],     pw2[2] = PKW(P1, 4), pw2[3] = PKW(P1, 6), pw2); \
    VRD(3); SBAR(); GAPA(C0 = ATT_MFMA(kf[6], qr[3], C0),   P1[10], P1[11], P1[12], P1[13], pw3[0] = PKW(P1, 8), pw3[1] = PKW(P1, 10), pw3); \
    if (B_VF8) { VRDX(7, 3, 1); } SBAR(); GAPA(C1 = ATT_MFMA(kf[7], qr[3], C1),   P1[14], P1[15], 0.f, 0.f,       pw3[2] = PKW(P1, 12), pw3[3] = PKW(P1, 14), pw3); \
    l_reg += sacc; \
    if (!(BPROBE & 2)) { if (BDMA_MODE < 4) { if (GK) { DMA_K((i) + 3, ks_cur); } } if (BDMA_MODE == 0 || BDMA_MODE == 4) { if (GV) { DMA_V((i) + 2, vs_n2); } } } \
    SBAR(); \
    if (!ISB) { \
        GAPX(o[0] = ATT_MFMA(PAF(0), vf[0], o[0]), C0[0] = EX(C0[0]); C0[1] = EX(C0[1]); C0[2] = EX(C0[2]), C0); \
        VRDA(0); SBAR(); GAPX(o[0] = ATT_MFMA(PAF(1), vf[1], o[0]), C0[3] = EX(C0[3]); C0[4] = EX(C0[4]); C0[5] = EX(C0[5]), C0); \
        VRDA(1); SBAR(); GAPX(osum = ATT_MFMA(PAF(0), ones, osum),  C0[6] = EX(C0[6]); C0[7] = EX(C0[7]); C0[8] = EX(C0[8]), C0); \
        GAPX(o[0] = ATT_MFMA(PAF(2), vf[2], o[0]), C0[9] = EX(C0[9]); C0[10] = EX(C0[10]); C0[11] = EX(C0[11]), C0); \
        VRDA(2); SBAR(); GAPX(o[0] = ATT_MFMA(PAF(3), vf[3], o[0]), C0[12] = EX(C0[12]); C0[13] = EX(C0[13]); C0[14] = EX(C0[14]), C0); \
        VRDA(3); SBAR(); GAPX(osum = ATT_MFMA(PAF(1), ones, osum),  C0[15] = EX(C0[15]); C1[0] = EX(C1[0]); C1[1] = EX(C1[1]), C1); PIN(C0); \
        KRD(GL, 0); GAPX(o[1] = ATT_MFMA(PAF(0), vf[0], o[1]), C1[2] = EX(C1[2]); C1[3] = EX(C1[3]); C1[4] = EX(C1[4]), C1); \
        KRD(GL, 1); GAPX(o[1] = ATT_MFMA(PAF(1), vf[1], o[1]), C1[5] = EX(C1[5]); C1[6] = EX(C1[6]); C1[7] = EX(C1[7]), C1); \
        KRD(GL, 2); GAPX(osum = ATT_MFMA(PAF(2), ones, osum),  C1[8] = EX(C1[8]); C1[9] = EX(C1[9]); C1[10] = EX(C1[10]), C1); \
        KRD(GL, 3); GAPX(o[1] = ATT_MFMA(PAF(2), vf[2], o[1]), C1[11] = EX(C1[11]); C1[12] = EX(C1[12]), C1); \
        GAPX(o[1] = ATT_MFMA(PAF(3), vf[3], o[1]), C1[13] = EX(C1[13]); C1[14] = EX(C1[14]), C1); \
        GAPX(osum = ATT_MFMA(PAF(3), ones, osum),  C1[15] = EX(C1[15]), C1); \
    } else { \
        GAPEN(o[0] = ATT_MFMA(PAF(0), vf[0], o[0]), C0, C1, 0, 3);  VRDN(0, B_VF8 ? 2 : 1); KRD1(GL, 0); SBAR(); \
        GAPEN(o[0] = ATT_MFMA(PAF(1), vf[1], o[0]), C0, C1, 3, 2);  VRDN(1, B_VF8 ? 2 : 1); KRD1(GL, 1); SBAR(); \
        GAPEN(o[0] = ATT_MFMA(PAF(2), vf[2], o[0]), C0, C1, 5, 3);  VRDN(2, B_VF8 ? 2 : 1); KRD1(GL, 2); SBAR(); \
        GAPEN(o[0] = ATT_MFMA(PAF(3), vf[3], o[0]), C0, C1, 8, 2);  VRDN(3, B_VF8 ? 2 : 1); KRD1(GL, 3); SBAR(); \
        if (BDMA_MODE == 2) { if (GV) { DMA_V((i) + 2, vs_n2); } SBAR(); } \
        GAPEN(o[1] = ATT_MFMA(PAF(0), vf[B_VF8 ? 4 : 0], o[1]), C0, C1, 10, 3); if (B_VF8) { VRDX(4, 0, 3); } else { VRDN(0, 2); } KRD1(GL, 4); SBAR(); \
        GAPEN(o[1] = ATT_MFMA(PAF(1), vf[B_VF8 ? 5 : 1], o[1]), C0, C1, 13, 2); if (B_VF8) { VRDX(5, 1, 3); } else { VRDN(1, 2); } KRD1(GL, 5); SBAR(); \
        GAPEN(o[1] = ATT_MFMA(PAF(2), vf[B_VF8 ? 6 : 2], o[1]), C0, C1, 15, 3); if (B_VF8) { VRDX(6, 2, 3); } else { VRDN(2, 2); } KRD1(GL, 6); SBAR(); \
        GAPEN(o[1] = ATT_MFMA(PAF(3), vf[B_VF8 ? 7 : 3], o[1]), C0, C1, 18, 2); if (B_VF8) { VRDX(7, 3, 3); } else { VRDN(3, 2); } KRD1(GL, 7); SBAR(); \
        if (BDMA_MODE == 1 || BDMA_MODE == 5) { if (GV) { DMA_V((i) + 2, vs_n2); } SBAR(); } if (BDMA_MODE == 4 || BDMA_MODE == 5) { if (GK) { DMA_K((i) + 3, ks_cur); } SBAR(); } \
        GAPC(o[ND0 - 2] = ATT_MFMA(PAF(0), vf[0], o[ND0 - 2]); EXN(C0, C1, 20, 2), GL, P0, 0, 0);  if (!B_VF8) { VRDN(0, 3); } SBAR(); \
        GAPC(o[ND0 - 2] = ATT_MFMA(PAF(1), vf[1], o[ND0 - 2]); EXN(C0, C1, 22, 1), GL, P0, 4, 0);  if (!B_VF8) { VRDN(1, 3); } SBAR(); \
        GAPC(o[ND0 - 2] = ATT_MFMA(PAF(2), vf[2], o[ND0 - 2]); EXN(C0, C1, 23, 2), GL, P0, 8, 0);  if (!B_VF8) { VRDN(2, 3); } SBAR(); \
        GAPC(o[ND0 - 2] = ATT_MFMA(PAF(3), vf[3], o[ND0 - 2]); EXN(C0, C1, 25, 1), GL, P0, 12, 0); if (!B_VF8) { VRDN(3, 3); } SBAR(); \
        GAPC(o[ND0 - 1] = ATT_MFMA(PAF(0), vf[B_VF8 ? 4 : 0], o[ND0 - 1]); EXN(C0, C1, 26, 2), GL, P1, 0, 16); \
        GAPC(o[ND0 - 1] = ATT_MFMA(PAF(1), vf[B_VF8 ? 5 : 1], o[ND0 - 1]); EXN(C0, C1, 28, 1), GL, P1, 4, 16); \
        GAPC(o[ND0 - 1] = ATT_MFMA(PAF(2), vf[B_VF8 ? 6 : 2], o[ND0 - 1]); EXN(C0, C1, 29, 2), GL, P1, 8, 16); \
        GAPC(o[ND0 - 1] = ATT_MFMA(PAF(3), vf[B_VF8 ? 7 : 3], o[ND0 - 1]); EXN(C0, C1, 31, 1); PIN(C1), GL, P1, 12, 16); \
        if (BDMA_MODE == 3) { if (GV) { DMA_V((i) + 2, vs_n2); } SBAR(); } \
    } } while (0)
    int i = 1;
    for (; i + 5 < n; i += 2) {
        STEP(pB0, pB1, pA0, pA1, i, true, true, true);     if (!(BPROBE & 16)) { if (BPROBE & 2) { WB_SEL(0); } else { WB_SEL(NK + 2 * NV); } } ROT();
        STEP(pA0, pA1, pB0, pB1, i + 1, true, true, true); if (!(BPROBE & 16)) { if (BPROBE & 2) { WB_SEL(0); } else { WB_SEL(NK + 2 * NV); } } ROT();
    }
#define ENDW(ii) do { if ((ii) + 3 < n) { WB_SEL(NK + 2 * NV); } else if ((ii) + 2 < n) { WB_SEL(2 * NV); } else { WB_SEL(0); } } while (0)
    for (; i + 1 < n; i += 2) {
        STEP(pB0, pB1, pA0, pA1, i, (i + 3 < n), (i + 2 < n), (i + 1 < n));         ENDW(i);     ROT();
        STEP(pA0, pA1, pB0, pB1, i + 1, (i + 4 < n), (i + 3 < n), (i + 2 < n));     ENDW(i + 1); ROT();
    }
    STEP(pB0, pB1, pA0, pA1, n - 1, false, false, false);
    { if (ISB) { float sacc = pB0[0] + pB0[1];
#pragma unroll
      for (int r = 2; r < 16; ++r) sacc += pB0[r];
#pragma unroll
      for (int r = 0; r < 16; ++r) sacc += pB1[r];
      l_reg += sacc; }
      pw0 = (u32x4){PKW(pB0, 0), PKW(pB0, 2), PKW(pB0, 4), PKW(pB0, 6)}; pw1 = (u32x4){PKW(pB0, 8), PKW(pB0, 10), PKW(pB0, 12), PKW(pB0, 14)};
      pw2 = (u32x4){PKW(pB1, 0), PKW(pB1, 2), PKW(pB1, 4), PKW(pB1, 6)}; pw3 = (u32x4){PKW(pB1, 8), PKW(pB1, 10), PKW(pB1, 12), PKW(pB1, 14)};
      SBAR();
      const ALAS char* vp_ = vp0 + vs_cur;
#pragma unroll
      for (int d = 0; d < ND0; ++d) {
          const bf16x8 v0 = *(const ALAS bf16x8*)(vp_ + 0 * (DV * 32) + d * 512), v1 = *(const ALAS bf16x8*)(vp_ + 1 * (DV * 32) + d * 512), v2 = *(const ALAS bf16x8*)(vp_ + 2 * (DV * 32) + d * 512), v3 = *(const ALAS bf16x8*)(vp_ + 3 * (DV * 32) + d * 512);
          o[d] = ATT_MFMA(PAF(0), v0, o[d]); o[d] = ATT_MFMA(PAF(1), v1, o[d]); o[d] = ATT_MFMA(PAF(2), v2, o[d]); o[d] = ATT_MFMA(PAF(3), v3, o[d]); }
      if (!ISB) { osum = ATT_MFMA(PAF(0), ones, osum); osum = ATT_MFMA(PAF(1), ones, osum); osum = ATT_MFMA(PAF(2), ones, osum); osum = ATT_MFMA(PAF(3), ones, osum); } }
    const float sacc = l_reg;
    const int lane_e = lane_id_v();
    ATT_WAIT_BAR(0);
    {
    const int lane = lane_e, r32 = lane & 31, hi = lane >> 5; const int q0 = ISB ? qb * 128 : qb * 256;
    float rli[16];
    ALAS float* wsf = (ALAS float*)(shm3 + WSF_OFF) + wid * 64;
    if (ISB) {
        const float l = sum_x32(sacc);
        if (hi == 0) wsf[r32] = l;
        asm volatile("s_waitcnt lgkmcnt(0)" ::: "memory");
#pragma unroll
        for (int r = 0; r < 16; ++r) rli[r] = __builtin_amdgcn_rcpf(wsf[crow(r, hi)]);
    } else {
#pragma unroll
        for (int r = 0; r < 16; ++r) rli[r] = __builtin_amdgcn_rcpf(osum[r]);
    }
    if (!ISB) {
        ALAS bf16_t* stg = (ALAS bf16_t*)shm3 + wid * 2048;
#pragma unroll
        for (int r = 0; r < 16; ++r) { const int orow = crow(r, hi);
#pragma unroll
            for (int d = 0; d < ND0; ++d) stg[orow * 64 + d * 32 + r32] = pg8::f2bf1(o[d][r] * rli[r]); }
        asm volatile("s_waitcnt lgkmcnt(0)" ::: "memory");
#pragma unroll
        for (int i = 0; i < 4; ++i) { const int row = i * 8 + (lane >> 3), ch = lane & 7; const u32x4 v = *(const ALAS u32x4*)(stg + row * 64 + ch * 8);
            *(u32x4*)(T_MIX + (size_t)(q0 + wid * 32 + row) * 1024 + head * 64 + ch * 8) = v; }
    } else {
        ALAS float* X = (ALAS float*)shm3 + wq * 4096;
        const float sc = (mapc == 1) ? lam : 1.0f;
        if (mapc == 1) {
#pragma unroll
            for (int r = 0; r < 16; ++r) { const int orow = crow(r, hi); const float f = rli[r] * sc;
#pragma unroll
                for (int d = 0; d < ND0; ++d) X[orow * 128 + d * 32 + r32] = o[d][r] * f; }
        }
        asm volatile("s_waitcnt lgkmcnt(0)\n\ts_barrier" ::: "memory");
        if (mapc == 0) {
#pragma unroll
            for (int r = 0; r < 16; ++r) { const int orow = crow(r, hi);
#pragma unroll
                for (int d = 0; d < ND0; ++d) { const int idx = orow * 128 + d * 32 + r32; X[idx] = o[d][r] * rli[r] - X[idx]; } }
            asm volatile("s_waitcnt lgkmcnt(0)" ::: "memory");
            const int qq = lane >> 1, hf = lane & 1;
            const ALAS float* rowp = X + qq * 128 + hf * 64;
            f32x4 vv[16]; float ss = 0.f;
#pragma unroll
            for (int i = 0; i < 16; ++i) { vv[i] = *(const ALAS f32x4*)(rowp + 4 * i); ss += (vv[i][0] * vv[i][0] + vv[i][1] * vv[i][1]) + (vv[i][2] * vv[i][2] + vv[i][3] * vv[i][3]); }
            ss += xor_lane<1>(ss);
            const float rs = 0.8f / sqrtf(ss * (1.0f / 128.0f) + 1e-6f);
            bf16_t* dst = T_MIX + (size_t)(q0 + wq * 32 + qq) * 1024 + 512 + head * 128 + hf * 64;
            const ALAS float* sl = T.subln + hf * 64;
#pragma unroll
            for (int i = 0; i < 8; ++i) { const f32x4 g0 = *(const ALAS f32x4*)(sl + 8 * i), g1 = *(const ALAS f32x4*)(sl + 8 * i + 4); const f32x4 a = vv[2 * i] * rs * g0, b = vv[2 * i + 1] * rs * g1;
                u32x4 w; w.x = cvtpk(a[0], a[1]); w.y = cvtpk(a[2], a[3]); w.z = cvtpk(b[0], b[1]); w.w = cvtpk(b[2], b[3]); *(u32x4*)(dst + 8 * i) = w; }
        }
    }
    }
    asm volatile("s_waitcnt lgkmcnt(0)\n\ts_barrier" ::: "memory");
#undef DMA_K
#undef DMA_V
#undef ROT
#undef STEP
#undef ENDW
#undef GAPA
#undef GAPB
#undef GAPC
#undef GAPE3
#undef GAPEN
#undef EXN
#undef EXE
#undef GAPX
#undef VRD
#undef VRD2
#undef VRDA
#undef VRDN
#undef KRD
#undef KRD1
#undef CIN
#undef PAF
#undef KLOAD2
#undef BIAS_GEN4
#undef BIAS_FAST4
#undef BIAS_ALL
#undef BIAS_STEP_SETUP
}

typedef int i32x8 __attribute__((ext_vector_type(8)));
typedef unsigned u32x8 __attribute__((ext_vector_type(8)));
#define MFMA8(a, b, c) __builtin_amdgcn_mfma_scale_f32_32x32x64_f8f6f4(a, b, c, 0, 0, 0, 0, 0, 0)
__device__ __forceinline__ void attn_unit_a8(const Tensors& T, int head, int qb, float negM2s, char* shm, int wave_id) {
    unsigned char* tws_ = T.ws; LAUNDER_G(tws_);
    constexpr int KSLOT = 4096, VSLOT = 4096, LDS_K = 0, LDS_V = 3 * KSLOT, n = 256;
    int tid_ = wave_id * 64 + lane_id_v(); asm volatile("" : "+v"(tid_));
    const int tid = tid_, lane = tid & 63, r32 = lane & 31, hi = lane >> 5; const int wid = __builtin_amdgcn_readfirstlane(tid >> 6);
    const int q0 = qb * 256; const int qrow = q0 + wid * 32 + r32;
    const unsigned lds0 = (unsigned)(uintptr_t)shm;
    const ALAS char* shm3 = (const ALAS char*)shm;
    const bool kw = wid < 4;
    const char* sb = (const char*)(tws_ + (kw ? WS_KA : WS_VA)) + (size_t)(head >> 2) * MROWS * 64 + (wid & 3) * 1024;
    const unsigned dvo = (unsigned)(lane * 16);
    const unsigned ddst = lds0 + (kw ? LDS_K : LDS_V) + (wid & 3) * 1024;
#define DMA8(i, so) glds16s(sb + (size_t)(i) * 4096, dvo, (unsigned)__builtin_amdgcn_readfirstlane(ddst + (so)))
#define WB8(NKW, NVW) do { if (kw) { WB_SEL(NKW); } else { WB_SEL(NVW); } } while (0)
    if (kw) { DMA8(0, 0); DMA8(1, KSLOT); DMA8(2, 2 * KSLOT); } else { DMA8(0, 0); DMA8(1, VSLOT); }
    const unsigned char* Qw = (tws_ + WS_QA) + ((size_t)head * MROWS + qrow) * 64 + hi * 32;
    i32x8 qf; { const u32x4 a_ = *(const u32x4*)Qw, b_ = *(const u32x4*)(Qw + 16); qf = (i32x8){(int)a_[0], (int)a_[1], (int)a_[2], (int)a_[3], (int)b_[0], (int)b_[1], (int)b_[2], (int)b_[3]}; }
    f32x16 o0 = f32x16{}, o1 = f32x16{}, osum = f32x16{};
    f32x16 negm;
#pragma unroll
    for (int r = 0; r < 16; ++r) negm[r] = negM2s;
    asm volatile("" : "+v"(negm));
    i32x8 ones; { const int o4 = 0x38383838; ones = (i32x8){o4, o4, o4, o4, o4, o4, o4, o4}; } asm volatile("" : "+v"(ones));
    const ALAS char* kp0 = shm3 + LDS_K + hi * 1024 + r32 * 16;
    const ALAS char* vp0 = shm3 + LDS_V + hi * 1024 + r32 * 16;
    f32x16 pA0, pA1, pB0, pB1;
    i32x8 kf0, kf1, vf0, vf1, pf = (i32x8){0, 0, 0, 0, 0, 0, 0, 0};
    int ks_prev = 0, ks_cur = 0, ks_next = KSLOT, vs_prev = 0, vs_cur = VSLOT, vs_next = 2 * VSLOT, vs_n2 = 3 * VSLOT;
#define ROTK8() do { ks_prev = ks_cur; ks_cur = ks_next; ks_next = (ks_next == 2 * KSLOT) ? 0 : ks_next + KSLOT; } while (0)
#define ROT8() do { ROTK8(); const int tv_ = vs_prev; vs_prev = vs_cur; vs_cur = vs_next; vs_next = vs_n2; vs_n2 = tv_; } while (0)
#define LD32(dst, p) do { const u32x4 a_ = *(const ALAS u32x4*)(p), b_ = *(const ALAS u32x4*)((p) + 512); dst = (i32x8){(int)a_[0], (int)a_[1], (int)a_[2], (int)a_[3], (int)b_[0], (int)b_[1], (int)b_[2], (int)b_[3]}; } while (0)
#define PK8(P, B, OLD) __builtin_amdgcn_cvt_pk_fp8_f32(P[(B) + 2], P[(B) + 3], __builtin_amdgcn_cvt_pk_fp8_f32(P[B], P[(B) + 1], OLD, false), true)
    WB8(2, 2);
    { LD32(kf0, kp0); LD32(kf1, kp0 + 2048);
      pA0 = MFMA8(kf0, qf, negm); pA1 = MFMA8(kf1, qf, negm);
#pragma unroll
      for (int r = 0; r < 16; ++r) { pA0[r] = EX(pA0[r]); pA1[r] = EX(pA1[r]); } }
    WB_SEL(0);
    if (kw) { DMA8(3, 0); } else { DMA8(2, 2 * VSLOT); }
    ROTK8();
    { const ALAS char* kb_ = kp0 + ks_cur; LD32(kf0, kb_); LD32(kf1, kb_ + 2048); }
    WB_SEL(1);
#define STEP8(C0, C1, P0, P1, i, GK, GV, GL) do { SBAR(); \
    const ALAS char* vp_ = vp0 + vs_prev; const ALAS char* kn_ = kp0 + ks_next; \
    LD32(vf0, vp_); LD32(vf1, vp_ + 2048); SBAR(); \
    C0 = MFMA8(kf0, qf, negm); \
    pf[0] = PK8(P0, 0, pf[0]); pf[1] = PK8(P0, 4, pf[1]); pf[2] = PK8(P0, 8, pf[2]); pf[3] = PK8(P0, 12, pf[3]); PIN(pf); SBAR(); \
    C1 = MFMA8(kf1, qf, negm); \
    pf[4] = PK8(P1, 0, pf[4]); pf[5] = PK8(P1, 4, pf[5]); pf[6] = PK8(P1, 8, pf[6]); pf[7] = PK8(P1, 12, pf[7]); PIN(pf); SBAR(); \
    if (kw) { if (GK) { DMA8((i) + 3, ks_cur); } } else { if (GV) { DMA8((i) + 2, vs_n2); } } \
    SBAR(); \
    o0 = MFMA8(pf, vf0, o0); \
    _Pragma("unroll") for (int r_ = 0; r_ < 16; ++r_) C0[r_] = EX(C0[r_]); PIN(C0); SBAR(); \
    if (GL) { LD32(kf0, kn_); LD32(kf1, kn_ + 2048); SBAR(); } \
    o1 = MFMA8(pf, vf1, o1); \
    _Pragma("unroll") for (int r_ = 0; r_ < 8; ++r_) C1[r_] = EX(C1[r_]); PIN(C1); SBAR(); \
    osum = MFMA8(pf, ones, osum); \
    _Pragma("unroll") for (int r_ = 8; r_ < 16; ++r_) C1[r_] = EX(C1[r_]); PIN(C1); SBAR(); \
    } while (0)
    int i = 1;
    for (; i + 5 < n; i += 2) {
        STEP8(pB0, pB1, pA0, pA1, i, true, true, true);     WB8(1, 2); ROT8();
        STEP8(pA0, pA1, pB0, pB1, i + 1, true, true, true); WB8(1, 2); ROT8();
    }
#define ENDW8(ii) do { if ((ii) + 3 < n) { WB8(1, 2); } else if ((ii) + 2 < n) { WB8(0, 2); } else { WB_SEL(0); } } while (0)
    for (; i + 1 < n; i += 2) {
        STEP8(pB0, pB1, pA0, pA1, i, (i + 3 < n), (i + 2 < n), (i + 1 < n));         ENDW8(i);     ROT8();
        STEP8(pA0, pA1, pB0, pB1, i + 1, (i + 4 < n), (i + 3 < n), (i + 2 < n));     ENDW8(i + 1); ROT8();
    }
    STEP8(pB0, pB1, pA0, pA1, n - 1, false, false, false);
    { pf[0] = PK8(pB0, 0, pf[0]); pf[1] = PK8(pB0, 4, pf[1]); pf[2] = PK8(pB0, 8, pf[2]); pf[3] = PK8(pB0, 12, pf[3]); pf[4] = PK8(pB1, 0, pf[4]); pf[5] = PK8(pB1, 4, pf[5]); pf[6] = PK8(pB1, 8, pf[6]); pf[7] = PK8(pB1, 12, pf[7]);
      const ALAS char* vp_ = vp0 + vs_cur; LD32(vf0, vp_); LD32(vf1, vp_ + 2048);
      o0 = MFMA8(pf, vf0, o0); o1 = MFMA8(pf, vf1, o1); osum = MFMA8(pf, ones, osum); }
    ATT_WAIT_BAR(0);
    {
        const int lane_e = lane_id_v(), l32 = lane_e & 31, hh = lane_e >> 5;
        ALAS bf16_t* stg = (ALAS bf16_t*)shm3 + wid * 2048;
#pragma unroll
        for (int r = 0; r < 16; ++r) { const int orow = crow(r, hh); const float rl = __builtin_amdgcn_rcpf(osum[r]);
            stg[orow * 64 + l32] = pg8::f2bf1(o0[r] * rl); stg[orow * 64 + 32 + l32] = pg8::f2bf1(o1[r] * rl); }
        asm volatile("s_waitcnt lgkmcnt(0)" ::: "memory");
#pragma unroll
        for (int i2 = 0; i2 < 4; ++i2) { const int row = i2 * 8 + (lane_e >> 3), ch = lane_e & 7; const u32x4 v = *(const ALAS u32x4*)(stg + row * 64 + ch * 8);
            *(u32x4*)(T_MIX + (size_t)(qb * 256 + wid * 32 + row) * 1024 + head * 64 + ch * 8) = v; }
    }
    asm volatile("s_waitcnt lgkmcnt(0)\n\ts_barrier" ::: "memory");
#undef DMA8
#undef EXPR
#undef PACKH0
#undef PACKH1
#undef ROWSUM_A
#undef ROWSUM_B
#undef EXPBLK
#undef PACK8
#undef WB8
#undef ROTK8
#undef ROT8
#undef LD32
#undef PK8
#undef STEP8
#undef ENDW8
}

typedef short v2i16_t __attribute__((ext_vector_type(2)));
template<int U, int PROBE = 0>
__device__ __forceinline__ void attn_unit_a8x2(const Tensors& T, int head, int qb, float negM2s, char* shm, int wave_id) {
    unsigned char* tws_ = T.ws; LAUNDER_G(tws_);
    constexpr int KSLOT = 4096, VSLOT = 4096, DD = (U >= 8) ? U + 2 : U + U, RS = (U + DD) * 4096, LDS_K = 0, LDS_V = RS, n = 256;
    int tid_ = wave_id * 64 + lane_id_v(); asm volatile("" : "+v"(tid_));
    const int tid = tid_, lane = tid & 63, r32 = lane & 31, hi = lane >> 5; const int wid = __builtin_amdgcn_readfirstlane(tid >> 6);
    const int q0 = qb * 512; const int qrow = q0 + wid * 64 + r32;
    const unsigned lds0 = (unsigned)(uintptr_t)shm;
    const ALAS char* shm3 = (const ALAS char*)shm;
    const bool kw = wid < 4;
    const char* sb = (const char*)(tws_ + (kw ? WS_KA : WS_VA)) + (size_t)(head >> 2) * MROWS * 64 + (wid & 3) * 1024;
    const unsigned dvo = (unsigned)(lane * 16);
    const unsigned ddst = lds0 + (kw ? LDS_K : LDS_V) + (wid & 3) * 1024;
#define DMA8(i, so) glds16s(sb + (size_t)(i) * 4096, dvo, (unsigned)__builtin_amdgcn_readfirstlane(ddst + (so)))
#pragma unroll
    for (int i0 = 0; i0 < DD; ++i0) DMA8(i0, i0 * 4096);
    if (kw) DMA8(DD, DD * 4096);
    const unsigned char* Qw = (tws_ + WS_QA) + ((size_t)head * MROWS + qrow) * 64 + hi * 32;
    i32x8 qfa, qfb;
    { const u32x4 a_ = *(const u32x4*)Qw, b_ = *(const u32x4*)(Qw + 16); qfa = (i32x8){(int)a_[0], (int)a_[1], (int)a_[2], (int)a_[3], (int)b_[0], (int)b_[1], (int)b_[2], (int)b_[3]}; }
    { const u32x4 a_ = *(const u32x4*)(Qw + 32 * 64), b_ = *(const u32x4*)(Qw + 32 * 64 + 16); qfb = (i32x8){(int)a_[0], (int)a_[1], (int)a_[2], (int)a_[3], (int)b_[0], (int)b_[1], (int)b_[2], (int)b_[3]}; }
#if A8_SUM16
    f32x16 oa0 = f32x16{}, oa1 = f32x16{}, ob0 = f32x16{}, ob1 = f32x16{};
    f32x4 sa4 = f32x4{}, sb4 = f32x4{};
#if A8_SUM16 == 2
    f32x16 osa = f32x16{};
#endif
#else
    f32x16 oa0 = f32x16{}, oa1 = f32x16{}, osa = f32x16{}, ob0 = f32x16{}, ob1 = f32x16{}, osb = f32x16{};
#endif
#if A8_SUM16 == 2
    const f32x16 negm = f32x16{};
#else
    f32x16 negm;
#pragma unroll
    for (int r = 0; r < 16; ++r) negm[r] = negM2s;
    asm volatile("" : "+v"(negm));
#endif
#if A8_SUM16
    i32x8 ind; { const int o4 = (((lane >> 4) & 1) == ((lane & 15) >> 3)) ? 0x38383838 : 0; ind = (i32x8){o4, o4, o4, o4, o4, o4, o4, o4}; } asm volatile("" : "+v"(ind));
#if A8_SUM16 == 2
    i32x8 ones; { const int o4 = 0x38383838; ones = (i32x8){o4, o4, o4, o4, o4, o4, o4, o4}; } asm volatile("" : "+v"(ones));
#endif
#else
    i32x8 ones; { const int o4 = 0x38383838; ones = (i32x8){o4, o4, o4, o4, o4, o4, o4, o4}; } asm volatile("" : "+v"(ones));
#endif
    const ALAS char* kp0 = shm3 + LDS_K + hi * 1024 + r32 * 16;
    const ALAS char* vp0 = shm3 + LDS_V + hi * 1024 + r32 * 16;
    f32x16 Ca0, Ca1, Cb0, Cb1;
#ifdef A8_EXPH
#define EXPBLK(H, C, b) do { const unsigned h0_ = __builtin_bit_cast(unsigned, __builtin_amdgcn_cvt_pkrtz(C[b], C[(b) + 1])), h1_ = __builtin_bit_cast(unsigned, __builtin_amdgcn_cvt_pkrtz(C[(b) + 2], C[(b) + 3])), \
        h2_ = __builtin_bit_cast(unsigned, __builtin_amdgcn_cvt_pkrtz(C[(b) + 4], C[(b) + 5])), h3_ = __builtin_bit_cast(unsigned, __builtin_amdgcn_cvt_pkrtz(C[(b) + 6], C[(b) + 7])); unsigned d0_, d1_, d2_, d3_; \
        asm volatile("v_exp_f16_e32 %0, %4\n\tv_exp_f16_e32 %1, %5\n\tv_exp_f16_e32 %2, %6\n\tv_exp_f16_e32 %3, %7\n\t" \
                     "v_exp_f16_sdwa %0, %4 dst_sel:WORD_1 dst_unused:UNUSED_PRESERVE src0_sel:WORD_1\n\tv_exp_f16_sdwa %1, %5 dst_sel:WORD_1 dst_unused:UNUSED_PRESERVE src0_sel:WORD_1\n\t" \
                     "v_exp_f16_sdwa %2, %6 dst_sel:WORD_1 dst_unused:UNUSED_PRESERVE src0_sel:WORD_1\n\tv_exp_f16_sdwa %3, %7 dst_sel:WORD_1 dst_unused:UNUSED_PRESERVE src0_sel:WORD_1" \
                     : "=&v"(d0_), "=&v"(d1_), "=&v"(d2_), "=&v"(d3_) : "v"(h0_), "v"(h1_), "v"(h2_), "v"(h3_)); \
        C[(b) / 2] = __builtin_bit_cast(float, d0_); C[(b) / 2 + 1] = __builtin_bit_cast(float, d1_); C[(b) / 2 + 2] = __builtin_bit_cast(float, d2_); C[(b) / 2 + 3] = __builtin_bit_cast(float, d3_); PIN(C); } while (0)
#define PKH(C, j) (int)__builtin_amdgcn_perm(__builtin_bit_cast(unsigned, C[2 * (j) + 1]), __builtin_bit_cast(unsigned, C[2 * (j)]), 0x07050301u)
#define PACK8(H0, H1, C0, C1) do { pf[0] = PKH(C0, 0); pf[1] = PKH(C0, 1); pf[2] = PKH(C0, 2); pf[3] = PKH(C0, 3); pf[4] = PKH(C1, 0); pf[5] = PKH(C1, 1); pf[6] = PKH(C1, 2); pf[7] = PKH(C1, 3); PIN(pf); } while (0)
#else
#define EXPBLK(H, C, b) do { _Pragma("unroll") for (int r_ = (b); r_ < (b) + 8; ++r_) C[r_] = ((PROBE & 1) ? __builtin_fmaxf(C[r_], 1.0f) : EX(C[r_])); PIN(C); } while (0)
#define PACK8(H0, H1, C0, C1) do { pf[0] = PK8(C0, 0, pf[0]); pf[1] = PK8(C0, 4, pf[1]); pf[2] = PK8(C0, 8, pf[2]); pf[3] = PK8(C0, 12, pf[3]); pf[4] = PK8(C1, 0, pf[4]); pf[5] = PK8(C1, 4, pf[5]); pf[6] = PK8(C1, 8, pf[6]); pf[7] = PK8(C1, 12, pf[7]); PIN(pf); } while (0)
#endif
    i32x8 kf0, kf1, vf0, vf1, pf = (i32x8){0, 0, 0, 0, 0, 0, 0, 0};
#define LD32(dst, p) do { const u32x4 a_ = *(const ALAS u32x4*)(p), b_ = *(const ALAS u32x4*)((p) + 512); dst = (i32x8){(int)a_[0], (int)a_[1], (int)a_[2], (int)a_[3], (int)b_[0], (int)b_[1], (int)b_[2], (int)b_[3]}; } while (0)
#ifdef A8_BF8
#define PK8(P, B, OLD) (int)__builtin_amdgcn_perm(__builtin_bit_cast(unsigned, __builtin_amdgcn_cvt_pkrtz(P[(B) + 2], P[(B) + 3])), __builtin_bit_cast(unsigned, __builtin_amdgcn_cvt_pkrtz(P[B], P[(B) + 1])), 0x07050301u)
#define MFMA8P(a, b, c) __builtin_amdgcn_mfma_scale_f32_32x32x64_f8f6f4(a, b, c, 1, 0, 0, 0, 0, 0)
#define MFMA16P(a, b, c) __builtin_amdgcn_mfma_scale_f32_16x16x128_f8f6f4(a, b, c, 1, 0, 0, 0, 0, 0)
#elif defined(A8_SCALECVT)
#define MFMA8P(a, b, c) MFMA8(a, b, c)
#define MFMA16P(a, b, c) __builtin_amdgcn_mfma_scale_f32_16x16x128_f8f6f4(a, b, c, 0, 0, 0, 0, 0, 0)
#define PK8(P, B, OLD) __builtin_bit_cast(int, __builtin_amdgcn_cvt_scalef32_pk_fp8_f32(__builtin_amdgcn_cvt_scalef32_pk_fp8_f32(__builtin_bit_cast(v2i16_t, (int)(OLD)), P[B], P[(B) + 1], 1.0f, false), P[(B) + 2], P[(B) + 3], 1.0f, true))
#else
#define MFMA8P(a, b, c) MFMA8(a, b, c)
#define MFMA16P(a, b, c) __builtin_amdgcn_mfma_scale_f32_16x16x128_f8f6f4(a, b, c, 0, 0, 0, 0, 0, 0)
#define PK8(P, B, OLD) __builtin_amdgcn_cvt_pk_fp8_f32(P[(B) + 2], P[(B) + 3], __builtin_amdgcn_cvt_pk_fp8_f32(P[B], P[(B) + 1], OLD, false), true)
#endif
    if (kw) { WB_SEL(DD - U); } else { WB_SEL(DD - U); }
    { LD32(kf0, kp0); LD32(kf1, kp0 + 2048);
      Ca0 = MFMA8(kf0, qfa, negm); Ca1 = MFMA8(kf1, qfa, negm); Cb0 = MFMA8(kf0, qfb, negm); Cb1 = MFMA8(kf1, qfb, negm);
      EXPBLK(Ha0, Ca0, 0); EXPBLK(Ha0, Ca0, 8); EXPBLK(Ha1, Ca1, 0); EXPBLK(Ha1, Ca1, 8); }
#define EXPR(C, lo, hi) do { _Pragma("unroll") for (int r_ = (lo); r_ < (hi); ++r_) C[r_] = EX(C[r_]); PIN(C); } while (0)
#define P2E1 (A8_PIPE2 / 100)
#define P2E2 (A8_PIPE2 % 100)
#define EXPR2(C0, C1, lo, hi) do { _Pragma("unroll") for (int r_ = (lo); r_ < (hi); ++r_) { if (r_ < 16) C0[r_ & 15] = EX(C0[r_ & 15]); else C1[r_ & 15] = EX(C1[r_ & 15]); } PIN(C0); PIN(C1); } while (0)
#define PACKH0(C0) do { pf[0] = PK8(C0, 0, pf[0]); pf[1] = PK8(C0, 4, pf[1]); pf[2] = PK8(C0, 8, pf[2]); pf[3] = PK8(C0, 12, pf[3]); PIN(pf); } while (0)
#define PACKH1(C1) do { pf[4] = PK8(C1, 0, pf[4]); pf[5] = PK8(C1, 4, pf[5]); pf[6] = PK8(C1, 8, pf[6]); pf[7] = PK8(C1, 12, pf[7]); PIN(pf); } while (0)
#if A8_SUM16
#define ROWSUM_A() sa4 = MFMA16P(pf, ind, sa4)
#define ROWSUM_B() sb4 = MFMA16P(pf, ind, sb4)
#else
#define ROWSUM_A() osa = MFMA8P(pf, ones, osa)
#define ROWSUM_B() osb = MFMA8P(pf, ones, osb)
#endif
#if A8_PIPE2
    PACKH0(Ca0); PACKH1(Ca1);
#endif
    asm volatile("s_waitcnt lgkmcnt(0)\n\ts_barrier" ::: "memory");
    int ks = 0, vs = 0;
    const int dslot = A8_DMASTAG ? ((wid + (kw ? 0 : 2)) & 3) : 3;
#define ADV(x, k) (((x) + (k) * 4096 >= RS) ? (x) + (k) * 4096 - RS : (x) + (k) * 4096)
    for (int t0 = 0; t0 < n; t0 += U) {
#pragma unroll
      for (int j = 0; j < U; ++j) {
        const int t = t0 + j;
        const bool GK = t + 1 + DD < n, GV = t + DD < n, GL = t + 1 < n;
        const int ksn = ADV(ks, 1);
        SBAR();
#if A8_PIPE2
        if (!A8_VPREF || j == 0) { const ALAS char* vp_ = vp0 + vs; LD32(vf0, vp_); LD32(vf1, vp_ + 2048); }
        if (GL) { const ALAS char* kn_ = kp0 + ksn; LD32(kf0, kn_); LD32(kf1, kn_ + 2048); } SBAR();
#if A8_PIPE2 >= 2
        oa0 = MFMA8P(pf, vf0, oa0); EXPR2(Cb0, Cb1, 0, P2E1); SBAR();
        oa1 = MFMA8P(pf, vf1, oa1); EXPR2(Cb0, Cb1, P2E1, P2E1 + P2E2); SBAR();
        ROWSUM_A(); EXPR2(Cb0, Cb1, P2E1 + P2E2, 32); SBAR();
        if (GL) { Ca0 = MFMA8(kf0, qfa, negm); } PACKH0(Cb0); SBAR();
        if (GL) { Ca1 = MFMA8(kf1, qfa, negm); } PACKH1(Cb1);
        if (kw) { if (GK) { DMA8(t + 1 + DD, ADV(ks, DD + 1)); } } else { if (GV) { DMA8(t + DD, ADV(vs, DD)); } }
        SBAR();
        ob0 = MFMA8P(pf, vf0, ob0); if (GL) { EXPR2(Ca0, Ca1, 0, P2E1); } SBAR();
        ob1 = MFMA8P(pf, vf1, ob1); if (GL) { EXPR2(Ca0, Ca1, P2E1, P2E1 + P2E2); } SBAR();
        ROWSUM_B(); if (GL) { EXPR2(Ca0, Ca1, P2E1 + P2E2, 32); } SBAR();
        if (GL) { Cb0 = MFMA8(kf0, qfb, negm); PACKH0(Ca0); } SBAR();
        if (GL) { Cb1 = MFMA8(kf1, qfb, negm); PACKH1(Ca1); } SBAR();
#else
        oa0 = MFMA8P(pf, vf0, oa0); EXPR(Cb0, 0, 11); SBAR();
        if (A8_DMAPOS == 1) { { if (kw) { if (GK) { DMA8(t + 1 + DD, ADV(ks, DD + 1)); } } else { if (GV) { DMA8(t + DD, ADV(vs, DD)); } } } SBAR(); }
        oa1 = MFMA8P(pf, vf1, oa1); EXPR(Cb0, 11, 16); EXPR(Cb1, 0, 6); SBAR();
        ROWSUM_A(); EXPR(Cb1, 6, 16); SBAR();
        if (A8_DMAPOS == 2) { { if (kw) { if (GK) { DMA8(t + 1 + DD, ADV(ks, DD + 1)); } } else { if (GV) { DMA8(t + DD, ADV(vs, DD)); } } } SBAR(); }
        if (GL) { Ca0 = MFMA8(kf0, qfa, negm); } PACKH0(Cb0); SBAR();
        if (GL) { Ca1 = MFMA8(kf1, qfa, negm); } PACKH1(Cb1);
        if (A8_DMAPOS == 0) { { if (kw) { if (GK) { DMA8(t + 1 + DD, ADV(ks, DD + 1)); } } else { if (GV) { DMA8(t + DD, ADV(vs, DD)); } } } SBAR(); }
        SBAR();
        ob0 = MFMA8P(pf, vf0, ob0); if (GL) { EXPR(Ca0, 0, 11); } SBAR();
        ob1 = MFMA8P(pf, vf1, ob1); if (GL) { EXPR(Ca0, 11, 16); EXPR(Ca1, 0, 6); } SBAR();
        if (A8_VPREF && j < U - 1) { const ALAS char* vn_ = vp0 + ADV(vs, 1); LD32(vf0, vn_); LD32(vf1, vn_ + 2048); SBAR(); }
        ROWSUM_B(); if (GL) { EXPR(Ca1, 6, 16); } SBAR();
        if (A8_DMAPOS == 4) { { if (kw) { if (GK) { DMA8(t + 1 + DD, ADV(ks, DD + 1)); } } else { if (GV) { DMA8(t + DD, ADV(vs, DD)); } } } SBAR(); }
        if (GL) { Cb0 = MFMA8(kf0, qfb, negm); PACKH0(Ca0); } SBAR();
        if (GL) { Cb1 = MFMA8(kf1, qfb, negm); PACKH1(Ca1); } SBAR();
        if (A8_DMAPOS == 3) { { if (kw) { if (GK) { DMA8(t + 1 + DD, ADV(ks, DD + 1)); } } else { if (GV) { DMA8(t + DD, ADV(vs, DD)); } } } SBAR(); }
#endif
#else
        if (!(PROBE & 4)) if (!A8_VPREF || j == 0) { const ALAS char* vp_ = vp0 + vs; LD32(vf0, vp_); LD32(vf1, vp_ + 2048); }
        if (!(PROBE & 4)) if (GL) { const ALAS char* kn_ = kp0 + ksn; LD32(kf0, kn_); LD32(kf1, kn_ + 2048); } SBAR();
        if (!(PROBE & 8)) { PACK8(Ha0, Ha1, Ca0, Ca1); } SBAR();
#ifdef A8_EXPH_DUP
        {
#pragma unroll
          for (int r = 0; r < 16; ++r) { float x_ = Ca0[r], y_ = Ca1[r]; asm volatile("v_exp_f16_e32 %0, %0\n\tv_exp_f16_e32 %1, %1" : "+v"(x_), "+v"(y_)); Ca0[r] = x_; Ca1[r] = y_; }
          SBAR(); }
#endif
#ifdef A8_CVT_DUP
        { int d0_ = 0, d1_ = 0, d2_ = 0, d3_ = 0;
#pragma unroll
          for (int r = 0; r < 16; r += 4) { d0_ = PK8(Ca0, r, d0_); d1_ = PK8(Ca1, r, d1_); d2_ = PK8(Ca0, r, d2_); d3_ = PK8(Ca1, r, d3_); asm volatile("" : "+v"(d0_), "+v"(d1_), "+v"(d2_), "+v"(d3_)); }
          SBAR(); }
#endif
        if (!(PROBE & 32)) oa0 = MFMA8P(pf, vf0, oa0);
        EXPBLK(Hb0, Cb0, 0); SBAR();
        if (A8_DMASTAG && !(PROBE & 2) && dslot == 0) { { if (kw) { if (GK) { DMA8(t + 1 + DD, ADV(ks, DD + 1)); } } else { if (GV) { DMA8(t + DD, ADV(vs, DD)); } } } SBAR(); }
        if (!(PROBE & 32)) oa1 = MFMA8P(pf, vf1, oa1);
        EXPBLK(Hb0, Cb0, 8); SBAR();
        if (A8_DMASTAG && !(PROBE & 2) && dslot == 1) { { if (kw) { if (GK) { DMA8(t + 1 + DD, ADV(ks, DD + 1)); } } else { if (GV) { DMA8(t + DD, ADV(vs, DD)); } } } SBAR(); }
#if A8_SUM16
        if (!(PROBE & 32)) sa4 = MFMA16P(pf, ind, sa4);
#if A8_SUM16 == 2
        osa = MFMA8P(pf, ones, osa);
#endif
#else
        osa = MFMA8P(pf, ones, osa);
#endif
        EXPBLK(Hb1, Cb1, 0); SBAR();
        if (A8_DMASTAG && !(PROBE & 2) && dslot == 2) { { if (kw) { if (GK) { DMA8(t + 1 + DD, ADV(ks, DD + 1)); } } else { if (GV) { DMA8(t + DD, ADV(vs, DD)); } } } SBAR(); }
        if (GL && !(PROBE & 64)) { Ca0 = MFMA8(kf0, qfa, negm); }
        EXPBLK(Hb1, Cb1, 8); SBAR();
        if (GL && !(PROBE & 64)) { Ca1 = MFMA8(kf1, qfa, negm); }
        if (!(PROBE & 2) && (!A8_DMASTAG || dslot == 3)) { if (kw) { if (GK) { DMA8(t + 1 + DD, ADV(ks, DD + 1)); } } else { if (GV) { DMA8(t + DD, ADV(vs, DD)); } } }
        SBAR();
        if (!(PROBE & 8)) { PACK8(Hb0, Hb1, Cb0, Cb1); } SBAR();
        if (!(PROBE & 32)) ob0 = MFMA8P(pf, vf0, ob0);
        if (GL) {
            EXPBLK(Ha0, Ca0, 0); }
        SBAR();
        if (!(PROBE & 32)) ob1 = MFMA8P(pf, vf1, ob1);
        if (GL) {
            EXPBLK(Ha0, Ca0, 8); }
        SBAR();
        if (A8_VPREF && j < U - 1) { const ALAS char* vn_ = vp0 + ADV(vs, 1); LD32(vf0, vn_); LD32(vf1, vn_ + 2048); SBAR(); }
#if A8_SUM16
        if (!(PROBE & 32)) sb4 = MFMA16P(pf, ind, sb4);
#else
        osb = MFMA8P(pf, ones, osb);
#endif
        if (GL) {
            EXPBLK(Ha1, Ca1, 0); }
        SBAR();
        if (GL) { if (!(PROBE & 64)) Cb0 = MFMA8(kf0, qfb, negm);
            EXPBLK(Ha1, Ca1, 8); }
        SBAR();
        if (GL && !(PROBE & 64)) { Cb1 = MFMA8(kf1, qfb, negm); }
#endif
        if (j == U - 1 && !(PROBE & 16)) { if ((PROBE & 2) == 0 && (kw ? GK : GV)) { WB_SEL(DD - U); } else { WB_SEL(0); }
#ifdef A8_LAG
            if (!kw) __builtin_amdgcn_s_sleep(A8_LAG);
#endif
        }
        ks = ksn; vs = ADV(vs, 1);
      }
    }
#undef ADV
    {
        const int lane_e = lane_id_v(), l32 = lane_e & 31, hh = lane_e >> 5;
        ALAS bf16_t* stg = (ALAS bf16_t*)shm3 + wid * 4096;
#if A8_SUM16
        ALAS float* ls = (ALAS float*)(shm3 + 65536) + wid * 64;
        if ((lane_e & 7) == 0) { const int q0_ = 16 * ((lane_e >> 3) & 1) + 4 * (lane_e >> 4);
#pragma unroll
            for (int r = 0; r < 4; ++r) { ls[q0_ + r] = sa4[r]; ls[32 + q0_ + r] = sb4[r]; } }
        asm volatile("s_waitcnt lgkmcnt(0)" ::: "memory");
#endif
#pragma unroll
        for (int r = 0; r < 16; ++r) { const int orow = crow(r, hh);
#if A8_SUM16
            float ra = __builtin_amdgcn_rcpf(ls[orow]); const float rb = __builtin_amdgcn_rcpf(ls[32 + orow]);
#if A8_SUM16 == 2
            { const float rref = __builtin_amdgcn_rcpf(osa[r]); if (!(__builtin_fabsf(ra - rref) <= 1e-3f * rref)) ra = __builtin_nanf(""); }
#endif
#else
            const float ra = __builtin_amdgcn_rcpf(osa[r]), rb = __builtin_amdgcn_rcpf(osb[r]);
#endif
            stg[orow * 64 + l32] = pg8::f2bf1(oa0[r] * ra); stg[orow * 64 + 32 + l32] = pg8::f2bf1(oa1[r] * ra);
            stg[2048 + orow * 64 + l32] = pg8::f2bf1(ob0[r] * rb); stg[2048 + orow * 64 + 32 + l32] = pg8::f2bf1(ob1[r] * rb); }
        asm volatile("s_waitcnt lgkmcnt(0)" ::: "memory");
#pragma unroll
        for (int i2 = 0; i2 < 8; ++i2) { const int row = i2 * 8 + (lane_e >> 3), ch = lane_e & 7; const u32x4 v = *(const ALAS u32x4*)(stg + row * 64 + ch * 8);
            *(u32x4*)(T_MIX + (size_t)(qb * 512 + wid * 64 + row) * 1024 + head * 64 + ch * 8) = v; }
    }
    asm volatile("s_waitcnt lgkmcnt(0)\n\ts_barrier" ::: "memory");
#undef DMA8
#undef LD32
#undef PK8
}
}
static_assert(att::LDS_NEED <= RING_BYTES, "LDS map");

#define GAS __attribute__((address_space(1)))
#define LAS __attribute__((address_space(3)))
typedef unsigned short bf16;
typedef unsigned v4u __attribute__((ext_vector_type(4)));
typedef float f32x4 __attribute__((ext_vector_type(4)));
typedef GAS unsigned gu32;
#define RLX_AGENT __ATOMIC_RELAXED, __HIP_MEMORY_SCOPE_AGENT
#define LDS_WAIT() asm volatile("s_waitcnt lgkmcnt(0)" ::: "memory")
#define VM_WAIT() asm volatile("s_waitcnt vmcnt(0)" ::: "memory")
__device__ __forceinline__ unsigned f2bf(float f) { unsigned u = __builtin_bit_cast(unsigned, f); return (u + 0x7fffu + ((u >> 16) & 1u)) >> 16; }
__device__ __forceinline__ unsigned pk2(float lo, float hi) { return f2bf(lo) | (f2bf(hi) << 16); }
#define XB_TMO      128
#define XB_XCNT(j)  (256  + 64 * (j))
#define XB_XSUB(j)  (1280 + 64 * (j))
#define XB_XGEN(j)  (2304 + 64 * (j))
#define XB_TOP      3328
#define XB_TOPGEN   3392
#define XCD_BAR_WORDS 3456
#define XB_SPIN_CAP (1u << 18)

__device__ __forceinline__ unsigned xb_ld(unsigned* p)              { return __hip_atomic_load(p, __ATOMIC_RELAXED, __HIP_MEMORY_SCOPE_AGENT); }
__device__ __forceinline__ unsigned xb_add(unsigned* p, unsigned v) { return __hip_atomic_fetch_add(p, v, __ATOMIC_RELAXED, __HIP_MEMORY_SCOPE_AGENT); }
__device__ __forceinline__ unsigned xb_xcc_id() { return (unsigned)__builtin_amdgcn_s_getreg((3 << 11) | 20) & 0xFu; }
#define XB_SPIN(cond, bar) do { unsigned _sp = 0; while (cond) { __builtin_amdgcn_s_sleep(1); \
    if ((++_sp & 255u) == 0u) { if (xb_ld(&(bar)[XB_TMO])) break; if (_sp > XB_SPIN_CAP) { atomicAdd(&(bar)[XB_TMO], 1u); break; } } } } while (0)

struct XcdBarrier {
    unsigned* bar; unsigned x;
    volatile LAS unsigned* st;
};

__device__ __forceinline__ XcdBarrier xcd_barrier_post(unsigned* bar, volatile LAS unsigned* st, bool t0) {
    XcdBarrier b; b.bar = bar; b.x = (unsigned)__builtin_amdgcn_readfirstlane((int)xb_xcc_id()); b.st = st;
    if (t0) (void)xb_add(&bar[XB_XCNT(b.x)], 1u);
    return b;
}
__device__ __forceinline__ void xcd_barrier_complete(unsigned* bar, unsigned x, unsigned& nloc, unsigned& nx) {
    const unsigned G = gridDim.x * gridDim.y * gridDim.z;
    unsigned sum, cnt, mine, sp = 0u;
    for (;;) {
        sum = 0u; cnt = 0u; mine = 0u;
#pragma unroll
        for (unsigned j = 0; j < 16; ++j) { const unsigned c = xb_ld(&bar[XB_XCNT(j)]); sum += c; cnt += (c > 0u) ? 1u : 0u; mine = (j == x) ? c : mine; }
        if (sum == G) break;
        __builtin_amdgcn_s_sleep(1);
        if ((++sp & 255u) == 0u) { if (xb_ld(&bar[XB_TMO])) break; if (sp > XB_SPIN_CAP) { atomicAdd(&bar[XB_TMO], 1u); break; } }
    }
    nloc = mine > 0u ? mine : 1u; nx = cnt > 0u ? cnt : 1u;
}

__device__ __forceinline__ void xcd_barrier(const XcdBarrier& b_, int wave_id) {
    XcdBarrier b = b_; asm volatile("" : "+s"(b.bar), "+s"(b.x));
    const bool t0 = (wave_id == 0) && (lane_id_v() == 0);
    asm volatile("s_waitcnt vmcnt(0)" ::: "memory");
    __syncthreads();
    if (t0) {
        unsigned* bar = b.bar;
        __builtin_amdgcn_s_waitcnt(0);
        unsigned nloc = b.st[0], nx = b.st[1];
        if (nloc == 0u) { xcd_barrier_complete(bar, b.x, nloc, nx); b.st[0] = nloc; b.st[1] = nx; }
        const unsigned old = xb_add(&bar[XB_XSUB(b.x)], 1u);
        const unsigned gen = old / nloc;
        if (old + 1u == (gen + 1u) * nloc) {
            __builtin_amdgcn_fence(__ATOMIC_RELEASE, "agent");
            asm volatile("s_waitcnt vmcnt(0)" ::: "memory");
            const unsigned og = xb_add(&bar[XB_TOP], 1u);
            const unsigned tg = og / nx;
            if (og + 1u == (tg + 1u) * nx) xb_add(&bar[XB_TOPGEN], 1u);
            else XB_SPIN(xb_ld(&bar[XB_TOPGEN]) == tg, bar);
            __builtin_amdgcn_fence(__ATOMIC_ACQUIRE, "agent");
            xb_add(&bar[XB_XGEN(b.x)], 1u);
            asm volatile("s_waitcnt vmcnt(0)" ::: "memory");
        } else {
            XB_SPIN(xb_ld(&bar[XB_XGEN(b.x)]) == gen, bar);
            __builtin_amdgcn_fence(__ATOMIC_ACQUIRE, "agent");
            asm volatile("s_waitcnt vmcnt(0)" ::: "memory");
        }
    }
    __syncthreads();
}
#ifndef PHMASK
#define PHMASK 63
#endif
#ifndef ATT_DUP
#define ATT_DUP 1
#endif
#ifndef GU_DUP
#define GU_DUP 1
#endif
#ifndef IN_DUP
#define IN_DUP 1
#endif
#ifndef D1_DUP
#define D1_DUP 1
#endif
#ifndef P0_DUP
#define P0_DUP 1
#endif
#ifndef NODEFER
#define DEFER_OK (G == 256)
#else
#define DEFER_OK false
#endif

__device__ __forceinline__ float wave_sum(float v) { v += xor_lane<1>(v); v += xor_lane<2>(v); v += xor_lane<4>(v); v += xor_lane<8>(v); v += xor_lane<16>(v); return sum_x32(v); }
__device__ __forceinline__ float wave_max(float v) { v = fmaxf(v, xor_lane<1>(v)); v = fmaxf(v, xor_lane<2>(v)); v = fmaxf(v, xor_lane<4>(v)); v = fmaxf(v, xor_lane<8>(v)); v = fmaxf(v, xor_lane<16>(v)); return max_x32(v); }
__device__ __forceinline__ void tr_item(const float* W, int ldw, int srccol0, const float* gain, bf16* WT, int K, int dstrow0, int k0, LAS float* scr, int lane) {
    const int kq = lane >> 3, nq = lane & 7;
    f32x4 w[8]; float g[8];
#pragma unroll
    for (int i = 0; i < 8; ++i) { const int kk = 8 * i + kq; w[i] = *(const GAS f32x4*)(W + (size_t)(k0 + kk) * ldw + srccol0 + 4 * nq); g[i] = gain ? gain[k0 + kk] : 1.0f; }
#pragma unroll
    for (int i = 0; i < 8; ++i) { const int kk = 8 * i + kq; LAS float* s = scr + kk * 33 + 4 * nq; s[0] = w[i][0] * g[i]; s[1] = w[i][1] * g[i]; s[2] = w[i][2] * g[i]; s[3] = w[i][3] * g[i]; }
    LDS_WAIT(); asm volatile("" ::: "memory");
    const int c = lane & 7;
#pragma unroll
    for (int j = 0; j < 4; ++j) { const int n = (lane >> 3) + 8 * j; const LAS float* s = scr + (8 * c) * 33 + n;
        v4u o; o.x = pk2(s[0 * 33], s[1 * 33]); o.y = pk2(s[2 * 33], s[3 * 33]); o.z = pk2(s[4 * 33], s[5 * 33]); o.w = pk2(s[6 * 33], s[7 * 33]);
        *(GAS v4u*)(WT + (size_t)(dstrow0 + n) * K + k0 + 8 * c) = o; }
    LDS_WAIT(); asm volatile("" ::: "memory");
}

#define TR_ONE(it_) do { int r = (it_); \
        if (r < 2 * I_GU) { const int l2 = r >= I_GU; if (l2) r -= I_GU; const int kb = r / (NGU / 32), nb = r % (NGU / 32), n0 = nb * 32, pn = n0 >> 8, j0 = n0 & 255; \
            const float* src = (j0 < 128) ? (l2 ? args.in[18] : args.in[2]) : (l2 ? args.in[19] : args.in[3]); \
            tr_item(src, FF, pn * 128 + (j0 & 127), l2 ? args.in[17] : args.in[1], (bf16*)(ws + (l2 ? WS_WGU2 : WS_WGU1)), D, n0, kb * 64, scr, lane); break; } \
        r -= 2 * I_GU; \
        if (r < 2 * I_D) { const int l2 = r >= I_D; if (l2) r -= I_D; const int kb = r / (D / 32), nb = r % (D / 32); \
            tr_item(l2 ? args.in[20] : args.in[4], D, nb * 32, nullptr, (bf16*)(ws + (l2 ? WS_WD2 : WS_WD1)), FF, nb * 32, kb * 64, scr, lane); break; } \
        r -= 2 * I_D; \
        if (r < I_IN) { const int kb = r / (NIN / 32), nb = r % (NIN / 32), n0 = nb * 32, pn = n0 >> 8, j0 = n0 & 255, bj = j0 >> 7, wc = (j0 >> 5) & 3; \
            tr_item(args.in[6], NIN, pn * 256 + wc * 64 + bj * 32, args.in[5], (bf16*)(ws + WS_WIN), D, n0, kb * 64, scr, lane); break; } \
        r -= I_IN; \
        { const int kb = r / (D / 32), nb = r % (D / 32); tr_item(args.in[16], D, nb * 32, nullptr, (bf16*)(ws + WS_WOUT), D, nb * 32, kb * 64, scr, lane); } } while (0)
constexpr int I_GU = (D / 64) * (NGU / 32), I_D = (FF / 64) * (D / 32), I_IN = (D / 64) * (NIN / 32), I_OUT = (D / 64) * (D / 32);
#define TR_DEFERRED(first_idle, IT0, IT1) do { if (bx >= (first_idle)) { const int lane = lane_id_v(); LAS float* scr = (LAS float*)(L + RING_OFF + wave * 16384); \
        const int nw_ = (G - (first_idle)) * NWAVES; for (int it = (IT0) + (bx - (first_idle)) * NWAVES + wave; it < (IT1); it += nw_) { TR_ONE(it); } } } while (0)
struct Args { const float* in[21]; float* out; unsigned char* ws; };
#define LAUNDER(p) asm volatile("" : "+s"(p))

__global__ void __launch_bounds__(NWAVES * 64, 2) mk_fwd(Args args) {
    extern __shared__ __attribute__((aligned(16))) unsigned char lds[];
    LAS unsigned char* L = (LAS unsigned char*)lds;
    volatile LAS unsigned* MISC = (volatile LAS unsigned*)(L + MISC_OFF);
    const int wave = __builtin_amdgcn_readfirstlane((int)threadIdx.x >> 6);
    const int G = gridDim.x; const int bx = blockIdx.x;
    unsigned char* ws = args.ws; float* out = args.out; LAUNDER_G(ws); LAUNDER_G(out);
    { const int tid = wave * 64 + lane_id_v(); for (int u = tid; u < (LDS_BYTES - LDSCTL_OFF) / 4; u += NWAVES * 64) ((LAS unsigned*)(L + LDSCTL_OFF))[u] = 0u; }
    __syncthreads();
    XcdBarrier bar = xcd_barrier_post((unsigned*)((gu32*)(ws + WS_CTL) + CW_BAR), MISC + 8, (wave == 0) && (lane_id_v() == 0));
    LAS float* rstd_tab = (LAS float*)(L + RSTD_OFF);
    LAS float* PRM = (LAS float*)(L + PRM_OFF);
    float pr0_ = 0.f, pr1_ = 0.f, pr2_ = 0.f, pr3_ = 0.f;
    { const int lane = lane_id_v();
      if (wave == 0) { pr0_ = ((const GAS float*)args.in[7])[lane]; pr1_ = ((const GAS float*)args.in[8])[lane]; }
      else if (wave == 1) { pr0_ = ((const GAS float*)args.in[9])[lane]; pr1_ = ((const GAS float*)args.in[10])[lane]; }
      else if (wave == 2) { pr0_ = ((const GAS float*)args.in[15])[lane]; pr1_ = ((const GAS float*)args.in[15])[64 + lane]; }
      else if (wave < 7) { const int h = wave - 3; pr0_ = ((const GAS float*)args.in[11])[h * 64 + lane]; pr1_ = ((const GAS float*)args.in[12])[h * 64 + lane]; pr2_ = ((const GAS float*)args.in[13])[h * 64 + lane]; pr3_ = ((const GAS float*)args.in[14])[h * 64 + lane]; } }
#define PRM_FINISH() do { const int lane = lane_id_v(); \
      if (wave == 0) { PRM[PRM_GAQ + lane] = pr0_; PRM[PRM_GAK + lane] = pr1_; const float ma_ = wave_max(fabsf(pr0_)), mk_ = wave_max(fabsf(pr1_)); if (lane == 0) PRM[PRM_NEGM2A] = -(8.0f * 1.4426950408889634f * 1.02f) * ma_ * mk_; } \
      else if (wave == 1) { PRM[PRM_GBQ + lane] = pr0_; PRM[PRM_GBK + lane] = pr1_; const float ma_ = wave_max(fabsf(pr0_)), mk_ = wave_max(fabsf(pr1_)); if (lane == 0) PRM[PRM_NEGM2B] = -(8.0f * 1.4426950408889634f * 1.02f) * ma_ * mk_; } \
      else if (wave == 2) { PRM[PRM_SUBLN + lane] = pr0_; PRM[PRM_SUBLN + 64 + lane] = pr1_; } \
      else if (wave < 7) { const float d1_ = wave_sum(pr0_ * pr1_), d2_ = wave_sum(pr2_ * pr3_); if (lane == 0) PRM[PRM_LAM + (wave - 3)] = expf(d1_) - expf(d2_) + 0.2f; } \
      LDS_WAIT(); } while (0)

#define BUILD_RSTD(S) do { pg8::Unit u_; const int tid = wave * 64 + lane_id_v(); const float* SSQ_ = (const float*)(ws + WS_SSQ); for (int i_ = 0; i_ < 6 && (S).next(i_, u_); ++i_) if (tid < 256) { const f32x4* p_ = (const f32x4*)(SSQ_ + (size_t)(u_.pm * 256 + tid) * 16); \
        const f32x4 a_ = p_[0], b_ = p_[1], c_ = p_[2], d_ = p_[3]; const float s_ = ((a_[0] + a_[1]) + (a_[2] + a_[3])) + ((b_[0] + b_[1]) + (b_[2] + b_[3])) + ((c_[0] + c_[1]) + (c_[2] + c_[3])) + ((d_[0] + d_[1]) + (d_[2] + d_[3])); \
        rstd_tab[i_ * 256 + tid] = 1.0f / sqrtf(s_ * (1.0f / 1024.0f) + 1e-6f); } LDS_WAIT(); __syncthreads(); } while (0)

#if (PHMASK & 1)
    for (int dup0 = 0; dup0 < P0_DUP; ++dup0) {
        if (dup0) xcd_barrier(bar, wave);
        const int lane = lane_id_v(), tid = wave * 64 + lane;
        const int vcu = (G % 8 == 0) ? (bx % 8) * (G / 8) + bx / 8 : bx;
        float* ROPE = (float*)(ws + WS_ROPE); float* SSQ = (float*)(ws + WS_SSQ); bf16* XB = (bf16*)(ws + WS_XB); const float* x = args.in[0];
        LAS float* scr = (LAS float*)(L + RING_OFF + wave * 16384);
        const int gw = vcu * NWAVES + wave, NGW = G * NWAVES;
        for (int it = gw; it < ((DEFER_OK) ? I_GU : 2 * I_GU + 2 * I_D + I_IN + I_OUT); it += NGW) { TR_ONE(it); }
        for (int m = gw; m < M; m += NGW) {
            const GAS f32x4* xr = (const GAS f32x4*)(x + (size_t)m * D) + lane; f32x4 v[4]; float s = 0.f;
#pragma unroll
            for (int j = 0; j < 4; ++j) { v[j] = xr[64 * j]; s += (v[j][0] * v[j][0] + v[j][1] * v[j][1]) + (v[j][2] * v[j][2] + v[j][3] * v[j][3]); }
            s = wave_sum(s);
            GAS unsigned long long* o8 = (GAS unsigned long long*)(XB + (size_t)m * D) + lane;
#pragma unroll
            for (int j = 0; j < 4; ++j) o8[64 * j] = (unsigned long long)pk2(v[j][0], v[j][1]) | ((unsigned long long)pk2(v[j][2], v[j][3]) << 32);
            if (lane < 16) SSQ[(size_t)m * 16 + lane] = (lane == 0) ? s : 0.f;
        }
        for (int e = bx * (NWAVES * 64) + tid; e < 5120; e += G * NWAVES * 64) {
            const int isc = e >= 4096, ee = isc ? e - 4096 : e, pos = ee >> 4, i = ee & 15;
            const float invf = powf(10000.0f, -(float)i * (1.0f / 16.0f)); const float ang = (float)pos * invf; float sn, cs; sincosf(ang, &sn, &cs);
            if (isc) { ROPE[8192 + ee] = cs; ROPE[9216 + ee] = sn; } else { ROPE[ee] = cs; ROPE[4096 + ee] = sn; }
        }
    }
#endif
    PRM_FINISH();
    xcd_barrier(bar, wave);

    for (int rep = 0; rep < 2; ++rep) {
#if (PHMASK & 2)
        {
            LAUNDER_G(ws);
            pg8::Gemm g{(const bf16*)(ws + WS_XB), (const bf16*)(ws + (rep ? WS_WGU2 : WS_WGU1)), M, NGU, D}; pg8::StaticOrderT<M, NGU> S; int bxs_ = bx, Gs_ = G; LAUNDER(bxs_); LAUNDER(Gs_); S.init(Gs_, bxs_);
#if defined(SPLITK_GU2)
            { pg8::SplitTailOrderT<pg8::StaticOrderT<M, NGU>, 5, D / 64> SKr{S, (rep == 1) && (G == 256)}; BUILD_RSTD(SKr); }
#else
            BUILD_RSTD(S);
#endif
            pg8::EpiSwiGLU E{ws, rstd_tab};
            for (int dup = 0; dup < GU_DUP; ++dup) { if (dup) xcd_barrier(bar, wave);
#if defined(CLK_PROBE_GU)
            unsigned long long c0_ = __builtin_amdgcn_s_memtime(), r0_ = __builtin_amdgcn_s_memrealtime();
#endif
#if defined(SPLITK_GU2)
            {
                typedef pg8::SplitTailOrderT<pg8::StaticOrderT<M, NGU>, 5, D / 64> SKO; SKO SK{S, (rep == 1) && (G == 256)};
                pg8::EpiSwiGLUSplit E2{ws, rstd_tab};
                pg8::gemm_phase<D, pg8::EpiSwiGLUSplit, SKO, true, true, D, true>(L + RING_OFF, g, SK, E2, wave);
            }
#else
            pg8::gemm_phase<D, pg8::EpiSwiGLU, pg8::StaticOrderT<M, NGU>, true, true>(L + RING_OFF, g, S, E, wave);
#endif
            if (rep == 0 && dup == 0 && DEFER_OK) { TR_DEFERRED(128, 2 * I_GU, 2 * I_GU + I_D); TR_DEFERRED(128, 2 * I_GU + 2 * I_D, 2 * I_GU + 2 * I_D + I_IN); }
#if defined(CLK_PROBE_GU)
            if (rep == 0 && bx == 0) { const unsigned long long c1_ = __builtin_amdgcn_s_memtime(), r1_ = __builtin_amdgcn_s_memrealtime(); const unsigned long long spin_ = 1000ull * (c1_ - c0_) / (r1_ - r0_); while (__builtin_amdgcn_s_memrealtime() - r1_ < spin_) __builtin_amdgcn_s_sleep(8); }
#endif
            }
        }
#endif
        xcd_barrier(bar, wave);
#if (PHMASK & 4)
        {
            LAUNDER_G(ws); LAUNDER_G(out);
            pg8::Gemm g{(const bf16*)(ws + WS_H), (const bf16*)(ws + (rep ? WS_WD2 : WS_WD1)), M, D, FF}; pg8::StaticOrderT<M, D> S; int bxs_ = bx, Gs_ = G; LAUNDER(bxs_); LAUNDER(Gs_); S.init(Gs_, bxs_);
            if (rep == 0) { pg8::EpiResid<true, true, false> E{nullptr, nullptr, ws, 0.5f}; for (int dup = 0; dup < D1_DUP; ++dup) { if (dup) xcd_barrier(bar, wave);
#if defined(D1_NULLEPI)
                if (dup) { pg8::EpiNull EN; pg8::gemm_phase<FF, pg8::EpiNull, pg8::StaticOrderT<M, D>, true, true>(L + RING_OFF, g, S, EN, wave); continue; }
#endif
#if defined(D1_SCRATCH)
                if (dup) { pg8::EpiResidStaged<true, false> ES{nullptr, ws, 0.5f, ws + (140u << 20)}; pg8::gemm_phase<FF, pg8::EpiResidStaged<true, false>, pg8::StaticOrderT<M, D>, false, true>(L + RING_OFF, g, S, ES, wave); continue; }
#endif
                pg8::gemm_phase<FF, pg8::EpiResid<true, true, false>, pg8::StaticOrderT<M, D>, true, true>(L + RING_OFF, g, S, E, wave); } }
            else {
#if defined(D7_DUP) && defined(D7_PROBE1)
                for (int dup = 0; dup < D7_DUP; ++dup) { if (dup) xcd_barrier(bar, wave);
                    if (dup < D7_DUP - 1) { pg8::EpiResid<true, false, true, 1> EP{nullptr, out, ws, 0.5f}; pg8::gemm_phase<FF, pg8::EpiResid<true, false, true, 1>, pg8::StaticOrderT<M, D>, true, true>(L + RING_OFF, g, S, EP, wave); }
                    else { pg8::EpiResid<true, false, true> E{nullptr, out, ws, 0.5f}; pg8::gemm_phase<FF, pg8::EpiResid<true, false, true>, pg8::StaticOrderT<M, D>, true, true>(L + RING_OFF, g, S, E, wave); } }
#elif defined(D7_DUP)
                pg8::EpiResid<true, false, true> E{nullptr, out, ws, 0.5f};
#pragma unroll 1
                for (int dup = 0; dup < D7_DUP; ++dup) { if (dup) xcd_barrier(bar, wave); pg8::gemm_phase<FF, pg8::EpiResid<true, false, true>, pg8::StaticOrderT<M, D>, true, true>(L + RING_OFF, g, S, E, wave); }
#else
                pg8::EpiResid<true, false, true> E{nullptr, out, ws, 0.5f}; pg8::gemm_phase<FF, pg8::EpiResid<true, false, true>, pg8::StaticOrderT<M, D>, true, true>(L + RING_OFF, g, S, E, wave);
#endif
            }
        }
#endif
        if (rep == 1) break;
        xcd_barrier(bar, wave);
#if (PHMASK & 8)
        {
            LAUNDER_G(ws);
            pg8::Gemm g{(const bf16*)(ws + WS_XB), (const bf16*)(ws + WS_WIN), M, NIN, D}; pg8::StaticOrderT<M, NIN> S; int bxs_ = bx, Gs_ = G; LAUNDER(bxs_); LAUNDER(Gs_); S.init(Gs_, bxs_);
            BUILD_RSTD(S);
            pg8::EpiInProj E{rstd_tab, PRM, ws};
            for (int dup = 0; dup < IN_DUP; ++dup) { if (dup) xcd_barrier(bar, wave);
            pg8::gemm_phase<D, pg8::EpiInProj, pg8::StaticOrderT<M, NIN>, true, true>(L + RING_OFF, g, S, E, wave);
            if (dup == 0 && DEFER_OK) { TR_DEFERRED(64, I_GU, 2 * I_GU); TR_DEFERRED(64, 2 * I_GU + I_D, 2 * I_GU + 2 * I_D); TR_DEFERRED(64, 2 * I_GU + 2 * I_D + I_IN, 2 * I_GU + 2 * I_D + I_IN + I_OUT); } }
        }
#endif
        xcd_barrier(bar, wave);
#if (PHMASK & 16)
        for (int dup = 0; dup < ATT_DUP; ++dup) {
            LAUNDER_G(ws);
            if (dup) xcd_barrier(bar, wave);
            gu32* qhead = (gu32*)(ws + WS_CTL) + CW_QUEUE + 64 * dup;
#if defined(CLK_PROBE)
            unsigned long long c0_ = __builtin_amdgcn_s_memtime(), r0_ = __builtin_amdgcn_s_memrealtime();
#endif
            const att::Tensors T = att::make_tensors(ws, PRM);
            const bool st = (G == 256);
            const int xg = bx & 7, cg = bx >> 3;
            for (int step = 0;; ++step) {
                int kind, h, qb;
                if (st && step < 2) {
                    if (step < 1) { kind = 0; h = xg; qb = cg; }
                    else { kind = 1; h = (xg < 4) ? 3 : 2; qb = 32 * (xg & 3) + cg; }
                } else {
                    if ((wave == 0) && (lane_id_v() == 0)) MISC[12] = __hip_atomic_fetch_add(qhead, 1u, RLX_AGENT);
                    LDS_WAIT(); __syncthreads();
                    int idx = __builtin_amdgcn_readfirstlane((int)MISC[12]);
                    if (st) idx += 512;
                    if (idx >= 768) break;
                    if (idx < 256 || idx >= 512) { kind = 1;
                        if (idx < 128) { h = 3; qb = idx; } else if (idx < 256) { const int i = idx - 128; h = 2; qb = (i & 1) ? 63 - (i >> 1) : 64 + (i >> 1); }
                        else if (idx < 640) { h = 1; qb = idx - 512; } else { h = 0; qb = idx - 640; }
                    } else { kind = 0; const int i = idx - 256; h = i >> 5; qb = i & 31; }
                }
#if defined(DUP_ONLY_A)
                if (dup && kind) continue;
#elif defined(DUP_ONLY_B)
                if (dup && !kind) continue;
#endif
                if (kind) {
                    const float slope = (h == 0) ? 0.25f : (h == 1) ? 0.0625f : (h == 2) ? 0.015625f : 0.00390625f;
                    const float c2 = slope * 1.4426950408889634f; const int dskip = (int)(150.0f / c2) + 1;
#if defined(B_PROBE_DUP)
                    if (dup < ATT_DUP - 1) att::attn_unit<true, B_PROBE_DUP>(T, h, qb, PRM[PRM_NEGM2B], PRM[PRM_LAM + h], c2, dskip, (char*)lds + RING_OFF, wave); else
#endif
                    att::attn_unit<true>(T, h, qb, PRM[PRM_NEGM2B], PRM[PRM_LAM + h], c2, dskip, (char*)lds + RING_OFF, wave);
                } else {
#if defined(A8_NOEXP_DUP)
                    if (dup < ATT_DUP - 1) att::attn_unit_a8x2<A8U, A8_NOEXP_DUP>(T, h, qb, PRM[PRM_NEGM2A] + 8.0f, (char*)lds + RING_OFF, wave); else
#endif
                    att::attn_unit_a8x2<A8U>(T, h, qb, PRM[PRM_NEGM2A] + 8.0f, (char*)lds + RING_OFF, wave); }
            }
#if defined(CLK_PROBE)
            if (dup == ATT_DUP - 1 && bx == 0) { const unsigned long long c1_ = __builtin_amdgcn_s_memtime(), r1_ = __builtin_amdgcn_s_memrealtime(); const unsigned long long spin_ = 1000ull * (c1_ - c0_) / (r1_ - r0_); while (__builtin_amdgcn_s_memrealtime() - r1_ < spin_) __builtin_amdgcn_s_sleep(8); }
#endif
        }
#endif
        xcd_barrier(bar, wave);
#if (PHMASK & 32)
        {
            LAUNDER_G(ws); LAUNDER_G(out);
            pg8::Gemm g{(const bf16*)(ws + WS_MIX), (const bf16*)(ws + WS_WOUT), M, D, D}; pg8::StaticOrderT<M, D> S; int bxs_ = bx, Gs_ = G; LAUNDER(bxs_); LAUNDER(Gs_); S.init(Gs_, bxs_);
            pg8::EpiResid<true, true, false> E{nullptr, nullptr, ws, 1.0f}; pg8::gemm_phase<D, pg8::EpiResid<true, true, false>, pg8::StaticOrderT<M, D>, true, true>(L + RING_OFF, g, S, E, wave);
        }
#endif
        xcd_barrier(bar, wave);
    }
}

extern "C" void kernel_launch(void* const* d_in, const int* in_sizes, int n_in, void* d_out, int out_size, void* d_ws, size_t ws_size, hipStream_t stream) {
    static int grid = 0;
    if (grid == 0) {
        if (n_in != 21 || in_sizes[0] != M * D || out_size != M * D || ws_size < WS_END) { fprintf(stderr, "kernel_launch: unexpected shapes (n_in %d, in0 %d, out %d, ws %zu)\n", n_in, n_in > 0 ? in_sizes[0] : -1, out_size, ws_size); grid = -1; return; }
        int dev = 0, cus = 0, per_cu = 0;
        if (hipGetDevice(&dev) != hipSuccess || hipDeviceGetAttribute(&cus, hipDeviceAttributeMultiprocessorCount, dev) != hipSuccess) { grid = -1; return; }
        if (hipFuncSetAttribute((const void*)mk_fwd, hipFuncAttributeMaxDynamicSharedMemorySize, LDS_BYTES) != hipSuccess) { fprintf(stderr, "kernel_launch: hipFuncSetAttribute failed\n"); grid = -1; return; }
        if (hipOccupancyMaxActiveBlocksPerMultiprocessor(&per_cu, (const void*)mk_fwd, NWAVES * 64, LDS_BYTES) != hipSuccess || per_cu < 1) { fprintf(stderr, "kernel_launch: occupancy query says %d blocks per CU\n", per_cu); (void)hipGetLastError(); grid = -1; return; }
        grid = cus;
    }
    if (grid < 0) return;
    if (hipMemsetAsync((char*)d_ws + WS_CTL, 0, CTL_ZERO_BYTES, stream) != hipSuccess) { fprintf(stderr, "kernel_launch: memset failed\n"); return; }
    Args a{};
    for (int i = 0; i < 21; ++i) a.in[i] = (const float*)d_in[i];
    a.out = (float*)d_out; a.ws = (unsigned char*)d_ws;
    hipLaunchKernelGGL(mk_fwd, dim3(grid), dim3(NWAVES * 64), LDS_BYTES, stream, a);
    const hipError_t le = hipPeekAtLastError();
    if (le != hipSuccess) fprintf(stderr, "kernel_launch: launch failed: %s\n", hipGetErrorName(le));
}
```

```cpp
#include <hip/hip_runtime.h>
#include <cstdio>
#include <cstdint>
#define ROPE_HOIST 1
#define HEADF_RSQ 1
#define XLOCAL_BAR 1
#ifndef NO_GLDS_M0_CLOBBER
#define GLDS_M0_CLOBBER 1
#endif
#ifndef NO_PG8_ASMDMA
#define PG8_ASMDMA 1
#endif
#ifndef NO_SWIGLU_FMA
#define SWIGLU_FMA 1
#endif
#ifndef NOTAIL
#define NOTAIL 1
#endif
#ifndef A8_PRO2
#define A8_PRO2 0
#endif
#ifndef A8_KLATE
#define A8_KLATE 0
#endif
#ifndef B_SPLIT
#define B_SPLIT 2
#endif
#ifndef B_KRDC
#define B_KRDC 0
#endif
#ifndef A8_DMAPOS
#define A8_DMAPOS 0
#endif
#ifndef B_VF8
#define B_VF8 1
#endif
#ifndef A8_PIPE2
#define A8_PIPE2 1
#endif
#ifndef A8_DMASTAG
#define A8_DMASTAG 0
#endif
#ifndef A8_SUM16
#define A8_SUM16 1
#endif
#ifndef B_ORDER
#define B_ORDER 0
#endif
#ifndef A8_VPREF
#define A8_VPREF 1
#endif
#ifndef BDMA_MODE
#define BDMA_MODE 6
#endif
#ifndef A8U
#define A8U 8
#endif
#ifndef A8_NOBF8
#define A8_BF8 1
#endif

constexpr int NWAVES = 8;
constexpr int M = 16384, D = 1024, FF = 2816, NGU = 2 * FF, NIN = 2304;
constexpr size_t MiB = 1u << 20;
constexpr size_t WS_CTL = 0, CTL_ZERO_BYTES = 64 * 1024;
constexpr size_t WS_WGU1 = 2 * MiB, WS_WD1 = 13 * MiB, WS_WIN = 19 * MiB, WS_WOUT = 24 * MiB, WS_WGU2 = 26 * MiB, WS_WD2 = 37 * MiB;
constexpr size_t WS_ROPE = 43 * MiB, WS_SSQ = 44 * MiB;
constexpr size_t WS_XB = 48 * MiB;
constexpr size_t WS_H = 80 * MiB;
constexpr size_t WS_QA = 80 * MiB, WS_KA = 96 * MiB, WS_VA = 100 * MiB, WS_QB = 104 * MiB, WS_KB = 120 * MiB, WS_VB = 136 * MiB, WS_MIX = 152 * MiB;
constexpr size_t WS_END = 184 * MiB;
static_assert(WS_WGU1 + (size_t)NGU * D * 2 <= WS_WD1 && WS_WD1 + (size_t)D * FF * 2 <= WS_WIN && WS_WIN + (size_t)NIN * D * 2 <= WS_WOUT && WS_WOUT + (size_t)D * D * 2 <= WS_WGU2 &&
              WS_WGU2 + (size_t)NGU * D * 2 <= WS_WD2 && WS_WD2 + (size_t)D * FF * 2 <= WS_ROPE && WS_H + (size_t)M * FF * 2 <= WS_END && WS_MIX + (size_t)M * D * 2 <= WS_END, "d_ws map");
constexpr int CW_BAR = 1024;
constexpr int CW_XFLAG = 9216;
constexpr size_t WS_XCH = 184 * MiB;
constexpr int CW_XMAP = 10240;
constexpr int CW_QUEUE = 8192;
constexpr int RING_OFF = 0, RING_BYTES = 131072;
constexpr int LDSCTL_OFF = 147456  , MISC_OFF = LDSCTL_OFF + 320, RSTD_OFF = LDSCTL_OFF + 1024, PRM_OFF = LDSCTL_OFF + 8192;
constexpr int LDS_BYTES = 163840;
constexpr int PRM_GAQ = 0, PRM_GAK = 64, PRM_GBQ = 128, PRM_GBK = 192, PRM_SUBLN = 256, PRM_NEGM2A = 384, PRM_NEGM2B = 385, PRM_LAM = 388, PRM_WORDS = 392;
static_assert(RSTD_OFF + 6 * 256 * 4 <= PRM_OFF && PRM_OFF + PRM_WORDS * 4 <= LDS_BYTES, "LDS map");

__device__ __forceinline__ int lane_id_v() { int l; asm volatile("v_mbcnt_lo_u32_b32 %0, -1, 0\n\tv_mbcnt_hi_u32_b32 %0, -1, %0" : "=v"(l)); return l; }

template <int MASK> __device__ __forceinline__ float xor_lane(float v) {
    if constexpr (MASK == 32) { const auto rr = __builtin_amdgcn_permlane32_swap(__float_as_uint(v), __float_as_uint(v), false, false); return __uint_as_float(lane_id_v() < 32 ? rr[1] : rr[0]); }
    else return __uint_as_float((unsigned)__builtin_amdgcn_ds_swizzle((int)__float_as_uint(v), (MASK << 10) | 0x1f));
}
__device__ __forceinline__ float sum_x32(float v) { const auto rr = __builtin_amdgcn_permlane32_swap(__float_as_uint(v), __float_as_uint(v), false, false); return __uint_as_float(rr[0]) + __uint_as_float(rr[1]); }
__device__ __forceinline__ float max_x32(float v) { const auto rr = __builtin_amdgcn_permlane32_swap(__float_as_uint(v), __float_as_uint(v), false, false); return fmaxf(__uint_as_float(rr[0]), __uint_as_float(rr[1])); }

#define LAUNDER_G(p) do { __attribute__((address_space(1))) void* g_ = (__attribute__((address_space(1))) void*)(p); asm volatile("" : "+s"(g_)); (p) = (decltype(p))g_; } while (0)
namespace pg8 {
#define PG8_LAS __attribute__((address_space(3)))
typedef unsigned short bf16_t;
typedef short bf16x8 __attribute__((ext_vector_type(8)));
typedef float f32x4 __attribute__((ext_vector_type(4)));
typedef unsigned u32x4 __attribute__((ext_vector_type(4)));
constexpr int BM = 256, BK = 64, HALF = 128, HTB = HALF * BK * 2  , STAGE_BYTES = 8 * HTB, NXCD = 8, WGM = 8;

__host__ __device__ __forceinline__ int lds_byte(int r, int c) { const int st = (r >> 4) * 2 + (c >> 5), rr = r & 15, cc = c & 31, ob = rr * 64 + cc * 2; return st * 1024 + (ob ^ (((ob >> 9) & 1) << 5)); }
__host__ __device__ __forceinline__ void stage_rc(int b, int& R, int& C) { const int st = b / 1024, sb = b % 1024, swz = sb ^ (((sb >> 9) & 1) << 5); R = (st >> 1) * 16 + swz / 64; C = (st & 1) * 32 + (swz % 64) / 2; }
__host__ __device__ __forceinline__ int perm32(int rho) { const int n = rho >> 4, i = rho & 15; return 8 * (i >> 2) + 4 * n + (i & 3); }

struct Unit { int pm, pn; int kofs, nt; };
struct Gemm { const bf16_t* A; const bf16_t* Bt; int M, N, K; };

template <int MD, int ND> struct StaticOrderT {
    static constexpr int nM = MD / BM, nN = ND / BM, nwg = nM * nN;
    int G, c;
    __host__ __device__ void init(int G_, int c_) { G = G_; c = c_; }
    __host__ __device__ bool next(int i, Unit& u) const { return at(i * G + c, u); }
    __host__ __device__ bool at(int L, Unit& u) const {
        if (L >= nwg) return false;
        int wgid = L; { constexpr int q = nwg / NXCD, r = nwg % NXCD; const int xcd = wgid % NXCD, off = wgid / NXCD; wgid = (xcd < r ? xcd * (q + 1) : r * (q + 1) + (xcd - r) * q) + off; }
        constexpr int nig = WGM * nN; const int gid = wgid / nig, fm = gid * WGM, gsz = (nM - fm) < WGM ? (nM - fm) : WGM;
        u.pm = fm + ((wgid % nig) % gsz); u.pn = (wgid % nig) / gsz; u.kofs = 0; u.nt = 0; return true;
    }
    __device__ __forceinline__ void a_ready(const Unit&) const {}
    __device__ __forceinline__ void done(const Unit&) const {}
};
template <class S0, int RT, int NTF> struct SplitTailOrderT { S0 s; bool sk;
    __host__ __device__ bool next(int i, Unit& u) const {
        if (!sk || i < RT) { const bool r = s.next(i, u); u.kofs = 0; u.nt = NTF; return r; }
        if (i > RT) return false;
        const int h = s.G >> 1; s.at(RT * s.G + (s.c % h), u); u.kofs = (s.c / h) * (NTF / 2) * BK * 2; u.nt = NTF / 2; return true; }
    __device__ __forceinline__ void a_ready(const Unit&) const {} __device__ __forceinline__ void done(const Unit&) const {} };


__device__ __forceinline__ unsigned cvt_pk_bf16(float lo, float hi) { unsigned r; asm volatile("v_cvt_pk_bf16_f32 %0, %1, %2" : "=v"(r) : "v"(lo), "v"(hi)); return r; }
__device__ __forceinline__ unsigned short f2bf1(float f) { unsigned u = __builtin_bit_cast(unsigned, f); return (unsigned short)((u + 0x7fffu + ((u >> 16) & 1u)) >> 16); }
typedef unsigned u32x2 __attribute__((ext_vector_type(2)));
constexpr int MROWS = M, DMODEL = D, DFF = FF;

typedef float f32x2 __attribute__((ext_vector_type(2)));
#ifdef SWIGLU_FMA
#define SWIGLU_RS2(rs) __builtin_amdgcn_rcpf((rs) * (rs))
#else
#define SWIGLU_RS2(rs) ((rs) * (rs))
#endif
__device__ __forceinline__ f32x2 swiglu2(f32x2 ag, f32x2 au, float k1, float rs2) {
    const f32x2 t = ag * k1; f32x2 ex; ex.x = __builtin_amdgcn_exp2f(t.x); ex.y = __builtin_amdgcn_exp2f(t.y);
#ifdef SWIGLU_FMA
    const f32x2 d = ex * rs2 + rs2; f32x2 r; r.x = __builtin_amdgcn_rcpf(d.x); r.y = __builtin_amdgcn_rcpf(d.y);
    return (ag * au) * r;
#else
    const f32x2 d = ex + 1.0f; f32x2 r; r.x = __builtin_amdgcn_rcpf(d.x); r.y = __builtin_amdgcn_rcpf(d.y);
    return ((ag * au) * rs2) * r;
#endif
}
__device__ __forceinline__ f32x4 swiglu4(f32x4 ag, f32x4 au, float k1, float rs2) {
    const f32x2 a = swiglu2((f32x2){ag[0], ag[1]}, (f32x2){au[0], au[1]}, k1, rs2), b = swiglu2((f32x2){ag[2], ag[3]}, (f32x2){au[2], au[3]}, k1, rs2);
    return (f32x4){a.x, a.y, b.x, b.y};
}
struct EpiSwiGLU {
    static constexpr bool PERM = true, AFTER_DRAIN = false;
    unsigned char* ws; const PG8_LAS float* rstd;
    __device__ __forceinline__ void operator()(const f32x4 (&acc)[2][2][4][2], const Unit& u, int ui, int wr, int wc, int fr, int fq) const {
        asm volatile("" : "+v"(fr), "+v"(fq));
        const int col0 = u.pn * 128 + wc * 32 + 8 * fq; unsigned char* w2 = ws; LAUNDER_G(w2); bf16_t* H = (bf16_t*)(w2 + WS_H);
#pragma unroll
        for (int ai = 0; ai < 2; ++ai)
#pragma unroll
            for (int m = 0; m < 4; ++m) {
                const int rl = ai * HALF + wr * 64 + m * 16 + fr; const float rs = rstd[ui * 256 + rl];
                const float k1 = rs * -1.4426950408889634f, rs2 = SWIGLU_RS2(rs);
                const f32x4 h0 = swiglu4(acc[ai][0][m][0], acc[ai][1][m][0], k1, rs2), h1 = swiglu4(acc[ai][0][m][1], acc[ai][1][m][1], k1, rs2);
                u32x4 w; w.x = cvt_pk_bf16(h0[0], h0[1]); w.y = cvt_pk_bf16(h0[2], h0[3]); w.z = cvt_pk_bf16(h1[0], h1[1]); w.w = cvt_pk_bf16(h1[2], h1[3]);
                *(u32x4*)(H + (size_t)(u.pm * BM + rl) * DFF + col0) = w;
            }
    }
};
struct EpiSwiGLUSplit {
    static constexpr bool PERM = true, AFTER_DRAIN = false;
    unsigned char* ws; const PG8_LAS float* rstd;
    typedef unsigned long long u64;
    __device__ __forceinline__ static void put(u64* p, const f32x4& v) {
        __hip_atomic_store(p, ((u64)__float_as_uint(v[1]) << 32) | __float_as_uint(v[0]), __ATOMIC_RELAXED, __HIP_MEMORY_SCOPE_AGENT);
        __hip_atomic_store(p + 1, ((u64)__float_as_uint(v[3]) << 32) | __float_as_uint(v[2]), __ATOMIC_RELAXED, __HIP_MEMORY_SCOPE_AGENT); }
    __device__ __forceinline__ static f32x4 get(const u64* p) {
        const u64 a = __hip_atomic_load(p, __ATOMIC_RELAXED, __HIP_MEMORY_SCOPE_AGENT), b = __hip_atomic_load(p + 1, __ATOMIC_RELAXED, __HIP_MEMORY_SCOPE_AGENT);
        return (f32x4){__uint_as_float((unsigned)a), __uint_as_float((unsigned)(a >> 32)), __uint_as_float((unsigned)b), __uint_as_float((unsigned)(b >> 32))}; }
    template <int SS> __device__ __forceinline__ void run(const f32x4 (&acc)[2][2][4][2], const Unit& u, int wr, int wc, int fr, int fq) const {
        unsigned char* w2 = ws; LAUNDER_G(w2);
        const int pair = (int)(__builtin_amdgcn_workgroup_id_x() & 127u); constexpr int rslot = 5;
        const unsigned tid = (unsigned)((wr * 4 + wc) * 64 + fq * 16 + fr);
        unsigned char* xb_ = w2 + WS_XCH + (size_t)pair * (2 * 16 * 512 * 16);
        u64* xo = (u64*)(xb_ + (size_t)(1 - SS) * (16 * 512 * 16) + tid * 16u);
        const u64* xi = (const u64*)(xb_ + (size_t)SS * (16 * 512 * 16) + tid * 16u);
        unsigned* flg = (unsigned*)(w2 + WS_CTL) + CW_XFLAG + pair * 2;
#pragma unroll
        for (int bj = 0; bj < 2; ++bj)
#pragma unroll
            for (int m = 0; m < 4; ++m)
#pragma unroll
                for (int n = 0; n < 2; ++n) put(xo + (size_t)((bj * 4 + m) * 2 + n) * 1024, acc[1 - SS][bj][m][n]);
        asm volatile("s_waitcnt vmcnt(0)" ::: "memory");
        __syncthreads();
        if (tid == 0) { __hip_atomic_store(flg + (1 - SS), 1u, __ATOMIC_RELAXED, __HIP_MEMORY_SCOPE_AGENT);
            unsigned sp = 0; while (__hip_atomic_load(flg + SS, __ATOMIC_RELAXED, __HIP_MEMORY_SCOPE_AGENT) == 0u) { __builtin_amdgcn_s_sleep(1); if (++sp > (1u << 20)) break; } }
        __syncthreads();
        bf16_t* H = (bf16_t*)(w2 + WS_H); const int col0 = u.pn * 128 + wc * 32 + 8 * fq;
#pragma unroll
        for (int m = 0; m < 4; ++m) {
            const f32x4 g0 = acc[SS][0][m][0] + get(xi + (size_t)((0 * 4 + m) * 2 + 0) * 1024), g1 = acc[SS][0][m][1] + get(xi + (size_t)((0 * 4 + m) * 2 + 1) * 1024);
            const f32x4 u0 = acc[SS][1][m][0] + get(xi + (size_t)((1 * 4 + m) * 2 + 0) * 1024), u1 = acc[SS][1][m][1] + get(xi + (size_t)((1 * 4 + m) * 2 + 1) * 1024);
            const int rl = SS * HALF + wr * 64 + m * 16 + fr; const float rs = rstd[rslot * 256 + rl];
            const float k1 = rs * -1.4426950408889634f, rs2 = SWIGLU_RS2(rs);
            const f32x4 h0 = swiglu4(g0, u0, k1, rs2), h1 = swiglu4(g1, u1, k1, rs2);
            u32x4 w; w.x = cvt_pk_bf16(h0[0], h0[1]); w.y = cvt_pk_bf16(h0[2], h0[3]); w.z = cvt_pk_bf16(h1[0], h1[1]); w.w = cvt_pk_bf16(h1[2], h1[3]);
            *(u32x4*)(H + (size_t)(u.pm * BM + rl) * DFF + col0) = w;
        }
    }
    __device__ __forceinline__ void operator()(const f32x4 (&acc)[2][2][4][2], const Unit& u, int ui, int wr, int wc, int fr, int fq) const {
        if (u.nt == (D / BK) / 2) { asm volatile("" : "+v"(fr), "+v"(fq));
            if (__builtin_amdgcn_workgroup_id_x() >> 7) run<1>(acc, u, wr, wc, fr, fq); else run<0>(acc, u, wr, wc, fr, fq); }
        else { EpiSwiGLU E0{ws, rstd}; E0(acc, u, ui, wr, wc, fr, fq); }
    }
};
template <bool SRC_B, bool WRITE_B, bool WRITE_F, int PROBE = 0> struct EpiResid {
    static constexpr bool PERM = true, AFTER_DRAIN = false;
    const float* base; float* out; unsigned char* ws; float alpha;
    __device__ __forceinline__ static f32x4 up4(unsigned a, unsigned b) { return (f32x4){__uint_as_float(a << 16), __uint_as_float(a & 0xffff0000u), __uint_as_float(b << 16), __uint_as_float(b & 0xffff0000u)}; }
    __device__ __forceinline__ void operator()(const f32x4 (&acc)[2][2][4][2], const Unit& u, int ui, int wr, int wc, int fr, int fq) const {
        asm volatile("" : "+v"(fr), "+v"(fq));
        const int col0 = u.pn * BM + wc * 32 + 8 * fq;
        unsigned char* w2 = ws; LAUNDER_G(w2); bf16_t* xb = (bf16_t*)(w2 + WS_XB); float* ssqp = (float*)(w2 + WS_SSQ);
#pragma unroll
        for (int ai = 0; ai < 2; ++ai) {
            f32x4 rb[4][2][2];
#pragma unroll
            for (int m = 0; m < 4; ++m) { const size_t off = (size_t)(u.pm * BM + ai * HALF + wr * 64 + m * 16 + fr) * DMODEL + col0;
#pragma unroll
                for (int bj = 0; bj < 2; ++bj) {
                    if (PROBE == 1) { rb[m][bj][0] = (f32x4){0.f, 0.f, 0.f, 0.f}; rb[m][bj][1] = rb[m][bj][0]; }
                    else if (SRC_B) { const u32x4 r = *(const u32x4*)(xb + off + bj * HALF); rb[m][bj][0] = __builtin_bit_cast(f32x4, r); }
                    else { rb[m][bj][0] = *(const f32x4*)(base + off + bj * HALF); rb[m][bj][1] = *(const f32x4*)(base + off + bj * HALF + 4); } } }
#pragma unroll
            for (int m = 0; m < 4; ++m) {
                const int row = u.pm * BM + ai * HALF + wr * 64 + m * 16 + fr; const size_t off = (size_t)row * DMODEL + col0; float ss = 0.f;
#pragma unroll
                for (int bj = 0; bj < 2; ++bj) { const size_t o = off + bj * HALF;
                    f32x4 b0, b1;
                    if (SRC_B) { const u32x4 r = __builtin_bit_cast(u32x4, rb[m][bj][0]); b0 = up4(r[0], r[1]); b1 = up4(r[2], r[3]); } else { b0 = rb[m][bj][0]; b1 = rb[m][bj][1]; }
                    const f32x4 v0 = b0 + acc[ai][bj][m][0] * alpha, v1 = b1 + acc[ai][bj][m][1] * alpha;
                    if (PROBE == 2) { asm volatile("" :: "v"(v0), "v"(v1)); }
#ifdef OUT_NT
                    if (WRITE_F && PROBE != 2) { __builtin_nontemporal_store(v0, (f32x4*)(out + o)); __builtin_nontemporal_store(v1, (f32x4*)(out + o + 4)); }
#else
                    if (WRITE_F && PROBE != 2) { *(f32x4*)(out + o) = v0; *(f32x4*)(out + o + 4) = v1; }
#endif
                    if (WRITE_B && PROBE != 2) { ss += ((v0[0] * v0[0] + v0[1] * v0[1]) + (v0[2] * v0[2] + v0[3] * v0[3])) + ((v1[0] * v1[0] + v1[1] * v1[1]) + (v1[2] * v1[2] + v1[3] * v1[3]));
                        u32x4 w; w.x = cvt_pk_bf16(v0[0], v0[1]); w.y = cvt_pk_bf16(v0[2], v0[3]); w.z = cvt_pk_bf16(v1[0], v1[1]); w.w = cvt_pk_bf16(v1[2], v1[3]); *(u32x4*)(xb + o) = w; } }
                if (WRITE_B && PROBE != 2) { ss += xor_lane<16>(ss); ss = sum_x32(ss); if (fq == 0) ssqp[(size_t)row * 16 + u.pn * 4 + wc] = ss; }
            }
            asm volatile("" ::: "memory");
        }
    }
};
template <bool WRITE_B, bool WRITE_F> struct EpiResidStaged {
    static constexpr bool PERM = true, AFTER_DRAIN = true;
    float* out; unsigned char* ws; float alpha; unsigned char* wsw;
    __device__ __forceinline__ static f32x4 up4(unsigned a, unsigned b) { return (f32x4){__uint_as_float(a << 16), __uint_as_float(a & 0xffff0000u), __uint_as_float(b << 16), __uint_as_float(b & 0xffff0000u)}; }
    __device__ __forceinline__ void fused(f32x4 (&acc)[2][2][4][2], const Unit& u, int wr, int wc, int fr, int fq, PG8_LAS unsigned char* lds, int wid, int lane) const {
        unsigned char* w2 = ws; LAUNDER_G(w2); const bf16_t* xb = (const bf16_t*)(w2 + WS_XB); unsigned char* w3 = wsw; LAUNDER_G(w3); bf16_t* xbw = (bf16_t*)(w3 + WS_XB); float* ssqp = (float*)(w3 + WS_SSQ);
        {
            const int tid = wid * 64 + lane, c = tid & 31, r0 = tid >> 5;
            const bf16_t* src = xb + (size_t)(u.pm * BM + r0) * DMODEL + u.pn * BM + c * 8;
            u32x4 t[16];
#pragma unroll
            for (int p = 0; p < 16; ++p) t[p] = *(const u32x4*)(src + (size_t)(p * 16) * DMODEL);
#pragma unroll
            for (int p = 0; p < 16; ++p) { const int r = p * 16 + r0; *(PG8_LAS u32x4*)(lds + r * 512 + ((c ^ (r & 15)) << 4)) = t[p]; }
        }
        asm volatile("s_waitcnt vmcnt(0) lgkmcnt(0)\n\ts_barrier" ::: "memory");
        asm volatile("" : "+v"(fr), "+v"(fq));
        const int col0 = u.pn * BM + wc * 32 + 8 * fq;
#pragma unroll
        for (int ai = 0; ai < 2; ++ai)
#pragma unroll
            for (int m = 0; m < 4; ++m) {
                const int rl = ai * HALF + wr * 64 + m * 16 + fr; const int row = u.pm * BM + rl; const size_t off = (size_t)row * DMODEL + col0; float ss = 0.f;
#pragma unroll
                for (int bj = 0; bj < 2; ++bj) { const size_t o = off + bj * HALF;
                    const int chunk = 16 * bj + 4 * wc + fq;
                    const u32x4 r = *(const PG8_LAS u32x4*)(lds + rl * 512 + ((chunk ^ (rl & 15)) << 4));
                    const f32x4 b0 = up4(r[0], r[1]), b1 = up4(r[2], r[3]);
                    const f32x4 v0 = b0 + acc[ai][bj][m][0] * alpha, v1 = b1 + acc[ai][bj][m][1] * alpha;
                    if (WRITE_F) { *(f32x4*)(out + o) = v0; *(f32x4*)(out + o + 4) = v1; }
                    if (WRITE_B) { ss += ((v0[0] * v0[0] + v0[1] * v0[1]) + (v0[2] * v0[2] + v0[3] * v0[3])) + ((v1[0] * v1[0] + v1[1] * v1[1]) + (v1[2] * v1[2] + v1[3] * v1[3]));
                        u32x4 w; w.x = cvt_pk_bf16(v0[0], v0[1]); w.y = cvt_pk_bf16(v0[2], v0[3]); w.z = cvt_pk_bf16(v1[0], v1[1]); w.w = cvt_pk_bf16(v1[2], v1[3]); *(u32x4*)(xbw + o) = w; } }
                if (WRITE_B) { ss += xor_lane<16>(ss); ss = sum_x32(ss); if (fq == 0) ssqp[(size_t)row * 16 + u.pn * 4 + wc] = ss; }
            }
    }
};
struct EpiNull {
    static constexpr bool PERM = true, AFTER_DRAIN = false;
    __device__ __forceinline__ void operator()(const f32x4 (&acc)[2][2][4][2], const Unit& u, int ui, int wr, int wc, int fr, int fq) const {
#pragma unroll
        for (int ai = 0; ai < 2; ++ai)
#pragma unroll
            for (int bj = 0; bj < 2; ++bj)
#pragma unroll
                for (int m = 0; m < 4; ++m)
#pragma unroll
                    for (int n = 0; n < 2; ++n) { f32x4 t = acc[ai][bj][m][n]; asm volatile("" :: "v"(t)); }
    }
};
#ifdef GAIN_HOIST
#define GAINV(bj, h) ((bj) ? ((h) ? gv11_ : gv10_) : ((h) ? gv01_ : gv00_))
#else
#define GAINV(bj, h) (*(const PG8_LAS f32x4*)(gp + 32 * (bj) + 16 * (h)))
#endif
template <int IPROBE = 0> struct EpiInProjT {
    static constexpr bool PERM = false, AFTER_DRAIN = false;
    const PG8_LAS float* rstd; const PG8_LAS float* prm; unsigned char* ws;
    __device__ __forceinline__ static float head_f(const f32x4 (&acc)[2][2][4][2], int ai, int m, float rs) {
        float ss = 0.f;
#pragma unroll
        for (int bj = 0; bj < 2; ++bj)
#pragma unroll
            for (int n = 0; n < 2; ++n) { const f32x4 a = acc[ai][bj][m][n]; ss += (a[0] * a[0] + a[1] * a[1]) + (a[2] * a[2] + a[3] * a[3]); }
        ss += xor_lane<16>(ss); ss = sum_x32(ss);
#ifdef HEADF_RSQ
        return rs * __builtin_amdgcn_rsqf(ss * rs * rs * (1.0f / 64.0f) + 1e-6f);
#else
        return rs / sqrtf(ss * rs * rs * (1.0f / 64.0f) + 1e-6f);
#endif
    }
    __device__ __forceinline__ void operator()(const f32x4 (&acc)[2][2][4][2], const Unit& u, int ui, int wr, int wc, int fr, int fq) const {
        const int G = __builtin_amdgcn_readfirstlane(u.pn * 4 + wc);
        unsigned char* w2 = ws; LAUNDER_G(w2);
        asm volatile("" : "+v"(fr), "+v"(fq));
        const int row0 = wr * 64 + fr;
        if ((IPROBE & 1) && ((G >= 10 && G < 12) || G >= 28)) return;
        if ((IPROBE & 2) && (G < 10 || (G >= 12 && G < 28))) return;
        if (G < 10) {
            const bool isq = G < 8;
            const PG8_LAS float* gp = prm + (isq ? PRM_GAQ : PRM_GAK) + 4 * fq;
#ifdef GAIN_HOIST
            const f32x4 gv00_ = *(const PG8_LAS f32x4*)(gp), gv01_ = *(const PG8_LAS f32x4*)(gp + 16), gv10_ = *(const PG8_LAS f32x4*)(gp + 32), gv11_ = *(const PG8_LAS f32x4*)(gp + 48);
#endif
            const float* rope = (const float*)(w2 + WS_ROPE) + 4 * fq;
            const float qs = isq ? 0.125f * 1.4426950408889634f : 1.0f;
            unsigned char* db = isq ? (w2 + WS_QA) + (size_t)G * MROWS * 64 + 8 * fq : (w2 + WS_KA) + (size_t)(G - 8) * MROWS * 64 + (fq >> 1) * 512 + 8 * (fq & 1);
#ifdef ROPE_HOIST
            f32x4 cr_[2], sr_[2], cc_[4], sc_[4];
#pragma unroll
            for (int ai = 0; ai < 2; ++ai) { const float* rp = rope + (u.pm * 4 + ai * 2 + wr) * 16; cr_[ai] = *(const f32x4*)rp; sr_[ai] = *(const f32x4*)(rp + 4096); }
#pragma unroll
            for (int m = 0; m < 4; ++m) { const float* rp = rope + 8192 + (m * 16 + fr) * 16; cc_[m] = *(const f32x4*)rp; sc_[m] = *(const f32x4*)(rp + 1024); }
#endif
#pragma unroll
            for (int ai = 0; ai < 2; ++ai)
#pragma unroll
                for (int m = 0; m < 4; ++m) {
                    const int rl = ai * HALF + m * 16 + row0; const int t = u.pm * BM + rl; const float f = head_f(acc, ai, m, rstd[ui * 256 + rl]) * qs;
                    unsigned char* dt = isq ? db + (size_t)t * 64 : db + (size_t)(t >> 6) * 4096 + ((t & 63) >> 5) * 2048 + (t & 31) * 16;
#pragma unroll
                    for (int bj = 0; bj < 2; ++bj) {
                        const f32x4 x1 = acc[ai][bj][m][0] * f * GAINV(bj, 0), x2 = acc[ai][bj][m][1] * f * GAINV(bj, 1);
#ifdef ROPE_HOIST
                        const f32x4 c = bj ? cc_[m] : cr_[ai], s = bj ? sc_[m] : sr_[ai];
#else
                        const int pos = bj ? (t & 63) : (t >> 6); const float* rp = rope + (bj ? 8192 : 0) + pos * 16;
                        const f32x4 c = *(const f32x4*)rp, s = *(const f32x4*)(rp + (bj ? 1024 : 4096));
#endif
                        const f32x4 y1 = x1 * c - x2 * s, y2 = x2 * c + x1 * s;
                        int lo = __builtin_amdgcn_cvt_pk_fp8_f32(y1[0], y1[1], 0, false); lo = __builtin_amdgcn_cvt_pk_fp8_f32(y1[2], y1[3], lo, true);
                        int hi = __builtin_amdgcn_cvt_pk_fp8_f32(y2[0], y2[1], 0, false); hi = __builtin_amdgcn_cvt_pk_fp8_f32(y2[2], y2[3], hi, true);
                        u32x2 w; w.x = (unsigned)lo; w.y = (unsigned)hi;
                        *(u32x2*)(dt + (isq ? 32 * bj : 1024 * bj)) = w;
                    }
                    asm volatile("" ::: "memory");
                }
        } else if (G < 12) {
            unsigned char* V8 = (w2 + WS_VA) + (size_t)(G - 10) * MROWS * 64 + (4 * fq) * 16;
#pragma unroll
            for (int ai = 0; ai < 2; ++ai)
#pragma unroll
                for (int m = 0; m < 4; ++m) {
                    const int rl = ai * HALF + m * 16 + row0; const int t = u.pm * BM + rl; const float rs = rstd[ui * 256 + rl];
                    const int kk = t & 63, c = kk >> 5, r = kk & 31, h = (r >> 2) & 1, jj = (r & 3) + 4 * (r >> 3);
                    unsigned char* vb = V8 + (size_t)(t >> 6) * 4096 + h * 1024 + c * 512 + jj;
#pragma unroll
                    for (int bj = 0; bj < 2; ++bj)
#pragma unroll
                        for (int n = 0; n < 2; ++n) { const f32x4 v = acc[ai][bj][m][n] * rs;
                            const int p01 = __builtin_amdgcn_cvt_pk_fp8_f32(v[0], v[1], 0, false), p23 = __builtin_amdgcn_cvt_pk_fp8_f32(v[2], v[3], 0, false);
                            unsigned char* q = vb + bj * 2048 + (16 * n) * 16;
                            q[0] = (unsigned char)(p01 & 0xff); q[16] = (unsigned char)((p01 >> 8) & 0xff); q[32] = (unsigned char)(p23 & 0xff); q[48] = (unsigned char)((p23 >> 8) & 0xff); }
                    asm volatile("" ::: "memory");
                }
        } else if (G < 28) {
            const bool isq = G < 20;
            const PG8_LAS float* gp = prm + (isq ? PRM_GBQ : PRM_GBK) + 4 * fq;
#ifdef GAIN_HOIST
            const f32x4 gv00_ = *(const PG8_LAS f32x4*)(gp), gv01_ = *(const PG8_LAS f32x4*)(gp + 16), gv10_ = *(const PG8_LAS f32x4*)(gp + 32), gv11_ = *(const PG8_LAS f32x4*)(gp + 48);
#endif
            const float qs = isq ? 0.125f * 1.4426950408889634f : 1.0f;
            bf16_t* db = isq ? (bf16_t*)(w2 + WS_QB) + (size_t)(G - 12) * MROWS * 64 + 8 * fq : (bf16_t*)(w2 + WS_KB) + (size_t)(G - 20) * MROWS * 64 + (size_t)fq * 512;
#pragma unroll
            for (int ai = 0; ai < 2; ++ai)
#pragma unroll
                for (int m = 0; m < 4; ++m) {
                    const int rl = ai * HALF + m * 16 + row0; const int t = u.pm * BM + rl; const float f = head_f(acc, ai, m, rstd[ui * 256 + rl]) * qs;
                    bf16_t* dt = isq ? db + (size_t)t * 64 : db + (size_t)(t >> 6) * 4096 + (t & 63) * 8;
#pragma unroll
                    for (int bj = 0; bj < 2; ++bj) {
                        const f32x4 x1 = acc[ai][bj][m][0] * f * GAINV(bj, 0), x2 = acc[ai][bj][m][1] * f * GAINV(bj, 1);
                        u32x4 w; w.x = cvt_pk_bf16(x1[0], x1[1]); w.y = cvt_pk_bf16(x1[2], x1[3]); w.z = cvt_pk_bf16(x2[0], x2[1]); w.w = cvt_pk_bf16(x2[2], x2[3]);
                        *(u32x4*)(dt + (isq ? 32 * bj : 2048 * bj)) = w;
                    }
                    asm volatile("" ::: "memory");
                }
        } else {
            bf16_t* V = (bf16_t*)(w2 + WS_VB) + (size_t)((G - 28) >> 1) * MROWS * 128 + (64 * ((G - 28) & 1) + 4 * fq) * 8;
#pragma unroll
            for (int ai = 0; ai < 2; ++ai)
#pragma unroll
                for (int m = 0; m < 4; ++m) {
                    const int rl = ai * HALF + m * 16 + row0; const int t = u.pm * BM + rl; const float rs = rstd[ui * 256 + rl];
                    const int kk = t & 63, ks = kk >> 4, ko = kk & 15, hi = (ko >> 2) & 1, j = ((ko >> 3) << 2) | (ko & 3);
                    bf16_t* vb = V + (size_t)(((t >> 6) * 4 + ks) * 2 + hi) * 1024 + j;
#pragma unroll
                    for (int bj = 0; bj < 2; ++bj)
#pragma unroll
                        for (int n = 0; n < 2; ++n)
#pragma unroll
                            for (int e = 0; e < 4; ++e) vb[(32 * bj + 16 * n + e) * 8] = f2bf1(acc[ai][bj][m][n][e] * rs);
                    asm volatile("" ::: "memory");
                }
        }
    }
};
typedef EpiInProjT<0> EpiInProj;

#ifdef PG8_PROBE
#define PG8_PRB(b) (probe & (b))
#else
#define PG8_PRB(b) 0
#endif
#ifndef PG8_NOPRIO
#define PG8_NOPRIO 0
#endif
#ifndef PG8_SPREAD
#define PG8_SPREAD 0
#endif
#ifndef PG8_STAGE_FIRST
#define PG8_STAGE_FIRST 0
#endif
#ifndef NOTAIL
#define NOTAIL 0
#endif
template <int KD, class Epi, class Sched, bool ALIGN_EPI = false, bool SP2 = false, int LD = KD, bool VARK = false>
__device__ __forceinline__ void gemm_phase(PG8_LAS unsigned char* lds, const Gemm g, const Sched& S, const Epi& E, int wave_id, int probe = 0) {
    int tid_ = wave_id * 64 + lane_id_v(); asm volatile("" : "+v"(tid_));
    const int tid = tid_, wid = __builtin_amdgcn_readfirstlane(tid >> 6), lane = tid & 63, wr = wid >> 2, wc = wid & 3, fr = lane & 15, fq = lane >> 4;
    constexpr int K = KD, ntc = K / BK; static_assert(ntc % 2 == 0, "even K-tile count");
    unsigned voffA[2], voffB[2];
#pragma unroll
    for (int i = 0; i < 2; ++i) { int R, C; stage_rc(tid * 16 + i * 8192, R, C); const int Rb = Epi::PERM ? ((R & ~31) + perm32(R & 31)) : R;
        voffA[i] = (unsigned)(R * LD + C) * 2u; voffB[i] = (unsigned)(Rb * LD + C) * 2u; }
    constexpr size_t kstep = (size_t)(BK * 2);
    constexpr size_t hstep = (size_t)HALF * LD * 2;
    constexpr size_t tstep = 2 * hstep;
    const unsigned ldsw = (unsigned)wid * 1024u;
    const int aoff = lds_byte(wr * 64 + fr, fq * 8), boff = lds_byte(wc * 32 + fr, fq * 8);
#define PG8_SA(b, h) (((b) * 2 + (h)) * HTB)
#define PG8_SB(b, h) ((4 + (b) * 2 + (h)) * HTB)
#ifdef PG8_ASMDMA
#define PG8_STAGE(bufoff, gbase, voff) do { if (PG8_PRB(2)) break; _Pragma("unroll") for (int _i = 0; _i < 2; ++_i) \
        asm volatile("s_mov_b32 m0, %2\n\ts_nop 0\n\tglobal_load_lds_dwordx4 %0, %1" :: "v"((voff)[_i]), "s"((const char*)(gbase)), "s"((unsigned)(size_t)(lds + (bufoff) + ldsw + _i * 8192)) : "memory", "m0"); } while (0)
#else
#define PG8_STAGE(bufoff, gbase, voff) do { _Pragma("unroll") for (int _i = 0; _i < 2; ++_i) \
        __builtin_amdgcn_global_load_lds((const unsigned*)((const char*)(gbase) + (voff)[_i]), (PG8_LAS unsigned*)(lds + (bufoff) + ldsw + _i * 8192), 16, 0, 0); } while (0)
#endif
#define PG8_LDA(dst, b, h) do { if (PG8_PRB(4)) break; _Pragma("unroll") for (int m = 0; m < 4; ++m) _Pragma("unroll") for (int k = 0; k < 2; ++k) dst[m][k] = *(const PG8_LAS bf16x8*)(lds + PG8_SA(b, h) + aoff + m * 2048 + k * 1024); } while (0)
#define PG8_LDB(dst, b, h) do { if (PG8_PRB(4)) break; _Pragma("unroll") for (int n = 0; n < 2; ++n) _Pragma("unroll") for (int k = 0; k < 2; ++k) dst[n][k] = *(const PG8_LAS bf16x8*)(lds + PG8_SB(b, h) + boff + n * 2048 + k * 1024); } while (0)
#define PG8_MMA(ai, bj, At, Bt) do { if (PG8_PRB(32)) break; if (!PG8_NOPRIO) __builtin_amdgcn_s_setprio(1); _Pragma("unroll") for (int m = 0; m < 4; ++m) _Pragma("unroll") for (int n = 0; n < 2; ++n) _Pragma("unroll") for (int k = 0; k < 2; ++k) \
        acc[ai][bj][m][n] = __builtin_amdgcn_mfma_f32_16x16x32_bf16(Bt[n][k], At[m][k], acc[ai][bj][m][n], 0, 0, 0); if (!PG8_NOPRIO) __builtin_amdgcn_s_setprio(0); } while (0)
#define PG8_WAIT_V(n) asm volatile("s_waitcnt vmcnt(" #n ")" ::: "memory")
#define PG8_WAIT_L(n) asm volatile("s_waitcnt lgkmcnt(" #n ")" ::: "memory")
#define PG8_BAR do { if (!PG8_PRB(16)) __builtin_amdgcn_s_barrier(); } while (0)
#define PG8_SCHED __builtin_amdgcn_sched_barrier(0)
    Unit cur, nxt; int ui = 0;
    if (!S.next(0, cur)) return;
    f32x4 acc[2][2][4][2];
#pragma unroll
    for (int a = 0; a < 2; ++a)
#pragma unroll
        for (int b = 0; b < 2; ++b)
#pragma unroll
            for (int m = 0; m < 4; ++m)
#pragma unroll
                for (int n = 0; n < 2; ++n) acc[a][b][m][n] = (f32x4){0.f, 0.f, 0.f, 0.f};
    bf16x8 At[4][2], B0[2][2], B1[2][2];
    const char* cA = (const char*)g.A + (size_t)cur.pm * tstep + (VARK ? cur.kofs : 0); const char* cB = (const char*)g.Bt + (size_t)cur.pn * tstep + (VARK ? cur.kofs : 0);
    S.a_ready(cur);
    if constexpr (SP2) {
        PG8_STAGE(PG8_SB(0, 0), cB, voffB); PG8_STAGE(PG8_SB(0, 1), cB + hstep, voffB); PG8_STAGE(PG8_SA(0, 0), cA, voffA); PG8_STAGE(PG8_SA(0, 1), cA + hstep, voffA);
        if (wr == 1) PG8_BAR;
        PG8_WAIT_V(2); PG8_BAR;
        PG8_STAGE(PG8_SB(1, 0), cB + kstep, voffB); PG8_STAGE(PG8_SA(1, 0), cA + kstep, voffA); PG8_STAGE(PG8_SB(1, 1), cB + hstep + kstep, voffB);
        PG8_WAIT_V(6); PG8_BAR;
    } else {
        PG8_STAGE(PG8_SB(0, 0), cB, voffB); PG8_STAGE(PG8_SA(0, 0), cA, voffA); PG8_STAGE(PG8_SB(0, 1), cB + hstep, voffB); PG8_STAGE(PG8_SA(0, 1), cA + hstep, voffA);
        if (wr == 1) PG8_BAR;
        PG8_WAIT_V(4); PG8_BAR;
        PG8_STAGE(PG8_SB(1, 0), cB + kstep, voffB); PG8_STAGE(PG8_SA(1, 0), cA + kstep, voffA); PG8_STAGE(PG8_SB(1, 1), cB + hstep + kstep, voffB);
        PG8_WAIT_V(6); PG8_BAR;
    }
    for (;;) {
        const bool has_next = S.next(ui + 1, nxt);
        const char* nA = has_next ? (const char*)g.A + (size_t)nxt.pm * tstep + (VARK ? nxt.kofs : 0) : cA; const char* nB = has_next ? (const char*)g.Bt + (size_t)nxt.pn * tstep + (VARK ? nxt.kofs : 0) : cB;
        const int nt = VARK ? cur.nt : ntc;
        for (int t = 0; t < nt; t += 2) {
            const bool last = (t == nt - 2); const bool fin = last && !has_next;
            const char* a1 = cA + (size_t)(t + 1) * kstep;
            const char* a2 = last ? nA : cA + (size_t)(t + 2) * kstep; const char* b2 = last ? nB : cB + (size_t)(t + 2) * kstep;
            const char* a3 = a2 + kstep; const char* b3 = b2 + kstep;
            if (last && has_next) S.a_ready(nxt);
            if constexpr (SP2) {
            if (PG8_STAGE_FIRST) { PG8_STAGE(PG8_SA(1, 1), a1 + hstep, voffA); PG8_SCHED; } PG8_LDB(B0, 0, 0); PG8_LDB(B1, 0, 1); PG8_SCHED; PG8_LDA(At, 0, 0); if (!PG8_STAGE_FIRST) { PG8_STAGE(PG8_SA(1, 1), a1 + hstep, voffA); }
            PG8_WAIT_V(8); PG8_WAIT_L(0); PG8_BAR; PG8_MMA(0, 0, At, B0); PG8_MMA(0, 1, At, B1); PG8_BAR; PG8_SCHED;
            if (!PG8_STAGE_FIRST) { PG8_LDA(At, 0, 1); } if (NOTAIL && fin) { if (PG8_STAGE_FIRST) { PG8_LDA(At, 0, 1); } PG8_WAIT_V(2); } else { PG8_STAGE(PG8_SB(0, 0), b2, voffB); PG8_STAGE(PG8_SB(0, 1), b2 + hstep, voffB); if (!PG8_SPREAD) { PG8_STAGE(PG8_SA(0, 0), a2, voffA); } if (PG8_STAGE_FIRST) { PG8_SCHED; PG8_LDA(At, 0, 1); } if (PG8_SPREAD) { PG8_WAIT_V(6); } else { PG8_WAIT_V(8); } }
            PG8_WAIT_L(0); PG8_BAR; PG8_MMA(1, 0, At, B0); if (PG8_SPREAD && !(NOTAIL && fin)) { PG8_SCHED; PG8_STAGE(PG8_SA(0, 0), a2, voffA); PG8_SCHED; } PG8_MMA(1, 1, At, B1); PG8_BAR; PG8_SCHED;
            if (PG8_STAGE_FIRST && !(NOTAIL && fin)) { PG8_STAGE(PG8_SA(0, 1), a2 + hstep, voffA); PG8_SCHED; } PG8_LDB(B0, 1, 0); PG8_LDB(B1, 1, 1); PG8_SCHED; PG8_LDA(At, 1, 0); if (NOTAIL && fin) { PG8_WAIT_V(0); } else { if (!PG8_STAGE_FIRST) { PG8_STAGE(PG8_SA(0, 1), a2 + hstep, voffA); } PG8_WAIT_V(8); }
            PG8_WAIT_L(0); PG8_BAR; PG8_MMA(0, 0, At, B0); PG8_MMA(0, 1, At, B1); PG8_BAR; PG8_SCHED;
            if (!PG8_STAGE_FIRST) { PG8_LDA(At, 1, 1); } if (!(NOTAIL && fin)) { PG8_STAGE(PG8_SB(1, 0), b3, voffB); PG8_STAGE(PG8_SB(1, 1), b3 + hstep, voffB); if (!PG8_SPREAD) { PG8_STAGE(PG8_SA(1, 0), a3, voffA); } if (PG8_STAGE_FIRST) { PG8_SCHED; PG8_LDA(At, 1, 1); } if (PG8_SPREAD) { PG8_WAIT_V(6); } else { PG8_WAIT_V(8); } } else if (PG8_STAGE_FIRST) { PG8_LDA(At, 1, 1); }
            PG8_WAIT_L(0); PG8_BAR; PG8_MMA(1, 0, At, B0); if (PG8_SPREAD && !(NOTAIL && fin)) { PG8_SCHED; PG8_STAGE(PG8_SA(1, 0), a3, voffA); PG8_SCHED; } PG8_MMA(1, 1, At, B1); PG8_BAR; PG8_SCHED;
            } else {
            PG8_LDB(B0, 0, 0); PG8_SCHED; PG8_LDA(At, 0, 0); PG8_STAGE(PG8_SA(1, 1), a1 + hstep, voffA);
            PG8_WAIT_L(8); PG8_BAR; PG8_WAIT_L(0); PG8_MMA(0, 0, At, B0); PG8_BAR; PG8_SCHED;
            PG8_LDB(B1, 0, 1); PG8_STAGE(PG8_SB(0, 0), b2, voffB);
            PG8_BAR; PG8_WAIT_L(0); PG8_MMA(0, 1, At, B1); PG8_BAR;
            PG8_LDA(At, 0, 1); PG8_STAGE(PG8_SA(0, 0), a2, voffA);
            PG8_BAR; PG8_WAIT_L(0); PG8_MMA(1, 0, At, B0); PG8_BAR; PG8_SCHED;
            PG8_STAGE(PG8_SB(0, 1), b2 + hstep, voffB);
            PG8_WAIT_V(6); PG8_BAR; PG8_MMA(1, 1, At, B1); PG8_BAR;
            PG8_LDB(B0, 1, 0); PG8_SCHED; PG8_LDA(At, 1, 0); PG8_STAGE(PG8_SA(0, 1), a2 + hstep, voffA);
            PG8_WAIT_L(8); PG8_BAR; PG8_WAIT_L(0); PG8_MMA(0, 0, At, B0); PG8_BAR; PG8_SCHED;
            PG8_LDB(B1, 1, 1); PG8_STAGE(PG8_SB(1, 0), b3, voffB);
            PG8_BAR; PG8_WAIT_L(0); PG8_MMA(0, 1, At, B1); PG8_BAR;
            PG8_LDA(At, 1, 1); PG8_STAGE(PG8_SA(1, 0), a3, voffA);
            PG8_BAR; PG8_WAIT_L(0); PG8_MMA(1, 0, At, B0); PG8_BAR; PG8_SCHED;
            PG8_STAGE(PG8_SB(1, 1), b3 + hstep, voffB);
            PG8_WAIT_V(6); PG8_BAR; PG8_MMA(1, 1, At, B1); PG8_BAR;
            }
        }
        if constexpr (ALIGN_EPI) { if (wr == 0) PG8_BAR; }
        if constexpr (!Epi::AFTER_DRAIN) { E(acc, cur, ui, wr, wc, fr, fq); S.done(cur); }
        if (!has_next) break;
#pragma unroll
        for (int a = 0; a < 2; ++a)
#pragma unroll
            for (int b = 0; b < 2; ++b)
#pragma unroll
                for (int m = 0; m < 4; ++m)
#pragma unroll
                    for (int n = 0; n < 2; ++n) acc[a][b][m][n] = (f32x4){0.f, 0.f, 0.f, 0.f};
        cur = nxt; cA = nA; cB = nB; ++ui;
        if constexpr (ALIGN_EPI) { if (wr == 1) PG8_BAR; }
    }
    PG8_WAIT_V(0);
    if constexpr (!ALIGN_EPI) { if (wr == 0) PG8_BAR; }
    PG8_BAR;
    if constexpr (Epi::AFTER_DRAIN) { E.fused(acc, cur, wr, wc, fr, fq, lds, wid, lane); S.done(cur); }
#undef PG8_SA
#undef PG8_SB
#undef PG8_STAGE
#undef PG8_LDA
#undef PG8_LDB
#undef PG8_MMA
#undef PG8_WAIT_V
#undef PG8_WAIT_L
#undef PG8_BAR
#undef PG8_SCHED
}
}
namespace att {
typedef unsigned short bf16_t;
typedef short bf16x8 __attribute__((ext_vector_type(8)));
typedef float f32x16 __attribute__((ext_vector_type(16)));
typedef float f32x4 __attribute__((ext_vector_type(4)));
typedef unsigned u32x4 __attribute__((ext_vector_type(4)));
#define ALAS __attribute__((address_space(3)))
constexpr int MROWS = M;
constexpr int WSF_OFF = 114688;
constexpr int LDS_NEED = WSF_OFF + 8 * 256;
__device__ __forceinline__ int crow(int r, int hi) { return (r & 3) + 8 * (r >> 2) + 4 * hi; }
__device__ __forceinline__ void glds16(const void* gsrc, unsigned lds_dst) { unsigned keep;
    asm volatile("s_mov_b32 %0, m0\n\ts_mov_b32 m0, %2\n\ts_nop 0\n\tglobal_load_lds_dwordx4 %1, off\n\ts_mov_b32 m0, %0" : "=&s"(keep) : "v"(gsrc), "s"(lds_dst) : "memory"); }
typedef float f32x2_t __attribute__((ext_vector_type(2))); typedef __bf16 bf16x2_t __attribute__((ext_vector_type(2)));
__device__ __forceinline__ unsigned cvtpk(float lo, float hi) { f32x2_t v = {lo, hi}; bf16x2_t b = __builtin_convertvector(v, bf16x2_t); return __builtin_bit_cast(unsigned, b); }
__device__ __forceinline__ void glds16s(const void* sbase, unsigned voff, unsigned lds_dst) { unsigned keep;
#ifdef GLDS_M0_CLOBBER
    (void)keep; asm volatile("s_mov_b32 m0, %2\n\ts_nop 0\n\tglobal_load_lds_dwordx4 %0, %1" :: "v"(voff), "s"(sbase), "s"(lds_dst) : "memory", "m0"); }
#else
    asm volatile("s_mov_b32 %0, m0\n\ts_mov_b32 m0, %3\n\ts_nop 0\n\tglobal_load_lds_dwordx4 %1, %2\n\ts_mov_b32 m0, %0" : "=&s"(keep) : "v"(voff), "s"(sbase), "s"(lds_dst) : "memory"); }
#endif
#define ATT_WAIT_BAR(N) asm volatile("s_waitcnt vmcnt(" #N ") lgkmcnt(0)\n\ts_barrier" ::: "memory")
#define ATT_MFMA(a, b, c) __builtin_amdgcn_mfma_f32_32x32x16_bf16(a, b, c, 0, 0, 0)

struct Tensors { unsigned char* ws; const ALAS float* subln; };
__device__ __forceinline__ Tensors make_tensors(unsigned char* ws, const ALAS float* prm) { return Tensors{ws, prm + PRM_SUBLN}; }
#define T_QA ((const bf16_t*)(tws_ + WS_QA))
#define T_KA ((const bf16_t*)(tws_ + WS_KA))
#define T_VA ((const bf16_t*)(tws_ + WS_VA))
#define T_QB ((const bf16_t*)(tws_ + WS_QB))
#define T_KB ((const bf16_t*)(tws_ + WS_KB))
#define T_VB ((const bf16_t*)(tws_ + WS_VB))
#define T_MIX ((bf16_t*)(tws_ + WS_MIX))

#define SBAR() __builtin_amdgcn_sched_barrier(0)
#define PIN(x) asm volatile("" : "+v"(x))
#define PKW(P, B) cvtpk(P[B], P[(B) + 1])
#define EX(v) __builtin_amdgcn_exp2f(v)
#define WB_SEL(n) do { switch (n) { case 0: ATT_WAIT_BAR(0); break; case 1: ATT_WAIT_BAR(1); break; case 2: ATT_WAIT_BAR(2); break; case 3: ATT_WAIT_BAR(3); break; case 4: ATT_WAIT_BAR(4); break; case 6: ATT_WAIT_BAR(6); break; default: ATT_WAIT_BAR(8); } } while (0)
template <bool ISB, int BPROBE = 0>
__device__ __forceinline__ void attn_unit(const Tensors& T, int head, int qb, float negM2, float lam, float c2, int dskip, char* shm, int wave_id) {
    unsigned char* tws_ = T.ws; LAUNDER_G(tws_);
    constexpr int DV = ISB ? 128 : 64, ND0 = DV / 32, NK = ISB ? 2 : 1, NV = ISB ? 2 : 1;
    constexpr int KSLOT = ISB ? 16384 : 8192, VSLOT = ISB ? 16384 : 8192, LDS_K = 0, LDS_V = 3 * KSLOT;
    int tid_ = wave_id * 64 + lane_id_v(); asm volatile("" : "+v"(tid_));
    const int tid = tid_, lane = tid & 63, r32 = lane & 31, hi = lane >> 5; const int wid = __builtin_amdgcn_readfirstlane(tid >> 6);
    const int mapc = ISB ? (wid >> 2) : 0, wq = ISB ? (wid & 3) : wid;
    const int q0 = ISB ? qb * 128 : qb * 256; const int qrow = q0 + wq * 32 + r32;
    int t0 = 0, t1 = 256;
    if (ISB) { const int lo = q0 - dskip, hi_ = q0 + 127 + dskip; t0 = lo > 0 ? (lo >> 6) : 0; t1 = (hi_ >> 6) + 1; if (t1 > 256) t1 = 256;
        if ((t1 - t0) & 1) { if (t0 > 0) --t0; else ++t1; } }
    const int n = t1 - t0;
    const unsigned lds0 = (unsigned)(uintptr_t)shm;
    const ALAS char* shm3 = (const ALAS char*)shm;
    const char* k1b = ISB ? (const char*)(T_KB + (size_t)(2 * head) * MROWS * 64) + (size_t)t0 * 8192 : (const char*)(T_KA + (size_t)(head >> 2) * MROWS * 64);
    const char* k2b = ISB ? (const char*)(T_KB + (size_t)(2 * head + 1) * MROWS * 64) + (size_t)t0 * 8192 : nullptr;
    const char* vb_ = ISB ? (const char*)(T_VB + (size_t)head * MROWS * 128) + (size_t)t0 * 16384 : (const char*)(T_VA + (size_t)(head >> 2) * MROWS * 64);
    const unsigned dvo = (unsigned)(wid * 1024 + lane * 16);
    const unsigned kdst = lds0 + LDS_K + wid * 1024, vdst = lds0 + LDS_V + wid * 1024;
#define DMA_K1(i, so) glds16s(k1b + (size_t)(i) * 8192, dvo, (unsigned)__builtin_amdgcn_readfirstlane(kdst + (so)))
#define DMA_K2(i, so) glds16s(k2b + (size_t)(i) * 8192, dvo, (unsigned)__builtin_amdgcn_readfirstlane(kdst + (so) + 8192))
#define DMA_K(i, so) do { glds16s(k1b + (size_t)(i) * 8192, dvo, (unsigned)__builtin_amdgcn_readfirstlane(kdst + (so))); if (ISB) glds16s(k2b + (size_t)(i) * 8192, dvo, (unsigned)__builtin_amdgcn_readfirstlane(kdst + (so) + 8192)); } while (0)
#define DMA_V0(i, so) glds16s(vb_ + (size_t)(i) * 16384, dvo, (unsigned)__builtin_amdgcn_readfirstlane(vdst + (so)))
#define DMA_V1(i, so) glds16s(vb_ + (size_t)(i) * 16384 + 8192, dvo, (unsigned)__builtin_amdgcn_readfirstlane(vdst + (so) + 8192))
#define DMA_V(i, so) do { if (ISB) { glds16s(vb_ + (size_t)(i) * 16384, dvo, (unsigned)__builtin_amdgcn_readfirstlane(vdst + (so))); glds16s(vb_ + (size_t)(i) * 16384 + 8192, dvo, (unsigned)__builtin_amdgcn_readfirstlane(vdst + (so) + 8192)); } \
      else glds16s(vb_ + (size_t)(i) * 8192, dvo, (unsigned)__builtin_amdgcn_readfirstlane(vdst + (so))); } while (0)
    DMA_K(0, 0); DMA_V(0, 0); DMA_K(1, KSLOT); DMA_V(1, VSLOT);
    const bf16_t* Qw = (ISB ? T_QB + (size_t)(2 * head + mapc) * MROWS * 64 : T_QA + (size_t)head * MROWS * 64) + (size_t)qrow * 64;
    bf16x8 qr[4];
#pragma unroll
    for (int d0 = 0; d0 < 4; ++d0) qr[d0] = *(const bf16x8*)(Qw + d0 * 16 + hi * 8);
    f32x16 o[ND0];
#pragma unroll
    for (int d = 0; d < ND0; ++d) o[d] = f32x16{};
    f32x16 negm;
#pragma unroll
    for (int r = 0; r < 16; ++r) negm[r] = negM2;
    asm volatile("" : "+v"(negm));
    float l_reg = 0.f;
    f32x16 osum = f32x16{}; bf16x8 ones; { const short o1 = (short)0x3f80; ones = (bf16x8){o1, o1, o1, o1, o1, o1, o1, o1}; } asm volatile("" : "+v"(ones));
    const ALAS char* kp0 = shm3 + LDS_K + (ISB ? mapc * 8192 : 0) + hi * 1024 + r32 * 16;
    const ALAS char* vp0 = shm3 + LDS_V + hi * (DV * 16) + r32 * 16;
    const int qw_lo = q0 + wq * 32, qw_hi = qw_lo + 31;
    const float nc2 = -c2; const float dl0 = (float)(64 * t0 - qrow + 4 * hi);
#define BIAS_GEN4(X, B, DC) do { const float e1_ = (DC) + 1.0f, e2_ = (DC) + 2.0f, e3_ = e1_ + 2.0f; \
        X[B] = __builtin_fmaf(__builtin_fabsf(DC), nc2, negM2); X[(B) + 1] = __builtin_fmaf(__builtin_fabsf(e1_), nc2, negM2); X[(B) + 2] = __builtin_fmaf(__builtin_fabsf(e2_), nc2, negM2); X[(B) + 3] = __builtin_fmaf(__builtin_fabsf(e3_), nc2, negM2); DC += 8.0f; } while (0)
#define BIAS_FAST4(X, B, DC) do { X[B] = __builtin_fmaf(sc1_, (DC), negM2); float t1_ = X[B] + sc1_; asm volatile("" : "+v"(t1_)); float t2_ = X[B] + sc2_; asm volatile("" : "+v"(t2_)); X[(B) + 1] = t1_; X[(B) + 2] = t2_; X[(B) + 3] = X[B] + sc3_; DC += 8.0f; } while (0)
#define BIAS_ALL(X0, X1, DL) do { float dc_ = (DL); BIAS_GEN4(X0, 0, dc_); BIAS_GEN4(X0, 4, dc_); BIAS_GEN4(X0, 8, dc_); BIAS_GEN4(X0, 12, dc_); BIAS_GEN4(X1, 0, dc_); BIAS_GEN4(X1, 4, dc_); BIAS_GEN4(X1, 8, dc_); BIAS_GEN4(X1, 12, dc_); } while (0)
#ifdef BIAS_CONST
    float cst[32];
#pragma unroll
    for (int e = 0; e < 32; ++e) { float cv_ = c2 * (float)(8 * (e >> 2) + (e & 3)); asm volatile("" : "+v"(cv_)); cst[e] = __builtin_bit_cast(float, __builtin_amdgcn_readfirstlane(__builtin_bit_cast(int, cv_))); }
#define BIAS_STEP_SETUP() const float base_ = __builtin_fmaf(sc1_, dcn_, negM2); float sgn_ = above_ ? -1.0f : 1.0f; asm volatile("" : "+v"(sgn_))
#else
#define BIAS_STEP_SETUP() do {} while (0)
#endif
    f32x16 pA0, pA1, pB0, pB1;
    bf16x8 kf[8], vf[B_VF8 ? 8 : 4]; u32x4 pw0, pw1, pw2, pw3;
    int ks_prev = 0, ks_cur = 0, ks_next = KSLOT, vs_prev = 0, vs_cur = VSLOT, vs_next = 2 * VSLOT, vs_n2 = 3 * VSLOT;
#define ROTK() do { ks_prev = ks_cur; ks_cur = ks_next; ks_next = (ks_next == 2 * KSLOT) ? 0 : ks_next + KSLOT; } while (0)
#define ROT() do { ROTK(); const int tv_ = vs_prev; vs_prev = vs_cur; vs_cur = vs_next; vs_next = vs_n2; vs_n2 = tv_; } while (0)
    DMA_K(2, 2 * KSLOT);
    WB_SEL(2 * NV + 2 * NK);
    if (ISB) { BIAS_ALL(pA0, pA1, dl0); } else { pA0 = negm; pA1 = negm; }
    {
        const ALAS char* kp = kp0;
#pragma unroll
        for (int d0 = 0; d0 < 4; ++d0) { const bf16x8 b0 = *(const ALAS bf16x8*)(kp + d0 * 2048), b1 = *(const ALAS bf16x8*)(kp + d0 * 2048 + 512);
            pA0 = ATT_MFMA(b0, qr[d0], pA0); pA1 = ATT_MFMA(b1, qr[d0], pA1); }
#pragma unroll
        for (int r = 0; r < 16; ++r) { pA0[r] = EX(pA0[r]); pA1[r] = EX(pA1[r]); }
    }
    WB_SEL(0);
    DMA_K(3, 0); DMA_V(2, 2 * VSLOT);
    ROTK();
#define KLOAD2(base, j) do { kf[2 * (j)] = *(const ALAS bf16x8*)((base) + (j) * 2048); kf[2 * (j) + 1] = *(const ALAS bf16x8*)((base) + (j) * 2048 + 512); } while (0)
    { const ALAS char* kb_ = kp0 + ks_cur; KLOAD2(kb_, 0); KLOAD2(kb_, 1); KLOAD2(kb_, 2); KLOAD2(kb_, 3); }
    if (ISB) { BIAS_ALL(pB0, pB1, dl0 + 64.f); }
    WB_SEL(NK + NV);
#define PAF(k) __builtin_bit_cast(bf16x8, pw##k)
#if (B_ORDER & 1)
#define GAPA(MF, A0, A1, A2, A3, W0, W1, PW) do { if (ISB) { sacc += A0; sacc += A1; sacc += A2; sacc += A3; PIN(sacc); } W0; W1; PIN(PW); SBAR(); MF; SBAR(); } while (0)
#else
#define GAPA(MF, A0, A1, A2, A3, W0, W1, PW) do { MF; if (ISB) { sacc += A0; sacc += A1; sacc += A2; sacc += A3; PIN(sacc); } W0; W1; PIN(PW); SBAR(); } while (0)
#endif
#define GAPB(MF, X, B) do { MF; X[B] = EX(X[B]); X[(B) + 1] = EX(X[(B) + 1]); X[(B) + 2] = EX(X[(B) + 2]); X[(B) + 3] = EX(X[(B) + 3]); PIN(X); SBAR(); } while (0)
#define GAPX(MF, EXS, X) do { MF; EXS; PIN(X); SBAR(); } while (0)
#define EXB(v) ((BPROBE & 1) ? __builtin_fmaxf((v), 1.0f) : EX(v))
#define EXE(C0, C1, k) do { if ((k) < 16) C0[(k) & 15] = EXB(C0[(k) & 15]); else C1[(k) & 15] = EXB(C1[(k) & 15]); } while (0)
#define EXN(C0, C1, k, N) do { EXE(C0, C1, k); if ((N) > 1) EXE(C0, C1, (k) + 1); if ((N) > 2) EXE(C0, C1, (k) + 2); } while (0)
#if (B_ORDER & 2)
#define GAPEN(MF, C0, C1, k, N) do { EXN(C0, C1, k, N); PIN(C0); PIN(C1); SBAR(); MF; SBAR(); } while (0)
#else
#define GAPEN(MF, C0, C1, k, N) do { MF; EXN(C0, C1, k, N); PIN(C0); PIN(C1); SBAR(); } while (0)
#endif
#if B_SPLIT == 0
#define EK_0 0
#define EN_0 3
#define EK_1 3
#define EN_1 2
#define EK_2 5
#define EN_2 3
#define EK_3 8
#define EN_3 2
#define EK_4 10
#define EN_4 3
#define EK_5 13
#define EN_5 2
#define EK_6 15
#define EN_6 3
#define EK_7 18
#define EN_7 2
#define EK_8 20
#define EN_8 2
#define EK_9 22
#define EN_9 1
#define EK_10 23
#define EN_10 2
#define EK_11 25
#define EN_11 1
#define EK_12 26
#define EN_12 2
#define EK_13 28
#define EN_13 1
#define EK_14 29
#define EN_14 2
#define EK_15 31
#define EN_15 1
#elif B_SPLIT == 1
#define EK_0 0
#define EN_0 3
#define EK_1 3
#define EN_1 2
#define EK_2 5
#define EN_2 2
#define EK_3 7
#define EN_3 2
#define EK_4 9
#define EN_4 3
#define EK_5 12
#define EN_5 2
#define EK_6 14
#define EN_6 2
#define EK_7 16
#define EN_7 2
#define EK_8 18
#define EN_8 2
#define EK_9 20
#define EN_9 2
#define EK_10 22
#define EN_10 2
#define EK_11 24
#define EN_11 1
#define EK_12 25
#define EN_12 2
#define EK_13 27
#define EN_13 2
#define EK_14 29
#define EN_14 2
#define EK_15 31
#define EN_15 1
#elif B_SPLIT == 3
#define EK_0 0
#define EN_0 3
#define EK_1 3
#define EN_1 3
#define EK_2 6
#define EN_2 3
#define EK_3 9
#define EN_3 3
#define EK_4 12
#define EN_4 3
#define EK_5 15
#define EN_5 3
#define EK_6 18
#define EN_6 3
#define EK_7 21
#define EN_7 3
#define EK_8 24
#define EN_8 1
#define EK_9 25
#define EN_9 1
#define EK_10 26
#define EN_10 1
#define EK_11 27
#define EN_11 1
#define EK_12 28
#define EN_12 1
#define EK_13 29
#define EN_13 1
#define EK_14 30
#define EN_14 1
#define EK_15 31
#define EN_15 1
#elif B_SPLIT == 2
#define EK_0 0
#define EN_0 3
#define EK_1 3
#define EN_1 3
#define EK_2 6
#define EN_2 3
#define EK_3 9
#define EN_3 2
#define EK_4 11
#define EN_4 3
#define EK_5 14
#define EN_5 3
#define EK_6 17
#define EN_6 3
#define EK_7 20
#define EN_7 2
#define EK_8 22
#define EN_8 2
#define EK_9 24
#define EN_9 1
#define EK_10 25
#define EN_10 1
#define EK_11 26
#define EN_11 1
#define EK_12 27
#define EN_12 2
#define EK_13 29
#define EN_13 1
#define EK_14 30
#define EN_14 1
#define EK_15 31
#define EN_15 1
#endif
#define GAPE3(MF, C0, C1, k) do { MF; EXE(C0, C1, k); EXE(C0, C1, (k) + 1); EXE(C0, C1, (k) + 2); PIN(C0); PIN(C1); SBAR(); } while (0)
#ifdef BIAS_CONST
#define GAPC(MF, G, X, B, E0) do { MF; if (G) { { float a0_ = __builtin_fmaf(sgn_, cst[(E0) + (B)], base_), a1_ = __builtin_fmaf(sgn_, cst[(E0) + (B) + 1], base_), a2_ = __builtin_fmaf(sgn_, cst[(E0) + (B) + 2], base_), a3_ = __builtin_fmaf(sgn_, cst[(E0) + (B) + 3], base_); asm volatile("" : "+v"(a0_), "+v"(a1_), "+v"(a2_), "+v"(a3_)); X[B] = a0_; X[(B) + 1] = a1_; X[(B) + 2] = a2_; X[(B) + 3] = a3_; } \
        if (__builtin_expect(!fastb_, 0)) { float dg_ = dcn_ + (float)(8 * (((E0) + (B)) >> 2)); BIAS_GEN4(X, B, dg_); } PIN(X); } SBAR(); } while (0)
#else
#define GAPC(MF, G, X, B, E0) do { MF; if (G) { BIAS_FAST4(X, B, dcn_); if (__builtin_expect(!fastb_, 0)) { float dg_ = dcn_ - 8.0f; BIAS_GEN4(X, B, dg_); } PIN(X); } SBAR(); } while (0)
#endif
#define VRD(i) do { if (!(BPROBE & 4)) vf[i] = *(const ALAS bf16x8*)(vp_ + ((i) & 3) * (DV * 32) + ((i) >> 2) * 512); } while (0)
#define VRDN(i, d) do { if (!(BPROBE & 4)) vf[i] = *(const ALAS bf16x8*)(vp_ + (i) * (DV * 32) + (d) * 512); } while (0)
#define VRDX(slot, ks, d) do { if (!(BPROBE & 4)) vf[slot] = *(const ALAS bf16x8*)(vp_ + (ks) * (DV * 32) + (d) * 512); } while (0)
#define VRDA(i) do { vf[i] = *(const ALAS bf16x8*)(vp_ + (i) * (DV * 32) + 512); } while (0)
#define VRD2(i) do { vf[i] = *(const ALAS bf16x8*)(vp_ + ((i) & 3) * (DV * 32) + (((i) >> 2) + 2) * 512); } while (0)
#define KRD(G, j) do { if (G) { KLOAD2(kn_, j); SBAR(); } } while (0)
#define KRD1(G, j) do { if ((G) && !(BPROBE & 4)) { kf[j] = *(const ALAS bf16x8*)(kn_ + ((j) >> 1) * 2048 + ((j) & 1) * 512); SBAR(); } } while (0)
#define CIN(C) (ISB ? C : negm)
#define STEP(C0, C1, P0, P1, i, GK, GV, GL) do { SBAR(); \
    const ALAS char* vp_ = vp0 + vs_prev; const ALAS char* kn_ = kp0 + ks_next; float dcn_ = dl0 + 64.f * (float)((i) + 1); const int kt_ = 64 * (t0 + (i) + 1); const bool above_ = kt_ > qw_hi, fastb_ = above_ || (kt_ + 63 < qw_lo); \
    const float sc1_ = above_ ? nc2 : c2, sc2_ = sc1_ + sc1_, sc3_ = sc2_ + sc1_; BIAS_STEP_SETUP(); \
    if (BDMA_MODE == 11 && !(BPROBE & 2)) { if (GK) { DMA_K((i) + 3, ks_cur); } SBAR(); } \
    VRD(0); SBAR(); float sacc = P0[0] + P0[1]; \
    GAPA(C0 = ATT_MFMA(kf[0], qr[0], CIN(C0)), P0[2], P0[3], P0[4], P0[5],     pw0[0] = PKW(P0, 0), pw0[1] = PKW(P0, 2), pw0); \
    if (B_VF8) { VRDX(4, 0, 1); } SBAR(); GAPA(C1 = ATT_MFMA(kf[1], qr[0], CIN(C1)), P0[6], P0[7], P0[8], P0[9],     pw0[2] = PKW(P0, 4), pw0[3] = PKW(P0, 6), pw0); \
    VRD(1); SBAR(); GAPA(C0 = ATT_MFMA(kf[2], qr[1], C0),   P0[10], P0[11], P0[12], P0[13], pw1[0] = PKW(P0, 8), pw1[1] = PKW(P0, 10), pw1); \
    if (B_VF8) { VRDX(5, 1, 1); } SBAR(); GAPA(C1 = ATT_MFMA(kf[3], qr[1], C1),   P0[14], P0[15], P1[0], P1[1],   pw1[2] = PKW(P0, 12), pw1[3] = PKW(P0, 14), pw1); \
    if (BDMA_MODE == 9 && !(BPROBE & 2)) { if (GK) { DMA_K1((i) + 3, ks_cur); } SBAR(); } \
    VRD(2); SBAR(); GAPA(C0 = ATT_MFMA(kf[4], qr[2], C0),   P1[2], P1[3], P1[4], P1[5],     pw2[0] = PKW(P1, 0), pw2[1] = PKW(P1, 2), pw2); \
    if (B_VF8) { VRDX(6, 2, 1); } SBAR(); GAPA(C1 = ATT_MFMA(kf[5], qr[2], C1),   P1[6], P1[7], P1[8], P1[9],     pw2[2] = PKW(P1, 4), pw2[3] = PKW(P1, 6), pw2); \
    VRD(3); SBAR(); GAPA(C0 = ATT_MFMA(kf[6], qr[3], C0),   P1[10], P1[11], P1[12], P1[13], pw3[0] = PKW(P1, 8), pw3[1] = PKW(P1, 10), pw3); \
    if (B_VF8) { VRDX(7, 3, 1); } SBAR(); GAPA(C1 = ATT_MFMA(kf[7], qr[3], C1),   P1[14], P1[15], 0.f, 0.f,       pw3[2] = PKW(P1, 12), pw3[3] = PKW(P1, 14), pw3); \
    l_reg += sacc; \
    if (!(BPROBE & 2)) { if (BDMA_MODE == 7 || BDMA_MODE == 10) { if (GK) { DMA_K1((i) + 3, ks_cur); } } if (BDMA_MODE == 9) { if (GK) { DMA_K2((i) + 3, ks_cur); } } if (BDMA_MODE < 4 || BDMA_MODE == 6 || BDMA_MODE == 8) { if (GK) { DMA_K((i) + 3, ks_cur); } } if (BDMA_MODE == 0 || BDMA_MODE == 4) { if (GV) { DMA_V((i) + 2, vs_n2); } } } \
    SBAR(); \
    if (!ISB) { \
        GAPX(o[0] = ATT_MFMA(PAF(0), vf[0], o[0]), C0[0] = EX(C0[0]); C0[1] = EX(C0[1]); C0[2] = EX(C0[2]), C0); \
        VRDA(0); SBAR(); GAPX(o[0] = ATT_MFMA(PAF(1), vf[1], o[0]), C0[3] = EX(C0[3]); C0[4] = EX(C0[4]); C0[5] = EX(C0[5]), C0); \
        VRDA(1); SBAR(); GAPX(osum = ATT_MFMA(PAF(0), ones, osum),  C0[6] = EX(C0[6]); C0[7] = EX(C0[7]); C0[8] = EX(C0[8]), C0); \
        GAPX(o[0] = ATT_MFMA(PAF(2), vf[2], o[0]), C0[9] = EX(C0[9]); C0[10] = EX(C0[10]); C0[11] = EX(C0[11]), C0); \
        VRDA(2); SBAR(); GAPX(o[0] = ATT_MFMA(PAF(3), vf[3], o[0]), C0[12] = EX(C0[12]); C0[13] = EX(C0[13]); C0[14] = EX(C0[14]), C0); \
        VRDA(3); SBAR(); GAPX(osum = ATT_MFMA(PAF(1), ones, osum),  C0[15] = EX(C0[15]); C1[0] = EX(C1[0]); C1[1] = EX(C1[1]), C1); PIN(C0); \
        KRD(GL, 0); GAPX(o[1] = ATT_MFMA(PAF(0), vf[0], o[1]), C1[2] = EX(C1[2]); C1[3] = EX(C1[3]); C1[4] = EX(C1[4]), C1); \
        KRD(GL, 1); GAPX(o[1] = ATT_MFMA(PAF(1), vf[1], o[1]), C1[5] = EX(C1[5]); C1[6] = EX(C1[6]); C1[7] = EX(C1[7]), C1); \
        KRD(GL, 2); GAPX(osum = ATT_MFMA(PAF(2), ones, osum),  C1[8] = EX(C1[8]); C1[9] = EX(C1[9]); C1[10] = EX(C1[10]), C1); \
        KRD(GL, 3); GAPX(o[1] = ATT_MFMA(PAF(2), vf[2], o[1]), C1[11] = EX(C1[11]); C1[12] = EX(C1[12]), C1); \
        GAPX(o[1] = ATT_MFMA(PAF(3), vf[3], o[1]), C1[13] = EX(C1[13]); C1[14] = EX(C1[14]), C1); \
        GAPX(osum = ATT_MFMA(PAF(3), ones, osum),  C1[15] = EX(C1[15]), C1); \
    } else { \
        GAPEN(o[0] = ATT_MFMA(PAF(0), vf[0], o[0]), C0, C1, EK_0, EN_0);  VRDN(0, B_VF8 ? 2 : 1); if (B_KRDC != 1) { KRD1(GL, 0); } SBAR(); \
        GAPEN(o[0] = ATT_MFMA(PAF(1), vf[1], o[0]), C0, C1, EK_1, EN_1);  VRDN(1, B_VF8 ? 2 : 1); if (B_KRDC != 1) { KRD1(GL, 1); } SBAR(); \
        if (BDMA_MODE == 6 || BDMA_MODE == 9 || BDMA_MODE == 10 || BDMA_MODE == 11) { if (GV) { DMA_V0((i) + 2, vs_n2); } SBAR(); } \
        if (BDMA_MODE == 7) { if (GK) { DMA_K2((i) + 3, ks_cur); } SBAR(); } \
        GAPEN(o[0] = ATT_MFMA(PAF(2), vf[2], o[0]), C0, C1, EK_2, EN_2);  VRDN(2, B_VF8 ? 2 : 1); if (B_KRDC != 1) { KRD1(GL, 2); } SBAR(); \
        GAPEN(o[0] = ATT_MFMA(PAF(3), vf[3], o[0]), C0, C1, EK_3, EN_3);  VRDN(3, B_VF8 ? 2 : 1); if (B_KRDC != 1) { KRD1(GL, 3); } SBAR(); \
        if (BDMA_MODE == 7 || BDMA_MODE == 8) { if (GV) { DMA_V0((i) + 2, vs_n2); } SBAR(); } \
        if (BDMA_MODE == 10) { if (GK) { DMA_K2((i) + 3, ks_cur); } SBAR(); } \
        if (BDMA_MODE == 2) { if (GV) { DMA_V((i) + 2, vs_n2); } SBAR(); } \
        GAPEN(o[1] = ATT_MFMA(PAF(0), vf[B_VF8 ? 4 : 0], o[1]), C0, C1, EK_4, EN_4); if (B_VF8) { VRDX(4, 0, 3); } else { VRDN(0, 2); } if (!B_KRDC) { KRD1(GL, 4); } SBAR(); \
        GAPEN(o[1] = ATT_MFMA(PAF(1), vf[B_VF8 ? 5 : 1], o[1]), C0, C1, EK_5, EN_5); if (B_VF8) { VRDX(5, 1, 3); } else { VRDN(1, 2); } if (!B_KRDC) { KRD1(GL, 5); } SBAR(); \
        if (BDMA_MODE == 6 || BDMA_MODE == 7 || BDMA_MODE == 9 || BDMA_MODE == 10 || BDMA_MODE == 11) { if (GV) { DMA_V1((i) + 2, vs_n2); } SBAR(); } \
        GAPEN(o[1] = ATT_MFMA(PAF(2), vf[B_VF8 ? 6 : 2], o[1]), C0, C1, EK_6, EN_6); if (B_VF8) { VRDX(6, 2, 3); } else { VRDN(2, 2); } if (!B_KRDC) { KRD1(GL, 6); } SBAR(); \
        GAPEN(o[1] = ATT_MFMA(PAF(3), vf[B_VF8 ? 7 : 3], o[1]), C0, C1, EK_7, EN_7); if (B_VF8) { VRDX(7, 3, 3); } else { VRDN(3, 2); } if (!B_KRDC) { KRD1(GL, 7); } SBAR(); \
        if (BDMA_MODE == 8) { if (GV) { DMA_V1((i) + 2, vs_n2); } SBAR(); } if (BDMA_MODE == 1 || BDMA_MODE == 5) { if (GV) { DMA_V((i) + 2, vs_n2); } SBAR(); } if (BDMA_MODE == 4 || BDMA_MODE == 5) { if (GK) { DMA_K((i) + 3, ks_cur); } SBAR(); } \
        GAPC(o[ND0 - 2] = ATT_MFMA(PAF(0), vf[0], o[ND0 - 2]); EXN(C0, C1, EK_8, EN_8), GL, P0, 0, 0);  if (!B_VF8) { VRDN(0, 3); } if (B_KRDC == 1) { KRD1(GL, 0); } if (B_KRDC == 2) { KRD1(GL, 4); } SBAR(); \
        GAPC(o[ND0 - 2] = ATT_MFMA(PAF(1), vf[1], o[ND0 - 2]); EXN(C0, C1, EK_9, EN_9), GL, P0, 4, 0);  if (!B_VF8) { VRDN(1, 3); } if (B_KRDC == 1) { KRD1(GL, 1); } if (B_KRDC == 2) { KRD1(GL, 5); } SBAR(); \
        GAPC(o[ND0 - 2] = ATT_MFMA(PAF(2), vf[2], o[ND0 - 2]); EXN(C0, C1, EK_10, EN_10), GL, P0, 8, 0);  if (!B_VF8) { VRDN(2, 3); } if (B_KRDC == 1) { KRD1(GL, 2); } if (B_KRDC == 2) { KRD1(GL, 6); } SBAR(); \
        GAPC(o[ND0 - 2] = ATT_MFMA(PAF(3), vf[3], o[ND0 - 2]); EXN(C0, C1, EK_11, EN_11), GL, P0, 12, 0); if (!B_VF8) { VRDN(3, 3); } if (B_KRDC == 1) { KRD1(GL, 3); } if (B_KRDC == 2) { KRD1(GL, 7); } SBAR(); \
        GAPC(o[ND0 - 1] = ATT_MFMA(PAF(0), vf[B_VF8 ? 4 : 0], o[ND0 - 1]); EXN(C0, C1, EK_12, EN_12), GL, P1, 0, 16); if (B_KRDC == 1) { KRD1(GL, 4); } \
        GAPC(o[ND0 - 1] = ATT_MFMA(PAF(1), vf[B_VF8 ? 5 : 1], o[ND0 - 1]); EXN(C0, C1, EK_13, EN_13), GL, P1, 4, 16); if (B_KRDC == 1) { KRD1(GL, 5); } \
        GAPC(o[ND0 - 1] = ATT_MFMA(PAF(2), vf[B_VF8 ? 6 : 2], o[ND0 - 1]); EXN(C0, C1, EK_14, EN_14), GL, P1, 8, 16); if (B_KRDC == 1) { KRD1(GL, 6); } \
        GAPC(o[ND0 - 1] = ATT_MFMA(PAF(3), vf[B_VF8 ? 7 : 3], o[ND0 - 1]); EXN(C0, C1, EK_15, EN_15); PIN(C1), GL, P1, 12, 16); if (B_KRDC == 1) { KRD1(GL, 7); } \
        if (BDMA_MODE == 3) { if (GV) { DMA_V((i) + 2, vs_n2); } SBAR(); } \
    } } while (0)
    int i = 1;
    for (; i + 5 < n; i += 2) {
        STEP(pB0, pB1, pA0, pA1, i, true, true, true);     if (!(BPROBE & 16)) { if (BPROBE & 2) { WB_SEL(0); } else { WB_SEL(NK + 2 * NV); } } ROT();
        STEP(pA0, pA1, pB0, pB1, i + 1, true, true, true); if (!(BPROBE & 16)) { if (BPROBE & 2) { WB_SEL(0); } else { WB_SEL(NK + 2 * NV); } } ROT();
    }
#define ENDW(ii) do { if ((ii) + 3 < n) { WB_SEL(NK + 2 * NV); } else if ((ii) + 2 < n) { WB_SEL(2 * NV); } else { WB_SEL(0); } } while (0)
    for (; i + 1 < n; i += 2) {
        STEP(pB0, pB1, pA0, pA1, i, (i + 3 < n), (i + 2 < n), (i + 1 < n));         ENDW(i);     ROT();
        STEP(pA0, pA1, pB0, pB1, i + 1, (i + 4 < n), (i + 3 < n), (i + 2 < n));     ENDW(i + 1); ROT();
    }
    STEP(pB0, pB1, pA0, pA1, n - 1, false, false, false);
    { if (ISB) { float sacc = pB0[0] + pB0[1];
#pragma unroll
      for (int r = 2; r < 16; ++r) sacc += pB0[r];
#pragma unroll
      for (int r = 0; r < 16; ++r) sacc += pB1[r];
      l_reg += sacc; }
      pw0 = (u32x4){PKW(pB0, 0), PKW(pB0, 2), PKW(pB0, 4), PKW(pB0, 6)}; pw1 = (u32x4){PKW(pB0, 8), PKW(pB0, 10), PKW(pB0, 12), PKW(pB0, 14)};
      pw2 = (u32x4){PKW(pB1, 0), PKW(pB1, 2), PKW(pB1, 4), PKW(pB1, 6)}; pw3 = (u32x4){PKW(pB1, 8), PKW(pB1, 10), PKW(pB1, 12), PKW(pB1, 14)};
      SBAR();
      const ALAS char* vp_ = vp0 + vs_cur;
#pragma unroll
      for (int d = 0; d < ND0; ++d) {
          const bf16x8 v0 = *(const ALAS bf16x8*)(vp_ + 0 * (DV * 32) + d * 512), v1 = *(const ALAS bf16x8*)(vp_ + 1 * (DV * 32) + d * 512), v2 = *(const ALAS bf16x8*)(vp_ + 2 * (DV * 32) + d * 512), v3 = *(const ALAS bf16x8*)(vp_ + 3 * (DV * 32) + d * 512);
          o[d] = ATT_MFMA(PAF(0), v0, o[d]); o[d] = ATT_MFMA(PAF(1), v1, o[d]); o[d] = ATT_MFMA(PAF(2), v2, o[d]); o[d] = ATT_MFMA(PAF(3), v3, o[d]); }
      if (!ISB) { osum = ATT_MFMA(PAF(0), ones, osum); osum = ATT_MFMA(PAF(1), ones, osum); osum = ATT_MFMA(PAF(2), ones, osum); osum = ATT_MFMA(PAF(3), ones, osum); } }
    const float sacc = l_reg;
    const int lane_e = lane_id_v();
    ATT_WAIT_BAR(0);
    {
    const int lane = lane_e, r32 = lane & 31, hi = lane >> 5; const int q0 = ISB ? qb * 128 : qb * 256;
    float rli[16];
    ALAS float* wsf = (ALAS float*)(shm3 + WSF_OFF) + wid * 64;
    if (ISB) {
        const float l = sum_x32(sacc);
        if (hi == 0) wsf[r32] = l;
        asm volatile("s_waitcnt lgkmcnt(0)" ::: "memory");
#pragma unroll
        for (int r = 0; r < 16; ++r) rli[r] = __builtin_amdgcn_rcpf(wsf[crow(r, hi)]);
    } else {
#pragma unroll
        for (int r = 0; r < 16; ++r) rli[r] = __builtin_amdgcn_rcpf(osum[r]);
    }
    if (!ISB) {
        ALAS bf16_t* stg = (ALAS bf16_t*)shm3 + wid * 2048;
#pragma unroll
        for (int r = 0; r < 16; ++r) { const int orow = crow(r, hi);
#pragma unroll
            for (int d = 0; d < ND0; ++d) stg[orow * 64 + d * 32 + r32] = pg8::f2bf1(o[d][r] * rli[r]); }
        asm volatile("s_waitcnt lgkmcnt(0)" ::: "memory");
#pragma unroll
        for (int i = 0; i < 4; ++i) { const int row = i * 8 + (lane >> 3), ch = lane & 7; const u32x4 v = *(const ALAS u32x4*)(stg + row * 64 + ch * 8);
            *(u32x4*)(T_MIX + (size_t)(q0 + wid * 32 + row) * 1024 + head * 64 + ch * 8) = v; }
    } else {
        ALAS float* X = (ALAS float*)shm3 + wq * 4096;
        const float sc = (mapc == 1) ? lam : 1.0f;
        if (mapc == 1) {
#pragma unroll
            for (int r = 0; r < 16; ++r) { const int orow = crow(r, hi); const float f = rli[r] * sc;
#pragma unroll
                for (int d = 0; d < ND0; ++d) X[orow * 128 + d * 32 + r32] = o[d][r] * f; }
        }
        asm volatile("s_waitcnt lgkmcnt(0)\n\ts_barrier" ::: "memory");
        if (mapc == 0) {
#pragma unroll
            for (int r = 0; r < 16; ++r) { const int orow = crow(r, hi);
#pragma unroll
                for (int d = 0; d < ND0; ++d) { const int idx = orow * 128 + d * 32 + r32; X[idx] = o[d][r] * rli[r] - X[idx]; } }
            asm volatile("s_waitcnt lgkmcnt(0)" ::: "memory");
            const int qq = lane >> 1, hf = lane & 1;
            const ALAS float* rowp = X + qq * 128 + hf * 64;
            f32x4 vv[16]; float ss = 0.f;
#pragma unroll
            for (int i = 0; i < 16; ++i) { vv[i] = *(const ALAS f32x4*)(rowp + 4 * i); ss += (vv[i][0] * vv[i][0] + vv[i][1] * vv[i][1]) + (vv[i][2] * vv[i][2] + vv[i][3] * vv[i][3]); }
            ss += xor_lane<1>(ss);
            const float rs = 0.8f / sqrtf(ss * (1.0f / 128.0f) + 1e-6f);
            bf16_t* dst = T_MIX + (size_t)(q0 + wq * 32 + qq) * 1024 + 512 + head * 128 + hf * 64;
            const ALAS float* sl = T.subln + hf * 64;
#pragma unroll
            for (int i = 0; i < 8; ++i) { const f32x4 g0 = *(const ALAS f32x4*)(sl + 8 * i), g1 = *(const ALAS f32x4*)(sl + 8 * i + 4); const f32x4 a = vv[2 * i] * rs * g0, b = vv[2 * i + 1] * rs * g1;
                u32x4 w; w.x = cvtpk(a[0], a[1]); w.y = cvtpk(a[2], a[3]); w.z = cvtpk(b[0], b[1]); w.w = cvtpk(b[2], b[3]); *(u32x4*)(dst + 8 * i) = w; }
        }
    }
    }
    asm volatile("s_waitcnt lgkmcnt(0)\n\ts_barrier" ::: "memory");
#undef DMA_K
#undef DMA_V
#undef ROT
#undef STEP
#undef ENDW
#undef GAPA
#undef GAPB
#undef GAPC
#undef GAPE3
#undef GAPEN
#undef EXN
#undef EXE
#undef GAPX
#undef VRD
#undef VRD2
#undef VRDA
#undef VRDN
#undef KRD
#undef KRD1
#undef CIN
#undef PAF
#undef KLOAD2
#undef BIAS_GEN4
#undef BIAS_FAST4
#undef BIAS_ALL
#undef BIAS_STEP_SETUP
}

typedef int i32x8 __attribute__((ext_vector_type(8)));
typedef unsigned u32x8 __attribute__((ext_vector_type(8)));
#define MFMA8(a, b, c) __builtin_amdgcn_mfma_scale_f32_32x32x64_f8f6f4(a, b, c, 0, 0, 0, 0, 0, 0)
__device__ __forceinline__ void attn_unit_a8(const Tensors& T, int head, int qb, float negM2s, char* shm, int wave_id) {
    unsigned char* tws_ = T.ws; LAUNDER_G(tws_);
    constexpr int KSLOT = 4096, VSLOT = 4096, LDS_K = 0, LDS_V = 3 * KSLOT, n = 256;
    int tid_ = wave_id * 64 + lane_id_v(); asm volatile("" : "+v"(tid_));
    const int tid = tid_, lane = tid & 63, r32 = lane & 31, hi = lane >> 5; const int wid = __builtin_amdgcn_readfirstlane(tid >> 6);
    const int q0 = qb * 256; const int qrow = q0 + wid * 32 + r32;
    const unsigned lds0 = (unsigned)(uintptr_t)shm;
    const ALAS char* shm3 = (const ALAS char*)shm;
    const bool kw = wid < 4;
    const char* sb = (const char*)(tws_ + (kw ? WS_KA : WS_VA)) + (size_t)(head >> 2) * MROWS * 64 + (wid & 3) * 1024;
    const unsigned dvo = (unsigned)(lane * 16);
    const unsigned ddst = lds0 + (kw ? LDS_K : LDS_V) + (wid & 3) * 1024;
#define DMA8(i, so) glds16s(sb + (size_t)(i) * 4096, dvo, (unsigned)__builtin_amdgcn_readfirstlane(ddst + (so)))
#define WB8(NKW, NVW) do { if (kw) { WB_SEL(NKW); } else { WB_SEL(NVW); } } while (0)
    if (kw) { DMA8(0, 0); DMA8(1, KSLOT); DMA8(2, 2 * KSLOT); } else { DMA8(0, 0); DMA8(1, VSLOT); }
    const unsigned char* Qw = (tws_ + WS_QA) + ((size_t)head * MROWS + qrow) * 64 + hi * 32;
    i32x8 qf; { const u32x4 a_ = *(const u32x4*)Qw, b_ = *(const u32x4*)(Qw + 16); qf = (i32x8){(int)a_[0], (int)a_[1], (int)a_[2], (int)a_[3], (int)b_[0], (int)b_[1], (int)b_[2], (int)b_[3]}; }
    f32x16 o0 = f32x16{}, o1 = f32x16{}, osum = f32x16{};
    f32x16 negm;
#pragma unroll
    for (int r = 0; r < 16; ++r) negm[r] = negM2s;
    asm volatile("" : "+v"(negm));
    i32x8 ones; { const int o4 = 0x38383838; ones = (i32x8){o4, o4, o4, o4, o4, o4, o4, o4}; } asm volatile("" : "+v"(ones));
    const ALAS char* kp0 = shm3 + LDS_K + hi * 1024 + r32 * 16;
    const ALAS char* vp0 = shm3 + LDS_V + hi * 1024 + r32 * 16;
    f32x16 pA0, pA1, pB0, pB1;
    i32x8 kf0, kf1, vf0, vf1, pf = (i32x8){0, 0, 0, 0, 0, 0, 0, 0};
    int ks_prev = 0, ks_cur = 0, ks_next = KSLOT, vs_prev = 0, vs_cur = VSLOT, vs_next = 2 * VSLOT, vs_n2 = 3 * VSLOT;
#define ROTK8() do { ks_prev = ks_cur; ks_cur = ks_next; ks_next = (ks_next == 2 * KSLOT) ? 0 : ks_next + KSLOT; } while (0)
#define ROT8() do { ROTK8(); const int tv_ = vs_prev; vs_prev = vs_cur; vs_cur = vs_next; vs_next = vs_n2; vs_n2 = tv_; } while (0)
#define LD32(dst, p) do { const u32x4 a_ = *(const ALAS u32x4*)(p), b_ = *(const ALAS u32x4*)((p) + 512); dst = (i32x8){(int)a_[0], (int)a_[1], (int)a_[2], (int)a_[3], (int)b_[0], (int)b_[1], (int)b_[2], (int)b_[3]}; } while (0)
#define PK8(P, B, OLD) __builtin_amdgcn_cvt_pk_fp8_f32(P[(B) + 2], P[(B) + 3], __builtin_amdgcn_cvt_pk_fp8_f32(P[B], P[(B) + 1], OLD, false), true)
    WB8(2, 2);
    { LD32(kf0, kp0); LD32(kf1, kp0 + 2048);
      pA0 = MFMA8(kf0, qf, negm); pA1 = MFMA8(kf1, qf, negm);
#pragma unroll
      for (int r = 0; r < 16; ++r) { pA0[r] = EX(pA0[r]); pA1[r] = EX(pA1[r]); } }
    WB_SEL(0);
    if (kw) { DMA8(3, 0); } else { DMA8(2, 2 * VSLOT); }
    ROTK8();
    { const ALAS char* kb_ = kp0 + ks_cur; LD32(kf0, kb_); LD32(kf1, kb_ + 2048); }
    WB_SEL(1);
#define STEP8(C0, C1, P0, P1, i, GK, GV, GL) do { SBAR(); \
    const ALAS char* vp_ = vp0 + vs_prev; const ALAS char* kn_ = kp0 + ks_next; \
    LD32(vf0, vp_); LD32(vf1, vp_ + 2048); SBAR(); \
    C0 = MFMA8(kf0, qf, negm); \
    pf[0] = PK8(P0, 0, pf[0]); pf[1] = PK8(P0, 4, pf[1]); pf[2] = PK8(P0, 8, pf[2]); pf[3] = PK8(P0, 12, pf[3]); PIN(pf); SBAR(); \
    C1 = MFMA8(kf1, qf, negm); \
    pf[4] = PK8(P1, 0, pf[4]); pf[5] = PK8(P1, 4, pf[5]); pf[6] = PK8(P1, 8, pf[6]); pf[7] = PK8(P1, 12, pf[7]); PIN(pf); SBAR(); \
    if (kw) { if (GK) { DMA8((i) + 3, ks_cur); } } else { if (GV) { DMA8((i) + 2, vs_n2); } } \
    SBAR(); \
    o0 = MFMA8(pf, vf0, o0); \
    _Pragma("unroll") for (int r_ = 0; r_ < 16; ++r_) C0[r_] = EX(C0[r_]); PIN(C0); SBAR(); \
    if (GL) { LD32(kf0, kn_); LD32(kf1, kn_ + 2048); SBAR(); } \
    o1 = MFMA8(pf, vf1, o1); \
    _Pragma("unroll") for (int r_ = 0; r_ < 8; ++r_) C1[r_] = EX(C1[r_]); PIN(C1); SBAR(); \
    osum = MFMA8(pf, ones, osum); \
    _Pragma("unroll") for (int r_ = 8; r_ < 16; ++r_) C1[r_] = EX(C1[r_]); PIN(C1); SBAR(); \
    } while (0)
    int i = 1;
    for (; i + 5 < n; i += 2) {
        STEP8(pB0, pB1, pA0, pA1, i, true, true, true);     WB8(1, 2); ROT8();
        STEP8(pA0, pA1, pB0, pB1, i + 1, true, true, true); WB8(1, 2); ROT8();
    }
#define ENDW8(ii) do { if ((ii) + 3 < n) { WB8(1, 2); } else if ((ii) + 2 < n) { WB8(0, 2); } else { WB_SEL(0); } } while (0)
    for (; i + 1 < n; i += 2) {
        STEP8(pB0, pB1, pA0, pA1, i, (i + 3 < n), (i + 2 < n), (i + 1 < n));         ENDW8(i);     ROT8();
        STEP8(pA0, pA1, pB0, pB1, i + 1, (i + 4 < n), (i + 3 < n), (i + 2 < n));     ENDW8(i + 1); ROT8();
    }
    STEP8(pB0, pB1, pA0, pA1, n - 1, false, false, false);
    { pf[0] = PK8(pB0, 0, pf[0]); pf[1] = PK8(pB0, 4, pf[1]); pf[2] = PK8(pB0, 8, pf[2]); pf[3] = PK8(pB0, 12, pf[3]); pf[4] = PK8(pB1, 0, pf[4]); pf[5] = PK8(pB1, 4, pf[5]); pf[6] = PK8(pB1, 8, pf[6]); pf[7] = PK8(pB1, 12, pf[7]);
      const ALAS char* vp_ = vp0 + vs_cur; LD32(vf0, vp_); LD32(vf1, vp_ + 2048);
      o0 = MFMA8(pf, vf0, o0); o1 = MFMA8(pf, vf1, o1); osum = MFMA8(pf, ones, osum); }
    ATT_WAIT_BAR(0);
    {
        const int lane_e = lane_id_v(), l32 = lane_e & 31, hh = lane_e >> 5;
        ALAS bf16_t* stg = (ALAS bf16_t*)shm3 + wid * 2048;
#pragma unroll
        for (int r = 0; r < 16; ++r) { const int orow = crow(r, hh); const float rl = __builtin_amdgcn_rcpf(osum[r]);
            stg[orow * 64 + l32] = pg8::f2bf1(o0[r] * rl); stg[orow * 64 + 32 + l32] = pg8::f2bf1(o1[r] * rl); }
        asm volatile("s_waitcnt lgkmcnt(0)" ::: "memory");
#pragma unroll
        for (int i2 = 0; i2 < 4; ++i2) { const int row = i2 * 8 + (lane_e >> 3), ch = lane_e & 7; const u32x4 v = *(const ALAS u32x4*)(stg + row * 64 + ch * 8);
            *(u32x4*)(T_MIX + (size_t)(qb * 256 + wid * 32 + row) * 1024 + head * 64 + ch * 8) = v; }
    }
    asm volatile("s_waitcnt lgkmcnt(0)\n\ts_barrier" ::: "memory");
#undef DMA8
#undef EXPR
#undef PACKH0
#undef PACKH1
#undef ROWSUM_A
#undef ROWSUM_B
#undef EXPBLK
#undef PACK8
#undef WB8
#undef ROTK8
#undef ROT8
#undef LD32
#undef PK8
#undef STEP8
#undef ENDW8
}

typedef short v2i16_t __attribute__((ext_vector_type(2)));
template<int U, int PROBE = 0>
__device__ __forceinline__ void attn_unit_a8x2(const Tensors& T, int head, int qb, float negM2s, char* shm, int wave_id) {
    unsigned char* tws_ = T.ws; LAUNDER_G(tws_);
    constexpr int KSLOT = 4096, VSLOT = 4096, DD = (U >= 8) ? U + 2 : U + U, RS = (U + DD) * 4096, LDS_K = 0, LDS_V = RS, n = 256;
    int tid_ = wave_id * 64 + lane_id_v(); asm volatile("" : "+v"(tid_));
    const int tid = tid_, lane = tid & 63, r32 = lane & 31, hi = lane >> 5; const int wid = __builtin_amdgcn_readfirstlane(tid >> 6);
    const int q0 = qb * 512; const int qrow = q0 + wid * 64 + r32;
    const unsigned lds0 = (unsigned)(uintptr_t)shm;
    const ALAS char* shm3 = (const ALAS char*)shm;
    const bool kw = wid < 4;
    const char* sb = (const char*)(tws_ + (kw ? WS_KA : WS_VA)) + (size_t)(head >> 2) * MROWS * 64 + (wid & 3) * 1024;
    const unsigned dvo = (unsigned)(lane * 16);
    const unsigned ddst = lds0 + (kw ? LDS_K : LDS_V) + (wid & 3) * 1024;
#define DMA8(i, so) glds16s(sb + (size_t)(i) * 4096, dvo, (unsigned)__builtin_amdgcn_readfirstlane(ddst + (so)))
#pragma unroll
    for (int i0 = 0; i0 < DD; ++i0) DMA8(i0, i0 * 4096);
    if (kw) DMA8(DD, DD * 4096);
    const unsigned char* Qw = (tws_ + WS_QA) + ((size_t)head * MROWS + qrow) * 64 + hi * 32;
    i32x8 qfa, qfb;
    { const u32x4 a_ = *(const u32x4*)Qw, b_ = *(const u32x4*)(Qw + 16); qfa = (i32x8){(int)a_[0], (int)a_[1], (int)a_[2], (int)a_[3], (int)b_[0], (int)b_[1], (int)b_[2], (int)b_[3]}; }
    { const u32x4 a_ = *(const u32x4*)(Qw + 32 * 64), b_ = *(const u32x4*)(Qw + 32 * 64 + 16); qfb = (i32x8){(int)a_[0], (int)a_[1], (int)a_[2], (int)a_[3], (int)b_[0], (int)b_[1], (int)b_[2], (int)b_[3]}; }
#if A8_SUM16
    f32x16 oa0 = f32x16{}, oa1 = f32x16{}, ob0 = f32x16{}, ob1 = f32x16{};
    f32x4 sa4 = f32x4{}, sb4 = f32x4{};
#if A8_SUM16 == 2
    f32x16 osa = f32x16{};
#endif
#else
    f32x16 oa0 = f32x16{}, oa1 = f32x16{}, osa = f32x16{}, ob0 = f32x16{}, ob1 = f32x16{}, osb = f32x16{};
#endif
#if A8_SUM16 == 2
    const f32x16 negm = f32x16{};
#else
    f32x16 negm;
#pragma unroll
    for (int r = 0; r < 16; ++r) negm[r] = negM2s;
    asm volatile("" : "+v"(negm));
#endif
#if A8_SUM16
    i32x8 ind; { const int o4 = (((lane >> 4) & 1) == ((lane & 15) >> 3)) ? 0x38383838 : 0; ind = (i32x8){o4, o4, o4, o4, o4, o4, o4, o4}; } asm volatile("" : "+v"(ind));
#if A8_SUM16 == 2
    i32x8 ones; { const int o4 = 0x38383838; ones = (i32x8){o4, o4, o4, o4, o4, o4, o4, o4}; } asm volatile("" : "+v"(ones));
#endif
#else
    i32x8 ones; { const int o4 = 0x38383838; ones = (i32x8){o4, o4, o4, o4, o4, o4, o4, o4}; } asm volatile("" : "+v"(ones));
#endif
    const ALAS char* kp0 = shm3 + LDS_K + hi * 1024 + r32 * 16;
    const ALAS char* vp0 = shm3 + LDS_V + hi * 1024 + r32 * 16;
    f32x16 Ca0, Ca1, Cb0, Cb1;
#ifdef A8_EXPH
#define EXPBLK(H, C, b) do { const unsigned h0_ = __builtin_bit_cast(unsigned, __builtin_amdgcn_cvt_pkrtz(C[b], C[(b) + 1])), h1_ = __builtin_bit_cast(unsigned, __builtin_amdgcn_cvt_pkrtz(C[(b) + 2], C[(b) + 3])), \
        h2_ = __builtin_bit_cast(unsigned, __builtin_amdgcn_cvt_pkrtz(C[(b) + 4], C[(b) + 5])), h3_ = __builtin_bit_cast(unsigned, __builtin_amdgcn_cvt_pkrtz(C[(b) + 6], C[(b) + 7])); unsigned d0_, d1_, d2_, d3_; \
        asm volatile("v_exp_f16_e32 %0, %4\n\tv_exp_f16_e32 %1, %5\n\tv_exp_f16_e32 %2, %6\n\tv_exp_f16_e32 %3, %7\n\t" \
                     "v_exp_f16_sdwa %0, %4 dst_sel:WORD_1 dst_unused:UNUSED_PRESERVE src0_sel:WORD_1\n\tv_exp_f16_sdwa %1, %5 dst_sel:WORD_1 dst_unused:UNUSED_PRESERVE src0_sel:WORD_1\n\t" \
                     "v_exp_f16_sdwa %2, %6 dst_sel:WORD_1 dst_unused:UNUSED_PRESERVE src0_sel:WORD_1\n\tv_exp_f16_sdwa %3, %7 dst_sel:WORD_1 dst_unused:UNUSED_PRESERVE src0_sel:WORD_1" \
                     : "=&v"(d0_), "=&v"(d1_), "=&v"(d2_), "=&v"(d3_) : "v"(h0_), "v"(h1_), "v"(h2_), "v"(h3_)); \
        C[(b) / 2] = __builtin_bit_cast(float, d0_); C[(b) / 2 + 1] = __builtin_bit_cast(float, d1_); C[(b) / 2 + 2] = __builtin_bit_cast(float, d2_); C[(b) / 2 + 3] = __builtin_bit_cast(float, d3_); PIN(C); } while (0)
#define PKH(C, j) (int)__builtin_amdgcn_perm(__builtin_bit_cast(unsigned, C[2 * (j) + 1]), __builtin_bit_cast(unsigned, C[2 * (j)]), 0x07050301u)
#define PACK8(H0, H1, C0, C1) do { pf[0] = PKH(C0, 0); pf[1] = PKH(C0, 1); pf[2] = PKH(C0, 2); pf[3] = PKH(C0, 3); pf[4] = PKH(C1, 0); pf[5] = PKH(C1, 1); pf[6] = PKH(C1, 2); pf[7] = PKH(C1, 3); PIN(pf); } while (0)
#else
#define EXPBLK(H, C, b) do { _Pragma("unroll") for (int r_ = (b); r_ < (b) + 8; ++r_) C[r_] = ((PROBE & 1) ? __builtin_fmaxf(C[r_], 1.0f) : EX(C[r_])); PIN(C); } while (0)
#define PACK8(H0, H1, C0, C1) do { pf[0] = PK8(C0, 0, pf[0]); pf[1] = PK8(C0, 4, pf[1]); pf[2] = PK8(C0, 8, pf[2]); pf[3] = PK8(C0, 12, pf[3]); pf[4] = PK8(C1, 0, pf[4]); pf[5] = PK8(C1, 4, pf[5]); pf[6] = PK8(C1, 8, pf[6]); pf[7] = PK8(C1, 12, pf[7]); PIN(pf); } while (0)
#endif
    i32x8 kf0, kf1, vf0, vf1, pf = (i32x8){0, 0, 0, 0, 0, 0, 0, 0};
#define LD32(dst, p) do { const u32x4 a_ = *(const ALAS u32x4*)(p), b_ = *(const ALAS u32x4*)((p) + 512); dst = (i32x8){(int)a_[0], (int)a_[1], (int)a_[2], (int)a_[3], (int)b_[0], (int)b_[1], (int)b_[2], (int)b_[3]}; } while (0)
#ifdef A8_BF8
#define PK8(P, B, OLD) (int)__builtin_amdgcn_perm(__builtin_bit_cast(unsigned, __builtin_amdgcn_cvt_pkrtz(P[(B) + 2], P[(B) + 3])), __builtin_bit_cast(unsigned, __builtin_amdgcn_cvt_pkrtz(P[B], P[(B) + 1])), 0x07050301u)
#define MFMA8P(a, b, c) __builtin_amdgcn_mfma_scale_f32_32x32x64_f8f6f4(a, b, c, 1, 0, 0, 0, 0, 0)
#define MFMA16P(a, b, c) __builtin_amdgcn_mfma_scale_f32_16x16x128_f8f6f4(a, b, c, 1, 0, 0, 0, 0, 0)
#elif defined(A8_SCALECVT)
#define MFMA8P(a, b, c) MFMA8(a, b, c)
#define MFMA16P(a, b, c) __builtin_amdgcn_mfma_scale_f32_16x16x128_f8f6f4(a, b, c, 0, 0, 0, 0, 0, 0)
#define PK8(P, B, OLD) __builtin_bit_cast(int, __builtin_amdgcn_cvt_scalef32_pk_fp8_f32(__builtin_amdgcn_cvt_scalef32_pk_fp8_f32(__builtin_bit_cast(v2i16_t, (int)(OLD)), P[B], P[(B) + 1], 1.0f, false), P[(B) + 2], P[(B) + 3], 1.0f, true))
#else
#define MFMA8P(a, b, c) MFMA8(a, b, c)
#define MFMA16P(a, b, c) __builtin_amdgcn_mfma_scale_f32_16x16x128_f8f6f4(a, b, c, 0, 0, 0, 0, 0, 0)
#define PK8(P, B, OLD) __builtin_amdgcn_cvt_pk_fp8_f32(P[(B) + 2], P[(B) + 3], __builtin_amdgcn_cvt_pk_fp8_f32(P[B], P[(B) + 1], OLD, false), true)
#endif
    if (A8_PRO2 && DD >= 8) { WB_SEL(8); } else { WB_SEL(DD - U); }
    { LD32(kf0, kp0); LD32(kf1, kp0 + 2048);
      Ca0 = MFMA8(kf0, qfa, negm); Ca1 = MFMA8(kf1, qfa, negm); Cb0 = MFMA8(kf0, qfb, negm); Cb1 = MFMA8(kf1, qfb, negm);
      EXPBLK(Ha0, Ca0, 0); EXPBLK(Ha0, Ca0, 8); EXPBLK(Ha1, Ca1, 0); EXPBLK(Ha1, Ca1, 8); }
#define EXPR(C, lo, hi) do { _Pragma("unroll") for (int r_ = (lo); r_ < (hi); ++r_) C[r_] = EX(C[r_]); PIN(C); } while (0)
#define P2E1 (A8_PIPE2 / 100)
#define P2E2 (A8_PIPE2 % 100)
#define EXPR2(C0, C1, lo, hi) do { _Pragma("unroll") for (int r_ = (lo); r_ < (hi); ++r_) { if (r_ < 16) C0[r_ & 15] = EX(C0[r_ & 15]); else C1[r_ & 15] = EX(C1[r_ & 15]); } PIN(C0); PIN(C1); } while (0)
#define PACKH0(C0) do { pf[0] = PK8(C0, 0, pf[0]); pf[1] = PK8(C0, 4, pf[1]); pf[2] = PK8(C0, 8, pf[2]); pf[3] = PK8(C0, 12, pf[3]); PIN(pf); } while (0)
#define PACKH1(C1) do { pf[4] = PK8(C1, 0, pf[4]); pf[5] = PK8(C1, 4, pf[5]); pf[6] = PK8(C1, 8, pf[6]); pf[7] = PK8(C1, 12, pf[7]); PIN(pf); } while (0)
#if A8_SUM16
#define ROWSUM_A() sa4 = MFMA16P(pf, ind, sa4)
#define ROWSUM_B() sb4 = MFMA16P(pf, ind, sb4)
#else
#define ROWSUM_A() osa = MFMA8P(pf, ones, osa)
#define ROWSUM_B() osb = MFMA8P(pf, ones, osb)
#endif
#if A8_PIPE2
    PACKH0(Ca0); PACKH1(Ca1);
#endif
    if (A8_PRO2 && DD >= 8) { WB_SEL(DD - U); } else
    asm volatile("s_waitcnt lgkmcnt(0)\n\ts_barrier" ::: "memory");
    int ks = 0, vs = 0;
    const int dofs = kw ? 1 : 0;
    const int dslot = A8_DMASTAG ? ((wid + (kw ? 0 : 2)) & 3) : 3;
#define ADV(x, k) (((x) + (k) * 4096 >= RS) ? (x) + (k) * 4096 - RS : (x) + (k) * 4096)
    for (int t0 = 0; t0 < n; t0 += U) {
#pragma unroll
      for (int j = 0; j < U; ++j) {
        const int t = t0 + j;
        const bool GK = t + 1 + DD < n, GV = t + DD < n, GL = t + 1 < n;
        const int ksn = ADV(ks, 1);
        SBAR();
#if A8_PIPE2
        if (!A8_VPREF || j == 0) { const ALAS char* vp_ = vp0 + vs; LD32(vf0, vp_); LD32(vf1, vp_ + 2048); }
        if (!A8_KLATE) { if (GL) { const ALAS char* kn_ = kp0 + ksn; LD32(kf0, kn_); LD32(kf1, kn_ + 2048); } } SBAR();
#if A8_PIPE2 >= 2
        oa0 = MFMA8P(pf, vf0, oa0); EXPR2(Cb0, Cb1, 0, P2E1); SBAR();
        oa1 = MFMA8P(pf, vf1, oa1); EXPR2(Cb0, Cb1, P2E1, P2E1 + P2E2); SBAR();
        ROWSUM_A(); EXPR2(Cb0, Cb1, P2E1 + P2E2, 32); SBAR();
        if (GL) { Ca0 = MFMA8(kf0, qfa, negm); } PACKH0(Cb0); SBAR();
        if (GL) { Ca1 = MFMA8(kf1, qfa, negm); } PACKH1(Cb1);
        if (kw) { if (GK) { DMA8(t + 1 + DD, ADV(ks, DD + 1)); } } else { if (GV) { DMA8(t + DD, ADV(vs, DD)); } }
        SBAR();
        ob0 = MFMA8P(pf, vf0, ob0); if (GL) { EXPR2(Ca0, Ca1, 0, P2E1); } SBAR();
        ob1 = MFMA8P(pf, vf1, ob1); if (GL) { EXPR2(Ca0, Ca1, P2E1, P2E1 + P2E2); } SBAR();
        ROWSUM_B(); if (GL) { EXPR2(Ca0, Ca1, P2E1 + P2E2, 32); } SBAR();
        if (GL) { Cb0 = MFMA8(kf0, qfb, negm); PACKH0(Ca0); } SBAR();
        if (GL) { Cb1 = MFMA8(kf1, qfb, negm); PACKH1(Ca1); } SBAR();
#else
        oa0 = MFMA8P(pf, vf0, oa0); EXPR(Cb0, 0, 11); SBAR();
        if (A8_KLATE) { if (GL) { const ALAS char* kn_ = kp0 + ksn; LD32(kf0, kn_); LD32(kf1, kn_ + 2048); } SBAR(); }
        if (A8_DMAPOS == 1) { { if (t + dofs + DD < n) { DMA8(t + dofs + DD, ADV(ks, DD + dofs)); } }     SBAR(); }
        oa1 = MFMA8P(pf, vf1, oa1); EXPR(Cb0, 11, 16); EXPR(Cb1, 0, 6); SBAR();
        ROWSUM_A(); EXPR(Cb1, 6, 16); SBAR();
        if (A8_DMAPOS == 2) { { if (t + dofs + DD < n) { DMA8(t + dofs + DD, ADV(ks, DD + dofs)); } }     SBAR(); }
        if (GL) { Ca0 = MFMA8(kf0, qfa, negm); } PACKH0(Cb0); SBAR();
        if (A8_DMAPOS == 5) { { if (t + dofs + DD < n) { DMA8(t + dofs + DD, ADV(ks, DD + dofs)); } }     SBAR(); }
        if (GL) { Ca1 = MFMA8(kf1, qfa, negm); } if (A8_DMAPOS == 6) { SBAR(); { if (t + dofs + DD < n) { DMA8(t + dofs + DD, ADV(ks, DD + dofs)); } }     SBAR(); } PACKH1(Cb1);
        if (A8_DMAPOS == 0) { { if (t + dofs + DD < n) { DMA8(t + dofs + DD, ADV(ks, DD + dofs)); } }     SBAR(); }
        SBAR();
        ob0 = MFMA8P(pf, vf0, ob0); if (GL) { EXPR(Ca0, 0, 11); } SBAR();
        ob1 = MFMA8P(pf, vf1, ob1); if (GL) { EXPR(Ca0, 11, 16); EXPR(Ca1, 0, 6); } SBAR();
        if (A8_VPREF && j < U - 1) { const ALAS char* vn_ = vp0 + ADV(vs, 1); LD32(vf0, vn_); LD32(vf1, vn_ + 2048); SBAR(); }
        ROWSUM_B(); if (GL) { EXPR(Ca1, 6, 16); } SBAR();
        if (A8_DMAPOS == 4) { { if (t + dofs + DD < n) { DMA8(t + dofs + DD, ADV(ks, DD + dofs)); } }     SBAR(); }
        if (GL) { Cb0 = MFMA8(kf0, qfb, negm); PACKH0(Ca0); } SBAR();
        if (GL) { Cb1 = MFMA8(kf1, qfb, negm); PACKH1(Ca1); } SBAR();
        if (A8_DMAPOS == 3) { { if (t + dofs + DD < n) { DMA8(t + dofs + DD, ADV(ks, DD + dofs)); } }     SBAR(); }
#endif
#else
        if (!(PROBE & 4)) if (!A8_VPREF || j == 0) { const ALAS char* vp_ = vp0 + vs; LD32(vf0, vp_); LD32(vf1, vp_ + 2048); }
        if (!(PROBE & 4)) if (GL) { const ALAS char* kn_ = kp0 + ksn; LD32(kf0, kn_); LD32(kf1, kn_ + 2048); } SBAR();
        if (!(PROBE & 8)) { PACK8(Ha0, Ha1, Ca0, Ca1); } SBAR();
#ifdef A8_EXPH_DUP
        {
#pragma unroll
          for (int r = 0; r < 16; ++r) { float x_ = Ca0[r], y_ = Ca1[r]; asm volatile("v_exp_f16_e32 %0, %0\n\tv_exp_f16_e32 %1, %1" : "+v"(x_), "+v"(y_)); Ca0[r] = x_; Ca1[r] = y_; }
          SBAR(); }
#endif
#ifdef A8_CVT_DUP
        { int d0_ = 0, d1_ = 0, d2_ = 0, d3_ = 0;
#pragma unroll
          for (int r = 0; r < 16; r += 4) { d0_ = PK8(Ca0, r, d0_); d1_ = PK8(Ca1, r, d1_); d2_ = PK8(Ca0, r, d2_); d3_ = PK8(Ca1, r, d3_); asm volatile("" : "+v"(d0_), "+v"(d1_), "+v"(d2_), "+v"(d3_)); }
          SBAR(); }
#endif
        if (!(PROBE & 32)) oa0 = MFMA8P(pf, vf0, oa0);
        EXPBLK(Hb0, Cb0, 0); SBAR();
        if (A8_DMASTAG && !(PROBE & 2) && dslot == 0) { { if (t + dofs + DD < n) { DMA8(t + dofs + DD, ADV(ks, DD + dofs)); } }     SBAR(); }
        if (!(PROBE & 32)) oa1 = MFMA8P(pf, vf1, oa1);
        EXPBLK(Hb0, Cb0, 8); SBAR();
        if (A8_DMASTAG && !(PROBE & 2) && dslot == 1) { { if (t + dofs + DD < n) { DMA8(t + dofs + DD, ADV(ks, DD + dofs)); } }     SBAR(); }
#if A8_SUM16
        if (!(PROBE & 32)) sa4 = MFMA16P(pf, ind, sa4);
#if A8_SUM16 == 2
        osa = MFMA8P(pf, ones, osa);
#endif
#else
        osa = MFMA8P(pf, ones, osa);
#endif
        EXPBLK(Hb1, Cb1, 0); SBAR();
        if (A8_DMASTAG && !(PROBE & 2) && dslot == 2) { { if (t + dofs + DD < n) { DMA8(t + dofs + DD, ADV(ks, DD + dofs)); } }     SBAR(); }
        if (GL && !(PROBE & 64)) { Ca0 = MFMA8(kf0, qfa, negm); }
        EXPBLK(Hb1, Cb1, 8); SBAR();
        if (GL && !(PROBE & 64)) { Ca1 = MFMA8(kf1, qfa, negm); }
        if (!(PROBE & 2) && (!A8_DMASTAG || dslot == 3)) { if (t + dofs + DD < n) { DMA8(t + dofs + DD, ADV(ks, DD + dofs)); } }
        SBAR();
        if (!(PROBE & 8)) { PACK8(Hb0, Hb1, Cb0, Cb1); } SBAR();
        if (!(PROBE & 32)) ob0 = MFMA8P(pf, vf0, ob0);
        if (GL) {
            EXPBLK(Ha0, Ca0, 0); }
        SBAR();
        if (!(PROBE & 32)) ob1 = MFMA8P(pf, vf1, ob1);
        if (GL) {
            EXPBLK(Ha0, Ca0, 8); }
        SBAR();
        if (A8_VPREF && j < U - 1) { const ALAS char* vn_ = vp0 + ADV(vs, 1); LD32(vf0, vn_); LD32(vf1, vn_ + 2048); SBAR(); }
#if A8_SUM16
        if (!(PROBE & 32)) sb4 = MFMA16P(pf, ind, sb4);
#else
        osb = MFMA8P(pf, ones, osb);
#endif
        if (GL) {
            EXPBLK(Ha1, Ca1, 0); }
        SBAR();
        if (GL) { if (!(PROBE & 64)) Cb0 = MFMA8(kf0, qfb, negm);
            EXPBLK(Ha1, Ca1, 8); }
        SBAR();
        if (GL && !(PROBE & 64)) { Cb1 = MFMA8(kf1, qfb, negm); }
#endif
        if (j == U - 1 && !(PROBE & 16)) { if ((PROBE & 2) == 0 && (kw ? GK : GV)) { WB_SEL(DD - U); } else { WB_SEL(0); }
#ifdef A8_LAG
            if (!kw) __builtin_amdgcn_s_sleep(A8_LAG);
#endif
        }
        ks = ksn; vs = ADV(vs, 1);
      }
    }
#undef ADV
    {
        const int lane_e = lane_id_v(), l32 = lane_e & 31, hh = lane_e >> 5;
        ALAS bf16_t* stg = (ALAS bf16_t*)shm3 + wid * 4096;
#if A8_SUM16
        ALAS float* ls = (ALAS float*)(shm3 + 65536) + wid * 64;
        if ((lane_e & 7) == 0) { const int q0_ = 16 * ((lane_e >> 3) & 1) + 4 * (lane_e >> 4);
#pragma unroll
            for (int r = 0; r < 4; ++r) { ls[q0_ + r] = sa4[r]; ls[32 + q0_ + r] = sb4[r]; } }
        asm volatile("s_waitcnt lgkmcnt(0)" ::: "memory");
#endif
#pragma unroll
        for (int r = 0; r < 16; ++r) { const int orow = crow(r, hh);
#if A8_SUM16
            float ra = __builtin_amdgcn_rcpf(ls[orow]); const float rb = __builtin_amdgcn_rcpf(ls[32 + orow]);
#if A8_SUM16 == 2
            { const float rref = __builtin_amdgcn_rcpf(osa[r]); if (!(__builtin_fabsf(ra - rref) <= 1e-3f * rref)) ra = __builtin_nanf(""); }
#endif
#else
            const float ra = __builtin_amdgcn_rcpf(osa[r]), rb = __builtin_amdgcn_rcpf(osb[r]);
#endif
            stg[orow * 64 + l32] = pg8::f2bf1(oa0[r] * ra); stg[orow * 64 + 32 + l32] = pg8::f2bf1(oa1[r] * ra);
            stg[2048 + orow * 64 + l32] = pg8::f2bf1(ob0[r] * rb); stg[2048 + orow * 64 + 32 + l32] = pg8::f2bf1(ob1[r] * rb); }
        asm volatile("s_waitcnt lgkmcnt(0)" ::: "memory");
#pragma unroll
        for (int i2 = 0; i2 < 8; ++i2) { const int row = i2 * 8 + (lane_e >> 3), ch = lane_e & 7; const u32x4 v = *(const ALAS u32x4*)(stg + row * 64 + ch * 8);
            *(u32x4*)(T_MIX + (size_t)(qb * 512 + wid * 64 + row) * 1024 + head * 64 + ch * 8) = v; }
    }
    asm volatile("s_waitcnt lgkmcnt(0)\n\ts_barrier" ::: "memory");
#undef DMA8
#undef LD32
#undef PK8
}
}
static_assert(att::LDS_NEED <= RING_BYTES, "LDS map");

#define GAS __attribute__((address_space(1)))
#define LAS __attribute__((address_space(3)))
typedef unsigned short bf16;
typedef unsigned v4u __attribute__((ext_vector_type(4)));
typedef float f32x4 __attribute__((ext_vector_type(4)));
typedef GAS unsigned gu32;
#define RLX_AGENT __ATOMIC_RELAXED, __HIP_MEMORY_SCOPE_AGENT
#define LDS_WAIT() asm volatile("s_waitcnt lgkmcnt(0)" ::: "memory")
#define VM_WAIT() asm volatile("s_waitcnt vmcnt(0)" ::: "memory")
__device__ __forceinline__ unsigned f2bf(float f) { unsigned u = __builtin_bit_cast(unsigned, f); return (u + 0x7fffu + ((u >> 16) & 1u)) >> 16; }
__device__ __forceinline__ unsigned pk2(float lo, float hi) { return f2bf(lo) | (f2bf(hi) << 16); }
#define XB_TMO      128
#define XB_XCNT(j)  (256  + 64 * (j))
#define XB_XSUB(j)  (1280 + 64 * (j))
#define XB_XGEN(j)  (2304 + 64 * (j))
#define XB_TOP      3328
#define XB_TOPGEN   3392
#define XCD_BAR_WORDS 3456
#define XB_SPIN_CAP (1u << 18)

__device__ __forceinline__ unsigned xb_ld(unsigned* p)              { return __hip_atomic_load(p, __ATOMIC_RELAXED, __HIP_MEMORY_SCOPE_AGENT); }
__device__ __forceinline__ unsigned xb_add(unsigned* p, unsigned v) { return __hip_atomic_fetch_add(p, v, __ATOMIC_RELAXED, __HIP_MEMORY_SCOPE_AGENT); }
__device__ __forceinline__ unsigned xb_xcc_id() { return (unsigned)__builtin_amdgcn_s_getreg((3 << 11) | 20) & 0xFu; }
#define XB_SPIN(cond, bar) do { unsigned _sp = 0; while (cond) { __builtin_amdgcn_s_sleep(1); \
    if ((++_sp & 255u) == 0u) { if (xb_ld(&(bar)[XB_TMO])) break; if (_sp > XB_SPIN_CAP) { atomicAdd(&(bar)[XB_TMO], 1u); break; } } } } while (0)

struct XcdBarrier {
    unsigned* bar; unsigned x;
    volatile LAS unsigned* st;
};

__device__ __forceinline__ XcdBarrier xcd_barrier_post(unsigned* bar, volatile LAS unsigned* st, bool t0) {
    XcdBarrier b; b.bar = bar; b.x = (unsigned)__builtin_amdgcn_readfirstlane((int)xb_xcc_id()); b.st = st;
    if (t0) (void)xb_add(&bar[XB_XCNT(b.x)], 1u);
    return b;
}
__device__ __forceinline__ void xcd_barrier_complete(unsigned* bar, unsigned x, unsigned& nloc, unsigned& nx) {
    const unsigned G = gridDim.x * gridDim.y * gridDim.z;
    unsigned sum, cnt, mine, sp = 0u;
    for (;;) {
        sum = 0u; cnt = 0u; mine = 0u;
#pragma unroll
        for (unsigned j = 0; j < 16; ++j) { const unsigned c = xb_ld(&bar[XB_XCNT(j)]); sum += c; cnt += (c > 0u) ? 1u : 0u; mine = (j == x) ? c : mine; }
        if (sum == G) break;
        __builtin_amdgcn_s_sleep(1);
        if ((++sp & 255u) == 0u) { if (xb_ld(&bar[XB_TMO])) break; if (sp > XB_SPIN_CAP) { atomicAdd(&bar[XB_TMO], 1u); break; } }
    }
    nloc = mine > 0u ? mine : 1u; nx = cnt > 0u ? cnt : 1u;
}

__device__ __forceinline__ void xcd_barrier(const XcdBarrier& b_, int wave_id) {
    XcdBarrier b = b_; asm volatile("" : "+s"(b.bar), "+s"(b.x));
    const bool t0 = (wave_id == 0) && (lane_id_v() == 0);
    asm volatile("s_waitcnt vmcnt(0)" ::: "memory");
    __syncthreads();
    if (t0) {
        unsigned* bar = b.bar;
        __builtin_amdgcn_s_waitcnt(0);
        unsigned nloc = b.st[0], nx = b.st[1];
        if (nloc == 0u) { xcd_barrier_complete(bar, b.x, nloc, nx); b.st[0] = nloc; b.st[1] = nx; }
        const unsigned old = xb_add(&bar[XB_XSUB(b.x)], 1u);
        const unsigned gen = old / nloc;
        if (old + 1u == (gen + 1u) * nloc) {
            __builtin_amdgcn_fence(__ATOMIC_RELEASE, "agent");
            asm volatile("s_waitcnt vmcnt(0)" ::: "memory");
            const unsigned og = xb_add(&bar[XB_TOP], 1u);
            const unsigned tg = og / nx;
            if (og + 1u == (tg + 1u) * nx) xb_add(&bar[XB_TOPGEN], 1u);
            else XB_SPIN(xb_ld(&bar[XB_TOPGEN]) == tg, bar);
            __builtin_amdgcn_fence(__ATOMIC_ACQUIRE, "agent");
            xb_add(&bar[XB_XGEN(b.x)], 1u);
            asm volatile("s_waitcnt vmcnt(0)" ::: "memory");
        } else {
            XB_SPIN(xb_ld(&bar[XB_XGEN(b.x)]) == gen, bar);
            __builtin_amdgcn_fence(__ATOMIC_ACQUIRE, "agent");
            asm volatile("s_waitcnt vmcnt(0)" ::: "memory");
        }
    }
    __syncthreads();
}

__device__ __forceinline__ void xcd_barrier_local(const XcdBarrier& b_, int wave_id) {
    XcdBarrier b = b_; asm volatile("" : "+s"(b.bar), "+s"(b.x));
    const bool t0 = (wave_id == 0) && (lane_id_v() == 0);
    asm volatile("s_waitcnt vmcnt(0)" ::: "memory");
    __syncthreads();
    if (t0) {
        unsigned* bar = b.bar;
        __builtin_amdgcn_s_waitcnt(0);
        const unsigned nloc = b.st[0];
        const unsigned old = xb_add(&bar[XB_XSUB(b.x)], 1u);
        const unsigned gen = old / nloc;
        if (old + 1u == (gen + 1u) * nloc) xb_add(&bar[XB_XGEN(b.x)], 1u);
        else XB_SPIN(xb_ld(&bar[XB_XGEN(b.x)]) == gen, bar);
        __builtin_amdgcn_fence(__ATOMIC_ACQUIRE, "agent");
        asm volatile("s_waitcnt vmcnt(0)" ::: "memory");
    }
    __syncthreads();
}
#ifndef PHMASK
#define PHMASK 63
#endif
#ifndef ATT_DUP
#define ATT_DUP 1
#endif
#ifndef GU_ALIGN_EPI
#define GU_ALIGN_EPI true
#endif
#ifndef GU_PROBE
#define GU_PROBE 0
#endif
#ifndef GU_DUP
#define GU_DUP 1
#endif
#ifndef IN_DUP
#define IN_DUP 1
#endif
#ifndef D1_DUP
#define D1_DUP 1
#endif
#ifndef P0_DUP
#define P0_DUP 1
#endif
#ifndef NODEFER
#define DEFER_OK (G == 256)
#else
#define DEFER_OK false
#endif

__device__ __forceinline__ float wave_sum(float v) { v += xor_lane<1>(v); v += xor_lane<2>(v); v += xor_lane<4>(v); v += xor_lane<8>(v); v += xor_lane<16>(v); return sum_x32(v); }
__device__ __forceinline__ float wave_max(float v) { v = fmaxf(v, xor_lane<1>(v)); v = fmaxf(v, xor_lane<2>(v)); v = fmaxf(v, xor_lane<4>(v)); v = fmaxf(v, xor_lane<8>(v)); v = fmaxf(v, xor_lane<16>(v)); return max_x32(v); }
__device__ __forceinline__ void tr_item(const float* W, int ldw, int srccol0, const float* gain, bf16* WT, int K, int dstrow0, int k0, LAS float* scr, int lane) {
    const int kq = lane >> 3, nq = lane & 7;
    f32x4 w[8]; float g[8];
#pragma unroll
    for (int i = 0; i < 8; ++i) { const int kk = 8 * i + kq; w[i] = *(const GAS f32x4*)(W + (size_t)(k0 + kk) * ldw + srccol0 + 4 * nq); g[i] = gain ? gain[k0 + kk] : 1.0f; }
#pragma unroll
    for (int i = 0; i < 8; ++i) { const int kk = 8 * i + kq; LAS float* s = scr + kk * 33 + 4 * nq; s[0] = w[i][0] * g[i]; s[1] = w[i][1] * g[i]; s[2] = w[i][2] * g[i]; s[3] = w[i][3] * g[i]; }
    LDS_WAIT(); asm volatile("" ::: "memory");
    const int c = lane & 7;
#pragma unroll
    for (int j = 0; j < 4; ++j) { const int n = (lane >> 3) + 8 * j; const LAS float* s = scr + (8 * c) * 33 + n;
        v4u o; o.x = pk2(s[0 * 33], s[1 * 33]); o.y = pk2(s[2 * 33], s[3 * 33]); o.z = pk2(s[4 * 33], s[5 * 33]); o.w = pk2(s[6 * 33], s[7 * 33]);
        *(GAS v4u*)(WT + (size_t)(dstrow0 + n) * K + k0 + 8 * c) = o; }
    LDS_WAIT(); asm volatile("" ::: "memory");
}

#define TR_ONE(it_) do { int r = (it_); \
        if (r < 2 * I_GU) { const int l2 = r >= I_GU; if (l2) r -= I_GU; const int kb = r / (NGU / 32), nb = r % (NGU / 32), n0 = nb * 32, pn = n0 >> 8, j0 = n0 & 255; \
            const float* src = (j0 < 128) ? (l2 ? args.in[18] : args.in[2]) : (l2 ? args.in[19] : args.in[3]); \
            tr_item(src, FF, pn * 128 + (j0 & 127), l2 ? args.in[17] : args.in[1], (bf16*)(ws + (l2 ? WS_WGU2 : WS_WGU1)), D, n0, kb * 64, scr, lane); break; } \
        r -= 2 * I_GU; \
        if (r < 2 * I_D) { const int l2 = r >= I_D; if (l2) r -= I_D; const int kb = r / (D / 32), nb = r % (D / 32); \
            tr_item(l2 ? args.in[20] : args.in[4], D, nb * 32, nullptr, (bf16*)(ws + (l2 ? WS_WD2 : WS_WD1)), FF, nb * 32, kb * 64, scr, lane); break; } \
        r -= 2 * I_D; \
        if (r < I_IN) { const int kb = r / (NIN / 32), nb = r % (NIN / 32), n0 = nb * 32, pn = n0 >> 8, j0 = n0 & 255, bj = j0 >> 7, wc = (j0 >> 5) & 3; \
            tr_item(args.in[6], NIN, pn * 256 + wc * 64 + bj * 32, args.in[5], (bf16*)(ws + WS_WIN), D, n0, kb * 64, scr, lane); break; } \
        r -= I_IN; \
        { const int kb = r / (D / 32), nb = r % (D / 32); tr_item(args.in[16], D, nb * 32, nullptr, (bf16*)(ws + WS_WOUT), D, nb * 32, kb * 64, scr, lane); } } while (0)
constexpr int I_GU = (D / 64) * (NGU / 32), I_D = (FF / 64) * (D / 32), I_IN = (D / 64) * (NIN / 32), I_OUT = (D / 64) * (D / 32);
#define TR_DEFERRED(first_idle, IT0, IT1) do { if (bx >= (first_idle)) { const int lane = lane_id_v(); LAS float* scr = (LAS float*)(L + RING_OFF + wave * 16384); \
        const int nw_ = (G - (first_idle)) * NWAVES; for (int it = (IT0) + (bx - (first_idle)) * NWAVES + wave; it < (IT1); it += nw_) { TR_ONE(it); } } } while (0)
struct Args { const float* in[21]; float* out; unsigned char* ws; };
#define LAUNDER(p) asm volatile("" : "+s"(p))

__global__ void __launch_bounds__(NWAVES * 64, 2) mk_fwd(Args args) {
    extern __shared__ __attribute__((aligned(16))) unsigned char lds[];
    LAS unsigned char* L = (LAS unsigned char*)lds;
    volatile LAS unsigned* MISC = (volatile LAS unsigned*)(L + MISC_OFF);
    const int wave = __builtin_amdgcn_readfirstlane((int)threadIdx.x >> 6);
    const int G = gridDim.x; const int bx = blockIdx.x;
    unsigned char* ws = args.ws; float* out = args.out; LAUNDER_G(ws); LAUNDER_G(out);
    { const int tid = wave * 64 + lane_id_v(); for (int u = tid; u < (LDS_BYTES - LDSCTL_OFF) / 4; u += NWAVES * 64) ((LAS unsigned*)(L + LDSCTL_OFF))[u] = 0u; }
    __syncthreads();
    XcdBarrier bar = xcd_barrier_post((unsigned*)((gu32*)(ws + WS_CTL) + CW_BAR), MISC + 8, (wave == 0) && (lane_id_v() == 0));
#ifdef XLOCAL_BAR
    if ((wave == 0) && (lane_id_v() == 0)) (void)__hip_atomic_fetch_or((unsigned*)((gu32*)(ws + WS_CTL) + CW_XMAP) + 64 * (bx & 7), 1u << bar.x, RLX_AGENT);
#endif
    LAS float* rstd_tab = (LAS float*)(L + RSTD_OFF);
    LAS float* PRM = (LAS float*)(L + PRM_OFF);
    float pr0_ = 0.f, pr1_ = 0.f, pr2_ = 0.f, pr3_ = 0.f;
    { const int lane = lane_id_v();
      if (wave == 0) { pr0_ = ((const GAS float*)args.in[7])[lane]; pr1_ = ((const GAS float*)args.in[8])[lane]; }
      else if (wave == 1) { pr0_ = ((const GAS float*)args.in[9])[lane]; pr1_ = ((const GAS float*)args.in[10])[lane]; }
      else if (wave == 2) { pr0_ = ((const GAS float*)args.in[15])[lane]; pr1_ = ((const GAS float*)args.in[15])[64 + lane]; }
      else if (wave < 7) { const int h = wave - 3; pr0_ = ((const GAS float*)args.in[11])[h * 64 + lane]; pr1_ = ((const GAS float*)args.in[12])[h * 64 + lane]; pr2_ = ((const GAS float*)args.in[13])[h * 64 + lane]; pr3_ = ((const GAS float*)args.in[14])[h * 64 + lane]; } }
#define PRM_FINISH() do { const int lane = lane_id_v(); \
      if (wave == 0) { PRM[PRM_GAQ + lane] = pr0_; PRM[PRM_GAK + lane] = pr1_; const float ma_ = wave_max(fabsf(pr0_)), mk_ = wave_max(fabsf(pr1_)); if (lane == 0) PRM[PRM_NEGM2A] = -(8.0f * 1.4426950408889634f * 1.02f) * ma_ * mk_; } \
      else if (wave == 1) { PRM[PRM_GBQ + lane] = pr0_; PRM[PRM_GBK + lane] = pr1_; const float ma_ = wave_max(fabsf(pr0_)), mk_ = wave_max(fabsf(pr1_)); if (lane == 0) PRM[PRM_NEGM2B] = -(8.0f * 1.4426950408889634f * 1.02f) * ma_ * mk_; } \
      else if (wave == 2) { PRM[PRM_SUBLN + lane] = pr0_; PRM[PRM_SUBLN + 64 + lane] = pr1_; } \
      else if (wave < 7) { const float d1_ = wave_sum(pr0_ * pr1_), d2_ = wave_sum(pr2_ * pr3_); if (lane == 0) PRM[PRM_LAM + (wave - 3)] = expf(d1_) - expf(d2_) + 0.2f; } \
      LDS_WAIT(); } while (0)

#define BUILD_RSTD(S) do { pg8::Unit u_; const int tid = wave * 64 + lane_id_v(); const float* SSQ_ = (const float*)(ws + WS_SSQ); for (int i_ = 0; i_ < 6 && (S).next(i_, u_); ++i_) if (tid < 256) { const f32x4* p_ = (const f32x4*)(SSQ_ + (size_t)(u_.pm * 256 + tid) * 16); \
        const f32x4 a_ = p_[0], b_ = p_[1], c_ = p_[2], d_ = p_[3]; const float s_ = ((a_[0] + a_[1]) + (a_[2] + a_[3])) + ((b_[0] + b_[1]) + (b_[2] + b_[3])) + ((c_[0] + c_[1]) + (c_[2] + c_[3])) + ((d_[0] + d_[1]) + (d_[2] + d_[3])); \
        rstd_tab[i_ * 256 + tid] = 1.0f / sqrtf(s_ * (1.0f / 1024.0f) + 1e-6f); } LDS_WAIT(); __syncthreads(); } while (0)

#if (PHMASK & 1)
    for (int dup0 = 0; dup0 < P0_DUP; ++dup0) {
        if (dup0) xcd_barrier(bar, wave);
        const int lane = lane_id_v(), tid = wave * 64 + lane;
        const int vcu = (G % 8 == 0) ? (bx % 8) * (G / 8) + bx / 8 : bx;
        float* ROPE = (float*)(ws + WS_ROPE); float* SSQ = (float*)(ws + WS_SSQ); bf16* XB = (bf16*)(ws + WS_XB); const float* x = args.in[0];
        LAS float* scr = (LAS float*)(L + RING_OFF + wave * 16384);
        const int gw = vcu * NWAVES + wave, NGW = G * NWAVES;
        for (int it = gw; it < ((DEFER_OK) ? I_GU : 2 * I_GU + 2 * I_D + I_IN + I_OUT); it += NGW) { TR_ONE(it); }
#ifdef P0_X2
        for (int m = gw; m < M; m += 2 * NGW) {
            const int m2 = m + NGW; const bool h2 = m2 < M;
            const GAS f32x4* xr = (const GAS f32x4*)(x + (size_t)m * D) + lane; const GAS f32x4* xr2 = (const GAS f32x4*)(x + (size_t)(h2 ? m2 : m) * D) + lane; f32x4 v[4], w[4]; float s = 0.f, s2 = 0.f;
#pragma unroll
            for (int j = 0; j < 4; ++j) { v[j] = xr[64 * j]; w[j] = xr2[64 * j]; }
#pragma unroll
            for (int j = 0; j < 4; ++j) { s += (v[j][0] * v[j][0] + v[j][1] * v[j][1]) + (v[j][2] * v[j][2] + v[j][3] * v[j][3]); s2 += (w[j][0] * w[j][0] + w[j][1] * w[j][1]) + (w[j][2] * w[j][2] + w[j][3] * w[j][3]); }
            s = wave_sum(s); s2 = wave_sum(s2);
            GAS unsigned long long* o8 = (GAS unsigned long long*)(XB + (size_t)m * D) + lane;
#pragma unroll
            for (int j = 0; j < 4; ++j) o8[64 * j] = (unsigned long long)pk2(v[j][0], v[j][1]) | ((unsigned long long)pk2(v[j][2], v[j][3]) << 32);
            if (lane < 16) SSQ[(size_t)m * 16 + lane] = (lane == 0) ? s : 0.f;
            if (h2) { GAS unsigned long long* p8 = (GAS unsigned long long*)(XB + (size_t)m2 * D) + lane;
#pragma unroll
                for (int j = 0; j < 4; ++j) p8[64 * j] = (unsigned long long)pk2(w[j][0], w[j][1]) | ((unsigned long long)pk2(w[j][2], w[j][3]) << 32);
                if (lane < 16) SSQ[(size_t)m2 * 16 + lane] = (lane == 0) ? s2 : 0.f; }
        }
#else
        for (int m = gw; m < M; m += NGW) {
            const GAS f32x4* xr = (const GAS f32x4*)(x + (size_t)m * D) + lane; f32x4 v[4]; float s = 0.f;
#pragma unroll
            for (int j = 0; j < 4; ++j) { v[j] = xr[64 * j]; s += (v[j][0] * v[j][0] + v[j][1] * v[j][1]) + (v[j][2] * v[j][2] + v[j][3] * v[j][3]); }
            s = wave_sum(s);
            GAS unsigned long long* o8 = (GAS unsigned long long*)(XB + (size_t)m * D) + lane;
#pragma unroll
            for (int j = 0; j < 4; ++j) o8[64 * j] = (unsigned long long)pk2(v[j][0], v[j][1]) | ((unsigned long long)pk2(v[j][2], v[j][3]) << 32);
            if (lane < 16) SSQ[(size_t)m * 16 + lane] = (lane == 0) ? s : 0.f;
        }
#endif
        for (int e = bx * (NWAVES * 64) + tid; e < 5120; e += G * NWAVES * 64) {
            const int isc = e >= 4096, ee = isc ? e - 4096 : e, pos = ee >> 4, i = ee & 15;
#ifdef ROPE_FAST
            const float invf = __builtin_amdgcn_exp2f(-(float)i * (13.287712379549449f / 16.0f)); const float rev = (float)pos * invf * 0.15915494309189535f;
            const float fr_ = rev - __builtin_floorf(rev); const float sn = __builtin_amdgcn_sinf(fr_), cs = __builtin_amdgcn_cosf(fr_);
#else
            const float invf = powf(10000.0f, -(float)i * (1.0f / 16.0f)); const float ang = (float)pos * invf; float sn, cs; sincosf(ang, &sn, &cs);
#endif
            if (isc) { ROPE[8192 + ee] = cs; ROPE[9216 + ee] = sn; } else { ROPE[ee] = cs; ROPE[4096 + ee] = sn; }
        }
    }
#endif
    PRM_FINISH();
    xcd_barrier(bar, wave);
#ifdef XLOCAL_BAR
    if ((wave == 0) && (lane_id_v() == 0)) { unsigned ok = (G == 256) ? 1u : 0u;
        for (int g_ = 0; g_ < 8; ++g_) { const unsigned m_ = __hip_atomic_load((unsigned*)((gu32*)(ws + WS_CTL) + CW_XMAP) + 64 * g_, RLX_AGENT); if (m_ == 0u || (m_ & (m_ - 1u))) ok = 0u; }
        MISC[14] = ok; }
    LDS_WAIT(); __syncthreads();
    const bool xloc = __builtin_amdgcn_readfirstlane((int)MISC[14]) != 0;
#define SEAM_LOCAL_BARRIER() do { if (xloc) xcd_barrier_local(bar, wave); else xcd_barrier(bar, wave); } while (0)
#else
#define SEAM_LOCAL_BARRIER() xcd_barrier(bar, wave)
#endif

    for (int rep = 0; rep < 2; ++rep) {
#if (PHMASK & 2)
        {
            LAUNDER_G(ws);
            pg8::Gemm g{(const bf16*)(ws + WS_XB), (const bf16*)(ws + (rep ? WS_WGU2 : WS_WGU1)), M, NGU, D}; pg8::StaticOrderT<M, NGU> S; int bxs_ = bx, Gs_ = G; LAUNDER(bxs_); LAUNDER(Gs_); S.init(Gs_, bxs_);
#if defined(SPLITK_GU2)
            { pg8::SplitTailOrderT<pg8::StaticOrderT<M, NGU>, 5, D / 64> SKr{S, (rep == 1) && (G == 256)}; BUILD_RSTD(SKr); }
#else
            BUILD_RSTD(S);
#endif
            pg8::EpiSwiGLU E{ws, rstd_tab};
            for (int dup = 0; dup < GU_DUP; ++dup) { if (dup) xcd_barrier(bar, wave);
#if defined(CLK_PROBE_GU)
            unsigned long long c0_ = __builtin_amdgcn_s_memtime(), r0_ = __builtin_amdgcn_s_memrealtime();
#endif
#if defined(SPLITK_GU2)
            {
                typedef pg8::SplitTailOrderT<pg8::StaticOrderT<M, NGU>, 5, D / 64> SKO; SKO SK{S, (rep == 1) && (G == 256)};
                pg8::EpiSwiGLUSplit E2{ws, rstd_tab};
                pg8::gemm_phase<D, pg8::EpiSwiGLUSplit, SKO, true, true, D, true>(L + RING_OFF, g, SK, E2, wave);
            }
#else
#if defined(GU_NULLEPI)
            if (dup < GU_DUP - 1) { pg8::EpiNull EN; pg8::gemm_phase<D, pg8::EpiNull, pg8::StaticOrderT<M, NGU>, true, true>(L + RING_OFF, g, S, EN, wave); } else
#endif
            pg8::gemm_phase<D, pg8::EpiSwiGLU, pg8::StaticOrderT<M, NGU>, GU_ALIGN_EPI, true>(L + RING_OFF, g, S, E, wave, (dup < GU_DUP - 1) ? GU_PROBE : 0);
#endif
            if (rep == 0 && dup == 0 && DEFER_OK) { TR_DEFERRED(128, 2 * I_GU, 2 * I_GU + I_D); TR_DEFERRED(128, 2 * I_GU + 2 * I_D, 2 * I_GU + 2 * I_D + I_IN); }
#if defined(CLK_PROBE_GU)
            if (rep == 0 && bx == 0) { const unsigned long long c1_ = __builtin_amdgcn_s_memtime(), r1_ = __builtin_amdgcn_s_memrealtime(); const unsigned long long spin_ = 1000ull * (c1_ - c0_) / (r1_ - r0_); while (__builtin_amdgcn_s_memrealtime() - r1_ < spin_) __builtin_amdgcn_s_sleep(8); }
#endif
            }
        }
#endif
        if (rep == 1) { SEAM_LOCAL_BARRIER(); } else xcd_barrier(bar, wave);
#if (PHMASK & 4)
        {
            LAUNDER_G(ws); LAUNDER_G(out);
            pg8::Gemm g{(const bf16*)(ws + WS_H), (const bf16*)(ws + (rep ? WS_WD2 : WS_WD1)), M, D, FF}; pg8::StaticOrderT<M, D> S; int bxs_ = bx, Gs_ = G; LAUNDER(bxs_); LAUNDER(Gs_); S.init(Gs_, bxs_);
            if (rep == 0) { pg8::EpiResid<true, true, false> E{nullptr, nullptr, ws, 0.5f}; for (int dup = 0; dup < D1_DUP; ++dup) { if (dup) xcd_barrier(bar, wave);
#if defined(D1_NULLEPI)
                if (dup) { pg8::EpiNull EN; pg8::gemm_phase<FF, pg8::EpiNull, pg8::StaticOrderT<M, D>, true, true>(L + RING_OFF, g, S, EN, wave); continue; }
#endif
#if defined(D1_SCRATCH)
                if (dup) { pg8::EpiResidStaged<true, false> ES{nullptr, ws, 0.5f, ws + (140u << 20)}; pg8::gemm_phase<FF, pg8::EpiResidStaged<true, false>, pg8::StaticOrderT<M, D>, false, true>(L + RING_OFF, g, S, ES, wave); continue; }
#endif
                pg8::gemm_phase<FF, pg8::EpiResid<true, true, false>, pg8::StaticOrderT<M, D>, true, true>(L + RING_OFF, g, S, E, wave); } }
            else {
#if defined(D7_DUP) && defined(D7_PROBE1)
                for (int dup = 0; dup < D7_DUP; ++dup) { if (dup) xcd_barrier(bar, wave);
                    if (dup < D7_DUP - 1) { pg8::EpiResid<true, false, true, 1> EP{nullptr, out, ws, 0.5f}; pg8::gemm_phase<FF, pg8::EpiResid<true, false, true, 1>, pg8::StaticOrderT<M, D>, true, true>(L + RING_OFF, g, S, EP, wave); }
                    else { pg8::EpiResid<true, false, true> E{nullptr, out, ws, 0.5f}; pg8::gemm_phase<FF, pg8::EpiResid<true, false, true>, pg8::StaticOrderT<M, D>, true, true>(L + RING_OFF, g, S, E, wave); } }
#elif defined(D7_DUP)
                pg8::EpiResid<true, false, true> E{nullptr, out, ws, 0.5f};
#pragma unroll 1
                for (int dup = 0; dup < D7_DUP; ++dup) { if (dup) xcd_barrier(bar, wave); pg8::gemm_phase<FF, pg8::EpiResid<true, false, true>, pg8::StaticOrderT<M, D>, true, true>(L + RING_OFF, g, S, E, wave); }
#else
                pg8::EpiResid<true, false, true> E{nullptr, out, ws, 0.5f}; pg8::gemm_phase<FF, pg8::EpiResid<true, false, true>, pg8::StaticOrderT<M, D>, true, true>(L + RING_OFF, g, S, E, wave);
#endif
            }
        }
#endif
        if (rep == 1) break;
        SEAM_LOCAL_BARRIER();
#if (PHMASK & 8)
        {
            LAUNDER_G(ws);
            pg8::Gemm g{(const bf16*)(ws + WS_XB), (const bf16*)(ws + WS_WIN), M, NIN, D}; pg8::StaticOrderT<M, NIN> S; int bxs_ = bx, Gs_ = G; LAUNDER(bxs_); LAUNDER(Gs_); S.init(Gs_, bxs_);
            BUILD_RSTD(S);
            pg8::EpiInProj E{rstd_tab, PRM, ws};
            for (int dup = 0; dup < IN_DUP; ++dup) { if (dup) xcd_barrier(bar, wave);
#if defined(IN_NULLEPI)
            if (dup < IN_DUP - 1) { pg8::EpiNull EN; pg8::gemm_phase<D, pg8::EpiNull, pg8::StaticOrderT<M, NIN>, true, true>(L + RING_OFF, g, S, EN, wave); } else
#endif
#if defined(IN_IPROBE)
            if (dup < IN_DUP - 1) { pg8::EpiInProjT<IN_IPROBE> EP{rstd_tab, PRM, ws}; pg8::gemm_phase<D, pg8::EpiInProjT<IN_IPROBE>, pg8::StaticOrderT<M, NIN>, true, true>(L + RING_OFF, g, S, EP, wave); } else
#endif
            pg8::gemm_phase<D, pg8::EpiInProj, pg8::StaticOrderT<M, NIN>, true, true>(L + RING_OFF, g, S, E, wave);
            if (dup == 0 && DEFER_OK) { TR_DEFERRED(64, I_GU, 2 * I_GU); TR_DEFERRED(64, 2 * I_GU + I_D, 2 * I_GU + 2 * I_D); TR_DEFERRED(64, 2 * I_GU + 2 * I_D + I_IN, 2 * I_GU + 2 * I_D + I_IN + I_OUT); } }
        }
#endif
        xcd_barrier(bar, wave);
#if (PHMASK & 16)
        for (int dup = 0; dup < ATT_DUP; ++dup) {
            LAUNDER_G(ws);
            if (dup) xcd_barrier(bar, wave);
            gu32* qhead = (gu32*)(ws + WS_CTL) + CW_QUEUE + 64 * dup;
#if defined(CLK_PROBE)
            unsigned long long c0_ = __builtin_amdgcn_s_memtime(), r0_ = __builtin_amdgcn_s_memrealtime();
#endif
            const att::Tensors T = att::make_tensors(ws, PRM);
            const bool st = (G == 256);
            const int xg = bx & 7, cg = bx >> 3;
            for (int step = 0;; ++step) {
                int kind, h, qb;
                if (st && step < 2) {
                    if (step < 1) { kind = 0; h = xg; qb = cg; }
                    else { kind = 1; h = (xg < 4) ? 3 : 2; qb = 32 * (xg & 3) + cg; }
                } else {
                    if ((wave == 0) && (lane_id_v() == 0)) MISC[12] = __hip_atomic_fetch_add(qhead, 1u, RLX_AGENT);
                    LDS_WAIT(); __syncthreads();
                    int idx = __builtin_amdgcn_readfirstlane((int)MISC[12]);
                    if (st) idx += 512;
                    if (idx >= 768) break;
                    if (idx < 256 || idx >= 512) { kind = 1;
                        if (idx < 128) { h = 3; qb = idx; } else if (idx < 256) { const int i = idx - 128; h = 2; qb = (i & 1) ? 63 - (i >> 1) : 64 + (i >> 1); }
                        else if (idx < 640) { h = 1; qb = idx - 512; } else { h = 0; qb = idx - 640; }
                    } else { kind = 0; const int i = idx - 256; h = i >> 5; qb = i & 31; }
                }
#if defined(DUP_ONLY_A)
                if (dup && kind) continue;
#elif defined(DUP_ONLY_B)
                if (dup && !kind) continue;
#endif
                if (kind) {
                    const float slope = (h == 0) ? 0.25f : (h == 1) ? 0.0625f : (h == 2) ? 0.015625f : 0.00390625f;
                    const float c2 = slope * 1.4426950408889634f; const int dskip = (int)(150.0f / c2) + 1;
#if defined(B_PROBE_DUP)
                    if (dup < ATT_DUP - 1) att::attn_unit<true, B_PROBE_DUP>(T, h, qb, PRM[PRM_NEGM2B], PRM[PRM_LAM + h], c2, dskip, (char*)lds + RING_OFF, wave); else
#endif
                    att::attn_unit<true>(T, h, qb, PRM[PRM_NEGM2B], PRM[PRM_LAM + h], c2, dskip, (char*)lds + RING_OFF, wave);
                } else {
#if defined(A8_NOEXP_DUP)
                    if (dup < ATT_DUP - 1) att::attn_unit_a8x2<A8U, A8_NOEXP_DUP>(T, h, qb, PRM[PRM_NEGM2A] + 8.0f, (char*)lds + RING_OFF, wave); else
#endif
                    att::attn_unit_a8x2<A8U>(T, h, qb, PRM[PRM_NEGM2A] + 8.0f, (char*)lds + RING_OFF, wave); }
            }
#if defined(CLK_PROBE)
            if (dup == ATT_DUP - 1 && bx == 0) { const unsigned long long c1_ = __builtin_amdgcn_s_memtime(), r1_ = __builtin_amdgcn_s_memrealtime(); const unsigned long long spin_ = 1000ull * (c1_ - c0_) / (r1_ - r0_); while (__builtin_amdgcn_s_memrealtime() - r1_ < spin_) __builtin_amdgcn_s_sleep(8); }
#endif
        }
#endif
        xcd_barrier(bar, wave);
#if (PHMASK & 32)
        {
            LAUNDER_G(ws); LAUNDER_G(out);
            pg8::Gemm g{(const bf16*)(ws + WS_MIX), (const bf16*)(ws + WS_WOUT), M, D, D}; pg8::StaticOrderT<M, D> S; int bxs_ = bx, Gs_ = G; LAUNDER(bxs_); LAUNDER(Gs_); S.init(Gs_, bxs_);
            pg8::EpiResid<true, true, false> E{nullptr, nullptr, ws, 1.0f}; pg8::gemm_phase<D, pg8::EpiResid<true, true, false>, pg8::StaticOrderT<M, D>, true, true>(L + RING_OFF, g, S, E, wave);
        }
#endif
        SEAM_LOCAL_BARRIER();
    }
}

extern "C" void kernel_launch(void* const* d_in, const int* in_sizes, int n_in, void* d_out, int out_size, void* d_ws, size_t ws_size, hipStream_t stream) {
    static int grid = 0;
    if (grid == 0) {
        if (n_in != 21 || in_sizes[0] != M * D || out_size != M * D || ws_size < WS_END) { fprintf(stderr, "kernel_launch: unexpected shapes (n_in %d, in0 %d, out %d, ws %zu)\n", n_in, n_in > 0 ? in_sizes[0] : -1, out_size, ws_size); grid = -1; return; }
        int dev = 0, cus = 0, per_cu = 0;
        if (hipGetDevice(&dev) != hipSuccess || hipDeviceGetAttribute(&cus, hipDeviceAttributeMultiprocessorCount, dev) != hipSuccess) { grid = -1; return; }
        if (hipFuncSetAttribute((const void*)mk_fwd, hipFuncAttributeMaxDynamicSharedMemorySize, LDS_BYTES) != hipSuccess) { fprintf(stderr, "kernel_launch: hipFuncSetAttribute failed\n"); grid = -1; return; }
        if (hipOccupancyMaxActiveBlocksPerMultiprocessor(&per_cu, (const void*)mk_fwd, NWAVES * 64, LDS_BYTES) != hipSuccess || per_cu < 1) { fprintf(stderr, "kernel_launch: occupancy query says %d blocks per CU\n", per_cu); (void)hipGetLastError(); grid = -1; return; }
        grid = cus;
    }
    if (grid < 0) return;
    if (hipMemsetAsync((char*)d_ws + WS_CTL, 0, CTL_ZERO_BYTES, stream) != hipSuccess) { fprintf(stderr, "kernel_launch: memset failed\n"); return; }
    Args a{};
    for (int i = 0; i < 21; ++i) a.in[i] = (const float*)d_in[i];
    a.out = (float*)d_out; a.ws = (unsigned char*)d_ws;
    hipLaunchKernelGGL(mk_fwd, dim3(grid), dim3(NWAVES * 64), LDS_BYTES, stream, a);
    const hipError_t le = hipPeekAtLastError();
    if (le != hipSuccess) fprintf(stderr, "kernel_launch: launch failed: %s\n", hipGetErrorName(le));
}
```
